# Optimizing an MI355X kernel written in HIP

```python
import jax
import jax.numpy as jnp
from jax import lax
import numpy as np

D_MODEL = 1024
BATCH = 4
SEQ = 8192
DEPTH = 4

GRID_W = 64
CTX_LEN = 256
N_MIXERS = 3
NORM_EPS = 1e-6

ML_HEADS = 8
ML_HEAD_DIM = D_MODEL // ML_HEADS
ML_CHUNK = 64

RW_HEAD_DIM = 64
RW_HEADS = D_MODEL // RW_HEAD_DIM
RW_DECAY_LORA = 64
RW_ICLR_LORA = 64
RW_GATE_LORA = 128
RW_GN_EPS = 64e-5

HG_EXPAND = 128
HG_HEADS = D_MODEL // HG_EXPAND
HG_CHUNK = 32

N_EXPERTS = 16
N_GROUPS = 4
EXPERTS_PER_GROUP = N_EXPERTS // N_GROUPS
TOP_K = 2
D_EXPERT = 512
MOE_BLOCK = 256

kernel_name = 'hybrid_mlstm_rwkv7_hgrn2_moe_dit'


def rmsnorm(x, g):
    xf = x.astype(jnp.float32)
    y = xf * lax.rsqrt(jnp.mean(xf * xf, axis=-1, keepdims=True) + NORM_EPS)
    return (y * g.astype(jnp.float32)).astype(x.dtype)


def split_ctx(a, axis):
    return (lax.slice_in_dim(a, 0, CTX_LEN, axis=axis),
            lax.slice_in_dim(a, CTX_LEN, a.shape[axis], axis=axis))


def modulate(h, shift_c, scale_c, shift_x, scale_x):
    h_c, h_x = split_ctx(h, 1)
    return jnp.concatenate([h_c * (1 + scale_c) + shift_c, h_x * (1 + scale_x) + shift_x], axis=1)


def gated_residual(s, y, gate_c, gate_x):
    y_c, y_x = split_ctx(y, 1)
    return s + jnp.concatenate([y_c * gate_c, y_x * gate_x], axis=1)


def to_heads(a, n_heads):
    b, t, d = a.shape
    return a.reshape(b, t, n_heads, d // n_heads).transpose(0, 2, 1, 3)


def from_heads(a):
    b, h, t, dh = a.shape
    return a.transpose(0, 2, 1, 3).reshape(b, t, h * dh)


def head_rmsnorm(o, g):
    o = o * lax.rsqrt(jnp.mean(o * o, axis=-1, keepdims=True) + NORM_EPS)
    return from_heads(o) * g.astype(jnp.float32)


def to_chunks(a, size):
    b, h, t = a.shape[:3]
    return jnp.moveaxis(a.reshape(b, h, t // size, size, *a.shape[3:]), 2, 0)


def from_chunks(a):
    nc, b, h, size = a.shape[:4]
    return jnp.moveaxis(a, 0, 2).reshape(b, h, nc * size, *a.shape[4:])


def conv1d_centred(x, w):
    xp = jnp.pad(x, ((0, 0), (1, 1), (0, 0)))
    return xp[:, :-2] * w[0] + xp[:, 1:-1] * w[1] + xp[:, 2:] * w[2]


def conv_grid(x, w, rows):
    b, t, ch = x.shape
    y = lax.conv_general_dilated(x.reshape(b, rows, GRID_W, ch), w[:, :, None, :].astype(x.dtype),
                                 (1, 1), 'SAME', dimension_numbers=('NHWC', 'HWIO', 'NHWC'),
                                 feature_group_count=ch)
    return y.reshape(b, t, ch)


def centred_shift(a):
    ap = jnp.pad(a, ((0, 0), (1, 1), (0, 0)))
    return 0.5 * (ap[:, :-2] + ap[:, 2:]) - a


def bidirectional(scan_fn, fwd_in, bwd_in, init):
    def run(inputs, reverse):
        parts = [split_ctx(a, 2) for a in inputs]
        ctx_in = tuple(p[0] for p in parts)
        lat_in = tuple(p[1] for p in parts)
        if reverse:
            ctx_in = tuple(jnp.flip(a, 2) for a in ctx_in)
            lat_in = tuple(jnp.flip(a, 2) for a in lat_in)
        y_ctx, state = scan_fn(ctx_in, init)
        y_lat, _ = scan_fn(lat_in, state)
        if reverse:
            y_ctx, y_lat = jnp.flip(y_ctx, 2), jnp.flip(y_lat, 2)
        return jnp.concatenate([y_ctx, y_lat], axis=2)
    return run(fwd_in, False) + run(bwd_in, True)


def mlstm_chunk_scan(inputs, state):
    causal = jnp.tril(jnp.ones((ML_CHUNK, ML_CHUNK), bool))

    def step(carry, blk):
        C, n, m = carry
        qc, kc, vc, ic, fc = blk
        b = jnp.cumsum(fc, axis=-1)
        d = jnp.where(causal, b[..., :, None] - b[..., None, :] + ic[..., None, :], -jnp.inf)
        inter = b + m[..., None]
        m_t = jnp.maximum(inter, jnp.max(d, axis=-1))
        s = jnp.einsum('bhtd,bhsd->bhts', qc, kc) * jnp.exp(d - m_t[..., None])
        w_inter = jnp.exp(inter - m_t)
        num = (jnp.einsum('bhts,bhsv->bhtv', s, vc)
               + w_inter[..., None] * jnp.einsum('bhvd,bhtd->bhtv', C, qc))
        den = jnp.sum(s, axis=-1) + w_inter * jnp.einsum('bhd,bhtd->bht', n, qc)
        h = num / jnp.maximum(jnp.abs(den), jnp.exp(-m_t))[..., None]
        b_last = b[..., -1]
        d_last = b_last[..., None] - b + ic
        m_new = jnp.maximum(b_last + m, jnp.max(d_last, axis=-1))
        w_k = jnp.exp(d_last - m_new[..., None])
        w_prev = jnp.exp(b_last + m - m_new)
        C = w_prev[..., None, None] * C + jnp.einsum('bhs,bhsv,bhsd->bhvd', w_k, vc, kc)
        n = w_prev[..., None] * n + jnp.einsum('bhs,bhsd->bhd', w_k, kc)
        return (C, n, m_new), h

    state, h = lax.scan(step, state, tuple(to_chunks(a, ML_CHUNK) for a in inputs))
    return from_chunks(h), state


def mlstm_mixer(u, rows, w_in, w_gate, b_gate, conv, head_g, w_out):
    f32 = jnp.float32
    z = u @ w_in
    qk = z[..., :2 * D_MODEL]
    v = z[..., 2 * D_MODEL:3 * D_MODEL]
    o_gate = jax.nn.sigmoid(z[..., 3 * D_MODEL:].astype(f32))
    qk_c, qk_x = split_ctx(qk, 1)
    qk = jax.nn.silu(jnp.concatenate([conv1d_centred(qk_c, conv[1]), conv_grid(qk_x, conv, rows)], axis=1))
    q = to_heads(qk[..., :D_MODEL], ML_HEADS).astype(f32)
    k = to_heads(qk[..., D_MODEL:], ML_HEADS).astype(f32) * ML_HEAD_DIM ** -0.5
    vh = to_heads(v, ML_HEADS).astype(f32)
    gates = (jnp.einsum('btd,rdg->rbgt', u, w_gate) + b_gate[:, None, :, None]).astype(f32)
    ig = gates[:, :, :ML_HEADS]
    lf = jax.nn.log_sigmoid(gates[:, :, ML_HEADS:])
    bsz = u.shape[0]
    init = (jnp.zeros((bsz, ML_HEADS, ML_HEAD_DIM, ML_HEAD_DIM), f32),
            jnp.zeros((bsz, ML_HEADS, ML_HEAD_DIM), f32),
            jnp.zeros((bsz, ML_HEADS), f32))
    h = bidirectional(mlstm_chunk_scan, (q, k, vh, ig[0], lf[0]), (q, k, vh, ig[1], lf[1]), init)
    y = head_rmsnorm(h, head_g) * o_gate
    return y.astype(u.dtype) @ w_out


def rwkv7_step_scan(inputs, state):
    seq = tuple(jnp.moveaxis(a, 2, 0) for a in inputs)

    def step(S, t_in):
        w_t, r_t, k_t, v_t, kk_t, akk_t = t_in
        S = (S * w_t[:, :, None, :]
             + jnp.einsum('bhvk,bhk->bhv', S, -kk_t)[..., None] * akk_t[:, :, None, :]
             + v_t[..., None] * k_t[:, :, None, :])
        return S, jnp.einsum('bhvk,bhk->bhv', S, r_t)

    state, out = lax.scan(step, state, seq, unroll=8)
    return jnp.moveaxis(out, 0, 2), state


def rwkv7_mixer(u, mu, w_rkv, w0, w1, w2, a0, a1, a2, g1, g2, k_k, k_a, r_k, ln_w, ln_b, w_out):
    f32 = jnp.float32
    u_c, u_x = split_ctx(u, 1)
    du = jnp.concatenate([centred_shift(u_c), centred_shift(u_x)], axis=1)

    def mix(idx):
        return u + du * mu[idx]

    r = (mix(0) @ w_rkv[0]).astype(f32)
    k = (mix(1) @ w_rkv[1]).astype(f32)
    v = (mix(2) @ w_rkv[2]).astype(f32)
    w_pre = w0[:, None, None, :] + jnp.einsum(
        'rbtl,rle->rbte', jnp.tanh(jnp.einsum('btd,rdl->rbtl', mix(3), w1)), w2)
    decay = jnp.exp(-jnp.exp(-jax.nn.softplus(-w_pre.astype(f32)) - 0.5))
    a = jax.nn.sigmoid((a0[:, None, None, :] + jnp.einsum(
        'rbtl,rle->rbte', jnp.einsum('btd,rdl->rbtl', mix(4), a1), a2)).astype(f32))
    g = (jax.nn.sigmoid(mix(5) @ g1) @ g2).astype(f32)
    kk = to_heads(k * k_k, RW_HEADS)
    kk = kk * lax.rsqrt(jnp.maximum(jnp.sum(kk * kk, axis=-1, keepdims=True), 1e-24))
    k_dir = k[None] * (1.0 + (a - 1.0) * k_a)
    rh = to_heads(r, RW_HEADS)
    vh = to_heads(v, RW_HEADS)
    kf = to_heads(k_dir[0], RW_HEADS)
    kb = to_heads(k_dir[1], RW_HEADS)
    fwd = (to_heads(decay[0], RW_HEADS), rh, kf, vh, kk, kk * to_heads(a[0], RW_HEADS))
    bwd = (to_heads(decay[1], RW_HEADS), rh, kb, vh, kk, kk * to_heads(a[1], RW_HEADS))
    bsz = u.shape[0]
    init = jnp.zeros((bsz, RW_HEADS, RW_HEAD_DIM, RW_HEAD_DIM), f32)
    o = bidirectional(rwkv7_step_scan, fwd, bwd, init)
    mean = jnp.mean(o, axis=-1, keepdims=True)
    var = jnp.mean(jnp.square(o - mean), axis=-1, keepdims=True)
    o = from_heads((o - mean) * lax.rsqrt(var + RW_GN_EPS)) * ln_w + ln_b
    r_k_h = r_k.reshape(RW_HEADS, 1, RW_HEAD_DIM)
    bonus = from_heads(jnp.sum(rh * (kf + kb) * r_k_h, axis=-1, keepdims=True) * vh)
    y = (o + bonus) * g
    return y.astype(u.dtype) @ w_out


def hgrn2_chunk_scan(inputs, state):
    causal = jnp.tril(jnp.ones((HG_CHUNK, HG_CHUNK), bool))[:, :, None]

    def step(S, blk):
        qc, kc, vc, gc = blk
        b = jnp.cumsum(gc, axis=2)
        decay = jnp.exp(jnp.where(causal, b[:, :, :, None, :] - b[:, :, None, :, :], -jnp.inf))
        att = jnp.einsum('bhtk,bhtsk,bhsk->bhts', qc, decay, kc)
        o = (jnp.einsum('bhts,bhsv->bhtv', att, vc)
             + jnp.einsum('bhtk,bhkv->bhtv', qc * jnp.exp(b), S))
        b_last = b[:, :, -1:]
        S = (jnp.exp(b_last[:, :, 0])[..., None] * S
             + jnp.einsum('bhsk,bhsv->bhkv', kc * jnp.exp(b_last - b), vc))
        return S, o

    state, o = lax.scan(step, state, tuple(to_chunks(a, HG_CHUNK) for a in inputs))
    return from_chunks(o), state


def hgrn2_mixer(u, layer_idx, w_in, w_f, b_f, lb_logits, head_g, w_out):
    f32 = jnp.float32
    z = u @ w_in
    q = to_heads(jax.nn.silu(z[..., :D_MODEL]), HG_HEADS).astype(f32)
    v = to_heads(z[..., D_MODEL:2 * D_MODEL], HG_HEADS).astype(f32)
    out_gate = jax.nn.silu(z[..., 2 * D_MODEL:].astype(f32))
    p = jax.nn.softmax(lb_logits.astype(f32), axis=0)
    lb = jnp.cumsum(p, axis=0)[layer_idx] - p[0]
    f_pre = (jnp.einsum('btd,rde->rbte', u, w_f) + b_f[:, None, None, :]).astype(f32)
    log_f = jnp.logaddexp(jnp.log(lb), jnp.log1p(-lb) + jax.nn.log_sigmoid(f_pre))
    key = -jnp.expm1(log_f)
    fwd = (q, to_heads(key[0], HG_HEADS), v, to_heads(log_f[0], HG_HEADS))
    bwd = (q, to_heads(key[1], HG_HEADS), v, to_heads(log_f[1], HG_HEADS))
    bsz = u.shape[0]
    init = jnp.zeros((bsz, HG_HEADS, HG_EXPAND, D_MODEL // HG_HEADS), f32)
    o = bidirectional(hgrn2_chunk_scan, fwd, bwd, init)
    y = head_rmsnorm(o, head_g) * out_gate
    return y.astype(u.dtype) @ w_out


def expert_dispatch(h, expert_idx, gate, w1, w3, w2):
    n_tok, d = h.shape
    n_assign = n_tok * TOP_K
    flat_e = expert_idx.reshape(n_assign)
    order = jnp.argsort(flat_e)
    sorted_e = flat_e[order]
    counts = jnp.zeros((N_EXPERTS,), jnp.int32).at[flat_e].add(1)
    padded = (counts + MOE_BLOCK - 1) // MOE_BLOCK * MOE_BLOCK
    start_sorted = jnp.cumsum(counts) - counts
    end_pad = jnp.cumsum(padded)
    start_pad = end_pad - padded
    dest = start_pad[sorted_e] + jnp.arange(n_assign, dtype=jnp.int32) - start_sorted[sorted_e]
    n_blocks = -(-n_assign // MOE_BLOCK) + N_EXPERTS
    token_of_slot = jnp.full((n_blocks * MOE_BLOCK,), n_tok, jnp.int32).at[dest].set(
        (order // TOP_K).astype(jnp.int32))
    block_expert = jnp.minimum(jnp.searchsorted(
        end_pad, jnp.arange(n_blocks, dtype=jnp.int32) * MOE_BLOCK, side='right'), N_EXPERTS - 1)
    h_pad = jnp.concatenate([h, jnp.zeros((1, d), h.dtype)], axis=0)
    xb = h_pad[token_of_slot].reshape(n_blocks, MOE_BLOCK, d)

    def block_ffn(args):
        xe, e = args
        return (jax.nn.silu(xe @ w1[e]) * (xe @ w3[e])) @ w2[e]

    yb = lax.map(block_ffn, (xb, block_expert)).reshape(n_blocks * MOE_BLOCK, d)
    contrib = yb[dest].astype(jnp.float32) * gate.reshape(n_assign)[order][:, None]
    out = jnp.zeros((n_tok, d), jnp.float32).at[order // TOP_K].add(contrib)
    return out.astype(h.dtype)


def grouped_moe(h, router_w, router_b, w1, w3, w2):
    n_tok = h.shape[0]
    affinity = jax.nn.sigmoid((h @ router_w).astype(jnp.float32))
    sel = (affinity + router_b.astype(jnp.float32)).reshape(n_tok, N_GROUPS, EXPERTS_PER_GROUP)
    group_score = jnp.sum(lax.top_k(sel, 2)[0], axis=-1)
    best_group = jnp.argmax(group_score, axis=-1).astype(jnp.int32)
    in_group = jnp.take_along_axis(sel, best_group[:, None, None], axis=1)[:, 0]
    local = lax.top_k(in_group, TOP_K)[1]
    expert_idx = best_group[:, None] * EXPERTS_PER_GROUP + local
    chosen = jnp.take_along_axis(affinity, expert_idx, axis=1)
    gate = chosen / jnp.sum(chosen, axis=-1, keepdims=True)
    return expert_dispatch(h, expert_idx, gate, w1, w3, w2)


def setup_inputs(seed: int = 0) -> dict:
    key = jax.random.key(seed)
    keys = iter(jax.random.split(key, 64))

    def nrm(shape, scale):
        return scale * jax.random.normal(next(keys), shape, jnp.float32)

    D, E, F = D_MODEL, N_EXPERTS, D_EXPERT
    n_a = len(range(0, DEPTH, N_MIXERS))
    n_b = len(range(1, DEPTH, N_MIXERS))
    n_c = len(range(2, DEPTH, N_MIXERS))
    inv_d = D ** -0.5
    return {
        'x': nrm((BATCH, SEQ, D), 1.0),
        'c': nrm((BATCH, D), 1.0),
        'ctx': nrm((BATCH, CTX_LEN, D), 1.0),
        'c_ctx': nrm((D,), 1.0),
        'ada_w': nrm((DEPTH, D, 6 * D), 0.5 * inv_d),
        'ada_b': nrm((DEPTH, 6 * D), 0.02),
        'norm_mix': 1.0 + nrm((DEPTH, D), 0.05),
        'norm_ffn': 1.0 + nrm((DEPTH, D), 0.05),
        'norm_out': 1.0 + nrm((D,), 0.05),
        'ml_w_in': nrm((n_a, D, 4 * D), inv_d),
        'ml_w_gate': nrm((n_a, 2, D, 2 * ML_HEADS), 0.1 * inv_d),
        'ml_b_gate': jnp.concatenate([nrm((n_a, 2, ML_HEADS), 0.1),
                                      jnp.linspace(3.0, 6.0, ML_HEADS) + nrm((n_a, 2, ML_HEADS), 0.1)], axis=-1),
        'ml_conv': nrm((n_a, 3, 3, 2 * D), 1.0 / 3.0),
        'ml_head_g': 1.0 + nrm((n_a, D), 0.05),
        'ml_w_out': nrm((n_a, D, D), inv_d),
        'rw_mu': jax.random.uniform(next(keys), (n_b, 6, D), jnp.float32),
        'rw_w_rkv': nrm((n_b, 3, D, D), inv_d),
        'rw_w0': jnp.linspace(-6.0, 1.0, D) + nrm((n_b, 2, D), 0.3),
        'rw_w1': nrm((n_b, 2, D, RW_DECAY_LORA), inv_d),
        'rw_w2': nrm((n_b, 2, RW_DECAY_LORA, D), 0.1 * RW_DECAY_LORA ** -0.5),
        'rw_a0': nrm((n_b, 2, D), 0.1),
        'rw_a1': nrm((n_b, 2, D, RW_ICLR_LORA), inv_d),
        'rw_a2': nrm((n_b, 2, RW_ICLR_LORA, D), 0.1 * RW_ICLR_LORA ** -0.5),
        'rw_g1': nrm((n_b, D, RW_GATE_LORA), inv_d),
        'rw_g2': nrm((n_b, RW_GATE_LORA, D), RW_GATE_LORA ** -0.5),
        'rw_k_k': 0.85 + nrm((n_b, D), 0.05),
        'rw_k_a': 1.0 + nrm((n_b, D), 0.05),
        'rw_r_k': nrm((n_b, D), 0.1),
        'rw_ln_w': 1.0 + nrm((n_b, D), 0.05),
        'rw_ln_b': nrm((n_b, D), 0.02),
        'rw_w_out': nrm((n_b, D, D), inv_d),
        'hg_w_in': nrm((n_c, D, 3 * D), inv_d),
        'hg_w_f': nrm((n_c, 2, D, D), inv_d),
        'hg_b_f': nrm((n_c, 2, D), 0.1),
        'hg_lb_logits': nrm((DEPTH, D), 0.5),
        'hg_head_g': 1.0 + nrm((n_c, D), 0.05),
        'hg_w_out': nrm((n_c, D, D), inv_d),
        'router_w': nrm((D, E), inv_d),
        'router_b': nrm((E,), 0.01),
        'ex_w1': nrm((DEPTH, E, D, F), inv_d),
        'ex_w3': nrm((DEPTH, E, D, F), inv_d),
        'ex_w2': nrm((DEPTH, E, F, D), F ** -0.5),
    }


def reference(x, c, ctx, c_ctx, ada_w, ada_b, norm_mix, norm_ffn, norm_out,
              ml_w_in, ml_w_gate, ml_b_gate, ml_conv, ml_head_g, ml_w_out,
              rw_mu, rw_w_rkv, rw_w0, rw_w1, rw_w2, rw_a0, rw_a1, rw_a2, rw_g1, rw_g2,
              rw_k_k, rw_k_a, rw_r_k, rw_ln_w, rw_ln_b, rw_w_out,
              hg_w_in, hg_w_f, hg_b_f, hg_lb_logits, hg_head_g, hg_w_out,
              router_w, router_b, ex_w1, ex_w3, ex_w2):
    rows = x.shape[1] // GRID_W
    cond_x = jax.nn.silu(c)
    cond_c = jax.nn.silu(c_ctx)
    s = jnp.concatenate([ctx, x], axis=1)
    for i in range(DEPTH):
        mod_x = jnp.split((cond_x @ ada_w[i] + ada_b[i])[:, None, :], 6, axis=-1)
        mod_c = jnp.split(cond_c @ ada_w[i] + ada_b[i], 6, axis=-1)
        h = modulate(rmsnorm(s, norm_mix[i]), mod_c[0], mod_c[1], mod_x[0], mod_x[1])
        kind, j = i % N_MIXERS, i // N_MIXERS
        if kind == 0:
            y = mlstm_mixer(h, rows, ml_w_in[j], ml_w_gate[j], ml_b_gate[j], ml_conv[j],
                            ml_head_g[j], ml_w_out[j])
        elif kind == 1:
            y = rwkv7_mixer(h, rw_mu[j], rw_w_rkv[j], rw_w0[j], rw_w1[j], rw_w2[j], rw_a0[j],
                            rw_a1[j], rw_a2[j], rw_g1[j], rw_g2[j], rw_k_k[j], rw_k_a[j],
                            rw_r_k[j], rw_ln_w[j], rw_ln_b[j], rw_w_out[j])
        else:
            y = hgrn2_mixer(h, i, hg_w_in[j], hg_w_f[j], hg_b_f[j], hg_lb_logits,
                            hg_head_g[j], hg_w_out[j])
        s = gated_residual(s, y, mod_c[2], mod_x[2])
        h = modulate(rmsnorm(s, norm_ffn[i]), mod_c[3], mod_c[4], mod_x[3], mod_x[4])
        y = grouped_moe(h.reshape(-1, h.shape[-1]), router_w, router_b,
                        ex_w1[i], ex_w3[i], ex_w2[i]).reshape(h.shape)
        s = gated_residual(s, y, mod_c[5], mod_x[5])
    return rmsnorm(s[:, CTX_LEN:], norm_out)
```

```cpp
#include <hip/hip_runtime.h>
#include <cstdio>
#include <cstdint>

__device__ __forceinline__ float sigmoid_f(float x) { return 1.0f / (1.0f + __expf(-x)); }
__device__ __forceinline__ float silu_f(float x) { return x / (1.0f + __expf(-x)); }
__device__ __forceinline__ float logsigmoid_f(float x) { return fminf(x, 0.f) - log1pf(__expf(-fabsf(x))); }
#define MK_PER_PHASE 1
namespace pg8 {
#define PG8_LAS __attribute__((address_space(3)))
typedef unsigned short bf16_t;
typedef short bf16x8 __attribute__((ext_vector_type(8)));
typedef float f32x4 __attribute__((ext_vector_type(4)));
typedef unsigned u32x4 __attribute__((ext_vector_type(4)));
constexpr int BM = 256, BK = 64, HALF = 128, HTB = HALF * BK * 2  , STAGE_BYTES = 8 * HTB, NXCD = 8, WGM = 8;

__host__ __device__ __forceinline__ int lds_byte(int r, int c) { const int st = (r >> 4) * 2 + (c >> 5), rr = r & 15, cc = c & 31, ob = rr * 64 + cc * 2; return st * 1024 + (ob ^ (((ob >> 9) & 1) << 5)); }
__host__ __device__ __forceinline__ void stage_rc(int b, int& R, int& C) { const int st = b / 1024, sb = b % 1024, swz = sb ^ (((sb >> 9) & 1) << 5); R = (st >> 1) * 16 + swz / 64; C = (st & 1) * 32 + (swz % 64) / 2; }
__host__ __device__ __forceinline__ int perm32(int rho) { const int n = rho >> 4, i = rho & 15; return 8 * (i >> 2) + 4 * n + (i & 3); }

struct Unit { int pm, pn; };
struct Gemm { const bf16_t* A; const bf16_t* Bt; int M, N, K; };

struct StaticOrder {
    int nM, nN, nwg, G, c;
    __host__ __device__ void init(int M, int N, int G_, int c_) { nM = M / BM; nN = N / BM; nwg = nM * nN; G = G_; c = c_; }
    __host__ __device__ bool next(int i, Unit& u) const {
        const long L = (long)i * G + c; if (L >= nwg) return false;
        int wgid = (int)L; { const int q = nwg / NXCD, r = nwg % NXCD, xcd = wgid % NXCD, off = wgid / NXCD; wgid = (xcd < r ? xcd * (q + 1) : r * (q + 1) + (xcd - r) * q) + off; }
        const int nig = WGM * nN, gid = wgid / nig, fm = gid * WGM, gsz = (nM - fm) < WGM ? (nM - fm) : WGM;
        u.pm = fm + ((wgid % nig) % gsz); u.pn = (wgid % nig) / gsz; return true;
    }
    __device__ __forceinline__ void a_ready(const Unit&) const {}
    __device__ __forceinline__ void done(const Unit&) const {}
};
__device__ __forceinline__ unsigned cvt_pk_bf16(float lo, float hi) { unsigned r; asm volatile("v_cvt_pk_bf16_f32 %0, %1, %2" : "=v"(r) : "v"(lo), "v"(hi)); return r; }
typedef unsigned u32x2 __attribute__((ext_vector_type(2)));
__device__ __forceinline__ void st8(bf16_t* p, f32x4 v0, f32x4 v1) { u32x4 w; w.x = cvt_pk_bf16(v0[0], v0[1]); w.y = cvt_pk_bf16(v0[2], v0[3]); w.z = cvt_pk_bf16(v1[0], v1[1]); w.w = cvt_pk_bf16(v1[2], v1[3]); *(u32x4*)p = w; }
template <int ACT> __device__ __forceinline__ f32x4 act4(f32x4 v) {
    if (ACT == 1) { v[0] = sigmoid_f(v[0]); v[1] = sigmoid_f(v[1]); v[2] = sigmoid_f(v[2]); v[3] = sigmoid_f(v[3]); }
    if (ACT == 2) { v[0] = silu_f(v[0]); v[1] = silu_f(v[1]); v[2] = silu_f(v[2]); v[3] = silu_f(v[3]); }
    return v; }
template <int ACT> __device__ __forceinline__ void store_tile_bf16(const f32x4 (&acc)[2][2][4][2], bf16_t* base, int ld, int row0, int cw) {
#pragma unroll
    for (int ai = 0; ai < 2; ++ai)
#pragma unroll
        for (int m = 0; m < 4; ++m) { bf16_t* rp = base + (size_t)(row0 + ai * HALF + m * 16) * ld + cw;
#pragma unroll
            for (int bj = 0; bj < 2; ++bj) st8(rp + bj * HALF, act4<ACT>(acc[ai][bj][m][0]), act4<ACT>(acc[ai][bj][m][1])); }
}
struct EpiBf16Plain { static constexpr bool PERM = true, AFTER_DRAIN = false; bf16_t* O; int ldc;
    __device__ __forceinline__ void operator()(const f32x4 (&acc)[2][2][4][2], const Unit& u, int wr, int wc, int fr, int fq) const {
        store_tile_bf16<0>(acc, O + u.pn * BM, ldc, u.pm * BM + wr * 64 + fr, wc * 32 + 8 * fq); }
};
struct EpiMlstmIn { static constexpr bool PERM = true, AFTER_DRAIN = false;
    bf16_t* QKPRE; bf16_t* V; bf16_t* OG; float* GATES; const float* bgate;
    __device__ __forceinline__ void operator()(const f32x4 (&acc)[2][2][4][2], const Unit& u, int wr, int wc, int fr, int fq) const {
        const int row0 = u.pm * BM + wr * 64 + fr, cw = wc * 32 + 8 * fq;
        if (u.pn < 8) store_tile_bf16<0>(acc, QKPRE + u.pn * BM, 2048, row0, cw);
        else if (u.pn < 12) store_tile_bf16<0>(acc, V + (u.pn - 8) * BM, 1024, row0, cw);
        else if (u.pn < 16) store_tile_bf16<1>(acc, OG + (u.pn - 12) * BM, 1024, row0, cw);
        else if (wc == 0) {
            const f32x4 b0 = *(const f32x4*)(bgate + 8 * fq), b1 = *(const f32x4*)(bgate + 8 * fq + 4);
#pragma unroll
            for (int ai = 0; ai < 2; ++ai)
#pragma unroll
                for (int m = 0; m < 4; ++m) { float* gp = GATES + (size_t)(row0 + ai * HALF + m * 16) * 32 + 8 * fq;
                    *(f32x4*)gp = acc[ai][0][m][0] + b0; *(f32x4*)(gp + 4) = acc[ai][0][m][1] + b1; }
        }
    }
};
struct EpiRwkvIn { static constexpr bool PERM = true, AFTER_DRAIN = false;
    bf16_t* R; bf16_t* Kk; bf16_t* V; float* WH; float* AH; bf16_t* GH;
    __device__ __forceinline__ void operator()(const f32x4 (&acc)[2][2][4][2], const Unit& u, int wr, int wc, int fr, int fq) const {
        const int row0 = u.pm * BM + wr * 64 + fr, cw = wc * 32 + 8 * fq;
        if (u.pn < 4) store_tile_bf16<0>(acc, R + u.pn * BM, 1024, row0, cw);
        else if (u.pn < 8) store_tile_bf16<0>(acc, Kk + (u.pn - 4) * BM, 1024, row0, cw);
        else if (u.pn < 12) store_tile_bf16<0>(acc, V + (u.pn - 8) * BM, 1024, row0, cw);
        else if (u.pn == 12) {
#pragma unroll
            for (int ai = 0; ai < 2; ++ai)
#pragma unroll
                for (int m = 0; m < 4; ++m) { const size_t r = (size_t)(row0 + ai * HALF + m * 16);
                    f32x4 t0 = acc[ai][0][m][0], t1 = acc[ai][0][m][1];
#pragma unroll
                    for (int j = 0; j < 4; ++j) { t0[j] = tanhf(t0[j]); t1[j] = tanhf(t1[j]); }
                    *(f32x4*)(WH + r * 128 + cw) = t0; *(f32x4*)(WH + r * 128 + cw + 4) = t1;
                    *(f32x4*)(AH + r * 128 + cw) = acc[ai][1][m][0]; *(f32x4*)(AH + r * 128 + cw + 4) = acc[ai][1][m][1]; }
        } else {
#pragma unroll
            for (int ai = 0; ai < 2; ++ai)
#pragma unroll
                for (int m = 0; m < 4; ++m) { bf16_t* rp = GH + (size_t)(row0 + ai * HALF + m * 16) * 256 + cw;
                    st8(rp, act4<1>(acc[ai][0][m][0]), act4<1>(acc[ai][0][m][1])); *(u32x4*)(rp + HALF) = (u32x4){0u, 0u, 0u, 0u}; }
        }
    }
};
struct EpiHgrnIn { static constexpr bool PERM = true, AFTER_DRAIN = false;
    bf16_t* Q; bf16_t* V; bf16_t* OG; bf16_t* LF; size_t lf_stride; const float* bf; const float* lb;
    __device__ __forceinline__ void operator()(const f32x4 (&acc)[2][2][4][2], const Unit& u, int wr, int wc, int fr, int fq) const {
        const int row0 = u.pm * BM + wr * 64 + fr, cw = wc * 32 + 8 * fq;
        if (u.pn < 4) store_tile_bf16<2>(acc, Q + u.pn * BM, 1024, row0, cw);
        else if (u.pn < 8) store_tile_bf16<0>(acc, V + (u.pn - 4) * BM, 1024, row0, cw);
        else if (u.pn < 12) store_tile_bf16<2>(acc, OG + (u.pn - 8) * BM, 1024, row0, cw);
        else {
            const int dir = (u.pn - 12) >> 2, ct = ((u.pn - 12) & 3) * BM; bf16_t* base = LF + (size_t)dir * lf_stride + ct;
            f32x4 bb[2][2], ll[2][2];
#pragma unroll
            for (int bj = 0; bj < 2; ++bj)
#pragma unroll
                for (int n = 0; n < 2; ++n) { bb[bj][n] = *(const f32x4*)(bf + dir * 1024 + ct + bj * HALF + cw + 4 * n); ll[bj][n] = *(const f32x4*)(lb + ct + bj * HALF + cw + 4 * n); }
#pragma unroll
            for (int ai = 0; ai < 2; ++ai)
#pragma unroll
                for (int m = 0; m < 4; ++m) { bf16_t* rp = base + (size_t)(row0 + ai * HALF + m * 16) * 1024 + cw;
#pragma unroll
                    for (int bj = 0; bj < 2; ++bj) { f32x4 o[2];
#pragma unroll
                        for (int n = 0; n < 2; ++n)
#pragma unroll
                            for (int j = 0; j < 4; ++j) { const float l = ll[bj][n][j]; o[n][j] = __logf(l + (1.f - l) * sigmoid_f(acc[ai][bj][m][n][j] + bb[bj][n][j])); }
                        st8(rp + bj * HALF, o[0], o[1]); } }
        }
    }
};
struct EpiResid { static constexpr bool PERM = false, AFTER_DRAIN = false;
    float* S; const float* mod; int gate_idx;
    __device__ __forceinline__ void operator()(const f32x4 (&acc)[2][2][4][2], const Unit& u, int wr, int wc, int fr, int fq) const {
        const int b = u.pm / 33, seg = (u.pm - b * 33 == 0) ? 0 : 1 + b;
        const int row0 = u.pm * BM + wr * 64 + fr, col0 = u.pn * BM + wc * 32 + 4 * fq;
        const float* gp = mod + seg * 6144 + gate_idx * 1024 + col0;
        f32x4 gv[2][2];
#pragma unroll
        for (int bj = 0; bj < 2; ++bj)
#pragma unroll
            for (int n = 0; n < 2; ++n) gv[bj][n] = *(const f32x4*)(gp + bj * HALF + n * 16);
#pragma unroll
        for (int ai = 0; ai < 2; ++ai)
#pragma unroll
            for (int m = 0; m < 4; ++m) { float* rowp = S + (size_t)(row0 + ai * HALF + m * 16) * 1024 + col0;
#pragma unroll
                for (int bj = 0; bj < 2; ++bj)
#pragma unroll
                    for (int n = 0; n < 2; ++n) { f32x4* p = (f32x4*)(rowp + bj * HALF + n * 16); *p = *p + acc[ai][bj][m][n] * gv[bj][n]; } }
    }
};
struct EpiMoe1 { static constexpr bool PERM = true, AFTER_DRAIN = false; bf16_t* ACT;
    __device__ __forceinline__ void operator()(const f32x4 (&acc)[2][2][4][2], const Unit& u, int wr, int wc, int fr, int fq) const {
        const int row0 = u.pm * BM + wr * 64 + fr, pnl = u.pn & 3, c0 = pnl * 128 + wc * 16 + 4 * fq;
#pragma unroll
        for (int ai = 0; ai < 2; ++ai)
#pragma unroll
            for (int m = 0; m < 4; ++m) { bf16_t* rp = ACT + (size_t)(row0 + ai * HALF + m * 16) * 512 + c0;
#pragma unroll
                for (int bj = 0; bj < 2; ++bj) { const f32x4 a = acc[ai][bj][m][0], b = acc[ai][bj][m][1];
                    u32x2 w; w.x = cvt_pk_bf16(silu_f(a[0]) * b[0], silu_f(a[1]) * b[1]); w.y = cvt_pk_bf16(silu_f(a[2]) * b[2], silu_f(a[3]) * b[3]);
                    *(u32x2*)(rp + bj * 64) = w; } }
    }
};
struct EpiMoe2 { static constexpr bool PERM = true, AFTER_DRAIN = false; bf16_t* YM; const int* slot_tok; const float* slot_gate;
    __device__ __forceinline__ void operator()(const f32x4 (&acc)[2][2][4][2], const Unit& u, int wr, int wc, int fr, int fq) const {
        const int row0 = u.pm * BM + wr * 64 + fr, col0 = (u.pn & 3) * BM + wc * 32 + 8 * fq;
#pragma unroll
        for (int ai = 0; ai < 2; ++ai)
#pragma unroll
            for (int m = 0; m < 4; ++m) { const int slot = row0 + ai * HALF + m * 16; const int dst = slot_tok[slot]; const float g = slot_gate[slot];
                if (dst >= 0) { bf16_t* rp = YM + (size_t)dst * 1024 + col0;
#pragma unroll
                    for (int bj = 0; bj < 2; ++bj) st8(rp + bj * HALF, acc[ai][bj][m][0] * g, acc[ai][bj][m][1] * g); } }
    }
};
struct MoeOrder { const PG8_LAS int* pref; int G, c;
    __device__ __forceinline__ bool next(int i, Unit& u) const {
        const int L = i * G + c, nt = pref[16]; if (L >= nt * 4) return false;
        const int tile = L >> 2; int e = 0;
#pragma unroll
        for (int j = 1; j < 16; ++j) e += (tile >= pref[j]) ? 1 : 0;
        u.pm = tile; u.pn = e * 4 + (L & 3); return true; }
    __device__ __forceinline__ void a_ready(const Unit&) const {}
    __device__ __forceinline__ void done(const Unit&) const {}
};
template <class Epi, class Sched, bool ALIGN_EPI = false, bool SP2 = false>
__device__ __forceinline__ void gemm_phase(PG8_LAS unsigned char* lds, const Gemm g, const Sched& S, const Epi& E) {
    int tid_ = threadIdx.x; asm volatile("" : "+v"(tid_));
    const int tid = tid_, wid = __builtin_amdgcn_readfirstlane(tid >> 6), lane = tid & 63, wr = wid >> 2, wc = wid & 3, fr = lane & 15, fq = lane >> 4;
    const int K = g.K, nt = K / BK;
    unsigned voffA[2], voffB[2];
#pragma unroll
    for (int i = 0; i < 2; ++i) { int R, C; stage_rc(tid * 16 + i * 8192, R, C); const int Rb = Epi::PERM ? ((R & ~31) + perm32(R & 31)) : R;
        voffA[i] = (unsigned)(R * K + C) * 2u; voffB[i] = (unsigned)(Rb * K + C) * 2u; }
    const size_t kstep = (size_t)(BK * 2);
    const size_t hstep = (size_t)HALF * K * 2;
    const size_t tstep = 2 * hstep;
    const unsigned ldsw = (unsigned)wid * 1024u;
    const int aoff = lds_byte(wr * 64 + fr, fq * 8), boff = lds_byte(wc * 32 + fr, fq * 8);
#define PG8_SA(b, h) (((b) * 2 + (h)) * HTB)
#define PG8_SB(b, h) ((4 + (b) * 2 + (h)) * HTB)
#define PG8_STAGE(bufoff, gbase, voff) do { _Pragma("unroll") for (int _i = 0; _i < 2; ++_i) \
        __builtin_amdgcn_global_load_lds((const unsigned*)((const char*)(gbase) + (voff)[_i]), (PG8_LAS unsigned*)(lds + (bufoff) + ldsw + _i * 8192), 16, 0, 0); } while (0)
#define PG8_LDA(dst, b, h) do { _Pragma("unroll") for (int m = 0; m < 4; ++m) _Pragma("unroll") for (int k = 0; k < 2; ++k) dst[m][k] = *(const PG8_LAS bf16x8*)(lds + PG8_SA(b, h) + aoff + m * 2048 + k * 1024); } while (0)
#define PG8_LDB(dst, b, h) do { _Pragma("unroll") for (int n = 0; n < 2; ++n) _Pragma("unroll") for (int k = 0; k < 2; ++k) dst[n][k] = *(const PG8_LAS bf16x8*)(lds + PG8_SB(b, h) + boff + n * 2048 + k * 1024); } while (0)
#define PG8_MMA(ai, bj, At, Bt) do { __builtin_amdgcn_s_setprio(1); _Pragma("unroll") for (int m = 0; m < 4; ++m) _Pragma("unroll") for (int n = 0; n < 2; ++n) _Pragma("unroll") for (int k = 0; k < 2; ++k) \
        acc[ai][bj][m][n] = __builtin_amdgcn_mfma_f32_16x16x32_bf16(Bt[n][k], At[m][k], acc[ai][bj][m][n], 0, 0, 0); __builtin_amdgcn_s_setprio(0); } while (0)
#define PG8_WAIT_V(n) asm volatile("s_waitcnt vmcnt(" #n ")" ::: "memory")
#define PG8_WAIT_L(n) asm volatile("s_waitcnt lgkmcnt(" #n ")" ::: "memory")
#define PG8_BAR __builtin_amdgcn_s_barrier()
#define PG8_SCHED __builtin_amdgcn_sched_barrier(0)
    Unit cur, nxt; int ui = 0;
    if (!S.next(0, cur)) return;
    f32x4 acc[2][2][4][2];
#pragma unroll
    for (int a = 0; a < 2; ++a)
#pragma unroll
        for (int b = 0; b < 2; ++b)
#pragma unroll
            for (int m = 0; m < 4; ++m)
#pragma unroll
                for (int n = 0; n < 2; ++n) acc[a][b][m][n] = (f32x4){0.f, 0.f, 0.f, 0.f};
    bf16x8 At[4][2], B0[2][2], B1[2][2];
    const char* cA = (const char*)g.A + (size_t)cur.pm * tstep; const char* cB = (const char*)g.Bt + (size_t)cur.pn * tstep;
    S.a_ready(cur);
    if constexpr (SP2) {
        PG8_STAGE(PG8_SB(0, 0), cB, voffB); PG8_STAGE(PG8_SB(0, 1), cB + hstep, voffB); PG8_STAGE(PG8_SA(0, 0), cA, voffA); PG8_STAGE(PG8_SA(0, 1), cA + hstep, voffA);
        if (wr == 1) PG8_BAR;
        PG8_WAIT_V(2); PG8_BAR;
        PG8_STAGE(PG8_SB(1, 0), cB + kstep, voffB); PG8_STAGE(PG8_SA(1, 0), cA + kstep, voffA); PG8_STAGE(PG8_SB(1, 1), cB + hstep + kstep, voffB);
        PG8_WAIT_V(6); PG8_BAR;
    } else {
        PG8_STAGE(PG8_SB(0, 0), cB, voffB); PG8_STAGE(PG8_SA(0, 0), cA, voffA); PG8_STAGE(PG8_SB(0, 1), cB + hstep, voffB); PG8_STAGE(PG8_SA(0, 1), cA + hstep, voffA);
        if (wr == 1) PG8_BAR;
        PG8_WAIT_V(4); PG8_BAR;
        PG8_STAGE(PG8_SB(1, 0), cB + kstep, voffB); PG8_STAGE(PG8_SA(1, 0), cA + kstep, voffA); PG8_STAGE(PG8_SB(1, 1), cB + hstep + kstep, voffB);
        PG8_WAIT_V(6); PG8_BAR;
    }
    for (;;) {
        const bool has_next = S.next(ui + 1, nxt);
        const char* nA = has_next ? (const char*)g.A + (size_t)nxt.pm * tstep : cA; const char* nB = has_next ? (const char*)g.Bt + (size_t)nxt.pn * tstep : cB;
        for (int t = 0; t < nt; t += 2) {
            const bool last = (t == nt - 2);
            const char* a1 = cA + (size_t)(t + 1) * kstep;
            const char* a2 = last ? nA : cA + (size_t)(t + 2) * kstep; const char* b2 = last ? nB : cB + (size_t)(t + 2) * kstep;
            const char* a3 = a2 + kstep; const char* b3 = b2 + kstep;
            if (last && has_next) S.a_ready(nxt);
            if constexpr (SP2) {
            PG8_LDB(B0, 0, 0); PG8_LDB(B1, 0, 1); PG8_SCHED; PG8_LDA(At, 0, 0); PG8_STAGE(PG8_SA(1, 1), a1 + hstep, voffA);
            PG8_WAIT_V(8); PG8_WAIT_L(0); PG8_BAR; PG8_MMA(0, 0, At, B0); PG8_MMA(0, 1, At, B1); PG8_BAR; PG8_SCHED;
            PG8_LDA(At, 0, 1); PG8_STAGE(PG8_SB(0, 0), b2, voffB); PG8_STAGE(PG8_SB(0, 1), b2 + hstep, voffB); PG8_STAGE(PG8_SA(0, 0), a2, voffA);
            PG8_WAIT_V(8); PG8_WAIT_L(0); PG8_BAR; PG8_MMA(1, 0, At, B0); PG8_MMA(1, 1, At, B1); PG8_BAR; PG8_SCHED;
            PG8_LDB(B0, 1, 0); PG8_LDB(B1, 1, 1); PG8_SCHED; PG8_LDA(At, 1, 0); PG8_STAGE(PG8_SA(0, 1), a2 + hstep, voffA);
            PG8_WAIT_V(8); PG8_WAIT_L(0); PG8_BAR; PG8_MMA(0, 0, At, B0); PG8_MMA(0, 1, At, B1); PG8_BAR; PG8_SCHED;
            PG8_LDA(At, 1, 1); PG8_STAGE(PG8_SB(1, 0), b3, voffB); PG8_STAGE(PG8_SB(1, 1), b3 + hstep, voffB); PG8_STAGE(PG8_SA(1, 0), a3, voffA);
            PG8_WAIT_V(8); PG8_WAIT_L(0); PG8_BAR; PG8_MMA(1, 0, At, B0); PG8_MMA(1, 1, At, B1); PG8_BAR; PG8_SCHED;
            } else {
            PG8_LDB(B0, 0, 0); PG8_SCHED; PG8_LDA(At, 0, 0); PG8_STAGE(PG8_SA(1, 1), a1 + hstep, voffA);
            PG8_WAIT_L(8); PG8_BAR; PG8_WAIT_L(0); PG8_MMA(0, 0, At, B0); PG8_BAR; PG8_SCHED;
            PG8_LDB(B1, 0, 1); PG8_STAGE(PG8_SB(0, 0), b2, voffB);
            PG8_BAR; PG8_WAIT_L(0); PG8_MMA(0, 1, At, B1); PG8_BAR;
            PG8_LDA(At, 0, 1); PG8_STAGE(PG8_SA(0, 0), a2, voffA);
            PG8_BAR; PG8_WAIT_L(0); PG8_MMA(1, 0, At, B0); PG8_BAR; PG8_SCHED;
            PG8_STAGE(PG8_SB(0, 1), b2 + hstep, voffB);
            PG8_WAIT_V(6); PG8_BAR; PG8_MMA(1, 1, At, B1); PG8_BAR;
            PG8_LDB(B0, 1, 0); PG8_SCHED; PG8_LDA(At, 1, 0); PG8_STAGE(PG8_SA(0, 1), a2 + hstep, voffA);
            PG8_WAIT_L(8); PG8_BAR; PG8_WAIT_L(0); PG8_MMA(0, 0, At, B0); PG8_BAR; PG8_SCHED;
            PG8_LDB(B1, 1, 1); PG8_STAGE(PG8_SB(1, 0), b3, voffB);
            PG8_BAR; PG8_WAIT_L(0); PG8_MMA(0, 1, At, B1); PG8_BAR;
            PG8_LDA(At, 1, 1); PG8_STAGE(PG8_SA(1, 0), a3, voffA);
            PG8_BAR; PG8_WAIT_L(0); PG8_MMA(1, 0, At, B0); PG8_BAR; PG8_SCHED;
            PG8_STAGE(PG8_SB(1, 1), b3 + hstep, voffB);
            PG8_WAIT_V(6); PG8_BAR; PG8_MMA(1, 1, At, B1); PG8_BAR;
            }
        }
        if constexpr (ALIGN_EPI) { if (wr == 0) PG8_BAR; }
        if constexpr (!Epi::AFTER_DRAIN) { E(acc, cur, wr, wc, fr, fq); S.done(cur); }
        if (!has_next) break;
#pragma unroll
        for (int a = 0; a < 2; ++a)
#pragma unroll
            for (int b = 0; b < 2; ++b)
#pragma unroll
                for (int m = 0; m < 4; ++m)
#pragma unroll
                    for (int n = 0; n < 2; ++n) acc[a][b][m][n] = (f32x4){0.f, 0.f, 0.f, 0.f};
        cur = nxt; cA = nA; cB = nB; ++ui;
        if constexpr (ALIGN_EPI) { if (wr == 1) PG8_BAR; }
    }
    PG8_WAIT_V(0);
    if constexpr (!ALIGN_EPI) { if (wr == 0) PG8_BAR; }
    PG8_BAR;
    if constexpr (Epi::AFTER_DRAIN) { E.fused(acc, cur, wr, wc, fr, fq, lds, wid, lane); S.done(cur); }
#undef PG8_SA
#undef PG8_SB
#undef PG8_STAGE
#undef PG8_LDA
#undef PG8_LDB
#undef PG8_MMA
#undef PG8_WAIT_V
#undef PG8_WAIT_L
#undef PG8_BAR
#undef PG8_SCHED
}
}

#define LAS __attribute__((address_space(3)))
#ifndef PHASE_FN
#define PHASE_FN __device__ __forceinline__
#endif
#ifndef GEMM_SP2
#define GEMM_SP2 true
#endif
#ifndef GEMM_ALIGN
#define GEMM_ALIGN false
#endif
typedef unsigned short bf16;
typedef pg8::bf16x8 bf16x8;
typedef pg8::f32x4 f32x4;
typedef pg8::u32x4 u32x4;
typedef pg8::u32x2 u32x2;
constexpr int D = 1024, NB = 4, SEQ = 8192, CTX = 256, T = CTX + SEQ, NTOK = NB * T, DEPTH = 4;
constexpr int NWAVES = 8, NTHR = 512;
constexpr int NSLOT = 71680;
constexpr size_t MiB = 1u << 20;
constexpr size_t CTL_ZERO_BYTES = 2 * MiB;
constexpr int CW_BAR = 1024;
constexpr int CW_MOE = 8192;
constexpr size_t WS_MOD = 1 * MiB;
constexpr size_t WS_LB = 2 * MiB;
constexpr size_t WS_TOK = 2 * MiB + 65536;
constexpr size_t WS_SLOT_TOK = 3 * MiB;
constexpr size_t WS_SLOT_GATE = 3 * MiB + 524288;
constexpr size_t WS_S = 4 * MiB;
constexpr size_t WS_HY = 136 * MiB;
constexpr size_t WS_MIX = 268 * MiB;
constexpr size_t WS_END = 610 * MiB;
constexpr size_t ROWB = (size_t)NTOK * 1024 * 2;
constexpr size_t W_ML_WIN = 0, W_ML_WIN_SZ = (size_t)4352 * 1024 * 2;
constexpr size_t W_ML_WOUT = 17 * MiB;
constexpr size_t W_RW_IN = 21 * MiB;
constexpr size_t W_RW_G2 = 35 * MiB;
constexpr size_t W_RW_WOUT = 36 * MiB;
constexpr size_t W_HG_IN = 38 * MiB;
constexpr size_t W_HG_WOUT = 48 * MiB;
constexpr size_t W_EX13 = 50 * MiB;
constexpr size_t W_EX2 = 82 * MiB;
constexpr size_t W_BYTES = 98 * MiB;
constexpr int LDS_PHASE_BYTES = 131072;
constexpr int MISC_OFF = LDS_PHASE_BYTES + 320;
constexpr int LDS_BYTES = 147456;

#define VM_WAIT() asm volatile("s_waitcnt vmcnt(0)" ::: "memory")
#define LDS_WAIT() asm volatile("s_waitcnt lgkmcnt(0)" ::: "memory")
__device__ __forceinline__ unsigned f2bf(float f) { unsigned u = __builtin_bit_cast(unsigned, f); return (u + 0x7fffu + ((u >> 16) & 1u)) >> 16; }
__device__ __forceinline__ unsigned pk2(float lo, float hi) { return f2bf(lo) | (f2bf(hi) << 16); }
__device__ __forceinline__ float bf2f(unsigned b) { return __builtin_bit_cast(float, b << 16); }
__device__ __forceinline__ float bflo(unsigned w) { return __builtin_bit_cast(float, w << 16); }
__device__ __forceinline__ float bfhi(unsigned w) { return __builtin_bit_cast(float, w & 0xffff0000u); }
__device__ __forceinline__ float wave_sum(float v) {
#pragma unroll
    for (int o = 1; o < 64; o <<= 1) v += __shfl_xor(v, o);
    return v; }
__device__ __forceinline__ float wave_max(float v) {
#pragma unroll
    for (int o = 1; o < 64; o <<= 1) v = fmaxf(v, __shfl_xor(v, o));
    return v; }
template <int CTRL> __device__ __forceinline__ float dpp_f(float v) { return __builtin_bit_cast(float, __builtin_amdgcn_update_dpp(0, __builtin_bit_cast(int, v), CTRL, 0xF, 0xF, false)); }
__device__ __forceinline__ float row16_sum(float v) { v += dpp_f<0xB1>(v); v += dpp_f<0x4E>(v); v += dpp_f<0x124>(v); v += dpp_f<0x128>(v); return v; }
template <int K> __device__ __forceinline__ f32x4 mm16(f32x4 acc, const LAS bf16* A, int lda, const LAS bf16* Bt, int ldb, int lane) {
    const int r = lane & 15, q = lane >> 4;
#pragma unroll
    for (int kk = 0; kk < K / 32; ++kk) {
        const bf16x8 a = *(const LAS bf16x8*)(A + r * lda + kk * 32 + q * 8);
        const bf16x8 b = *(const LAS bf16x8*)(Bt + r * ldb + kk * 32 + q * 8);
        acc = __builtin_amdgcn_mfma_f32_16x16x32_bf16(a, b, acc, 0, 0, 0); }
    return acc; }
__device__ __forceinline__ int seq_row(int b, int dir, int i) {
    const int tt = (i < CTX) ? (dir ? CTX - 1 - i : i) : CTX + (dir ? SEQ - 1 - (i - CTX) : (i - CTX));
    return b * T + tt; }

#define XB_TMO      128
#define XB_XCNT(j)  (256  + 64 * (j))
#define XB_XSUB(j)  (1280 + 64 * (j))
#define XB_XGEN(j)  (2304 + 64 * (j))
#define XB_TOP      3328
#define XB_TOPGEN   3392
#define XCD_BAR_WORDS 3456
#define XB_SPIN_CAP (1u << 18)

__device__ __forceinline__ unsigned xb_ld(unsigned* p)              { return __hip_atomic_load(p, __ATOMIC_RELAXED, __HIP_MEMORY_SCOPE_AGENT); }
__device__ __forceinline__ unsigned xb_add(unsigned* p, unsigned v) { return __hip_atomic_fetch_add(p, v, __ATOMIC_RELAXED, __HIP_MEMORY_SCOPE_AGENT); }
__device__ __forceinline__ unsigned xb_xcc_id() { return (unsigned)__builtin_amdgcn_s_getreg((3 << 11) | 20) & 0xFu; }
#define XB_SPIN(cond, bar) do { unsigned _sp = 0; while (cond) { __builtin_amdgcn_s_sleep(1); \
    if ((++_sp & 255u) == 0u) { if (xb_ld(&(bar)[XB_TMO])) break; if (_sp > XB_SPIN_CAP) { atomicAdd(&(bar)[XB_TMO], 1u); break; } } } } while (0)

struct XcdBarrier {
    unsigned* bar; unsigned x;
    volatile LAS unsigned* st;
};

__device__ __forceinline__ XcdBarrier xcd_barrier_post(unsigned* bar, volatile LAS unsigned* st) {
    XcdBarrier b; b.bar = bar; b.x = xb_xcc_id(); b.st = st;
    if (threadIdx.x == 0) (void)xb_add(&bar[XB_XCNT(b.x)], 1u);
    return b;
}
__device__ __forceinline__ void xcd_barrier_complete(unsigned* bar, unsigned x, unsigned& nloc, unsigned& nx) {
    const unsigned G = gridDim.x * gridDim.y * gridDim.z;
    unsigned sum, cnt, mine, sp = 0u;
    for (;;) {
        sum = 0u; cnt = 0u; mine = 0u;
#pragma unroll
        for (unsigned j = 0; j < 16; ++j) { const unsigned c = xb_ld(&bar[XB_XCNT(j)]); sum += c; cnt += (c > 0u) ? 1u : 0u; mine = (j == x) ? c : mine; }
        if (sum == G) break;
        __builtin_amdgcn_s_sleep(1);
        if ((++sp & 255u) == 0u) { if (xb_ld(&bar[XB_TMO])) break; if (sp > XB_SPIN_CAP) { atomicAdd(&bar[XB_TMO], 1u); break; } }
    }
    nloc = mine > 0u ? mine : 1u; nx = cnt > 0u ? cnt : 1u;
}

__device__ __forceinline__ void xcd_barrier(const XcdBarrier& b) {
    asm volatile("s_waitcnt vmcnt(0)" ::: "memory");
    __syncthreads();
    if (threadIdx.x == 0) {
        unsigned* bar = b.bar;
        __builtin_amdgcn_s_waitcnt(0);
        unsigned nloc = b.st[0], nx = b.st[1];
        if (nloc == 0u) { xcd_barrier_complete(bar, b.x, nloc, nx); b.st[0] = nloc; b.st[1] = nx; }
        const unsigned old = xb_add(&bar[XB_XSUB(b.x)], 1u);
        const unsigned gen = old / nloc;
        if (old + 1u == (gen + 1u) * nloc) {
            __builtin_amdgcn_fence(__ATOMIC_RELEASE, "agent");
            asm volatile("s_waitcnt vmcnt(0)" ::: "memory");
            const unsigned og = xb_add(&bar[XB_TOP], 1u);
            const unsigned tg = og / nx;
            if (og + 1u == (tg + 1u) * nx) xb_add(&bar[XB_TOPGEN], 1u);
            else XB_SPIN(xb_ld(&bar[XB_TOPGEN]) == tg, bar);
            __builtin_amdgcn_fence(__ATOMIC_ACQUIRE, "agent");
            xb_add(&bar[XB_XGEN(b.x)], 1u);
            asm volatile("s_waitcnt vmcnt(0)" ::: "memory");
        } else {
            XB_SPIN(xb_ld(&bar[XB_XGEN(b.x)]) == gen, bar);
            __builtin_amdgcn_fence(__ATOMIC_ACQUIRE, "agent");
            asm volatile("s_waitcnt vmcnt(0)" ::: "memory");
        }
    }
    __syncthreads();
}

struct Args { const float* in[42]; float* out; unsigned char* ws; unsigned char* wts; int ph_lo, ph_hi; };
struct Frame {
    LAS unsigned char* lds; float* out; unsigned char* ws; unsigned char* W;
    int tid, lane, wave, bid, G;
};
constexpr int PTAB_OFF = LDS_PHASE_BYTES + 1024;
__device__ __forceinline__ const float* ldptr(const Frame& F, int i) { const unsigned long long v = ((const LAS unsigned long long*)(F.lds + PTAB_OFF))[i];
    const unsigned lo = __builtin_amdgcn_readfirstlane((unsigned)v), hi = __builtin_amdgcn_readfirstlane((unsigned)(v >> 32)); return (const float*)(((unsigned long long)hi << 32) | lo); }
#define INP(i) ldptr(F, (i))
__device__ __forceinline__ Frame fresh(const Frame& F0) { Frame F = F0; int t = threadIdx.x; asm volatile("" : "+v"(t)); F.tid = t; F.lane = t & 63; F.wave = __builtin_amdgcn_readfirstlane(t >> 6);
    asm volatile("" : "+s"(F.bid), "+s"(F.G), "+s"(F.ws), "+s"(F.W), "+s"(F.out)); return F; }
enum { IN_X = 0, IN_C, IN_CTX, IN_CCTX, IN_ADAW, IN_ADAB, IN_NMIX, IN_NFFN, IN_NOUT, IN_ML_WIN, IN_ML_WGATE, IN_ML_BGATE, IN_ML_CONV, IN_ML_HEADG, IN_ML_WOUT,
       IN_RW_MU, IN_RW_WRKV, IN_RW_W0, IN_RW_W1, IN_RW_W2, IN_RW_A0, IN_RW_A1, IN_RW_A2, IN_RW_G1, IN_RW_G2, IN_RW_KK, IN_RW_KA, IN_RW_RK, IN_RW_LNW, IN_RW_LNB, IN_RW_WOUT,
       IN_HG_WIN, IN_HG_WF, IN_HG_BF, IN_HG_LB, IN_HG_HEADG, IN_HG_WOUT, IN_ROUTER_W, IN_ROUTER_B, IN_EX_W1, IN_EX_W3, IN_EX_W2 };

template <int MAP> __device__ __forceinline__ int rowmap(int n) { return MAP == 0 ? n : (MAP == 1 ? 8 * (n >> 2) + (n & 3) : 8 * (n >> 2) + 4 + (n & 3)); }
template <int MAP> __device__ __forceinline__ void tr_item(const float* W, int ldw, int nblk, bf16* WT, int ldd, int row_off, int k_off, const float* kscale, LAS float* scr, int item, int lane) {
    const int kb = item / nblk, nb = item - kb * nblk, k0 = 64 * kb, n0 = 32 * nb;
#pragma unroll 8
    for (int i = 0; i < 32; ++i) { const int kk = 2 * i + (lane >> 5); float v = W[(size_t)(k0 + kk) * ldw + n0 + (lane & 31)]; if (kscale) v *= kscale[k0 + kk]; scr[kk * 33 + (lane & 31)] = v; }
    LDS_WAIT(); asm volatile("" ::: "memory");
    const int c = lane & 7;
#pragma unroll
    for (int j = 0; j < 4; ++j) { const int n = (lane >> 3) + 8 * j; const LAS float* s = scr + (8 * c) * 33 + n;
        u32x4 o; o.x = pk2(s[0 * 33], s[1 * 33]); o.y = pk2(s[2 * 33], s[3 * 33]); o.z = pk2(s[4 * 33], s[5 * 33]); o.w = pk2(s[6 * 33], s[7 * 33]);
        *(u32x4*)(WT + (size_t)(row_off + rowmap<MAP>(n0 + n)) * ldd + k_off + k0 + 8 * c) = o; }
    LDS_WAIT(); asm volatile("" ::: "memory");
}
#define TRJOB(MAP, cnt, ...) if (r < (cnt)) { tr_item<MAP>(__VA_ARGS__, scr, r, F.lane); continue; } r -= (cnt);

PHASE_FN void pre_phase(Frame F) {
    LAS float* scr = (LAS float*)(F.lds + F.wave * 16384);
    const int gw = F.bid * NWAVES + F.wave, NGW = F.G * NWAVES;
    const size_t gt = (size_t)F.bid * NTHR + F.tid, NGT = (size_t)F.G * NTHR;
    bf16* W = (bf16*)F.W;
    constexpr int NITEMS = 2 * 2048 + 2 * 512 + 6 * 512 + 4 * 32 + 4 * 32 + 2 * 64 + 64 + 512 + 1536 + 2 * 512 + 512;
    for (int it = gw; it < NITEMS; it += NGW) {
        int r = it;
        TRJOB(0, 2048, INP(IN_ML_WIN), 4096, 128, (bf16*)(F.W + W_ML_WIN), 1024, 0, 0, nullptr)
        TRJOB(0, 2048, INP(IN_ML_WIN) + (size_t)1024 * 4096, 4096, 128, (bf16*)(F.W + W_ML_WIN + W_ML_WIN_SZ), 1024, 0, 0, nullptr)
        TRJOB(0, 512, INP(IN_ML_WOUT), 1024, 32, (bf16*)(F.W + W_ML_WOUT), 1024, 0, 0, nullptr)
        TRJOB(0, 512, INP(IN_ML_WOUT) + (size_t)1024 * 1024, 1024, 32, (bf16*)(F.W + W_ML_WOUT + 2 * MiB), 1024, 0, 0, nullptr)
        bf16* RWIN = (bf16*)(F.W + W_RW_IN); const float* mu = INP(IN_RW_MU);
        if (r < 6 * 512) { const int idx = r / 1024, ps = (r / 512) & 1, rr = r & 511;
            tr_item<0>(INP(IN_RW_WRKV) + (size_t)idx * 1024 * 1024, 1024, 32, RWIN, 2048, idx * 1024, ps * 1024, ps ? mu + idx * 1024 : nullptr, scr, rr, F.lane); continue; } r -= 6 * 512;
        if (r < 4 * 32) { const int dir = r / 64, ps = (r / 32) & 1, rr = r & 31;
            tr_item<0>(INP(IN_RW_W1) + (size_t)dir * 1024 * 64, 64, 2, RWIN, 2048, 3072 + dir * 64, ps * 1024, ps ? mu + 3 * 1024 : nullptr, scr, rr, F.lane); continue; } r -= 4 * 32;
        if (r < 4 * 32) { const int dir = r / 64, ps = (r / 32) & 1, rr = r & 31;
            tr_item<0>(INP(IN_RW_A1) + (size_t)dir * 1024 * 64, 64, 2, RWIN, 2048, 3200 + dir * 64, ps * 1024, ps ? mu + 4 * 1024 : nullptr, scr, rr, F.lane); continue; } r -= 4 * 32;
        if (r < 2 * 64) { const int ps = r / 64, rr = r & 63;
            tr_item<0>(INP(IN_RW_G1), 128, 4, RWIN, 2048, 3328, ps * 1024, ps ? mu + 5 * 1024 : nullptr, scr, rr, F.lane); continue; } r -= 2 * 64;
        TRJOB(0, 64, INP(IN_RW_G2), 1024, 32, (bf16*)(F.W + W_RW_G2), 256, 0, 0, nullptr)
        TRJOB(0, 512, INP(IN_RW_WOUT), 1024, 32, (bf16*)(F.W + W_RW_WOUT), 1024, 0, 0, nullptr)
        TRJOB(0, 1536, INP(IN_HG_WIN), 3072, 96, (bf16*)(F.W + W_HG_IN), 1024, 0, 0, nullptr)
        TRJOB(0, 512, INP(IN_HG_WF), 1024, 32, (bf16*)(F.W + W_HG_IN), 1024, 3072, 0, nullptr)
        TRJOB(0, 512, INP(IN_HG_WF) + (size_t)1024 * 1024, 1024, 32, (bf16*)(F.W + W_HG_IN), 1024, 4096, 0, nullptr)
        TRJOB(0, 512, INP(IN_HG_WOUT), 1024, 32, (bf16*)(F.W + W_HG_WOUT), 1024, 0, 0, nullptr)
    }
    for (size_t i = gt; i < (size_t)2 * 256 * 1024; i += NGT) { const int j = (int)(i >> 18), rr = (int)((i >> 10) & 255), k = (int)(i & 1023);
        float v = 0.f; if (rr < 32) { const int dir = rr >> 4, g = rr & 15; v = INP(IN_ML_WGATE)[((size_t)(j * 2 + dir) * 1024 + k) * 16 + g]; }
        ((bf16*)(F.W + W_ML_WIN + j * W_ML_WIN_SZ))[(size_t)(4096 + rr) * 1024 + k] = (bf16)f2bf(v); }
    for (size_t i = gt; i < (size_t)128 * 2048; i += NGT) ((bf16*)(F.W + W_RW_IN))[(size_t)3456 * 2048 + i] = 0;
    for (size_t i = gt; i < (size_t)1024 * 128; i += NGT) ((bf16*)(F.W + W_RW_G2))[(i >> 7) * 256 + 128 + (i & 127)] = 0;
    if (F.bid == 0) for (int c = F.tid; c < 1024; c += NTHR) { const float* lg = INP(IN_HG_LB) + c; const float l0 = lg[0], l1 = lg[1024], l2 = lg[2048], l3 = lg[3072];
        const float mx = fmaxf(fmaxf(l0, l1), fmaxf(l2, l3)); const float e0 = __expf(l0 - mx), e1 = __expf(l1 - mx), e2 = __expf(l2 - mx), e3 = __expf(l3 - mx);
        ((float*)(F.ws + WS_LB))[c] = (e1 + e2) / (e0 + e1 + e2 + e3); }
    { f32x4* S4 = (f32x4*)(F.ws + WS_S);
      for (size_t i = gt; i < (size_t)NTOK * 256; i += NGT) { const int m = (int)(i >> 8), c4 = (int)(i & 255); const int b = m / T, t = m - b * T;
          const float* src = (t < CTX) ? INP(IN_CTX) + ((size_t)(b * CTX + t)) * 1024 : INP(IN_X) + ((size_t)(b * SEQ + t - CTX)) * 1024;
          S4[i] = ((const f32x4*)src)[c4]; } }
    { LAS float* sc = (LAS float*)(F.lds + 8448); float* MODP = (float*)(F.ws + WS_MIX);
      for (int it = F.bid; it < 768; it += F.G) { const int i = it / 192, rem = it - i * 192, kc = rem / 12, jb = rem - kc * 12;
          __syncthreads();
          if (F.tid < 320) { const int seg = F.tid >> 6, kk = F.tid & 63; const float cv = seg == 0 ? INP(IN_CCTX)[kc * 64 + kk] : INP(IN_C)[(seg - 1) * 1024 + kc * 64 + kk]; sc[F.tid] = silu_f(cv); }
          __syncthreads();
          const int j = jb * 512 + F.tid; const float* wp = INP(IN_ADAW) + ((size_t)i * 1024 + kc * 64) * 6144 + j;
          float a0 = 0.f, a1 = 0.f, a2 = 0.f, a3 = 0.f, a4 = 0.f;
#pragma unroll 8
          for (int kk = 0; kk < 64; ++kk) { const float w = wp[(size_t)kk * 6144]; a0 += sc[kk] * w; a1 += sc[64 + kk] * w; a2 += sc[128 + kk] * w; a3 += sc[192 + kk] * w; a4 += sc[256 + kk] * w; }
          float* mp = MODP + ((size_t)kc * 4 + i) * 5 * 6144 + j;
          mp[0] = a0; mp[6144] = a1; mp[2 * 6144] = a2; mp[3 * 6144] = a3; mp[4 * 6144] = a4; } }
}
PHASE_FN void modsum_phase(Frame F) {
    const float* MODP = (const float*)(F.ws + WS_MIX); float* MOD = (float*)(F.ws + WS_MOD);
    for (int idx = F.bid * NTHR + F.tid; idx < 4 * 5 * 6144; idx += F.G * NTHR) { const int i = idx / (5 * 6144), j = idx % 6144;
        float a = INP(IN_ADAB)[i * 6144 + j];
#pragma unroll
        for (int kc = 0; kc < 16; ++kc) a += MODP[(size_t)kc * 4 * 5 * 6144 + idx];
        MOD[idx] = a; }
}
PHASE_FN void expert_weights(Frame F, int L) {
    LAS float* scr = (LAS float*)(F.lds + F.wave * 16384);
    const int gw = F.bid * NWAVES + F.wave, NGW = F.G * NWAVES;
    bf16* W13 = (bf16*)(F.W + W_EX13); bf16* W2 = (bf16*)(F.W + W_EX2);
    const float* w1 = INP(IN_EX_W1) + (size_t)L * 16 * 1024 * 512; const float* w3 = INP(IN_EX_W3) + (size_t)L * 16 * 1024 * 512; const float* w2 = INP(IN_EX_W2) + (size_t)L * 16 * 512 * 1024;
    for (int it = gw; it < 3 * 4096; it += NGW) { const int which = it >> 12, e = (it >> 8) & 15, rr = it & 255;
        if (which == 0) tr_item<1>(w1 + (size_t)e * 1024 * 512, 512, 16, W13, 1024, e * 1024, 0, nullptr, scr, rr, F.lane);
        else if (which == 1) tr_item<2>(w3 + (size_t)e * 1024 * 512, 512, 16, W13, 1024, e * 1024, 0, nullptr, scr, rr, F.lane);
        else tr_item<0>(w2 + (size_t)e * 512 * 1024, 1024, 32, W2, 512, e * 1024, 0, nullptr, scr, rr, F.lane); }
}

template <int MODE> PHASE_FN void norm_phase(Frame F, int L, bool add_moe, int ldh) {
    float* S = (float*)(F.ws + WS_S); bf16* H = (bf16*)(F.ws + WS_HY); const bf16* YM = (const bf16*)(F.ws + WS_MIX + 210 * MiB);
    const float* MOD = (const float*)(F.ws + WS_MOD);
    const int gw = F.bid * NWAVES + F.wave, NGW = F.G * NWAVES, lane = F.lane;
    LAS float* rwl = (LAS float*)F.lds;
    LAS int* cntl = (LAS int*)(F.lds + 65536);
    if (MODE == 1) {
        for (int i = F.tid; i < 16384; i += NTHR) { const int c = i >> 4, e = i & 15; rwl[e * 1024 + c] = INP(IN_ROUTER_W)[i]; }
        if (F.tid < 16) cntl[F.tid] = 0;
        __syncthreads();
    }
    const float* gnp = MODE == 0 ? INP(IN_NMIX) + L * 1024 : (MODE == 1 ? INP(IN_NFFN) + L * 1024 : INP(IN_NOUT));
    for (int m = gw; m < NTOK; m += NGW) {
        const int b = m / T, t = m - b * T, seg = t < CTX ? 0 : 1 + b;
        if (MODE == 2 && t < CTX) continue;
        f32x4 v[4]; f32x4* sp = (f32x4*)(S + (size_t)m * 1024) + lane;
#pragma unroll
        for (int j = 0; j < 4; ++j) v[j] = sp[64 * j];
        if (add_moe) {
            const float* gp = MOD + ((size_t)((MODE == 2 ? 3 : L - 1) * 5 + seg)) * 6144 + 5 * 1024;
            const u32x2* ya = (const u32x2*)(YM + (size_t)(2 * m) * 1024) + lane; const u32x2* yb = ya + 256;
#pragma unroll
            for (int j = 0; j < 4; ++j) { const u32x2 a = ya[64 * j], bq = yb[64 * j]; const f32x4 g = ((const f32x4*)gp)[lane + 64 * j];
                v[j][0] += g[0] * (bflo(a.x) + bflo(bq.x)); v[j][1] += g[1] * (bfhi(a.x) + bfhi(bq.x)); v[j][2] += g[2] * (bflo(a.y) + bflo(bq.y)); v[j][3] += g[3] * (bfhi(a.y) + bfhi(bq.y)); }
            if (MODE != 2) {
#pragma unroll
                for (int j = 0; j < 4; ++j) sp[64 * j] = v[j]; }
        }
        float ss = 0.f;
#pragma unroll
        for (int j = 0; j < 4; ++j) ss += (v[j][0] * v[j][0] + v[j][1] * v[j][1]) + (v[j][2] * v[j][2] + v[j][3] * v[j][3]);
        const float rinv = 1.0f / sqrtf(wave_sum(ss) * (1.0f / 1024.0f) + 1e-6f);
        if (MODE == 2) { f32x4* op = (f32x4*)(F.out + ((size_t)(b * SEQ + t - CTX)) * 1024) + lane;
#pragma unroll
            for (int j = 0; j < 4; ++j) { const f32x4 g = ((const f32x4*)gnp)[lane + 64 * j]; op[64 * j] = v[j] * rinv * g; }
            continue; }
        const float* mp = MOD + ((size_t)(L * 5 + seg)) * 6144 + (MODE == 0 ? 0 : 3 * 1024);
        f32x4 h[4];
#pragma unroll
        for (int j = 0; j < 4; ++j) { const f32x4 g = ((const f32x4*)gnp)[lane + 64 * j], sh = ((const f32x4*)mp)[lane + 64 * j], sc = ((const f32x4*)(mp + 1024))[lane + 64 * j];
            h[j] = v[j] * rinv * g * (sc + 1.0f) + sh;
            u32x2 o; o.x = pk2(h[j][0], h[j][1]); o.y = pk2(h[j][2], h[j][3]); *((u32x2*)(H + (size_t)m * ldh) + lane + 64 * j) = o; }
        if (MODE == 1) {
            float lg[16];
#pragma unroll
            for (int e = 0; e < 16; ++e) { float a = 0.f;
#pragma unroll
                for (int j = 0; j < 4; ++j) { const f32x4 w = *(const LAS f32x4*)(rwl + e * 1024 + 256 * j + 4 * lane); a += (h[j][0] * w[0] + h[j][1] * w[1]) + (h[j][2] * w[2] + h[j][3] * w[3]); }
                lg[e] = wave_sum(a); }
            float aff[16], sel[16];
#pragma unroll
            for (int e = 0; e < 16; ++e) { aff[e] = sigmoid_f(lg[e]); sel[e] = aff[e] + INP(IN_ROUTER_B)[e]; }
            float best = -3.0e38f; int bg = 0; float s0 = 0.f, s1 = 0.f, s2 = 0.f, s3 = 0.f, a0 = 0.f, a1 = 0.f, a2 = 0.f, a3 = 0.f;
#pragma unroll
            for (int g = 0; g < 4; ++g) { const float x0 = sel[4 * g], x1 = sel[4 * g + 1], x2 = sel[4 * g + 2], x3 = sel[4 * g + 3];
                const float t1 = fmaxf(x0, x1), t2 = fminf(x0, x1), u1 = fmaxf(x2, x3), u2 = fminf(x2, x3);
                const float sum = fmaxf(t1, u1) + fmaxf(fminf(t1, u1), fmaxf(t2, u2));
                const bool bt = sum > best; best = bt ? sum : best; bg = bt ? g : bg;
                s0 = bt ? x0 : s0; s1 = bt ? x1 : s1; s2 = bt ? x2 : s2; s3 = bt ? x3 : s3;
                a0 = bt ? aff[4 * g] : a0; a1 = bt ? aff[4 * g + 1] : a1; a2 = bt ? aff[4 * g + 2] : a2; a3 = bt ? aff[4 * g + 3] : a3; }
            int i1 = 0; float m1 = s0; if (s1 > m1) { m1 = s1; i1 = 1; } if (s2 > m1) { m1 = s2; i1 = 2; } if (s3 > m1) { m1 = s3; i1 = 3; }
            int i2 = -1; float m2 = -3.0e38f;
            if (i1 != 0 && s0 > m2) { m2 = s0; i2 = 0; } if (i1 != 1 && s1 > m2) { m2 = s1; i2 = 1; } if (i1 != 2 && s2 > m2) { m2 = s2; i2 = 2; } if (i1 != 3 && s3 > m2) { m2 = s3; i2 = 3; }
            const float c1 = i1 == 0 ? a0 : (i1 == 1 ? a1 : (i1 == 2 ? a2 : a3)), c2 = i2 == 0 ? a0 : (i2 == 1 ? a1 : (i2 == 2 ? a2 : a3));
            const float inv = 1.0f / (c1 + c2);
            if (lane == 0) { const int e1 = bg * 4 + i1, e2 = bg * 4 + i2;
                int4 tk; tk.x = e1; tk.y = e2; tk.z = __float_as_int(c1 * inv); tk.w = __float_as_int(c2 * inv); ((int4*)(F.ws + WS_TOK))[m] = tk;
                __hip_atomic_fetch_add(cntl + e1, 1, __ATOMIC_RELAXED, __HIP_MEMORY_SCOPE_WORKGROUP); __hip_atomic_fetch_add(cntl + e2, 1, __ATOMIC_RELAXED, __HIP_MEMORY_SCOPE_WORKGROUP); }
        }
    }
    if (MODE == 1) { __syncthreads(); if (F.tid < 16) atomicAdd((unsigned*)F.ws + CW_MOE + L * 2048 + 64 * F.tid, (unsigned)cntl[F.tid]); }
}

__device__ __forceinline__ void moe_prefix(const Frame& F, int L, LAS int* pref  , LAS int* cnt  ) {
    if (F.tid < 16) cnt[F.tid] = (int)__hip_atomic_load((unsigned*)F.ws + CW_MOE + L * 2048 + 64 * F.tid, __ATOMIC_RELAXED, __HIP_MEMORY_SCOPE_AGENT);
    __syncthreads();
    if (F.tid == 0) { int p = 0; for (int e = 0; e < 16; ++e) { pref[e] = p; p += (cnt[e] + 255) >> 8; } pref[16] = p; }
    __syncthreads();
}
PHASE_FN void slots_phase(Frame F, int L) {
    LAS int* pref = (LAS int*)F.lds; LAS int* cnt = pref + 32;
    moe_prefix(F, L, pref, cnt);
    const int gw = F.bid * NWAVES + F.wave, NGW = F.G * NWAVES, lane = F.lane;
    unsigned* cursor = (unsigned*)F.ws + CW_MOE + L * 2048 + 1024;
    int* slot_tok = (int*)(F.ws + WS_SLOT_TOK); float* slot_gate = (float*)(F.ws + WS_SLOT_GATE);
    const bf16* H = (const bf16*)(F.ws + WS_HY); bf16* XG = (bf16*)(F.ws + WS_MIX);
    for (int it = gw; it < NTOK / 64; it += NGW) {
        const int m = it * 64 + lane; const int4 tk = ((const int4*)(F.ws + WS_TOK))[m];
        int myslot[2];
#pragma unroll
        for (int k = 0; k < 2; ++k) { const int e = k ? tk.y : tk.x; int slot = 0;
            for (int ee = 0; ee < 16; ++ee) { const unsigned long long mask = __ballot(e == ee);
                if (mask) { const int n = __popcll(mask); unsigned base = 0; if (lane == 0) base = atomicAdd(cursor + 64 * ee, (unsigned)n); base = __builtin_amdgcn_readfirstlane(base);
                    if (e == ee) slot = pref[ee] * 256 + (int)base + __popcll(mask & ((1ull << lane) - 1ull)); } }
            myslot[k] = slot; slot_tok[slot] = 2 * m + k; slot_gate[slot] = __int_as_float(k ? tk.w : tk.z); }
#pragma unroll
        for (int k = 0; k < 2; ++k)
            for (int l = 0; l < 64; ++l) { const int sl = __shfl(myslot[k], l); const u32x4* src = (const u32x4*)(H + (size_t)(it * 64 + l) * 1024); u32x4* dst = (u32x4*)(XG + (size_t)sl * 1024);
                dst[lane] = src[lane]; dst[64 + lane] = src[64 + lane]; }
    }
    for (int e = 0; e < 16; ++e) { const int lo = pref[e] * 256 + cnt[e], hi = pref[e + 1] * 256;
        for (int s = lo + gw; s < hi; s += NGW) { u32x4* dst = (u32x4*)(XG + (size_t)s * 1024); dst[lane] = (u32x4){0u, 0u, 0u, 0u}; dst[64 + lane] = (u32x4){0u, 0u, 0u, 0u};
            if (lane == 0) { slot_tok[s] = -1; slot_gate[s] = 0.f; } } }
}

PHASE_FN void du_phase(Frame F) {
    bf16* H2 = (bf16*)(F.ws + WS_HY);
    const size_t gt = (size_t)F.bid * NTHR + F.tid, NGT = (size_t)F.G * NTHR;
    for (size_t i = gt; i < (size_t)NTOK * 128; i += NGT) { const int m = (int)(i >> 7), c8 = (int)(i & 127); const int t = m % T;
        const bool hp = !(t == 0 || t == CTX), hn = !(t == CTX - 1 || t == T - 1);
        const u32x4 z = {0u, 0u, 0u, 0u};
        const u32x4 u = *(const u32x4*)(H2 + (size_t)m * 2048 + c8 * 8), p = hp ? *(const u32x4*)(H2 + (size_t)(m - 1) * 2048 + c8 * 8) : z, n = hn ? *(const u32x4*)(H2 + (size_t)(m + 1) * 2048 + c8 * 8) : z;
        u32x4 o;
#pragma unroll
        for (int j = 0; j < 4; ++j) o[j] = pk2(0.5f * (bflo(p[j]) + bflo(n[j])) - bflo(u[j]), 0.5f * (bfhi(p[j]) + bfhi(n[j])) - bfhi(u[j]));
        *(u32x4*)(H2 + (size_t)m * 2048 + 1024 + c8 * 8) = o; }
}

PHASE_FN void conv_phase(Frame F, int j) {
    const bf16* QP = (const bf16*)(F.ws + WS_MIX); bf16* QK = (bf16*)(F.ws + WS_HY); const float* cw = INP(IN_ML_CONV) + (size_t)j * 9 * 2048;
    const size_t gt = (size_t)F.bid * NTHR + F.tid, NGT = (size_t)F.G * NTHR;
    for (size_t i = gt; i < (size_t)NTOK * 256; i += NGT) { const int m = (int)(i >> 8), c = (int)(i & 255) * 8; const int t = m % T;
        float acc[8];
#pragma unroll
        for (int q = 0; q < 8; ++q) acc[q] = 0.f;
        const int p = t - CTX, gr = p >> 6, gc = p & 63;
#pragma unroll
        for (int dr = 0; dr < 3; ++dr)
#pragma unroll
            for (int dw = 0; dw < 3; ++dw) {
                bool ok; int mm;
                if (t < CTX) { ok = (dr == 1) && (t + dw - 1 >= 0) && (t + dw - 1 < CTX); mm = m + dw - 1; }
                else { ok = (gr + dr - 1 >= 0) && (gr + dr - 1 < 128) && (gc + dw - 1 >= 0) && (gc + dw - 1 < 64); mm = m + (dr - 1) * 64 + (dw - 1); }
                if (ok) { const u32x4 x = *(const u32x4*)(QP + (size_t)mm * 2048 + c); const f32x4 w0 = *(const f32x4*)(cw + (dr * 3 + dw) * 2048 + c), w1 = *(const f32x4*)(cw + (dr * 3 + dw) * 2048 + c + 4);
                    acc[0] += bflo(x[0]) * w0[0]; acc[1] += bfhi(x[0]) * w0[1]; acc[2] += bflo(x[1]) * w0[2]; acc[3] += bfhi(x[1]) * w0[3];
                    acc[4] += bflo(x[2]) * w1[0]; acc[5] += bfhi(x[2]) * w1[1]; acc[6] += bflo(x[3]) * w1[2]; acc[7] += bfhi(x[3]) * w1[3]; } }
        const float sc = c >= 1024 ? 0.08838834764831845f : 1.0f;
        u32x4 o;
#pragma unroll
        for (int q = 0; q < 4; ++q) o[q] = pk2(silu_f(acc[2 * q]) * sc, silu_f(acc[2 * q + 1]) * sc);
        *(u32x4*)(QK + (size_t)m * 2048 + c) = o; }
}

PHASE_FN void headnorm_phase(Frame F, const bf16* HSf, const bf16* HSb, const bf16* OG, const float* hg, bf16* Y) {
    const int gw = F.bid * NWAVES + F.wave, NGW = F.G * NWAVES, lane = F.lane;
    for (int m = gw; m < NTOK; m += NGW) { const size_t off = (size_t)m * 1024 + lane * 16;
        float x[16]; float ss = 0.f;
#pragma unroll
        for (int hlf = 0; hlf < 2; ++hlf) { const u32x4 a = *(const u32x4*)(HSf + off + 8 * hlf), bq = *(const u32x4*)(HSb + off + 8 * hlf);
#pragma unroll
            for (int q = 0; q < 4; ++q) { x[8 * hlf + 2 * q] = bflo(a[q]) + bflo(bq[q]); x[8 * hlf + 2 * q + 1] = bfhi(a[q]) + bfhi(bq[q]); } }
#pragma unroll
        for (int q = 0; q < 16; ++q) ss += x[q] * x[q];
        ss += __shfl_xor(ss, 1); ss += __shfl_xor(ss, 2); ss += __shfl_xor(ss, 4);
        const float rinv = 1.0f / sqrtf(ss * (1.0f / 128.0f) + 1e-6f);
#pragma unroll
        for (int hlf = 0; hlf < 2; ++hlf) { const u32x4 g = *(const u32x4*)(OG + off + 8 * hlf); const f32x4 h0 = *(const f32x4*)(hg + lane * 16 + 8 * hlf), h1 = *(const f32x4*)(hg + lane * 16 + 8 * hlf + 4);
            u32x4 o;
            o[0] = pk2(x[8 * hlf + 0] * rinv * h0[0] * bflo(g[0]), x[8 * hlf + 1] * rinv * h0[1] * bfhi(g[0])); o[1] = pk2(x[8 * hlf + 2] * rinv * h0[2] * bflo(g[1]), x[8 * hlf + 3] * rinv * h0[3] * bfhi(g[1]));
            o[2] = pk2(x[8 * hlf + 4] * rinv * h1[0] * bflo(g[2]), x[8 * hlf + 5] * rinv * h1[1] * bfhi(g[2])); o[3] = pk2(x[8 * hlf + 6] * rinv * h1[2] * bflo(g[3]), x[8 * hlf + 7] * rinv * h1[3] * bfhi(g[3]));
            *(u32x4*)(Y + off + 8 * hlf) = o; } }
}
PHASE_FN void rwpost_phase(Frame F, const bf16* Of, const bf16* Ob, const float* BETA, const bf16* V, const bf16* Gt, bf16* Y) {
    const int gw = F.bid * NWAVES + F.wave, NGW = F.G * NWAVES, lane = F.lane;
    const float* lnw = INP(IN_RW_LNW); const float* lnb = INP(IN_RW_LNB);
    for (int m = gw; m < NTOK; m += NGW) { const size_t off = (size_t)m * 1024 + lane * 16;
        float x[16]; float s = 0.f;
#pragma unroll
        for (int hlf = 0; hlf < 2; ++hlf) { const u32x4 a = *(const u32x4*)(Of + off + 8 * hlf), bq = *(const u32x4*)(Ob + off + 8 * hlf);
#pragma unroll
            for (int q = 0; q < 4; ++q) { x[8 * hlf + 2 * q] = bflo(a[q]) + bflo(bq[q]); x[8 * hlf + 2 * q + 1] = bfhi(a[q]) + bfhi(bq[q]); } }
#pragma unroll
        for (int q = 0; q < 16; ++q) s += x[q];
        s += __shfl_xor(s, 1); s += __shfl_xor(s, 2);
        const float mean = s * (1.0f / 64.0f); float vs = 0.f;
#pragma unroll
        for (int q = 0; q < 16; ++q) { x[q] -= mean; vs += x[q] * x[q]; }
        vs += __shfl_xor(vs, 1); vs += __shfl_xor(vs, 2);
        const float rinv = 1.0f / sqrtf(vs * (1.0f / 64.0f) + 64e-5f);
        const int hd = lane >> 2; const float beta = BETA[(size_t)m * 16 + hd] + BETA[((size_t)NTOK + m) * 16 + hd];
#pragma unroll
        for (int hlf = 0; hlf < 2; ++hlf) { const u32x4 vv = *(const u32x4*)(V + off + 8 * hlf), gg = *(const u32x4*)(Gt + off + 8 * hlf);
            const f32x4 w0 = *(const f32x4*)(lnw + lane * 16 + 8 * hlf), w1 = *(const f32x4*)(lnw + lane * 16 + 8 * hlf + 4), b0 = *(const f32x4*)(lnb + lane * 16 + 8 * hlf), b1 = *(const f32x4*)(lnb + lane * 16 + 8 * hlf + 4);
            float y[8];
#pragma unroll
            for (int q = 0; q < 4; ++q) { y[q] = x[8 * hlf + q] * rinv * w0[q] + b0[q]; y[4 + q] = x[8 * hlf + 4 + q] * rinv * w1[q] + b1[q]; }
            u32x4 o;
#pragma unroll
            for (int q = 0; q < 4; ++q) o[q] = pk2((y[2 * q] + beta * bflo(vv[q])) * bflo(gg[q]), (y[2 * q + 1] + beta * bfhi(vv[q])) * bfhi(gg[q]));
            *(u32x4*)(Y + off + 8 * hlf) = o; } }
}

PHASE_FN void ml_scan_phase(Frame F, const bf16* QK, const bf16* V, const float* GATES, bf16* HS) {
    LAS bf16* QS = (LAS bf16*)(F.lds + 0); LAS bf16* KS = (LAS bf16*)(F.lds + 17408); LAS bf16* VT = (LAS bf16*)(F.lds + 34816); LAS bf16* KT = (LAS bf16*)(F.lds + 39424);
    LAS bf16* SS = (LAS bf16*)(F.lds + 57856); LAS bf16* CS = (LAS bf16*)(F.lds + 67072);
    LAS float* su = (LAS float*)(F.lds + 75776); LAS float* scc = su + 64; LAS float* swi = scc + 64; LAS float* semt = swi + 64; LAS float* swk = semt + 64;
    LAS float* sdenp = swk + 64;   LAS float* snq = sdenp + 256; LAS float* sn = snq + 64;   LAS float* sscal = sn + 128;
    const int tid = F.tid, lane = F.lane, w = F.wave, r = lane & 15, q = lane >> 4;
    const int lrow = tid >> 3, lp = tid & 7;
    for (int unit = F.bid; unit < 256; unit += F.G) {
        const int vs = unit & 3, dir = (unit >> 2) & 1, h = (unit >> 3) & 7, b = unit >> 6;
        f32x4 Cst[2]; Cst[0] = (f32x4){0.f, 0.f, 0.f, 0.f}; Cst[1] = Cst[0];
        __syncthreads();
        for (int i = tid; i < 32 * 136; i += NTHR) CS[i] = 0;
        if (tid < 128) sn[tid] = 0.f;
        float m_run = 0.f;
        u32x4 rq[2], rk[2], rv = {0u, 0u, 0u, 0u}; float rig = 0.f, rlf = 0.f;
#define ML_LOAD(c) do { const int row_ = seq_row(b, dir, (c) * 64 + lrow); const bf16* qp_ = QK + (size_t)row_ * 2048 + h * 128; \
            rq[0] = *(const u32x4*)(qp_ + 8 * lp); rq[1] = *(const u32x4*)(qp_ + 8 * (lp + 8)); rk[0] = *(const u32x4*)(qp_ + 1024 + 8 * lp); rk[1] = *(const u32x4*)(qp_ + 1024 + 8 * (lp + 8)); \
            if (tid < 256) { const int vrow_ = seq_row(b, dir, (c) * 64 + (tid >> 2)); rv = *(const u32x4*)(V + (size_t)vrow_ * 1024 + h * 128 + vs * 32 + 8 * (tid & 3)); } \
            if (w == 0) { const int grow_ = seq_row(b, dir, (c) * 64 + lane); rig = GATES[(size_t)grow_ * 32 + dir * 16 + h]; rlf = GATES[(size_t)grow_ * 32 + dir * 16 + 8 + h]; } } while (0)
        ML_LOAD(0);
        __syncthreads();
        for (int c = 0; c < T / 64; ++c) {
            if (w == 0) {
                const float lf = logsigmoid_f(rlf), ig = rig;
                float bc = lf;
#pragma unroll
                for (int o = 1; o < 64; o <<= 1) { const float t_ = __shfl_up(bc, o); if (lane >= o) bc += t_; }
                const float u = ig - bc;
                float pm = u;
#pragma unroll
                for (int o = 1; o < 64; o <<= 1) { const float t_ = __shfl_up(pm, o); if (lane >= o) pm = fmaxf(pm, t_); }
                const float cc = fmaxf(m_run, pm);
                const float blast = __shfl(bc, 63), pmall = __shfl(pm, 63);
                const float m_new = blast + fmaxf(m_run, pmall);
                su[lane] = u; scc[lane] = cc; swi[lane] = __expf(m_run - cc); semt[lane] = __expf(-(bc + cc)); swk[lane] = __expf(blast + u - m_new);
                if (lane == 0) sscal[0] = __expf(blast + m_run - m_new);
                m_run = m_new;
            }
            __syncthreads();
            {
                *(LAS u32x4*)(QS + lrow * 136 + 8 * lp) = rq[0]; *(LAS u32x4*)(QS + lrow * 136 + 8 * (lp + 8)) = rq[1];
                *(LAS u32x4*)(KS + lrow * 136 + 8 * lp) = rk[0]; *(LAS u32x4*)(KS + lrow * 136 + 8 * (lp + 8)) = rk[1];
                const float wk = swk[lrow];
#pragma unroll
                for (int pc = 0; pc < 2; ++pc)
#pragma unroll
                    for (int jj = 0; jj < 4; ++jj) { const int d = 8 * (lp + 8 * pc) + 2 * jj; const unsigned x = rk[pc][jj];
                        KT[d * 72 + lrow] = (bf16)f2bf(bflo(x) * wk); KT[(d + 1) * 72 + lrow] = (bf16)f2bf(bfhi(x) * wk); }
                if (tid < 256) { const int s_ = tid >> 2;
#pragma unroll
                    for (int jj = 0; jj < 4; ++jj) { const int vv = 8 * (tid & 3) + 2 * jj; VT[vv * 72 + s_] = (bf16)(rv[jj] & 0xffffu); VT[(vv + 1) * 72 + s_] = (bf16)(rv[jj] >> 16); } }
                if (c + 1 < T / 64) ML_LOAD(c + 1);
            }
            __syncthreads();
            {
                const int ti = w >> 1;
#pragma unroll
                for (int jj = 0; jj < 2; ++jj) { const int sj = (w & 1) * 2 + jj; f32x4 acc = {0.f, 0.f, 0.f, 0.f};
                    if (sj <= ti) acc = mm16<128>(acc, QS + 16 * ti * 136, 136, KS + 16 * sj * 136, 136, lane);
                    const int s_ = 16 * sj + r; const float us = su[s_];
#pragma unroll
                    for (int i = 0; i < 4; ++i) { const int t_ = 16 * ti + 4 * q + i; const float val = (s_ <= t_) ? acc[i] * __expf(us - scc[t_]) : 0.f;
                        const float rs = row16_sum(val); if (r == 0) sdenp[sj * 64 + t_] = rs;
                        SS[t_ * 72 + s_] = (bf16)f2bf(val); } }
                const int t2 = tid >> 3, part = tid & 7; float a = 0.f;
#pragma unroll
                for (int d = 0; d < 16; ++d) a += sn[part * 16 + d] * bf2f(QS[t2 * 136 + part * 16 + d]);
                a += __shfl_xor(a, 1); a += __shfl_xor(a, 2); a += __shfl_xor(a, 4);
                if (part == 0) snq[t2] = a;
            }
            __syncthreads();
            float wprev;
            {
                const int ti = w >> 1, vj = w & 1; f32x4 a1 = {0.f, 0.f, 0.f, 0.f}, a2 = a1;
                a1 = mm16<64>(a1, SS + 16 * ti * 72, 72, VT + 16 * vj * 72, 72, lane);
                a2 = mm16<128>(a2, QS + 16 * ti * 136, 136, CS + 16 * vj * 136, 136, lane);
#pragma unroll
                for (int i = 0; i < 4; ++i) { const int t_ = 16 * ti + 4 * q + i; const float wi = swi[t_];
                    const float num = a1[i] + wi * a2[i], den = ((sdenp[t_] + sdenp[64 + t_]) + (sdenp[128 + t_] + sdenp[192 + t_])) + wi * snq[t_];
                    const float hv = num / fmaxf(fabsf(den), semt[t_]);
                    const int row = seq_row(b, dir, c * 64 + t_);
                    HS[((size_t)dir * NTOK + row) * 1024 + h * 128 + vs * 32 + 16 * vj + r] = (bf16)f2bf(hv); }
                wprev = sscal[0];
            }
            __syncthreads();
            {
                const int vi = w & 1;
#pragma unroll
                for (int jj = 0; jj < 2; ++jj) { const int dj = (w >> 1) * 2 + jj; Cst[jj] = Cst[jj] * wprev;
                    Cst[jj] = mm16<64>(Cst[jj], VT + 16 * vi * 72, 72, KT + 16 * dj * 72, 72, lane);
#pragma unroll
                    for (int i = 0; i < 4; ++i) CS[(16 * vi + 4 * q + i) * 136 + 16 * dj + r] = (bf16)f2bf(Cst[jj][i]); }
                if (tid < 128) { float a = 0.f;
#pragma unroll 8
                    for (int s_ = 0; s_ < 64; ++s_) a += bf2f(KT[tid * 72 + s_]);
                    sn[tid] = wprev * sn[tid] + a; }
            }
        }
#undef ML_LOAD
    }
}

PHASE_FN void hg_scan_phase(Frame F, const bf16* Q, const bf16* V, const bf16* LF, bf16* HSf, bf16* HSb) {
    LAS bf16* QT = (LAS bf16*)(F.lds + 0); LAS bf16* KTs = (LAS bf16*)(F.lds + 8704); LAS bf16* KH = (LAS bf16*)(F.lds + 17408); LAS bf16* VT = (LAS bf16*)(F.lds + 27648);
    LAS bf16* AS = (LAS bf16*)(F.lds + 30208); LAS bf16* STs = (LAS bf16*)(F.lds + 32768); LAS float* BF = (LAS float*)(F.lds + 41472); LAS float* SBL = (LAS float*)(F.lds + 57856); LAS bf16* QI = (LAS bf16*)(F.lds + 58368);
    const int tid = F.tid, lane = F.lane, w = F.wave, r = lane & 15, q = lane >> 4;
    const int lrow = tid >> 4, lp = tid & 15;
    for (int unit = F.bid; unit < 256; unit += F.G) {
        const int vs = unit & 3, dir = (unit >> 2) & 1, h = (unit >> 3) & 7, b = unit >> 6;
        bf16* HS = dir ? HSb : HSf; const bf16* LFd = LF + (size_t)dir * NTOK * 1024;
        f32x4 Sst[2]; Sst[0] = (f32x4){0.f, 0.f, 0.f, 0.f}; Sst[1] = Sst[0];
        __syncthreads();
        for (int i = tid; i < 32 * 136; i += NTHR) STs[i] = 0;
        u32x4 rq, rl, rv = {0u, 0u, 0u, 0u};
#define HG_LOAD(c) do { const int row_ = seq_row(b, dir, (c) * 32 + lrow); rq = *(const u32x4*)(Q + (size_t)row_ * 1024 + h * 128 + 8 * lp); rl = *(const u32x4*)(LFd + (size_t)row_ * 1024 + h * 128 + 8 * lp); \
            if (tid < 128) { const int vrow_ = seq_row(b, dir, (c) * 32 + (tid >> 2)); rv = *(const u32x4*)(V + (size_t)vrow_ * 1024 + h * 128 + vs * 32 + 8 * (tid & 3)); } } while (0)
        HG_LOAD(0);
        for (int c = 0; c < T / 32; ++c) {
#pragma unroll
            for (int jj = 0; jj < 4; ++jj) { BF[lrow * 128 + 8 * lp + 2 * jj] = bflo(rl[jj]); BF[lrow * 128 + 8 * lp + 2 * jj + 1] = bfhi(rl[jj]); }
            __syncthreads();
            if (tid < 128) { float a = 0.f;
#pragma unroll 8
                for (int t_ = 0; t_ < 32; ++t_) { a += BF[t_ * 128 + tid]; BF[t_ * 128 + tid] = a; }
                SBL[tid] = __expf(a); }
            __syncthreads();
            {
#pragma unroll
                for (int jj = 0; jj < 4; ++jj)
#pragma unroll
                    for (int hh = 0; hh < 2; ++hh) { const int k_ = 8 * lp + 2 * jj + hh; const float bt = BF[lrow * 128 + k_], bl = BF[31 * 128 + k_], br = BF[15 * 128 + k_];
                        const float lf = hh ? bfhi(rl[jj]) : bflo(rl[jj]), qv = hh ? bfhi(rq[jj]) : bflo(rq[jj]); const float key = -expm1f(lf);
                        QT[lrow * 136 + k_] = (bf16)f2bf(qv * __expf(bt - br)); QI[lrow * 136 + k_] = (bf16)f2bf(qv * __expf(bt)); KTs[lrow * 136 + k_] = (bf16)f2bf(key * __expf(br - bt)); KH[k_ * 40 + lrow] = (bf16)f2bf(key * __expf(bl - bt)); }
                if (tid < 128) { const int s_ = tid >> 2;
#pragma unroll
                    for (int jj = 0; jj < 4; ++jj) { const int vv = 8 * (tid & 3) + 2 * jj; VT[vv * 40 + s_] = (bf16)(rv[jj] & 0xffffu); VT[(vv + 1) * 40 + s_] = (bf16)(rv[jj] >> 16); } }
                if (c + 1 < T / 32) HG_LOAD(c + 1);
            }
            __syncthreads();
            if (w < 4) { const int ti = w >> 1, sj = w & 1; f32x4 acc = {0.f, 0.f, 0.f, 0.f};
                if (sj <= ti) acc = mm16<128>(acc, QT + 16 * ti * 136, 136, KTs + 16 * sj * 136, 136, lane);
#pragma unroll
                for (int i = 0; i < 4; ++i) { const int t_ = 16 * ti + 4 * q + i, s_ = 16 * sj + r; AS[t_ * 40 + s_] = (bf16)f2bf(s_ <= t_ ? acc[i] : 0.f); } }
            __syncthreads();
            if (w < 4) { const int ti = w >> 1, vj = w & 1; f32x4 a1 = {0.f, 0.f, 0.f, 0.f}, a2 = a1;
                a1 = mm16<32>(a1, AS + 16 * ti * 40, 40, VT + 16 * vj * 40, 40, lane);
                a2 = mm16<128>(a2, QI + 16 * ti * 136, 136, STs + 16 * vj * 136, 136, lane);
#pragma unroll
                for (int i = 0; i < 4; ++i) { const int t_ = 16 * ti + 4 * q + i; const int row = seq_row(b, dir, c * 32 + t_);
                    HS[(size_t)row * 1024 + h * 128 + vs * 32 + 16 * vj + r] = (bf16)f2bf(a1[i] + a2[i]); } }
            __syncthreads();
            { const int vi = w & 1;
#pragma unroll
              for (int jj = 0; jj < 2; ++jj) { const int kj = (w >> 1) * 2 + jj; Sst[jj] = Sst[jj] * SBL[16 * kj + r];
                  Sst[jj] = mm16<32>(Sst[jj], VT + 16 * vi * 40, 40, KH + 16 * kj * 40, 40, lane);
#pragma unroll
                  for (int i = 0; i < 4; ++i) STs[(16 * vi + 4 * q + i) * 136 + 16 * kj + r] = (bf16)f2bf(Sst[jj][i]); } }
        }
#undef HG_LOAD
    }
}

PHASE_FN void rw_scan_phase(Frame F, const bf16* Rr, const bf16* Kk, const bf16* Vv, const float* WH, const float* AH, bf16* O  , float* BETA  ) {
    LAS float* W2S = (LAS float*)(F.lds + 0); LAS float* A2S = (LAS float*)(F.lds + 16384);
    LAS float* SW = (LAS float*)(F.lds + 32768); LAS float* SKK = (LAS float*)(F.lds + 40960); LAS float* SAK = (LAS float*)(F.lds + 49152); LAS float* SKD = (LAS float*)(F.lds + 57344); LAS float* SR = (LAS float*)(F.lds + 65536);
    LAS float* SV = (LAS float*)(F.lds + 73728); LAS float* SWH = (LAS float*)(F.lds + 77824); LAS float* SAH = (LAS float*)(F.lds + 86016); LAS float* SO = (LAS float*)(F.lds + 94208);
    LAS float* SVEC = (LAS float*)(F.lds + 98304);
    const int tid = F.tid, t16 = tid >> 4, cg = tid & 15, kc = cg * 4;
    for (int unit = F.bid; unit < 256; unit += F.G) {
        const int half = unit & 1, dir = (unit >> 1) & 1, h = (unit >> 2) & 15, b = unit >> 6;
        __syncthreads();
        for (int i = tid; i < 4096; i += NTHR) { const int l = i >> 6, jn = i & 63; W2S[i] = INP(IN_RW_W2)[((size_t)(dir * 64 + l)) * 1024 + h * 64 + jn]; A2S[i] = INP(IN_RW_A2)[((size_t)(dir * 64 + l)) * 1024 + h * 64 + jn]; }
        if (tid < 64) { SVEC[tid] = INP(IN_RW_W0)[dir * 1024 + h * 64 + tid]; SVEC[64 + tid] = INP(IN_RW_A0)[dir * 1024 + h * 64 + tid]; SVEC[128 + tid] = INP(IN_RW_KK)[h * 64 + tid];
            SVEC[192 + tid] = INP(IN_RW_KA)[h * 64 + tid]; SVEC[256 + tid] = INP(IN_RW_RK)[h * 64 + tid]; }
        float S0 = 0.f, S1 = 0.f, S2 = 0.f, S3 = 0.f;
        u32x2 rr, rk; unsigned rv; f32x4 rwh, rah;
#define RW_LOAD(c) do { const size_t row_ = (size_t)seq_row(b, dir, (c) * 32 + t16); rr = *(const u32x2*)(Rr + row_ * 1024 + h * 64 + kc); rk = *(const u32x2*)(Kk + row_ * 1024 + h * 64 + kc); \
            rv = *(const unsigned*)(Vv + row_ * 1024 + h * 64 + half * 32 + 2 * cg); rwh = *(const f32x4*)(WH + row_ * 128 + dir * 64 + kc); rah = *(const f32x4*)(AH + row_ * 128 + dir * 64 + kc); } while (0)
        RW_LOAD(0);
        for (int c = 0; c < T / 32; ++c) {
            *(LAS f32x4*)(SWH + t16 * 64 + kc) = rwh; *(LAS f32x4*)(SAH + t16 * 64 + kc) = rah;
            __syncthreads();
            {
                f32x4 wp = *(const LAS f32x4*)(SVEC + kc), ap = *(const LAS f32x4*)(SVEC + 64 + kc);
#pragma unroll 8
                for (int l = 0; l < 64; ++l) { const float x = SWH[t16 * 64 + l], y = SAH[t16 * 64 + l]; const f32x4 w2 = *(const LAS f32x4*)(W2S + l * 64 + kc), a2 = *(const LAS f32x4*)(A2S + l * 64 + kc); wp += w2 * x; ap += a2 * y; }
                const f32x4 kkw = *(const LAS f32x4*)(SVEC + 128 + kc), kaw = *(const LAS f32x4*)(SVEC + 192 + kc), rkw = *(const LAS f32x4*)(SVEC + 256 + kc);
                f32x4 kv, rv4, dec, av, kx; kv[0] = bflo(rk.x); kv[1] = bfhi(rk.x); kv[2] = bflo(rk.y); kv[3] = bfhi(rk.y); rv4[0] = bflo(rr.x); rv4[1] = bfhi(rr.x); rv4[2] = bflo(rr.y); rv4[3] = bfhi(rr.y);
                float ssq = 0.f, bet = 0.f;
#pragma unroll
                for (int jn = 0; jn < 4; ++jn) { dec[jn] = __expf(-0.6065306597126334f * sigmoid_f(wp[jn])); av[jn] = sigmoid_f(ap[jn]); kx[jn] = kv[jn] * kkw[jn]; ssq += kx[jn] * kx[jn]; }
                ssq = row16_sum(ssq); const float rn = 1.0f / sqrtf(fmaxf(ssq, 1e-24f));
                f32x4 nkk, akk, kd;
#pragma unroll
                for (int jn = 0; jn < 4; ++jn) { const float kkn = kx[jn] * rn; nkk[jn] = -kkn; akk[jn] = kkn * av[jn]; kd[jn] = kv[jn] * (1.0f + (av[jn] - 1.0f) * kaw[jn]); bet += rv4[jn] * kd[jn] * rkw[jn]; }
                bet = row16_sum(bet);
                *(LAS f32x4*)(SW + t16 * 64 + kc) = dec; *(LAS f32x4*)(SKK + t16 * 64 + kc) = nkk; *(LAS f32x4*)(SAK + t16 * 64 + kc) = akk; *(LAS f32x4*)(SKD + t16 * 64 + kc) = kd; *(LAS f32x4*)(SR + t16 * 64 + kc) = rv4;
                SV[t16 * 32 + 2 * cg] = bflo(rv); SV[t16 * 32 + 2 * cg + 1] = bfhi(rv);
                if (cg == 0 && half == 0) BETA[((size_t)dir * NTOK + seq_row(b, dir, c * 32 + t16)) * 16 + h] = bet;
                if (c + 1 < T / 32) RW_LOAD(c + 1);
            }
            __syncthreads();
#pragma unroll 4
            for (int t_ = 0; t_ < 32; ++t_) {
                const f32x4 w4 = *(const LAS f32x4*)(SW + t_ * 64 + kc), nk = *(const LAS f32x4*)(SKK + t_ * 64 + kc), ak = *(const LAS f32x4*)(SAK + t_ * 64 + kc), kd = *(const LAS f32x4*)(SKD + t_ * 64 + kc), r4 = *(const LAS f32x4*)(SR + t_ * 64 + kc);
                const float vv = SV[t_ * 32 + t16];
                float sa = (S0 * nk[0] + S1 * nk[1]) + (S2 * nk[2] + S3 * nk[3]);
                sa = row16_sum(sa);
                S0 = S0 * w4[0] + (sa * ak[0] + vv * kd[0]); S1 = S1 * w4[1] + (sa * ak[1] + vv * kd[1]); S2 = S2 * w4[2] + (sa * ak[2] + vv * kd[2]); S3 = S3 * w4[3] + (sa * ak[3] + vv * kd[3]);
                float o = (S0 * r4[0] + S1 * r4[1]) + (S2 * r4[2] + S3 * r4[3]);
                o = row16_sum(o);
                if (cg == 0) SO[t_ * 32 + t16] = o;
            }
            __syncthreads();
            { const size_t row_ = (size_t)seq_row(b, dir, c * 32 + t16);
              *(unsigned*)(O + ((size_t)dir * NTOK + row_) * 1024 + h * 64 + half * 32 + 2 * cg) = pk2(SO[t16 * 32 + 2 * cg], SO[t16 * 32 + 2 * cg + 1]); }
        }
#undef RW_LOAD
    }
}

PHASE_FN void gemm_mlin(Frame F, int jl) { unsigned char* MIX = F.ws + WS_MIX; unsigned char* HY = F.ws + WS_HY;
    pg8::Gemm g{(const bf16*)HY, (const bf16*)(F.W + W_ML_WIN + jl * W_ML_WIN_SZ), NTOK, 4352, 1024}; pg8::StaticOrder So; So.init(NTOK, 4352, F.G, F.bid);
    pg8::EpiMlstmIn E{(bf16*)MIX, (bf16*)(MIX + 2 * ROWB), (bf16*)(MIX + 3 * ROWB), (float*)(MIX + 4 * ROWB), INP(IN_ML_BGATE) + jl * 32};
    pg8::gemm_phase<pg8::EpiMlstmIn, pg8::StaticOrder, GEMM_ALIGN, GEMM_SP2>(F.lds, g, So, E); }
PHASE_FN void gemm_resid(Frame F, const bf16* A, const bf16* Bt, int L) {
    pg8::Gemm g{A, Bt, NTOK, 1024, 1024}; pg8::StaticOrder So; So.init(NTOK, 1024, F.G, F.bid);
    pg8::EpiResid E{(float*)(F.ws + WS_S), (const float*)(F.ws + WS_MOD) + (size_t)L * 5 * 6144, 2}; pg8::gemm_phase<pg8::EpiResid, pg8::StaticOrder, GEMM_ALIGN, GEMM_SP2>(F.lds, g, So, E); }
PHASE_FN void gemm_rwin(Frame F) { unsigned char* MIX = F.ws + WS_MIX; unsigned char* HY = F.ws + WS_HY;
    bf16* Rb = (bf16*)MIX; bf16* Kb = (bf16*)(MIX + ROWB); bf16* Vb = (bf16*)(MIX + 2 * ROWB); float* WH = (float*)(MIX + 3 * ROWB); float* AH = WH + (size_t)NTOK * 128; bf16* GH = (bf16*)(AH + (size_t)NTOK * 128);
    pg8::Gemm g{(const bf16*)HY, (const bf16*)(F.W + W_RW_IN), NTOK, 3584, 2048}; pg8::StaticOrder So; So.init(NTOK, 3584, F.G, F.bid);
    pg8::EpiRwkvIn E{Rb, Kb, Vb, WH, AH, GH}; pg8::gemm_phase<pg8::EpiRwkvIn, pg8::StaticOrder, GEMM_ALIGN, GEMM_SP2>(F.lds, g, So, E); }
PHASE_FN void gemm_rwg(Frame F) { unsigned char* MIX = F.ws + WS_MIX;
    float* WH = (float*)(MIX + 3 * ROWB); float* AH = WH + (size_t)NTOK * 128; bf16* GH = (bf16*)(AH + (size_t)NTOK * 128);
    pg8::Gemm g{GH, (const bf16*)(F.W + W_RW_G2), NTOK, 1024, 256}; pg8::StaticOrder So; So.init(NTOK, 1024, F.G, F.bid);
    pg8::EpiBf16Plain E{(bf16*)MIX, 1024}; pg8::gemm_phase<pg8::EpiBf16Plain, pg8::StaticOrder, GEMM_ALIGN, GEMM_SP2>(F.lds, g, So, E); }
PHASE_FN void gemm_hgin(Frame F) { unsigned char* MIX = F.ws + WS_MIX; unsigned char* HY = F.ws + WS_HY;
    pg8::Gemm g{(const bf16*)HY, (const bf16*)(F.W + W_HG_IN), NTOK, 5120, 1024}; pg8::StaticOrder So; So.init(NTOK, 5120, F.G, F.bid);
    pg8::EpiHgrnIn E{(bf16*)MIX, (bf16*)(MIX + ROWB), (bf16*)(MIX + 2 * ROWB), (bf16*)(MIX + 3 * ROWB), (size_t)NTOK * 1024, INP(IN_HG_BF), (const float*)(F.ws + WS_LB)};
    pg8::gemm_phase<pg8::EpiHgrnIn, pg8::StaticOrder, GEMM_ALIGN, GEMM_SP2>(F.lds, g, So, E); }
PHASE_FN void gemm_moe1(Frame F, int L) { unsigned char* MIX = F.ws + WS_MIX; LAS int* pref = (LAS int*)(F.lds + LDS_PHASE_BYTES); moe_prefix(F, L, pref, pref + 32);
    pg8::Gemm g{(const bf16*)MIX, (const bf16*)(F.W + W_EX13), NSLOT, 16384, 1024}; pg8::MoeOrder So{pref, F.G, F.bid};
    pg8::EpiMoe1 E{(bf16*)(MIX + 140 * MiB)}; pg8::gemm_phase<pg8::EpiMoe1, pg8::MoeOrder, GEMM_ALIGN, GEMM_SP2>(F.lds, g, So, E); }
PHASE_FN void gemm_moe2(Frame F, int L) { unsigned char* MIX = F.ws + WS_MIX; LAS int* pref = (LAS int*)(F.lds + LDS_PHASE_BYTES); moe_prefix(F, L, pref, pref + 32);
    pg8::Gemm g{(const bf16*)(MIX + 140 * MiB), (const bf16*)(F.W + W_EX2), NSLOT, 16384, 512}; pg8::MoeOrder So{pref, F.G, F.bid};
    pg8::EpiMoe2 E{(bf16*)(MIX + 210 * MiB), (const int*)(F.ws + WS_SLOT_TOK), (const float*)(F.ws + WS_SLOT_GATE)};
    pg8::gemm_phase<pg8::EpiMoe2, pg8::MoeOrder, GEMM_ALIGN, GEMM_SP2>(F.lds, g, So, E); }

constexpr int PH_PER_LAYER = 12, PH_LAYER0 = 2, PH_FINAL = PH_LAYER0 + DEPTH * PH_PER_LAYER, N_PHASES = PH_FINAL + 1;
__global__ void __launch_bounds__(NTHR, 2) fwd_kernel(Args args) {
    extern __shared__ __attribute__((aligned(16))) unsigned char lds_raw[];
    Frame F;
    F.lds = (LAS unsigned char*)lds_raw; F.out = args.out; F.ws = args.ws; F.W = args.wts;
    F.tid = threadIdx.x; F.lane = F.tid & 63; F.wave = __builtin_amdgcn_readfirstlane(F.tid >> 6); F.bid = blockIdx.x; F.G = gridDim.x;
    volatile LAS unsigned* MISC = (volatile LAS unsigned*)(F.lds + MISC_OFF);
    if (F.tid < 32) MISC[F.tid] = 0u;
    if (F.tid < 42) ((LAS unsigned long long*)(F.lds + PTAB_OFF))[F.tid] = (unsigned long long)args.in[F.tid];
    __syncthreads();
    const int lo = args.ph_lo, hi = args.ph_hi;
    XcdBarrier bar; bar.bar = (unsigned*)args.ws + CW_BAR; bar.x = 0; bar.st = MISC + 8;
    if (hi - lo > 1) bar = xcd_barrier_post((unsigned*)args.ws + CW_BAR, MISC + 8);
#define IN(k) (lo <= (k) && (k) < hi)
#define SEAM(k) do { if ((k) + 1 < hi) xcd_barrier(bar); } while (0)

    if (IN(0)) { pre_phase(fresh(F)); SEAM(0); }
    if (IN(1)) { modsum_phase(fresh(F)); SEAM(1); }

    for (int L = 0; L < DEPTH; ++L) {
        const int kind = L % 3, jl = L / 3, pb = PH_LAYER0 + L * PH_PER_LAYER;
        if (IN(pb + 0)) { expert_weights(fresh(F), L); norm_phase<0>(fresh(F), L, L > 0, kind == 1 ? 2048 : 1024); SEAM(pb + 0); }
        if (kind == 0) {
            if (IN(pb + 2)) { gemm_mlin(fresh(F), jl); SEAM(pb + 2); }
            if (IN(pb + 3)) { conv_phase(fresh(F), jl); SEAM(pb + 3); }
            if (IN(pb + 4)) { const Frame Fp = fresh(F); unsigned char* MIX = Fp.ws + WS_MIX; ml_scan_phase(Fp, (const bf16*)(Fp.ws + WS_HY), (const bf16*)(MIX + 2 * ROWB), (const float*)(MIX + 4 * ROWB), (bf16*)MIX); SEAM(pb + 4); }
            if (IN(pb + 6)) { const Frame Fp = fresh(F); unsigned char* MIX = Fp.ws + WS_MIX;
                headnorm_phase(Fp, (const bf16*)MIX, (const bf16*)(MIX + ROWB), (const bf16*)(MIX + 3 * ROWB), ldptr(Fp, IN_ML_HEADG) + jl * 1024, (bf16*)(Fp.ws + WS_HY + ROWB)); SEAM(pb + 6); }
            if (IN(pb + 7)) { const Frame Fp = fresh(F); gemm_resid(Fp, (const bf16*)(Fp.ws + WS_HY + ROWB), (const bf16*)(Fp.W + W_ML_WOUT + jl * 2 * MiB), L); SEAM(pb + 7); }
        } else if (kind == 1) {
            if (IN(pb + 1)) { du_phase(fresh(F)); SEAM(pb + 1); }
            if (IN(pb + 2)) { gemm_rwin(fresh(F)); SEAM(pb + 2); }
            if (IN(pb + 4)) { const Frame Fp = fresh(F); unsigned char* MIX = Fp.ws + WS_MIX; float* WH = (float*)(MIX + 3 * ROWB); float* AH = WH + (size_t)NTOK * 128; float* BETA = (float*)((bf16*)(AH + (size_t)NTOK * 128) + (size_t)NTOK * 256);
                rw_scan_phase(Fp, (const bf16*)MIX, (const bf16*)(MIX + ROWB), (const bf16*)(MIX + 2 * ROWB), WH, AH, (bf16*)(Fp.ws + WS_HY), BETA); SEAM(pb + 4); }
            if (IN(pb + 5)) { gemm_rwg(fresh(F)); SEAM(pb + 5); }
            if (IN(pb + 6)) { const Frame Fp = fresh(F); unsigned char* MIX = Fp.ws + WS_MIX; float* WH = (float*)(MIX + 3 * ROWB); float* AH = WH + (size_t)NTOK * 128; float* BETA = (float*)((bf16*)(AH + (size_t)NTOK * 128) + (size_t)NTOK * 256);
                rwpost_phase(Fp, (const bf16*)(Fp.ws + WS_HY), (const bf16*)(Fp.ws + WS_HY + ROWB), BETA, (const bf16*)(MIX + 2 * ROWB), (const bf16*)MIX, (bf16*)(MIX + ROWB)); SEAM(pb + 6); }
            if (IN(pb + 7)) { const Frame Fp = fresh(F); gemm_resid(Fp, (const bf16*)(Fp.ws + WS_MIX + ROWB), (const bf16*)(Fp.W + W_RW_WOUT), L); SEAM(pb + 7); }
        } else {
            if (IN(pb + 2)) { gemm_hgin(fresh(F)); SEAM(pb + 2); }
            if (IN(pb + 4)) { const Frame Fp = fresh(F); unsigned char* MIX = Fp.ws + WS_MIX; hg_scan_phase(Fp, (const bf16*)MIX, (const bf16*)(MIX + ROWB), (const bf16*)(MIX + 3 * ROWB), (bf16*)(Fp.ws + WS_HY + ROWB), (bf16*)(Fp.ws + WS_HY)); SEAM(pb + 4); }
            if (IN(pb + 6)) { const Frame Fp = fresh(F); unsigned char* MIX = Fp.ws + WS_MIX;
                headnorm_phase(Fp, (const bf16*)(Fp.ws + WS_HY + ROWB), (const bf16*)(Fp.ws + WS_HY), (const bf16*)(MIX + 2 * ROWB), ldptr(Fp, IN_HG_HEADG), (bf16*)(Fp.ws + WS_HY + ROWB)); SEAM(pb + 6); }
            if (IN(pb + 7)) { const Frame Fp = fresh(F); gemm_resid(Fp, (const bf16*)(Fp.ws + WS_HY + ROWB), (const bf16*)(Fp.W + W_HG_WOUT), L); SEAM(pb + 7); }
        }
        if (IN(pb + 8)) { norm_phase<1>(fresh(F), L, false, 1024); SEAM(pb + 8); }
        if (IN(pb + 9)) { slots_phase(fresh(F), L); SEAM(pb + 9); }
        if (IN(pb + 10)) { gemm_moe1(fresh(F), L); SEAM(pb + 10); }
        if (IN(pb + 11)) { gemm_moe2(fresh(F), L); SEAM(pb + 11); }
    }
    if (IN(PH_FINAL)) norm_phase<2>(fresh(F), 0, true, 1024);
#undef IN
#undef SEAM
}

#ifndef MK_PER_PHASE
#define MK_PER_PHASE 0
#endif
extern "C" void kernel_launch(void* const* d_in, const int* in_sizes, int n_in, void* d_out, int out_size, void* d_ws, size_t ws_size, hipStream_t stream) {
    static int grid = 0;
    if (grid == 0) {
        if (n_in != 42 || out_size != NB * SEQ * D || ws_size < WS_END) { fprintf(stderr, "kernel_launch: unexpected problem (n_in %d, out %d, ws %zu)\n", n_in, out_size, ws_size); grid = -1; return; }
        int dev = 0, cus = 0, per_cu = 0;
        if (hipGetDevice(&dev) != hipSuccess || hipDeviceGetAttribute(&cus, hipDeviceAttributeMultiprocessorCount, dev) != hipSuccess) { grid = -1; return; }
        if (hipFuncSetAttribute((const void*)fwd_kernel, hipFuncAttributeMaxDynamicSharedMemorySize, LDS_BYTES) != hipSuccess) { fprintf(stderr, "kernel_launch: hipFuncSetAttribute failed\n"); grid = -1; return; }
        if (hipOccupancyMaxActiveBlocksPerMultiprocessor(&per_cu, (const void*)fwd_kernel, NTHR, LDS_BYTES) != hipSuccess || per_cu < 1) { fprintf(stderr, "kernel_launch: occupancy query reports %d\n", per_cu); (void)hipGetLastError(); grid = -1; return; }
        grid = cus;
    }
    if (grid < 0) return;
    (void)hipMemsetAsync(d_ws, 0, CTL_ZERO_BYTES, stream);
    Args a{};
    for (int i = 0; i < 42; ++i) a.in[i] = (const float*)d_in[i];
    a.out = (float*)d_out; a.ws = (unsigned char*)d_ws;
    a.wts = (ws_size >= WS_END + W_BYTES) ? (unsigned char*)d_ws + WS_END : (unsigned char*)d_out;
#if MK_PER_PHASE
    for (int p = 0; p < N_PHASES; ++p) { a.ph_lo = p; a.ph_hi = p + 1; hipLaunchKernelGGL(fwd_kernel, dim3(grid), dim3(NTHR), LDS_BYTES, stream, a); }
#else
    a.ph_lo = 0; a.ph_hi = N_PHASES;
    hipLaunchKernelGGL(fwd_kernel, dim3(grid), dim3(NTHR), LDS_BYTES, stream, a);
#endif
}
```

```cpp
#include <hip/hip_runtime.h>
#include <cstdio>
#include <cstdint>

__device__ __forceinline__ float sigmoid_f(float x) { return 1.0f / (1.0f + __expf(-x)); }
__device__ __forceinline__ float silu_f(float x) { return x / (1.0f + __expf(-x)); }
__device__ __forceinline__ float logsigmoid_f(float x) { return fminf(x, 0.f) - log1pf(__expf(-fabsf(x))); }
namespace pg8 {
#define PG8_LAS __attribute__((address_space(3)))
typedef unsigned short bf16_t;
typedef short bf16x8 __attribute__((ext_vector_type(8)));
typedef float f32x4 __attribute__((ext_vector_type(4)));
typedef unsigned u32x4 __attribute__((ext_vector_type(4)));
constexpr int BM = 256, BK = 64, HALF = 128, HTB = HALF * BK * 2  , STAGE_BYTES = 8 * HTB, NXCD = 8, WGM = 8;

__host__ __device__ __forceinline__ int lds_byte(int r, int c) { const int st = (r >> 4) * 2 + (c >> 5), rr = r & 15, cc = c & 31, ob = rr * 64 + cc * 2; return st * 1024 + (ob ^ (((ob >> 9) & 1) << 5)); }
__host__ __device__ __forceinline__ void stage_rc(int b, int& R, int& C) { const int st = b / 1024, sb = b % 1024, swz = sb ^ (((sb >> 9) & 1) << 5); R = (st >> 1) * 16 + swz / 64; C = (st & 1) * 32 + (swz % 64) / 2; }
__host__ __device__ __forceinline__ int perm32(int rho) { const int n = rho >> 4, i = rho & 15; return 8 * (i >> 2) + 4 * n + (i & 3); }

struct Unit { int pm, pn; };
struct Gemm { const bf16_t* A; const bf16_t* Bt; int M, N, K; };

struct StaticOrder {
    int nM, nN, nwg, G, c;
    __host__ __device__ void init(int M, int N, int G_, int c_) { nM = M / BM; nN = N / BM; nwg = nM * nN; G = G_; c = c_; }
    __host__ __device__ bool next(int i, Unit& u) const {
        const long L = (long)i * G + c; if (L >= nwg) return false;
        int wgid = (int)L; { const int q = nwg / NXCD, r = nwg % NXCD, xcd = wgid % NXCD, off = wgid / NXCD; wgid = (xcd < r ? xcd * (q + 1) : r * (q + 1) + (xcd - r) * q) + off; }
        const int nig = WGM * nN, gid = wgid / nig, fm = gid * WGM, gsz = (nM - fm) < WGM ? (nM - fm) : WGM;
        u.pm = fm + ((wgid % nig) % gsz); u.pn = (wgid % nig) / gsz; return true;
    }
    __device__ __forceinline__ void a_ready(const Unit&) const {}
    __device__ __forceinline__ void done(const Unit&) const {}
};
__device__ __forceinline__ unsigned cvt_pk_bf16(float lo, float hi) { unsigned r; asm volatile("v_cvt_pk_bf16_f32 %0, %1, %2" : "=v"(r) : "v"(lo), "v"(hi)); return r; }
typedef unsigned u32x2 __attribute__((ext_vector_type(2)));
__device__ __forceinline__ void st8(bf16_t* p, f32x4 v0, f32x4 v1) { u32x4 w; w.x = cvt_pk_bf16(v0[0], v0[1]); w.y = cvt_pk_bf16(v0[2], v0[3]); w.z = cvt_pk_bf16(v1[0], v1[1]); w.w = cvt_pk_bf16(v1[2], v1[3]); *(u32x4*)p = w; }
template <int ACT> __device__ __forceinline__ f32x4 act4(f32x4 v) {
    if (ACT == 1) { v[0] = sigmoid_f(v[0]); v[1] = sigmoid_f(v[1]); v[2] = sigmoid_f(v[2]); v[3] = sigmoid_f(v[3]); }
    if (ACT == 2) { v[0] = silu_f(v[0]); v[1] = silu_f(v[1]); v[2] = silu_f(v[2]); v[3] = silu_f(v[3]); }
    return v; }
template <int ACT> __device__ __forceinline__ void store_tile_bf16(const f32x4 (&acc)[2][2][4][2], bf16_t* base, int ld, int row0, int cw) {
#pragma unroll
    for (int ai = 0; ai < 2; ++ai)
#pragma unroll
        for (int m = 0; m < 4; ++m) { bf16_t* rp = base + (size_t)(row0 + ai * HALF + m * 16) * ld + cw;
#pragma unroll
            for (int bj = 0; bj < 2; ++bj) st8(rp + bj * HALF, act4<ACT>(acc[ai][bj][m][0]), act4<ACT>(acc[ai][bj][m][1])); }
}
struct EpiBf16Plain { static constexpr bool PERM = true, AFTER_DRAIN = false; bf16_t* O; int ldc;
    __device__ __forceinline__ void operator()(const f32x4 (&acc)[2][2][4][2], const Unit& u, int wr, int wc, int fr, int fq) const {
        store_tile_bf16<0>(acc, O + u.pn * BM, ldc, u.pm * BM + wr * 64 + fr, wc * 32 + 8 * fq); }
};
struct EpiMlstmIn { static constexpr bool PERM = true, AFTER_DRAIN = false;
    bf16_t* QKPRE; bf16_t* V; bf16_t* OG; float* GATES; const float* bgate;
    __device__ __forceinline__ void operator()(const f32x4 (&acc)[2][2][4][2], const Unit& u, int wr, int wc, int fr, int fq) const {
        const int row0 = u.pm * BM + wr * 64 + fr, cw = wc * 32 + 8 * fq;
        if (u.pn < 8) store_tile_bf16<0>(acc, QKPRE + u.pn * BM, 2048, row0, cw);
        else if (u.pn < 12) store_tile_bf16<0>(acc, V + (u.pn - 8) * BM, 1024, row0, cw);
        else if (u.pn < 16) store_tile_bf16<1>(acc, OG + (u.pn - 12) * BM, 1024, row0, cw);
        else if (wc == 0) {
            const f32x4 b0 = *(const f32x4*)(bgate + 8 * fq), b1 = *(const f32x4*)(bgate + 8 * fq + 4);
#pragma unroll
            for (int ai = 0; ai < 2; ++ai)
#pragma unroll
                for (int m = 0; m < 4; ++m) { float* gp = GATES + (size_t)(row0 + ai * HALF + m * 16) * 32 + 8 * fq;
                    *(f32x4*)gp = acc[ai][0][m][0] + b0; *(f32x4*)(gp + 4) = acc[ai][0][m][1] + b1; }
        }
    }
};
struct EpiRwkvIn { static constexpr bool PERM = true, AFTER_DRAIN = false;
    bf16_t* R; bf16_t* Kk; bf16_t* V; float* WH; float* AH; bf16_t* GH;
    __device__ __forceinline__ void operator()(const f32x4 (&acc)[2][2][4][2], const Unit& u, int wr, int wc, int fr, int fq) const {
        const int row0 = u.pm * BM + wr * 64 + fr, cw = wc * 32 + 8 * fq;
        if (u.pn < 4) store_tile_bf16<0>(acc, R + u.pn * BM, 1024, row0, cw);
        else if (u.pn < 8) store_tile_bf16<0>(acc, Kk + (u.pn - 4) * BM, 1024, row0, cw);
        else if (u.pn < 12) store_tile_bf16<0>(acc, V + (u.pn - 8) * BM, 1024, row0, cw);
        else if (u.pn == 12) {
#pragma unroll
            for (int ai = 0; ai < 2; ++ai)
#pragma unroll
                for (int m = 0; m < 4; ++m) { const size_t r = (size_t)(row0 + ai * HALF + m * 16);
                    f32x4 t0 = acc[ai][0][m][0], t1 = acc[ai][0][m][1];
#pragma unroll
                    for (int j = 0; j < 4; ++j) { t0[j] = tanhf(t0[j]); t1[j] = tanhf(t1[j]); }
                    *(f32x4*)(WH + r * 128 + cw) = t0; *(f32x4*)(WH + r * 128 + cw + 4) = t1;
                    *(f32x4*)(AH + r * 128 + cw) = acc[ai][1][m][0]; *(f32x4*)(AH + r * 128 + cw + 4) = acc[ai][1][m][1]; }
        } else {
#pragma unroll
            for (int ai = 0; ai < 2; ++ai)
#pragma unroll
                for (int m = 0; m < 4; ++m) { bf16_t* rp = GH + (size_t)(row0 + ai * HALF + m * 16) * 256 + cw;
                    st8(rp, act4<1>(acc[ai][0][m][0]), act4<1>(acc[ai][0][m][1])); *(u32x4*)(rp + HALF) = (u32x4){0u, 0u, 0u, 0u}; }
        }
    }
};
struct EpiHgrnIn { static constexpr bool PERM = true, AFTER_DRAIN = false;
    bf16_t* Q; bf16_t* V; bf16_t* OG; bf16_t* LF; size_t lf_stride; const float* bf; const float* lb;
    __device__ __forceinline__ void operator()(const f32x4 (&acc)[2][2][4][2], const Unit& u, int wr, int wc, int fr, int fq) const {
        const int row0 = u.pm * BM + wr * 64 + fr, cw = wc * 32 + 8 * fq;
        if (u.pn < 4) store_tile_bf16<2>(acc, Q + u.pn * BM, 1024, row0, cw);
        else if (u.pn < 8) store_tile_bf16<0>(acc, V + (u.pn - 4) * BM, 1024, row0, cw);
        else if (u.pn < 12) store_tile_bf16<2>(acc, OG + (u.pn - 8) * BM, 1024, row0, cw);
        else {
            const int dir = (u.pn - 12) >> 2, ct = ((u.pn - 12) & 3) * BM; bf16_t* base = LF + (size_t)dir * lf_stride + ct;
            f32x4 bb[2][2], ll[2][2];
#pragma unroll
            for (int bj = 0; bj < 2; ++bj)
#pragma unroll
                for (int n = 0; n < 2; ++n) { bb[bj][n] = *(const f32x4*)(bf + dir * 1024 + ct + bj * HALF + cw + 4 * n); ll[bj][n] = *(const f32x4*)(lb + ct + bj * HALF + cw + 4 * n); }
#pragma unroll
            for (int ai = 0; ai < 2; ++ai)
#pragma unroll
                for (int m = 0; m < 4; ++m) { bf16_t* rp = base + (size_t)(row0 + ai * HALF + m * 16) * 1024 + cw;
#pragma unroll
                    for (int bj = 0; bj < 2; ++bj) { f32x4 o[2];
#pragma unroll
                        for (int n = 0; n < 2; ++n)
#pragma unroll
                            for (int j = 0; j < 4; ++j) { const float l = ll[bj][n][j]; o[n][j] = __logf(l + (1.f - l) * sigmoid_f(acc[ai][bj][m][n][j] + bb[bj][n][j])); }
                        st8(rp + bj * HALF, o[0], o[1]); } }
        }
    }
};
struct EpiResid { static constexpr bool PERM = false, AFTER_DRAIN = false;
    float* S; const float* mod; int gate_idx;
    __device__ __forceinline__ void operator()(const f32x4 (&acc)[2][2][4][2], const Unit& u, int wr, int wc, int fr, int fq) const {
        const int b = u.pm / 33, seg = (u.pm - b * 33 == 0) ? 0 : 1 + b;
        const int row0 = u.pm * BM + wr * 64 + fr, col0 = u.pn * BM + wc * 32 + 4 * fq;
        const float* gp = mod + seg * 6144 + gate_idx * 1024 + col0;
        f32x4 gv[2][2];
#pragma unroll
        for (int bj = 0; bj < 2; ++bj)
#pragma unroll
            for (int n = 0; n < 2; ++n) gv[bj][n] = *(const f32x4*)(gp + bj * HALF + n * 16);
#pragma unroll
        for (int ai = 0; ai < 2; ++ai)
#pragma unroll
            for (int m = 0; m < 4; ++m) { float* rowp = S + (size_t)(row0 + ai * HALF + m * 16) * 1024 + col0;
#pragma unroll
                for (int bj = 0; bj < 2; ++bj)
#pragma unroll
                    for (int n = 0; n < 2; ++n) { f32x4* p = (f32x4*)(rowp + bj * HALF + n * 16); *p = *p + acc[ai][bj][m][n] * gv[bj][n]; } }
    }
};
struct EpiMoe1 { static constexpr bool PERM = true, AFTER_DRAIN = false; bf16_t* ACT;
    __device__ __forceinline__ void operator()(const f32x4 (&acc)[2][2][4][2], const Unit& u, int wr, int wc, int fr, int fq) const {
        const int row0 = u.pm * BM + wr * 64 + fr, pnl = u.pn & 3, c0 = pnl * 128 + wc * 16 + 4 * fq;
#pragma unroll
        for (int ai = 0; ai < 2; ++ai)
#pragma unroll
            for (int m = 0; m < 4; ++m) { bf16_t* rp = ACT + (size_t)(row0 + ai * HALF + m * 16) * 512 + c0;
#pragma unroll
                for (int bj = 0; bj < 2; ++bj) { const f32x4 a = acc[ai][bj][m][0], b = acc[ai][bj][m][1];
                    u32x2 w; w.x = cvt_pk_bf16(silu_f(a[0]) * b[0], silu_f(a[1]) * b[1]); w.y = cvt_pk_bf16(silu_f(a[2]) * b[2], silu_f(a[3]) * b[3]);
                    *(u32x2*)(rp + bj * 64) = w; } }
    }
};
struct EpiMoe2 { static constexpr bool PERM = true, AFTER_DRAIN = false; bf16_t* YM; const int* slot_tok; const float* slot_gate;
    __device__ __forceinline__ void operator()(const f32x4 (&acc)[2][2][4][2], const Unit& u, int wr, int wc, int fr, int fq) const {
        const int row0 = u.pm * BM + wr * 64 + fr, col0 = (u.pn & 3) * BM + wc * 32 + 8 * fq;
#pragma unroll
        for (int ai = 0; ai < 2; ++ai)
#pragma unroll
            for (int m = 0; m < 4; ++m) { const int slot = row0 + ai * HALF + m * 16; const int dst = slot_tok[slot]; const float g = slot_gate[slot];
                if (dst >= 0) { bf16_t* rp = YM + (size_t)dst * 1024 + col0;
#pragma unroll
                    for (int bj = 0; bj < 2; ++bj) st8(rp + bj * HALF, acc[ai][bj][m][0] * g, acc[ai][bj][m][1] * g); } }
    }
};
struct MoeOrder { const PG8_LAS int* pref; int G, c;
    __device__ __forceinline__ bool next(int i, Unit& u) const {
        const int L = i * G + c, nt = pref[16]; if (L >= nt * 4) return false;
        const int tile = L >> 2; int e = 0;
#pragma unroll
        for (int j = 1; j < 16; ++j) e += (tile >= pref[j]) ? 1 : 0;
        u.pm = tile; u.pn = e * 4 + (L & 3); return true; }
    __device__ __forceinline__ void a_ready(const Unit&) const {}
    __device__ __forceinline__ void done(const Unit&) const {}
};
template <class Epi, class Sched, bool ALIGN_EPI = false, bool SP2 = false>
__device__ __forceinline__ void gemm_phase(PG8_LAS unsigned char* lds, const Gemm g, const Sched& S, const Epi& E) {
    int tid_ = threadIdx.x; asm volatile("" : "+v"(tid_));
    const int tid = tid_, wid = __builtin_amdgcn_readfirstlane(tid >> 6), lane = tid & 63, wr = wid >> 2, wc = wid & 3, fr = lane & 15, fq = lane >> 4;
    const int K = g.K, nt = K / BK;
    unsigned voffA[2], voffB[2];
#pragma unroll
    for (int i = 0; i < 2; ++i) { int R, C; stage_rc(tid * 16 + i * 8192, R, C); const int Rb = Epi::PERM ? ((R & ~31) + perm32(R & 31)) : R;
        voffA[i] = (unsigned)(R * K + C) * 2u; voffB[i] = (unsigned)(Rb * K + C) * 2u; }
    const size_t kstep = (size_t)(BK * 2);
    const size_t hstep = (size_t)HALF * K * 2;
    const size_t tstep = 2 * hstep;
    const unsigned ldsw = (unsigned)wid * 1024u;
    const int aoff = lds_byte(wr * 64 + fr, fq * 8), boff = lds_byte(wc * 32 + fr, fq * 8);
#define PG8_SA(b, h) (((b) * 2 + (h)) * HTB)
#define PG8_SB(b, h) ((4 + (b) * 2 + (h)) * HTB)
#define PG8_STAGE(bufoff, gbase, voff) do { _Pragma("unroll") for (int _i = 0; _i < 2; ++_i) \
        __builtin_amdgcn_global_load_lds((const unsigned*)((const char*)(gbase) + (voff)[_i]), (PG8_LAS unsigned*)(lds + (bufoff) + ldsw + _i * 8192), 16, 0, 0); } while (0)
#define PG8_LDA(dst, b, h) do { _Pragma("unroll") for (int m = 0; m < 4; ++m) _Pragma("unroll") for (int k = 0; k < 2; ++k) dst[m][k] = *(const PG8_LAS bf16x8*)(lds + PG8_SA(b, h) + aoff + m * 2048 + k * 1024); } while (0)
#define PG8_LDB(dst, b, h) do { _Pragma("unroll") for (int n = 0; n < 2; ++n) _Pragma("unroll") for (int k = 0; k < 2; ++k) dst[n][k] = *(const PG8_LAS bf16x8*)(lds + PG8_SB(b, h) + boff + n * 2048 + k * 1024); } while (0)
#define PG8_MMA(ai, bj, At, Bt) do { __builtin_amdgcn_s_setprio(1); _Pragma("unroll") for (int m = 0; m < 4; ++m) _Pragma("unroll") for (int n = 0; n < 2; ++n) _Pragma("unroll") for (int k = 0; k < 2; ++k) \
        acc[ai][bj][m][n] = __builtin_amdgcn_mfma_f32_16x16x32_bf16(Bt[n][k], At[m][k], acc[ai][bj][m][n], 0, 0, 0); __builtin_amdgcn_s_setprio(0); } while (0)
#define PG8_WAIT_V(n) asm volatile("s_waitcnt vmcnt(" #n ")" ::: "memory")
#define PG8_WAIT_L(n) asm volatile("s_waitcnt lgkmcnt(" #n ")" ::: "memory")
#define PG8_BAR __builtin_amdgcn_s_barrier()
#define PG8_SCHED __builtin_amdgcn_sched_barrier(0)
    Unit cur, nxt; int ui = 0;
    if (!S.next(0, cur)) return;
    f32x4 acc[2][2][4][2];
#pragma unroll
    for (int a = 0; a < 2; ++a)
#pragma unroll
        for (int b = 0; b < 2; ++b)
#pragma unroll
            for (int m = 0; m < 4; ++m)
#pragma unroll
                for (int n = 0; n < 2; ++n) acc[a][b][m][n] = (f32x4){0.f, 0.f, 0.f, 0.f};
    bf16x8 At[4][2], B0[2][2], B1[2][2];
    const char* cA = (const char*)g.A + (size_t)cur.pm * tstep; const char* cB = (const char*)g.Bt + (size_t)cur.pn * tstep;
    S.a_ready(cur);
    if constexpr (SP2) {
        PG8_STAGE(PG8_SB(0, 0), cB, voffB); PG8_STAGE(PG8_SB(0, 1), cB + hstep, voffB); PG8_STAGE(PG8_SA(0, 0), cA, voffA); PG8_STAGE(PG8_SA(0, 1), cA + hstep, voffA);
        if (wr == 1) PG8_BAR;
        PG8_WAIT_V(2); PG8_BAR;
        PG8_STAGE(PG8_SB(1, 0), cB + kstep, voffB); PG8_STAGE(PG8_SA(1, 0), cA + kstep, voffA); PG8_STAGE(PG8_SB(1, 1), cB + hstep + kstep, voffB);
        PG8_WAIT_V(6); PG8_BAR;
    } else {
        PG8_STAGE(PG8_SB(0, 0), cB, voffB); PG8_STAGE(PG8_SA(0, 0), cA, voffA); PG8_STAGE(PG8_SB(0, 1), cB + hstep, voffB); PG8_STAGE(PG8_SA(0, 1), cA + hstep, voffA);
        if (wr == 1) PG8_BAR;
        PG8_WAIT_V(4); PG8_BAR;
        PG8_STAGE(PG8_SB(1, 0), cB + kstep, voffB); PG8_STAGE(PG8_SA(1, 0), cA + kstep, voffA); PG8_STAGE(PG8_SB(1, 1), cB + hstep + kstep, voffB);
        PG8_WAIT_V(6); PG8_BAR;
    }
    for (;;) {
        const bool has_next = S.next(ui + 1, nxt);
        const char* nA = has_next ? (const char*)g.A + (size_t)nxt.pm * tstep : cA; const char* nB = has_next ? (const char*)g.Bt + (size_t)nxt.pn * tstep : cB;
        for (int t = 0; t < nt; t += 2) {
            const bool last = (t == nt - 2);
            const char* a1 = cA + (size_t)(t + 1) * kstep;
            const char* a2 = last ? nA : cA + (size_t)(t + 2) * kstep; const char* b2 = last ? nB : cB + (size_t)(t + 2) * kstep;
            const char* a3 = a2 + kstep; const char* b3 = b2 + kstep;
            if (last && has_next) S.a_ready(nxt);
            if constexpr (SP2) {
            PG8_LDB(B0, 0, 0); PG8_LDB(B1, 0, 1); PG8_SCHED; PG8_LDA(At, 0, 0); PG8_STAGE(PG8_SA(1, 1), a1 + hstep, voffA);
            PG8_WAIT_V(8); PG8_WAIT_L(0); PG8_BAR; PG8_MMA(0, 0, At, B0); PG8_MMA(0, 1, At, B1); PG8_BAR; PG8_SCHED;
            PG8_LDA(At, 0, 1); PG8_STAGE(PG8_SB(0, 0), b2, voffB); PG8_STAGE(PG8_SB(0, 1), b2 + hstep, voffB); PG8_STAGE(PG8_SA(0, 0), a2, voffA);
            PG8_WAIT_V(8); PG8_WAIT_L(0); PG8_BAR; PG8_MMA(1, 0, At, B0); PG8_MMA(1, 1, At, B1); PG8_BAR; PG8_SCHED;
            PG8_LDB(B0, 1, 0); PG8_LDB(B1, 1, 1); PG8_SCHED; PG8_LDA(At, 1, 0); PG8_STAGE(PG8_SA(0, 1), a2 + hstep, voffA);
            PG8_WAIT_V(8); PG8_WAIT_L(0); PG8_BAR; PG8_MMA(0, 0, At, B0); PG8_MMA(0, 1, At, B1); PG8_BAR; PG8_SCHED;
            PG8_LDA(At, 1, 1); PG8_STAGE(PG8_SB(1, 0), b3, voffB); PG8_STAGE(PG8_SB(1, 1), b3 + hstep, voffB); PG8_STAGE(PG8_SA(1, 0), a3, voffA);
            PG8_WAIT_V(8); PG8_WAIT_L(0); PG8_BAR; PG8_MMA(1, 0, At, B0); PG8_MMA(1, 1, At, B1); PG8_BAR; PG8_SCHED;
            } else {
            PG8_LDB(B0, 0, 0); PG8_SCHED; PG8_LDA(At, 0, 0); PG8_STAGE(PG8_SA(1, 1), a1 + hstep, voffA);
            PG8_WAIT_L(8); PG8_BAR; PG8_WAIT_L(0); PG8_MMA(0, 0, At, B0); PG8_BAR; PG8_SCHED;
            PG8_LDB(B1, 0, 1); PG8_STAGE(PG8_SB(0, 0), b2, voffB);
            PG8_BAR; PG8_WAIT_L(0); PG8_MMA(0, 1, At, B1); PG8_BAR;
            PG8_LDA(At, 0, 1); PG8_STAGE(PG8_SA(0, 0), a2, voffA);
            PG8_BAR; PG8_WAIT_L(0); PG8_MMA(1, 0, At, B0); PG8_BAR; PG8_SCHED;
            PG8_STAGE(PG8_SB(0, 1), b2 + hstep, voffB);
            PG8_WAIT_V(6); PG8_BAR; PG8_MMA(1, 1, At, B1); PG8_BAR;
            PG8_LDB(B0, 1, 0); PG8_SCHED; PG8_LDA(At, 1, 0); PG8_STAGE(PG8_SA(0, 1), a2 + hstep, voffA);
            PG8_WAIT_L(8); PG8_BAR; PG8_WAIT_L(0); PG8_MMA(0, 0, At, B0); PG8_BAR; PG8_SCHED;
            PG8_LDB(B1, 1, 1); PG8_STAGE(PG8_SB(1, 0), b3, voffB);
            PG8_BAR; PG8_WAIT_L(0); PG8_MMA(0, 1, At, B1); PG8_BAR;
            PG8_LDA(At, 1, 1); PG8_STAGE(PG8_SA(1, 0), a3, voffA);
            PG8_BAR; PG8_WAIT_L(0); PG8_MMA(1, 0, At, B0); PG8_BAR; PG8_SCHED;
            PG8_STAGE(PG8_SB(1, 1), b3 + hstep, voffB);
            PG8_WAIT_V(6); PG8_BAR; PG8_MMA(1, 1, At, B1); PG8_BAR;
            }
        }
        if constexpr (ALIGN_EPI) { if (wr == 0) PG8_BAR; }
        if constexpr (!Epi::AFTER_DRAIN) { E(acc, cur, wr, wc, fr, fq); S.done(cur); }
        if (!has_next) break;
#pragma unroll
        for (int a = 0; a < 2; ++a)
#pragma unroll
            for (int b = 0; b < 2; ++b)
#pragma unroll
                for (int m = 0; m < 4; ++m)
#pragma unroll
                    for (int n = 0; n < 2; ++n) acc[a][b][m][n] = (f32x4){0.f, 0.f, 0.f, 0.f};
        cur = nxt; cA = nA; cB = nB; ++ui;
        if constexpr (ALIGN_EPI) { if (wr == 1) PG8_BAR; }
    }
    PG8_WAIT_V(0);
    if constexpr (!ALIGN_EPI) { if (wr == 0) PG8_BAR; }
    PG8_BAR;
    if constexpr (Epi::AFTER_DRAIN) { E.fused(acc, cur, wr, wc, fr, fq, lds, wid, lane); S.done(cur); }
#undef PG8_SA
#undef PG8_SB
#undef PG8_STAGE
#undef PG8_LDA
#undef PG8_LDB
#undef PG8_MMA
#undef PG8_WAIT_V
#undef PG8_WAIT_L
#undef PG8_BAR
#undef PG8_SCHED
}
}

#define LAS __attribute__((address_space(3)))
#ifndef PHASE_FN
#define PHASE_FN __device__ __forceinline__
#endif
#ifndef GEMM_SP2
#define GEMM_SP2 true
#endif
#ifndef GEMM_ALIGN
#define GEMM_ALIGN false
#endif
typedef unsigned short bf16;
typedef pg8::bf16x8 bf16x8;
typedef pg8::f32x4 f32x4;
typedef pg8::u32x4 u32x4;
typedef pg8::u32x2 u32x2;
constexpr int D = 1024, NB = 4, SEQ = 8192, CTX = 256, T = CTX + SEQ, NTOK = NB * T, DEPTH = 4;
constexpr int NWAVES = 8, NTHR = 512;
constexpr int NSLOT = 71680;
constexpr size_t MiB = 1u << 20;
constexpr size_t CTL_ZERO_BYTES = 2 * MiB;
constexpr int CW_BAR = 1024;
constexpr int CW_MOE = 8192;
constexpr size_t WS_MOD = 1 * MiB;
constexpr size_t WS_LB = 2 * MiB;
constexpr size_t WS_TOK = 2 * MiB + 65536;
constexpr size_t WS_SLOT_TOK = 3 * MiB;
constexpr size_t WS_SLOT_GATE = 3 * MiB + 524288;
constexpr size_t WS_S = 4 * MiB;
constexpr size_t WS_HY = 136 * MiB;
constexpr size_t WS_MIX = 268 * MiB;
constexpr size_t WS_END = 610 * MiB;
constexpr size_t ROWB = (size_t)NTOK * 1024 * 2;
constexpr size_t W_ML_WIN = 0, W_ML_WIN_SZ = (size_t)4352 * 1024 * 2;
constexpr size_t W_ML_WOUT = 17 * MiB;
constexpr size_t W_RW_IN = 21 * MiB;
constexpr size_t W_RW_G2 = 35 * MiB;
constexpr size_t W_RW_WOUT = 36 * MiB;
constexpr size_t W_HG_IN = 38 * MiB;
constexpr size_t W_HG_WOUT = 48 * MiB;
constexpr size_t W_EX13 = 50 * MiB;
constexpr size_t W_EX2 = 82 * MiB;
constexpr size_t W_BYTES = 98 * MiB;
constexpr int LDS_PHASE_BYTES = 131072;
constexpr int MISC_OFF = LDS_PHASE_BYTES + 320;
constexpr int LDS_BYTES = 147456;

#define VM_WAIT() asm volatile("s_waitcnt vmcnt(0)" ::: "memory")
#define LDS_WAIT() asm volatile("s_waitcnt lgkmcnt(0)" ::: "memory")
__device__ __forceinline__ unsigned f2bf(float f) { unsigned u = __builtin_bit_cast(unsigned, f); return (u + 0x7fffu + ((u >> 16) & 1u)) >> 16; }
__device__ __forceinline__ unsigned pk2(float lo, float hi) { return f2bf(lo) | (f2bf(hi) << 16); }
__device__ __forceinline__ float bf2f(unsigned b) { return __builtin_bit_cast(float, b << 16); }
__device__ __forceinline__ float bflo(unsigned w) { return __builtin_bit_cast(float, w << 16); }
__device__ __forceinline__ float bfhi(unsigned w) { return __builtin_bit_cast(float, w & 0xffff0000u); }
__device__ __forceinline__ float wave_sum(float v) {
#pragma unroll
    for (int o = 1; o < 64; o <<= 1) v += __shfl_xor(v, o);
    return v; }
__device__ __forceinline__ float wave_max(float v) {
#pragma unroll
    for (int o = 1; o < 64; o <<= 1) v = fmaxf(v, __shfl_xor(v, o));
    return v; }
template <int CTRL> __device__ __forceinline__ float dpp_f(float v) { return __builtin_bit_cast(float, __builtin_amdgcn_update_dpp(0, __builtin_bit_cast(int, v), CTRL, 0xF, 0xF, false)); }
__device__ __forceinline__ float row16_sum(float v) { v += dpp_f<0xB1>(v); v += dpp_f<0x4E>(v); v += dpp_f<0x124>(v); v += dpp_f<0x128>(v); return v; }
template <int K> __device__ __forceinline__ f32x4 mm16(f32x4 acc, const LAS bf16* A, int lda, const LAS bf16* Bt, int ldb, int lane) {
    const int r = lane & 15, q = lane >> 4;
#pragma unroll
    for (int kk = 0; kk < K / 32; ++kk) {
        const bf16x8 a = *(const LAS bf16x8*)(A + r * lda + kk * 32 + q * 8);
        const bf16x8 b = *(const LAS bf16x8*)(Bt + r * ldb + kk * 32 + q * 8);
        acc = __builtin_amdgcn_mfma_f32_16x16x32_bf16(a, b, acc, 0, 0, 0); }
    return acc; }
__device__ __forceinline__ int seq_row(int b, int dir, int i) {
    const int tt = (i < CTX) ? (dir ? CTX - 1 - i : i) : CTX + (dir ? SEQ - 1 - (i - CTX) : (i - CTX));
    return b * T + tt; }

#define XB_TMO      128
#define XB_XCNT(j)  (256  + 64 * (j))
#define XB_XSUB(j)  (1280 + 64 * (j))
#define XB_XGEN(j)  (2304 + 64 * (j))
#define XB_TOP      3328
#define XB_TOPGEN   3392
#define XCD_BAR_WORDS 3456
#define XB_SPIN_CAP (1u << 18)

__device__ __forceinline__ unsigned xb_ld(unsigned* p)              { return __hip_atomic_load(p, __ATOMIC_RELAXED, __HIP_MEMORY_SCOPE_AGENT); }
__device__ __forceinline__ unsigned xb_add(unsigned* p, unsigned v) { return __hip_atomic_fetch_add(p, v, __ATOMIC_RELAXED, __HIP_MEMORY_SCOPE_AGENT); }
__device__ __forceinline__ unsigned xb_xcc_id() { return (unsigned)__builtin_amdgcn_s_getreg((3 << 11) | 20) & 0xFu; }
#define XB_SPIN(cond, bar) do { unsigned _sp = 0; while (cond) { __builtin_amdgcn_s_sleep(1); \
    if ((++_sp & 255u) == 0u) { if (xb_ld(&(bar)[XB_TMO])) break; if (_sp > XB_SPIN_CAP) { atomicAdd(&(bar)[XB_TMO], 1u); break; } } } } while (0)

struct XcdBarrier {
    unsigned* bar; unsigned x;
    volatile LAS unsigned* st;
};

__device__ __forceinline__ XcdBarrier xcd_barrier_post(unsigned* bar, volatile LAS unsigned* st) {
    XcdBarrier b; b.bar = bar; b.x = xb_xcc_id(); b.st = st;
    if (threadIdx.x == 0) (void)xb_add(&bar[XB_XCNT(b.x)], 1u);
    return b;
}
__device__ __forceinline__ void xcd_barrier_complete(unsigned* bar, unsigned x, unsigned& nloc, unsigned& nx) {
    const unsigned G = gridDim.x * gridDim.y * gridDim.z;
    unsigned sum, cnt, mine, sp = 0u;
    for (;;) {
        sum = 0u; cnt = 0u; mine = 0u;
#pragma unroll
        for (unsigned j = 0; j < 16; ++j) { const unsigned c = xb_ld(&bar[XB_XCNT(j)]); sum += c; cnt += (c > 0u) ? 1u : 0u; mine = (j == x) ? c : mine; }
        if (sum == G) break;
        __builtin_amdgcn_s_sleep(1);
        if ((++sp & 255u) == 0u) { if (xb_ld(&bar[XB_TMO])) break; if (sp > XB_SPIN_CAP) { atomicAdd(&bar[XB_TMO], 1u); break; } }
    }
    nloc = mine > 0u ? mine : 1u; nx = cnt > 0u ? cnt : 1u;
}

__device__ __forceinline__ void xcd_barrier(const XcdBarrier& b) {
    asm volatile("s_waitcnt vmcnt(0)" ::: "memory");
    __syncthreads();
    if (threadIdx.x == 0) {
        unsigned* bar = b.bar;
        __builtin_amdgcn_s_waitcnt(0);
        unsigned nloc = b.st[0], nx = b.st[1];
        if (nloc == 0u) { xcd_barrier_complete(bar, b.x, nloc, nx); b.st[0] = nloc; b.st[1] = nx; }
        const unsigned old = xb_add(&bar[XB_XSUB(b.x)], 1u);
        const unsigned gen = old / nloc;
        if (old + 1u == (gen + 1u) * nloc) {
            __builtin_amdgcn_fence(__ATOMIC_RELEASE, "agent");
            asm volatile("s_waitcnt vmcnt(0)" ::: "memory");
            const unsigned og = xb_add(&bar[XB_TOP], 1u);
            const unsigned tg = og / nx;
            if (og + 1u == (tg + 1u) * nx) xb_add(&bar[XB_TOPGEN], 1u);
            else XB_SPIN(xb_ld(&bar[XB_TOPGEN]) == tg, bar);
            __builtin_amdgcn_fence(__ATOMIC_ACQUIRE, "agent");
            xb_add(&bar[XB_XGEN(b.x)], 1u);
            asm volatile("s_waitcnt vmcnt(0)" ::: "memory");
        } else {
            XB_SPIN(xb_ld(&bar[XB_XGEN(b.x)]) == gen, bar);
            __builtin_amdgcn_fence(__ATOMIC_ACQUIRE, "agent");
            asm volatile("s_waitcnt vmcnt(0)" ::: "memory");
        }
    }
    __syncthreads();
}

struct Args { const float* in[42]; float* out; unsigned char* ws; unsigned char* wts; int ph_lo, ph_hi; };
struct Frame {
    LAS unsigned char* lds; float* out; unsigned char* ws; unsigned char* W;
    int tid, lane, wave, bid, G;
};
constexpr int PTAB_OFF = LDS_PHASE_BYTES + 1024;
__device__ __forceinline__ const float* ldptr(const Frame& F, int i) { const unsigned long long v = ((const LAS unsigned long long*)(F.lds + PTAB_OFF))[i];
    const unsigned lo = __builtin_amdgcn_readfirstlane((unsigned)v), hi = __builtin_amdgcn_readfirstlane((unsigned)(v >> 32)); return (const float*)(((unsigned long long)hi << 32) | lo); }
#define INP(i) ldptr(F, (i))
__device__ __forceinline__ Frame fresh(const Frame& F0) { Frame F = F0; int t = threadIdx.x; asm volatile("" : "+v"(t)); F.tid = t; F.lane = t & 63; F.wave = __builtin_amdgcn_readfirstlane(t >> 6);
    asm volatile("" : "+s"(F.bid), "+s"(F.G), "+s"(F.ws), "+s"(F.W), "+s"(F.out)); return F; }
enum { IN_X = 0, IN_C, IN_CTX, IN_CCTX, IN_ADAW, IN_ADAB, IN_NMIX, IN_NFFN, IN_NOUT, IN_ML_WIN, IN_ML_WGATE, IN_ML_BGATE, IN_ML_CONV, IN_ML_HEADG, IN_ML_WOUT,
       IN_RW_MU, IN_RW_WRKV, IN_RW_W0, IN_RW_W1, IN_RW_W2, IN_RW_A0, IN_RW_A1, IN_RW_A2, IN_RW_G1, IN_RW_G2, IN_RW_KK, IN_RW_KA, IN_RW_RK, IN_RW_LNW, IN_RW_LNB, IN_RW_WOUT,
       IN_HG_WIN, IN_HG_WF, IN_HG_BF, IN_HG_LB, IN_HG_HEADG, IN_HG_WOUT, IN_ROUTER_W, IN_ROUTER_B, IN_EX_W1, IN_EX_W3, IN_EX_W2 };

template <int MAP> __device__ __forceinline__ int rowmap(int n) { return MAP == 0 ? n : (MAP == 1 ? 8 * (n >> 2) + (n & 3) : 8 * (n >> 2) + 4 + (n & 3)); }
template <int MAP> __device__ __forceinline__ void tr_item(const float* W, int ldw, int nblk, bf16* WT, int ldd, int row_off, int k_off, const float* kscale, LAS float* scr, int item, int lane) {
    const int kb = item / nblk, nb = item - kb * nblk, k0 = 64 * kb, n0 = 32 * nb;
#pragma unroll 8
    for (int i = 0; i < 32; ++i) { const int kk = 2 * i + (lane >> 5); float v = W[(size_t)(k0 + kk) * ldw + n0 + (lane & 31)]; if (kscale) v *= kscale[k0 + kk]; scr[kk * 33 + (lane & 31)] = v; }
    LDS_WAIT(); asm volatile("" ::: "memory");
    const int c = lane & 7;
#pragma unroll
    for (int j = 0; j < 4; ++j) { const int n = (lane >> 3) + 8 * j; const LAS float* s = scr + (8 * c) * 33 + n;
        u32x4 o; o.x = pk2(s[0 * 33], s[1 * 33]); o.y = pk2(s[2 * 33], s[3 * 33]); o.z = pk2(s[4 * 33], s[5 * 33]); o.w = pk2(s[6 * 33], s[7 * 33]);
        *(u32x4*)(WT + (size_t)(row_off + rowmap<MAP>(n0 + n)) * ldd + k_off + k0 + 8 * c) = o; }
    LDS_WAIT(); asm volatile("" ::: "memory");
}
#define TRJOB(MAP, cnt, ...) if (r < (cnt)) { tr_item<MAP>(__VA_ARGS__, scr, r, F.lane); continue; } r -= (cnt);

PHASE_FN void pre_phase(Frame F) {
    LAS float* scr = (LAS float*)(F.lds + F.wave * 16384);
    const int gw = F.bid * NWAVES + F.wave, NGW = F.G * NWAVES;
    const size_t gt = (size_t)F.bid * NTHR + F.tid, NGT = (size_t)F.G * NTHR;
    bf16* W = (bf16*)F.W;
    constexpr int NITEMS = 2 * 2048 + 2 * 512 + 6 * 512 + 4 * 32 + 4 * 32 + 2 * 64 + 64 + 512 + 1536 + 2 * 512 + 512;
    for (int it = gw; it < NITEMS; it += NGW) {
        int r = it;
        TRJOB(0, 2048, INP(IN_ML_WIN), 4096, 128, (bf16*)(F.W + W_ML_WIN), 1024, 0, 0, nullptr)
        TRJOB(0, 2048, INP(IN_ML_WIN) + (size_t)1024 * 4096, 4096, 128, (bf16*)(F.W + W_ML_WIN + W_ML_WIN_SZ), 1024, 0, 0, nullptr)
        TRJOB(0, 512, INP(IN_ML_WOUT), 1024, 32, (bf16*)(F.W + W_ML_WOUT), 1024, 0, 0, nullptr)
        TRJOB(0, 512, INP(IN_ML_WOUT) + (size_t)1024 * 1024, 1024, 32, (bf16*)(F.W + W_ML_WOUT + 2 * MiB), 1024, 0, 0, nullptr)
        bf16* RWIN = (bf16*)(F.W + W_RW_IN); const float* mu = INP(IN_RW_MU);
        if (r < 6 * 512) { const int idx = r / 1024, ps = (r / 512) & 1, rr = r & 511;
            tr_item<0>(INP(IN_RW_WRKV) + (size_t)idx * 1024 * 1024, 1024, 32, RWIN, 2048, idx * 1024, ps * 1024, ps ? mu + idx * 1024 : nullptr, scr, rr, F.lane); continue; } r -= 6 * 512;
        if (r < 4 * 32) { const int dir = r / 64, ps = (r / 32) & 1, rr = r & 31;
            tr_item<0>(INP(IN_RW_W1) + (size_t)dir * 1024 * 64, 64, 2, RWIN, 2048, 3072 + dir * 64, ps * 1024, ps ? mu + 3 * 1024 : nullptr, scr, rr, F.lane); continue; } r -= 4 * 32;
        if (r < 4 * 32) { const int dir = r / 64, ps = (r / 32) & 1, rr = r & 31;
            tr_item<0>(INP(IN_RW_A1) + (size_t)dir * 1024 * 64, 64, 2, RWIN, 2048, 3200 + dir * 64, ps * 1024, ps ? mu + 4 * 1024 : nullptr, scr, rr, F.lane); continue; } r -= 4 * 32;
        if (r < 2 * 64) { const int ps = r / 64, rr = r & 63;
            tr_item<0>(INP(IN_RW_G1), 128, 4, RWIN, 2048, 3328, ps * 1024, ps ? mu + 5 * 1024 : nullptr, scr, rr, F.lane); continue; } r -= 2 * 64;
        TRJOB(0, 64, INP(IN_RW_G2), 1024, 32, (bf16*)(F.W + W_RW_G2), 256, 0, 0, nullptr)
        TRJOB(0, 512, INP(IN_RW_WOUT), 1024, 32, (bf16*)(F.W + W_RW_WOUT), 1024, 0, 0, nullptr)
        TRJOB(0, 1536, INP(IN_HG_WIN), 3072, 96, (bf16*)(F.W + W_HG_IN), 1024, 0, 0, nullptr)
        TRJOB(0, 512, INP(IN_HG_WF), 1024, 32, (bf16*)(F.W + W_HG_IN), 1024, 3072, 0, nullptr)
        TRJOB(0, 512, INP(IN_HG_WF) + (size_t)1024 * 1024, 1024, 32, (bf16*)(F.W + W_HG_IN), 1024, 4096, 0, nullptr)
        TRJOB(0, 512, INP(IN_HG_WOUT), 1024, 32, (bf16*)(F.W + W_HG_WOUT), 1024, 0, 0, nullptr)
    }
    for (size_t i = gt; i < (size_t)2 * 256 * 1024; i += NGT) { const int j = (int)(i >> 18), rr = (int)((i >> 10) & 255), k = (int)(i & 1023);
        float v = 0.f; if (rr < 32) { const int dir = rr >> 4, g = rr & 15; v = INP(IN_ML_WGATE)[((size_t)(j * 2 + dir) * 1024 + k) * 16 + g]; }
        ((bf16*)(F.W + W_ML_WIN + j * W_ML_WIN_SZ))[(size_t)(4096 + rr) * 1024 + k] = (bf16)f2bf(v); }
    for (size_t i = gt; i < (size_t)128 * 2048; i += NGT) ((bf16*)(F.W + W_RW_IN))[(size_t)3456 * 2048 + i] = 0;
    for (size_t i = gt; i < (size_t)1024 * 128; i += NGT) ((bf16*)(F.W + W_RW_G2))[(i >> 7) * 256 + 128 + (i & 127)] = 0;
    if (F.bid == 0) for (int c = F.tid; c < 1024; c += NTHR) { const float* lg = INP(IN_HG_LB) + c; const float l0 = lg[0], l1 = lg[1024], l2 = lg[2048], l3 = lg[3072];
        const float mx = fmaxf(fmaxf(l0, l1), fmaxf(l2, l3)); const float e0 = __expf(l0 - mx), e1 = __expf(l1 - mx), e2 = __expf(l2 - mx), e3 = __expf(l3 - mx);
        ((float*)(F.ws + WS_LB))[c] = (e1 + e2) / (e0 + e1 + e2 + e3); }
    { f32x4* S4 = (f32x4*)(F.ws + WS_S);
      for (size_t i = gt; i < (size_t)NTOK * 256; i += NGT) { const int m = (int)(i >> 8), c4 = (int)(i & 255); const int b = m / T, t = m - b * T;
          const float* src = (t < CTX) ? INP(IN_CTX) + ((size_t)(b * CTX + t)) * 1024 : INP(IN_X) + ((size_t)(b * SEQ + t - CTX)) * 1024;
          S4[i] = ((const f32x4*)src)[c4]; } }
    { LAS float* sc = (LAS float*)(F.lds + 8448); float* MODP = (float*)(F.ws + WS_MIX);
      for (int it = F.bid; it < 768; it += F.G) { const int i = it / 192, rem = it - i * 192, kc = rem / 12, jb = rem - kc * 12;
          __syncthreads();
          if (F.tid < 320) { const int seg = F.tid >> 6, kk = F.tid & 63; const float cv = seg == 0 ? INP(IN_CCTX)[kc * 64 + kk] : INP(IN_C)[(seg - 1) * 1024 + kc * 64 + kk]; sc[F.tid] = silu_f(cv); }
          __syncthreads();
          const int j = jb * 512 + F.tid; const float* wp = INP(IN_ADAW) + ((size_t)i * 1024 + kc * 64) * 6144 + j;
          float a0 = 0.f, a1 = 0.f, a2 = 0.f, a3 = 0.f, a4 = 0.f;
#pragma unroll 8
          for (int kk = 0; kk < 64; ++kk) { const float w = wp[(size_t)kk * 6144]; a0 += sc[kk] * w; a1 += sc[64 + kk] * w; a2 += sc[128 + kk] * w; a3 += sc[192 + kk] * w; a4 += sc[256 + kk] * w; }
          float* mp = MODP + ((size_t)kc * 4 + i) * 5 * 6144 + j;
          mp[0] = a0; mp[6144] = a1; mp[2 * 6144] = a2; mp[3 * 6144] = a3; mp[4 * 6144] = a4; } }
}
PHASE_FN void modsum_phase(Frame F) {
    const float* MODP = (const float*)(F.ws + WS_MIX); float* MOD = (float*)(F.ws + WS_MOD);
    for (int idx = F.bid * NTHR + F.tid; idx < 4 * 5 * 6144; idx += F.G * NTHR) { const int i = idx / (5 * 6144), j = idx % 6144;
        float a = INP(IN_ADAB)[i * 6144 + j];
#pragma unroll
        for (int kc = 0; kc < 16; ++kc) a += MODP[(size_t)kc * 4 * 5 * 6144 + idx];
        MOD[idx] = a; }
}
PHASE_FN void expert_weights(Frame F, int L) {
    LAS float* scr = (LAS float*)(F.lds + F.wave * 16384);
    const int gw = F.bid * NWAVES + F.wave, NGW = F.G * NWAVES;
    bf16* W13 = (bf16*)(F.W + W_EX13); bf16* W2 = (bf16*)(F.W + W_EX2);
    const float* w1 = INP(IN_EX_W1) + (size_t)L * 16 * 1024 * 512; const float* w3 = INP(IN_EX_W3) + (size_t)L * 16 * 1024 * 512; const float* w2 = INP(IN_EX_W2) + (size_t)L * 16 * 512 * 1024;
    for (int it = gw; it < 3 * 4096; it += NGW) { const int which = it >> 12, e = (it >> 8) & 15, rr = it & 255;
        if (which == 0) tr_item<1>(w1 + (size_t)e * 1024 * 512, 512, 16, W13, 1024, e * 1024, 0, nullptr, scr, rr, F.lane);
        else if (which == 1) tr_item<2>(w3 + (size_t)e * 1024 * 512, 512, 16, W13, 1024, e * 1024, 0, nullptr, scr, rr, F.lane);
        else tr_item<0>(w2 + (size_t)e * 512 * 1024, 1024, 32, W2, 512, e * 1024, 0, nullptr, scr, rr, F.lane); }
}

template <int MODE> PHASE_FN void norm_phase(Frame F, int L, bool add_moe, int ldh) {
    float* S = (float*)(F.ws + WS_S); bf16* H = (bf16*)(F.ws + WS_HY); const bf16* YM = (const bf16*)(F.ws + WS_MIX + 210 * MiB);
    const float* MOD = (const float*)(F.ws + WS_MOD);
    const int gw = F.bid * NWAVES + F.wave, NGW = F.G * NWAVES, lane = F.lane;
    LAS float* rwl = (LAS float*)F.lds;
    LAS int* cntl = (LAS int*)(F.lds + 65536);
    if (MODE == 1) {
        for (int i = F.tid; i < 16384; i += NTHR) { const int c = i >> 4, e = i & 15; rwl[e * 1024 + c] = INP(IN_ROUTER_W)[i]; }
        if (F.tid < 16) cntl[F.tid] = 0;
        __syncthreads();
    }
    const float* gnp = MODE == 0 ? INP(IN_NMIX) + L * 1024 : (MODE == 1 ? INP(IN_NFFN) + L * 1024 : INP(IN_NOUT));
    for (int m = gw; m < NTOK; m += NGW) {
        const int b = m / T, t = m - b * T, seg = t < CTX ? 0 : 1 + b;
        if (MODE == 2 && t < CTX) continue;
        f32x4 v[4]; f32x4* sp = (f32x4*)(S + (size_t)m * 1024) + lane;
#pragma unroll
        for (int j = 0; j < 4; ++j) v[j] = sp[64 * j];
        if (add_moe) {
            const float* gp = MOD + ((size_t)((MODE == 2 ? 3 : L - 1) * 5 + seg)) * 6144 + 5 * 1024;
            const u32x2* ya = (const u32x2*)(YM + (size_t)(2 * m) * 1024) + lane; const u32x2* yb = ya + 256;
#pragma unroll
            for (int j = 0; j < 4; ++j) { const u32x2 a = ya[64 * j], bq = yb[64 * j]; const f32x4 g = ((const f32x4*)gp)[lane + 64 * j];
                v[j][0] += g[0] * (bflo(a.x) + bflo(bq.x)); v[j][1] += g[1] * (bfhi(a.x) + bfhi(bq.x)); v[j][2] += g[2] * (bflo(a.y) + bflo(bq.y)); v[j][3] += g[3] * (bfhi(a.y) + bfhi(bq.y)); }
            if (MODE != 2) {
#pragma unroll
                for (int j = 0; j < 4; ++j) sp[64 * j] = v[j]; }
        }
        float ss = 0.f;
#pragma unroll
        for (int j = 0; j < 4; ++j) ss += (v[j][0] * v[j][0] + v[j][1] * v[j][1]) + (v[j][2] * v[j][2] + v[j][3] * v[j][3]);
        const float rinv = 1.0f / sqrtf(wave_sum(ss) * (1.0f / 1024.0f) + 1e-6f);
        if (MODE == 2) { f32x4* op = (f32x4*)(F.out + ((size_t)(b * SEQ + t - CTX)) * 1024) + lane;
#pragma unroll
            for (int j = 0; j < 4; ++j) { const f32x4 g = ((const f32x4*)gnp)[lane + 64 * j]; op[64 * j] = v[j] * rinv * g; }
            continue; }
        const float* mp = MOD + ((size_t)(L * 5 + seg)) * 6144 + (MODE == 0 ? 0 : 3 * 1024);
        f32x4 h[4];
#pragma unroll
        for (int j = 0; j < 4; ++j) { const f32x4 g = ((const f32x4*)gnp)[lane + 64 * j], sh = ((const f32x4*)mp)[lane + 64 * j], sc = ((const f32x4*)(mp + 1024))[lane + 64 * j];
            h[j] = v[j] * rinv * g * (sc + 1.0f) + sh;
            u32x2 o; o.x = pk2(h[j][0], h[j][1]); o.y = pk2(h[j][2], h[j][3]); *((u32x2*)(H + (size_t)m * ldh) + lane + 64 * j) = o; }
        if (MODE == 1) {
            float lg[16];
#pragma unroll
            for (int e = 0; e < 16; ++e) { float a = 0.f;
#pragma unroll
                for (int j = 0; j < 4; ++j) { const f32x4 w = *(const LAS f32x4*)(rwl + e * 1024 + 256 * j + 4 * lane); a += (h[j][0] * w[0] + h[j][1] * w[1]) + (h[j][2] * w[2] + h[j][3] * w[3]); }
                lg[e] = wave_sum(a); }
            float aff[16], sel[16];
#pragma unroll
            for (int e = 0; e < 16; ++e) { aff[e] = sigmoid_f(lg[e]); sel[e] = aff[e] + INP(IN_ROUTER_B)[e]; }
            float best = -3.0e38f; int bg = 0; float s0 = 0.f, s1 = 0.f, s2 = 0.f, s3 = 0.f, a0 = 0.f, a1 = 0.f, a2 = 0.f, a3 = 0.f;
#pragma unroll
            for (int g = 0; g < 4; ++g) { const float x0 = sel[4 * g], x1 = sel[4 * g + 1], x2 = sel[4 * g + 2], x3 = sel[4 * g + 3];
                const float t1 = fmaxf(x0, x1), t2 = fminf(x0, x1), u1 = fmaxf(x2, x3), u2 = fminf(x2, x3);
                const float sum = fmaxf(t1, u1) + fmaxf(fminf(t1, u1), fmaxf(t2, u2));
                const bool bt = sum > best; best = bt ? sum : best; bg = bt ? g : bg;
                s0 = bt ? x0 : s0; s1 = bt ? x1 : s1; s2 = bt ? x2 : s2; s3 = bt ? x3 : s3;
                a0 = bt ? aff[4 * g] : a0; a1 = bt ? aff[4 * g + 1] : a1; a2 = bt ? aff[4 * g + 2] : a2; a3 = bt ? aff[4 * g + 3] : a3; }
            int i1 = 0; float m1 = s0; if (s1 > m1) { m1 = s1; i1 = 1; } if (s2 > m1) { m1 = s2; i1 = 2; } if (s3 > m1) { m1 = s3; i1 = 3; }
            int i2 = -1; float m2 = -3.0e38f;
            if (i1 != 0 && s0 > m2) { m2 = s0; i2 = 0; } if (i1 != 1 && s1 > m2) { m2 = s1; i2 = 1; } if (i1 != 2 && s2 > m2) { m2 = s2; i2 = 2; } if (i1 != 3 && s3 > m2) { m2 = s3; i2 = 3; }
            const float c1 = i1 == 0 ? a0 : (i1 == 1 ? a1 : (i1 == 2 ? a2 : a3)), c2 = i2 == 0 ? a0 : (i2 == 1 ? a1 : (i2 == 2 ? a2 : a3));
            const float inv = 1.0f / (c1 + c2);
            if (lane == 0) { const int e1 = bg * 4 + i1, e2 = bg * 4 + i2;
                int4 tk; tk.x = e1; tk.y = e2; tk.z = __float_as_int(c1 * inv); tk.w = __float_as_int(c2 * inv); ((int4*)(F.ws + WS_TOK))[m] = tk;
                __hip_atomic_fetch_add(cntl + e1, 1, __ATOMIC_RELAXED, __HIP_MEMORY_SCOPE_WORKGROUP); __hip_atomic_fetch_add(cntl + e2, 1, __ATOMIC_RELAXED, __HIP_MEMORY_SCOPE_WORKGROUP); }
        }
    }
    if (MODE == 1) { __syncthreads(); if (F.tid < 16) atomicAdd((unsigned*)F.ws + CW_MOE + L * 2048 + 64 * F.tid, (unsigned)cntl[F.tid]); }
}

__device__ __forceinline__ void moe_prefix(const Frame& F, int L, LAS int* pref  , LAS int* cnt  ) {
    if (F.tid < 16) cnt[F.tid] = (int)__hip_atomic_load((unsigned*)F.ws + CW_MOE + L * 2048 + 64 * F.tid, __ATOMIC_RELAXED, __HIP_MEMORY_SCOPE_AGENT);
    __syncthreads();
    if (F.tid == 0) { int p = 0; for (int e = 0; e < 16; ++e) { pref[e] = p; p += (cnt[e] + 255) >> 8; } pref[16] = p; }
    __syncthreads();
}
PHASE_FN void slots_phase(Frame F, int L) {
    LAS int* pref = (LAS int*)F.lds; LAS int* cnt = pref + 32;
    moe_prefix(F, L, pref, cnt);
    const int gw = F.bid * NWAVES + F.wave, NGW = F.G * NWAVES, lane = F.lane;
    unsigned* cursor = (unsigned*)F.ws + CW_MOE + L * 2048 + 1024;
    int* slot_tok = (int*)(F.ws + WS_SLOT_TOK); float* slot_gate = (float*)(F.ws + WS_SLOT_GATE);
    const bf16* H = (const bf16*)(F.ws + WS_HY); bf16* XG = (bf16*)(F.ws + WS_MIX);
    for (int it = gw; it < NTOK / 64; it += NGW) {
        const int m = it * 64 + lane; const int4 tk = ((const int4*)(F.ws + WS_TOK))[m];
        int myslot[2];
#pragma unroll
        for (int k = 0; k < 2; ++k) { const int e = k ? tk.y : tk.x; int slot = 0;
            for (int ee = 0; ee < 16; ++ee) { const unsigned long long mask = __ballot(e == ee);
                if (mask) { const int n = __popcll(mask); unsigned base = 0; if (lane == 0) base = atomicAdd(cursor + 64 * ee, (unsigned)n); base = __builtin_amdgcn_readfirstlane(base);
                    if (e == ee) slot = pref[ee] * 256 + (int)base + __popcll(mask & ((1ull << lane) - 1ull)); } }
            myslot[k] = slot; slot_tok[slot] = 2 * m + k; slot_gate[slot] = __int_as_float(k ? tk.w : tk.z); }
#pragma unroll
        for (int k = 0; k < 2; ++k)
            for (int l = 0; l < 64; ++l) { const int sl = __shfl(myslot[k], l); const u32x4* src = (const u32x4*)(H + (size_t)(it * 64 + l) * 1024); u32x4* dst = (u32x4*)(XG + (size_t)sl * 1024);
                dst[lane] = src[lane]; dst[64 + lane] = src[64 + lane]; }
    }
    for (int e = 0; e < 16; ++e) { const int lo = pref[e] * 256 + cnt[e], hi = pref[e + 1] * 256;
        for (int s = lo + gw; s < hi; s += NGW) { u32x4* dst = (u32x4*)(XG + (size_t)s * 1024); dst[lane] = (u32x4){0u, 0u, 0u, 0u}; dst[64 + lane] = (u32x4){0u, 0u, 0u, 0u};
            if (lane == 0) { slot_tok[s] = -1; slot_gate[s] = 0.f; } } }
}

PHASE_FN void du_phase(Frame F) {
    bf16* H2 = (bf16*)(F.ws + WS_HY);
    const size_t gt = (size_t)F.bid * NTHR + F.tid, NGT = (size_t)F.G * NTHR;
    for (size_t i = gt; i < (size_t)NTOK * 128; i += NGT) { const int m = (int)(i >> 7), c8 = (int)(i & 127); const int t = m % T;
        const bool hp = !(t == 0 || t == CTX), hn = !(t == CTX - 1 || t == T - 1);
        const u32x4 z = {0u, 0u, 0u, 0u};
        const u32x4 u = *(const u32x4*)(H2 + (size_t)m * 2048 + c8 * 8), p = hp ? *(const u32x4*)(H2 + (size_t)(m - 1) * 2048 + c8 * 8) : z, n = hn ? *(const u32x4*)(H2 + (size_t)(m + 1) * 2048 + c8 * 8) : z;
        u32x4 o;
#pragma unroll
        for (int j = 0; j < 4; ++j) o[j] = pk2(0.5f * (bflo(p[j]) + bflo(n[j])) - bflo(u[j]), 0.5f * (bfhi(p[j]) + bfhi(n[j])) - bfhi(u[j]));
        *(u32x4*)(H2 + (size_t)m * 2048 + 1024 + c8 * 8) = o; }
}

PHASE_FN void conv_phase(Frame F, int j) {
    const bf16* QP = (const bf16*)(F.ws + WS_MIX); bf16* QK = (bf16*)(F.ws + WS_HY); const float* cw = INP(IN_ML_CONV) + (size_t)j * 9 * 2048;
    const size_t gt = (size_t)F.bid * NTHR + F.tid, NGT = (size_t)F.G * NTHR;
    for (size_t i = gt; i < (size_t)NTOK * 256; i += NGT) { const int m = (int)(i >> 8), c = (int)(i & 255) * 8; const int t = m % T;
        float acc[8];
#pragma unroll
        for (int q = 0; q < 8; ++q) acc[q] = 0.f;
        const int p = t - CTX, gr = p >> 6, gc = p & 63;
#pragma unroll
        for (int dr = 0; dr < 3; ++dr)
#pragma unroll
            for (int dw = 0; dw < 3; ++dw) {
                bool ok; int mm;
                if (t < CTX) { ok = (dr == 1) && (t + dw - 1 >= 0) && (t + dw - 1 < CTX); mm = m + dw - 1; }
                else { ok = (gr + dr - 1 >= 0) && (gr + dr - 1 < 128) && (gc + dw - 1 >= 0) && (gc + dw - 1 < 64); mm = m + (dr - 1) * 64 + (dw - 1); }
                if (ok) { const u32x4 x = *(const u32x4*)(QP + (size_t)mm * 2048 + c); const f32x4 w0 = *(const f32x4*)(cw + (dr * 3 + dw) * 2048 + c), w1 = *(const f32x4*)(cw + (dr * 3 + dw) * 2048 + c + 4);
                    acc[0] += bflo(x[0]) * w0[0]; acc[1] += bfhi(x[0]) * w0[1]; acc[2] += bflo(x[1]) * w0[2]; acc[3] += bfhi(x[1]) * w0[3];
                    acc[4] += bflo(x[2]) * w1[0]; acc[5] += bfhi(x[2]) * w1[1]; acc[6] += bflo(x[3]) * w1[2]; acc[7] += bfhi(x[3]) * w1[3]; } }
        const float sc = c >= 1024 ? 0.08838834764831845f : 1.0f;
        u32x4 o;
#pragma unroll
        for (int q = 0; q < 4; ++q) o[q] = pk2(silu_f(acc[2 * q]) * sc, silu_f(acc[2 * q + 1]) * sc);
        *(u32x4*)(QK + (size_t)m * 2048 + c) = o; }
}

PHASE_FN void headnorm_phase(Frame F, const bf16* HSf, const bf16* HSb, const bf16* OG, const float* hg, bf16* Y) {
    const int gw = F.bid * NWAVES + F.wave, NGW = F.G * NWAVES, lane = F.lane;
    for (int m = gw; m < NTOK; m += NGW) { const size_t off = (size_t)m * 1024 + lane * 16;
        float x[16]; float ss = 0.f;
#pragma unroll
        for (int hlf = 0; hlf < 2; ++hlf) { const u32x4 a = *(const u32x4*)(HSf + off + 8 * hlf), bq = *(const u32x4*)(HSb + off + 8 * hlf);
#pragma unroll
            for (int q = 0; q < 4; ++q) { x[8 * hlf + 2 * q] = bflo(a[q]) + bflo(bq[q]); x[8 * hlf + 2 * q + 1] = bfhi(a[q]) + bfhi(bq[q]); } }
#pragma unroll
        for (int q = 0; q < 16; ++q) ss += x[q] * x[q];
        ss += __shfl_xor(ss, 1); ss += __shfl_xor(ss, 2); ss += __shfl_xor(ss, 4);
        const float rinv = 1.0f / sqrtf(ss * (1.0f / 128.0f) + 1e-6f);
#pragma unroll
        for (int hlf = 0; hlf < 2; ++hlf) { const u32x4 g = *(const u32x4*)(OG + off + 8 * hlf); const f32x4 h0 = *(const f32x4*)(hg + lane * 16 + 8 * hlf), h1 = *(const f32x4*)(hg + lane * 16 + 8 * hlf + 4);
            u32x4 o;
            o[0] = pk2(x[8 * hlf + 0] * rinv * h0[0] * bflo(g[0]), x[8 * hlf + 1] * rinv * h0[1] * bfhi(g[0])); o[1] = pk2(x[8 * hlf + 2] * rinv * h0[2] * bflo(g[1]), x[8 * hlf + 3] * rinv * h0[3] * bfhi(g[1]));
            o[2] = pk2(x[8 * hlf + 4] * rinv * h1[0] * bflo(g[2]), x[8 * hlf + 5] * rinv * h1[1] * bfhi(g[2])); o[3] = pk2(x[8 * hlf + 6] * rinv * h1[2] * bflo(g[3]), x[8 * hlf + 7] * rinv * h1[3] * bfhi(g[3]));
            *(u32x4*)(Y + off + 8 * hlf) = o; } }
}
PHASE_FN void rwpost_phase(Frame F, const bf16* Of, const bf16* Ob, const float* BETA, const bf16* V, const bf16* Gt, bf16* Y) {
    const int gw = F.bid * NWAVES + F.wave, NGW = F.G * NWAVES, lane = F.lane;
    const float* lnw = INP(IN_RW_LNW); const float* lnb = INP(IN_RW_LNB);
    for (int m = gw; m < NTOK; m += NGW) { const size_t off = (size_t)m * 1024 + lane * 16;
        float x[16]; float s = 0.f;
#pragma unroll
        for (int hlf = 0; hlf < 2; ++hlf) { const u32x4 a = *(const u32x4*)(Of + off + 8 * hlf), bq = *(const u32x4*)(Ob + off + 8 * hlf);
#pragma unroll
            for (int q = 0; q < 4; ++q) { x[8 * hlf + 2 * q] = bflo(a[q]) + bflo(bq[q]); x[8 * hlf + 2 * q + 1] = bfhi(a[q]) + bfhi(bq[q]); } }
#pragma unroll
        for (int q = 0; q < 16; ++q) s += x[q];
        s += __shfl_xor(s, 1); s += __shfl_xor(s, 2);
        const float mean = s * (1.0f / 64.0f); float vs = 0.f;
#pragma unroll
        for (int q = 0; q < 16; ++q) { x[q] -= mean; vs += x[q] * x[q]; }
        vs += __shfl_xor(vs, 1); vs += __shfl_xor(vs, 2);
        const float rinv = 1.0f / sqrtf(vs * (1.0f / 64.0f) + 64e-5f);
        const int hd = lane >> 2; const float beta = BETA[(size_t)m * 16 + hd] + BETA[((size_t)NTOK + m) * 16 + hd];
#pragma unroll
        for (int hlf = 0; hlf < 2; ++hlf) { const u32x4 vv = *(const u32x4*)(V + off + 8 * hlf), gg = *(const u32x4*)(Gt + off + 8 * hlf);
            const f32x4 w0 = *(const f32x4*)(lnw + lane * 16 + 8 * hlf), w1 = *(const f32x4*)(lnw + lane * 16 + 8 * hlf + 4), b0 = *(const f32x4*)(lnb + lane * 16 + 8 * hlf), b1 = *(const f32x4*)(lnb + lane * 16 + 8 * hlf + 4);
            float y[8];
#pragma unroll
            for (int q = 0; q < 4; ++q) { y[q] = x[8 * hlf + q] * rinv * w0[q] + b0[q]; y[4 + q] = x[8 * hlf + 4 + q] * rinv * w1[q] + b1[q]; }
            u32x4 o;
#pragma unroll
            for (int q = 0; q < 4; ++q) o[q] = pk2((y[2 * q] + beta * bflo(vv[q])) * bflo(gg[q]), (y[2 * q + 1] + beta * bfhi(vv[q])) * bfhi(gg[q]));
            *(u32x4*)(Y + off + 8 * hlf) = o; } }
}

PHASE_FN void ml_scan_phase(Frame F, const bf16* QK, const bf16* V, const float* GATES, bf16* HS) {
    LAS bf16* QS = (LAS bf16*)(F.lds + 0); LAS bf16* KS = (LAS bf16*)(F.lds + 17408); LAS bf16* VT = (LAS bf16*)(F.lds + 34816); LAS bf16* KT = (LAS bf16*)(F.lds + 39424);
    LAS bf16* SS = (LAS bf16*)(F.lds + 57856); LAS bf16* CS = (LAS bf16*)(F.lds + 67072);
    LAS float* su = (LAS float*)(F.lds + 75776); LAS float* scc = su + 64; LAS float* swi = scc + 64; LAS float* semt = swi + 64; LAS float* swk = semt + 64;
    LAS float* sdenp = swk + 64;   LAS float* snq = sdenp + 256; LAS float* sn = snq + 64;   LAS float* sscal = sn + 128;
    const int tid = F.tid, lane = F.lane, w = F.wave, r = lane & 15, q = lane >> 4;
    const int lrow = tid >> 3, lp = tid & 7;
    for (int unit = F.bid; unit < 256; unit += F.G) {
        const int vs = unit & 3, dir = (unit >> 2) & 1, h = (unit >> 3) & 7, b = unit >> 6;
        f32x4 Cst[2]; Cst[0] = (f32x4){0.f, 0.f, 0.f, 0.f}; Cst[1] = Cst[0];
        __syncthreads();
        for (int i = tid; i < 32 * 136; i += NTHR) CS[i] = 0;
        if (tid < 128) sn[tid] = 0.f;
        float m_run = 0.f;
        u32x4 rq[2], rk[2], rv = {0u, 0u, 0u, 0u}; float rig = 0.f, rlf = 0.f;
#define ML_LOAD(c) do { const int row_ = seq_row(b, dir, (c) * 64 + lrow); const bf16* qp_ = QK + (size_t)row_ * 2048 + h * 128; \
            rq[0] = *(const u32x4*)(qp_ + 8 * lp); rq[1] = *(const u32x4*)(qp_ + 8 * (lp + 8)); rk[0] = *(const u32x4*)(qp_ + 1024 + 8 * lp); rk[1] = *(const u32x4*)(qp_ + 1024 + 8 * (lp + 8)); \
            if (tid < 256) { const int vrow_ = seq_row(b, dir, (c) * 64 + (tid >> 2)); rv = *(const u32x4*)(V + (size_t)vrow_ * 1024 + h * 128 + vs * 32 + 8 * (tid & 3)); } \
            if (w == 0) { const int grow_ = seq_row(b, dir, (c) * 64 + lane); rig = GATES[(size_t)grow_ * 32 + dir * 16 + h]; rlf = GATES[(size_t)grow_ * 32 + dir * 16 + 8 + h]; } } while (0)
        ML_LOAD(0);
        __syncthreads();
        for (int c = 0; c < T / 64; ++c) {
            if (w == 0) {
                const float lf = logsigmoid_f(rlf), ig = rig;
                float bc = lf;
#pragma unroll
                for (int o = 1; o < 64; o <<= 1) { const float t_ = __shfl_up(bc, o); if (lane >= o) bc += t_; }
                const float u = ig - bc;
                float pm = u;
#pragma unroll
                for (int o = 1; o < 64; o <<= 1) { const float t_ = __shfl_up(pm, o); if (lane >= o) pm = fmaxf(pm, t_); }
                const float cc = fmaxf(m_run, pm);
                const float blast = __shfl(bc, 63), pmall = __shfl(pm, 63);
                const float m_new = blast + fmaxf(m_run, pmall);
                su[lane] = u; scc[lane] = cc; swi[lane] = __expf(m_run - cc); semt[lane] = __expf(-(bc + cc)); swk[lane] = __expf(blast + u - m_new);
                if (lane == 0) sscal[0] = __expf(blast + m_run - m_new);
                m_run = m_new;
            }
            __syncthreads();
            {
                *(LAS u32x4*)(QS + lrow * 136 + 8 * lp) = rq[0]; *(LAS u32x4*)(QS + lrow * 136 + 8 * (lp + 8)) = rq[1];
                *(LAS u32x4*)(KS + lrow * 136 + 8 * lp) = rk[0]; *(LAS u32x4*)(KS + lrow * 136 + 8 * (lp + 8)) = rk[1];
                const float wk = swk[lrow];
#pragma unroll
                for (int pc = 0; pc < 2; ++pc)
#pragma unroll
                    for (int jj = 0; jj < 4; ++jj) { const int d = 8 * (lp + 8 * pc) + 2 * jj; const unsigned x = rk[pc][jj];
                        KT[d * 72 + lrow] = (bf16)f2bf(bflo(x) * wk); KT[(d + 1) * 72 + lrow] = (bf16)f2bf(bfhi(x) * wk); }
                if (tid < 256) { const int s_ = tid >> 2;
#pragma unroll
                    for (int jj = 0; jj < 4; ++jj) { const int vv = 8 * (tid & 3) + 2 * jj; VT[vv * 72 + s_] = (bf16)(rv[jj] & 0xffffu); VT[(vv + 1) * 72 + s_] = (bf16)(rv[jj] >> 16); } }
                if (c + 1 < T / 64) ML_LOAD(c + 1);
            }
            __syncthreads();
            {
                const int ti = w >> 1;
#pragma unroll
                for (int jj = 0; jj < 2; ++jj) { const int sj = (w & 1) * 2 + jj; f32x4 acc = {0.f, 0.f, 0.f, 0.f};
                    if (sj <= ti) acc = mm16<128>(acc, QS + 16 * ti * 136, 136, KS + 16 * sj * 136, 136, lane);
                    const int s_ = 16 * sj + r; const float us = su[s_];
#pragma unroll
                    for (int i = 0; i < 4; ++i) { const int t_ = 16 * ti + 4 * q + i; const float val = (s_ <= t_) ? acc[i] * __expf(us - scc[t_]) : 0.f;
                        const float rs = row16_sum(val); if (r == 0) sdenp[sj * 64 + t_] = rs;
                        SS[t_ * 72 + s_] = (bf16)f2bf(val); } }
                const int t2 = tid >> 3, part = tid & 7; float a = 0.f;
#pragma unroll
                for (int d = 0; d < 16; ++d) a += sn[part * 16 + d] * bf2f(QS[t2 * 136 + part * 16 + d]);
                a += __shfl_xor(a, 1); a += __shfl_xor(a, 2); a += __shfl_xor(a, 4);
                if (part == 0) snq[t2] = a;
            }
            __syncthreads();
            float wprev;
            {
                const int ti = w >> 1, vj = w & 1; f32x4 a1 = {0.f, 0.f, 0.f, 0.f}, a2 = a1;
                a1 = mm16<64>(a1, SS + 16 * ti * 72, 72, VT + 16 * vj * 72, 72, lane);
                a2 = mm16<128>(a2, QS + 16 * ti * 136, 136, CS + 16 * vj * 136, 136, lane);
#pragma unroll
                for (int i = 0; i < 4; ++i) { const int t_ = 16 * ti + 4 * q + i; const float wi = swi[t_];
                    const float num = a1[i] + wi * a2[i], den = ((sdenp[t_] + sdenp[64 + t_]) + (sdenp[128 + t_] + sdenp[192 + t_])) + wi * snq[t_];
                    const float hv = num / fmaxf(fabsf(den), semt[t_]);
                    const int row = seq_row(b, dir, c * 64 + t_);
                    HS[((size_t)dir * NTOK + row) * 1024 + h * 128 + vs * 32 + 16 * vj + r] = (bf16)f2bf(hv); }
                wprev = sscal[0];
            }
            __syncthreads();
            {
                const int vi = w & 1;
#pragma unroll
                for (int jj = 0; jj < 2; ++jj) { const int dj = (w >> 1) * 2 + jj; Cst[jj] = Cst[jj] * wprev;
                    Cst[jj] = mm16<64>(Cst[jj], VT + 16 * vi * 72, 72, KT + 16 * dj * 72, 72, lane);
#pragma unroll
                    for (int i = 0; i < 4; ++i) CS[(16 * vi + 4 * q + i) * 136 + 16 * dj + r] = (bf16)f2bf(Cst[jj][i]); }
                if (tid < 128) { float a = 0.f;
#pragma unroll 8
                    for (int s_ = 0; s_ < 64; ++s_) a += bf2f(KT[tid * 72 + s_]);
                    sn[tid] = wprev * sn[tid] + a; }
            }
        }
#undef ML_LOAD
    }
}

PHASE_FN void hg_scan_phase(Frame F, const bf16* Q, const bf16* V, const bf16* LF, bf16* HSf, bf16* HSb) {
    LAS bf16* QT = (LAS bf16*)(F.lds + 0); LAS bf16* KTs = (LAS bf16*)(F.lds + 8704); LAS bf16* KH = (LAS bf16*)(F.lds + 17408); LAS bf16* VT = (LAS bf16*)(F.lds + 27648);
    LAS bf16* AS = (LAS bf16*)(F.lds + 30208); LAS bf16* STs = (LAS bf16*)(F.lds + 32768); LAS float* BF = (LAS float*)(F.lds + 41472); LAS float* SBL = (LAS float*)(F.lds + 57856); LAS bf16* QI = (LAS bf16*)(F.lds + 58368);
    const int tid = F.tid, lane = F.lane, w = F.wave, r = lane & 15, q = lane >> 4;
    const int lrow = tid >> 4, lp = tid & 15;
    for (int unit = F.bid; unit < 256; unit += F.G) {
        const int vs = unit & 3, dir = (unit >> 2) & 1, h = (unit >> 3) & 7, b = unit >> 6;
        bf16* HS = dir ? HSb : HSf; const bf16* LFd = LF + (size_t)dir * NTOK * 1024;
        f32x4 Sst[2]; Sst[0] = (f32x4){0.f, 0.f, 0.f, 0.f}; Sst[1] = Sst[0];
        __syncthreads();
        for (int i = tid; i < 32 * 136; i += NTHR) STs[i] = 0;
        u32x4 rq, rl, rv = {0u, 0u, 0u, 0u};
#define HG_LOAD(c) do { const int row_ = seq_row(b, dir, (c) * 32 + lrow); rq = *(const u32x4*)(Q + (size_t)row_ * 1024 + h * 128 + 8 * lp); rl = *(const u32x4*)(LFd + (size_t)row_ * 1024 + h * 128 + 8 * lp); \
            if (tid < 128) { const int vrow_ = seq_row(b, dir, (c) * 32 + (tid >> 2)); rv = *(const u32x4*)(V + (size_t)vrow_ * 1024 + h * 128 + vs * 32 + 8 * (tid & 3)); } } while (0)
        HG_LOAD(0);
        for (int c = 0; c < T / 32; ++c) {
#pragma unroll
            for (int jj = 0; jj < 4; ++jj) { BF[lrow * 128 + 8 * lp + 2 * jj] = bflo(rl[jj]); BF[lrow * 128 + 8 * lp + 2 * jj + 1] = bfhi(rl[jj]); }
            __syncthreads();
            if (tid < 128) { float a = 0.f;
#pragma unroll 8
                for (int t_ = 0; t_ < 32; ++t_) { a += BF[t_ * 128 + tid]; BF[t_ * 128 + tid] = a; }
                SBL[tid] = __expf(a); }
            __syncthreads();
            {
#pragma unroll
                for (int jj = 0; jj < 4; ++jj)
#pragma unroll
                    for (int hh = 0; hh < 2; ++hh) { const int k_ = 8 * lp + 2 * jj + hh; const float bt = BF[lrow * 128 + k_], bl = BF[31 * 128 + k_], br = BF[15 * 128 + k_];
                        const float lf = hh ? bfhi(rl[jj]) : bflo(rl[jj]), qv = hh ? bfhi(rq[jj]) : bflo(rq[jj]); const float key = -expm1f(lf);
                        QT[lrow * 136 + k_] = (bf16)f2bf(qv * __expf(bt - br)); QI[lrow * 136 + k_] = (bf16)f2bf(qv * __expf(bt)); KTs[lrow * 136 + k_] = (bf16)f2bf(key * __expf(br - bt)); KH[k_ * 40 + lrow] = (bf16)f2bf(key * __expf(bl - bt)); }
                if (tid < 128) { const int s_ = tid >> 2;
#pragma unroll
                    for (int jj = 0; jj < 4; ++jj) { const int vv = 8 * (tid & 3) + 2 * jj; VT[vv * 40 + s_] = (bf16)(rv[jj] & 0xffffu); VT[(vv + 1) * 40 + s_] = (bf16)(rv[jj] >> 16); } }
                if (c + 1 < T / 32) HG_LOAD(c + 1);
            }
            __syncthreads();
            if (w < 4) { const int ti = w >> 1, sj = w & 1; f32x4 acc = {0.f, 0.f, 0.f, 0.f};
                if (sj <= ti) acc = mm16<128>(acc, QT + 16 * ti * 136, 136, KTs + 16 * sj * 136, 136, lane);
#pragma unroll
                for (int i = 0; i < 4; ++i) { const int t_ = 16 * ti + 4 * q + i, s_ = 16 * sj + r; AS[t_ * 40 + s_] = (bf16)f2bf(s_ <= t_ ? acc[i] : 0.f); } }
            __syncthreads();
            if (w < 4) { const int ti = w >> 1, vj = w & 1; f32x4 a1 = {0.f, 0.f, 0.f, 0.f}, a2 = a1;
                a1 = mm16<32>(a1, AS + 16 * ti * 40, 40, VT + 16 * vj * 40, 40, lane);
                a2 = mm16<128>(a2, QI + 16 * ti * 136, 136, STs + 16 * vj * 136, 136, lane);
#pragma unroll
                for (int i = 0; i < 4; ++i) { const int t_ = 16 * ti + 4 * q + i; const int row = seq_row(b, dir, c * 32 + t_);
                    HS[(size_t)row * 1024 + h * 128 + vs * 32 + 16 * vj + r] = (bf16)f2bf(a1[i] + a2[i]); } }
            __syncthreads();
            { const int vi = w & 1;
#pragma unroll
              for (int jj = 0; jj < 2; ++jj) { const int kj = (w >> 1) * 2 + jj; Sst[jj] = Sst[jj] * SBL[16 * kj + r];
                  Sst[jj] = mm16<32>(Sst[jj], VT + 16 * vi * 40, 40, KH + 16 * kj * 40, 40, lane);
#pragma unroll
                  for (int i = 0; i < 4; ++i) STs[(16 * vi + 4 * q + i) * 136 + 16 * kj + r] = (bf16)f2bf(Sst[jj][i]); } }
        }
#undef HG_LOAD
    }
}

PHASE_FN void rw_scan_phase(Frame F, const bf16* Rr, const bf16* Kk, const bf16* Vv, const float* WH, const float* AH, bf16* O  , float* BETA  ) {
    LAS float* W2S = (LAS float*)(F.lds + 0); LAS float* A2S = (LAS float*)(F.lds + 16384);
    LAS float* SW = (LAS float*)(F.lds + 32768); LAS float* SKK = (LAS float*)(F.lds + 40960); LAS float* SAK = (LAS float*)(F.lds + 49152); LAS float* SKD = (LAS float*)(F.lds + 57344); LAS float* SR = (LAS float*)(F.lds + 65536);
    LAS float* SV = (LAS float*)(F.lds + 73728); LAS float* SWH = (LAS float*)(F.lds + 77824); LAS float* SAH = (LAS float*)(F.lds + 86016); LAS float* SO = (LAS float*)(F.lds + 94208);
    LAS float* SVEC = (LAS float*)(F.lds + 98304);
    const int tid = F.tid, t16 = tid >> 4, cg = tid & 15, kc = cg * 4;
    for (int unit = F.bid; unit < 256; unit += F.G) {
        const int half = unit & 1, dir = (unit >> 1) & 1, h = (unit >> 2) & 15, b = unit >> 6;
        __syncthreads();
        for (int i = tid; i < 4096; i += NTHR) { const int l = i >> 6, jn = i & 63; W2S[i] = INP(IN_RW_W2)[((size_t)(dir * 64 + l)) * 1024 + h * 64 + jn]; A2S[i] = INP(IN_RW_A2)[((size_t)(dir * 64 + l)) * 1024 + h * 64 + jn]; }
        if (tid < 64) { SVEC[tid] = INP(IN_RW_W0)[dir * 1024 + h * 64 + tid]; SVEC[64 + tid] = INP(IN_RW_A0)[dir * 1024 + h * 64 + tid]; SVEC[128 + tid] = INP(IN_RW_KK)[h * 64 + tid];
            SVEC[192 + tid] = INP(IN_RW_KA)[h * 64 + tid]; SVEC[256 + tid] = INP(IN_RW_RK)[h * 64 + tid]; }
        float S0 = 0.f, S1 = 0.f, S2 = 0.f, S3 = 0.f;
        u32x2 rr, rk; unsigned rv; f32x4 rwh, rah;
#define RW_LOAD(c) do { const size_t row_ = (size_t)seq_row(b, dir, (c) * 32 + t16); rr = *(const u32x2*)(Rr + row_ * 1024 + h * 64 + kc); rk = *(const u32x2*)(Kk + row_ * 1024 + h * 64 + kc); \
            rv = *(const unsigned*)(Vv + row_ * 1024 + h * 64 + half * 32 + 2 * cg); rwh = *(const f32x4*)(WH + row_ * 128 + dir * 64 + kc); rah = *(const f32x4*)(AH + row_ * 128 + dir * 64 + kc); } while (0)
        RW_LOAD(0);
        for (int c = 0; c < T / 32; ++c) {
            *(LAS f32x4*)(SWH + t16 * 64 + kc) = rwh; *(LAS f32x4*)(SAH + t16 * 64 + kc) = rah;
            __syncthreads();
            {
                f32x4 wp = *(const LAS f32x4*)(SVEC + kc), ap = *(const LAS f32x4*)(SVEC + 64 + kc);
#pragma unroll 8
                for (int l = 0; l < 64; ++l) { const float x = SWH[t16 * 64 + l], y = SAH[t16 * 64 + l]; const f32x4 w2 = *(const LAS f32x4*)(W2S + l * 64 + kc), a2 = *(const LAS f32x4*)(A2S + l * 64 + kc); wp += w2 * x; ap += a2 * y; }
                const f32x4 kkw = *(const LAS f32x4*)(SVEC + 128 + kc), kaw = *(const LAS f32x4*)(SVEC + 192 + kc), rkw = *(const LAS f32x4*)(SVEC + 256 + kc);
                f32x4 kv, rv4, dec, av, kx; kv[0] = bflo(rk.x); kv[1] = bfhi(rk.x); kv[2] = bflo(rk.y); kv[3] = bfhi(rk.y); rv4[0] = bflo(rr.x); rv4[1] = bfhi(rr.x); rv4[2] = bflo(rr.y); rv4[3] = bfhi(rr.y);
                float ssq = 0.f, bet = 0.f;
#pragma unroll
                for (int jn = 0; jn < 4; ++jn) { dec[jn] = __expf(-0.6065306597126334f * sigmoid_f(wp[jn])); av[jn] = sigmoid_f(ap[jn]); kx[jn] = kv[jn] * kkw[jn]; ssq += kx[jn] * kx[jn]; }
                ssq = row16_sum(ssq); const float rn = 1.0f / sqrtf(fmaxf(ssq, 1e-24f));
                f32x4 nkk, akk, kd;
#pragma unroll
                for (int jn = 0; jn < 4; ++jn) { const float kkn = kx[jn] * rn; nkk[jn] = -kkn; akk[jn] = kkn * av[jn]; kd[jn] = kv[jn] * (1.0f + (av[jn] - 1.0f) * kaw[jn]); bet += rv4[jn] * kd[jn] * rkw[jn]; }
                bet = row16_sum(bet);
                *(LAS f32x4*)(SW + t16 * 64 + kc) = dec; *(LAS f32x4*)(SKK + t16 * 64 + kc) = nkk; *(LAS f32x4*)(SAK + t16 * 64 + kc) = akk; *(LAS f32x4*)(SKD + t16 * 64 + kc) = kd; *(LAS f32x4*)(SR + t16 * 64 + kc) = rv4;
                SV[t16 * 32 + 2 * cg] = bflo(rv); SV[t16 * 32 + 2 * cg + 1] = bfhi(rv);
                if (cg == 0 && half == 0) BETA[((size_t)dir * NTOK + seq_row(b, dir, c * 32 + t16)) * 16 + h] = bet;
                if (c + 1 < T / 32) RW_LOAD(c + 1);
            }
            __syncthreads();
#pragma unroll 4
            for (int t_ = 0; t_ < 32; ++t_) {
                const f32x4 w4 = *(const LAS f32x4*)(SW + t_ * 64 + kc), nk = *(const LAS f32x4*)(SKK + t_ * 64 + kc), ak = *(const LAS f32x4*)(SAK + t_ * 64 + kc), kd = *(const LAS f32x4*)(SKD + t_ * 64 + kc), r4 = *(const LAS f32x4*)(SR + t_ * 64 + kc);
                const float vv = SV[t_ * 32 + t16];
                float sa = (S0 * nk[0] + S1 * nk[1]) + (S2 * nk[2] + S3 * nk[3]);
                sa = row16_sum(sa);
                S0 = S0 * w4[0] + (sa * ak[0] + vv * kd[0]); S1 = S1 * w4[1] + (sa * ak[1] + vv * kd[1]); S2 = S2 * w4[2] + (sa * ak[2] + vv * kd[2]); S3 = S3 * w4[3] + (sa * ak[3] + vv * kd[3]);
                float o = (S0 * r4[0] + S1 * r4[1]) + (S2 * r4[2] + S3 * r4[3]);
                o = row16_sum(o);
                if (cg == 0) SO[t_ * 32 + t16] = o;
            }
            __syncthreads();
            { const size_t row_ = (size_t)seq_row(b, dir, c * 32 + t16);
              *(unsigned*)(O + ((size_t)dir * NTOK + row_) * 1024 + h * 64 + half * 32 + 2 * cg) = pk2(SO[t16 * 32 + 2 * cg], SO[t16 * 32 + 2 * cg + 1]); }
        }
#undef RW_LOAD
    }
}

PHASE_FN void gemm_mlin(Frame F, int jl) { unsigned char* MIX = F.ws + WS_MIX; unsigned char* HY = F.ws + WS_HY;
    pg8::Gemm g{(const bf16*)HY, (const bf16*)(F.W + W_ML_WIN + jl * W_ML_WIN_SZ), NTOK, 4352, 1024}; pg8::StaticOrder So; So.init(NTOK, 4352, F.G, F.bid);
    pg8::EpiMlstmIn E{(bf16*)MIX, (bf16*)(MIX + 2 * ROWB), (bf16*)(MIX + 3 * ROWB), (float*)(MIX + 4 * ROWB), INP(IN_ML_BGATE) + jl * 32};
    pg8::gemm_phase<pg8::EpiMlstmIn, pg8::StaticOrder, GEMM_ALIGN, GEMM_SP2>(F.lds, g, So, E); }
PHASE_FN void gemm_resid(Frame F, const bf16* A, const bf16* Bt, int L) {
    pg8::Gemm g{A, Bt, NTOK, 1024, 1024}; pg8::StaticOrder So; So.init(NTOK, 1024, F.G, F.bid);
    pg8::EpiResid E{(float*)(F.ws + WS_S), (const float*)(F.ws + WS_MOD) + (size_t)L * 5 * 6144, 2}; pg8::gemm_phase<pg8::EpiResid, pg8::StaticOrder, GEMM_ALIGN, GEMM_SP2>(F.lds, g, So, E); }
PHASE_FN void gemm_rwin(Frame F) { unsigned char* MIX = F.ws + WS_MIX; unsigned char* HY = F.ws + WS_HY;
    bf16* Rb = (bf16*)MIX; bf16* Kb = (bf16*)(MIX + ROWB); bf16* Vb = (bf16*)(MIX + 2 * ROWB); float* WH = (float*)(MIX + 3 * ROWB); float* AH = WH + (size_t)NTOK * 128; bf16* GH = (bf16*)(AH + (size_t)NTOK * 128);
    pg8::Gemm g{(const bf16*)HY, (const bf16*)(F.W + W_RW_IN), NTOK, 3584, 2048}; pg8::StaticOrder So; So.init(NTOK, 3584, F.G, F.bid);
    pg8::EpiRwkvIn E{Rb, Kb, Vb, WH, AH, GH}; pg8::gemm_phase<pg8::EpiRwkvIn, pg8::StaticOrder, GEMM_ALIGN, GEMM_SP2>(F.lds, g, So, E); }
PHASE_FN void gemm_rwg(Frame F) { unsigned char* MIX = F.ws + WS_MIX;
    float* WH = (float*)(MIX + 3 * ROWB); float* AH = WH + (size_t)NTOK * 128; bf16* GH = (bf16*)(AH + (size_t)NTOK * 128);
    pg8::Gemm g{GH, (const bf16*)(F.W + W_RW_G2), NTOK, 1024, 256}; pg8::StaticOrder So; So.init(NTOK, 1024, F.G, F.bid);
    pg8::EpiBf16Plain E{(bf16*)MIX, 1024}; pg8::gemm_phase<pg8::EpiBf16Plain, pg8::StaticOrder, GEMM_ALIGN, GEMM_SP2>(F.lds, g, So, E); }
PHASE_FN void gemm_hgin(Frame F) { unsigned char* MIX = F.ws + WS_MIX; unsigned char* HY = F.ws + WS_HY;
    pg8::Gemm g{(const bf16*)HY, (const bf16*)(F.W + W_HG_IN), NTOK, 5120, 1024}; pg8::StaticOrder So; So.init(NTOK, 5120, F.G, F.bid);
    pg8::EpiHgrnIn E{(bf16*)MIX, (bf16*)(MIX + ROWB), (bf16*)(MIX + 2 * ROWB), (bf16*)(MIX + 3 * ROWB), (size_t)NTOK * 1024, INP(IN_HG_BF), (const float*)(F.ws + WS_LB)};
    pg8::gemm_phase<pg8::EpiHgrnIn, pg8::StaticOrder, GEMM_ALIGN, GEMM_SP2>(F.lds, g, So, E); }
PHASE_FN void gemm_moe1(Frame F, int L) { unsigned char* MIX = F.ws + WS_MIX; LAS int* pref = (LAS int*)(F.lds + LDS_PHASE_BYTES); moe_prefix(F, L, pref, pref + 32);
    pg8::Gemm g{(const bf16*)MIX, (const bf16*)(F.W + W_EX13), NSLOT, 16384, 1024}; pg8::MoeOrder So{pref, F.G, F.bid};
    pg8::EpiMoe1 E{(bf16*)(MIX + 140 * MiB)}; pg8::gemm_phase<pg8::EpiMoe1, pg8::MoeOrder, GEMM_ALIGN, GEMM_SP2>(F.lds, g, So, E); }
PHASE_FN void gemm_moe2(Frame F, int L) { unsigned char* MIX = F.ws + WS_MIX; LAS int* pref = (LAS int*)(F.lds + LDS_PHASE_BYTES); moe_prefix(F, L, pref, pref + 32);
    pg8::Gemm g{(const bf16*)(MIX + 140 * MiB), (const bf16*)(F.W + W_EX2), NSLOT, 16384, 512}; pg8::MoeOrder So{pref, F.G, F.bid};
    pg8::EpiMoe2 E{(bf16*)(MIX + 210 * MiB), (const int*)(F.ws + WS_SLOT_TOK), (const float*)(F.ws + WS_SLOT_GATE)};
    pg8::gemm_phase<pg8::EpiMoe2, pg8::MoeOrder, GEMM_ALIGN, GEMM_SP2>(F.lds, g, So, E); }

constexpr int PH_PER_LAYER = 12, PH_LAYER0 = 2, PH_FINAL = PH_LAYER0 + DEPTH * PH_PER_LAYER, N_PHASES = PH_FINAL + 1;
__global__ void __launch_bounds__(NTHR, 2) fwd_kernel(Args args) {
    extern __shared__ __attribute__((aligned(16))) unsigned char lds_raw[];
    Frame F;
    F.lds = (LAS unsigned char*)lds_raw; F.out = args.out; F.ws = args.ws; F.W = args.wts;
    F.tid = threadIdx.x; F.lane = F.tid & 63; F.wave = __builtin_amdgcn_readfirstlane(F.tid >> 6); F.bid = blockIdx.x; F.G = gridDim.x;
    volatile LAS unsigned* MISC = (volatile LAS unsigned*)(F.lds + MISC_OFF);
    if (F.tid < 32) MISC[F.tid] = 0u;
    if (F.tid < 42) ((LAS unsigned long long*)(F.lds + PTAB_OFF))[F.tid] = (unsigned long long)args.in[F.tid];
    __syncthreads();
    const int lo = args.ph_lo, hi = args.ph_hi;
    XcdBarrier bar; bar.bar = (unsigned*)args.ws + CW_BAR; bar.x = 0; bar.st = MISC + 8;
    if (hi - lo > 1) bar = xcd_barrier_post((unsigned*)args.ws + CW_BAR, MISC + 8);
#define IN(k) (lo <= (k) && (k) < hi)
#define SEAM(k) do { if ((k) + 1 < hi) xcd_barrier(bar); } while (0)

    if (IN(0)) { pre_phase(fresh(F)); SEAM(0); }
    if (IN(1)) { modsum_phase(fresh(F)); SEAM(1); }

    for (int L = 0; L < DEPTH; ++L) {
        const int kind = L % 3, jl = L / 3, pb = PH_LAYER0 + L * PH_PER_LAYER;
        if (IN(pb + 0)) { expert_weights(fresh(F), L); norm_phase<0>(fresh(F), L, L > 0, kind == 1 ? 2048 : 1024); SEAM(pb + 0); }
        if (kind == 0) {
            if (IN(pb + 2)) { gemm_mlin(fresh(F), jl); SEAM(pb + 2); }
            if (IN(pb + 3)) { conv_phase(fresh(F), jl); SEAM(pb + 3); }
            if (IN(pb + 4)) { const Frame Fp = fresh(F); unsigned char* MIX = Fp.ws + WS_MIX; ml_scan_phase(Fp, (const bf16*)(Fp.ws + WS_HY), (const bf16*)(MIX + 2 * ROWB), (const float*)(MIX + 4 * ROWB), (bf16*)MIX); SEAM(pb + 4); }
            if (IN(pb + 6)) { const Frame Fp = fresh(F); unsigned char* MIX = Fp.ws + WS_MIX;
                headnorm_phase(Fp, (const bf16*)MIX, (const bf16*)(MIX + ROWB), (const bf16*)(MIX + 3 * ROWB), ldptr(Fp, IN_ML_HEADG) + jl * 1024, (bf16*)(Fp.ws + WS_HY + ROWB)); SEAM(pb + 6); }
            if (IN(pb + 7)) { const Frame Fp = fresh(F); gemm_resid(Fp, (const bf16*)(Fp.ws + WS_HY + ROWB), (const bf16*)(Fp.W + W_ML_WOUT + jl * 2 * MiB), L); SEAM(pb + 7); }
        } else if (kind == 1) {
            if (IN(pb + 1)) { du_phase(fresh(F)); SEAM(pb + 1); }
            if (IN(pb + 2)) { gemm_rwin(fresh(F)); SEAM(pb + 2); }
            if (IN(pb + 4)) { const Frame Fp = fresh(F); unsigned char* MIX = Fp.ws + WS_MIX; float* WH = (float*)(MIX + 3 * ROWB); float* AH = WH + (size_t)NTOK * 128; float* BETA = (float*)((bf16*)(AH + (size_t)NTOK * 128) + (size_t)NTOK * 256);
                rw_scan_phase(Fp, (const bf16*)MIX, (const bf16*)(MIX + ROWB), (const bf16*)(MIX + 2 * ROWB), WH, AH, (bf16*)(Fp.ws + WS_HY), BETA); SEAM(pb + 4); }
            if (IN(pb + 5)) { gemm_rwg(fresh(F)); SEAM(pb + 5); }
            if (IN(pb + 6)) { const Frame Fp = fresh(F); unsigned char* MIX = Fp.ws + WS_MIX; float* WH = (float*)(MIX + 3 * ROWB); float* AH = WH + (size_t)NTOK * 128; float* BETA = (float*)((bf16*)(AH + (size_t)NTOK * 128) + (size_t)NTOK * 256);
                rwpost_phase(Fp, (const bf16*)(Fp.ws + WS_HY), (const bf16*)(Fp.ws + WS_HY + ROWB), BETA, (const bf16*)(MIX + 2 * ROWB), (const bf16*)MIX, (bf16*)(MIX + ROWB)); SEAM(pb + 6); }
            if (IN(pb + 7)) { const Frame Fp = fresh(F); gemm_resid(Fp, (const bf16*)(Fp.ws + WS_MIX + ROWB), (const bf16*)(Fp.W + W_RW_WOUT), L); SEAM(pb + 7); }
        } else {
            if (IN(pb + 2)) { gemm_hgin(fresh(F)); SEAM(pb + 2); }
            if (IN(pb + 4)) { const Frame Fp = fresh(F); unsigned char* MIX = Fp.ws + WS_MIX; hg_scan_phase(Fp, (const bf16*)MIX, (const bf16*)(MIX + ROWB), (const bf16*)(MIX + 3 * ROWB), (bf16*)(Fp.ws + WS_HY + ROWB), (bf16*)(Fp.ws + WS_HY)); SEAM(pb + 4); }
            if (IN(pb + 6)) { const Frame Fp = fresh(F); unsigned char* MIX = Fp.ws + WS_MIX;
                headnorm_phase(Fp, (const bf16*)(Fp.ws + WS_HY + ROWB), (const bf16*)(Fp.ws + WS_HY), (const bf16*)(MIX + 2 * ROWB), ldptr(Fp, IN_HG_HEADG), (bf16*)(Fp.ws + WS_HY + ROWB)); SEAM(pb + 6); }
            if (IN(pb + 7)) { const Frame Fp = fresh(F); gemm_resid(Fp, (const bf16*)(Fp.ws + WS_HY + ROWB), (const bf16*)(Fp.W + W_HG_WOUT), L); SEAM(pb + 7); }
        }
        if (IN(pb + 8)) { norm_phase<1>(fresh(F), L, false, 1024); SEAM(pb + 8); }
        if (IN(pb + 9)) { slots_phase(fresh(F), L); SEAM(pb + 9); }
        if (IN(pb + 10)) { gemm_moe1(fresh(F), L); SEAM(pb + 10); }
        if (IN(pb + 11)) { gemm_moe2(fresh(F), L); SEAM(pb + 11); }
    }
    if (IN(PH_FINAL)) norm_phase<2>(fresh(F), 0, true, 1024);
#undef IN
#undef SEAM
}

#ifndef MK_PER_PHASE
#define MK_PER_PHASE 0
#endif
extern "C" void kernel_launch(void* const* d_in, const int* in_sizes, int n_in, void* d_out, int out_size, void* d_ws, size_t ws_size, hipStream_t stream) {
    static int grid = 0;
    if (grid == 0) {
        if (n_in != 42 || out_size != NB * SEQ * D || ws_size < WS_END) { fprintf(stderr, "kernel_launch: unexpected problem (n_in %d, out %d, ws %zu)\n", n_in, out_size, ws_size); grid = -1; return; }
        int dev = 0, cus = 0, per_cu = 0;
        if (hipGetDevice(&dev) != hipSuccess || hipDeviceGetAttribute(&cus, hipDeviceAttributeMultiprocessorCount, dev) != hipSuccess) { grid = -1; return; }
        if (hipFuncSetAttribute((const void*)fwd_kernel, hipFuncAttributeMaxDynamicSharedMemorySize, LDS_BYTES) != hipSuccess) { fprintf(stderr, "kernel_launch: hipFuncSetAttribute failed\n"); grid = -1; return; }
        if (hipOccupancyMaxActiveBlocksPerMultiprocessor(&per_cu, (const void*)fwd_kernel, NTHR, LDS_BYTES) != hipSuccess || per_cu < 1) { fprintf(stderr, "kernel_launch: occupancy query reports %d\n", per_cu); (void)hipGetLastError(); grid = -1; return; }
        grid = cus;
    }
    if (grid < 0) return;
    (void)hipMemsetAsync(d_ws, 0, CTL_ZERO_BYTES, stream);
    Args a{};
    for (int i = 0; i < 42; ++i) a.in[i] = (const float*)d_in[i];
    a.out = (float*)d_out; a.ws = (unsigned char*)d_ws;
    a.wts = (ws_size >= WS_END + W_BYTES) ? (unsigned char*)d_ws + WS_END : (unsigned char*)d_out;
#if MK_PER_PHASE
    for (int p = 0; p < N_PHASES; ++p) { a.ph_lo = p; a.ph_hi = p + 1; hipLaunchKernelGGL(fwd_kernel, dim3(grid), dim3(NTHR), LDS_BYTES, stream, a); }
#else
    a.ph_lo = 0; a.ph_hi = N_PHASES;
    hipLaunchKernelGGL(fwd_kernel, dim3(grid), dim3(NTHR), LDS_BYTES, stream, a);
#endif
}
```

```cpp
#include <hip/hip_runtime.h>
#include <cstdio>
#include <cstdint>

__device__ __forceinline__ float sigmoid_f(float x) { return 1.0f / (1.0f + __expf(-x)); }
__device__ __forceinline__ float silu_f(float x) { return x / (1.0f + __expf(-x)); }
__device__ __forceinline__ float logsigmoid_f(float x) { return fminf(x, 0.f) - log1pf(__expf(-fabsf(x))); }
#define GAS __attribute__((address_space(1)))
namespace pg8 {
#define PG8_LAS __attribute__((address_space(3)))
typedef unsigned short bf16_t;
typedef short bf16x8 __attribute__((ext_vector_type(8)));
typedef float f32x4 __attribute__((ext_vector_type(4)));
typedef unsigned u32x4 __attribute__((ext_vector_type(4)));
constexpr int BM = 256, BK = 64, HALF = 128, HTB = HALF * BK * 2  , STAGE_BYTES = 8 * HTB, NXCD = 8, WGM = 8;

__host__ __device__ __forceinline__ int lds_byte(int r, int c) { const int st = (r >> 4) * 2 + (c >> 5), rr = r & 15, cc = c & 31, ob = rr * 64 + cc * 2; return st * 1024 + (ob ^ (((ob >> 9) & 1) << 5)); }
__host__ __device__ __forceinline__ void stage_rc(int b, int& R, int& C) { const int st = b / 1024, sb = b % 1024, swz = sb ^ (((sb >> 9) & 1) << 5); R = (st >> 1) * 16 + swz / 64; C = (st & 1) * 32 + (swz % 64) / 2; }
__host__ __device__ __forceinline__ int perm32(int rho) { const int n = rho >> 4, i = rho & 15; return 8 * (i >> 2) + 4 * n + (i & 3); }

struct Unit { int pm, pn; };
struct Gemm { const GAS bf16_t* A; const GAS bf16_t* Bt; int M, N, K; };

struct StaticOrder {
    int nM, nN, nwg, G, c;
    __host__ __device__ void init(int M, int N, int G_, int c_) { nM = M / BM; nN = N / BM; nwg = nM * nN; G = G_; c = c_; }
    __host__ __device__ bool next(int i, Unit& u) const {
        const long L = (long)i * G + c; if (L >= nwg) return false;
        int wgid = (int)L; { const int q = nwg / NXCD, r = nwg % NXCD, xcd = wgid % NXCD, off = wgid / NXCD; wgid = (xcd < r ? xcd * (q + 1) : r * (q + 1) + (xcd - r) * q) + off; }
        const int nig = WGM * nN, gid = wgid / nig, fm = gid * WGM, gsz = (nM - fm) < WGM ? (nM - fm) : WGM;
        u.pm = fm + ((wgid % nig) % gsz); u.pn = (wgid % nig) / gsz; return true;
    }
    __device__ __forceinline__ void a_ready(const Unit&) const {}
    __device__ __forceinline__ void done(const Unit&) const {}
};
__device__ __forceinline__ unsigned cvt_pk_bf16(float lo, float hi) { unsigned r; asm volatile("v_cvt_pk_bf16_f32 %0, %1, %2" : "=v"(r) : "v"(lo), "v"(hi)); return r; }
typedef unsigned u32x2 __attribute__((ext_vector_type(2)));
__device__ __forceinline__ void st8(GAS bf16_t* p, f32x4 v0, f32x4 v1) { u32x4 w; w.x = cvt_pk_bf16(v0[0], v0[1]); w.y = cvt_pk_bf16(v0[2], v0[3]); w.z = cvt_pk_bf16(v1[0], v1[1]); w.w = cvt_pk_bf16(v1[2], v1[3]); *(GAS u32x4*)p = w; }
template <int ACT> __device__ __forceinline__ f32x4 act4(f32x4 v) {
    if (ACT == 1) { v[0] = sigmoid_f(v[0]); v[1] = sigmoid_f(v[1]); v[2] = sigmoid_f(v[2]); v[3] = sigmoid_f(v[3]); }
    if (ACT == 2) { v[0] = silu_f(v[0]); v[1] = silu_f(v[1]); v[2] = silu_f(v[2]); v[3] = silu_f(v[3]); }
    return v; }
template <int ACT> __device__ __forceinline__ void store_tile_bf16(const f32x4 (&acc)[2][2][4][2], GAS bf16_t* base, int ld, int row0, int cw) {
#pragma unroll
    for (int ai = 0; ai < 2; ++ai)
#pragma unroll
        for (int m = 0; m < 4; ++m) { GAS bf16_t* rp = base + (size_t)(row0 + ai * HALF + m * 16) * ld + cw;
#pragma unroll
            for (int bj = 0; bj < 2; ++bj) st8(rp + bj * HALF, act4<ACT>(acc[ai][bj][m][0]), act4<ACT>(acc[ai][bj][m][1])); }
}
struct EpiBf16Plain { static constexpr bool PERM = true, AFTER_DRAIN = false; GAS bf16_t* O; int ldc;
    __device__ __forceinline__ void operator()(const f32x4 (&acc)[2][2][4][2], const Unit& u, int wr, int wc, int fr, int fq) const {
        store_tile_bf16<0>(acc, O + u.pn * BM, ldc, u.pm * BM + wr * 64 + fr, wc * 32 + 8 * fq); }
};
struct EpiMlstmIn { static constexpr bool PERM = true, AFTER_DRAIN = false;
    GAS bf16_t* QKPRE; GAS bf16_t* V; GAS bf16_t* OG; GAS float* GATES; const GAS float* bgate;
    __device__ __forceinline__ void operator()(const f32x4 (&acc)[2][2][4][2], const Unit& u, int wr, int wc, int fr, int fq) const {
        const int row0 = u.pm * BM + wr * 64 + fr, cw = wc * 32 + 8 * fq;
        if (u.pn < 8) store_tile_bf16<0>(acc, QKPRE + u.pn * BM, 2048, row0, cw);
        else if (u.pn < 12) store_tile_bf16<0>(acc, V + (u.pn - 8) * BM, 1024, row0, cw);
        else if (u.pn < 16) store_tile_bf16<1>(acc, OG + (u.pn - 12) * BM, 1024, row0, cw);
        else if (wc == 0) {
            const f32x4 b0 = *(const GAS f32x4*)(bgate + 8 * fq), b1 = *(const GAS f32x4*)(bgate + 8 * fq + 4);
#pragma unroll
            for (int ai = 0; ai < 2; ++ai)
#pragma unroll
                for (int m = 0; m < 4; ++m) { GAS float* gp = GATES + (size_t)(row0 + ai * HALF + m * 16) * 32 + 8 * fq;
                    *(GAS f32x4*)gp = acc[ai][0][m][0] + b0; *(GAS f32x4*)(gp + 4) = acc[ai][0][m][1] + b1; }
        }
    }
};
struct EpiRwkvIn { static constexpr bool PERM = true, AFTER_DRAIN = false;
    GAS bf16_t* R; GAS bf16_t* Kk; GAS bf16_t* V; GAS float* WH; GAS float* AH; GAS bf16_t* GH;
    __device__ __forceinline__ void operator()(const f32x4 (&acc)[2][2][4][2], const Unit& u, int wr, int wc, int fr, int fq) const {
        const int row0 = u.pm * BM + wr * 64 + fr, cw = wc * 32 + 8 * fq;
        if (u.pn < 4) store_tile_bf16<0>(acc, R + u.pn * BM, 1024, row0, cw);
        else if (u.pn < 8) store_tile_bf16<0>(acc, Kk + (u.pn - 4) * BM, 1024, row0, cw);
        else if (u.pn < 12) store_tile_bf16<0>(acc, V + (u.pn - 8) * BM, 1024, row0, cw);
        else if (u.pn == 12) {
#pragma unroll
            for (int ai = 0; ai < 2; ++ai)
#pragma unroll
                for (int m = 0; m < 4; ++m) { const size_t r = (size_t)(row0 + ai * HALF + m * 16);
                    f32x4 t0 = acc[ai][0][m][0], t1 = acc[ai][0][m][1];
#pragma unroll
                    for (int j = 0; j < 4; ++j) { t0[j] = tanhf(t0[j]); t1[j] = tanhf(t1[j]); }
                    st8((GAS bf16_t*)WH + r * 128 + cw, t0, t1); st8((GAS bf16_t*)AH + r * 128 + cw, acc[ai][1][m][0], acc[ai][1][m][1]); }
        } else {
#pragma unroll
            for (int ai = 0; ai < 2; ++ai)
#pragma unroll
                for (int m = 0; m < 4; ++m) { GAS bf16_t* rp = GH + (size_t)(row0 + ai * HALF + m * 16) * 256 + cw;
                    st8(rp, act4<1>(acc[ai][0][m][0]), act4<1>(acc[ai][0][m][1])); *(GAS u32x4*)(rp + HALF) = (u32x4){0u, 0u, 0u, 0u}; }
        }
    }
};
struct EpiHgrnIn { static constexpr bool PERM = true, AFTER_DRAIN = false;
    GAS bf16_t* Q; GAS bf16_t* V; GAS bf16_t* OG; GAS bf16_t* LF; size_t lf_stride; const GAS float* bf; const GAS float* lb;
    __device__ __forceinline__ void operator()(const f32x4 (&acc)[2][2][4][2], const Unit& u, int wr, int wc, int fr, int fq) const {
        const int row0 = u.pm * BM + wr * 64 + fr, cw = wc * 32 + 8 * fq;
        if (u.pn < 4) store_tile_bf16<2>(acc, Q + u.pn * BM, 1024, row0, cw);
        else if (u.pn < 8) store_tile_bf16<0>(acc, V + (u.pn - 4) * BM, 1024, row0, cw);
        else if (u.pn < 12) store_tile_bf16<2>(acc, OG + (u.pn - 8) * BM, 1024, row0, cw);
        else {
            const int dir = (u.pn - 12) >> 2, ct = ((u.pn - 12) & 3) * BM; GAS bf16_t* base = LF + (size_t)dir * lf_stride + ct;
            f32x4 bb[2][2], ll[2][2];
#pragma unroll
            for (int bj = 0; bj < 2; ++bj)
#pragma unroll
                for (int n = 0; n < 2; ++n) { bb[bj][n] = *(const GAS f32x4*)(bf + dir * 1024 + ct + bj * HALF + cw + 4 * n); ll[bj][n] = *(const GAS f32x4*)(lb + ct + bj * HALF + cw + 4 * n); }
#pragma unroll
            for (int ai = 0; ai < 2; ++ai)
#pragma unroll
                for (int m = 0; m < 4; ++m) { GAS bf16_t* rp = base + (size_t)(row0 + ai * HALF + m * 16) * 1024 + cw;
#pragma unroll
                    for (int bj = 0; bj < 2; ++bj) { f32x4 o[2];
#pragma unroll
                        for (int n = 0; n < 2; ++n)
#pragma unroll
                            for (int j = 0; j < 4; ++j) { const float l = ll[bj][n][j]; o[n][j] = __logf(l + (1.f - l) * sigmoid_f(acc[ai][bj][m][n][j] + bb[bj][n][j])); }
                        st8(rp + bj * HALF, o[0], o[1]); } }
        }
    }
};
struct EpiResid { static constexpr bool PERM = false, AFTER_DRAIN = false;
    GAS float* S; const GAS float* mod; int gate_idx;
    __device__ __forceinline__ void operator()(const f32x4 (&acc)[2][2][4][2], const Unit& u, int wr, int wc, int fr, int fq) const {
        const int b = u.pm / 33, seg = (u.pm - b * 33 == 0) ? 0 : 1 + b;
        const int row0 = u.pm * BM + wr * 64 + fr, col0 = u.pn * BM + wc * 32 + 4 * fq;
        const GAS float* gp = mod + seg * 6144 + gate_idx * 1024 + col0;
        f32x4 gv[2][2];
#pragma unroll
        for (int bj = 0; bj < 2; ++bj)
#pragma unroll
            for (int n = 0; n < 2; ++n) gv[bj][n] = *(const GAS f32x4*)(gp + bj * HALF + n * 16);
#pragma unroll
        for (int ai = 0; ai < 2; ++ai)
#pragma unroll
            for (int m = 0; m < 4; ++m) { GAS float* rowp = S + (size_t)(row0 + ai * HALF + m * 16) * 1024 + col0;
#pragma unroll
                for (int bj = 0; bj < 2; ++bj)
#pragma unroll
                    for (int n = 0; n < 2; ++n) { GAS f32x4* p = (GAS f32x4*)(rowp + bj * HALF + n * 16); *p = *p + acc[ai][bj][m][n] * gv[bj][n]; } }
    }
};
struct EpiMoe1 { static constexpr bool PERM = true, AFTER_DRAIN = false; GAS bf16_t* ACT;
    __device__ __forceinline__ void operator()(const f32x4 (&acc)[2][2][4][2], const Unit& u, int wr, int wc, int fr, int fq) const {
        const int row0 = u.pm * BM + wr * 64 + fr, pnl = u.pn & 3, c0 = pnl * 128 + wc * 16 + 4 * fq;
#pragma unroll
        for (int ai = 0; ai < 2; ++ai)
#pragma unroll
            for (int m = 0; m < 4; ++m) { GAS bf16_t* rp = ACT + (size_t)(row0 + ai * HALF + m * 16) * 512 + c0;
#pragma unroll
                for (int bj = 0; bj < 2; ++bj) { const f32x4 a = acc[ai][bj][m][0], b = acc[ai][bj][m][1];
                    u32x2 w; w.x = cvt_pk_bf16(silu_f(a[0]) * b[0], silu_f(a[1]) * b[1]); w.y = cvt_pk_bf16(silu_f(a[2]) * b[2], silu_f(a[3]) * b[3]);
                    *(GAS u32x2*)(rp + bj * 64) = w; } }
    }
};
struct EpiMoe2 { static constexpr bool PERM = true, AFTER_DRAIN = false; GAS bf16_t* YM; const GAS int* slot_tok; const GAS float* slot_gate;
    __device__ __forceinline__ void operator()(const f32x4 (&acc)[2][2][4][2], const Unit& u, int wr, int wc, int fr, int fq) const {
        const int row0 = u.pm * BM + wr * 64 + fr, col0 = (u.pn & 3) * BM + wc * 32 + 8 * fq;
#pragma unroll
        for (int ai = 0; ai < 2; ++ai)
#pragma unroll
            for (int m = 0; m < 4; ++m) { const int slot = row0 + ai * HALF + m * 16; const int dst = slot_tok[slot]; const float g = slot_gate[slot];
                if (dst >= 0) { GAS bf16_t* rp = YM + (size_t)dst * 1024 + col0;
#pragma unroll
                    for (int bj = 0; bj < 2; ++bj) st8(rp + bj * HALF, acc[ai][bj][m][0] * g, acc[ai][bj][m][1] * g); } }
    }
};
struct MoeOrder { const PG8_LAS int* pref; int G, c;
    __device__ __forceinline__ bool next(int i, Unit& u) const {
        const int L = i * G + c, nt = pref[16]; if (L >= nt * 4) return false;
        const int tile = L >> 2; int e = 0;
#pragma unroll
        for (int j = 1; j < 16; ++j) e += (tile >= pref[j]) ? 1 : 0;
        u.pm = tile; u.pn = e * 4 + (L & 3); return true; }
    __device__ __forceinline__ void a_ready(const Unit&) const {}
    __device__ __forceinline__ void done(const Unit&) const {}
};
template <class Epi, class Sched, bool ALIGN_EPI = false, bool SP2 = false>
__device__ __forceinline__ void gemm_phase(PG8_LAS unsigned char* lds, const Gemm g, const Sched& S, const Epi& E) {
    int tid_ = threadIdx.x; asm volatile("" : "+v"(tid_));
    const int tid = tid_, wid = __builtin_amdgcn_readfirstlane(tid >> 6), lane = tid & 63, wr = wid >> 2, wc = wid & 3, fr = lane & 15, fq = lane >> 4;
    const int K = g.K, nt = K / BK;
    unsigned voffA[2], voffB[2];
#pragma unroll
    for (int i = 0; i < 2; ++i) { int R, C; stage_rc(tid * 16 + i * 8192, R, C); const int Rb = Epi::PERM ? ((R & ~31) + perm32(R & 31)) : R;
        voffA[i] = (unsigned)(R * K + C) * 2u; voffB[i] = (unsigned)(Rb * K + C) * 2u; }
    const size_t kstep = (size_t)(BK * 2);
    const size_t hstep = (size_t)HALF * K * 2;
    const size_t tstep = 2 * hstep;
    const unsigned ldsw = (unsigned)wid * 1024u;
    const int aoff = lds_byte(wr * 64 + fr, fq * 8), boff = lds_byte(wc * 32 + fr, fq * 8);
#define PG8_SA(b, h) (((b) * 2 + (h)) * HTB)
#define PG8_SB(b, h) ((4 + (b) * 2 + (h)) * HTB)
#define PG8_STAGE(bufoff, gbase, voff) do { _Pragma("unroll") for (int _i = 0; _i < 2; ++_i) \
        __builtin_amdgcn_global_load_lds((const unsigned*)((const char*)(gbase) + (voff)[_i]), (PG8_LAS unsigned*)(lds + (bufoff) + ldsw + _i * 8192), 16, 0, 0); } while (0)
#define PG8_LDA(dst, b, h) do { _Pragma("unroll") for (int m = 0; m < 4; ++m) _Pragma("unroll") for (int k = 0; k < 2; ++k) dst[m][k] = *(const PG8_LAS bf16x8*)(lds + PG8_SA(b, h) + aoff + m * 2048 + k * 1024); } while (0)
#define PG8_LDB(dst, b, h) do { _Pragma("unroll") for (int n = 0; n < 2; ++n) _Pragma("unroll") for (int k = 0; k < 2; ++k) dst[n][k] = *(const PG8_LAS bf16x8*)(lds + PG8_SB(b, h) + boff + n * 2048 + k * 1024); } while (0)
#define PG8_MMA(ai, bj, At, Bt) do { __builtin_amdgcn_s_setprio(1); _Pragma("unroll") for (int m = 0; m < 4; ++m) _Pragma("unroll") for (int n = 0; n < 2; ++n) _Pragma("unroll") for (int k = 0; k < 2; ++k) \
        acc[ai][bj][m][n] = __builtin_amdgcn_mfma_f32_16x16x32_bf16(Bt[n][k], At[m][k], acc[ai][bj][m][n], 0, 0, 0); __builtin_amdgcn_s_setprio(0); } while (0)
#define PG8_WAIT_V(n) asm volatile("s_waitcnt vmcnt(" #n ")" ::: "memory")
#define PG8_WAIT_L(n) asm volatile("s_waitcnt lgkmcnt(" #n ")" ::: "memory")
#define PG8_BAR __builtin_amdgcn_s_barrier()
#define PG8_SCHED __builtin_amdgcn_sched_barrier(0)
    Unit cur, nxt; int ui = 0;
    if (!S.next(0, cur)) return;
    f32x4 acc[2][2][4][2];
#pragma unroll
    for (int a = 0; a < 2; ++a)
#pragma unroll
        for (int b = 0; b < 2; ++b)
#pragma unroll
            for (int m = 0; m < 4; ++m)
#pragma unroll
                for (int n = 0; n < 2; ++n) acc[a][b][m][n] = (f32x4){0.f, 0.f, 0.f, 0.f};
    bf16x8 At[4][2], B0[2][2], B1[2][2];
    const char* cA = (const char*)g.A + (size_t)cur.pm * tstep; const char* cB = (const char*)g.Bt + (size_t)cur.pn * tstep;
    S.a_ready(cur);
    if constexpr (SP2) {
        PG8_STAGE(PG8_SB(0, 0), cB, voffB); PG8_STAGE(PG8_SB(0, 1), cB + hstep, voffB); PG8_STAGE(PG8_SA(0, 0), cA, voffA); PG8_STAGE(PG8_SA(0, 1), cA + hstep, voffA);
        if (wr == 1) PG8_BAR;
        PG8_WAIT_V(2); PG8_BAR;
        PG8_STAGE(PG8_SB(1, 0), cB + kstep, voffB); PG8_STAGE(PG8_SA(1, 0), cA + kstep, voffA); PG8_STAGE(PG8_SB(1, 1), cB + hstep + kstep, voffB);
        PG8_WAIT_V(6); PG8_BAR;
    } else {
        PG8_STAGE(PG8_SB(0, 0), cB, voffB); PG8_STAGE(PG8_SA(0, 0), cA, voffA); PG8_STAGE(PG8_SB(0, 1), cB + hstep, voffB); PG8_STAGE(PG8_SA(0, 1), cA + hstep, voffA);
        if (wr == 1) PG8_BAR;
        PG8_WAIT_V(4); PG8_BAR;
        PG8_STAGE(PG8_SB(1, 0), cB + kstep, voffB); PG8_STAGE(PG8_SA(1, 0), cA + kstep, voffA); PG8_STAGE(PG8_SB(1, 1), cB + hstep + kstep, voffB);
        PG8_WAIT_V(6); PG8_BAR;
    }
    for (;;) {
        const bool has_next = S.next(ui + 1, nxt);
        const char* nA = has_next ? (const char*)g.A + (size_t)nxt.pm * tstep : cA; const char* nB = has_next ? (const char*)g.Bt + (size_t)nxt.pn * tstep : cB;
        for (int t = 0; t < nt; t += 2) {
            const bool last = (t == nt - 2);
            const char* a1 = cA + (size_t)(t + 1) * kstep;
            const char* a2 = last ? nA : cA + (size_t)(t + 2) * kstep; const char* b2 = last ? nB : cB + (size_t)(t + 2) * kstep;
            const char* a3 = a2 + kstep; const char* b3 = b2 + kstep;
            if (last && has_next) S.a_ready(nxt);
            if constexpr (SP2) {
            PG8_LDB(B0, 0, 0); PG8_LDB(B1, 0, 1); PG8_SCHED; PG8_LDA(At, 0, 0); PG8_STAGE(PG8_SA(1, 1), a1 + hstep, voffA);
            PG8_WAIT_V(8); PG8_WAIT_L(0); PG8_BAR; PG8_MMA(0, 0, At, B0); PG8_MMA(0, 1, At, B1); PG8_BAR; PG8_SCHED;
            PG8_LDA(At, 0, 1); PG8_STAGE(PG8_SB(0, 0), b2, voffB); PG8_STAGE(PG8_SB(0, 1), b2 + hstep, voffB); PG8_STAGE(PG8_SA(0, 0), a2, voffA);
            PG8_WAIT_V(8); PG8_WAIT_L(0); PG8_BAR; PG8_MMA(1, 0, At, B0); PG8_MMA(1, 1, At, B1); PG8_BAR; PG8_SCHED;
            PG8_LDB(B0, 1, 0); PG8_LDB(B1, 1, 1); PG8_SCHED; PG8_LDA(At, 1, 0); PG8_STAGE(PG8_SA(0, 1), a2 + hstep, voffA);
            PG8_WAIT_V(8); PG8_WAIT_L(0); PG8_BAR; PG8_MMA(0, 0, At, B0); PG8_MMA(0, 1, At, B1); PG8_BAR; PG8_SCHED;
            PG8_LDA(At, 1, 1); PG8_STAGE(PG8_SB(1, 0), b3, voffB); PG8_STAGE(PG8_SB(1, 1), b3 + hstep, voffB); PG8_STAGE(PG8_SA(1, 0), a3, voffA);
            PG8_WAIT_V(8); PG8_WAIT_L(0); PG8_BAR; PG8_MMA(1, 0, At, B0); PG8_MMA(1, 1, At, B1); PG8_BAR; PG8_SCHED;
            } else {
            PG8_LDB(B0, 0, 0); PG8_SCHED; PG8_LDA(At, 0, 0); PG8_STAGE(PG8_SA(1, 1), a1 + hstep, voffA);
            PG8_WAIT_L(8); PG8_BAR; PG8_WAIT_L(0); PG8_MMA(0, 0, At, B0); PG8_BAR; PG8_SCHED;
            PG8_LDB(B1, 0, 1); PG8_STAGE(PG8_SB(0, 0), b2, voffB);
            PG8_BAR; PG8_WAIT_L(0); PG8_MMA(0, 1, At, B1); PG8_BAR;
            PG8_LDA(At, 0, 1); PG8_STAGE(PG8_SA(0, 0), a2, voffA);
            PG8_BAR; PG8_WAIT_L(0); PG8_MMA(1, 0, At, B0); PG8_BAR; PG8_SCHED;
            PG8_STAGE(PG8_SB(0, 1), b2 + hstep, voffB);
            PG8_WAIT_V(6); PG8_BAR; PG8_MMA(1, 1, At, B1); PG8_BAR;
            PG8_LDB(B0, 1, 0); PG8_SCHED; PG8_LDA(At, 1, 0); PG8_STAGE(PG8_SA(0, 1), a2 + hstep, voffA);
            PG8_WAIT_L(8); PG8_BAR; PG8_WAIT_L(0); PG8_MMA(0, 0, At, B0); PG8_BAR; PG8_SCHED;
            PG8_LDB(B1, 1, 1); PG8_STAGE(PG8_SB(1, 0), b3, voffB);
            PG8_BAR; PG8_WAIT_L(0); PG8_MMA(0, 1, At, B1); PG8_BAR;
            PG8_LDA(At, 1, 1); PG8_STAGE(PG8_SA(1, 0), a3, voffA);
            PG8_BAR; PG8_WAIT_L(0); PG8_MMA(1, 0, At, B0); PG8_BAR; PG8_SCHED;
            PG8_STAGE(PG8_SB(1, 1), b3 + hstep, voffB);
            PG8_WAIT_V(6); PG8_BAR; PG8_MMA(1, 1, At, B1); PG8_BAR;
            }
        }
        if constexpr (ALIGN_EPI) { if (wr == 0) PG8_BAR; }
        if constexpr (!Epi::AFTER_DRAIN) { E(acc, cur, wr, wc, fr, fq); S.done(cur); }
        if (!has_next) break;
#pragma unroll
        for (int a = 0; a < 2; ++a)
#pragma unroll
            for (int b = 0; b < 2; ++b)
#pragma unroll
                for (int m = 0; m < 4; ++m)
#pragma unroll
                    for (int n = 0; n < 2; ++n) acc[a][b][m][n] = (f32x4){0.f, 0.f, 0.f, 0.f};
        cur = nxt; cA = nA; cB = nB; ++ui;
        if constexpr (ALIGN_EPI) { if (wr == 1) PG8_BAR; }
    }
    PG8_WAIT_V(0);
    if constexpr (!ALIGN_EPI) { if (wr == 0) PG8_BAR; }
    PG8_BAR;
    if constexpr (Epi::AFTER_DRAIN) { E.fused(acc, cur, wr, wc, fr, fq, lds, wid, lane); S.done(cur); }
#undef PG8_SA
#undef PG8_SB
#undef PG8_STAGE
#undef PG8_LDA
#undef PG8_LDB
#undef PG8_MMA
#undef PG8_WAIT_V
#undef PG8_WAIT_L
#undef PG8_BAR
#undef PG8_SCHED
}
}

#define LAS __attribute__((address_space(3)))
#ifndef PHASE_FN
#define PHASE_FN __device__ __forceinline__
#endif
#ifndef GEMM_SP2
#define GEMM_SP2 true
#endif
#ifndef GEMM_ALIGN
#define GEMM_ALIGN false
#endif
typedef unsigned short bf16;
typedef pg8::bf16x8 bf16x8;
typedef pg8::f32x4 f32x4;
typedef pg8::u32x4 u32x4;
typedef pg8::u32x2 u32x2;
constexpr int D = 1024, NB = 4, SEQ = 8192, CTX = 256, T = CTX + SEQ, NTOK = NB * T, DEPTH = 4;
constexpr int NWAVES = 8, NTHR = 512;
constexpr int NSLOT = 71680;
constexpr size_t MiB = 1u << 20;
constexpr size_t CTL_ZERO_BYTES = 2 * MiB;
constexpr int CW_BAR = 1024;
constexpr int CW_MOE = 8192;
constexpr size_t WS_MOD = 1 * MiB;
constexpr size_t WS_LB = 2 * MiB;
constexpr size_t WS_TOK = 2 * MiB + 65536;
constexpr size_t WS_SLOT_TOK = 3 * MiB;
constexpr size_t WS_SLOT_GATE = 3 * MiB + 524288;
constexpr size_t WS_S = 4 * MiB;
constexpr size_t WS_HY = 136 * MiB;
constexpr size_t WS_MIX = 268 * MiB;
constexpr size_t WS_END = 610 * MiB;
constexpr size_t ROWB = (size_t)NTOK * 1024 * 2;
constexpr size_t W_ML_WIN = 0, W_ML_WIN_SZ = (size_t)4352 * 1024 * 2;
constexpr size_t W_ML_WOUT = 17 * MiB;
constexpr size_t W_RW_IN = 21 * MiB;
constexpr size_t W_RW_G2 = 35 * MiB;
constexpr size_t W_RW_WOUT = 36 * MiB;
constexpr size_t W_HG_IN = 38 * MiB;
constexpr size_t W_HG_WOUT = 48 * MiB;
constexpr size_t W_EX13 = 50 * MiB;
constexpr size_t W_EX2 = 82 * MiB;
constexpr size_t W_BYTES = 98 * MiB;
constexpr int LDS_PHASE_BYTES = 131072;
constexpr int MISC_OFF = LDS_PHASE_BYTES + 320;
constexpr int LDS_BYTES = 147456;

#define VM_WAIT() asm volatile("s_waitcnt vmcnt(0)" ::: "memory")
#define LDS_WAIT() asm volatile("s_waitcnt lgkmcnt(0)" ::: "memory")
__device__ __forceinline__ unsigned f2bf(float f) { unsigned u = __builtin_bit_cast(unsigned, f); return (u + 0x7fffu + ((u >> 16) & 1u)) >> 16; }
__device__ __forceinline__ unsigned pk2(float lo, float hi) { return f2bf(lo) | (f2bf(hi) << 16); }
__device__ __forceinline__ float bf2f(unsigned b) { return __builtin_bit_cast(float, b << 16); }
__device__ __forceinline__ float bflo(unsigned w) { return __builtin_bit_cast(float, w << 16); }
__device__ __forceinline__ float bfhi(unsigned w) { return __builtin_bit_cast(float, w & 0xffff0000u); }
__device__ __forceinline__ float wave_sum(float v) {
#pragma unroll
    for (int o = 1; o < 64; o <<= 1) v += __shfl_xor(v, o);
    return v; }
__device__ __forceinline__ float wave_max(float v) {
#pragma unroll
    for (int o = 1; o < 64; o <<= 1) v = fmaxf(v, __shfl_xor(v, o));
    return v; }
template <int CTRL> __device__ __forceinline__ float dpp_f(float v) { return __builtin_bit_cast(float, __builtin_amdgcn_update_dpp(0, __builtin_bit_cast(int, v), CTRL, 0xF, 0xF, false)); }
__device__ __forceinline__ float row16_sum(float v) { v += dpp_f<0xB1>(v); v += dpp_f<0x4E>(v); v += dpp_f<0x124>(v); v += dpp_f<0x128>(v); return v; }
template <int K> __device__ __forceinline__ f32x4 mm16(f32x4 acc, const LAS bf16* A, int lda, const LAS bf16* Bt, int ldb, int lane) {
    const int r = lane & 15, q = lane >> 4;
#pragma unroll
    for (int kk = 0; kk < K / 32; ++kk) {
        const bf16x8 a = *(const LAS bf16x8*)(A + r * lda + kk * 32 + q * 8);
        const bf16x8 b = *(const LAS bf16x8*)(Bt + r * ldb + kk * 32 + q * 8);
        acc = __builtin_amdgcn_mfma_f32_16x16x32_bf16(a, b, acc, 0, 0, 0); }
    return acc; }
typedef short s16x4 __attribute__((ext_vector_type(4)));
__device__ __forceinline__ bf16x8 tr_frag(const LAS bf16* X, int ld, int k0, int n0, int lane) {
    const int g = lane >> 4, a = (lane & 15) >> 2, p = lane & 3;
    const LAS bf16* p0 = X + (k0 + 8 * g + a) * ld + n0 + 4 * p;
    const s16x4 lo = __builtin_amdgcn_ds_read_tr16_b64_v4i16((LAS s16x4*)p0), hi = __builtin_amdgcn_ds_read_tr16_b64_v4i16((LAS s16x4*)(p0 + 4 * ld));
    return (bf16x8){lo[0], lo[1], lo[2], lo[3], hi[0], hi[1], hi[2], hi[3]}; }
__device__ __forceinline__ bf16x8 row_frag(const LAS bf16* A, int ld, int k0, int lane) { return *(const LAS bf16x8*)(A + (lane & 15) * ld + k0 + (lane >> 4) * 8); }
__device__ __forceinline__ int seq_row(int b, int dir, int i) {
    const int tt = (i < CTX) ? (dir ? CTX - 1 - i : i) : CTX + (dir ? SEQ - 1 - (i - CTX) : (i - CTX));
    return b * T + tt; }

#define XB_TMO      128
#define XB_XCNT(j)  (256  + 64 * (j))
#define XB_XSUB(j)  (1280 + 64 * (j))
#define XB_XGEN(j)  (2304 + 64 * (j))
#define XB_TOP      3328
#define XB_TOPGEN   3392
#define XCD_BAR_WORDS 3456
#define XB_SPIN_CAP (1u << 18)

__device__ __forceinline__ unsigned xb_ld(unsigned* p)              { return __hip_atomic_load(p, __ATOMIC_RELAXED, __HIP_MEMORY_SCOPE_AGENT); }
__device__ __forceinline__ unsigned xb_add(unsigned* p, unsigned v) { return __hip_atomic_fetch_add(p, v, __ATOMIC_RELAXED, __HIP_MEMORY_SCOPE_AGENT); }
__device__ __forceinline__ unsigned xb_xcc_id() { return (unsigned)__builtin_amdgcn_s_getreg((3 << 11) | 20) & 0xFu; }
#define XB_SPIN(cond, bar) do { unsigned _sp = 0; while (cond) { __builtin_amdgcn_s_sleep(1); \
    if ((++_sp & 255u) == 0u) { if (xb_ld(&(bar)[XB_TMO])) break; if (_sp > XB_SPIN_CAP) { atomicAdd(&(bar)[XB_TMO], 1u); break; } } } } while (0)

struct XcdBarrier {
    unsigned* bar; unsigned x;
    volatile LAS unsigned* st;
};

__device__ __forceinline__ XcdBarrier xcd_barrier_post(unsigned* bar, volatile LAS unsigned* st) {
    XcdBarrier b; b.bar = bar; b.x = xb_xcc_id(); b.st = st;
    if (threadIdx.x == 0) (void)xb_add(&bar[XB_XCNT(b.x)], 1u);
    return b;
}
__device__ __forceinline__ void xcd_barrier_complete(unsigned* bar, unsigned x, unsigned& nloc, unsigned& nx) {
    const unsigned G = gridDim.x * gridDim.y * gridDim.z;
    unsigned sum, cnt, mine, sp = 0u;
    for (;;) {
        sum = 0u; cnt = 0u; mine = 0u;
#pragma unroll
        for (unsigned j = 0; j < 16; ++j) { const unsigned c = xb_ld(&bar[XB_XCNT(j)]); sum += c; cnt += (c > 0u) ? 1u : 0u; mine = (j == x) ? c : mine; }
        if (sum == G) break;
        __builtin_amdgcn_s_sleep(1);
        if ((++sp & 255u) == 0u) { if (xb_ld(&bar[XB_TMO])) break; if (sp > XB_SPIN_CAP) { atomicAdd(&bar[XB_TMO], 1u); break; } }
    }
    nloc = mine > 0u ? mine : 1u; nx = cnt > 0u ? cnt : 1u;
}

__device__ __forceinline__ void xcd_barrier(const XcdBarrier& b) {
    asm volatile("s_waitcnt vmcnt(0)" ::: "memory");
    __syncthreads();
    if (threadIdx.x == 0) {
        unsigned* bar = b.bar;
        __builtin_amdgcn_s_waitcnt(0);
        unsigned nloc = b.st[0], nx = b.st[1];
        if (nloc == 0u) { xcd_barrier_complete(bar, b.x, nloc, nx); b.st[0] = nloc; b.st[1] = nx; }
        const unsigned old = xb_add(&bar[XB_XSUB(b.x)], 1u);
        const unsigned gen = old / nloc;
        if (old + 1u == (gen + 1u) * nloc) {
            __builtin_amdgcn_fence(__ATOMIC_RELEASE, "agent");
            asm volatile("s_waitcnt vmcnt(0)" ::: "memory");
            const unsigned og = xb_add(&bar[XB_TOP], 1u);
            const unsigned tg = og / nx;
            if (og + 1u == (tg + 1u) * nx) xb_add(&bar[XB_TOPGEN], 1u);
            else XB_SPIN(xb_ld(&bar[XB_TOPGEN]) == tg, bar);
            __builtin_amdgcn_fence(__ATOMIC_ACQUIRE, "agent");
            xb_add(&bar[XB_XGEN(b.x)], 1u);
            asm volatile("s_waitcnt vmcnt(0)" ::: "memory");
        } else {
            XB_SPIN(xb_ld(&bar[XB_XGEN(b.x)]) == gen, bar);
            __builtin_amdgcn_fence(__ATOMIC_ACQUIRE, "agent");
            asm volatile("s_waitcnt vmcnt(0)" ::: "memory");
        }
    }
    __syncthreads();
}

struct Args { const float* in[42]; float* out; unsigned char* ws; unsigned char* wts; int ph_lo, ph_hi; };
struct Frame {
    LAS unsigned char* lds; GAS float* out; GAS unsigned char* ws; GAS unsigned char* W;
    int tid, lane, wave, bid, G;
};
constexpr int PTAB_OFF = LDS_PHASE_BYTES + 1024;
__device__ __forceinline__ const GAS float* ldptr(const Frame& F, int i) { const unsigned long long v = ((const LAS unsigned long long*)(F.lds + PTAB_OFF))[i];
    const unsigned lo = __builtin_amdgcn_readfirstlane((unsigned)v), hi = __builtin_amdgcn_readfirstlane((unsigned)(v >> 32)); return (const GAS float*)(((unsigned long long)hi << 32) | lo); }
#define INP(i) ldptr(F, (i))
__device__ __forceinline__ Frame fresh(const Frame& F0) { Frame F = F0; int t = threadIdx.x; asm volatile("" : "+v"(t)); F.tid = t; F.lane = t & 63; F.wave = __builtin_amdgcn_readfirstlane(t >> 6);
    asm volatile("" : "+s"(F.bid), "+s"(F.G), "+s"(F.ws), "+s"(F.W), "+s"(F.out)); return F; }
enum { IN_X = 0, IN_C, IN_CTX, IN_CCTX, IN_ADAW, IN_ADAB, IN_NMIX, IN_NFFN, IN_NOUT, IN_ML_WIN, IN_ML_WGATE, IN_ML_BGATE, IN_ML_CONV, IN_ML_HEADG, IN_ML_WOUT,
       IN_RW_MU, IN_RW_WRKV, IN_RW_W0, IN_RW_W1, IN_RW_W2, IN_RW_A0, IN_RW_A1, IN_RW_A2, IN_RW_G1, IN_RW_G2, IN_RW_KK, IN_RW_KA, IN_RW_RK, IN_RW_LNW, IN_RW_LNB, IN_RW_WOUT,
       IN_HG_WIN, IN_HG_WF, IN_HG_BF, IN_HG_LB, IN_HG_HEADG, IN_HG_WOUT, IN_ROUTER_W, IN_ROUTER_B, IN_EX_W1, IN_EX_W3, IN_EX_W2 };

template <int MAP> __device__ __forceinline__ int rowmap(int n) { return MAP == 0 ? n : (MAP == 1 ? 8 * (n >> 2) + (n & 3) : 8 * (n >> 2) + 4 + (n & 3)); }
template <int MAP> __device__ __forceinline__ void tr_item(const GAS float* W, int ldw, int nblk, GAS bf16* WT, int ldd, int row_off, int k_off, const GAS float* kscale, LAS float* scr, int item, int lane) {
    const int kb = item / nblk, nb = item - kb * nblk, k0 = 64 * kb, n0 = 32 * nb;
#pragma unroll 8
    for (int i = 0; i < 32; ++i) { const int kk = 2 * i + (lane >> 5); float v = W[(size_t)(k0 + kk) * ldw + n0 + (lane & 31)]; if (kscale) v *= kscale[k0 + kk]; scr[kk * 33 + (lane & 31)] = v; }
    LDS_WAIT(); asm volatile("" ::: "memory");
    const int c = lane & 7;
#pragma unroll
    for (int j = 0; j < 4; ++j) { const int n = (lane >> 3) + 8 * j; const LAS float* s = scr + (8 * c) * 33 + n;
        u32x4 o; o.x = pk2(s[0 * 33], s[1 * 33]); o.y = pk2(s[2 * 33], s[3 * 33]); o.z = pk2(s[4 * 33], s[5 * 33]); o.w = pk2(s[6 * 33], s[7 * 33]);
        *(GAS u32x4*)(WT + (size_t)(row_off + rowmap<MAP>(n0 + n)) * ldd + k_off + k0 + 8 * c) = o; }
    LDS_WAIT(); asm volatile("" ::: "memory");
}
#define TRJOB(MAP, cnt, ...) if (r < (cnt)) { tr_item<MAP>(__VA_ARGS__, scr, r, F.lane); continue; } r -= (cnt);

PHASE_FN void pre_phase(Frame F) {
    LAS float* scr = (LAS float*)(F.lds + F.wave * 16384);
    const int gw = F.bid * NWAVES + F.wave, NGW = F.G * NWAVES;
    const size_t gt = (size_t)F.bid * NTHR + F.tid, NGT = (size_t)F.G * NTHR;
    GAS bf16* W = (GAS bf16*)F.W;
    constexpr int NITEMS = 2 * 2048 + 2 * 512 + 6 * 512 + 4 * 32 + 4 * 32 + 2 * 64 + 64 + 512 + 1536 + 2 * 512 + 512;
    for (int it = gw; it < NITEMS; it += NGW) {
        int r = it;
        TRJOB(0, 2048, INP(IN_ML_WIN), 4096, 128, (GAS bf16*)(F.W + W_ML_WIN), 1024, 0, 0, nullptr)
        TRJOB(0, 2048, INP(IN_ML_WIN) + (size_t)1024 * 4096, 4096, 128, (GAS bf16*)(F.W + W_ML_WIN + W_ML_WIN_SZ), 1024, 0, 0, nullptr)
        TRJOB(0, 512, INP(IN_ML_WOUT), 1024, 32, (GAS bf16*)(F.W + W_ML_WOUT), 1024, 0, 0, nullptr)
        TRJOB(0, 512, INP(IN_ML_WOUT) + (size_t)1024 * 1024, 1024, 32, (GAS bf16*)(F.W + W_ML_WOUT + 2 * MiB), 1024, 0, 0, nullptr)
        GAS bf16* RWIN = (GAS bf16*)(F.W + W_RW_IN); const GAS float* mu = INP(IN_RW_MU);
        if (r < 6 * 512) { const int idx = r / 1024, ps = (r / 512) & 1, rr = r & 511;
            tr_item<0>(INP(IN_RW_WRKV) + (size_t)idx * 1024 * 1024, 1024, 32, RWIN, 2048, idx * 1024, ps * 1024, ps ? mu + idx * 1024 : nullptr, scr, rr, F.lane); continue; } r -= 6 * 512;
        if (r < 4 * 32) { const int dir = r / 64, ps = (r / 32) & 1, rr = r & 31;
            tr_item<0>(INP(IN_RW_W1) + (size_t)dir * 1024 * 64, 64, 2, RWIN, 2048, 3072 + dir * 64, ps * 1024, ps ? mu + 3 * 1024 : nullptr, scr, rr, F.lane); continue; } r -= 4 * 32;
        if (r < 4 * 32) { const int dir = r / 64, ps = (r / 32) & 1, rr = r & 31;
            tr_item<0>(INP(IN_RW_A1) + (size_t)dir * 1024 * 64, 64, 2, RWIN, 2048, 3200 + dir * 64, ps * 1024, ps ? mu + 4 * 1024 : nullptr, scr, rr, F.lane); continue; } r -= 4 * 32;
        if (r < 2 * 64) { const int ps = r / 64, rr = r & 63;
            tr_item<0>(INP(IN_RW_G1), 128, 4, RWIN, 2048, 3328, ps * 1024, ps ? mu + 5 * 1024 : nullptr, scr, rr, F.lane); continue; } r -= 2 * 64;
        TRJOB(0, 64, INP(IN_RW_G2), 1024, 32, (GAS bf16*)(F.W + W_RW_G2), 256, 0, 0, nullptr)
        TRJOB(0, 512, INP(IN_RW_WOUT), 1024, 32, (GAS bf16*)(F.W + W_RW_WOUT), 1024, 0, 0, nullptr)
        TRJOB(0, 1536, INP(IN_HG_WIN), 3072, 96, (GAS bf16*)(F.W + W_HG_IN), 1024, 0, 0, nullptr)
        TRJOB(0, 512, INP(IN_HG_WF), 1024, 32, (GAS bf16*)(F.W + W_HG_IN), 1024, 3072, 0, nullptr)
        TRJOB(0, 512, INP(IN_HG_WF) + (size_t)1024 * 1024, 1024, 32, (GAS bf16*)(F.W + W_HG_IN), 1024, 4096, 0, nullptr)
        TRJOB(0, 512, INP(IN_HG_WOUT), 1024, 32, (GAS bf16*)(F.W + W_HG_WOUT), 1024, 0, 0, nullptr)
    }
    for (size_t i = gt; i < (size_t)2 * 256 * 1024; i += NGT) { const int j = (int)(i >> 18), rr = (int)((i >> 10) & 255), k = (int)(i & 1023);
        float v = 0.f; if (rr < 32) { const int dir = rr >> 4, g = rr & 15; v = INP(IN_ML_WGATE)[((size_t)(j * 2 + dir) * 1024 + k) * 16 + g]; }
        ((GAS bf16*)(F.W + W_ML_WIN + j * W_ML_WIN_SZ))[(size_t)(4096 + rr) * 1024 + k] = (bf16)f2bf(v); }
    for (size_t i = gt; i < (size_t)128 * 2048; i += NGT) ((GAS bf16*)(F.W + W_RW_IN))[(size_t)3456 * 2048 + i] = 0;
    for (size_t i = gt; i < (size_t)1024 * 128; i += NGT) ((GAS bf16*)(F.W + W_RW_G2))[(i >> 7) * 256 + 128 + (i & 127)] = 0;
    if (F.bid == 0) for (int c = F.tid; c < 1024; c += NTHR) { const GAS float* lg = INP(IN_HG_LB) + c; const float l0 = lg[0], l1 = lg[1024], l2 = lg[2048], l3 = lg[3072];
        const float mx = fmaxf(fmaxf(l0, l1), fmaxf(l2, l3)); const float e0 = __expf(l0 - mx), e1 = __expf(l1 - mx), e2 = __expf(l2 - mx), e3 = __expf(l3 - mx);
        ((GAS float*)(F.ws + WS_LB))[c] = (e1 + e2) / (e0 + e1 + e2 + e3); }
    { GAS f32x4* S4 = (GAS f32x4*)(F.ws + WS_S);
      for (size_t i = gt; i < (size_t)NTOK * 256; i += NGT) { const int m = (int)(i >> 8), c4 = (int)(i & 255); const int b = m / T, t = m - b * T;
          const GAS float* src = (t < CTX) ? INP(IN_CTX) + ((size_t)(b * CTX + t)) * 1024 : INP(IN_X) + ((size_t)(b * SEQ + t - CTX)) * 1024;
          S4[i] = ((const GAS f32x4*)src)[c4]; } }
    { LAS float* sc = (LAS float*)(F.lds + 8448); GAS float* MODP = (GAS float*)(F.ws + WS_MIX);
      for (int it = F.bid; it < 768; it += F.G) { const int i = it / 192, rem = it - i * 192, kc = rem / 12, jb = rem - kc * 12;
          __syncthreads();
          if (F.tid < 320) { const int seg = F.tid >> 6, kk = F.tid & 63; const float cv = seg == 0 ? INP(IN_CCTX)[kc * 64 + kk] : INP(IN_C)[(seg - 1) * 1024 + kc * 64 + kk]; sc[F.tid] = silu_f(cv); }
          __syncthreads();
          const int j = jb * 512 + F.tid; const GAS float* wp = INP(IN_ADAW) + ((size_t)i * 1024 + kc * 64) * 6144 + j;
          float a0 = 0.f, a1 = 0.f, a2 = 0.f, a3 = 0.f, a4 = 0.f;
#pragma unroll 8
          for (int kk = 0; kk < 64; ++kk) { const float w = wp[(size_t)kk * 6144]; a0 += sc[kk] * w; a1 += sc[64 + kk] * w; a2 += sc[128 + kk] * w; a3 += sc[192 + kk] * w; a4 += sc[256 + kk] * w; }
          GAS float* mp = MODP + ((size_t)kc * 4 + i) * 5 * 6144 + j;
          mp[0] = a0; mp[6144] = a1; mp[2 * 6144] = a2; mp[3 * 6144] = a3; mp[4 * 6144] = a4; } }
}
PHASE_FN void modsum_phase(Frame F) {
    const GAS float* MODP = (const GAS float*)(F.ws + WS_MIX); GAS float* MOD = (GAS float*)(F.ws + WS_MOD);
    for (int idx = F.bid * NTHR + F.tid; idx < 4 * 5 * 6144; idx += F.G * NTHR) { const int i = idx / (5 * 6144), j = idx % 6144;
        float a = INP(IN_ADAB)[i * 6144 + j];
#pragma unroll
        for (int kc = 0; kc < 16; ++kc) a += MODP[(size_t)kc * 4 * 5 * 6144 + idx];
        MOD[idx] = a; }
}
PHASE_FN void expert_weights(Frame F, int L) {
    LAS float* scr = (LAS float*)(F.lds + F.wave * 16384);
    const int gw = F.bid * NWAVES + F.wave, NGW = F.G * NWAVES;
    GAS bf16* W13 = (GAS bf16*)(F.W + W_EX13); GAS bf16* W2 = (GAS bf16*)(F.W + W_EX2);
    const GAS float* w1 = INP(IN_EX_W1) + (size_t)L * 16 * 1024 * 512; const GAS float* w3 = INP(IN_EX_W3) + (size_t)L * 16 * 1024 * 512; const GAS float* w2 = INP(IN_EX_W2) + (size_t)L * 16 * 512 * 1024;
    for (int it = gw; it < 3 * 4096; it += NGW) { const int which = it >> 12, e = (it >> 8) & 15, rr = it & 255;
        if (which == 0) tr_item<1>(w1 + (size_t)e * 1024 * 512, 512, 16, W13, 1024, e * 1024, 0, nullptr, scr, rr, F.lane);
        else if (which == 1) tr_item<2>(w3 + (size_t)e * 1024 * 512, 512, 16, W13, 1024, e * 1024, 0, nullptr, scr, rr, F.lane);
        else tr_item<0>(w2 + (size_t)e * 512 * 1024, 1024, 32, W2, 512, e * 1024, 0, nullptr, scr, rr, F.lane); }
}

template <int MODE> PHASE_FN void norm_phase(Frame F, int L, bool add_moe, int ldh) {
    GAS float* S = (GAS float*)(F.ws + WS_S); GAS bf16* H = (GAS bf16*)(F.ws + WS_HY); const GAS bf16* YM = (const GAS bf16*)(F.ws + WS_MIX + 210 * MiB);
    const GAS float* MOD = (const GAS float*)(F.ws + WS_MOD);
    const int gw = F.bid * NWAVES + F.wave, NGW = F.G * NWAVES, lane = F.lane;
    LAS float* rwl = (LAS float*)F.lds;
    LAS int* cntl = (LAS int*)(F.lds + 65536);
    if (MODE == 1) {
        for (int i = F.tid; i < 16384; i += NTHR) { const int c = i >> 4, e = i & 15; rwl[e * 1024 + c] = INP(IN_ROUTER_W)[i]; }
        if (F.tid < 16) cntl[F.tid] = 0;
        __syncthreads();
    }
    const GAS float* gnp = MODE == 0 ? INP(IN_NMIX) + L * 1024 : (MODE == 1 ? INP(IN_NFFN) + L * 1024 : INP(IN_NOUT));
    for (int m = gw; m < NTOK; m += NGW) {
        const int b = m / T, t = m - b * T, seg = t < CTX ? 0 : 1 + b;
        if (MODE == 2 && t < CTX) continue;
        f32x4 v[4]; GAS f32x4* sp = (GAS f32x4*)(S + (size_t)m * 1024) + lane;
#pragma unroll
        for (int j = 0; j < 4; ++j) v[j] = sp[64 * j];
        if (add_moe) {
            const GAS float* gp = MOD + ((size_t)((MODE == 2 ? 3 : L - 1) * 5 + seg)) * 6144 + 5 * 1024;
            const GAS u32x2* ya = (const GAS u32x2*)(YM + (size_t)(2 * m) * 1024) + lane; const GAS u32x2* yb = ya + 256;
#pragma unroll
            for (int j = 0; j < 4; ++j) { const u32x2 a = ya[64 * j], bq = yb[64 * j]; const f32x4 g = ((const GAS f32x4*)gp)[lane + 64 * j];
                v[j][0] += g[0] * (bflo(a.x) + bflo(bq.x)); v[j][1] += g[1] * (bfhi(a.x) + bfhi(bq.x)); v[j][2] += g[2] * (bflo(a.y) + bflo(bq.y)); v[j][3] += g[3] * (bfhi(a.y) + bfhi(bq.y)); }
            if (MODE != 2) {
#pragma unroll
                for (int j = 0; j < 4; ++j) sp[64 * j] = v[j]; }
        }
        float ss = 0.f;
#pragma unroll
        for (int j = 0; j < 4; ++j) ss += (v[j][0] * v[j][0] + v[j][1] * v[j][1]) + (v[j][2] * v[j][2] + v[j][3] * v[j][3]);
        const float rinv = 1.0f / sqrtf(wave_sum(ss) * (1.0f / 1024.0f) + 1e-6f);
        if (MODE == 2) { GAS f32x4* op = (GAS f32x4*)(F.out + ((size_t)(b * SEQ + t - CTX)) * 1024) + lane;
#pragma unroll
            for (int j = 0; j < 4; ++j) { const f32x4 g = ((const GAS f32x4*)gnp)[lane + 64 * j]; op[64 * j] = v[j] * rinv * g; }
            continue; }
        const GAS float* mp = MOD + ((size_t)(L * 5 + seg)) * 6144 + (MODE == 0 ? 0 : 3 * 1024);
        f32x4 h[4];
#pragma unroll
        for (int j = 0; j < 4; ++j) { const f32x4 g = ((const GAS f32x4*)gnp)[lane + 64 * j], sh = ((const GAS f32x4*)mp)[lane + 64 * j], sc = ((const GAS f32x4*)(mp + 1024))[lane + 64 * j];
            h[j] = v[j] * rinv * g * (sc + 1.0f) + sh;
            u32x2 o; o.x = pk2(h[j][0], h[j][1]); o.y = pk2(h[j][2], h[j][3]); *((GAS u32x2*)(H + (size_t)m * ldh) + lane + 64 * j) = o; }
        if (MODE == 1) {
            float lg[16];
#pragma unroll
            for (int e = 0; e < 16; ++e) { float a = 0.f;
#pragma unroll
                for (int j = 0; j < 4; ++j) { const f32x4 w = *(const LAS f32x4*)(rwl + e * 1024 + 256 * j + 4 * lane); a += (h[j][0] * w[0] + h[j][1] * w[1]) + (h[j][2] * w[2] + h[j][3] * w[3]); }
                lg[e] = wave_sum(a); }
            float aff[16], sel[16];
#pragma unroll
            for (int e = 0; e < 16; ++e) { aff[e] = sigmoid_f(lg[e]); sel[e] = aff[e] + INP(IN_ROUTER_B)[e]; }
            float best = -3.0e38f; int bg = 0; float s0 = 0.f, s1 = 0.f, s2 = 0.f, s3 = 0.f, a0 = 0.f, a1 = 0.f, a2 = 0.f, a3 = 0.f;
#pragma unroll
            for (int g = 0; g < 4; ++g) { const float x0 = sel[4 * g], x1 = sel[4 * g + 1], x2 = sel[4 * g + 2], x3 = sel[4 * g + 3];
                const float t1 = fmaxf(x0, x1), t2 = fminf(x0, x1), u1 = fmaxf(x2, x3), u2 = fminf(x2, x3);
                const float sum = fmaxf(t1, u1) + fmaxf(fminf(t1, u1), fmaxf(t2, u2));
                const bool bt = sum > best; best = bt ? sum : best; bg = bt ? g : bg;
                s0 = bt ? x0 : s0; s1 = bt ? x1 : s1; s2 = bt ? x2 : s2; s3 = bt ? x3 : s3;
                a0 = bt ? aff[4 * g] : a0; a1 = bt ? aff[4 * g + 1] : a1; a2 = bt ? aff[4 * g + 2] : a2; a3 = bt ? aff[4 * g + 3] : a3; }
            int i1 = 0; float m1 = s0; if (s1 > m1) { m1 = s1; i1 = 1; } if (s2 > m1) { m1 = s2; i1 = 2; } if (s3 > m1) { m1 = s3; i1 = 3; }
            int i2 = -1; float m2 = -3.0e38f;
            if (i1 != 0 && s0 > m2) { m2 = s0; i2 = 0; } if (i1 != 1 && s1 > m2) { m2 = s1; i2 = 1; } if (i1 != 2 && s2 > m2) { m2 = s2; i2 = 2; } if (i1 != 3 && s3 > m2) { m2 = s3; i2 = 3; }
            const float c1 = i1 == 0 ? a0 : (i1 == 1 ? a1 : (i1 == 2 ? a2 : a3)), c2 = i2 == 0 ? a0 : (i2 == 1 ? a1 : (i2 == 2 ? a2 : a3));
            const float inv = 1.0f / (c1 + c2);
            if (lane == 0) { const int e1 = bg * 4 + i1, e2 = bg * 4 + i2;
                u32x4 tk; tk.x = (unsigned)e1; tk.y = (unsigned)e2; tk.z = __float_as_uint(c1 * inv); tk.w = __float_as_uint(c2 * inv); ((GAS u32x4*)(F.ws + WS_TOK))[m] = tk;
                __hip_atomic_fetch_add(cntl + e1, 1, __ATOMIC_RELAXED, __HIP_MEMORY_SCOPE_WORKGROUP); __hip_atomic_fetch_add(cntl + e2, 1, __ATOMIC_RELAXED, __HIP_MEMORY_SCOPE_WORKGROUP); }
        }
    }
    if (MODE == 1) { __syncthreads(); if (F.tid < 16) __hip_atomic_fetch_add((GAS unsigned*)F.ws + CW_MOE + L * 2048 + 64 * F.tid, (unsigned)cntl[F.tid], __ATOMIC_RELAXED, __HIP_MEMORY_SCOPE_AGENT); }
}

__device__ __forceinline__ void moe_prefix(const Frame& F, int L, LAS int* pref  , LAS int* cnt  ) {
    if (F.tid < 16) cnt[F.tid] = (int)__hip_atomic_load((GAS unsigned*)F.ws + CW_MOE + L * 2048 + 64 * F.tid, __ATOMIC_RELAXED, __HIP_MEMORY_SCOPE_AGENT);
    __syncthreads();
    if (F.tid == 0) { int p = 0; for (int e = 0; e < 16; ++e) { pref[e] = p; p += (cnt[e] + 255) >> 8; } pref[16] = p; }
    __syncthreads();
}
PHASE_FN void slots_phase(Frame F, int L) {
    LAS int* pref = (LAS int*)F.lds; LAS int* cnt = pref + 32;
    moe_prefix(F, L, pref, cnt);
    const int gw = F.bid * NWAVES + F.wave, NGW = F.G * NWAVES, lane = F.lane;
    GAS unsigned* cursor = (GAS unsigned*)F.ws + CW_MOE + L * 2048 + 1024;
    GAS int* slot_tok = (GAS int*)(F.ws + WS_SLOT_TOK); GAS float* slot_gate = (GAS float*)(F.ws + WS_SLOT_GATE);
    const GAS bf16* H = (const GAS bf16*)(F.ws + WS_HY); GAS bf16* XG = (GAS bf16*)(F.ws + WS_MIX);
    for (int it = gw; it < NTOK / 64; it += NGW) {
        const int m = it * 64 + lane; const u32x4 tk = ((const GAS u32x4*)(F.ws + WS_TOK))[m];
        int myslot[2];
#pragma unroll
        for (int k = 0; k < 2; ++k) { const int e = (int)(k ? tk.y : tk.x); int slot = 0;
            for (int ee = 0; ee < 16; ++ee) { const unsigned long long mask = __ballot(e == ee);
                if (mask) { const int n = __popcll(mask); unsigned base = 0; if (lane == 0) base = __hip_atomic_fetch_add(cursor + 64 * ee, (unsigned)n, __ATOMIC_RELAXED, __HIP_MEMORY_SCOPE_AGENT); base = __builtin_amdgcn_readfirstlane(base);
                    if (e == ee) slot = pref[ee] * 256 + (int)base + __popcll(mask & ((1ull << lane) - 1ull)); } }
            myslot[k] = slot; slot_tok[slot] = 2 * m + k; slot_gate[slot] = __uint_as_float(k ? tk.w : tk.z); }
#pragma unroll
        for (int k = 0; k < 2; ++k)
            for (int l = 0; l < 64; ++l) { const int sl = __shfl(myslot[k], l); const GAS u32x4* src = (const GAS u32x4*)(H + (size_t)(it * 64 + l) * 1024); GAS u32x4* dst = (GAS u32x4*)(XG + (size_t)sl * 1024);
                dst[lane] = src[lane]; dst[64 + lane] = src[64 + lane]; }
    }
    for (int e = 0; e < 16; ++e) { const int lo = pref[e] * 256 + cnt[e], hi = pref[e + 1] * 256;
        for (int s = lo + gw; s < hi; s += NGW) { GAS u32x4* dst = (GAS u32x4*)(XG + (size_t)s * 1024); dst[lane] = (u32x4){0u, 0u, 0u, 0u}; dst[64 + lane] = (u32x4){0u, 0u, 0u, 0u};
            if (lane == 0) { slot_tok[s] = -1; slot_gate[s] = 0.f; } } }
}

PHASE_FN void du_phase(Frame F) {
    GAS bf16* H2 = (GAS bf16*)(F.ws + WS_HY);
    const size_t gt = (size_t)F.bid * NTHR + F.tid, NGT = (size_t)F.G * NTHR;
    for (size_t i = gt; i < (size_t)NTOK * 128; i += NGT) { const int m = (int)(i >> 7), c8 = (int)(i & 127); const int t = m % T;
        const bool hp = !(t == 0 || t == CTX), hn = !(t == CTX - 1 || t == T - 1);
        const u32x4 z = {0u, 0u, 0u, 0u};
        const u32x4 u = *(const GAS u32x4*)(H2 + (size_t)m * 2048 + c8 * 8), p = hp ? *(const GAS u32x4*)(H2 + (size_t)(m - 1) * 2048 + c8 * 8) : z, n = hn ? *(const GAS u32x4*)(H2 + (size_t)(m + 1) * 2048 + c8 * 8) : z;
        u32x4 o;
#pragma unroll
        for (int j = 0; j < 4; ++j) o[j] = pk2(0.5f * (bflo(p[j]) + bflo(n[j])) - bflo(u[j]), 0.5f * (bfhi(p[j]) + bfhi(n[j])) - bfhi(u[j]));
        *(GAS u32x4*)(H2 + (size_t)m * 2048 + 1024 + c8 * 8) = o; }
}

PHASE_FN void conv_phase(Frame F, int j) {
    const GAS bf16* QP = (const GAS bf16*)(F.ws + WS_MIX); GAS bf16* QK = (GAS bf16*)(F.ws + WS_HY); const GAS float* cw = INP(IN_ML_CONV) + (size_t)j * 9 * 2048;
    const size_t gt = (size_t)F.bid * NTHR + F.tid, NGT = (size_t)F.G * NTHR;
    for (size_t i = gt; i < (size_t)NTOK * 256; i += NGT) { const int m = (int)(i >> 8), c = (int)(i & 255) * 8; const int t = m % T;
        float acc[8];
#pragma unroll
        for (int q = 0; q < 8; ++q) acc[q] = 0.f;
        const int p = t - CTX, gr = p >> 6, gc = p & 63;
#pragma unroll
        for (int dr = 0; dr < 3; ++dr)
#pragma unroll
            for (int dw = 0; dw < 3; ++dw) {
                bool ok; int mm;
                if (t < CTX) { ok = (dr == 1) && (t + dw - 1 >= 0) && (t + dw - 1 < CTX); mm = m + dw - 1; }
                else { ok = (gr + dr - 1 >= 0) && (gr + dr - 1 < 128) && (gc + dw - 1 >= 0) && (gc + dw - 1 < 64); mm = m + (dr - 1) * 64 + (dw - 1); }
                if (ok) { const u32x4 x = *(const GAS u32x4*)(QP + (size_t)mm * 2048 + c); const f32x4 w0 = *(const GAS f32x4*)(cw + (dr * 3 + dw) * 2048 + c), w1 = *(const GAS f32x4*)(cw + (dr * 3 + dw) * 2048 + c + 4);
                    acc[0] += bflo(x[0]) * w0[0]; acc[1] += bfhi(x[0]) * w0[1]; acc[2] += bflo(x[1]) * w0[2]; acc[3] += bfhi(x[1]) * w0[3];
                    acc[4] += bflo(x[2]) * w1[0]; acc[5] += bfhi(x[2]) * w1[1]; acc[6] += bflo(x[3]) * w1[2]; acc[7] += bfhi(x[3]) * w1[3]; } }
        const float sc = c >= 1024 ? 0.08838834764831845f : 1.0f;
        u32x4 o;
#pragma unroll
        for (int q = 0; q < 4; ++q) o[q] = pk2(silu_f(acc[2 * q]) * sc, silu_f(acc[2 * q + 1]) * sc);
        *(GAS u32x4*)(QK + (size_t)m * 2048 + c) = o; }
}

PHASE_FN void headnorm_phase(Frame F, const GAS bf16* HSf, const GAS bf16* HSb, const GAS bf16* OG, const GAS float* hg, GAS bf16* Y) {
    const int gw = F.bid * NWAVES + F.wave, NGW = F.G * NWAVES, lane = F.lane;
    for (int m = gw; m < NTOK; m += NGW) { const size_t off = (size_t)m * 1024 + lane * 16;
        float x[16]; float ss = 0.f;
#pragma unroll
        for (int hlf = 0; hlf < 2; ++hlf) { const u32x4 a = *(const GAS u32x4*)(HSf + off + 8 * hlf), bq = *(const GAS u32x4*)(HSb + off + 8 * hlf);
#pragma unroll
            for (int q = 0; q < 4; ++q) { x[8 * hlf + 2 * q] = bflo(a[q]) + bflo(bq[q]); x[8 * hlf + 2 * q + 1] = bfhi(a[q]) + bfhi(bq[q]); } }
#pragma unroll
        for (int q = 0; q < 16; ++q) ss += x[q] * x[q];
        ss += __shfl_xor(ss, 1); ss += __shfl_xor(ss, 2); ss += __shfl_xor(ss, 4);
        const float rinv = 1.0f / sqrtf(ss * (1.0f / 128.0f) + 1e-6f);
#pragma unroll
        for (int hlf = 0; hlf < 2; ++hlf) { const u32x4 g = *(const GAS u32x4*)(OG + off + 8 * hlf); const f32x4 h0 = *(const GAS f32x4*)(hg + lane * 16 + 8 * hlf), h1 = *(const GAS f32x4*)(hg + lane * 16 + 8 * hlf + 4);
            u32x4 o;
            o[0] = pk2(x[8 * hlf + 0] * rinv * h0[0] * bflo(g[0]), x[8 * hlf + 1] * rinv * h0[1] * bfhi(g[0])); o[1] = pk2(x[8 * hlf + 2] * rinv * h0[2] * bflo(g[1]), x[8 * hlf + 3] * rinv * h0[3] * bfhi(g[1]));
            o[2] = pk2(x[8 * hlf + 4] * rinv * h1[0] * bflo(g[2]), x[8 * hlf + 5] * rinv * h1[1] * bfhi(g[2])); o[3] = pk2(x[8 * hlf + 6] * rinv * h1[2] * bflo(g[3]), x[8 * hlf + 7] * rinv * h1[3] * bfhi(g[3]));
            *(GAS u32x4*)(Y + off + 8 * hlf) = o; } }
}
PHASE_FN void rwpost_phase(Frame F, const GAS bf16* Of, const GAS bf16* Ob, const GAS float* BETA, const GAS bf16* V, const GAS bf16* Gt, GAS bf16* Y) {
    const int gw = F.bid * NWAVES + F.wave, NGW = F.G * NWAVES, lane = F.lane;
    const GAS float* lnw = INP(IN_RW_LNW); const GAS float* lnb = INP(IN_RW_LNB);
    for (int m = gw; m < NTOK; m += NGW) { const size_t off = (size_t)m * 1024 + lane * 16;
        float x[16]; float s = 0.f;
#pragma unroll
        for (int hlf = 0; hlf < 2; ++hlf) { const u32x4 a = *(const GAS u32x4*)(Of + off + 8 * hlf), bq = *(const GAS u32x4*)(Ob + off + 8 * hlf);
#pragma unroll
            for (int q = 0; q < 4; ++q) { x[8 * hlf + 2 * q] = bflo(a[q]) + bflo(bq[q]); x[8 * hlf + 2 * q + 1] = bfhi(a[q]) + bfhi(bq[q]); } }
#pragma unroll
        for (int q = 0; q < 16; ++q) s += x[q];
        s += __shfl_xor(s, 1); s += __shfl_xor(s, 2);
        const float mean = s * (1.0f / 64.0f); float vs = 0.f;
#pragma unroll
        for (int q = 0; q < 16; ++q) { x[q] -= mean; vs += x[q] * x[q]; }
        vs += __shfl_xor(vs, 1); vs += __shfl_xor(vs, 2);
        const float rinv = 1.0f / sqrtf(vs * (1.0f / 64.0f) + 64e-5f);
        const int hd = lane >> 2; const float beta = BETA[(size_t)m * 16 + hd] + BETA[((size_t)NTOK + m) * 16 + hd];
#pragma unroll
        for (int hlf = 0; hlf < 2; ++hlf) { const u32x4 vv = *(const GAS u32x4*)(V + off + 8 * hlf), gg = *(const GAS u32x4*)(Gt + off + 8 * hlf);
            const f32x4 w0 = *(const GAS f32x4*)(lnw + lane * 16 + 8 * hlf), w1 = *(const GAS f32x4*)(lnw + lane * 16 + 8 * hlf + 4), b0 = *(const GAS f32x4*)(lnb + lane * 16 + 8 * hlf), b1 = *(const GAS f32x4*)(lnb + lane * 16 + 8 * hlf + 4);
            float y[8];
#pragma unroll
            for (int q = 0; q < 4; ++q) { y[q] = x[8 * hlf + q] * rinv * w0[q] + b0[q]; y[4 + q] = x[8 * hlf + 4 + q] * rinv * w1[q] + b1[q]; }
            u32x4 o;
#pragma unroll
            for (int q = 0; q < 4; ++q) o[q] = pk2((y[2 * q] + beta * bflo(vv[q])) * bflo(gg[q]), (y[2 * q + 1] + beta * bfhi(vv[q])) * bfhi(gg[q]));
            *(GAS u32x4*)(Y + off + 8 * hlf) = o; } }
}

PHASE_FN void ml_scan_phase(Frame F, const GAS bf16* QK, const GAS bf16* V, const GAS float* GATES, GAS bf16* HS) {
    constexpr int OFF_Q = 0, OFF_K = 17408, OFF_V = 34816, OFF_VW = 39936, OFF_WKR = 45056, INB = 47360;
    LAS bf16* SS = (LAS bf16*)(F.lds + 2 * INB); LAS bf16* CS = (LAS bf16*)(F.lds + 2 * INB + 9216); LAS bf16* HO = (LAS bf16*)(F.lds + 2 * INB + 9216 + 13056);
    LAS float* SC = (LAS float*)(F.lds + 2 * INB + 9216 + 13056 + 5120);
    LAS float* sdenp = SC + 2 * 336;
    const int tid = F.tid, lane = F.lane, w = F.wave, r = lane & 15, q = lane >> 4;
    const int lrow = tid >> 3, lp = tid & 7;
    for (int unit = F.bid; unit < 256; unit += F.G) {
        const int vs = unit & 3, dir = (unit >> 2) & 1, h = (unit >> 3) & 7, b = unit >> 6;
        f32x4 Cst[2], Nst; Cst[0] = (f32x4){0.f, 0.f, 0.f, 0.f}; Cst[1] = Cst[0]; Nst = Cst[0];
        __syncthreads();
        for (int i = tid; i < 48 * 136; i += NTHR) CS[i] = 0;
        for (int i = tid; i < 2 * 16 * 72; i += NTHR) { ((LAS bf16*)(F.lds + OFF_WKR))[i % 1152] = 0; ((LAS bf16*)(F.lds + INB + OFF_WKR))[i % 1152] = 0; }
        float m_run = 0.f;
        u32x4 rq[2], rk[2], rv = {0u, 0u, 0u, 0u}; float rig = 0.f, rlf = 0.f;
#define ML_LOAD(c) do { const int row_ = seq_row(b, dir, (c) * 64 + lrow); const GAS bf16* qp_ = QK + (size_t)row_ * 2048 + h * 128; \
            rq[0] = *(const GAS u32x4*)(qp_ + 8 * lp); rq[1] = *(const GAS u32x4*)(qp_ + 8 * (lp + 8)); rk[0] = *(const GAS u32x4*)(qp_ + 1024 + 8 * lp); rk[1] = *(const GAS u32x4*)(qp_ + 1024 + 8 * (lp + 8)); \
            if (tid < 256) { const int vrow_ = seq_row(b, dir, (c) * 64 + (tid >> 2)); rv = *(const GAS u32x4*)(V + (size_t)vrow_ * 1024 + h * 128 + vs * 32 + 8 * (tid & 3)); } } while (0)
#define ML_GLOAD(c) do { const int grow_ = seq_row(b, dir, (c) * 64 + lane); rig = GATES[(size_t)grow_ * 32 + dir * 16 + h]; rlf = GATES[(size_t)grow_ * 32 + dir * 16 + 8 + h]; } while (0)
#define ML_SCALARS(buf) do { const float lf_ = logsigmoid_f(rlf); float bc_ = lf_; \
            _Pragma("unroll") for (int o_ = 1; o_ < 64; o_ <<= 1) { const float t_ = __shfl_up(bc_, o_); if (lane >= o_) bc_ += t_; } \
            const float u_ = rig - bc_; float pm_ = u_; \
            _Pragma("unroll") for (int o_ = 1; o_ < 64; o_ <<= 1) { const float t_ = __shfl_up(pm_, o_); if (lane >= o_) pm_ = fmaxf(pm_, t_); } \
            const float cc_ = fmaxf(m_run, pm_), blast_ = __shfl(bc_, 63), pmall_ = __shfl(pm_, 63), mnew_ = blast_ + fmaxf(m_run, pmall_); LAS float* sc_ = SC + (buf) * 336; \
            sc_[lane] = u_; sc_[64 + lane] = cc_; sc_[128 + lane] = __expf(m_run - cc_); sc_[192 + lane] = __expf(-(bc_ + cc_)); sc_[256 + lane] = __expf(blast_ + u_ - mnew_); \
            if (lane == 0) sc_[320] = __expf(blast_ + m_run - mnew_); m_run = mnew_; } while (0)
        ML_LOAD(0);
        if (w == 7) { ML_GLOAD(0); ML_SCALARS(0); ML_GLOAD(1); }
        __syncthreads();
        constexpr int NCH = T / 64;
        for (int c = 0; c < NCH; ++c) {
            const int pb = c & 1; LAS unsigned char* ib = F.lds + pb * INB;
            LAS bf16* QS = (LAS bf16*)(ib + OFF_Q); LAS bf16* KS = (LAS bf16*)(ib + OFF_K); LAS bf16* VS = (LAS bf16*)(ib + OFF_V); LAS bf16* VW = (LAS bf16*)(ib + OFF_VW); LAS bf16* WKR = (LAS bf16*)(ib + OFF_WKR);
            const LAS float* sc = SC + pb * 336;
            {
                *(LAS u32x4*)(QS + lrow * 136 + 8 * lp) = rq[0]; *(LAS u32x4*)(QS + lrow * 136 + 8 * (lp + 8)) = rq[1];
                *(LAS u32x4*)(KS + lrow * 136 + 8 * lp) = rk[0]; *(LAS u32x4*)(KS + lrow * 136 + 8 * (lp + 8)) = rk[1];
                if (tid < 256) { const int s_ = tid >> 2; const float wk = sc[256 + s_]; u32x4 vw;
#pragma unroll
                    for (int jj = 0; jj < 4; ++jj) vw[jj] = pk2(bflo(rv[jj]) * wk, bfhi(rv[jj]) * wk);
                    *(LAS u32x4*)(VS + s_ * 40 + 8 * (tid & 3)) = rv; *(LAS u32x4*)(VW + s_ * 40 + 8 * (tid & 3)) = vw; }
                if (tid < 64) WKR[tid] = (bf16)f2bf(sc[256 + tid]);
                if (c > 0 && tid < 256) { const int t_ = tid >> 2; const int row = seq_row(b, dir, (c - 1) * 64 + t_);
                    *(GAS u32x4*)(HS + ((size_t)dir * NTOK + row) * 1024 + h * 128 + vs * 32 + 8 * (tid & 3)) = *(const LAS u32x4*)(HO + t_ * 40 + 8 * (tid & 3)); }
                if (c + 1 < NCH) ML_LOAD(c + 1);
                if (w == 7 && c + 1 < NCH) { ML_SCALARS(pb ^ 1); if (c + 2 < NCH) ML_GLOAD(c + 2); }
            }
            __syncthreads();
            {
                const int ti = w >> 1;
#pragma unroll
                for (int jj = 0; jj < 2; ++jj) { const int sj = (w & 1) * 2 + jj; f32x4 acc = {0.f, 0.f, 0.f, 0.f};
                    if (sj <= ti) acc = mm16<128>(acc, QS + 16 * ti * 136, 136, KS + 16 * sj * 136, 136, lane);
                    const int s_ = 16 * sj + r; const float us = sc[s_];
#pragma unroll
                    for (int i = 0; i < 4; ++i) { const int t_ = 16 * ti + 4 * q + i; const float val = (s_ <= t_) ? acc[i] * __expf(us - sc[64 + t_]) : 0.f;
                        const float rs = row16_sum(val); if (r == 0) sdenp[sj * 64 + t_] = rs;
                        SS[t_ * 72 + s_] = (bf16)f2bf(val); } }
            }
            __syncthreads();
            float wprev;
            {
                const int ti = w >> 1, vj = w & 1; f32x4 a1 = {0.f, 0.f, 0.f, 0.f}, a2 = a1, a3 = a1;
#pragma unroll
                for (int kk = 0; kk < 2; ++kk) a1 = __builtin_amdgcn_mfma_f32_16x16x32_bf16(row_frag(SS + 16 * ti * 72, 72, 32 * kk, lane), tr_frag(VS, 40, 32 * kk, 16 * vj, lane), a1, 0, 0, 0);
                a2 = mm16<128>(a2, QS + 16 * ti * 136, 136, CS + 16 * vj * 136, 136, lane);
                a3 = mm16<128>(a3, QS + 16 * ti * 136, 136, CS + 32 * 136, 136, lane);
#pragma unroll
                for (int i = 0; i < 4; ++i) { const int t_ = 16 * ti + 4 * q + i; const float wi = sc[128 + t_]; const float nq = row16_sum(a3[i]);
                    const float num = a1[i] + wi * a2[i], den = ((sdenp[t_] + sdenp[64 + t_]) + (sdenp[128 + t_] + sdenp[192 + t_])) + wi * nq;
                    HO[t_ * 40 + 16 * vj + r] = (bf16)f2bf(num / fmaxf(fabsf(den), sc[192 + t_])); }
                wprev = sc[320];
            }
            __syncthreads();
            {
                const int vi = w & 1; bf16x8 av[2];
#pragma unroll
                for (int kk = 0; kk < 2; ++kk) av[kk] = tr_frag(VW, 40, 32 * kk, 16 * vi, lane);
#pragma unroll
                for (int jj = 0; jj < 2; ++jj) { const int dj = (w >> 1) * 2 + jj; Cst[jj] = Cst[jj] * wprev;
#pragma unroll
                    for (int kk = 0; kk < 2; ++kk) Cst[jj] = __builtin_amdgcn_mfma_f32_16x16x32_bf16(av[kk], tr_frag(KS, 136, 32 * kk, 16 * dj, lane), Cst[jj], 0, 0, 0);
#pragma unroll
                    for (int i = 0; i < 4; ++i) CS[(16 * vi + 4 * q + i) * 136 + 16 * dj + r] = (bf16)f2bf(Cst[jj][i]); }
                Nst = Nst * wprev;
#pragma unroll
                for (int kk = 0; kk < 2; ++kk) Nst = __builtin_amdgcn_mfma_f32_16x16x32_bf16(row_frag(WKR, 72, 32 * kk, lane), tr_frag(KS, 136, 32 * kk, 16 * w, lane), Nst, 0, 0, 0);
                if (q == 0) CS[32 * 136 + 16 * w + r] = (bf16)f2bf(Nst[0]);
            }
        }
        __syncthreads();
        if (tid < 256) { const int t_ = tid >> 2; const int row = seq_row(b, dir, (NCH - 1) * 64 + t_);
            *(GAS u32x4*)(HS + ((size_t)dir * NTOK + row) * 1024 + h * 128 + vs * 32 + 8 * (tid & 3)) = *(const LAS u32x4*)(HO + t_ * 40 + 8 * (tid & 3)); }
#undef ML_LOAD
#undef ML_GLOAD
#undef ML_SCALARS
    }
}

PHASE_FN void hg_scan_phase(Frame F, const GAS bf16* Q, const GAS bf16* V, const GAS bf16* LF, GAS bf16* HSf, GAS bf16* HSb) {
    LAS bf16* QT = (LAS bf16*)(F.lds + 0); LAS bf16* KTs = (LAS bf16*)(F.lds + 8704); LAS bf16* KH = (LAS bf16*)(F.lds + 17408); LAS bf16* VT = (LAS bf16*)(F.lds + 27648);
    LAS bf16* AS = (LAS bf16*)(F.lds + 30208); LAS bf16* STs = (LAS bf16*)(F.lds + 32768); LAS float* BF = (LAS float*)(F.lds + 41472); LAS float* SBL = (LAS float*)(F.lds + 57856); LAS bf16* QI = (LAS bf16*)(F.lds + 58368);
    const int tid = F.tid, lane = F.lane, w = F.wave, r = lane & 15, q = lane >> 4;
    const int lrow = tid >> 4, lp = tid & 15;
    for (int unit = F.bid; unit < 256; unit += F.G) {
        const int vs = unit & 3, dir = (unit >> 2) & 1, h = (unit >> 3) & 7, b = unit >> 6;
        GAS bf16* HS = dir ? HSb : HSf; const GAS bf16* LFd = LF + (size_t)dir * NTOK * 1024;
        f32x4 Sst[2]; Sst[0] = (f32x4){0.f, 0.f, 0.f, 0.f}; Sst[1] = Sst[0];
        __syncthreads();
        for (int i = tid; i < 32 * 136; i += NTHR) STs[i] = 0;
        u32x4 rq, rl, rv = {0u, 0u, 0u, 0u};
#define HG_LOAD(c) do { const int row_ = seq_row(b, dir, (c) * 32 + lrow); rq = *(const GAS u32x4*)(Q + (size_t)row_ * 1024 + h * 128 + 8 * lp); rl = *(const GAS u32x4*)(LFd + (size_t)row_ * 1024 + h * 128 + 8 * lp); \
            if (tid < 128) { const int vrow_ = seq_row(b, dir, (c) * 32 + (tid >> 2)); rv = *(const GAS u32x4*)(V + (size_t)vrow_ * 1024 + h * 128 + vs * 32 + 8 * (tid & 3)); } } while (0)
        HG_LOAD(0);
        for (int c = 0; c < T / 32; ++c) {
#pragma unroll
            for (int jj = 0; jj < 4; ++jj) { BF[lrow * 128 + 8 * lp + 2 * jj] = bflo(rl[jj]); BF[lrow * 128 + 8 * lp + 2 * jj + 1] = bfhi(rl[jj]); }
            __syncthreads();
            if (tid < 128) { float a = 0.f;
#pragma unroll 8
                for (int t_ = 0; t_ < 32; ++t_) { a += BF[t_ * 128 + tid]; BF[t_ * 128 + tid] = a; }
                SBL[tid] = __expf(a); }
            __syncthreads();
            {
#pragma unroll
                for (int jj = 0; jj < 4; ++jj)
#pragma unroll
                    for (int hh = 0; hh < 2; ++hh) { const int k_ = 8 * lp + 2 * jj + hh; const float bt = BF[lrow * 128 + k_], bl = BF[31 * 128 + k_], br = BF[15 * 128 + k_];
                        const float lf = hh ? bfhi(rl[jj]) : bflo(rl[jj]), qv = hh ? bfhi(rq[jj]) : bflo(rq[jj]); const float key = -expm1f(lf);
                        QT[lrow * 136 + k_] = (bf16)f2bf(qv * __expf(bt - br)); QI[lrow * 136 + k_] = (bf16)f2bf(qv * __expf(bt)); KTs[lrow * 136 + k_] = (bf16)f2bf(key * __expf(br - bt)); KH[k_ * 40 + lrow] = (bf16)f2bf(key * __expf(bl - bt)); }
                if (tid < 128) { const int s_ = tid >> 2;
#pragma unroll
                    for (int jj = 0; jj < 4; ++jj) { const int vv = 8 * (tid & 3) + 2 * jj; VT[vv * 40 + s_] = (bf16)(rv[jj] & 0xffffu); VT[(vv + 1) * 40 + s_] = (bf16)(rv[jj] >> 16); } }
                if (c + 1 < T / 32) HG_LOAD(c + 1);
            }
            __syncthreads();
            if (w < 4) { const int ti = w >> 1, sj = w & 1; f32x4 acc = {0.f, 0.f, 0.f, 0.f};
                if (sj <= ti) acc = mm16<128>(acc, QT + 16 * ti * 136, 136, KTs + 16 * sj * 136, 136, lane);
#pragma unroll
                for (int i = 0; i < 4; ++i) { const int t_ = 16 * ti + 4 * q + i, s_ = 16 * sj + r; AS[t_ * 40 + s_] = (bf16)f2bf(s_ <= t_ ? acc[i] : 0.f); } }
            __syncthreads();
            if (w < 4) { const int ti = w >> 1, vj = w & 1; f32x4 a1 = {0.f, 0.f, 0.f, 0.f}, a2 = a1;
                a1 = mm16<32>(a1, AS + 16 * ti * 40, 40, VT + 16 * vj * 40, 40, lane);
                a2 = mm16<128>(a2, QI + 16 * ti * 136, 136, STs + 16 * vj * 136, 136, lane);
#pragma unroll
                for (int i = 0; i < 4; ++i) { const int t_ = 16 * ti + 4 * q + i; const int row = seq_row(b, dir, c * 32 + t_);
                    HS[(size_t)row * 1024 + h * 128 + vs * 32 + 16 * vj + r] = (bf16)f2bf(a1[i] + a2[i]); } }
            __syncthreads();
            { const int vi = w & 1;
#pragma unroll
              for (int jj = 0; jj < 2; ++jj) { const int kj = (w >> 1) * 2 + jj; Sst[jj] = Sst[jj] * SBL[16 * kj + r];
                  Sst[jj] = mm16<32>(Sst[jj], VT + 16 * vi * 40, 40, KH + 16 * kj * 40, 40, lane);
#pragma unroll
                  for (int i = 0; i < 4; ++i) STs[(16 * vi + 4 * q + i) * 136 + 16 * kj + r] = (bf16)f2bf(Sst[jj][i]); } }
        }
#undef HG_LOAD
    }
}

__device__ __forceinline__ float fmix_lo(float a, unsigned b, float c) { float d; asm("v_fma_mix_f32 %0, %1, %2, %3 op_sel:[0,0,0] op_sel_hi:[0,1,0]" : "=v"(d) : "v"(a), "v"(b), "v"(c)); return d; }
__device__ __forceinline__ float fmix_hi(float a, unsigned b, float c) { float d; asm("v_fma_mix_f32 %0, %1, %2, %3 op_sel:[0,1,0] op_sel_hi:[0,1,0]" : "=v"(d) : "v"(a), "v"(b), "v"(c)); return d; }
__device__ __forceinline__ unsigned pkh2(float lo, float hi) { typedef _Float16 h2_t __attribute__((ext_vector_type(2))); h2_t v; v.x = (_Float16)lo; v.y = (_Float16)hi; return __builtin_bit_cast(unsigned, v); }
constexpr int RW_STEPB = 896;
template <int PROBE> PHASE_FN void rw_scan_phase(Frame F, const GAS bf16* Rr, const GAS bf16* Kk, const GAS bf16* Vv, const GAS bf16* WH, const GAS bf16* AH, GAS bf16* O  , GAS float* BETA  ) {
    LAS bf16* W2T = (LAS bf16*)(F.lds + 0); LAS bf16* A2T = (LAS bf16*)(F.lds + 9216);
    LAS bf16* WHS = (LAS bf16*)(F.lds + 18432); LAS bf16* AHS = (LAS bf16*)(F.lds + 27648);
    LAS float* WP = (LAS float*)(F.lds + 36864); LAS float* AP = (LAS float*)(F.lds + 45056);
    LAS unsigned char* STEP = F.lds + 53248;
    LAS float* SO = (LAS float*)(F.lds + 110592);
    LAS float* SVEC = (LAS float*)(F.lds + 118784);
    const int tid = F.tid, lane = F.lane, w = F.wave, t16 = tid >> 4, cg = tid & 15, kc = cg * 4;
    for (int unit = F.bid; unit < 256; unit += F.G) {
        const int half = unit & 1, dir = (unit >> 1) & 1, h = (unit >> 2) & 15, b = unit >> 6;
        __syncthreads();
        for (int i = tid; i < 4096; i += NTHR) { const int l = i >> 6, jn = i & 63; W2T[jn * 72 + l] = (bf16)f2bf(INP(IN_RW_W2)[((size_t)(dir * 64 + l)) * 1024 + h * 64 + jn]); A2T[jn * 72 + l] = (bf16)f2bf(INP(IN_RW_A2)[((size_t)(dir * 64 + l)) * 1024 + h * 64 + jn]); }
        if (tid < 64) { SVEC[tid] = INP(IN_RW_W0)[dir * 1024 + h * 64 + tid]; SVEC[64 + tid] = INP(IN_RW_A0)[dir * 1024 + h * 64 + tid]; SVEC[128 + tid] = INP(IN_RW_KK)[h * 64 + tid];
            SVEC[192 + tid] = INP(IN_RW_KA)[h * 64 + tid]; SVEC[256 + tid] = INP(IN_RW_RK)[h * 64 + tid]; }
        float S0 = 0.f, S1 = 0.f, S2 = 0.f, S3 = 0.f;
        u32x2 rr, rk, rwh, rah; unsigned rv;
#define RW_LOAD_RKV(c) do { const size_t row_ = (size_t)seq_row(b, dir, (c) * 32 + t16); rr = *(const GAS u32x2*)(Rr + row_ * 1024 + h * 64 + kc); rk = *(const GAS u32x2*)(Kk + row_ * 1024 + h * 64 + kc); \
            rv = *(const GAS unsigned*)(Vv + row_ * 1024 + h * 64 + half * 32 + 2 * cg); } while (0)
#define RW_LOAD_H(c) do { const size_t row_ = (size_t)seq_row(b, dir, (c) * 32 + t16); rwh = *(const GAS u32x2*)(WH + row_ * 128 + dir * 64 + kc); rah = *(const GAS u32x2*)(AH + row_ * 128 + dir * 64 + kc); } while (0)
        RW_LOAD_H(0); RW_LOAD_RKV(0);
        *(LAS u32x2*)(WHS + t16 * 72 + kc) = rwh; *(LAS u32x2*)(AHS + t16 * 72 + kc) = rah;
        RW_LOAD_H(1);
        __syncthreads();
        constexpr int NCH = T / 32;
        for (int c = 0; c < NCH; ++c) {
            const int pb = c & 1;
            if (!(PROBE & 2)) {   const LAS bf16* As = ((w < 4) ? WHS : AHS) + pb * (32 * 72); const LAS bf16* Bs = (w < 4) ? W2T : A2T; LAS float* Cd = (w < 4) ? WP : AP;
                const int tt = w & 1, r = lane & 15, q = lane >> 4;
#pragma unroll
                for (int jj = 0; jj < 2; ++jj) { const int kt = ((w >> 1) & 1) * 2 + jj; f32x4 acc = {0.f, 0.f, 0.f, 0.f};
                    acc = mm16<64>(acc, As + 16 * tt * 72, 72, Bs + 16 * kt * 72, 72, lane);
#pragma unroll
                    for (int i = 0; i < 4; ++i) Cd[(16 * tt + 4 * q + i) * 64 + 16 * kt + r] = acc[i]; } }
            __syncthreads();
            if (!(PROBE & 2)) {
                if (c > 0) { const size_t row_ = (size_t)seq_row(b, dir, (c - 1) * 32 + t16); const LAS float* so = SO + (pb ^ 1) * 1024 + t16 * 32 + 2 * cg;
                    *(GAS unsigned*)(O + ((size_t)dir * NTOK + row_) * 1024 + h * 64 + half * 32 + 2 * cg) = pk2(so[0], so[1]); }
                const f32x4 wp = *(const LAS f32x4*)(SVEC + kc) + *(const LAS f32x4*)(WP + t16 * 64 + kc), ap = *(const LAS f32x4*)(SVEC + 64 + kc) + *(const LAS f32x4*)(AP + t16 * 64 + kc);
                const f32x4 kkw = *(const LAS f32x4*)(SVEC + 128 + kc), kaw = *(const LAS f32x4*)(SVEC + 192 + kc), rkw = *(const LAS f32x4*)(SVEC + 256 + kc);
                f32x4 kv, rv4, now, av, kx; kv[0] = bflo(rk.x); kv[1] = bfhi(rk.x); kv[2] = bflo(rk.y); kv[3] = bfhi(rk.y); rv4[0] = bflo(rr.x); rv4[1] = bfhi(rr.x); rv4[2] = bflo(rr.y); rv4[3] = bfhi(rr.y);
                float ssq = 0.f, bet = 0.f;
#pragma unroll
                for (int jn = 0; jn < 4; ++jn) { now[jn] = expm1f(-0.6065306597126334f * sigmoid_f(wp[jn])); av[jn] = sigmoid_f(ap[jn]); kx[jn] = kv[jn] * kkw[jn]; ssq += kx[jn] * kx[jn]; }
                ssq = row16_sum(ssq); const float rn = 1.0f / sqrtf(fmaxf(ssq, 1e-24f));
                f32x4 nkk, akk, kd;
#pragma unroll
                for (int jn = 0; jn < 4; ++jn) { const float kkn = kx[jn] * rn; nkk[jn] = -kkn; akk[jn] = kkn * av[jn]; kd[jn] = kv[jn] * (1.0f + (av[jn] - 1.0f) * kaw[jn]); bet += rv4[jn] * kd[jn] * rkw[jn]; }
                bet = row16_sum(bet);
                LAS unsigned char* sp = STEP + pb * (32 * RW_STEPB) + t16 * RW_STEPB;
                u32x4 p0, p1; u32x2 p2;
                p0[0] = pkh2(now[0], now[1]); p0[1] = pkh2(now[2], now[3]); p0[2] = pkh2(nkk[0], nkk[1]); p0[3] = pkh2(nkk[2], nkk[3]);
                p1[0] = pkh2(akk[0], akk[1]); p1[1] = pkh2(akk[2], akk[3]); p1[2] = pkh2(kd[0], kd[1]); p1[3] = pkh2(kd[2], kd[3]);
                p2[0] = pkh2(rv4[0], rv4[1]); p2[1] = pkh2(rv4[2], rv4[3]);
                *(LAS u32x4*)(sp + cg * 48) = p0; *(LAS u32x4*)(sp + cg * 48 + 16) = p1; *(LAS u32x2*)(sp + cg * 48 + 32) = p2;
                { typedef float f32x2_t __attribute__((ext_vector_type(2))); f32x2_t v2; v2.x = bflo(rv); v2.y = bfhi(rv); *(LAS f32x2_t*)(sp + 768 + 8 * cg) = v2; }
                if (cg == 0 && half == 0) BETA[((size_t)dir * NTOK + seq_row(b, dir, c * 32 + t16)) * 16 + h] = bet;
                if (c + 1 < NCH) { *(LAS u32x2*)(WHS + (pb ^ 1) * (32 * 72) + t16 * 72 + kc) = rwh; *(LAS u32x2*)(AHS + (pb ^ 1) * (32 * 72) + t16 * 72 + kc) = rah; RW_LOAD_RKV(c + 1); }
                if (c + 2 < NCH) RW_LOAD_H(c + 2);
            }
            __syncthreads();
            if (!(PROBE & 1)) {
                const LAS unsigned char* sp = STEP + pb * (32 * RW_STEPB) + cg * 48; const LAS unsigned char* vp = STEP + pb * (32 * RW_STEPB) + 768 + 4 * t16; LAS float* so = SO + pb * 1024 + t16;
                u32x4 a0 = *(const LAS u32x4*)sp, a1 = *(const LAS u32x4*)(sp + 16); u32x2 a2 = *(const LAS u32x2*)(sp + 32); float vv = *(const LAS float*)vp;
#pragma unroll 2
                for (int t_ = 0; t_ < 32; ++t_) {
                    const int tn = (t_ + 1) & 31;
                    const u32x4 n0 = *(const LAS u32x4*)(sp + tn * RW_STEPB), n1 = *(const LAS u32x4*)(sp + tn * RW_STEPB + 16); const u32x2 n2 = *(const LAS u32x2*)(sp + tn * RW_STEPB + 32); const float vn = *(const LAS float*)(vp + tn * RW_STEPB);
                    float sa = fmix_hi(S1, a0[2], fmix_lo(S0, a0[2], 0.f)), sb = fmix_hi(S3, a0[3], fmix_lo(S2, a0[3], 0.f));
                    float e0 = fmix_lo(vv, a1[2], S0), e1 = fmix_hi(vv, a1[2], S1), e2 = fmix_lo(vv, a1[3], S2), e3 = fmix_hi(vv, a1[3], S3);
                    sa = row16_sum(sa + sb);
                    e0 = fmix_lo(sa, a1[0], e0); e1 = fmix_hi(sa, a1[0], e1); e2 = fmix_lo(sa, a1[1], e2); e3 = fmix_hi(sa, a1[1], e3);
                    S0 = fmix_lo(S0, a0[0], e0); S1 = fmix_hi(S1, a0[0], e1); S2 = fmix_lo(S2, a0[1], e2); S3 = fmix_hi(S3, a0[1], e3);
                    float o = fmix_hi(S1, a2[0], fmix_lo(S0, a2[0], 0.f)) + fmix_hi(S3, a2[1], fmix_lo(S2, a2[1], 0.f));
                    o = row16_sum(o);
                    if (cg == 0) so[t_ * 32] = o;
                    a0 = n0; a1 = n1; a2 = n2; vv = vn;
                }
            }
        }
        __syncthreads();
        { const size_t row_ = (size_t)seq_row(b, dir, (NCH - 1) * 32 + t16); const LAS float* so = SO + ((NCH - 1) & 1) * 1024 + t16 * 32 + 2 * cg;
          *(GAS unsigned*)(O + ((size_t)dir * NTOK + row_) * 1024 + h * 64 + half * 32 + 2 * cg) = pk2(so[0], so[1]); }
#undef RW_LOAD_RKV
#undef RW_LOAD_H
    }
}

PHASE_FN void gemm_mlin(Frame F, int jl) { GAS unsigned char* MIX = F.ws + WS_MIX; GAS unsigned char* HY = F.ws + WS_HY;
    pg8::Gemm g{(const GAS bf16*)HY, (const GAS bf16*)(F.W + W_ML_WIN + jl * W_ML_WIN_SZ), NTOK, 4352, 1024}; pg8::StaticOrder So; So.init(NTOK, 4352, F.G, F.bid);
    pg8::EpiMlstmIn E{(GAS bf16*)MIX, (GAS bf16*)(MIX + 2 * ROWB), (GAS bf16*)(MIX + 3 * ROWB), (GAS float*)(MIX + 4 * ROWB), INP(IN_ML_BGATE) + jl * 32};
    pg8::gemm_phase<pg8::EpiMlstmIn, pg8::StaticOrder, GEMM_ALIGN, GEMM_SP2>(F.lds, g, So, E); }
PHASE_FN void gemm_resid(Frame F, const GAS bf16* A, const GAS bf16* Bt, int L) {
    pg8::Gemm g{A, Bt, NTOK, 1024, 1024}; pg8::StaticOrder So; So.init(NTOK, 1024, F.G, F.bid);
    pg8::EpiResid E{(GAS float*)(F.ws + WS_S), (const GAS float*)(F.ws + WS_MOD) + (size_t)L * 5 * 6144, 2}; pg8::gemm_phase<pg8::EpiResid, pg8::StaticOrder, GEMM_ALIGN, GEMM_SP2>(F.lds, g, So, E); }
PHASE_FN void gemm_rwin(Frame F) { GAS unsigned char* MIX = F.ws + WS_MIX; GAS unsigned char* HY = F.ws + WS_HY;
    GAS bf16* Rb = (GAS bf16*)MIX; GAS bf16* Kb = (GAS bf16*)(MIX + ROWB); GAS bf16* Vb = (GAS bf16*)(MIX + 2 * ROWB); GAS float* WH = (GAS float*)(MIX + 3 * ROWB); GAS float* AH = WH + (size_t)NTOK * 128; GAS bf16* GH = (GAS bf16*)(AH + (size_t)NTOK * 128);
    pg8::Gemm g{(const GAS bf16*)HY, (const GAS bf16*)(F.W + W_RW_IN), NTOK, 3584, 2048}; pg8::StaticOrder So; So.init(NTOK, 3584, F.G, F.bid);
    pg8::EpiRwkvIn E{Rb, Kb, Vb, WH, AH, GH}; pg8::gemm_phase<pg8::EpiRwkvIn, pg8::StaticOrder, GEMM_ALIGN, GEMM_SP2>(F.lds, g, So, E); }
PHASE_FN void gemm_rwg(Frame F) { GAS unsigned char* MIX = F.ws + WS_MIX;
    GAS float* WH = (GAS float*)(MIX + 3 * ROWB); GAS float* AH = WH + (size_t)NTOK * 128; GAS bf16* GH = (GAS bf16*)(AH + (size_t)NTOK * 128);
    pg8::Gemm g{GH, (const GAS bf16*)(F.W + W_RW_G2), NTOK, 1024, 256}; pg8::StaticOrder So; So.init(NTOK, 1024, F.G, F.bid);
    pg8::EpiBf16Plain E{(GAS bf16*)MIX, 1024}; pg8::gemm_phase<pg8::EpiBf16Plain, pg8::StaticOrder, GEMM_ALIGN, GEMM_SP2>(F.lds, g, So, E); }
PHASE_FN void gemm_hgin(Frame F) { GAS unsigned char* MIX = F.ws + WS_MIX; GAS unsigned char* HY = F.ws + WS_HY;
    pg8::Gemm g{(const GAS bf16*)HY, (const GAS bf16*)(F.W + W_HG_IN), NTOK, 5120, 1024}; pg8::StaticOrder So; So.init(NTOK, 5120, F.G, F.bid);
    pg8::EpiHgrnIn E{(GAS bf16*)MIX, (GAS bf16*)(MIX + ROWB), (GAS bf16*)(MIX + 2 * ROWB), (GAS bf16*)(MIX + 3 * ROWB), (size_t)NTOK * 1024, INP(IN_HG_BF), (const GAS float*)(F.ws + WS_LB)};
    pg8::gemm_phase<pg8::EpiHgrnIn, pg8::StaticOrder, GEMM_ALIGN, GEMM_SP2>(F.lds, g, So, E); }
PHASE_FN void gemm_moe1(Frame F, int L) { GAS unsigned char* MIX = F.ws + WS_MIX; LAS int* pref = (LAS int*)(F.lds + LDS_PHASE_BYTES); moe_prefix(F, L, pref, pref + 32);
    pg8::Gemm g{(const GAS bf16*)MIX, (const GAS bf16*)(F.W + W_EX13), NSLOT, 16384, 1024}; pg8::MoeOrder So{pref, F.G, F.bid};
    pg8::EpiMoe1 E{(GAS bf16*)(MIX + 140 * MiB)}; pg8::gemm_phase<pg8::EpiMoe1, pg8::MoeOrder, GEMM_ALIGN, GEMM_SP2>(F.lds, g, So, E); }
PHASE_FN void gemm_moe2(Frame F, int L) { GAS unsigned char* MIX = F.ws + WS_MIX; LAS int* pref = (LAS int*)(F.lds + LDS_PHASE_BYTES); moe_prefix(F, L, pref, pref + 32);
    pg8::Gemm g{(const GAS bf16*)(MIX + 140 * MiB), (const GAS bf16*)(F.W + W_EX2), NSLOT, 16384, 512}; pg8::MoeOrder So{pref, F.G, F.bid};
    pg8::EpiMoe2 E{(GAS bf16*)(MIX + 210 * MiB), (const GAS int*)(F.ws + WS_SLOT_TOK), (const GAS float*)(F.ws + WS_SLOT_GATE)};
    pg8::gemm_phase<pg8::EpiMoe2, pg8::MoeOrder, GEMM_ALIGN, GEMM_SP2>(F.lds, g, So, E); }

constexpr int PH_PER_LAYER = 12, PH_LAYER0 = 2, PH_FINAL = PH_LAYER0 + DEPTH * PH_PER_LAYER, N_PHASES = PH_FINAL + 1;
__global__ void __launch_bounds__(NTHR, 2) fwd_kernel(Args args) {
    extern __shared__ __attribute__((aligned(16))) unsigned char lds_raw[];
    Frame F;
    F.lds = (LAS unsigned char*)lds_raw; F.out = (GAS float*)args.out; F.ws = (GAS unsigned char*)args.ws; F.W = (GAS unsigned char*)args.wts;
    F.tid = threadIdx.x; F.lane = F.tid & 63; F.wave = __builtin_amdgcn_readfirstlane(F.tid >> 6); F.bid = blockIdx.x; F.G = gridDim.x;
    volatile LAS unsigned* MISC = (volatile LAS unsigned*)(F.lds + MISC_OFF);
    if (F.tid < 32) MISC[F.tid] = 0u;
    if (F.tid < 42) ((LAS unsigned long long*)(F.lds + PTAB_OFF))[F.tid] = (unsigned long long)args.in[F.tid];
    __syncthreads();
    const int lo = args.ph_lo, hi = args.ph_hi;
    XcdBarrier bar; bar.bar = (unsigned*)args.ws + CW_BAR; bar.x = 0; bar.st = MISC + 8;
    if (hi - lo > 1) bar = xcd_barrier_post((unsigned*)args.ws + CW_BAR, MISC + 8);
#define IN(k) (lo <= (k) && (k) < hi)
#define SEAM(k) do { if ((k) + 1 < hi) xcd_barrier(bar); } while (0)
#ifndef DUP_MASK
#define DUP_MASK 0
#endif
#define DUP(bit, stmt) do { stmt; if ((DUP_MASK >> (bit)) & 1) { xcd_barrier(bar); stmt; } } while (0)

    if (IN(0)) { pre_phase(fresh(F)); SEAM(0); }
    if (IN(1)) { modsum_phase(fresh(F)); SEAM(1); }

    for (int L = 0; L < DEPTH; ++L) {
        const int kind = L % 3, jl = L / 3, pb = PH_LAYER0 + L * PH_PER_LAYER;
        if (IN(pb + 0)) { DUP(6, expert_weights(fresh(F), L)); norm_phase<0>(fresh(F), L, L > 0, kind == 1 ? 2048 : 1024); SEAM(pb + 0); }
        if (kind == 0) {
            if (IN(pb + 2)) { DUP(3, gemm_mlin(fresh(F), jl)); SEAM(pb + 2); }
            if (IN(pb + 3)) { DUP(7, conv_phase(fresh(F), jl)); SEAM(pb + 3); }
            if (IN(pb + 4)) { const Frame Fp = fresh(F); GAS unsigned char* MIX = Fp.ws + WS_MIX; DUP(0, ml_scan_phase(Fp, (const GAS bf16*)(Fp.ws + WS_HY), (const GAS bf16*)(MIX + 2 * ROWB), (const GAS float*)(MIX + 4 * ROWB), (GAS bf16*)MIX)); SEAM(pb + 4); }
            if (IN(pb + 6)) { const Frame Fp = fresh(F); GAS unsigned char* MIX = Fp.ws + WS_MIX;
                headnorm_phase(Fp, (const GAS bf16*)MIX, (const GAS bf16*)(MIX + ROWB), (const GAS bf16*)(MIX + 3 * ROWB), ldptr(Fp, IN_ML_HEADG) + jl * 1024, (GAS bf16*)(Fp.ws + WS_HY + ROWB)); SEAM(pb + 6); }
            if (IN(pb + 7)) { const Frame Fp = fresh(F); gemm_resid(Fp, (const GAS bf16*)(Fp.ws + WS_HY + ROWB), (const GAS bf16*)(Fp.W + W_ML_WOUT + jl * 2 * MiB), L); SEAM(pb + 7); }
        } else if (kind == 1) {
            if (IN(pb + 1)) { du_phase(fresh(F)); SEAM(pb + 1); }
            if (IN(pb + 2)) { DUP(3, gemm_rwin(fresh(F))); SEAM(pb + 2); }
            if (IN(pb + 4)) { const Frame Fp = fresh(F); GAS unsigned char* MIX = Fp.ws + WS_MIX; GAS float* WH = (GAS float*)(MIX + 3 * ROWB); GAS float* AH = WH + (size_t)NTOK * 128; GAS float* BETA = (GAS float*)((GAS bf16*)(AH + (size_t)NTOK * 128) + (size_t)NTOK * 256);

#ifndef RW_PROBE
#define RW_PROBE 0
#endif
                if (RW_PROBE) { rw_scan_phase<RW_PROBE>(Fp, (const GAS bf16*)MIX, (const GAS bf16*)(MIX + ROWB), (const GAS bf16*)(MIX + 2 * ROWB), (const GAS bf16*)WH, (const GAS bf16*)AH, (GAS bf16*)(Fp.ws + WS_HY), BETA); xcd_barrier(bar); }
                DUP(1, rw_scan_phase<0>(Fp, (const GAS bf16*)MIX, (const GAS bf16*)(MIX + ROWB), (const GAS bf16*)(MIX + 2 * ROWB), (const GAS bf16*)WH, (const GAS bf16*)AH, (GAS bf16*)(Fp.ws + WS_HY), BETA)); SEAM(pb + 4); }
            if (IN(pb + 5)) { gemm_rwg(fresh(F)); SEAM(pb + 5); }
            if (IN(pb + 6)) { const Frame Fp = fresh(F); GAS unsigned char* MIX = Fp.ws + WS_MIX; GAS float* WH = (GAS float*)(MIX + 3 * ROWB); GAS float* AH = WH + (size_t)NTOK * 128; GAS float* BETA = (GAS float*)((GAS bf16*)(AH + (size_t)NTOK * 128) + (size_t)NTOK * 256);
                rwpost_phase(Fp, (const GAS bf16*)(Fp.ws + WS_HY), (const GAS bf16*)(Fp.ws + WS_HY + ROWB), BETA, (const GAS bf16*)(MIX + 2 * ROWB), (const GAS bf16*)MIX, (GAS bf16*)(MIX + ROWB)); SEAM(pb + 6); }
            if (IN(pb + 7)) { const Frame Fp = fresh(F); gemm_resid(Fp, (const GAS bf16*)(Fp.ws + WS_MIX + ROWB), (const GAS bf16*)(Fp.W + W_RW_WOUT), L); SEAM(pb + 7); }
        } else {
            if (IN(pb + 2)) { DUP(3, gemm_hgin(fresh(F))); SEAM(pb + 2); }
            if (IN(pb + 4)) { const Frame Fp = fresh(F); GAS unsigned char* MIX = Fp.ws + WS_MIX; DUP(2, hg_scan_phase(Fp, (const GAS bf16*)MIX, (const GAS bf16*)(MIX + ROWB), (const GAS bf16*)(MIX + 3 * ROWB), (GAS bf16*)(Fp.ws + WS_HY + ROWB), (GAS bf16*)(Fp.ws + WS_HY))); SEAM(pb + 4); }
            if (IN(pb + 6)) { const Frame Fp = fresh(F); GAS unsigned char* MIX = Fp.ws + WS_MIX;
                headnorm_phase(Fp, (const GAS bf16*)(Fp.ws + WS_HY + ROWB), (const GAS bf16*)(Fp.ws + WS_HY), (const GAS bf16*)(MIX + 2 * ROWB), ldptr(Fp, IN_HG_HEADG), (GAS bf16*)(Fp.ws + WS_HY + ROWB)); SEAM(pb + 6); }
            if (IN(pb + 7)) { const Frame Fp = fresh(F); gemm_resid(Fp, (const GAS bf16*)(Fp.ws + WS_HY + ROWB), (const GAS bf16*)(Fp.W + W_HG_WOUT), L); SEAM(pb + 7); }
        }
        if (IN(pb + 8)) { norm_phase<1>(fresh(F), L, false, 1024); SEAM(pb + 8); }
        if (IN(pb + 9)) { slots_phase(fresh(F), L); SEAM(pb + 9); }
        if (IN(pb + 10)) { DUP(4, gemm_moe1(fresh(F), L)); SEAM(pb + 10); }
        if (IN(pb + 11)) { DUP(5, gemm_moe2(fresh(F), L)); SEAM(pb + 11); }
    }
    if (IN(PH_FINAL)) norm_phase<2>(fresh(F), 0, true, 1024);
#undef IN
#undef SEAM
}

#ifndef MK_PER_PHASE
#define MK_PER_PHASE 0
#endif
extern "C" void kernel_launch(void* const* d_in, const int* in_sizes, int n_in, void* d_out, int out_size, void* d_ws, size_t ws_size, hipStream_t stream) {
    static int grid = 0;
    if (grid == 0) {
        if (n_in != 42 || out_size != NB * SEQ * D || ws_size < WS_END) { fprintf(stderr, "kernel_launch: unexpected problem (n_in %d, out %d, ws %zu)\n", n_in, out_size, ws_size); grid = -1; return; }
        int dev = 0, cus = 0, per_cu = 0;
        if (hipGetDevice(&dev) != hipSuccess || hipDeviceGetAttribute(&cus, hipDeviceAttributeMultiprocessorCount, dev) != hipSuccess) { grid = -1; return; }
        if (hipFuncSetAttribute((const void*)fwd_kernel, hipFuncAttributeMaxDynamicSharedMemorySize, LDS_BYTES) != hipSuccess) { fprintf(stderr, "kernel_launch: hipFuncSetAttribute failed\n"); grid = -1; return; }
        if (hipOccupancyMaxActiveBlocksPerMultiprocessor(&per_cu, (const void*)fwd_kernel, NTHR, LDS_BYTES) != hipSuccess || per_cu < 1) { fprintf(stderr, "kernel_launch: occupancy query reports %d\n", per_cu); (void)hipGetLastError(); grid = -1; return; }
        grid = cus;
    }
    if (grid < 0) return;
    (void)hipMemsetAsync(d_ws, 0, CTL_ZERO_BYTES, stream);
    Args a{};
    for (int i = 0; i < 42; ++i) a.in[i] = (const float*)d_in[i];
    a.out = (float*)d_out; a.ws = (unsigned char*)d_ws;
    a.wts = (ws_size >= WS_END + W_BYTES) ? (unsigned char*)d_ws + WS_END : (unsigned char*)d_out;
#if MK_PER_PHASE
    for (int p = 0; p < N_PHASES; ++p) { a.ph_lo = p; a.ph_hi = p + 1; hipLaunchKernelGGL(fwd_kernel, dim3(grid), dim3(NTHR), LDS_BYTES, stream, a); }
#else
    a.ph_lo = 0; a.ph_hi = N_PHASES;
    hipLaunchKernelGGL(fwd_kernel, dim3(grid), dim3(NTHR), LDS_BYTES, stream, a);
#endif
}
```

```cpp
#include <hip/hip_runtime.h>
#include <cstdio>
#include <cstdint>

__device__ __forceinline__ float sigmoid_f(float x) { return 1.0f / (1.0f + __expf(-x)); }
__device__ __forceinline__ float silu_f(float x) { return x / (1.0f + __expf(-x)); }
__device__ __forceinline__ float logsigmoid_f(float x) { return fminf(x, 0.f) - log1pf(__expf(-fabsf(x))); }
#define GAS __attribute__((address_space(1)))
namespace pg8 {
#define PG8_LAS __attribute__((address_space(3)))
typedef unsigned short bf16_t;
typedef short bf16x8 __attribute__((ext_vector_type(8)));
typedef float f32x4 __attribute__((ext_vector_type(4)));
typedef unsigned u32x4 __attribute__((ext_vector_type(4)));
constexpr int BM = 256, BK = 64, HALF = 128, HTB = HALF * BK * 2  , STAGE_BYTES = 8 * HTB, NXCD = 8, WGM = 8;

__host__ __device__ __forceinline__ int lds_byte(int r, int c) { const int st = (r >> 4) * 2 + (c >> 5), rr = r & 15, cc = c & 31, ob = rr * 64 + cc * 2; return st * 1024 + (ob ^ (((ob >> 9) & 1) << 5)); }
__host__ __device__ __forceinline__ void stage_rc(int b, int& R, int& C) { const int st = b / 1024, sb = b % 1024, swz = sb ^ (((sb >> 9) & 1) << 5); R = (st >> 1) * 16 + swz / 64; C = (st & 1) * 32 + (swz % 64) / 2; }
__host__ __device__ __forceinline__ int perm32(int rho) { const int n = rho >> 4, i = rho & 15; return 8 * (i >> 2) + 4 * n + (i & 3); }

struct Unit { int pm, pn; };
struct Gemm { const GAS bf16_t* A; const GAS bf16_t* Bt; int M, N, K; };

struct StaticOrder {
    int nM, nN, nwg, G, c;
    __host__ __device__ void init(int M, int N, int G_, int c_) { nM = M / BM; nN = N / BM; nwg = nM * nN; G = G_; c = c_; }
    __host__ __device__ bool next(int i, Unit& u) const {
        const long L = (long)i * G + c; if (L >= nwg) return false;
        int wgid = (int)L; { const int q = nwg / NXCD, r = nwg % NXCD, xcd = wgid % NXCD, off = wgid / NXCD; wgid = (xcd < r ? xcd * (q + 1) : r * (q + 1) + (xcd - r) * q) + off; }
        const int nig = WGM * nN, gid = wgid / nig, fm = gid * WGM, gsz = (nM - fm) < WGM ? (nM - fm) : WGM;
        u.pm = fm + ((wgid % nig) % gsz); u.pn = (wgid % nig) / gsz; return true;
    }
    __device__ __forceinline__ void a_ready(const Unit&) const {}
    __device__ __forceinline__ void done(const Unit&) const {}
};
__device__ __forceinline__ unsigned cvt_pk_bf16(float lo, float hi) { unsigned r; asm volatile("v_cvt_pk_bf16_f32 %0, %1, %2" : "=v"(r) : "v"(lo), "v"(hi)); return r; }
typedef unsigned u32x2 __attribute__((ext_vector_type(2)));
__device__ __forceinline__ void st8(GAS bf16_t* p, f32x4 v0, f32x4 v1) { u32x4 w; w.x = cvt_pk_bf16(v0[0], v0[1]); w.y = cvt_pk_bf16(v0[2], v0[3]); w.z = cvt_pk_bf16(v1[0], v1[1]); w.w = cvt_pk_bf16(v1[2], v1[3]); *(GAS u32x4*)p = w; }
template <int ACT> __device__ __forceinline__ f32x4 act4(f32x4 v) {
    if (ACT == 1) { v[0] = sigmoid_f(v[0]); v[1] = sigmoid_f(v[1]); v[2] = sigmoid_f(v[2]); v[3] = sigmoid_f(v[3]); }
    if (ACT == 2) { v[0] = silu_f(v[0]); v[1] = silu_f(v[1]); v[2] = silu_f(v[2]); v[3] = silu_f(v[3]); }
    return v; }
template <int ACT> __device__ __forceinline__ void store_tile_bf16(const f32x4 (&acc)[2][2][4][2], GAS bf16_t* base, int ld, int row0, int cw) {
#pragma unroll
    for (int ai = 0; ai < 2; ++ai)
#pragma unroll
        for (int m = 0; m < 4; ++m) { GAS bf16_t* rp = base + (size_t)(row0 + ai * HALF + m * 16) * ld + cw;
#pragma unroll
            for (int bj = 0; bj < 2; ++bj) st8(rp + bj * HALF, act4<ACT>(acc[ai][bj][m][0]), act4<ACT>(acc[ai][bj][m][1])); }
}
struct EpiBf16Plain { static constexpr bool PERM = true, AFTER_DRAIN = false; GAS bf16_t* O; int ldc;
    __device__ __forceinline__ void operator()(const f32x4 (&acc)[2][2][4][2], const Unit& u, int wr, int wc, int fr, int fq) const {
        store_tile_bf16<0>(acc, O + u.pn * BM, ldc, u.pm * BM + wr * 64 + fr, wc * 32 + 8 * fq); }
};
struct EpiMlstmIn { static constexpr bool PERM = true, AFTER_DRAIN = false;
    GAS bf16_t* QKPRE; GAS bf16_t* V; GAS bf16_t* OG; GAS float* GATES; const GAS float* bgate;
    __device__ __forceinline__ void operator()(const f32x4 (&acc)[2][2][4][2], const Unit& u, int wr, int wc, int fr, int fq) const {
        const int row0 = u.pm * BM + wr * 64 + fr, cw = wc * 32 + 8 * fq;
        if (u.pn < 8) store_tile_bf16<0>(acc, QKPRE + u.pn * BM, 2048, row0, cw);
        else if (u.pn < 12) store_tile_bf16<0>(acc, V + (u.pn - 8) * BM, 1024, row0, cw);
        else if (u.pn < 16) store_tile_bf16<1>(acc, OG + (u.pn - 12) * BM, 1024, row0, cw);
        else if (wc == 0) {
            const f32x4 b0 = *(const GAS f32x4*)(bgate + 8 * fq), b1 = *(const GAS f32x4*)(bgate + 8 * fq + 4);
#pragma unroll
            for (int ai = 0; ai < 2; ++ai)
#pragma unroll
                for (int m = 0; m < 4; ++m) { GAS float* gp = GATES + (size_t)(row0 + ai * HALF + m * 16) * 32 + 8 * fq;
                    *(GAS f32x4*)gp = acc[ai][0][m][0] + b0; *(GAS f32x4*)(gp + 4) = acc[ai][0][m][1] + b1; }
        }
    }
};
struct EpiRwkvIn { static constexpr bool PERM = true, AFTER_DRAIN = false;
    GAS bf16_t* R; GAS bf16_t* Kk; GAS bf16_t* V; GAS float* WH; GAS float* AH; GAS bf16_t* GH;
    __device__ __forceinline__ void operator()(const f32x4 (&acc)[2][2][4][2], const Unit& u, int wr, int wc, int fr, int fq) const {
        const int row0 = u.pm * BM + wr * 64 + fr, cw = wc * 32 + 8 * fq;
        if (u.pn < 4) store_tile_bf16<0>(acc, R + u.pn * BM, 1024, row0, cw);
        else if (u.pn < 8) store_tile_bf16<0>(acc, Kk + (u.pn - 4) * BM, 1024, row0, cw);
        else if (u.pn < 12) store_tile_bf16<0>(acc, V + (u.pn - 8) * BM, 1024, row0, cw);
        else if (u.pn == 12) {
#pragma unroll
            for (int ai = 0; ai < 2; ++ai)
#pragma unroll
                for (int m = 0; m < 4; ++m) { const size_t r = (size_t)(row0 + ai * HALF + m * 16);
                    f32x4 t0 = acc[ai][0][m][0], t1 = acc[ai][0][m][1];
#pragma unroll
                    for (int j = 0; j < 4; ++j) { t0[j] = tanhf(t0[j]); t1[j] = tanhf(t1[j]); }
                    st8((GAS bf16_t*)WH + r * 128 + cw, t0, t1); st8((GAS bf16_t*)AH + r * 128 + cw, acc[ai][1][m][0], acc[ai][1][m][1]); }
        } else {
#pragma unroll
            for (int ai = 0; ai < 2; ++ai)
#pragma unroll
                for (int m = 0; m < 4; ++m) { GAS bf16_t* rp = GH + (size_t)(row0 + ai * HALF + m * 16) * 256 + cw;
                    st8(rp, act4<1>(acc[ai][0][m][0]), act4<1>(acc[ai][0][m][1])); *(GAS u32x4*)(rp + HALF) = (u32x4){0u, 0u, 0u, 0u}; }
        }
    }
};
struct EpiHgrnIn { static constexpr bool PERM = true, AFTER_DRAIN = false;
    GAS bf16_t* Q; GAS bf16_t* V; GAS bf16_t* OG; GAS bf16_t* LF; size_t lf_stride; const GAS float* bf; const GAS float* lb;
    __device__ __forceinline__ void operator()(const f32x4 (&acc)[2][2][4][2], const Unit& u, int wr, int wc, int fr, int fq) const {
        const int row0 = u.pm * BM + wr * 64 + fr, cw = wc * 32 + 8 * fq;
        if (u.pn < 4) store_tile_bf16<2>(acc, Q + u.pn * BM, 1024, row0, cw);
        else if (u.pn < 8) store_tile_bf16<0>(acc, V + (u.pn - 4) * BM, 1024, row0, cw);
        else if (u.pn < 12) store_tile_bf16<2>(acc, OG + (u.pn - 8) * BM, 1024, row0, cw);
        else {
            const int dir = (u.pn - 12) >> 2, ct = ((u.pn - 12) & 3) * BM; GAS bf16_t* base = LF + (size_t)dir * lf_stride + ct;
            f32x4 bb[2][2], ll[2][2];
#pragma unroll
            for (int bj = 0; bj < 2; ++bj)
#pragma unroll
                for (int n = 0; n < 2; ++n) { bb[bj][n] = *(const GAS f32x4*)(bf + dir * 1024 + ct + bj * HALF + cw + 4 * n); ll[bj][n] = *(const GAS f32x4*)(lb + ct + bj * HALF + cw + 4 * n); }
#pragma unroll
            for (int ai = 0; ai < 2; ++ai)
#pragma unroll
                for (int m = 0; m < 4; ++m) { GAS bf16_t* rp = base + (size_t)(row0 + ai * HALF + m * 16) * 1024 + cw;
#pragma unroll
                    for (int bj = 0; bj < 2; ++bj) { f32x4 o[2];
#pragma unroll
                        for (int n = 0; n < 2; ++n)
#pragma unroll
                            for (int j = 0; j < 4; ++j) { const float l = ll[bj][n][j]; o[n][j] = __logf(l + (1.f - l) * sigmoid_f(acc[ai][bj][m][n][j] + bb[bj][n][j])); }
                        st8(rp + bj * HALF, o[0], o[1]); } }
        }
    }
};
struct EpiResid { static constexpr bool PERM = false, AFTER_DRAIN = false;
    GAS float* S; const GAS float* mod; int gate_idx;
    __device__ __forceinline__ void operator()(const f32x4 (&acc)[2][2][4][2], const Unit& u, int wr, int wc, int fr, int fq) const {
        const int b = u.pm / 33, seg = (u.pm - b * 33 == 0) ? 0 : 1 + b;
        const int row0 = u.pm * BM + wr * 64 + fr, col0 = u.pn * BM + wc * 32 + 4 * fq;
        const GAS float* gp = mod + seg * 6144 + gate_idx * 1024 + col0;
        f32x4 gv[2][2];
#pragma unroll
        for (int bj = 0; bj < 2; ++bj)
#pragma unroll
            for (int n = 0; n < 2; ++n) gv[bj][n] = *(const GAS f32x4*)(gp + bj * HALF + n * 16);
#pragma unroll
        for (int ai = 0; ai < 2; ++ai)
#pragma unroll
            for (int m = 0; m < 4; ++m) { GAS float* rowp = S + (size_t)(row0 + ai * HALF + m * 16) * 1024 + col0;
#pragma unroll
                for (int bj = 0; bj < 2; ++bj)
#pragma unroll
                    for (int n = 0; n < 2; ++n) { GAS f32x4* p = (GAS f32x4*)(rowp + bj * HALF + n * 16); *p = *p + acc[ai][bj][m][n] * gv[bj][n]; } }
    }
};
struct EpiMoe1 { static constexpr bool PERM = true, AFTER_DRAIN = false; GAS bf16_t* ACT;
    __device__ __forceinline__ void operator()(const f32x4 (&acc)[2][2][4][2], const Unit& u, int wr, int wc, int fr, int fq) const {
        const int row0 = u.pm * BM + wr * 64 + fr, pnl = u.pn & 3, c0 = pnl * 128 + wc * 16 + 4 * fq;
#pragma unroll
        for (int ai = 0; ai < 2; ++ai)
#pragma unroll
            for (int m = 0; m < 4; ++m) { GAS bf16_t* rp = ACT + (size_t)(row0 + ai * HALF + m * 16) * 512 + c0;
#pragma unroll
                for (int bj = 0; bj < 2; ++bj) { const f32x4 a = acc[ai][bj][m][0], b = acc[ai][bj][m][1];
                    u32x2 w; w.x = cvt_pk_bf16(silu_f(a[0]) * b[0], silu_f(a[1]) * b[1]); w.y = cvt_pk_bf16(silu_f(a[2]) * b[2], silu_f(a[3]) * b[3]);
                    *(GAS u32x2*)(rp + bj * 64) = w; } }
    }
};
struct EpiMoe2 { static constexpr bool PERM = true, AFTER_DRAIN = false; GAS bf16_t* YM; const GAS int* slot_tok; const GAS float* slot_gate;
    __device__ __forceinline__ void operator()(const f32x4 (&acc)[2][2][4][2], const Unit& u, int wr, int wc, int fr, int fq) const {
        const int row0 = u.pm * BM + wr * 64 + fr, col0 = (u.pn & 3) * BM + wc * 32 + 8 * fq;
#pragma unroll
        for (int ai = 0; ai < 2; ++ai)
#pragma unroll
            for (int m = 0; m < 4; ++m) { const int slot = row0 + ai * HALF + m * 16; const int dst = slot_tok[slot]; const float g = slot_gate[slot];
                if (dst >= 0) { GAS bf16_t* rp = YM + (size_t)dst * 1024 + col0;
#pragma unroll
                    for (int bj = 0; bj < 2; ++bj) st8(rp + bj * HALF, acc[ai][bj][m][0] * g, acc[ai][bj][m][1] * g); } }
    }
};
struct MoeOrder { const PG8_LAS int* pref; int G, c;
    __device__ __forceinline__ bool next(int i, Unit& u) const {
        const int L = i * G + c, nt = pref[16]; if (L >= nt * 4) return false;
        const int tile = L >> 2; int e = 0;
#pragma unroll
        for (int j = 1; j < 16; ++j) e += (tile >= pref[j]) ? 1 : 0;
        u.pm = tile; u.pn = e * 4 + (L & 3); return true; }
    __device__ __forceinline__ void a_ready(const Unit&) const {}
    __device__ __forceinline__ void done(const Unit&) const {}
};
template <class Epi, class Sched, bool ALIGN_EPI = false, bool SP2 = false>
__device__ __forceinline__ void gemm_phase(PG8_LAS unsigned char* lds, const Gemm g, const Sched& S, const Epi& E) {
    int tid_ = threadIdx.x; asm volatile("" : "+v"(tid_));
    const int tid = tid_, wid = __builtin_amdgcn_readfirstlane(tid >> 6), lane = tid & 63, wr = wid >> 2, wc = wid & 3, fr = lane & 15, fq = lane >> 4;
    const int K = g.K, nt = K / BK;
    unsigned voffA[2], voffB[2];
#pragma unroll
    for (int i = 0; i < 2; ++i) { int R, C; stage_rc(tid * 16 + i * 8192, R, C); const int Rb = Epi::PERM ? ((R & ~31) + perm32(R & 31)) : R;
        voffA[i] = (unsigned)(R * K + C) * 2u; voffB[i] = (unsigned)(Rb * K + C) * 2u; }
    const size_t kstep = (size_t)(BK * 2);
    const size_t hstep = (size_t)HALF * K * 2;
    const size_t tstep = 2 * hstep;
    const unsigned ldsw = (unsigned)wid * 1024u;
    const int aoff = lds_byte(wr * 64 + fr, fq * 8), boff = lds_byte(wc * 32 + fr, fq * 8);
#define PG8_SA(b, h) (((b) * 2 + (h)) * HTB)
#define PG8_SB(b, h) ((4 + (b) * 2 + (h)) * HTB)
#define PG8_STAGE(bufoff, gbase, voff) do { _Pragma("unroll") for (int _i = 0; _i < 2; ++_i) \
        __builtin_amdgcn_global_load_lds((const unsigned*)((const char*)(gbase) + (voff)[_i]), (PG8_LAS unsigned*)(lds + (bufoff) + ldsw + _i * 8192), 16, 0, 0); } while (0)
#define PG8_LDA(dst, b, h) do { _Pragma("unroll") for (int m = 0; m < 4; ++m) _Pragma("unroll") for (int k = 0; k < 2; ++k) dst[m][k] = *(const PG8_LAS bf16x8*)(lds + PG8_SA(b, h) + aoff + m * 2048 + k * 1024); } while (0)
#define PG8_LDB(dst, b, h) do { _Pragma("unroll") for (int n = 0; n < 2; ++n) _Pragma("unroll") for (int k = 0; k < 2; ++k) dst[n][k] = *(const PG8_LAS bf16x8*)(lds + PG8_SB(b, h) + boff + n * 2048 + k * 1024); } while (0)
#define PG8_MMA(ai, bj, At, Bt) do { __builtin_amdgcn_s_setprio(1); _Pragma("unroll") for (int m = 0; m < 4; ++m) _Pragma("unroll") for (int n = 0; n < 2; ++n) _Pragma("unroll") for (int k = 0; k < 2; ++k) \
        acc[ai][bj][m][n] = __builtin_amdgcn_mfma_f32_16x16x32_bf16(Bt[n][k], At[m][k], acc[ai][bj][m][n], 0, 0, 0); __builtin_amdgcn_s_setprio(0); } while (0)
#define PG8_WAIT_V(n) asm volatile("s_waitcnt vmcnt(" #n ")" ::: "memory")
#define PG8_WAIT_L(n) asm volatile("s_waitcnt lgkmcnt(" #n ")" ::: "memory")
#define PG8_BAR __builtin_amdgcn_s_barrier()
#define PG8_SCHED __builtin_amdgcn_sched_barrier(0)
    Unit cur, nxt; int ui = 0;
    if (!S.next(0, cur)) return;
    f32x4 acc[2][2][4][2];
#pragma unroll
    for (int a = 0; a < 2; ++a)
#pragma unroll
        for (int b = 0; b < 2; ++b)
#pragma unroll
            for (int m = 0; m < 4; ++m)
#pragma unroll
                for (int n = 0; n < 2; ++n) acc[a][b][m][n] = (f32x4){0.f, 0.f, 0.f, 0.f};
    bf16x8 At[4][2], B0[2][2], B1[2][2];
    const char* cA = (const char*)g.A + (size_t)cur.pm * tstep; const char* cB = (const char*)g.Bt + (size_t)cur.pn * tstep;
    S.a_ready(cur);
    if constexpr (SP2) {
        PG8_STAGE(PG8_SB(0, 0), cB, voffB); PG8_STAGE(PG8_SB(0, 1), cB + hstep, voffB); PG8_STAGE(PG8_SA(0, 0), cA, voffA); PG8_STAGE(PG8_SA(0, 1), cA + hstep, voffA);
        if (wr == 1) PG8_BAR;
        PG8_WAIT_V(2); PG8_BAR;
        PG8_STAGE(PG8_SB(1, 0), cB + kstep, voffB); PG8_STAGE(PG8_SA(1, 0), cA + kstep, voffA); PG8_STAGE(PG8_SB(1, 1), cB + hstep + kstep, voffB);
        PG8_WAIT_V(6); PG8_BAR;
    } else {
        PG8_STAGE(PG8_SB(0, 0), cB, voffB); PG8_STAGE(PG8_SA(0, 0), cA, voffA); PG8_STAGE(PG8_SB(0, 1), cB + hstep, voffB); PG8_STAGE(PG8_SA(0, 1), cA + hstep, voffA);
        if (wr == 1) PG8_BAR;
        PG8_WAIT_V(4); PG8_BAR;
        PG8_STAGE(PG8_SB(1, 0), cB + kstep, voffB); PG8_STAGE(PG8_SA(1, 0), cA + kstep, voffA); PG8_STAGE(PG8_SB(1, 1), cB + hstep + kstep, voffB);
        PG8_WAIT_V(6); PG8_BAR;
    }
    for (;;) {
        const bool has_next = S.next(ui + 1, nxt);
        const char* nA = has_next ? (const char*)g.A + (size_t)nxt.pm * tstep : cA; const char* nB = has_next ? (const char*)g.Bt + (size_t)nxt.pn * tstep : cB;
        for (int t = 0; t < nt; t += 2) {
            const bool last = (t == nt - 2);
            const char* a1 = cA + (size_t)(t + 1) * kstep;
            const char* a2 = last ? nA : cA + (size_t)(t + 2) * kstep; const char* b2 = last ? nB : cB + (size_t)(t + 2) * kstep;
            const char* a3 = a2 + kstep; const char* b3 = b2 + kstep;
            if (last && has_next) S.a_ready(nxt);
            if constexpr (SP2) {
            PG8_LDB(B0, 0, 0); PG8_LDB(B1, 0, 1); PG8_SCHED; PG8_LDA(At, 0, 0); PG8_STAGE(PG8_SA(1, 1), a1 + hstep, voffA);
            PG8_WAIT_V(8); PG8_WAIT_L(0); PG8_BAR; PG8_MMA(0, 0, At, B0); PG8_MMA(0, 1, At, B1); PG8_BAR; PG8_SCHED;
            PG8_LDA(At, 0, 1); PG8_STAGE(PG8_SB(0, 0), b2, voffB); PG8_STAGE(PG8_SB(0, 1), b2 + hstep, voffB); PG8_STAGE(PG8_SA(0, 0), a2, voffA);
            PG8_WAIT_V(8); PG8_WAIT_L(0); PG8_BAR; PG8_MMA(1, 0, At, B0); PG8_MMA(1, 1, At, B1); PG8_BAR; PG8_SCHED;
            PG8_LDB(B0, 1, 0); PG8_LDB(B1, 1, 1); PG8_SCHED; PG8_LDA(At, 1, 0); PG8_STAGE(PG8_SA(0, 1), a2 + hstep, voffA);
            PG8_WAIT_V(8); PG8_WAIT_L(0); PG8_BAR; PG8_MMA(0, 0, At, B0); PG8_MMA(0, 1, At, B1); PG8_BAR; PG8_SCHED;
            PG8_LDA(At, 1, 1); PG8_STAGE(PG8_SB(1, 0), b3, voffB); PG8_STAGE(PG8_SB(1, 1), b3 + hstep, voffB); PG8_STAGE(PG8_SA(1, 0), a3, voffA);
            PG8_WAIT_V(8); PG8_WAIT_L(0); PG8_BAR; PG8_MMA(1, 0, At, B0); PG8_MMA(1, 1, At, B1); PG8_BAR; PG8_SCHED;
            } else {
            PG8_LDB(B0, 0, 0); PG8_SCHED; PG8_LDA(At, 0, 0); PG8_STAGE(PG8_SA(1, 1), a1 + hstep, voffA);
            PG8_WAIT_L(8); PG8_BAR; PG8_WAIT_L(0); PG8_MMA(0, 0, At, B0); PG8_BAR; PG8_SCHED;
            PG8_LDB(B1, 0, 1); PG8_STAGE(PG8_SB(0, 0), b2, voffB);
            PG8_BAR; PG8_WAIT_L(0); PG8_MMA(0, 1, At, B1); PG8_BAR;
            PG8_LDA(At, 0, 1); PG8_STAGE(PG8_SA(0, 0), a2, voffA);
            PG8_BAR; PG8_WAIT_L(0); PG8_MMA(1, 0, At, B0); PG8_BAR; PG8_SCHED;
            PG8_STAGE(PG8_SB(0, 1), b2 + hstep, voffB);
            PG8_WAIT_V(6); PG8_BAR; PG8_MMA(1, 1, At, B1); PG8_BAR;
            PG8_LDB(B0, 1, 0); PG8_SCHED; PG8_LDA(At, 1, 0); PG8_STAGE(PG8_SA(0, 1), a2 + hstep, voffA);
            PG8_WAIT_L(8); PG8_BAR; PG8_WAIT_L(0); PG8_MMA(0, 0, At, B0); PG8_BAR; PG8_SCHED;
            PG8_LDB(B1, 1, 1); PG8_STAGE(PG8_SB(1, 0), b3, voffB);
            PG8_BAR; PG8_WAIT_L(0); PG8_MMA(0, 1, At, B1); PG8_BAR;
            PG8_LDA(At, 1, 1); PG8_STAGE(PG8_SA(1, 0), a3, voffA);
            PG8_BAR; PG8_WAIT_L(0); PG8_MMA(1, 0, At, B0); PG8_BAR; PG8_SCHED;
            PG8_STAGE(PG8_SB(1, 1), b3 + hstep, voffB);
            PG8_WAIT_V(6); PG8_BAR; PG8_MMA(1, 1, At, B1); PG8_BAR;
            }
        }
        if constexpr (ALIGN_EPI) { if (wr == 0) PG8_BAR; }
        if constexpr (!Epi::AFTER_DRAIN) { E(acc, cur, wr, wc, fr, fq); S.done(cur); }
        if (!has_next) break;
#pragma unroll
        for (int a = 0; a < 2; ++a)
#pragma unroll
            for (int b = 0; b < 2; ++b)
#pragma unroll
                for (int m = 0; m < 4; ++m)
#pragma unroll
                    for (int n = 0; n < 2; ++n) acc[a][b][m][n] = (f32x4){0.f, 0.f, 0.f, 0.f};
        cur = nxt; cA = nA; cB = nB; ++ui;
        if constexpr (ALIGN_EPI) { if (wr == 1) PG8_BAR; }
    }
    PG8_WAIT_V(0);
    if constexpr (!ALIGN_EPI) { if (wr == 0) PG8_BAR; }
    PG8_BAR;
    if constexpr (Epi::AFTER_DRAIN) { E.fused(acc, cur, wr, wc, fr, fq, lds, wid, lane); S.done(cur); }
#undef PG8_SA
#undef PG8_SB
#undef PG8_STAGE
#undef PG8_LDA
#undef PG8_LDB
#undef PG8_MMA
#undef PG8_WAIT_V
#undef PG8_WAIT_L
#undef PG8_BAR
#undef PG8_SCHED
}
}

#define LAS __attribute__((address_space(3)))
#ifndef PHASE_FN
#define PHASE_FN __device__ __forceinline__
#endif
#ifndef GEMM_SP2
#define GEMM_SP2 true
#endif
#ifndef GEMM_ALIGN
#define GEMM_ALIGN false
#endif
typedef unsigned short bf16;
typedef pg8::bf16x8 bf16x8;
typedef pg8::f32x4 f32x4;
typedef pg8::u32x4 u32x4;
typedef pg8::u32x2 u32x2;
constexpr int D = 1024, NB = 4, SEQ = 8192, CTX = 256, T = CTX + SEQ, NTOK = NB * T, DEPTH = 4;
constexpr int NWAVES = 8, NTHR = 512;
constexpr int NSLOT = 71680;
constexpr size_t MiB = 1u << 20;
constexpr size_t CTL_ZERO_BYTES = 2 * MiB;
constexpr int CW_BAR = 1024;
constexpr int CW_MOE = 8192;
constexpr size_t WS_MOD = 1 * MiB;
constexpr size_t WS_LB = 2 * MiB;
constexpr size_t WS_TOK = 2 * MiB + 65536;
constexpr size_t WS_SLOT_TOK = 3 * MiB;
constexpr size_t WS_SLOT_GATE = 3 * MiB + 524288;
constexpr size_t WS_S = 4 * MiB;
constexpr size_t WS_HY = 136 * MiB;
constexpr size_t WS_MIX = 268 * MiB;
constexpr size_t WS_END = 610 * MiB;
constexpr size_t ROWB = (size_t)NTOK * 1024 * 2;
constexpr size_t W_ML_WIN = 0, W_ML_WIN_SZ = (size_t)4352 * 1024 * 2;
constexpr size_t W_ML_WOUT = 17 * MiB;
constexpr size_t W_RW_IN = 21 * MiB;
constexpr size_t W_RW_G2 = 35 * MiB;
constexpr size_t W_RW_WOUT = 36 * MiB;
constexpr size_t W_HG_IN = 38 * MiB;
constexpr size_t W_HG_WOUT = 48 * MiB;
constexpr size_t W_EX13 = 50 * MiB;
constexpr size_t W_EX2 = 82 * MiB;
constexpr size_t W_BYTES = 98 * MiB;
constexpr int LDS_PHASE_BYTES = 131072;
constexpr int LDS_BYTES = 163840;
constexpr int MISC_OFF = LDS_BYTES - 2048;

#define VM_WAIT() asm volatile("s_waitcnt vmcnt(0)" ::: "memory")
#define LDS_WAIT() asm volatile("s_waitcnt lgkmcnt(0)" ::: "memory")
typedef float f32x2_t __attribute__((ext_vector_type(2))); typedef __bf16 bf16x2_t __attribute__((ext_vector_type(2)));
__device__ __forceinline__ unsigned pk2(float lo, float hi) { f32x2_t v = {lo, hi}; bf16x2_t b = __builtin_convertvector(v, bf16x2_t); return __builtin_bit_cast(unsigned, b); }
__device__ __forceinline__ unsigned f2bf(float f) { return pk2(f, f) & 0xffffu; }
__device__ __forceinline__ float bf2f(unsigned b) { return __builtin_bit_cast(float, b << 16); }
__device__ __forceinline__ float bflo(unsigned w) { return __builtin_bit_cast(float, w << 16); }
__device__ __forceinline__ float bfhi(unsigned w) { return __builtin_bit_cast(float, w & 0xffff0000u); }
__device__ __forceinline__ float wave_sum(float v) {
#pragma unroll
    for (int o = 1; o < 64; o <<= 1) v += __shfl_xor(v, o);
    return v; }
__device__ __forceinline__ float wave_max(float v) {
#pragma unroll
    for (int o = 1; o < 64; o <<= 1) v = fmaxf(v, __shfl_xor(v, o));
    return v; }
template <int CTRL> __device__ __forceinline__ float dpp_f(float v) { return __builtin_bit_cast(float, __builtin_amdgcn_update_dpp(0, __builtin_bit_cast(int, v), CTRL, 0xF, 0xF, false)); }
__device__ __forceinline__ float row16_sum(float v) { v += dpp_f<0xB1>(v); v += dpp_f<0x4E>(v); v += dpp_f<0x124>(v); v += dpp_f<0x128>(v); return v; }
template <int K> __device__ __forceinline__ f32x4 mm16(f32x4 acc, const LAS bf16* A, int lda, const LAS bf16* Bt, int ldb, int lane) {
    const int r = lane & 15, q = lane >> 4;
#pragma unroll
    for (int kk = 0; kk < K / 32; ++kk) {
        const bf16x8 a = *(const LAS bf16x8*)(A + r * lda + kk * 32 + q * 8);
        const bf16x8 b = *(const LAS bf16x8*)(Bt + r * ldb + kk * 32 + q * 8);
        acc = __builtin_amdgcn_mfma_f32_16x16x32_bf16(a, b, acc, 0, 0, 0); }
    return acc; }
typedef short s16x4 __attribute__((ext_vector_type(4)));
__device__ __forceinline__ bf16x8 tr_frag(const LAS bf16* X, int ld, int k0, int n0, int lane) {
    const int g = lane >> 4, a = (lane & 15) >> 2, p = lane & 3;
    const LAS bf16* p0 = X + (k0 + 8 * g + a) * ld + n0 + 4 * p;
    const s16x4 lo = __builtin_amdgcn_ds_read_tr16_b64_v4i16((LAS s16x4*)p0), hi = __builtin_amdgcn_ds_read_tr16_b64_v4i16((LAS s16x4*)(p0 + 4 * ld));
    return (bf16x8){lo[0], lo[1], lo[2], lo[3], hi[0], hi[1], hi[2], hi[3]}; }
__device__ __forceinline__ bf16x8 row_frag(const LAS bf16* A, int ld, int k0, int lane) { return *(const LAS bf16x8*)(A + (lane & 15) * ld + k0 + (lane >> 4) * 8); }
__device__ __forceinline__ int seq_row(int b, int dir, int i) {
    const int tt = (i < CTX) ? (dir ? CTX - 1 - i : i) : CTX + (dir ? SEQ - 1 - (i - CTX) : (i - CTX));
    return b * T + tt; }

#define XB_TMO      128
#define XB_XCNT(j)  (256  + 64 * (j))
#define XB_XSUB(j)  (1280 + 64 * (j))
#define XB_XGEN(j)  (2304 + 64 * (j))
#define XB_TOP      3328
#define XB_TOPGEN   3392
#define XCD_BAR_WORDS 3456
#define XB_SPIN_CAP (1u << 18)

__device__ __forceinline__ unsigned xb_ld(unsigned* p)              { return __hip_atomic_load(p, __ATOMIC_RELAXED, __HIP_MEMORY_SCOPE_AGENT); }
__device__ __forceinline__ unsigned xb_add(unsigned* p, unsigned v) { return __hip_atomic_fetch_add(p, v, __ATOMIC_RELAXED, __HIP_MEMORY_SCOPE_AGENT); }
__device__ __forceinline__ unsigned xb_xcc_id() { return (unsigned)__builtin_amdgcn_s_getreg((3 << 11) | 20) & 0xFu; }
#define XB_SPIN(cond, bar) do { unsigned _sp = 0; while (cond) { __builtin_amdgcn_s_sleep(1); \
    if ((++_sp & 255u) == 0u) { if (xb_ld(&(bar)[XB_TMO])) break; if (_sp > XB_SPIN_CAP) { atomicAdd(&(bar)[XB_TMO], 1u); break; } } } } while (0)

struct XcdBarrier {
    unsigned* bar; unsigned x;
    volatile LAS unsigned* st;
};

__device__ __forceinline__ XcdBarrier xcd_barrier_post(unsigned* bar, volatile LAS unsigned* st) {
    XcdBarrier b; b.bar = bar; b.x = xb_xcc_id(); b.st = st;
    if (threadIdx.x == 0) (void)xb_add(&bar[XB_XCNT(b.x)], 1u);
    return b;
}
__device__ __forceinline__ void xcd_barrier_complete(unsigned* bar, unsigned x, unsigned& nloc, unsigned& nx) {
    const unsigned G = gridDim.x * gridDim.y * gridDim.z;
    unsigned sum, cnt, mine, sp = 0u;
    for (;;) {
        sum = 0u; cnt = 0u; mine = 0u;
#pragma unroll
        for (unsigned j = 0; j < 16; ++j) { const unsigned c = xb_ld(&bar[XB_XCNT(j)]); sum += c; cnt += (c > 0u) ? 1u : 0u; mine = (j == x) ? c : mine; }
        if (sum == G) break;
        __builtin_amdgcn_s_sleep(1);
        if ((++sp & 255u) == 0u) { if (xb_ld(&bar[XB_TMO])) break; if (sp > XB_SPIN_CAP) { atomicAdd(&bar[XB_TMO], 1u); break; } }
    }
    nloc = mine > 0u ? mine : 1u; nx = cnt > 0u ? cnt : 1u;
}

__device__ __forceinline__ void xcd_barrier(const XcdBarrier& b) {
    asm volatile("s_waitcnt vmcnt(0)" ::: "memory");
    __syncthreads();
    if (threadIdx.x == 0) {
        unsigned* bar = b.bar;
        __builtin_amdgcn_s_waitcnt(0);
        unsigned nloc = b.st[0], nx = b.st[1];
        if (nloc == 0u) { xcd_barrier_complete(bar, b.x, nloc, nx); b.st[0] = nloc; b.st[1] = nx; }
        const unsigned old = xb_add(&bar[XB_XSUB(b.x)], 1u);
        const unsigned gen = old / nloc;
        if (old + 1u == (gen + 1u) * nloc) {
            __builtin_amdgcn_fence(__ATOMIC_RELEASE, "agent");
            asm volatile("s_waitcnt vmcnt(0)" ::: "memory");
            const unsigned og = xb_add(&bar[XB_TOP], 1u);
            const unsigned tg = og / nx;
            if (og + 1u == (tg + 1u) * nx) xb_add(&bar[XB_TOPGEN], 1u);
            else XB_SPIN(xb_ld(&bar[XB_TOPGEN]) == tg, bar);
            __builtin_amdgcn_fence(__ATOMIC_ACQUIRE, "agent");
            xb_add(&bar[XB_XGEN(b.x)], 1u);
            asm volatile("s_waitcnt vmcnt(0)" ::: "memory");
        } else {
            XB_SPIN(xb_ld(&bar[XB_XGEN(b.x)]) == gen, bar);
            __builtin_amdgcn_fence(__ATOMIC_ACQUIRE, "agent");
            asm volatile("s_waitcnt vmcnt(0)" ::: "memory");
        }
    }
    __syncthreads();
}

struct Args { const float* in[42]; float* out; unsigned char* ws; unsigned char* wts; int ph_lo, ph_hi; };
struct Frame {
    LAS unsigned char* lds; GAS float* out; GAS unsigned char* ws; GAS unsigned char* W;
    int tid, lane, wave, bid, G;
};
constexpr int PTAB_OFF = MISC_OFF + 512;
__device__ __forceinline__ const GAS float* ldptr(const Frame& F, int i) { const unsigned long long v = ((const LAS unsigned long long*)(F.lds + PTAB_OFF))[i];
    const unsigned lo = __builtin_amdgcn_readfirstlane((unsigned)v), hi = __builtin_amdgcn_readfirstlane((unsigned)(v >> 32)); return (const GAS float*)(((unsigned long long)hi << 32) | lo); }
#define INP(i) ldptr(F, (i))
__device__ __forceinline__ Frame fresh(const Frame& F0) { Frame F = F0; int t = threadIdx.x; asm volatile("" : "+v"(t)); F.tid = t; F.lane = t & 63; F.wave = __builtin_amdgcn_readfirstlane(t >> 6);
    asm volatile("" : "+s"(F.bid), "+s"(F.G), "+s"(F.ws), "+s"(F.W), "+s"(F.out)); return F; }
enum { IN_X = 0, IN_C, IN_CTX, IN_CCTX, IN_ADAW, IN_ADAB, IN_NMIX, IN_NFFN, IN_NOUT, IN_ML_WIN, IN_ML_WGATE, IN_ML_BGATE, IN_ML_CONV, IN_ML_HEADG, IN_ML_WOUT,
       IN_RW_MU, IN_RW_WRKV, IN_RW_W0, IN_RW_W1, IN_RW_W2, IN_RW_A0, IN_RW_A1, IN_RW_A2, IN_RW_G1, IN_RW_G2, IN_RW_KK, IN_RW_KA, IN_RW_RK, IN_RW_LNW, IN_RW_LNB, IN_RW_WOUT,
       IN_HG_WIN, IN_HG_WF, IN_HG_BF, IN_HG_LB, IN_HG_HEADG, IN_HG_WOUT, IN_ROUTER_W, IN_ROUTER_B, IN_EX_W1, IN_EX_W3, IN_EX_W2 };

template <int MAP> __device__ __forceinline__ int rowmap(int n) { return MAP == 0 ? n : (MAP == 1 ? 8 * (n >> 2) + (n & 3) : 8 * (n >> 2) + 4 + (n & 3)); }
template <int MAP> __device__ __forceinline__ void tr_item(const GAS float* W, int ldw, int nblk, GAS bf16* WT, int ldd, int row_off, int k_off, const GAS float* kscale, LAS float* scr, int item, int lane) {
    const int kb = item / nblk, nb = item - kb * nblk, k0 = 64 * kb, n0 = 32 * nb;
#pragma unroll 8
    for (int i = 0; i < 32; ++i) { const int kk = 2 * i + (lane >> 5); float v = W[(size_t)(k0 + kk) * ldw + n0 + (lane & 31)]; if (kscale) v *= kscale[k0 + kk]; scr[kk * 33 + (lane & 31)] = v; }
    LDS_WAIT(); asm volatile("" ::: "memory");
    const int c = lane & 7;
#pragma unroll
    for (int j = 0; j < 4; ++j) { const int n = (lane >> 3) + 8 * j; const LAS float* s = scr + (8 * c) * 33 + n;
        u32x4 o; o.x = pk2(s[0 * 33], s[1 * 33]); o.y = pk2(s[2 * 33], s[3 * 33]); o.z = pk2(s[4 * 33], s[5 * 33]); o.w = pk2(s[6 * 33], s[7 * 33]);
        *(GAS u32x4*)(WT + (size_t)(row_off + rowmap<MAP>(n0 + n)) * ldd + k_off + k0 + 8 * c) = o; }
    LDS_WAIT(); asm volatile("" ::: "memory");
}
#define TRJOB(MAP, cnt, ...) if (r < (cnt)) { tr_item<MAP>(__VA_ARGS__, scr, r, F.lane); continue; } r -= (cnt);

PHASE_FN void pre_phase(Frame F) {
    LAS float* scr = (LAS float*)(F.lds + F.wave * 16384);
    const int gw = F.bid * NWAVES + F.wave, NGW = F.G * NWAVES;
    const size_t gt = (size_t)F.bid * NTHR + F.tid, NGT = (size_t)F.G * NTHR;
    GAS bf16* W = (GAS bf16*)F.W;
    constexpr int NITEMS = 2 * 2048 + 2 * 512 + 6 * 512 + 4 * 32 + 4 * 32 + 2 * 64 + 64 + 512 + 1536 + 2 * 512 + 512;
    for (int it = gw; it < NITEMS; it += NGW) {
        int r = it;
        TRJOB(0, 2048, INP(IN_ML_WIN), 4096, 128, (GAS bf16*)(F.W + W_ML_WIN), 1024, 0, 0, nullptr)
        TRJOB(0, 2048, INP(IN_ML_WIN) + (size_t)1024 * 4096, 4096, 128, (GAS bf16*)(F.W + W_ML_WIN + W_ML_WIN_SZ), 1024, 0, 0, nullptr)
        TRJOB(0, 512, INP(IN_ML_WOUT), 1024, 32, (GAS bf16*)(F.W + W_ML_WOUT), 1024, 0, 0, nullptr)
        TRJOB(0, 512, INP(IN_ML_WOUT) + (size_t)1024 * 1024, 1024, 32, (GAS bf16*)(F.W + W_ML_WOUT + 2 * MiB), 1024, 0, 0, nullptr)
        GAS bf16* RWIN = (GAS bf16*)(F.W + W_RW_IN); const GAS float* mu = INP(IN_RW_MU);
        if (r < 6 * 512) { const int idx = r / 1024, ps = (r / 512) & 1, rr = r & 511;
            tr_item<0>(INP(IN_RW_WRKV) + (size_t)idx * 1024 * 1024, 1024, 32, RWIN, 2048, idx * 1024, ps * 1024, ps ? mu + idx * 1024 : nullptr, scr, rr, F.lane); continue; } r -= 6 * 512;
        if (r < 4 * 32) { const int dir = r / 64, ps = (r / 32) & 1, rr = r & 31;
            tr_item<0>(INP(IN_RW_W1) + (size_t)dir * 1024 * 64, 64, 2, RWIN, 2048, 3072 + dir * 64, ps * 1024, ps ? mu + 3 * 1024 : nullptr, scr, rr, F.lane); continue; } r -= 4 * 32;
        if (r < 4 * 32) { const int dir = r / 64, ps = (r / 32) & 1, rr = r & 31;
            tr_item<0>(INP(IN_RW_A1) + (size_t)dir * 1024 * 64, 64, 2, RWIN, 2048, 3200 + dir * 64, ps * 1024, ps ? mu + 4 * 1024 : nullptr, scr, rr, F.lane); continue; } r -= 4 * 32;
        if (r < 2 * 64) { const int ps = r / 64, rr = r & 63;
            tr_item<0>(INP(IN_RW_G1), 128, 4, RWIN, 2048, 3328, ps * 1024, ps ? mu + 5 * 1024 : nullptr, scr, rr, F.lane); continue; } r -= 2 * 64;
        TRJOB(0, 64, INP(IN_RW_G2), 1024, 32, (GAS bf16*)(F.W + W_RW_G2), 256, 0, 0, nullptr)
        TRJOB(0, 512, INP(IN_RW_WOUT), 1024, 32, (GAS bf16*)(F.W + W_RW_WOUT), 1024, 0, 0, nullptr)
        TRJOB(0, 1536, INP(IN_HG_WIN), 3072, 96, (GAS bf16*)(F.W + W_HG_IN), 1024, 0, 0, nullptr)
        TRJOB(0, 512, INP(IN_HG_WF), 1024, 32, (GAS bf16*)(F.W + W_HG_IN), 1024, 3072, 0, nullptr)
        TRJOB(0, 512, INP(IN_HG_WF) + (size_t)1024 * 1024, 1024, 32, (GAS bf16*)(F.W + W_HG_IN), 1024, 4096, 0, nullptr)
        TRJOB(0, 512, INP(IN_HG_WOUT), 1024, 32, (GAS bf16*)(F.W + W_HG_WOUT), 1024, 0, 0, nullptr)
    }
    for (size_t i = gt; i < (size_t)2 * 256 * 1024; i += NGT) { const int j = (int)(i >> 18), rr = (int)((i >> 10) & 255), k = (int)(i & 1023);
        float v = 0.f; if (rr < 32) { const int dir = rr >> 4, g = rr & 15; v = INP(IN_ML_WGATE)[((size_t)(j * 2 + dir) * 1024 + k) * 16 + g]; }
        ((GAS bf16*)(F.W + W_ML_WIN + j * W_ML_WIN_SZ))[(size_t)(4096 + rr) * 1024 + k] = (bf16)f2bf(v); }
    for (size_t i = gt; i < (size_t)128 * 2048; i += NGT) ((GAS bf16*)(F.W + W_RW_IN))[(size_t)3456 * 2048 + i] = 0;
    for (size_t i = gt; i < (size_t)1024 * 128; i += NGT) ((GAS bf16*)(F.W + W_RW_G2))[(i >> 7) * 256 + 128 + (i & 127)] = 0;
    if (F.bid == 0) for (int c = F.tid; c < 1024; c += NTHR) { const GAS float* lg = INP(IN_HG_LB) + c; const float l0 = lg[0], l1 = lg[1024], l2 = lg[2048], l3 = lg[3072];
        const float mx = fmaxf(fmaxf(l0, l1), fmaxf(l2, l3)); const float e0 = __expf(l0 - mx), e1 = __expf(l1 - mx), e2 = __expf(l2 - mx), e3 = __expf(l3 - mx);
        ((GAS float*)(F.ws + WS_LB))[c] = (e1 + e2) / (e0 + e1 + e2 + e3); }
    { GAS f32x4* S4 = (GAS f32x4*)(F.ws + WS_S);
      for (size_t i = gt; i < (size_t)NTOK * 256; i += NGT) { const int m = (int)(i >> 8), c4 = (int)(i & 255); const int b = m / T, t = m - b * T;
          const GAS float* src = (t < CTX) ? INP(IN_CTX) + ((size_t)(b * CTX + t)) * 1024 : INP(IN_X) + ((size_t)(b * SEQ + t - CTX)) * 1024;
          S4[i] = ((const GAS f32x4*)src)[c4]; } }
    { LAS float* sc = (LAS float*)(F.lds + 8448); GAS float* MODP = (GAS float*)(F.ws + WS_MIX);
      for (int it = F.bid; it < 768; it += F.G) { const int i = it / 192, rem = it - i * 192, kc = rem / 12, jb = rem - kc * 12;
          __syncthreads();
          if (F.tid < 320) { const int seg = F.tid >> 6, kk = F.tid & 63; const float cv = seg == 0 ? INP(IN_CCTX)[kc * 64 + kk] : INP(IN_C)[(seg - 1) * 1024 + kc * 64 + kk]; sc[F.tid] = silu_f(cv); }
          __syncthreads();
          const int j = jb * 512 + F.tid; const GAS float* wp = INP(IN_ADAW) + ((size_t)i * 1024 + kc * 64) * 6144 + j;
          float a0 = 0.f, a1 = 0.f, a2 = 0.f, a3 = 0.f, a4 = 0.f;
#pragma unroll 8
          for (int kk = 0; kk < 64; ++kk) { const float w = wp[(size_t)kk * 6144]; a0 += sc[kk] * w; a1 += sc[64 + kk] * w; a2 += sc[128 + kk] * w; a3 += sc[192 + kk] * w; a4 += sc[256 + kk] * w; }
          GAS float* mp = MODP + ((size_t)kc * 4 + i) * 5 * 6144 + j;
          mp[0] = a0; mp[6144] = a1; mp[2 * 6144] = a2; mp[3 * 6144] = a3; mp[4 * 6144] = a4; } }
}
PHASE_FN void modsum_phase(Frame F) {
    const GAS float* MODP = (const GAS float*)(F.ws + WS_MIX); GAS float* MOD = (GAS float*)(F.ws + WS_MOD);
    for (int idx = F.bid * NTHR + F.tid; idx < 4 * 5 * 6144; idx += F.G * NTHR) { const int i = idx / (5 * 6144), j = idx % 6144;
        float a = INP(IN_ADAB)[i * 6144 + j];
#pragma unroll
        for (int kc = 0; kc < 16; ++kc) a += MODP[(size_t)kc * 4 * 5 * 6144 + idx];
        MOD[idx] = a; }
}
PHASE_FN void expert_weights(Frame F, int L) {
    LAS float* scr = (LAS float*)(F.lds + F.wave * 16384);
    const int gw = F.bid * NWAVES + F.wave, NGW = F.G * NWAVES;
    GAS bf16* W13 = (GAS bf16*)(F.W + W_EX13); GAS bf16* W2 = (GAS bf16*)(F.W + W_EX2);
    const GAS float* w1 = INP(IN_EX_W1) + (size_t)L * 16 * 1024 * 512; const GAS float* w3 = INP(IN_EX_W3) + (size_t)L * 16 * 1024 * 512; const GAS float* w2 = INP(IN_EX_W2) + (size_t)L * 16 * 512 * 1024;
    for (int it = gw; it < 3 * 4096; it += NGW) { const int which = it >> 12, e = (it >> 8) & 15, rr = it & 255;
        if (which == 0) tr_item<1>(w1 + (size_t)e * 1024 * 512, 512, 16, W13, 1024, e * 1024, 0, nullptr, scr, rr, F.lane);
        else if (which == 1) tr_item<2>(w3 + (size_t)e * 1024 * 512, 512, 16, W13, 1024, e * 1024, 0, nullptr, scr, rr, F.lane);
        else tr_item<0>(w2 + (size_t)e * 512 * 1024, 1024, 32, W2, 512, e * 1024, 0, nullptr, scr, rr, F.lane); }
}

template <int MODE, int PRB = 0> PHASE_FN void norm_phase(Frame F, int L, bool add_moe, int ldh) {
    GAS float* S = (GAS float*)(F.ws + WS_S); GAS bf16* H = (GAS bf16*)(F.ws + WS_HY); const GAS bf16* YM = (const GAS bf16*)(F.ws + WS_MIX + 210 * MiB);
    const GAS float* MOD = (const GAS float*)(F.ws + WS_MOD);
    const int gw = F.bid * NWAVES + F.wave, NGW = F.G * NWAVES, lane = F.lane;
    LAS float* rwl = (LAS float*)F.lds;
    LAS int* cntl = (LAS int*)(F.lds + 65536);
    if (MODE == 1) {
        for (int i = F.tid; i < 16384; i += NTHR) { const int c = i >> 4, e = i & 15; rwl[e * 1024 + c] = INP(IN_ROUTER_W)[i]; }
        if (F.tid < 16) cntl[F.tid] = 0;
        __syncthreads();
    }
    const GAS float* gnp = MODE == 0 ? INP(IN_NMIX) + L * 1024 : (MODE == 1 ? INP(IN_NFFN) + L * 1024 : INP(IN_NOUT));
    for (int m = gw; m < NTOK; m += NGW) {
        const int b = m / T, t = m - b * T, seg = t < CTX ? 0 : 1 + b;
        if (MODE == 2 && t < CTX) continue;
        f32x4 v[4]; GAS f32x4* sp = (GAS f32x4*)(S + (size_t)m * 1024) + lane;
#pragma unroll
        for (int j = 0; j < 4; ++j) v[j] = sp[64 * j];
        if (add_moe) {
            const GAS float* gp = MOD + ((size_t)((MODE == 2 ? 3 : L - 1) * 5 + seg)) * 6144 + 5 * 1024;
            const GAS u32x2* ya = (const GAS u32x2*)(YM + (size_t)(2 * m) * 1024) + lane; const GAS u32x2* yb = ya + 256;
#pragma unroll
            for (int j = 0; j < 4; ++j) { const u32x2 a = ya[64 * j], bq = yb[64 * j]; const f32x4 g = ((const GAS f32x4*)gp)[lane + 64 * j];
                v[j][0] += g[0] * (bflo(a.x) + bflo(bq.x)); v[j][1] += g[1] * (bfhi(a.x) + bfhi(bq.x)); v[j][2] += g[2] * (bflo(a.y) + bflo(bq.y)); v[j][3] += g[3] * (bfhi(a.y) + bfhi(bq.y)); }
            if (MODE != 2 && !PRB) {
#pragma unroll
                for (int j = 0; j < 4; ++j) sp[64 * j] = v[j]; }
        }
        float ss = 0.f;
#pragma unroll
        for (int j = 0; j < 4; ++j) ss += (v[j][0] * v[j][0] + v[j][1] * v[j][1]) + (v[j][2] * v[j][2] + v[j][3] * v[j][3]);
        const float rinv = 1.0f / sqrtf(wave_sum(ss) * (1.0f / 1024.0f) + 1e-6f);
        if (MODE == 2) { GAS f32x4* op = (GAS f32x4*)(F.out + ((size_t)(b * SEQ + t - CTX)) * 1024) + lane;
#pragma unroll
            for (int j = 0; j < 4; ++j) { const f32x4 g = ((const GAS f32x4*)gnp)[lane + 64 * j]; op[64 * j] = v[j] * rinv * g; }
            continue; }
        const GAS float* mp = MOD + ((size_t)(L * 5 + seg)) * 6144 + (MODE == 0 ? 0 : 3 * 1024);
        f32x4 h[4];
#pragma unroll
        for (int j = 0; j < 4; ++j) { const f32x4 g = ((const GAS f32x4*)gnp)[lane + 64 * j], sh = ((const GAS f32x4*)mp)[lane + 64 * j], sc = ((const GAS f32x4*)(mp + 1024))[lane + 64 * j];
            h[j] = v[j] * rinv * g * (sc + 1.0f) + sh;
            u32x2 o; o.x = pk2(h[j][0], h[j][1]); o.y = pk2(h[j][2], h[j][3]); *((GAS u32x2*)(H + (size_t)m * ldh) + lane + 64 * j) = o; }
        if (MODE == 1) {
            float lg[16];
#pragma unroll
            for (int e = 0; e < 16; ++e) { float a = 0.f;
#pragma unroll
                for (int j = 0; j < 4; ++j) { const f32x4 w = *(const LAS f32x4*)(rwl + e * 1024 + 256 * j + 4 * lane); a += (h[j][0] * w[0] + h[j][1] * w[1]) + (h[j][2] * w[2] + h[j][3] * w[3]); }
                lg[e] = wave_sum(a); }
            float aff[16], sel[16];
#pragma unroll
            for (int e = 0; e < 16; ++e) { aff[e] = sigmoid_f(lg[e]); sel[e] = aff[e] + INP(IN_ROUTER_B)[e]; }
            float best = -3.0e38f; int bg = 0; float s0 = 0.f, s1 = 0.f, s2 = 0.f, s3 = 0.f, a0 = 0.f, a1 = 0.f, a2 = 0.f, a3 = 0.f;
#pragma unroll
            for (int g = 0; g < 4; ++g) { const float x0 = sel[4 * g], x1 = sel[4 * g + 1], x2 = sel[4 * g + 2], x3 = sel[4 * g + 3];
                const float t1 = fmaxf(x0, x1), t2 = fminf(x0, x1), u1 = fmaxf(x2, x3), u2 = fminf(x2, x3);
                const float sum = fmaxf(t1, u1) + fmaxf(fminf(t1, u1), fmaxf(t2, u2));
                const bool bt = sum > best; best = bt ? sum : best; bg = bt ? g : bg;
                s0 = bt ? x0 : s0; s1 = bt ? x1 : s1; s2 = bt ? x2 : s2; s3 = bt ? x3 : s3;
                a0 = bt ? aff[4 * g] : a0; a1 = bt ? aff[4 * g + 1] : a1; a2 = bt ? aff[4 * g + 2] : a2; a3 = bt ? aff[4 * g + 3] : a3; }
            int i1 = 0; float m1 = s0; if (s1 > m1) { m1 = s1; i1 = 1; } if (s2 > m1) { m1 = s2; i1 = 2; } if (s3 > m1) { m1 = s3; i1 = 3; }
            int i2 = -1; float m2 = -3.0e38f;
            if (i1 != 0 && s0 > m2) { m2 = s0; i2 = 0; } if (i1 != 1 && s1 > m2) { m2 = s1; i2 = 1; } if (i1 != 2 && s2 > m2) { m2 = s2; i2 = 2; } if (i1 != 3 && s3 > m2) { m2 = s3; i2 = 3; }
            const float c1 = i1 == 0 ? a0 : (i1 == 1 ? a1 : (i1 == 2 ? a2 : a3)), c2 = i2 == 0 ? a0 : (i2 == 1 ? a1 : (i2 == 2 ? a2 : a3));
            const float inv = 1.0f / (c1 + c2);
            if (lane == 0) { const int e1 = bg * 4 + i1, e2 = bg * 4 + i2;
                u32x4 tk; tk.x = (unsigned)e1; tk.y = (unsigned)e2; tk.z = __float_as_uint(c1 * inv); tk.w = __float_as_uint(c2 * inv); ((GAS u32x4*)(F.ws + WS_TOK))[m] = tk;
                __hip_atomic_fetch_add(cntl + e1, 1, __ATOMIC_RELAXED, __HIP_MEMORY_SCOPE_WORKGROUP); __hip_atomic_fetch_add(cntl + e2, 1, __ATOMIC_RELAXED, __HIP_MEMORY_SCOPE_WORKGROUP); }
        }
    }
    if (MODE == 1) { __syncthreads(); if (F.tid < 16) __hip_atomic_fetch_add((GAS unsigned*)F.ws + CW_MOE + L * 2048 + (PRB ? 512 : 0) + 64 * F.tid, (unsigned)cntl[F.tid], __ATOMIC_RELAXED, __HIP_MEMORY_SCOPE_AGENT); }
}

__device__ __forceinline__ void moe_prefix(const Frame& F, int L, LAS int* pref  , LAS int* cnt  ) {
    if (F.tid < 16) cnt[F.tid] = (int)__hip_atomic_load((GAS unsigned*)F.ws + CW_MOE + L * 2048 + 64 * F.tid, __ATOMIC_RELAXED, __HIP_MEMORY_SCOPE_AGENT);
    __syncthreads();
    if (F.tid == 0) { int p = 0; for (int e = 0; e < 16; ++e) { pref[e] = p; p += (cnt[e] + 255) >> 8; } pref[16] = p; }
    __syncthreads();
}
template <int PRB = 0> PHASE_FN void slots_phase(Frame F, int L) {
    LAS int* pref = (LAS int*)F.lds; LAS int* cnt = pref + 32;
    moe_prefix(F, L, pref, cnt);
    const int gw = F.bid * NWAVES + F.wave, NGW = F.G * NWAVES, lane = F.lane;
    GAS unsigned* cursor = (GAS unsigned*)F.ws + CW_MOE + L * 2048 + 1024 + (PRB ? 32 : 0);
    GAS int* slot_tok = (GAS int*)(F.ws + WS_SLOT_TOK); GAS float* slot_gate = (GAS float*)(F.ws + WS_SLOT_GATE);
    const GAS bf16* H = (const GAS bf16*)(F.ws + WS_HY); GAS bf16* XG = (GAS bf16*)(F.ws + WS_MIX);
    for (int it = gw; it < NTOK / 64; it += NGW) {
        const int m = it * 64 + lane; const u32x4 tk = ((const GAS u32x4*)(F.ws + WS_TOK))[m];
        int myslot[2];
#pragma unroll
        for (int k = 0; k < 2; ++k) { const int e = (int)(k ? tk.y : tk.x); int slot = 0;
            for (int ee = 0; ee < 16; ++ee) { const unsigned long long mask = __ballot(e == ee);
                if (mask) { const int n = __popcll(mask); unsigned base = 0; if (lane == 0) base = __hip_atomic_fetch_add(cursor + 64 * ee, (unsigned)n, __ATOMIC_RELAXED, __HIP_MEMORY_SCOPE_AGENT); base = __builtin_amdgcn_readfirstlane(base);
                    if (e == ee) slot = pref[ee] * 256 + (int)base + __popcll(mask & ((1ull << lane) - 1ull)); } }
            myslot[k] = slot; slot_tok[slot] = 2 * m + k; slot_gate[slot] = __uint_as_float(k ? tk.w : tk.z); }
#pragma unroll
        for (int k = 0; k < 2; ++k)
            for (int l = 0; l < 64; ++l) { const int sl = __shfl(myslot[k], l); const GAS u32x4* src = (const GAS u32x4*)(H + (size_t)(it * 64 + l) * 1024); GAS u32x4* dst = (GAS u32x4*)(XG + (size_t)sl * 1024);
                dst[lane] = src[lane]; dst[64 + lane] = src[64 + lane]; }
    }
    for (int e = 0; e < 16; ++e) { const int lo = pref[e] * 256 + cnt[e], hi = pref[e + 1] * 256;
        for (int s = lo + gw; s < hi; s += NGW) { GAS u32x4* dst = (GAS u32x4*)(XG + (size_t)s * 1024); dst[lane] = (u32x4){0u, 0u, 0u, 0u}; dst[64 + lane] = (u32x4){0u, 0u, 0u, 0u};
            if (lane == 0) { slot_tok[s] = -1; slot_gate[s] = 0.f; } } }
}

PHASE_FN void du_phase(Frame F) {
    GAS bf16* H2 = (GAS bf16*)(F.ws + WS_HY);
    const size_t gt = (size_t)F.bid * NTHR + F.tid, NGT = (size_t)F.G * NTHR;
    for (size_t i = gt; i < (size_t)NTOK * 128; i += NGT) { const int m = (int)(i >> 7), c8 = (int)(i & 127); const int t = m % T;
        const bool hp = !(t == 0 || t == CTX), hn = !(t == CTX - 1 || t == T - 1);
        const u32x4 z = {0u, 0u, 0u, 0u};
        const u32x4 u = *(const GAS u32x4*)(H2 + (size_t)m * 2048 + c8 * 8), p = hp ? *(const GAS u32x4*)(H2 + (size_t)(m - 1) * 2048 + c8 * 8) : z, n = hn ? *(const GAS u32x4*)(H2 + (size_t)(m + 1) * 2048 + c8 * 8) : z;
        u32x4 o;
#pragma unroll
        for (int j = 0; j < 4; ++j) o[j] = pk2(0.5f * (bflo(p[j]) + bflo(n[j])) - bflo(u[j]), 0.5f * (bfhi(p[j]) + bfhi(n[j])) - bfhi(u[j]));
        *(GAS u32x4*)(H2 + (size_t)m * 2048 + 1024 + c8 * 8) = o; }
}

PHASE_FN void conv_phase(Frame F, int j) {
    const GAS bf16* QP = (const GAS bf16*)(F.ws + WS_MIX); GAS bf16* QK = (GAS bf16*)(F.ws + WS_HY); const GAS float* cw = INP(IN_ML_CONV) + (size_t)j * 9 * 2048;
    const size_t gt = (size_t)F.bid * NTHR + F.tid, NGT = (size_t)F.G * NTHR;
    for (size_t i = gt; i < (size_t)NTOK * 256; i += NGT) { const int m = (int)(i >> 8), c = (int)(i & 255) * 8; const int t = m % T;
        float acc[8];
#pragma unroll
        for (int q = 0; q < 8; ++q) acc[q] = 0.f;
        const int p = t - CTX, gr = p >> 6, gc = p & 63;
#pragma unroll
        for (int dr = 0; dr < 3; ++dr)
#pragma unroll
            for (int dw = 0; dw < 3; ++dw) {
                bool ok; int mm;
                if (t < CTX) { ok = (dr == 1) && (t + dw - 1 >= 0) && (t + dw - 1 < CTX); mm = m + dw - 1; }
                else { ok = (gr + dr - 1 >= 0) && (gr + dr - 1 < 128) && (gc + dw - 1 >= 0) && (gc + dw - 1 < 64); mm = m + (dr - 1) * 64 + (dw - 1); }
                if (ok) { const u32x4 x = *(const GAS u32x4*)(QP + (size_t)mm * 2048 + c); const f32x4 w0 = *(const GAS f32x4*)(cw + (dr * 3 + dw) * 2048 + c), w1 = *(const GAS f32x4*)(cw + (dr * 3 + dw) * 2048 + c + 4);
                    acc[0] += bflo(x[0]) * w0[0]; acc[1] += bfhi(x[0]) * w0[1]; acc[2] += bflo(x[1]) * w0[2]; acc[3] += bfhi(x[1]) * w0[3];
                    acc[4] += bflo(x[2]) * w1[0]; acc[5] += bfhi(x[2]) * w1[1]; acc[6] += bflo(x[3]) * w1[2]; acc[7] += bfhi(x[3]) * w1[3]; } }
        const float sc = c >= 1024 ? 0.08838834764831845f : 1.0f;
        u32x4 o;
#pragma unroll
        for (int q = 0; q < 4; ++q) o[q] = pk2(silu_f(acc[2 * q]) * sc, silu_f(acc[2 * q + 1]) * sc);
        *(GAS u32x4*)(QK + (size_t)m * 2048 + c) = o; }
}

PHASE_FN void headnorm_phase(Frame F, const GAS bf16* HSf, const GAS bf16* HSb, const GAS bf16* OG, const GAS float* hg, GAS bf16* Y) {
    const int gw = F.bid * NWAVES + F.wave, NGW = F.G * NWAVES, lane = F.lane;
    for (int m = gw; m < NTOK; m += NGW) { const size_t off = (size_t)m * 1024 + lane * 16;
        float x[16]; float ss = 0.f;
#pragma unroll
        for (int hlf = 0; hlf < 2; ++hlf) { const u32x4 a = *(const GAS u32x4*)(HSf + off + 8 * hlf), bq = *(const GAS u32x4*)(HSb + off + 8 * hlf);
#pragma unroll
            for (int q = 0; q < 4; ++q) { x[8 * hlf + 2 * q] = bflo(a[q]) + bflo(bq[q]); x[8 * hlf + 2 * q + 1] = bfhi(a[q]) + bfhi(bq[q]); } }
#pragma unroll
        for (int q = 0; q < 16; ++q) ss += x[q] * x[q];
        ss += __shfl_xor(ss, 1); ss += __shfl_xor(ss, 2); ss += __shfl_xor(ss, 4);
        const float rinv = 1.0f / sqrtf(ss * (1.0f / 128.0f) + 1e-6f);
#pragma unroll
        for (int hlf = 0; hlf < 2; ++hlf) { const u32x4 g = *(const GAS u32x4*)(OG + off + 8 * hlf); const f32x4 h0 = *(const GAS f32x4*)(hg + lane * 16 + 8 * hlf), h1 = *(const GAS f32x4*)(hg + lane * 16 + 8 * hlf + 4);
            u32x4 o;
            o[0] = pk2(x[8 * hlf + 0] * rinv * h0[0] * bflo(g[0]), x[8 * hlf + 1] * rinv * h0[1] * bfhi(g[0])); o[1] = pk2(x[8 * hlf + 2] * rinv * h0[2] * bflo(g[1]), x[8 * hlf + 3] * rinv * h0[3] * bfhi(g[1]));
            o[2] = pk2(x[8 * hlf + 4] * rinv * h1[0] * bflo(g[2]), x[8 * hlf + 5] * rinv * h1[1] * bfhi(g[2])); o[3] = pk2(x[8 * hlf + 6] * rinv * h1[2] * bflo(g[3]), x[8 * hlf + 7] * rinv * h1[3] * bfhi(g[3]));
            *(GAS u32x4*)(Y + off + 8 * hlf) = o; } }
}
PHASE_FN void rwpost_phase(Frame F, const GAS bf16* Of, const GAS bf16* Ob, const GAS float* BETA, const GAS bf16* V, const GAS bf16* Gt, GAS bf16* Y) {
    const int gw = F.bid * NWAVES + F.wave, NGW = F.G * NWAVES, lane = F.lane;
    const GAS float* lnw = INP(IN_RW_LNW); const GAS float* lnb = INP(IN_RW_LNB);
    for (int m = gw; m < NTOK; m += NGW) { const size_t off = (size_t)m * 1024 + lane * 16;
        float x[16]; float s = 0.f;
#pragma unroll
        for (int hlf = 0; hlf < 2; ++hlf) { const u32x4 a = *(const GAS u32x4*)(Of + off + 8 * hlf), bq = *(const GAS u32x4*)(Ob + off + 8 * hlf);
#pragma unroll
            for (int q = 0; q < 4; ++q) { x[8 * hlf + 2 * q] = bflo(a[q]) + bflo(bq[q]); x[8 * hlf + 2 * q + 1] = bfhi(a[q]) + bfhi(bq[q]); } }
#pragma unroll
        for (int q = 0; q < 16; ++q) s += x[q];
        s += __shfl_xor(s, 1); s += __shfl_xor(s, 2);
        const float mean = s * (1.0f / 64.0f); float vs = 0.f;
#pragma unroll
        for (int q = 0; q < 16; ++q) { x[q] -= mean; vs += x[q] * x[q]; }
        vs += __shfl_xor(vs, 1); vs += __shfl_xor(vs, 2);
        const float rinv = 1.0f / sqrtf(vs * (1.0f / 64.0f) + 64e-5f);
        const int hd = lane >> 2; const float beta = BETA[(size_t)m * 16 + hd] + BETA[((size_t)NTOK + m) * 16 + hd];
#pragma unroll
        for (int hlf = 0; hlf < 2; ++hlf) { const u32x4 vv = *(const GAS u32x4*)(V + off + 8 * hlf), gg = *(const GAS u32x4*)(Gt + off + 8 * hlf);
            const f32x4 w0 = *(const GAS f32x4*)(lnw + lane * 16 + 8 * hlf), w1 = *(const GAS f32x4*)(lnw + lane * 16 + 8 * hlf + 4), b0 = *(const GAS f32x4*)(lnb + lane * 16 + 8 * hlf), b1 = *(const GAS f32x4*)(lnb + lane * 16 + 8 * hlf + 4);
            float y[8];
#pragma unroll
            for (int q = 0; q < 4; ++q) { y[q] = x[8 * hlf + q] * rinv * w0[q] + b0[q]; y[4 + q] = x[8 * hlf + 4 + q] * rinv * w1[q] + b1[q]; }
            u32x4 o;
#pragma unroll
            for (int q = 0; q < 4; ++q) o[q] = pk2((y[2 * q] + beta * bflo(vv[q])) * bflo(gg[q]), (y[2 * q + 1] + beta * bfhi(vv[q])) * bfhi(gg[q]));
            *(GAS u32x4*)(Y + off + 8 * hlf) = o; } }
}

template <int PROBE> PHASE_FN void ml_scan_phase(Frame F, const GAS bf16* QK, const GAS bf16* V, const GAS float* GATES, GAS bf16* HS) {
    constexpr int OFF_Q = 0, OFF_K = 17408, OFF_V = 34816, OFF_VW = 39936, OFF_WKR = 45056, INB = 47360;
    LAS bf16* SS = (LAS bf16*)(F.lds + 2 * INB); LAS bf16* CS = (LAS bf16*)(F.lds + 2 * INB + 9216); LAS bf16* HO = (LAS bf16*)(F.lds + 2 * INB + 9216 + 13056);
    LAS float* SC = (LAS float*)(F.lds + 2 * INB + 9216 + 13056 + 5120);
    LAS float* sdenp = SC + 2 * 336;
    const int tid = F.tid, lane = F.lane, w = F.wave, r = lane & 15, q = lane >> 4;
    const int lrow = tid >> 3, lp = tid & 7;
    for (int unit = F.bid; unit < 256; unit += F.G) {
        const int vs = unit & 3, dir = (unit >> 2) & 1, h = (unit >> 3) & 7, b = unit >> 6;
        f32x4 Cst[2], Nst; Cst[0] = (f32x4){0.f, 0.f, 0.f, 0.f}; Cst[1] = Cst[0]; Nst = Cst[0];
        __syncthreads();
        for (int i = tid; i < 48 * 136; i += NTHR) CS[i] = 0;
        for (int i = tid; i < 2 * 16 * 72; i += NTHR) { ((LAS bf16*)(F.lds + OFF_WKR))[i % 1152] = 0; ((LAS bf16*)(F.lds + INB + OFF_WKR))[i % 1152] = 0; }
        float m_run = 0.f;
        u32x4 rq[2], rk[2], rv = {0u, 0u, 0u, 0u}; float rig = 0.f, rlf = 0.f;
#define ML_LOAD(c) do { const int row_ = seq_row(b, dir, (c) * 64 + lrow); const GAS bf16* qp_ = QK + (size_t)row_ * 2048 + h * 128; \
            rq[0] = *(const GAS u32x4*)(qp_ + 8 * lp); rq[1] = *(const GAS u32x4*)(qp_ + 8 * (lp + 8)); rk[0] = *(const GAS u32x4*)(qp_ + 1024 + 8 * lp); rk[1] = *(const GAS u32x4*)(qp_ + 1024 + 8 * (lp + 8)); \
            if (tid < 256) { const int vrow_ = seq_row(b, dir, (c) * 64 + (tid >> 2)); rv = *(const GAS u32x4*)(V + (size_t)vrow_ * 1024 + h * 128 + vs * 32 + 8 * (tid & 3)); } } while (0)
#define ML_GLOAD(c) do { const int grow_ = seq_row(b, dir, (c) * 64 + lane); rig = GATES[(size_t)grow_ * 32 + dir * 16 + h]; rlf = GATES[(size_t)grow_ * 32 + dir * 16 + 8 + h]; } while (0)
#define ML_SCALARS(buf) do { const float lf_ = logsigmoid_f(rlf); float bc_ = lf_; \
            _Pragma("unroll") for (int o_ = 1; o_ < 64; o_ <<= 1) { const float t_ = __shfl_up(bc_, o_); if (lane >= o_) bc_ += t_; } \
            const float u_ = rig - bc_; float pm_ = u_; \
            _Pragma("unroll") for (int o_ = 1; o_ < 64; o_ <<= 1) { const float t_ = __shfl_up(pm_, o_); if (lane >= o_) pm_ = fmaxf(pm_, t_); } \
            const float cc_ = fmaxf(m_run, pm_), blast_ = __shfl(bc_, 63), pmall_ = __shfl(pm_, 63), mnew_ = blast_ + fmaxf(m_run, pmall_); LAS float* sc_ = SC + (buf) * 336; \
            sc_[lane] = u_; sc_[64 + lane] = cc_; sc_[128 + lane] = __expf(m_run - cc_); sc_[192 + lane] = __expf(-(bc_ + cc_)); sc_[256 + lane] = __expf(blast_ + u_ - mnew_); \
            if (lane == 0) sc_[320] = __expf(blast_ + m_run - mnew_); m_run = mnew_; } while (0)
        ML_LOAD(0);
        if (w == 7) { ML_GLOAD(0); ML_SCALARS(0); ML_GLOAD(1); }
        __syncthreads();
        constexpr int NCH = T / 64;
        for (int c = 0; c < NCH; ++c) {
            const int pb = c & 1; LAS unsigned char* ib = F.lds + pb * INB;
            LAS bf16* QS = (LAS bf16*)(ib + OFF_Q); LAS bf16* KS = (LAS bf16*)(ib + OFF_K); LAS bf16* VS = (LAS bf16*)(ib + OFF_V); LAS bf16* VW = (LAS bf16*)(ib + OFF_VW); LAS bf16* WKR = (LAS bf16*)(ib + OFF_WKR);
            const LAS float* sc = SC + pb * 336;
            {
                *(LAS u32x4*)(QS + lrow * 136 + 8 * lp) = rq[0]; *(LAS u32x4*)(QS + lrow * 136 + 8 * (lp + 8)) = rq[1];
                *(LAS u32x4*)(KS + lrow * 136 + 8 * lp) = rk[0]; *(LAS u32x4*)(KS + lrow * 136 + 8 * (lp + 8)) = rk[1];
                if (tid < 256) { const int s_ = tid >> 2; const float wk = sc[256 + s_]; u32x4 vw;
#pragma unroll
                    for (int jj = 0; jj < 4; ++jj) vw[jj] = pk2(bflo(rv[jj]) * wk, bfhi(rv[jj]) * wk);
                    *(LAS u32x4*)(VS + s_ * 40 + 8 * (tid & 3)) = rv; *(LAS u32x4*)(VW + s_ * 40 + 8 * (tid & 3)) = vw; }
                if (tid < 64) WKR[tid] = (bf16)f2bf(sc[256 + tid]);
                if (c > 0 && tid < 256) { const int t_ = tid >> 2; const int row = seq_row(b, dir, (c - 1) * 64 + t_);
                    *(GAS u32x4*)(HS + ((size_t)dir * NTOK + row) * 1024 + h * 128 + vs * 32 + 8 * (tid & 3)) = *(const LAS u32x4*)(HO + t_ * 40 + 8 * (tid & 3)); }
                if (c + 1 < NCH && !(PROBE & 1)) ML_LOAD(c + 1);
                if (w == 7 && c + 1 < NCH) { ML_SCALARS(pb ^ 1); if (c + 2 < NCH) ML_GLOAD(c + 2); }
            }
            __syncthreads();
            {
                const int ti = w >> 1;
#pragma unroll
                for (int jj = 0; jj < 2; ++jj) { const int sj = (w & 1) * 2 + jj; f32x4 acc = {0.f, 0.f, 0.f, 0.f};
                    if (sj <= ti) acc = mm16<128>(acc, QS + 16 * ti * 136, 136, KS + 16 * sj * 136, 136, lane);
                    const int s_ = 16 * sj + r; const float us = sc[s_];
#pragma unroll
                    for (int i = 0; i < 4; ++i) { const int t_ = 16 * ti + 4 * q + i; const float val = (s_ <= t_) ? acc[i] * __expf(us - sc[64 + t_]) : 0.f;
                        const float rs = row16_sum(val); if (r == 0) sdenp[sj * 64 + t_] = rs;
                        SS[t_ * 72 + s_] = (bf16)f2bf(val); } }
            }
            __syncthreads();
            float wprev;
            {
                const int ti = w >> 1, vj = w & 1; f32x4 a1 = {0.f, 0.f, 0.f, 0.f}, a2 = a1, a3 = a1;
#pragma unroll
                for (int kk = 0; kk < 2; ++kk) a1 = __builtin_amdgcn_mfma_f32_16x16x32_bf16(row_frag(SS + 16 * ti * 72, 72, 32 * kk, lane), tr_frag(VS, 40, 32 * kk, 16 * vj, lane), a1, 0, 0, 0);
                a2 = mm16<128>(a2, QS + 16 * ti * 136, 136, CS + 16 * vj * 136, 136, lane);
                a3 = mm16<128>(a3, QS + 16 * ti * 136, 136, CS + 32 * 136, 136, lane);
#pragma unroll
                for (int i = 0; i < 4; ++i) { const int t_ = 16 * ti + 4 * q + i; const float wi = sc[128 + t_]; const float nq = row16_sum(a3[i]);
                    const float num = a1[i] + wi * a2[i], den = ((sdenp[t_] + sdenp[64 + t_]) + (sdenp[128 + t_] + sdenp[192 + t_])) + wi * nq;
                    HO[t_ * 40 + 16 * vj + r] = (bf16)f2bf(num / fmaxf(fabsf(den), sc[192 + t_])); }
                wprev = sc[320];
            }
            __syncthreads();
            {
                const int vi = w & 1; bf16x8 av[2];
#pragma unroll
                for (int kk = 0; kk < 2; ++kk) av[kk] = tr_frag(VW, 40, 32 * kk, 16 * vi, lane);
#pragma unroll
                for (int jj = 0; jj < 2; ++jj) { const int dj = (w >> 1) * 2 + jj; Cst[jj] = Cst[jj] * wprev;
#pragma unroll
                    for (int kk = 0; kk < 2; ++kk) Cst[jj] = __builtin_amdgcn_mfma_f32_16x16x32_bf16(av[kk], tr_frag(KS, 136, 32 * kk, 16 * dj, lane), Cst[jj], 0, 0, 0);
#pragma unroll
                    for (int i = 0; i < 4; ++i) CS[(16 * vi + 4 * q + i) * 136 + 16 * dj + r] = (bf16)f2bf(Cst[jj][i]); }
                Nst = Nst * wprev;
#pragma unroll
                for (int kk = 0; kk < 2; ++kk) Nst = __builtin_amdgcn_mfma_f32_16x16x32_bf16(row_frag(WKR, 72, 32 * kk, lane), tr_frag(KS, 136, 32 * kk, 16 * w, lane), Nst, 0, 0, 0);
                if (q == 0) CS[32 * 136 + 16 * w + r] = (bf16)f2bf(Nst[0]);
            }
        }
        __syncthreads();
        if (tid < 256) { const int t_ = tid >> 2; const int row = seq_row(b, dir, (NCH - 1) * 64 + t_);
            *(GAS u32x4*)(HS + ((size_t)dir * NTOK + row) * 1024 + h * 128 + vs * 32 + 8 * (tid & 3)) = *(const LAS u32x4*)(HO + t_ * 40 + 8 * (tid & 3)); }
#undef ML_LOAD
#undef ML_GLOAD
#undef ML_SCALARS
    }
}

template <int PROBE> PHASE_FN void hg_scan_phase(Frame F, const GAS bf16* Q, const GAS bf16* V, const GAS bf16* LF, GAS bf16* HSf, GAS bf16* HSb) {
    LAS bf16* QT = (LAS bf16*)(F.lds + 0); LAS bf16* QI = (LAS bf16*)(F.lds + 8704); LAS bf16* KT = (LAS bf16*)(F.lds + 17408); LAS bf16* KH = (LAS bf16*)(F.lds + 26112);
    LAS bf16* VS = (LAS bf16*)(F.lds + 34816); LAS bf16* AS = (LAS bf16*)(F.lds + 37376); LAS bf16* STs = (LAS bf16*)(F.lds + 39936); LAS bf16* HO = (LAS bf16*)(F.lds + 48640);
    LAS float* WT = (LAS float*)(F.lds + 51200); LAS float* SBL = (LAS float*)(F.lds + 55296);
    const int tid = F.tid, lane = F.lane, w = F.wave, r = lane & 15, q = lane >> 4;
    const int lrow = tid >> 4, lp = tid & 15;
    for (int unit = F.bid; unit < 256; unit += F.G) {
        const int vs = unit & 3, dir = (unit >> 2) & 1, h = (unit >> 3) & 7, b = unit >> 6;
        GAS bf16* HS = dir ? HSb : HSf; const GAS bf16* LFd = LF + (size_t)dir * NTOK * 1024;
        f32x4 Sst[2]; Sst[0] = (f32x4){0.f, 0.f, 0.f, 0.f}; Sst[1] = Sst[0];
        __syncthreads();
        for (int i = tid; i < 32 * 136; i += NTHR) STs[i] = 0;
        u32x4 rq, rl, rv = {0u, 0u, 0u, 0u};
#define HG_LOAD(c) do { const int row_ = seq_row(b, dir, (c) * 32 + lrow); rq = *(const GAS u32x4*)(Q + (size_t)row_ * 1024 + h * 128 + 8 * lp); rl = *(const GAS u32x4*)(LFd + (size_t)row_ * 1024 + h * 128 + 8 * lp); \
            if (tid < 128) { const int vrow_ = seq_row(b, dir, (c) * 32 + (tid >> 2)); rv = *(const GAS u32x4*)(V + (size_t)vrow_ * 1024 + h * 128 + vs * 32 + 8 * (tid & 3)); } } while (0)
        HG_LOAD(0);
        constexpr int NCH = T / 32;
        for (int c = 0; c < NCH; ++c) {
            float lf[8], bc[8];
#pragma unroll
            for (int jj = 0; jj < 4; ++jj) { lf[2 * jj] = bflo(rl[jj]); lf[2 * jj + 1] = bfhi(rl[jj]); }
#pragma unroll
            for (int j = 0; j < 8; ++j) { float x = lf[j]; float y = __shfl_up(x, 16); if (lane >= 16) x += y; y = __shfl_up(x, 32); if (lane >= 32) x += y; bc[j] = x; }
            if (lane >= 48) { *(LAS f32x4*)(WT + w * 128 + 8 * lp) = (f32x4){bc[0], bc[1], bc[2], bc[3]}; *(LAS f32x4*)(WT + w * 128 + 8 * lp + 4) = (f32x4){bc[4], bc[5], bc[6], bc[7]}; }
            __syncthreads();
            {
                float off[8], br[8], bl[8];
#pragma unroll
                for (int j = 0; j < 8; ++j) { off[j] = 0.f; br[j] = 0.f; bl[j] = 0.f; }
#pragma unroll
                for (int ww = 0; ww < 8; ++ww) { const f32x4 t0 = *(const LAS f32x4*)(WT + ww * 128 + 8 * lp), t1 = *(const LAS f32x4*)(WT + ww * 128 + 8 * lp + 4);
#pragma unroll
                    for (int j = 0; j < 4; ++j) { if (ww < w) { off[j] += t0[j]; off[4 + j] += t1[j]; } if (ww < 4) { br[j] += t0[j]; br[4 + j] += t1[j]; } bl[j] += t0[j]; bl[4 + j] += t1[j]; } }
                float qv[8];
#pragma unroll
                for (int jj = 0; jj < 4; ++jj) { qv[2 * jj] = bflo(rq[jj]); qv[2 * jj + 1] = bfhi(rq[jj]); }
                u32x4 oq, oi, ok, oh;
#pragma unroll
                for (int jj = 0; jj < 4; ++jj) { float a_[2], i_[2], k_[2], h_[2];
#pragma unroll
                    for (int hh = 0; hh < 2; ++hh) { const int j = 2 * jj + hh; const float bt = bc[j] + off[j]; const float key = -expm1f(lf[j]);
                        a_[hh] = qv[j] * __expf(bt - br[j]); i_[hh] = qv[j] * __expf(bt); k_[hh] = key * __expf(br[j] - bt); h_[hh] = key * __expf(bl[j] - bt); }
                    oq[jj] = pk2(a_[0], a_[1]); oi[jj] = pk2(i_[0], i_[1]); ok[jj] = pk2(k_[0], k_[1]); oh[jj] = pk2(h_[0], h_[1]); }
                *(LAS u32x4*)(QT + lrow * 136 + 8 * lp) = oq; *(LAS u32x4*)(QI + lrow * 136 + 8 * lp) = oi; *(LAS u32x4*)(KT + lrow * 136 + 8 * lp) = ok; *(LAS u32x4*)(KH + lrow * 136 + 8 * lp) = oh;
                if (lrow == 0) { *(LAS f32x4*)(SBL + 8 * lp) = (f32x4){__expf(bl[0]), __expf(bl[1]), __expf(bl[2]), __expf(bl[3])}; *(LAS f32x4*)(SBL + 8 * lp + 4) = (f32x4){__expf(bl[4]), __expf(bl[5]), __expf(bl[6]), __expf(bl[7])}; }
                if (tid < 128) { const int s_ = tid >> 2;
                    if (c > 0) { const int row = seq_row(b, dir, (c - 1) * 32 + s_); *(GAS u32x4*)(HS + (size_t)row * 1024 + h * 128 + vs * 32 + 8 * (tid & 3)) = *(const LAS u32x4*)(HO + s_ * 40 + 8 * (tid & 3)); }
                    *(LAS u32x4*)(VS + s_ * 40 + 8 * (tid & 3)) = rv; }
                if (c + 1 < NCH && !(PROBE & 1)) HG_LOAD(c + 1);
            }
            __syncthreads();
            f32x4 oacc = {0.f, 0.f, 0.f, 0.f}; const int ti = (w & 3) >> 1, xj = w & 1;
            if (w < 4) { f32x4 acc = {0.f, 0.f, 0.f, 0.f};
                if (xj <= ti) acc = mm16<128>(acc, QT + 16 * ti * 136, 136, KT + 16 * xj * 136, 136, lane);
#pragma unroll
                for (int i = 0; i < 4; ++i) { const int t_ = 16 * ti + 4 * q + i, s_ = 16 * xj + r; AS[t_ * 40 + s_] = (bf16)f2bf(s_ <= t_ ? acc[i] : 0.f); } }
            else oacc = mm16<128>(oacc, QI + 16 * ti * 136, 136, STs + 16 * xj * 136, 136, lane);
            __syncthreads();
            {
                const bf16x8 vb = tr_frag(VS, 40, 0, 16 * xj, lane);
                if (w >= 4) { oacc = __builtin_amdgcn_mfma_f32_16x16x32_bf16(row_frag(AS + 16 * ti * 40, 40, 0, lane), vb, oacc, 0, 0, 0);
#pragma unroll
                    for (int i = 0; i < 4; ++i) HO[(16 * ti + 4 * q + i) * 40 + 16 * xj + r] = (bf16)f2bf(oacc[i]); }
#pragma unroll
                for (int jj = 0; jj < 2; ++jj) { const int kj = (w >> 1) * 2 + jj; Sst[jj] = Sst[jj] * SBL[16 * kj + r];
                    Sst[jj] = __builtin_amdgcn_mfma_f32_16x16x32_bf16(vb, tr_frag(KH, 136, 0, 16 * kj, lane), Sst[jj], 0, 0, 0);
#pragma unroll
                    for (int i = 0; i < 4; ++i) STs[(16 * xj + 4 * q + i) * 136 + 16 * kj + r] = (bf16)f2bf(Sst[jj][i]); }
            }
        }
        __syncthreads();
        if (tid < 128) { const int s_ = tid >> 2; const int row = seq_row(b, dir, (NCH - 1) * 32 + s_); *(GAS u32x4*)(HS + (size_t)row * 1024 + h * 128 + vs * 32 + 8 * (tid & 3)) = *(const LAS u32x4*)(HO + s_ * 40 + 8 * (tid & 3)); }
#undef HG_LOAD
    }
}

__device__ __forceinline__ float fmix_lo(float a, unsigned b, float c) { float d; asm("v_fma_mix_f32 %0, %1, %2, %3 op_sel:[0,0,0] op_sel_hi:[0,1,0]" : "=v"(d) : "v"(a), "v"(b), "v"(c)); return d; }
__device__ __forceinline__ float fmix_hi(float a, unsigned b, float c) { float d; asm("v_fma_mix_f32 %0, %1, %2, %3 op_sel:[0,1,0] op_sel_hi:[0,1,0]" : "=v"(d) : "v"(a), "v"(b), "v"(c)); return d; }
__device__ __forceinline__ unsigned pkh2(float lo, float hi) { typedef _Float16 h2_t __attribute__((ext_vector_type(2))); h2_t v; v.x = (_Float16)lo; v.y = (_Float16)hi; return __builtin_bit_cast(unsigned, v); }
constexpr int RW_STEPB = 896;
typedef _Float16 h2_t __attribute__((ext_vector_type(2)));
template <int PROBE> PHASE_FN void rw_scan_phase(Frame F, const GAS bf16* Rr, const GAS bf16* Kk, const GAS bf16* Vv, const GAS bf16* WH, const GAS bf16* AH, GAS bf16* O  , GAS float* BETA  ) {
    LAS bf16* W2T = (LAS bf16*)(F.lds + 0); LAS bf16* A2T = (LAS bf16*)(F.lds + 9216);
    LAS bf16* WHS = (LAS bf16*)(F.lds + 18432); LAS bf16* AHS = (LAS bf16*)(F.lds + 23040);
    LAS float* WP = (LAS float*)(F.lds + 27648); LAS float* AP = (LAS float*)(F.lds + 35840);
    LAS unsigned char* STEP = F.lds + 44032;
    LAS float* OP = (LAS float*)(F.lds + 72704);
    LAS float* SVEC = (LAS float*)(F.lds + 138240);
    const int tid = F.tid, lane = F.lane, w = F.wave, t16 = tid >> 4, cg = tid & 15, kc = cg * 4;
    for (int unit = F.bid; unit < 256; unit += F.G) {
        const int half = unit & 1, dir = (unit >> 1) & 1, h = (unit >> 2) & 15, b = unit >> 6;
        __syncthreads();
        for (int i = tid; i < 4096; i += NTHR) { const int l = i >> 6, jn = i & 63; W2T[jn * 72 + l] = (bf16)f2bf(INP(IN_RW_W2)[((size_t)(dir * 64 + l)) * 1024 + h * 64 + jn]); A2T[jn * 72 + l] = (bf16)f2bf(INP(IN_RW_A2)[((size_t)(dir * 64 + l)) * 1024 + h * 64 + jn]); }
        if (tid < 64) { SVEC[tid] = INP(IN_RW_W0)[dir * 1024 + h * 64 + tid]; SVEC[64 + tid] = INP(IN_RW_A0)[dir * 1024 + h * 64 + tid]; SVEC[128 + tid] = INP(IN_RW_KK)[h * 64 + tid];
            SVEC[192 + tid] = INP(IN_RW_KA)[h * 64 + tid]; SVEC[256 + tid] = INP(IN_RW_RK)[h * 64 + tid]; }
        float S0 = 0.f, S1 = 0.f, S2 = 0.f, S3 = 0.f;
        u32x2 rr, rk, rwh, rah; unsigned rv;
#define RW_LOAD_RKV(c) do { const size_t row_ = (size_t)seq_row(b, dir, (c) * 32 + t16); rr = *(const GAS u32x2*)(Rr + row_ * 1024 + h * 64 + kc); rk = *(const GAS u32x2*)(Kk + row_ * 1024 + h * 64 + kc); \
            rv = *(const GAS unsigned*)(Vv + row_ * 1024 + h * 64 + half * 32 + 2 * cg); } while (0)
#define RW_LOAD_H(c) do { const size_t row_ = (size_t)seq_row(b, dir, (c) * 32 + t16); rwh = *(const GAS u32x2*)(WH + row_ * 128 + dir * 64 + kc); rah = *(const GAS u32x2*)(AH + row_ * 128 + dir * 64 + kc); } while (0)
        RW_LOAD_H(0); RW_LOAD_RKV(0);
        *(LAS u32x2*)(WHS + t16 * 72 + kc) = rwh; *(LAS u32x2*)(AHS + t16 * 72 + kc) = rah;
        RW_LOAD_H(1);
        __syncthreads();
        constexpr int NCH = T / 32;
        for (int c = 0; c < NCH; ++c) {
            if (!(PROBE & 2)) {   const LAS bf16* As = (w < 4) ? WHS : AHS; const LAS bf16* Bs = (w < 4) ? W2T : A2T; LAS float* Cd = (w < 4) ? WP : AP;
                const int tt = w & 1, r = lane & 15, q = lane >> 4;
#pragma unroll
                for (int jj = 0; jj < 2; ++jj) { const int kt = ((w >> 1) & 1) * 2 + jj; f32x4 acc = {0.f, 0.f, 0.f, 0.f};
                    acc = mm16<64>(acc, As + 16 * tt * 72, 72, Bs + 16 * kt * 72, 72, lane);
#pragma unroll
                    for (int i = 0; i < 4; ++i) Cd[(16 * tt + 4 * q + i) * 64 + 16 * kt + r] = acc[i]; } }
            __syncthreads();
            if (!(PROBE & 2)) {
                if (c > 0) { const size_t row_ = (size_t)seq_row(b, dir, (c - 1) * 32 + t16); const LAS f32x4* op = (const LAS f32x4*)(OP + (t16 * 32 + 2 * cg) * 16);
                    f32x4 x0 = (op[0] + op[1]) + (op[2] + op[3]), x1 = (op[4] + op[5]) + (op[6] + op[7]);
                    *(GAS unsigned*)(O + ((size_t)dir * NTOK + row_) * 1024 + h * 64 + half * 32 + 2 * cg) = pk2((x0[0] + x0[1]) + (x0[2] + x0[3]), (x1[0] + x1[1]) + (x1[2] + x1[3])); }
                const f32x4 wp = *(const LAS f32x4*)(SVEC + kc) + *(const LAS f32x4*)(WP + t16 * 64 + kc), ap = *(const LAS f32x4*)(SVEC + 64 + kc) + *(const LAS f32x4*)(AP + t16 * 64 + kc);
                const f32x4 kkw = *(const LAS f32x4*)(SVEC + 128 + kc), kaw = *(const LAS f32x4*)(SVEC + 192 + kc), rkw = *(const LAS f32x4*)(SVEC + 256 + kc);
                f32x4 kv, rv4, now, av, kx; kv[0] = bflo(rk.x); kv[1] = bfhi(rk.x); kv[2] = bflo(rk.y); kv[3] = bfhi(rk.y); rv4[0] = bflo(rr.x); rv4[1] = bfhi(rr.x); rv4[2] = bflo(rr.y); rv4[3] = bfhi(rr.y);
                float ssq = 0.f, bet = 0.f;
#pragma unroll
                for (int jn = 0; jn < 4; ++jn) { now[jn] = expm1f(-0.6065306597126334f * sigmoid_f(wp[jn])); av[jn] = sigmoid_f(ap[jn]); kx[jn] = kv[jn] * kkw[jn]; ssq += kx[jn] * kx[jn]; }
                ssq = row16_sum(ssq); const float rn = 1.0f / sqrtf(fmaxf(ssq, 1e-24f));
                f32x4 nkk, akk, kd;
#pragma unroll
                for (int jn = 0; jn < 4; ++jn) { const float kkn = kx[jn] * rn; nkk[jn] = -kkn; akk[jn] = kkn * av[jn]; kd[jn] = kv[jn] * (1.0f + (av[jn] - 1.0f) * kaw[jn]); bet += rv4[jn] * kd[jn] * rkw[jn]; }
                bet = row16_sum(bet);
                LAS unsigned char* sp = STEP + t16 * RW_STEPB;
                u32x4 p0, p1; u32x2 p2;
                p0[0] = pkh2(now[0], now[1]); p0[1] = pkh2(now[2], now[3]); p0[2] = pkh2(nkk[0], nkk[1]); p0[3] = pkh2(nkk[2], nkk[3]);
                p1[0] = pkh2(akk[0], kd[0]); p1[1] = pkh2(akk[1], kd[1]); p1[2] = pkh2(akk[2], kd[2]); p1[3] = pkh2(akk[3], kd[3]);
                p2[0] = pkh2(rv4[0], rv4[1]); p2[1] = pkh2(rv4[2], rv4[3]);
                *(LAS u32x4*)(sp + cg * 48) = p0; *(LAS u32x4*)(sp + cg * 48 + 16) = p1; *(LAS u32x2*)(sp + cg * 48 + 32) = p2;
                { f32x2_t v2; v2.x = bflo(rv); v2.y = bfhi(rv); *(LAS f32x2_t*)(sp + 768 + 8 * cg) = v2; }
                if (cg == 0 && half == 0) BETA[((size_t)dir * NTOK + seq_row(b, dir, c * 32 + t16)) * 16 + h] = bet;
                if (c + 1 < NCH) { *(LAS u32x2*)(WHS + t16 * 72 + kc) = rwh; *(LAS u32x2*)(AHS + t16 * 72 + kc) = rah; RW_LOAD_RKV(c + 1); }
                if (c + 2 < NCH) RW_LOAD_H(c + 2);
            }
            __syncthreads();
            if (!(PROBE & 1)) {
                const LAS unsigned char* sp = STEP + cg * 48; const LAS unsigned char* vp = STEP + 768 + 4 * t16; LAS float* op = OP + t16 * 16 + cg;
                u32x4 a0 = *(const LAS u32x4*)sp, a1 = *(const LAS u32x4*)(sp + 16); u32x2 a2 = *(const LAS u32x2*)(sp + 32); float vv = *(const LAS float*)vp;
#pragma unroll 8
                for (int t_ = 0; t_ < 32; ++t_) {
                    const int tn = (t_ + 1) & 31;
                    const u32x4 n0 = *(const LAS u32x4*)(sp + tn * RW_STEPB), n1 = *(const LAS u32x4*)(sp + tn * RW_STEPB + 16); const u32x2 n2 = *(const LAS u32x2*)(sp + tn * RW_STEPB + 32); const float vn = *(const LAS float*)(vp + tn * RW_STEPB);
                    float sa, sb, oa, ob; unsigned sv;
                    asm volatile(
                        "v_fma_mix_f32 %4, %0, %11, 0 op_sel:[0,0,0] op_sel_hi:[0,1,0]\n\t"
                        "v_fma_mix_f32 %5, %2, %12, 0 op_sel:[0,0,0] op_sel_hi:[0,1,0]\n\t"
                        "v_fma_mix_f32 %4, %1, %11, %4 op_sel:[0,1,0] op_sel_hi:[0,1,0]\n\t"
                        "v_fma_mix_f32 %5, %3, %12, %5 op_sel:[0,1,0] op_sel_hi:[0,1,0]\n\t"
                        "v_fma_mix_f32 %0, %0, %9, %0 op_sel:[0,0,0] op_sel_hi:[0,1,0]\n\t"
                        "v_fma_mix_f32 %1, %1, %9, %1 op_sel:[0,1,0] op_sel_hi:[0,1,0]\n\t"
                        "v_add_f32 %4, %4, %5\n\t"
                        "v_fma_mix_f32 %2, %2, %10, %2 op_sel:[0,0,0] op_sel_hi:[0,1,0]\n\t"
                        "v_fma_mix_f32 %3, %3, %10, %3 op_sel:[0,1,0] op_sel_hi:[0,1,0]\n\t"
                        "v_add_f32_dpp %4, %4, %4 quad_perm:[1,0,3,2] row_mask:0xf bank_mask:0xf bound_ctrl:1\n\t"
                        "s_nop 1\n\t"
                        "v_add_f32_dpp %4, %4, %4 quad_perm:[2,3,0,1] row_mask:0xf bank_mask:0xf bound_ctrl:1\n\t"
                        "s_nop 1\n\t"
                        "v_add_f32_dpp %4, %4, %4 row_ror:4 row_mask:0xf bank_mask:0xf bound_ctrl:1\n\t"
                        "s_nop 1\n\t"
                        "v_add_f32_dpp %4, %4, %4 row_ror:8 row_mask:0xf bank_mask:0xf bound_ctrl:1\n\t"
                        "v_cvt_pkrtz_f16_f32 %6, %4, %19\n\t"
                        "v_dot2c_f32_f16 %0, %6, %13\n\t"
                        "v_dot2c_f32_f16 %1, %6, %14\n\t"
                        "v_dot2c_f32_f16 %2, %6, %15\n\t"
                        "v_dot2c_f32_f16 %3, %6, %16\n\t"
                        "v_fma_mix_f32 %7, %0, %17, 0 op_sel:[0,0,0] op_sel_hi:[0,1,0]\n\t"
                        "v_fma_mix_f32 %7, %1, %17, %7 op_sel:[0,1,0] op_sel_hi:[0,1,0]\n\t"
                        "v_fma_mix_f32 %8, %2, %18, 0 op_sel:[0,0,0] op_sel_hi:[0,1,0]\n\t"
                        "v_fma_mix_f32 %8, %3, %18, %8 op_sel:[0,1,0] op_sel_hi:[0,1,0]\n\t"
                        "v_add_f32 %7, %7, %8\n\t"
                        "s_nop 0"
                        : "+v"(S0), "+v"(S1), "+v"(S2), "+v"(S3), "=&v"(sa), "=&v"(sb), "=&v"(sv), "=&v"(oa), "=&v"(ob)
                        : "v"(a0[0]), "v"(a0[1]), "v"(a0[2]), "v"(a0[3]), "v"(a1[0]), "v"(a1[1]), "v"(a1[2]), "v"(a1[3]), "v"(a2[0]), "v"(a2[1]), "v"(vv));
                    op[t_ * 512] = oa;
                    a0 = n0; a1 = n1; a2 = n2; vv = vn;
                }
            }
        }
        __syncthreads();
        { const size_t row_ = (size_t)seq_row(b, dir, (NCH - 1) * 32 + t16); const LAS f32x4* op = (const LAS f32x4*)(OP + (t16 * 32 + 2 * cg) * 16);
          f32x4 x0 = (op[0] + op[1]) + (op[2] + op[3]), x1 = (op[4] + op[5]) + (op[6] + op[7]);
          *(GAS unsigned*)(O + ((size_t)dir * NTOK + row_) * 1024 + h * 64 + half * 32 + 2 * cg) = pk2((x0[0] + x0[1]) + (x0[2] + x0[3]), (x1[0] + x1[1]) + (x1[2] + x1[3])); }
#undef RW_LOAD_RKV
#undef RW_LOAD_H
    }
}

PHASE_FN void gemm_mlin(Frame F, int jl) { GAS unsigned char* MIX = F.ws + WS_MIX; GAS unsigned char* HY = F.ws + WS_HY;
    pg8::Gemm g{(const GAS bf16*)HY, (const GAS bf16*)(F.W + W_ML_WIN + jl * W_ML_WIN_SZ), NTOK, 4352, 1024}; pg8::StaticOrder So; So.init(NTOK, 4352, F.G, F.bid);
    pg8::EpiMlstmIn E{(GAS bf16*)MIX, (GAS bf16*)(MIX + 2 * ROWB), (GAS bf16*)(MIX + 3 * ROWB), (GAS float*)(MIX + 4 * ROWB), INP(IN_ML_BGATE) + jl * 32};
    pg8::gemm_phase<pg8::EpiMlstmIn, pg8::StaticOrder, GEMM_ALIGN, GEMM_SP2>(F.lds, g, So, E); }
PHASE_FN void gemm_resid(Frame F, const GAS bf16* A, const GAS bf16* Bt, int L) {
    pg8::Gemm g{A, Bt, NTOK, 1024, 1024}; pg8::StaticOrder So; So.init(NTOK, 1024, F.G, F.bid);
    pg8::EpiResid E{(GAS float*)(F.ws + WS_S), (const GAS float*)(F.ws + WS_MOD) + (size_t)L * 5 * 6144, 2}; pg8::gemm_phase<pg8::EpiResid, pg8::StaticOrder, GEMM_ALIGN, GEMM_SP2>(F.lds, g, So, E); }
PHASE_FN void gemm_rwin(Frame F) { GAS unsigned char* MIX = F.ws + WS_MIX; GAS unsigned char* HY = F.ws + WS_HY;
    GAS bf16* Rb = (GAS bf16*)MIX; GAS bf16* Kb = (GAS bf16*)(MIX + ROWB); GAS bf16* Vb = (GAS bf16*)(MIX + 2 * ROWB); GAS float* WH = (GAS float*)(MIX + 3 * ROWB); GAS float* AH = WH + (size_t)NTOK * 128; GAS bf16* GH = (GAS bf16*)(AH + (size_t)NTOK * 128);
    pg8::Gemm g{(const GAS bf16*)HY, (const GAS bf16*)(F.W + W_RW_IN), NTOK, 3584, 2048}; pg8::StaticOrder So; So.init(NTOK, 3584, F.G, F.bid);
    pg8::EpiRwkvIn E{Rb, Kb, Vb, WH, AH, GH}; pg8::gemm_phase<pg8::EpiRwkvIn, pg8::StaticOrder, GEMM_ALIGN, GEMM_SP2>(F.lds, g, So, E); }
PHASE_FN void gemm_rwg(Frame F) { GAS unsigned char* MIX = F.ws + WS_MIX;
    GAS float* WH = (GAS float*)(MIX + 3 * ROWB); GAS float* AH = WH + (size_t)NTOK * 128; GAS bf16* GH = (GAS bf16*)(AH + (size_t)NTOK * 128);
    pg8::Gemm g{GH, (const GAS bf16*)(F.W + W_RW_G2), NTOK, 1024, 256}; pg8::StaticOrder So; So.init(NTOK, 1024, F.G, F.bid);
    pg8::EpiBf16Plain E{(GAS bf16*)MIX, 1024}; pg8::gemm_phase<pg8::EpiBf16Plain, pg8::StaticOrder, GEMM_ALIGN, GEMM_SP2>(F.lds, g, So, E); }
PHASE_FN void gemm_hgin(Frame F) { GAS unsigned char* MIX = F.ws + WS_MIX; GAS unsigned char* HY = F.ws + WS_HY;
    pg8::Gemm g{(const GAS bf16*)HY, (const GAS bf16*)(F.W + W_HG_IN), NTOK, 5120, 1024}; pg8::StaticOrder So; So.init(NTOK, 5120, F.G, F.bid);
    pg8::EpiHgrnIn E{(GAS bf16*)MIX, (GAS bf16*)(MIX + ROWB), (GAS bf16*)(MIX + 2 * ROWB), (GAS bf16*)(MIX + 3 * ROWB), (size_t)NTOK * 1024, INP(IN_HG_BF), (const GAS float*)(F.ws + WS_LB)};
    pg8::gemm_phase<pg8::EpiHgrnIn, pg8::StaticOrder, GEMM_ALIGN, GEMM_SP2>(F.lds, g, So, E); }
PHASE_FN void gemm_moe1(Frame F, int L) { GAS unsigned char* MIX = F.ws + WS_MIX; LAS int* pref = (LAS int*)(F.lds + LDS_PHASE_BYTES); moe_prefix(F, L, pref, pref + 32);
    pg8::Gemm g{(const GAS bf16*)MIX, (const GAS bf16*)(F.W + W_EX13), NSLOT, 16384, 1024}; pg8::MoeOrder So{pref, F.G, F.bid};
    pg8::EpiMoe1 E{(GAS bf16*)(MIX + 140 * MiB)}; pg8::gemm_phase<pg8::EpiMoe1, pg8::MoeOrder, GEMM_ALIGN, GEMM_SP2>(F.lds, g, So, E); }
PHASE_FN void gemm_moe2(Frame F, int L) { GAS unsigned char* MIX = F.ws + WS_MIX; LAS int* pref = (LAS int*)(F.lds + LDS_PHASE_BYTES); moe_prefix(F, L, pref, pref + 32);
    pg8::Gemm g{(const GAS bf16*)(MIX + 140 * MiB), (const GAS bf16*)(F.W + W_EX2), NSLOT, 16384, 512}; pg8::MoeOrder So{pref, F.G, F.bid};
    pg8::EpiMoe2 E{(GAS bf16*)(MIX + 210 * MiB), (const GAS int*)(F.ws + WS_SLOT_TOK), (const GAS float*)(F.ws + WS_SLOT_GATE)};
    pg8::gemm_phase<pg8::EpiMoe2, pg8::MoeOrder, GEMM_ALIGN, GEMM_SP2>(F.lds, g, So, E); }

constexpr int PH_PER_LAYER = 12, PH_LAYER0 = 2, PH_FINAL = PH_LAYER0 + DEPTH * PH_PER_LAYER, N_PHASES = PH_FINAL + 1;
__global__ void __launch_bounds__(NTHR, 2) fwd_kernel(Args args) {
    extern __shared__ __attribute__((aligned(16))) unsigned char lds_raw[];
    Frame F;
    F.lds = (LAS unsigned char*)lds_raw; F.out = (GAS float*)args.out; F.ws = (GAS unsigned char*)args.ws; F.W = (GAS unsigned char*)args.wts;
    F.tid = threadIdx.x; F.lane = F.tid & 63; F.wave = __builtin_amdgcn_readfirstlane(F.tid >> 6); F.bid = blockIdx.x; F.G = gridDim.x;
    volatile LAS unsigned* MISC = (volatile LAS unsigned*)(F.lds + MISC_OFF);
    if (F.tid < 32) MISC[F.tid] = 0u;
    if (F.tid < 42) ((LAS unsigned long long*)(F.lds + PTAB_OFF))[F.tid] = (unsigned long long)args.in[F.tid];
    __syncthreads();
    const int lo = args.ph_lo, hi = args.ph_hi;
    XcdBarrier bar; bar.bar = (unsigned*)args.ws + CW_BAR; bar.x = 0; bar.st = MISC + 8;
    if (hi - lo > 1) bar = xcd_barrier_post((unsigned*)args.ws + CW_BAR, MISC + 8);
#define IN(k) (lo <= (k) && (k) < hi)
#define SEAM(k) do { if ((k) + 1 < hi) xcd_barrier(bar); } while (0)
#ifndef DUP_MASK
#define DUP_MASK 0
#endif
#ifndef PRB_MASK
#define PRB_MASK 0
#endif
#define PRB(bit, stmt) do { if ((PRB_MASK >> (bit)) & 1) { stmt; xcd_barrier(bar); } } while (0)
#define DUP(bit, stmt) do { stmt; if ((DUP_MASK >> (bit)) & 1) { xcd_barrier(bar); stmt; } } while (0)

    if (IN(0)) { PRB(0, pre_phase(fresh(F))); pre_phase(fresh(F)); SEAM(0); }
    if (IN(1)) { PRB(0, modsum_phase(fresh(F))); modsum_phase(fresh(F)); SEAM(1); }

    for (int L = 0; L < DEPTH; ++L) {
        const int kind = L % 3, jl = L / 3, pb = PH_LAYER0 + L * PH_PER_LAYER;
        if (IN(pb + 0)) { DUP(6, expert_weights(fresh(F), L)); if ((PRB_MASK >> 1) & 1) { norm_phase<0, 1>(fresh(F), L, L > 0, kind == 1 ? 2048 : 1024); xcd_barrier(bar); } norm_phase<0>(fresh(F), L, L > 0, kind == 1 ? 2048 : 1024); SEAM(pb + 0); }
        if (kind == 0) {
            if (IN(pb + 2)) { DUP(3, gemm_mlin(fresh(F), jl)); SEAM(pb + 2); }
            if (IN(pb + 3)) { DUP(7, conv_phase(fresh(F), jl)); SEAM(pb + 3); }
            if (IN(pb + 4)) { const Frame Fp = fresh(F); GAS unsigned char* MIX = Fp.ws + WS_MIX;
#ifndef SC_PROBE
#define SC_PROBE 0
#endif
                if (SC_PROBE) { ml_scan_phase<SC_PROBE>(Fp, (const GAS bf16*)(Fp.ws + WS_HY), (const GAS bf16*)(MIX + 2 * ROWB), (const GAS float*)(MIX + 4 * ROWB), (GAS bf16*)MIX); xcd_barrier(bar); }
                DUP(0, ml_scan_phase<0>(Fp, (const GAS bf16*)(Fp.ws + WS_HY), (const GAS bf16*)(MIX + 2 * ROWB), (const GAS float*)(MIX + 4 * ROWB), (GAS bf16*)MIX)); SEAM(pb + 4); }
            if (IN(pb + 6)) { const Frame Fp = fresh(F); GAS unsigned char* MIX = Fp.ws + WS_MIX;
                PRB(4, headnorm_phase(Fp, (const GAS bf16*)MIX, (const GAS bf16*)(MIX + ROWB), (const GAS bf16*)(MIX + 3 * ROWB), ldptr(Fp, IN_ML_HEADG) + jl * 1024, (GAS bf16*)(Fp.ws + WS_HY + ROWB)));
                headnorm_phase(Fp, (const GAS bf16*)MIX, (const GAS bf16*)(MIX + ROWB), (const GAS bf16*)(MIX + 3 * ROWB), ldptr(Fp, IN_ML_HEADG) + jl * 1024, (GAS bf16*)(Fp.ws + WS_HY + ROWB)); SEAM(pb + 6); }
            if (IN(pb + 7)) { const Frame Fp = fresh(F); gemm_resid(Fp, (const GAS bf16*)(Fp.ws + WS_HY + ROWB), (const GAS bf16*)(Fp.W + W_ML_WOUT + jl * 2 * MiB), L); SEAM(pb + 7); }
        } else if (kind == 1) {
            if (IN(pb + 1)) { PRB(4, du_phase(fresh(F))); du_phase(fresh(F)); SEAM(pb + 1); }
            if (IN(pb + 2)) { DUP(3, gemm_rwin(fresh(F))); SEAM(pb + 2); }
            if (IN(pb + 4)) { const Frame Fp = fresh(F); GAS unsigned char* MIX = Fp.ws + WS_MIX; GAS float* WH = (GAS float*)(MIX + 3 * ROWB); GAS float* AH = WH + (size_t)NTOK * 128; GAS float* BETA = (GAS float*)((GAS bf16*)(AH + (size_t)NTOK * 128) + (size_t)NTOK * 256);

#ifndef RW_PROBE
#define RW_PROBE 0
#endif
                if (RW_PROBE) { rw_scan_phase<RW_PROBE>(Fp, (const GAS bf16*)MIX, (const GAS bf16*)(MIX + ROWB), (const GAS bf16*)(MIX + 2 * ROWB), (const GAS bf16*)WH, (const GAS bf16*)AH, (GAS bf16*)(Fp.ws + WS_HY), BETA); xcd_barrier(bar); }
                DUP(1, rw_scan_phase<0>(Fp, (const GAS bf16*)MIX, (const GAS bf16*)(MIX + ROWB), (const GAS bf16*)(MIX + 2 * ROWB), (const GAS bf16*)WH, (const GAS bf16*)AH, (GAS bf16*)(Fp.ws + WS_HY), BETA)); SEAM(pb + 4); }
            if (IN(pb + 5)) { PRB(4, gemm_rwg(fresh(F))); gemm_rwg(fresh(F)); SEAM(pb + 5); }
            if (IN(pb + 6)) { const Frame Fp = fresh(F); GAS unsigned char* MIX = Fp.ws + WS_MIX; GAS float* WH = (GAS float*)(MIX + 3 * ROWB); GAS float* AH = WH + (size_t)NTOK * 128; GAS float* BETA = (GAS float*)((GAS bf16*)(AH + (size_t)NTOK * 128) + (size_t)NTOK * 256);
                PRB(4, rwpost_phase(Fp, (const GAS bf16*)(Fp.ws + WS_HY), (const GAS bf16*)(Fp.ws + WS_HY + ROWB), BETA, (const GAS bf16*)(MIX + 2 * ROWB), (const GAS bf16*)MIX, (GAS bf16*)(MIX + ROWB)));
                rwpost_phase(Fp, (const GAS bf16*)(Fp.ws + WS_HY), (const GAS bf16*)(Fp.ws + WS_HY + ROWB), BETA, (const GAS bf16*)(MIX + 2 * ROWB), (const GAS bf16*)MIX, (GAS bf16*)(MIX + ROWB)); SEAM(pb + 6); }
            if (IN(pb + 7)) { const Frame Fp = fresh(F); gemm_resid(Fp, (const GAS bf16*)(Fp.ws + WS_MIX + ROWB), (const GAS bf16*)(Fp.W + W_RW_WOUT), L); SEAM(pb + 7); }
        } else {
            if (IN(pb + 2)) { DUP(3, gemm_hgin(fresh(F))); SEAM(pb + 2); }
            if (IN(pb + 4)) { const Frame Fp = fresh(F); GAS unsigned char* MIX = Fp.ws + WS_MIX;
                if (SC_PROBE) { hg_scan_phase<SC_PROBE>(Fp, (const GAS bf16*)MIX, (const GAS bf16*)(MIX + ROWB), (const GAS bf16*)(MIX + 3 * ROWB), (GAS bf16*)(Fp.ws + WS_HY + ROWB), (GAS bf16*)(Fp.ws + WS_HY)); xcd_barrier(bar); }
                DUP(2, hg_scan_phase<0>(Fp, (const GAS bf16*)MIX, (const GAS bf16*)(MIX + ROWB), (const GAS bf16*)(MIX + 3 * ROWB), (GAS bf16*)(Fp.ws + WS_HY + ROWB), (GAS bf16*)(Fp.ws + WS_HY))); SEAM(pb + 4); }
            if (IN(pb + 6)) { const Frame Fp = fresh(F); GAS unsigned char* MIX = Fp.ws + WS_MIX;
                headnorm_phase(Fp, (const GAS bf16*)(Fp.ws + WS_HY + ROWB), (const GAS bf16*)(Fp.ws + WS_HY), (const GAS bf16*)(MIX + 2 * ROWB), ldptr(Fp, IN_HG_HEADG), (GAS bf16*)(Fp.ws + WS_HY + ROWB)); SEAM(pb + 6); }
            if (IN(pb + 7)) { const Frame Fp = fresh(F); gemm_resid(Fp, (const GAS bf16*)(Fp.ws + WS_HY + ROWB), (const GAS bf16*)(Fp.W + W_HG_WOUT), L); SEAM(pb + 7); }
        }
        if (IN(pb + 8)) { if ((PRB_MASK >> 2) & 1) { norm_phase<1, 1>(fresh(F), L, false, 1024); xcd_barrier(bar); } norm_phase<1>(fresh(F), L, false, 1024); SEAM(pb + 8); }
        if (IN(pb + 9)) { if ((PRB_MASK >> 3) & 1) { slots_phase<1>(fresh(F), L); xcd_barrier(bar); } slots_phase<0>(fresh(F), L); SEAM(pb + 9); }
        if (IN(pb + 10)) { DUP(4, gemm_moe1(fresh(F), L)); SEAM(pb + 10); }
        if (IN(pb + 11)) { DUP(5, gemm_moe2(fresh(F), L)); SEAM(pb + 11); }
    }
    if (IN(PH_FINAL)) norm_phase<2>(fresh(F), 0, true, 1024);
#undef IN
#undef SEAM
}

#ifndef MK_PER_PHASE
#define MK_PER_PHASE 0
#endif
extern "C" void kernel_launch(void* const* d_in, const int* in_sizes, int n_in, void* d_out, int out_size, void* d_ws, size_t ws_size, hipStream_t stream) {
    static int grid = 0;
    if (grid == 0) {
        if (n_in != 42 || out_size != NB * SEQ * D || ws_size < WS_END) { fprintf(stderr, "kernel_launch: unexpected problem (n_in %d, out %d, ws %zu)\n", n_in, out_size, ws_size); grid = -1; return; }
        int dev = 0, cus = 0, per_cu = 0;
        if (hipGetDevice(&dev) != hipSuccess || hipDeviceGetAttribute(&cus, hipDeviceAttributeMultiprocessorCount, dev) != hipSuccess) { grid = -1; return; }
        if (hipFuncSetAttribute((const void*)fwd_kernel, hipFuncAttributeMaxDynamicSharedMemorySize, LDS_BYTES) != hipSuccess) { fprintf(stderr, "kernel_launch: hipFuncSetAttribute failed\n"); grid = -1; return; }
        if (hipOccupancyMaxActiveBlocksPerMultiprocessor(&per_cu, (const void*)fwd_kernel, NTHR, LDS_BYTES) != hipSuccess || per_cu < 1) { fprintf(stderr, "kernel_launch: occupancy query reports %d\n", per_cu); (void)hipGetLastError(); grid = -1; return; }
        grid = cus;
    }
    if (grid < 0) return;
    (void)hipMemsetAsync(d_ws, 0, CTL_ZERO_BYTES, stream);
    Args a{};
    for (int i = 0; i < 42; ++i) a.in[i] = (const float*)d_in[i];
    a.out = (float*)d_out; a.ws = (unsigned char*)d_ws;
    a.wts = (ws_size >= WS_END + W_BYTES) ? (unsigned char*)d_ws + WS_END : (unsigned char*)d_out;
#if MK_PER_PHASE
    for (int p = 0; p < N_PHASES; ++p) { a.ph_lo = p; a.ph_hi = p + 1; hipLaunchKernelGGL(fwd_kernel, dim3(grid), dim3(NTHR), LDS_BYTES, stream, a); }
#else
    a.ph_lo = 0; a.ph_hi = N_PHASES;
    hipLaunchKernelGGL(fwd_kernel, dim3(grid), dim3(NTHR), LDS_BYTES, stream, a);
#endif
}
```

```cpp
#include <hip/hip_runtime.h>
#include <cstdio>
#include <cstdint>

__device__ __forceinline__ float sigmoid_f(float x) { return 1.0f / (1.0f + __expf(-x)); }
__device__ __forceinline__ float silu_f(float x) { return x / (1.0f + __expf(-x)); }
__device__ __forceinline__ float logsigmoid_f(float x) { return fminf(x, 0.f) - log1pf(__expf(-fabsf(x))); }
#define GAS __attribute__((address_space(1)))
namespace pg8 {
#define PG8_LAS __attribute__((address_space(3)))
typedef unsigned short bf16_t;
typedef short bf16x8 __attribute__((ext_vector_type(8)));
typedef float f32x4 __attribute__((ext_vector_type(4)));
typedef unsigned u32x4 __attribute__((ext_vector_type(4)));
constexpr int BM = 256, BK = 64, HALF = 128, HTB = HALF * BK * 2  , STAGE_BYTES = 8 * HTB, NXCD = 8, WGM = 8;

__host__ __device__ __forceinline__ int lds_byte(int r, int c) { const int st = (r >> 4) * 2 + (c >> 5), rr = r & 15, cc = c & 31, ob = rr * 64 + cc * 2; return st * 1024 + (ob ^ (((ob >> 9) & 1) << 5)); }
__host__ __device__ __forceinline__ void stage_rc(int b, int& R, int& C) { const int st = b / 1024, sb = b % 1024, swz = sb ^ (((sb >> 9) & 1) << 5); R = (st >> 1) * 16 + swz / 64; C = (st & 1) * 32 + (swz % 64) / 2; }
__host__ __device__ __forceinline__ int perm32(int rho) { const int n = rho >> 4, i = rho & 15; return 8 * (i >> 2) + 4 * n + (i & 3); }

struct Unit { int pm, pn; };
struct Gemm { const GAS bf16_t* A; const GAS bf16_t* Bt; int M, N, K; const GAS int* gidx; };

struct StaticOrder {
    int nM, nN, nwg, G, c;
    __host__ __device__ void init(int M, int N, int G_, int c_) { nM = M / BM; nN = N / BM; nwg = nM * nN; G = G_; c = c_; }
    __host__ __device__ bool next(int i, Unit& u) const {
        const long L = (long)i * G + c; if (L >= nwg) return false;
        int wgid = (int)L; { const int q = nwg / NXCD, r = nwg % NXCD, xcd = wgid % NXCD, off = wgid / NXCD; wgid = (xcd < r ? xcd * (q + 1) : r * (q + 1) + (xcd - r) * q) + off; }
        const int nig = WGM * nN, gid = wgid / nig, fm = gid * WGM, gsz = (nM - fm) < WGM ? (nM - fm) : WGM;
        u.pm = fm + ((wgid % nig) % gsz); u.pn = (wgid % nig) / gsz; return true;
    }
    __device__ __forceinline__ void a_ready(const Unit&) const {}
    __device__ __forceinline__ void done(const Unit&) const {}
};
__device__ __forceinline__ unsigned cvt_pk_bf16(float lo, float hi) { unsigned r; asm volatile("v_cvt_pk_bf16_f32 %0, %1, %2" : "=v"(r) : "v"(lo), "v"(hi)); return r; }
typedef unsigned u32x2 __attribute__((ext_vector_type(2)));
__device__ __forceinline__ void st8(GAS bf16_t* p, f32x4 v0, f32x4 v1) { u32x4 w; w.x = cvt_pk_bf16(v0[0], v0[1]); w.y = cvt_pk_bf16(v0[2], v0[3]); w.z = cvt_pk_bf16(v1[0], v1[1]); w.w = cvt_pk_bf16(v1[2], v1[3]); *(GAS u32x4*)p = w; }
template <int ACT> __device__ __forceinline__ f32x4 act4(f32x4 v) {
    if (ACT == 1) { v[0] = sigmoid_f(v[0]); v[1] = sigmoid_f(v[1]); v[2] = sigmoid_f(v[2]); v[3] = sigmoid_f(v[3]); }
    if (ACT == 2) { v[0] = silu_f(v[0]); v[1] = silu_f(v[1]); v[2] = silu_f(v[2]); v[3] = silu_f(v[3]); }
    return v; }
template <int ACT> __device__ __forceinline__ void store_tile_bf16(const f32x4 (&acc)[2][2][4][2], GAS bf16_t* base, int ld, int row0, int cw) {
#pragma unroll
    for (int ai = 0; ai < 2; ++ai)
#pragma unroll
        for (int m = 0; m < 4; ++m) { GAS bf16_t* rp = base + (size_t)(row0 + ai * HALF + m * 16) * ld + cw;
#pragma unroll
            for (int bj = 0; bj < 2; ++bj) st8(rp + bj * HALF, act4<ACT>(acc[ai][bj][m][0]), act4<ACT>(acc[ai][bj][m][1])); }
}
struct EpiBf16Plain { static constexpr bool PERM = true, AFTER_DRAIN = false; GAS bf16_t* O; int ldc;
    __device__ __forceinline__ void operator()(const f32x4 (&acc)[2][2][4][2], const Unit& u, int wr, int wc, int fr, int fq) const {
        store_tile_bf16<0>(acc, O + u.pn * BM, ldc, u.pm * BM + wr * 64 + fr, wc * 32 + 8 * fq); }
};
struct EpiMlstmIn { static constexpr bool PERM = true, AFTER_DRAIN = false;
    GAS bf16_t* QKPRE; GAS bf16_t* V; GAS bf16_t* OG; GAS float* GATES; const GAS float* bgate;
    __device__ __forceinline__ void operator()(const f32x4 (&acc)[2][2][4][2], const Unit& u, int wr, int wc, int fr, int fq) const {
        const int row0 = u.pm * BM + wr * 64 + fr, cw = wc * 32 + 8 * fq;
        if (u.pn < 8) store_tile_bf16<0>(acc, QKPRE + u.pn * BM, 2048, row0, cw);
        else if (u.pn < 12) store_tile_bf16<0>(acc, V + (u.pn - 8) * BM, 1024, row0, cw);
        else if (u.pn < 16) store_tile_bf16<1>(acc, OG + (u.pn - 12) * BM, 1024, row0, cw);
        else if (wc == 0) {
            const f32x4 b0 = *(const GAS f32x4*)(bgate + 8 * fq), b1 = *(const GAS f32x4*)(bgate + 8 * fq + 4);
#pragma unroll
            for (int ai = 0; ai < 2; ++ai)
#pragma unroll
                for (int m = 0; m < 4; ++m) { GAS float* gp = GATES + (size_t)(row0 + ai * HALF + m * 16) * 32 + 8 * fq;
                    *(GAS f32x4*)gp = acc[ai][0][m][0] + b0; *(GAS f32x4*)(gp + 4) = acc[ai][0][m][1] + b1; }
        }
    }
};
struct EpiRwkvIn { static constexpr bool PERM = true, AFTER_DRAIN = false;
    GAS bf16_t* R; GAS bf16_t* Kk; GAS bf16_t* V; GAS float* WH; GAS float* AH; GAS bf16_t* GH;
    __device__ __forceinline__ void operator()(const f32x4 (&acc)[2][2][4][2], const Unit& u, int wr, int wc, int fr, int fq) const {
        const int row0 = u.pm * BM + wr * 64 + fr, cw = wc * 32 + 8 * fq;
        if (u.pn < 4) store_tile_bf16<0>(acc, R + u.pn * BM, 1024, row0, cw);
        else if (u.pn < 8) store_tile_bf16<0>(acc, Kk + (u.pn - 4) * BM, 1024, row0, cw);
        else if (u.pn < 12) store_tile_bf16<0>(acc, V + (u.pn - 8) * BM, 1024, row0, cw);
        else if (u.pn == 12) {
#pragma unroll
            for (int ai = 0; ai < 2; ++ai)
#pragma unroll
                for (int m = 0; m < 4; ++m) { const size_t r = (size_t)(row0 + ai * HALF + m * 16);
                    f32x4 t0 = acc[ai][0][m][0], t1 = acc[ai][0][m][1];
#pragma unroll
                    for (int j = 0; j < 4; ++j) { t0[j] = tanhf(t0[j]); t1[j] = tanhf(t1[j]); }
                    st8((GAS bf16_t*)WH + r * 128 + cw, t0, t1); st8((GAS bf16_t*)AH + r * 128 + cw, acc[ai][1][m][0], acc[ai][1][m][1]); }
        } else {
#pragma unroll
            for (int ai = 0; ai < 2; ++ai)
#pragma unroll
                for (int m = 0; m < 4; ++m) { GAS bf16_t* rp = GH + (size_t)(row0 + ai * HALF + m * 16) * 256 + cw;
                    st8(rp, act4<1>(acc[ai][0][m][0]), act4<1>(acc[ai][0][m][1])); *(GAS u32x4*)(rp + HALF) = (u32x4){0u, 0u, 0u, 0u}; }
        }
    }
};
struct EpiHgrnIn { static constexpr bool PERM = true, AFTER_DRAIN = false;
    GAS bf16_t* Q; GAS bf16_t* V; GAS bf16_t* OG; GAS bf16_t* LF; size_t lf_stride; const GAS float* bf; const GAS float* lb;
    __device__ __forceinline__ void operator()(const f32x4 (&acc)[2][2][4][2], const Unit& u, int wr, int wc, int fr, int fq) const {
        const int row0 = u.pm * BM + wr * 64 + fr, cw = wc * 32 + 8 * fq;
        if (u.pn < 4) store_tile_bf16<2>(acc, Q + u.pn * BM, 1024, row0, cw);
        else if (u.pn < 8) store_tile_bf16<0>(acc, V + (u.pn - 4) * BM, 1024, row0, cw);
        else if (u.pn < 12) store_tile_bf16<2>(acc, OG + (u.pn - 8) * BM, 1024, row0, cw);
        else {
            const int dir = (u.pn - 12) >> 2, ct = ((u.pn - 12) & 3) * BM; GAS bf16_t* base = LF + (size_t)dir * lf_stride + ct;
            f32x4 bb[2][2], ll[2][2];
#pragma unroll
            for (int bj = 0; bj < 2; ++bj)
#pragma unroll
                for (int n = 0; n < 2; ++n) { bb[bj][n] = *(const GAS f32x4*)(bf + dir * 1024 + ct + bj * HALF + cw + 4 * n); ll[bj][n] = *(const GAS f32x4*)(lb + ct + bj * HALF + cw + 4 * n); }
#pragma unroll
            for (int ai = 0; ai < 2; ++ai)
#pragma unroll
                for (int m = 0; m < 4; ++m) { GAS bf16_t* rp = base + (size_t)(row0 + ai * HALF + m * 16) * 1024 + cw;
#pragma unroll
                    for (int bj = 0; bj < 2; ++bj) { f32x4 o[2];
#pragma unroll
                        for (int n = 0; n < 2; ++n)
#pragma unroll
                            for (int j = 0; j < 4; ++j) { const float l = ll[bj][n][j]; o[n][j] = __logf(l + (1.f - l) * sigmoid_f(acc[ai][bj][m][n][j] + bb[bj][n][j])); }
                        st8(rp + bj * HALF, o[0], o[1]); } }
        }
    }
};
struct EpiResid { static constexpr bool PERM = false, AFTER_DRAIN = false;
    GAS float* S; const GAS float* mod; int gate_idx;
    __device__ __forceinline__ void operator()(const f32x4 (&acc)[2][2][4][2], const Unit& u, int wr, int wc, int fr, int fq) const {
        const int b = u.pm / 33, seg = (u.pm - b * 33 == 0) ? 0 : 1 + b;
        const int row0 = u.pm * BM + wr * 64 + fr, col0 = u.pn * BM + wc * 32 + 4 * fq;
        const GAS float* gp = mod + seg * 6144 + gate_idx * 1024 + col0;
        f32x4 gv[2][2];
#pragma unroll
        for (int bj = 0; bj < 2; ++bj)
#pragma unroll
            for (int n = 0; n < 2; ++n) gv[bj][n] = *(const GAS f32x4*)(gp + bj * HALF + n * 16);
#pragma unroll
        for (int ai = 0; ai < 2; ++ai)
#pragma unroll
            for (int m = 0; m < 4; ++m) { GAS float* rowp = S + (size_t)(row0 + ai * HALF + m * 16) * 1024 + col0;
#pragma unroll
                for (int bj = 0; bj < 2; ++bj)
#pragma unroll
                    for (int n = 0; n < 2; ++n) { GAS f32x4* p = (GAS f32x4*)(rowp + bj * HALF + n * 16); *p = *p + acc[ai][bj][m][n] * gv[bj][n]; } }
    }
};
struct EpiMoe1 { static constexpr bool PERM = true, AFTER_DRAIN = false; GAS bf16_t* ACT;
    __device__ __forceinline__ void operator()(const f32x4 (&acc)[2][2][4][2], const Unit& u, int wr, int wc, int fr, int fq) const {
        const int row0 = u.pm * BM + wr * 64 + fr, pnl = u.pn & 3, c0 = pnl * 128 + wc * 16 + 4 * fq;
#pragma unroll
        for (int ai = 0; ai < 2; ++ai)
#pragma unroll
            for (int m = 0; m < 4; ++m) { GAS bf16_t* rp = ACT + (size_t)(row0 + ai * HALF + m * 16) * 512 + c0;
#pragma unroll
                for (int bj = 0; bj < 2; ++bj) { const f32x4 a = acc[ai][bj][m][0], b = acc[ai][bj][m][1];
                    u32x2 w; w.x = cvt_pk_bf16(silu_f(a[0]) * b[0], silu_f(a[1]) * b[1]); w.y = cvt_pk_bf16(silu_f(a[2]) * b[2], silu_f(a[3]) * b[3]);
                    *(GAS u32x2*)(rp + bj * 64) = w; } }
    }
};
struct EpiMoe2 { static constexpr bool PERM = true, AFTER_DRAIN = false; GAS bf16_t* YM; const GAS int* slot_tok; const GAS float* slot_gate;
    __device__ __forceinline__ void operator()(const f32x4 (&acc)[2][2][4][2], const Unit& u, int wr, int wc, int fr, int fq) const {
        const int row0 = u.pm * BM + wr * 64 + fr, col0 = (u.pn & 3) * BM + wc * 32 + 8 * fq;
#pragma unroll
        for (int ai = 0; ai < 2; ++ai)
#pragma unroll
            for (int m = 0; m < 4; ++m) { const int slot = row0 + ai * HALF + m * 16; const int dst = slot_tok[slot]; const float g = slot_gate[slot];
                if (dst >= 0) { GAS bf16_t* rp = YM + (size_t)dst * 1024 + col0;
#pragma unroll
                    for (int bj = 0; bj < 2; ++bj) st8(rp + bj * HALF, acc[ai][bj][m][0] * g, acc[ai][bj][m][1] * g); } }
    }
};
struct MoeOrder { const PG8_LAS int* pref; int G, c;
    __device__ __forceinline__ bool next(int i, Unit& u) const {
        const int L = i * G + c, nt = pref[16]; if (L >= nt * 4) return false;
        const int tile = L >> 2; int e = 0;
#pragma unroll
        for (int j = 1; j < 16; ++j) e += (tile >= pref[j]) ? 1 : 0;
        u.pm = tile; u.pn = e * 4 + (L & 3); return true; }
    __device__ __forceinline__ void a_ready(const Unit&) const {}
    __device__ __forceinline__ void done(const Unit&) const {}
};
template <class Epi, class Sched, bool ALIGN_EPI = false, bool SP2 = false, bool GATHER = false>
__device__ __forceinline__ void gemm_phase(PG8_LAS unsigned char* lds, const Gemm g, const Sched& S, const Epi& E, const int tid_in) {
    int tid_ = tid_in; asm volatile("" : "+v"(tid_));
    const int tid = tid_, wid = __builtin_amdgcn_readfirstlane(tid >> 6), lane = tid & 63, wr = wid >> 2, wc = wid & 3, fr = lane & 15, fq = lane >> 4;
    const int K = g.K, nt = K / BK;
    unsigned voffA[2], voffB[2];
#pragma unroll
    for (int i = 0; i < 2; ++i) { int R, C; stage_rc(tid * 16 + i * 8192, R, C); const int Rb = Epi::PERM ? ((R & ~31) + perm32(R & 31)) : R;
        voffA[i] = (unsigned)(R * K + C) * 2u; voffB[i] = (unsigned)(Rb * K + C) * 2u; }
    unsigned offc[2][2], offn[2][2];
#define PG8_GOFF(dst, unit) do { _Pragma("unroll") for (int _h = 0; _h < 2; ++_h) _Pragma("unroll") for (int _i = 0; _i < 2; ++_i) { int _R, _C; stage_rc(tid * 16 + _i * 8192, _R, _C); \
        const int _t = g.gidx[(unit).pm * BM + _h * HALF + _R]; dst[_h][_i] = (unsigned)(((_t < 0 ? 0 : (_t >> 1)) * K + _C) * 2); } } while (0)
    const size_t kstep = (size_t)(BK * 2);
    const size_t hstep = (size_t)HALF * K * 2;
    const size_t tstep = 2 * hstep;
    if constexpr (!GATHER) {
#pragma unroll
        for (int h_ = 0; h_ < 2; ++h_)
#pragma unroll
            for (int i = 0; i < 2; ++i) { offc[h_][i] = voffA[i] + (unsigned)(h_ * hstep); offn[h_][i] = offc[h_][i]; } }
    const unsigned ldsw = (unsigned)wid * 1024u;
    const int aoff = lds_byte(wr * 64 + fr, fq * 8), boff = lds_byte(wc * 32 + fr, fq * 8);
#define PG8_SA(b, h) (((b) * 2 + (h)) * HTB)
#define PG8_SB(b, h) ((4 + (b) * 2 + (h)) * HTB)
#define PG8_STAGE(bufoff, gbase, voff) do { _Pragma("unroll") for (int _i = 0; _i < 2; ++_i) \
        __builtin_amdgcn_global_load_lds((const unsigned*)((const char*)(gbase) + (voff)[_i]), (PG8_LAS unsigned*)(lds + (bufoff) + ldsw + _i * 8192), 16, 0, 0); } while (0)
#define PG8_STAGE_A(bufoff, gbase, off2) do { _Pragma("unroll") for (int _i = 0; _i < 2; ++_i) \
        __builtin_amdgcn_global_load_lds((const unsigned*)((const char*)(gbase) + (off2)[_i]), (PG8_LAS unsigned*)(lds + (bufoff) + ldsw + _i * 8192), 16, 0, 0); } while (0)
#define PG8_LDA(dst, b, h) do { _Pragma("unroll") for (int m = 0; m < 4; ++m) _Pragma("unroll") for (int k = 0; k < 2; ++k) dst[m][k] = *(const PG8_LAS bf16x8*)(lds + PG8_SA(b, h) + aoff + m * 2048 + k * 1024); } while (0)
#define PG8_LDB(dst, b, h) do { _Pragma("unroll") for (int n = 0; n < 2; ++n) _Pragma("unroll") for (int k = 0; k < 2; ++k) dst[n][k] = *(const PG8_LAS bf16x8*)(lds + PG8_SB(b, h) + boff + n * 2048 + k * 1024); } while (0)
#define PG8_MMA(ai, bj, At, Bt) do { __builtin_amdgcn_s_setprio(1); _Pragma("unroll") for (int m = 0; m < 4; ++m) _Pragma("unroll") for (int n = 0; n < 2; ++n) _Pragma("unroll") for (int k = 0; k < 2; ++k) \
        acc[ai][bj][m][n] = __builtin_amdgcn_mfma_f32_16x16x32_bf16(Bt[n][k], At[m][k], acc[ai][bj][m][n], 0, 0, 0); __builtin_amdgcn_s_setprio(0); } while (0)
#define PG8_WAIT_V(n) asm volatile("s_waitcnt vmcnt(" #n ")" ::: "memory")
#define PG8_WAIT_L(n) asm volatile("s_waitcnt lgkmcnt(" #n ")" ::: "memory")
#define PG8_BAR __builtin_amdgcn_s_barrier()
#define PG8_SCHED __builtin_amdgcn_sched_barrier(0)
    Unit cur, nxt; int ui = 0;
    if (!S.next(0, cur)) return;
    f32x4 acc[2][2][4][2];
#pragma unroll
    for (int a = 0; a < 2; ++a)
#pragma unroll
        for (int b = 0; b < 2; ++b)
#pragma unroll
            for (int m = 0; m < 4; ++m)
#pragma unroll
                for (int n = 0; n < 2; ++n) acc[a][b][m][n] = (f32x4){0.f, 0.f, 0.f, 0.f};
    bf16x8 At[4][2], B0[2][2], B1[2][2];
    const char* cA = (const char*)g.A + (GATHER ? (size_t)0 : (size_t)cur.pm * tstep); const char* cB = (const char*)g.Bt + (size_t)cur.pn * tstep;
    S.a_ready(cur);
    if constexpr (GATHER) PG8_GOFF(offc, cur);
    if constexpr (SP2) {
        PG8_STAGE(PG8_SB(0, 0), cB, voffB); PG8_STAGE(PG8_SB(0, 1), cB + hstep, voffB); PG8_STAGE_A(PG8_SA(0, 0), cA, offc[0]); PG8_STAGE_A(PG8_SA(0, 1), cA, offc[1]);
        if (wr == 1) PG8_BAR;
        PG8_WAIT_V(2); PG8_BAR;
        PG8_STAGE(PG8_SB(1, 0), cB + kstep, voffB); PG8_STAGE_A(PG8_SA(1, 0), cA + kstep, offc[0]); PG8_STAGE(PG8_SB(1, 1), cB + hstep + kstep, voffB);
        PG8_WAIT_V(6); PG8_BAR;
    } else {
        PG8_STAGE(PG8_SB(0, 0), cB, voffB); PG8_STAGE_A(PG8_SA(0, 0), cA, offc[0]); PG8_STAGE(PG8_SB(0, 1), cB + hstep, voffB); PG8_STAGE_A(PG8_SA(0, 1), cA, offc[1]);
        if (wr == 1) PG8_BAR;
        PG8_WAIT_V(4); PG8_BAR;
        PG8_STAGE(PG8_SB(1, 0), cB + kstep, voffB); PG8_STAGE_A(PG8_SA(1, 0), cA + kstep, offc[0]); PG8_STAGE(PG8_SB(1, 1), cB + hstep + kstep, voffB);
        PG8_WAIT_V(6); PG8_BAR;
    }
    for (;;) {
        const bool has_next = S.next(ui + 1, nxt);
        const char* nA = (has_next && !GATHER) ? (const char*)g.A + (size_t)nxt.pm * tstep : cA; const char* nB = has_next ? (const char*)g.Bt + (size_t)nxt.pn * tstep : cB;
        if constexpr (GATHER) { if (has_next) PG8_GOFF(offn, nxt); else {
#pragma unroll
            for (int h_ = 0; h_ < 2; ++h_)
#pragma unroll
                for (int i = 0; i < 2; ++i) offn[h_][i] = offc[h_][i]; } }
        for (int t = 0; t < nt; t += 2) {
            const bool last = (t == nt - 2);
            const char* a1 = cA + (size_t)(t + 1) * kstep;
            const char* a2 = last ? nA : cA + (size_t)(t + 2) * kstep; const char* b2 = last ? nB : cB + (size_t)(t + 2) * kstep;
            const char* a3 = a2 + kstep; const char* b3 = b2 + kstep;
            if (last && has_next) S.a_ready(nxt);
            if constexpr (SP2) {
            PG8_LDB(B0, 0, 0); PG8_LDB(B1, 0, 1); PG8_SCHED; PG8_LDA(At, 0, 0); PG8_STAGE_A(PG8_SA(1, 1), a1, offc[1]); if constexpr (GATHER) { if (last) { offc[0][0] = offn[0][0]; offc[0][1] = offn[0][1]; offc[1][0] = offn[1][0]; offc[1][1] = offn[1][1]; } }
            PG8_WAIT_V(8); PG8_WAIT_L(0); PG8_BAR; PG8_MMA(0, 0, At, B0); PG8_MMA(0, 1, At, B1); PG8_BAR; PG8_SCHED;
            PG8_LDA(At, 0, 1); PG8_STAGE(PG8_SB(0, 0), b2, voffB); PG8_STAGE(PG8_SB(0, 1), b2 + hstep, voffB); PG8_STAGE_A(PG8_SA(0, 0), a2, offc[0]);
            PG8_WAIT_V(8); PG8_WAIT_L(0); PG8_BAR; PG8_MMA(1, 0, At, B0); PG8_MMA(1, 1, At, B1); PG8_BAR; PG8_SCHED;
            PG8_LDB(B0, 1, 0); PG8_LDB(B1, 1, 1); PG8_SCHED; PG8_LDA(At, 1, 0); PG8_STAGE_A(PG8_SA(0, 1), a2, offc[1]);
            PG8_WAIT_V(8); PG8_WAIT_L(0); PG8_BAR; PG8_MMA(0, 0, At, B0); PG8_MMA(0, 1, At, B1); PG8_BAR; PG8_SCHED;
            PG8_LDA(At, 1, 1); PG8_STAGE(PG8_SB(1, 0), b3, voffB); PG8_STAGE(PG8_SB(1, 1), b3 + hstep, voffB); PG8_STAGE_A(PG8_SA(1, 0), a3, offc[0]);
            PG8_WAIT_V(8); PG8_WAIT_L(0); PG8_BAR; PG8_MMA(1, 0, At, B0); PG8_MMA(1, 1, At, B1); PG8_BAR; PG8_SCHED;
            } else {
            PG8_LDB(B0, 0, 0); PG8_SCHED; PG8_LDA(At, 0, 0); PG8_STAGE_A(PG8_SA(1, 1), a1, offc[1]); if constexpr (GATHER) { if (last) { offc[0][0] = offn[0][0]; offc[0][1] = offn[0][1]; offc[1][0] = offn[1][0]; offc[1][1] = offn[1][1]; } }
            PG8_WAIT_L(8); PG8_BAR; PG8_WAIT_L(0); PG8_MMA(0, 0, At, B0); PG8_BAR; PG8_SCHED;
            PG8_LDB(B1, 0, 1); PG8_STAGE(PG8_SB(0, 0), b2, voffB);
            PG8_BAR; PG8_WAIT_L(0); PG8_MMA(0, 1, At, B1); PG8_BAR;
            PG8_LDA(At, 0, 1); PG8_STAGE_A(PG8_SA(0, 0), a2, offc[0]);
            PG8_BAR; PG8_WAIT_L(0); PG8_MMA(1, 0, At, B0); PG8_BAR; PG8_SCHED;
            PG8_STAGE(PG8_SB(0, 1), b2 + hstep, voffB);
            PG8_WAIT_V(6); PG8_BAR; PG8_MMA(1, 1, At, B1); PG8_BAR;
            PG8_LDB(B0, 1, 0); PG8_SCHED; PG8_LDA(At, 1, 0); PG8_STAGE_A(PG8_SA(0, 1), a2, offc[1]);
            PG8_WAIT_L(8); PG8_BAR; PG8_WAIT_L(0); PG8_MMA(0, 0, At, B0); PG8_BAR; PG8_SCHED;
            PG8_LDB(B1, 1, 1); PG8_STAGE(PG8_SB(1, 0), b3, voffB);
            PG8_BAR; PG8_WAIT_L(0); PG8_MMA(0, 1, At, B1); PG8_BAR;
            PG8_LDA(At, 1, 1); PG8_STAGE_A(PG8_SA(1, 0), a3, offc[0]);
            PG8_BAR; PG8_WAIT_L(0); PG8_MMA(1, 0, At, B0); PG8_BAR; PG8_SCHED;
            PG8_STAGE(PG8_SB(1, 1), b3 + hstep, voffB);
            PG8_WAIT_V(6); PG8_BAR; PG8_MMA(1, 1, At, B1); PG8_BAR;
            }
        }
        if constexpr (ALIGN_EPI) { if (wr == 0) PG8_BAR; }
        if constexpr (!Epi::AFTER_DRAIN) { E(acc, cur, wr, wc, fr, fq); S.done(cur); }
        if (!has_next) break;
#pragma unroll
        for (int a = 0; a < 2; ++a)
#pragma unroll
            for (int b = 0; b < 2; ++b)
#pragma unroll
                for (int m = 0; m < 4; ++m)
#pragma unroll
                    for (int n = 0; n < 2; ++n) acc[a][b][m][n] = (f32x4){0.f, 0.f, 0.f, 0.f};
        cur = nxt; cA = nA; cB = nB; ++ui;

        if constexpr (ALIGN_EPI) { if (wr == 1) PG8_BAR; }
    }
    PG8_WAIT_V(0);
    if constexpr (!ALIGN_EPI) { if (wr == 0) PG8_BAR; }
    PG8_BAR;
    if constexpr (Epi::AFTER_DRAIN) { E.fused(acc, cur, wr, wc, fr, fq, lds, wid, lane); S.done(cur); }
#undef PG8_SA
#undef PG8_SB
#undef PG8_STAGE
#undef PG8_STAGE_A
#undef PG8_GOFF
#undef PG8_LDA
#undef PG8_LDB
#undef PG8_MMA
#undef PG8_WAIT_V
#undef PG8_WAIT_L
#undef PG8_BAR
#undef PG8_SCHED
}
}

#define LAS __attribute__((address_space(3)))
#ifndef PHASE_FN
#define PHASE_FN __device__ __forceinline__
#endif
#ifndef GEMM_SP2
#define GEMM_SP2 true
#endif
#ifndef GEMM_ALIGN
#define GEMM_ALIGN false
#endif
typedef unsigned short bf16;
typedef pg8::bf16x8 bf16x8;
typedef pg8::f32x4 f32x4;
typedef pg8::u32x4 u32x4;
typedef pg8::u32x2 u32x2;
constexpr int D = 1024, NB = 4, SEQ = 8192, CTX = 256, T = CTX + SEQ, NTOK = NB * T, DEPTH = 4;
constexpr int NWAVES = 8, NTHR = 512;
constexpr int NSLOT = 71680;
constexpr size_t MiB = 1u << 20;
constexpr size_t CTL_ZERO_BYTES = 2 * MiB;
constexpr int CW_BAR = 1024;
constexpr int CW_MOE = 8192;
constexpr size_t WS_MOD = 1 * MiB;
constexpr size_t WS_LB = 2 * MiB;
constexpr size_t WS_TOK = 2 * MiB + 65536;
constexpr size_t WS_SLOT_TOK = 3 * MiB;
constexpr size_t WS_SLOT_GATE = 3 * MiB + 524288;
constexpr size_t WS_S = 4 * MiB;
constexpr size_t WS_HY = 136 * MiB;
constexpr size_t WS_MIX = 268 * MiB;
constexpr size_t WS_END = 610 * MiB;
constexpr size_t ROWB = (size_t)NTOK * 1024 * 2;
constexpr size_t W_ML_WIN = 0, W_ML_WIN_SZ = (size_t)4352 * 1024 * 2;
constexpr size_t W_ML_WOUT = 17 * MiB;
constexpr size_t W_RW_IN = 21 * MiB;
constexpr size_t W_RW_G2 = 35 * MiB;
constexpr size_t W_RW_WOUT = 36 * MiB;
constexpr size_t W_HG_IN = 38 * MiB;
constexpr size_t W_HG_WOUT = 48 * MiB;
constexpr size_t W_EX13 = 50 * MiB;
constexpr size_t W_EX2 = 82 * MiB;
constexpr size_t W_BYTES = 98 * MiB;
constexpr int LDS_PHASE_BYTES = 131072;
constexpr int LDS_BYTES = 163840;
constexpr int MISC_OFF = LDS_BYTES - 2048;

#define VM_WAIT() asm volatile("s_waitcnt vmcnt(0)" ::: "memory")
#define LDS_WAIT() asm volatile("s_waitcnt lgkmcnt(0)" ::: "memory")
typedef float f32x2_t __attribute__((ext_vector_type(2))); typedef __bf16 bf16x2_t __attribute__((ext_vector_type(2)));
__device__ __forceinline__ unsigned pk2(float lo, float hi) { f32x2_t v = {lo, hi}; bf16x2_t b = __builtin_convertvector(v, bf16x2_t); return __builtin_bit_cast(unsigned, b); }
__device__ __forceinline__ unsigned f2bf(float f) { return pk2(f, f) & 0xffffu; }
__device__ __forceinline__ float bf2f(unsigned b) { return __builtin_bit_cast(float, b << 16); }
__device__ __forceinline__ float bflo(unsigned w) { return __builtin_bit_cast(float, w << 16); }
__device__ __forceinline__ float bfhi(unsigned w) { return __builtin_bit_cast(float, w & 0xffff0000u); }
__device__ __forceinline__ float wave_sum(float v) {
#pragma unroll
    for (int o = 1; o < 64; o <<= 1) v += __shfl_xor(v, o);
    return v; }
__device__ __forceinline__ float wave_max(float v) {
#pragma unroll
    for (int o = 1; o < 64; o <<= 1) v = fmaxf(v, __shfl_xor(v, o));
    return v; }
template <int CTRL> __device__ __forceinline__ float dpp_f(float v) { return __builtin_bit_cast(float, __builtin_amdgcn_update_dpp(0, __builtin_bit_cast(int, v), CTRL, 0xF, 0xF, false)); }
__device__ __forceinline__ float row16_sum(float v) { v += dpp_f<0xB1>(v); v += dpp_f<0x4E>(v); v += dpp_f<0x124>(v); v += dpp_f<0x128>(v); return v; }
template <int K> __device__ __forceinline__ f32x4 mm16(f32x4 acc, const LAS bf16* A, int lda, const LAS bf16* Bt, int ldb, int lane) {
    const int r = lane & 15, q = lane >> 4;
#pragma unroll
    for (int kk = 0; kk < K / 32; ++kk) {
        const bf16x8 a = *(const LAS bf16x8*)(A + r * lda + kk * 32 + q * 8);
        const bf16x8 b = *(const LAS bf16x8*)(Bt + r * ldb + kk * 32 + q * 8);
        acc = __builtin_amdgcn_mfma_f32_16x16x32_bf16(a, b, acc, 0, 0, 0); }
    return acc; }
typedef short s16x4 __attribute__((ext_vector_type(4)));
__device__ __forceinline__ bf16x8 tr_frag(const LAS bf16* X, int ld, int k0, int n0, int lane) {
    const int g = lane >> 4, a = (lane & 15) >> 2, p = lane & 3;
    const LAS bf16* p0 = X + (k0 + 8 * g + a) * ld + n0 + 4 * p;
    const s16x4 lo = __builtin_amdgcn_ds_read_tr16_b64_v4i16((LAS s16x4*)p0), hi = __builtin_amdgcn_ds_read_tr16_b64_v4i16((LAS s16x4*)(p0 + 4 * ld));
    return (bf16x8){lo[0], lo[1], lo[2], lo[3], hi[0], hi[1], hi[2], hi[3]}; }
__device__ __forceinline__ bf16x8 row_frag(const LAS bf16* A, int ld, int k0, int lane) { return *(const LAS bf16x8*)(A + (lane & 15) * ld + k0 + (lane >> 4) * 8); }
__device__ __forceinline__ int seq_row(int b, int dir, int i) {
    const int tt = (i < CTX) ? (dir ? CTX - 1 - i : i) : CTX + (dir ? SEQ - 1 - (i - CTX) : (i - CTX));
    return b * T + tt; }

#define XB_TMO      128
#define XB_XCNT(j)  (256  + 64 * (j))
#define XB_XSUB(j)  (1280 + 64 * (j))
#define XB_XGEN(j)  (2304 + 64 * (j))
#define XB_TOP      3328
#define XB_TOPGEN   3392
#define XCD_BAR_WORDS 3456
#define XB_SPIN_CAP (1u << 18)

__device__ __forceinline__ unsigned xb_ld(unsigned* p)              { return __hip_atomic_load(p, __ATOMIC_RELAXED, __HIP_MEMORY_SCOPE_AGENT); }
__device__ __forceinline__ unsigned xb_add(unsigned* p, unsigned v) { return __hip_atomic_fetch_add(p, v, __ATOMIC_RELAXED, __HIP_MEMORY_SCOPE_AGENT); }
__device__ __forceinline__ unsigned xb_xcc_id() { return (unsigned)__builtin_amdgcn_s_getreg((3 << 11) | 20) & 0xFu; }
#define XB_SPIN(cond, bar) do { unsigned _sp = 0; while (cond) { __builtin_amdgcn_s_sleep(1); \
    if ((++_sp & 255u) == 0u) { if (xb_ld(&(bar)[XB_TMO])) break; if (_sp > XB_SPIN_CAP) { atomicAdd(&(bar)[XB_TMO], 1u); break; } } } } while (0)

struct XcdBarrier {
    unsigned* bar; unsigned x;
    volatile LAS unsigned* st;
};

__device__ __forceinline__ XcdBarrier xcd_barrier_post(unsigned* bar, volatile LAS unsigned* st) {
    XcdBarrier b; b.bar = bar; b.x = xb_xcc_id(); b.st = st;
    if (threadIdx.x == 0) (void)xb_add(&bar[XB_XCNT(b.x)], 1u);
    return b;
}
__device__ __forceinline__ void xcd_barrier_complete(unsigned* bar, unsigned x, unsigned& nloc, unsigned& nx) {
    const unsigned G = gridDim.x * gridDim.y * gridDim.z;
    unsigned sum, cnt, mine, sp = 0u;
    for (;;) {
        sum = 0u; cnt = 0u; mine = 0u;
#pragma unroll
        for (unsigned j = 0; j < 16; ++j) { const unsigned c = xb_ld(&bar[XB_XCNT(j)]); sum += c; cnt += (c > 0u) ? 1u : 0u; mine = (j == x) ? c : mine; }
        if (sum == G) break;
        __builtin_amdgcn_s_sleep(1);
        if ((++sp & 255u) == 0u) { if (xb_ld(&bar[XB_TMO])) break; if (sp > XB_SPIN_CAP) { atomicAdd(&bar[XB_TMO], 1u); break; } }
    }
    nloc = mine > 0u ? mine : 1u; nx = cnt > 0u ? cnt : 1u;
}

__device__ __forceinline__ void xcd_barrier(const XcdBarrier& b) {
    asm volatile("s_waitcnt vmcnt(0)" ::: "memory");
    __syncthreads();
    if (threadIdx.x == 0) {
        unsigned* bar = b.bar;
        __builtin_amdgcn_s_waitcnt(0);
        unsigned nloc = b.st[0], nx = b.st[1];
        if (nloc == 0u) { xcd_barrier_complete(bar, b.x, nloc, nx); b.st[0] = nloc; b.st[1] = nx; }
        const unsigned old = xb_add(&bar[XB_XSUB(b.x)], 1u);
        const unsigned gen = old / nloc;
        if (old + 1u == (gen + 1u) * nloc) {
            __builtin_amdgcn_fence(__ATOMIC_RELEASE, "agent");
            asm volatile("s_waitcnt vmcnt(0)" ::: "memory");
            const unsigned og = xb_add(&bar[XB_TOP], 1u);
            const unsigned tg = og / nx;
            if (og + 1u == (tg + 1u) * nx) xb_add(&bar[XB_TOPGEN], 1u);
            else XB_SPIN(xb_ld(&bar[XB_TOPGEN]) == tg, bar);
            __builtin_amdgcn_fence(__ATOMIC_ACQUIRE, "agent");
            xb_add(&bar[XB_XGEN(b.x)], 1u);
            asm volatile("s_waitcnt vmcnt(0)" ::: "memory");
        } else {
            XB_SPIN(xb_ld(&bar[XB_XGEN(b.x)]) == gen, bar);
            __builtin_amdgcn_fence(__ATOMIC_ACQUIRE, "agent");
            asm volatile("s_waitcnt vmcnt(0)" ::: "memory");
        }
    }
    __syncthreads();
}

struct Args { const float* in[42]; float* out; unsigned char* ws; unsigned char* wts; int ph_lo, ph_hi; };
struct Frame {
    LAS unsigned char* lds; GAS float* out; GAS unsigned char* ws; GAS unsigned char* W;
    int tid, lane, wave, bid, G;
};
constexpr int PTAB_OFF = MISC_OFF + 512;
__device__ __forceinline__ const GAS float* ldptr(const Frame& F, int i) { const unsigned long long v = ((const LAS unsigned long long*)(F.lds + PTAB_OFF))[i];
    const unsigned lo = __builtin_amdgcn_readfirstlane((unsigned)v), hi = __builtin_amdgcn_readfirstlane((unsigned)(v >> 32)); return (const GAS float*)(((unsigned long long)hi << 32) | lo); }
#define INP(i) ldptr(F, (i))
__device__ __forceinline__ Frame fresh(const Frame& F0) { Frame F = F0; int t; asm volatile("v_mbcnt_lo_u32_b32 %0, -1, 0\n\tv_mbcnt_hi_u32_b32 %0, -1, %0\n\tv_lshl_add_u32 %0, %1, 6, %0" : "=&v"(t) : "s"(F0.wave));     F.tid = t; F.lane = t & 63; F.wave = __builtin_amdgcn_readfirstlane(t >> 6);
    asm volatile("" : "+s"(F.bid), "+s"(F.G), "+s"(F.ws), "+s"(F.W), "+s"(F.out)); return F; }
enum { IN_X = 0, IN_C, IN_CTX, IN_CCTX, IN_ADAW, IN_ADAB, IN_NMIX, IN_NFFN, IN_NOUT, IN_ML_WIN, IN_ML_WGATE, IN_ML_BGATE, IN_ML_CONV, IN_ML_HEADG, IN_ML_WOUT,
       IN_RW_MU, IN_RW_WRKV, IN_RW_W0, IN_RW_W1, IN_RW_W2, IN_RW_A0, IN_RW_A1, IN_RW_A2, IN_RW_G1, IN_RW_G2, IN_RW_KK, IN_RW_KA, IN_RW_RK, IN_RW_LNW, IN_RW_LNB, IN_RW_WOUT,
       IN_HG_WIN, IN_HG_WF, IN_HG_BF, IN_HG_LB, IN_HG_HEADG, IN_HG_WOUT, IN_ROUTER_W, IN_ROUTER_B, IN_EX_W1, IN_EX_W3, IN_EX_W2 };

template <int MAP> __device__ __forceinline__ int rowmap(int n) { return MAP == 0 ? n : (MAP == 1 ? 8 * (n >> 2) + (n & 3) : 8 * (n >> 2) + 4 + (n & 3)); }
template <int MAP> __device__ __forceinline__ void tr_item(const GAS float* W, int ldw, int nblk, GAS bf16* WT, int ldd, int row_off, int k_off, const GAS float* kscale, LAS float* scr, int item, int lane) {
    const int kb = item / nblk, nb = item - kb * nblk, k0 = 64 * kb, n0 = 32 * nb;
#pragma unroll 8
    for (int i = 0; i < 32; ++i) { const int kk = 2 * i + (lane >> 5); float v = W[(size_t)(k0 + kk) * ldw + n0 + (lane & 31)]; if (kscale) v *= kscale[k0 + kk]; scr[kk * 33 + (lane & 31)] = v; }
    LDS_WAIT(); asm volatile("" ::: "memory");
    const int c = lane & 7;
#pragma unroll
    for (int j = 0; j < 4; ++j) { const int n = (lane >> 3) + 8 * j; const LAS float* s = scr + (8 * c) * 33 + n;
        u32x4 o; o.x = pk2(s[0 * 33], s[1 * 33]); o.y = pk2(s[2 * 33], s[3 * 33]); o.z = pk2(s[4 * 33], s[5 * 33]); o.w = pk2(s[6 * 33], s[7 * 33]);
        *(GAS u32x4*)(WT + (size_t)(row_off + rowmap<MAP>(n0 + n)) * ldd + k_off + k0 + 8 * c) = o; }
    LDS_WAIT(); asm volatile("" ::: "memory");
}
#define TRJOB(MAP, cnt, ...) if (r < (cnt)) { tr_item<MAP>(__VA_ARGS__, scr, r, F.lane); continue; } r -= (cnt);

PHASE_FN void pre_phase(Frame F) {
    LAS float* scr = (LAS float*)(F.lds + F.wave * 16384);
    const int gw = F.bid * NWAVES + F.wave, NGW = F.G * NWAVES;
    const size_t gt = (size_t)F.bid * NTHR + F.tid, NGT = (size_t)F.G * NTHR;
    GAS bf16* W = (GAS bf16*)F.W;
    constexpr int NITEMS = 2 * 2048 + 2 * 512 + 6 * 512 + 4 * 32 + 4 * 32 + 2 * 64 + 64 + 512 + 1536 + 2 * 512 + 512;
    for (int it = gw; it < NITEMS; it += NGW) {
        int r = it;
        TRJOB(0, 2048, INP(IN_ML_WIN), 4096, 128, (GAS bf16*)(F.W + W_ML_WIN), 1024, 0, 0, nullptr)
        TRJOB(0, 2048, INP(IN_ML_WIN) + (size_t)1024 * 4096, 4096, 128, (GAS bf16*)(F.W + W_ML_WIN + W_ML_WIN_SZ), 1024, 0, 0, nullptr)
        TRJOB(0, 512, INP(IN_ML_WOUT), 1024, 32, (GAS bf16*)(F.W + W_ML_WOUT), 1024, 0, 0, nullptr)
        TRJOB(0, 512, INP(IN_ML_WOUT) + (size_t)1024 * 1024, 1024, 32, (GAS bf16*)(F.W + W_ML_WOUT + 2 * MiB), 1024, 0, 0, nullptr)
        GAS bf16* RWIN = (GAS bf16*)(F.W + W_RW_IN); const GAS float* mu = INP(IN_RW_MU);
        if (r < 6 * 512) { const int idx = r / 1024, ps = (r / 512) & 1, rr = r & 511;
            tr_item<0>(INP(IN_RW_WRKV) + (size_t)idx * 1024 * 1024, 1024, 32, RWIN, 2048, idx * 1024, ps * 1024, ps ? mu + idx * 1024 : nullptr, scr, rr, F.lane); continue; } r -= 6 * 512;
        if (r < 4 * 32) { const int dir = r / 64, ps = (r / 32) & 1, rr = r & 31;
            tr_item<0>(INP(IN_RW_W1) + (size_t)dir * 1024 * 64, 64, 2, RWIN, 2048, 3072 + dir * 64, ps * 1024, ps ? mu + 3 * 1024 : nullptr, scr, rr, F.lane); continue; } r -= 4 * 32;
        if (r < 4 * 32) { const int dir = r / 64, ps = (r / 32) & 1, rr = r & 31;
            tr_item<0>(INP(IN_RW_A1) + (size_t)dir * 1024 * 64, 64, 2, RWIN, 2048, 3200 + dir * 64, ps * 1024, ps ? mu + 4 * 1024 : nullptr, scr, rr, F.lane); continue; } r -= 4 * 32;
        if (r < 2 * 64) { const int ps = r / 64, rr = r & 63;
            tr_item<0>(INP(IN_RW_G1), 128, 4, RWIN, 2048, 3328, ps * 1024, ps ? mu + 5 * 1024 : nullptr, scr, rr, F.lane); continue; } r -= 2 * 64;
        TRJOB(0, 64, INP(IN_RW_G2), 1024, 32, (GAS bf16*)(F.W + W_RW_G2), 256, 0, 0, nullptr)
        TRJOB(0, 512, INP(IN_RW_WOUT), 1024, 32, (GAS bf16*)(F.W + W_RW_WOUT), 1024, 0, 0, nullptr)
        TRJOB(0, 1536, INP(IN_HG_WIN), 3072, 96, (GAS bf16*)(F.W + W_HG_IN), 1024, 0, 0, nullptr)
        TRJOB(0, 512, INP(IN_HG_WF), 1024, 32, (GAS bf16*)(F.W + W_HG_IN), 1024, 3072, 0, nullptr)
        TRJOB(0, 512, INP(IN_HG_WF) + (size_t)1024 * 1024, 1024, 32, (GAS bf16*)(F.W + W_HG_IN), 1024, 4096, 0, nullptr)
        TRJOB(0, 512, INP(IN_HG_WOUT), 1024, 32, (GAS bf16*)(F.W + W_HG_WOUT), 1024, 0, 0, nullptr)
    }
    for (size_t i = gt; i < (size_t)2 * 256 * 1024; i += NGT) { const int j = (int)(i >> 18), rr = (int)((i >> 10) & 255), k = (int)(i & 1023);
        float v = 0.f; if (rr < 32) { const int dir = rr >> 4, g = rr & 15; v = INP(IN_ML_WGATE)[((size_t)(j * 2 + dir) * 1024 + k) * 16 + g]; }
        ((GAS bf16*)(F.W + W_ML_WIN + j * W_ML_WIN_SZ))[(size_t)(4096 + rr) * 1024 + k] = (bf16)f2bf(v); }
    for (size_t i = gt; i < (size_t)128 * 2048; i += NGT) ((GAS bf16*)(F.W + W_RW_IN))[(size_t)3456 * 2048 + i] = 0;
    for (size_t i = gt; i < (size_t)1024 * 128; i += NGT) ((GAS bf16*)(F.W + W_RW_G2))[(i >> 7) * 256 + 128 + (i & 127)] = 0;
    if (F.bid == 0) for (int c = F.tid; c < 1024; c += NTHR) { const GAS float* lg = INP(IN_HG_LB) + c; const float l0 = lg[0], l1 = lg[1024], l2 = lg[2048], l3 = lg[3072];
        const float mx = fmaxf(fmaxf(l0, l1), fmaxf(l2, l3)); const float e0 = __expf(l0 - mx), e1 = __expf(l1 - mx), e2 = __expf(l2 - mx), e3 = __expf(l3 - mx);
        ((GAS float*)(F.ws + WS_LB))[c] = (e1 + e2) / (e0 + e1 + e2 + e3); }
    { GAS f32x4* S4 = (GAS f32x4*)(F.ws + WS_S);
      for (size_t i = gt; i < (size_t)NTOK * 256; i += NGT) { const int m = (int)(i >> 8), c4 = (int)(i & 255); const int b = m / T, t = m - b * T;
          const GAS float* src = (t < CTX) ? INP(IN_CTX) + ((size_t)(b * CTX + t)) * 1024 : INP(IN_X) + ((size_t)(b * SEQ + t - CTX)) * 1024;
          S4[i] = ((const GAS f32x4*)src)[c4]; } }
    { LAS float* sc = (LAS float*)(F.lds + 8448); GAS float* MODP = (GAS float*)(F.ws + WS_MIX);
      for (int it = F.bid; it < 768; it += F.G) { const int i = it / 192, rem = it - i * 192, kc = rem / 12, jb = rem - kc * 12;
          __syncthreads();
          if (F.tid < 320) { const int seg = F.tid >> 6, kk = F.tid & 63; const float cv = seg == 0 ? INP(IN_CCTX)[kc * 64 + kk] : INP(IN_C)[(seg - 1) * 1024 + kc * 64 + kk]; sc[F.tid] = silu_f(cv); }
          __syncthreads();
          const int j = jb * 512 + F.tid; const GAS float* wp = INP(IN_ADAW) + ((size_t)i * 1024 + kc * 64) * 6144 + j;
          float a0 = 0.f, a1 = 0.f, a2 = 0.f, a3 = 0.f, a4 = 0.f;
#pragma unroll 8
          for (int kk = 0; kk < 64; ++kk) { const float w = wp[(size_t)kk * 6144]; a0 += sc[kk] * w; a1 += sc[64 + kk] * w; a2 += sc[128 + kk] * w; a3 += sc[192 + kk] * w; a4 += sc[256 + kk] * w; }
          GAS float* mp = MODP + ((size_t)kc * 4 + i) * 5 * 6144 + j;
          mp[0] = a0; mp[6144] = a1; mp[2 * 6144] = a2; mp[3 * 6144] = a3; mp[4 * 6144] = a4; } }
}
PHASE_FN void modsum_phase(Frame F) {
    const GAS float* MODP = (const GAS float*)(F.ws + WS_MIX); GAS float* MOD = (GAS float*)(F.ws + WS_MOD);
    for (int idx = F.bid * NTHR + F.tid; idx < 4 * 5 * 6144; idx += F.G * NTHR) { const int i = idx / (5 * 6144), j = idx % 6144;
        float a = INP(IN_ADAB)[i * 6144 + j];
#pragma unroll
        for (int kc = 0; kc < 16; ++kc) a += MODP[(size_t)kc * 4 * 5 * 6144 + idx];
        MOD[idx] = a; }
}
struct ExwItem { const GAS float* src; GAS bf16* dst; int ldw, ldd, map; };
__device__ __forceinline__ ExwItem exw_item(const Frame& F, const GAS float* w1, const GAS float* w3, const GAS float* w2, int it) {
    const int which = it >> 12, e = (it >> 8) & 15, rr = it & 255; ExwItem x;
    if (which < 2) { const int kb = rr >> 4, nb = rr & 15; x.src = (which ? w3 : w1) + (size_t)e * 1024 * 512 + (size_t)(64 * kb) * 512 + 32 * nb; x.ldw = 512; x.ldd = 1024; x.map = which + 1;
        x.dst = (GAS bf16*)(F.W + W_EX13) + (size_t)(e * 1024 + 2 * (32 * nb)) * 1024 + 64 * kb; }
    else { const int kb = rr >> 5, nb = rr & 31; x.src = w2 + (size_t)e * 512 * 1024 + (size_t)(64 * kb) * 1024 + 32 * nb; x.ldw = 1024; x.ldd = 512; x.map = 0;
        x.dst = (GAS bf16*)(F.W + W_EX2) + (size_t)(e * 1024 + 32 * nb) * 512 + 64 * kb; }
    return x; }
PHASE_FN void expert_weights(Frame F, int L) {
    LAS float* scr = (LAS float*)(F.lds + F.wave * 16384);
    const int gw = F.bid * NWAVES + F.wave, NGW = F.G * NWAVES, lane = F.lane;
    const GAS float* w1 = INP(IN_EX_W1) + (size_t)L * 16 * 1024 * 512; const GAS float* w3 = INP(IN_EX_W3) + (size_t)L * 16 * 1024 * 512; const GAS float* w2 = INP(IN_EX_W2) + (size_t)L * 16 * 512 * 1024;
    const int lk = lane >> 3, ln = (lane & 7) * 4;
    f32x4 v[8]; int it = gw;
    if (it < 3 * 4096) { const ExwItem x = exw_item(F, w1, w3, w2, it);
#pragma unroll
        for (int i = 0; i < 8; ++i) v[i] = *(const GAS f32x4*)(x.src + (size_t)(lk + 8 * i) * x.ldw + ln); }
    for (; it < 3 * 4096; it += NGW) {
        const ExwItem x = exw_item(F, w1, w3, w2, it);
#pragma unroll
        for (int i = 0; i < 8; ++i) { LAS float* d = scr + (lk + 8 * i) * 33 + ln; d[0] = v[i][0]; d[1] = v[i][1]; d[2] = v[i][2]; d[3] = v[i][3]; }
        if (it + NGW < 3 * 4096) { const ExwItem y = exw_item(F, w1, w3, w2, it + NGW);
#pragma unroll
            for (int i = 0; i < 8; ++i) v[i] = *(const GAS f32x4*)(y.src + (size_t)(lk + 8 * i) * y.ldw + ln); }
        LDS_WAIT(); asm volatile("" ::: "memory");
        const int c = lane & 7;
#pragma unroll
        for (int j = 0; j < 4; ++j) { const int n = (lane >> 3) + 8 * j; const LAS float* s_ = scr + (8 * c) * 33 + n;
            u32x4 o; o.x = pk2(s_[0 * 33], s_[1 * 33]); o.y = pk2(s_[2 * 33], s_[3 * 33]); o.z = pk2(s_[4 * 33], s_[5 * 33]); o.w = pk2(s_[6 * 33], s_[7 * 33]);
            const int drow = x.map == 0 ? n : 2 * (n & ~3) + (n & 3) + (x.map == 2 ? 4 : 0);
            *(GAS u32x4*)(x.dst + (size_t)drow * x.ldd + 8 * c) = o; }
        LDS_WAIT(); asm volatile("" ::: "memory");
    }
}

template <int MODE, int PRB = 0> PHASE_FN void norm_phase(Frame F, int L, bool add_moe, int ldh) {
    GAS float* S = (GAS float*)(F.ws + WS_S); GAS bf16* H = (GAS bf16*)(F.ws + WS_HY); const GAS bf16* YM = (const GAS bf16*)(F.ws + WS_MIX + 210 * MiB);
    const GAS float* MOD = (const GAS float*)(F.ws + WS_MOD);
    const int gw = F.bid * NWAVES + F.wave, NGW = F.G * NWAVES, lane = F.lane;
    LAS float* rwl = (LAS float*)F.lds;
    LAS int* cntl = (LAS int*)(F.lds + 65536);
    if (MODE == 1) {
        for (int i = F.tid; i < 16384; i += NTHR) { const int c = i >> 4, e = i & 15; rwl[e * 1024 + c] = INP(IN_ROUTER_W)[i]; }
        if (F.tid < 16) cntl[F.tid] = 0;
        __syncthreads();
    }
    const GAS float* gnp = MODE == 0 ? INP(IN_NMIX) + L * 1024 : (MODE == 1 ? INP(IN_NFFN) + L * 1024 : INP(IN_NOUT));
    for (int m = gw; m < NTOK; m += NGW) {
        const int b = m / T, t = m - b * T, seg = t < CTX ? 0 : 1 + b;
        if (MODE == 2 && t < CTX) continue;
        f32x4 v[4]; GAS f32x4* sp = (GAS f32x4*)(S + (size_t)m * 1024) + lane;
#pragma unroll
        for (int j = 0; j < 4; ++j) v[j] = sp[64 * j];
        if (add_moe) {
            const GAS float* gp = MOD + ((size_t)((MODE == 2 ? 3 : L - 1) * 5 + seg)) * 6144 + 5 * 1024;
            const GAS u32x2* ya = (const GAS u32x2*)(YM + (size_t)(2 * m) * 1024) + lane; const GAS u32x2* yb = ya + 256;
#pragma unroll
            for (int j = 0; j < 4; ++j) { const u32x2 a = ya[64 * j], bq = yb[64 * j]; const f32x4 g = ((const GAS f32x4*)gp)[lane + 64 * j];
                v[j][0] += g[0] * (bflo(a.x) + bflo(bq.x)); v[j][1] += g[1] * (bfhi(a.x) + bfhi(bq.x)); v[j][2] += g[2] * (bflo(a.y) + bflo(bq.y)); v[j][3] += g[3] * (bfhi(a.y) + bfhi(bq.y)); }
            if (MODE != 2 && !PRB) {
#pragma unroll
                for (int j = 0; j < 4; ++j) sp[64 * j] = v[j]; }
        }
        float ss = 0.f;
#pragma unroll
        for (int j = 0; j < 4; ++j) ss += (v[j][0] * v[j][0] + v[j][1] * v[j][1]) + (v[j][2] * v[j][2] + v[j][3] * v[j][3]);
        const float rinv = 1.0f / sqrtf(wave_sum(ss) * (1.0f / 1024.0f) + 1e-6f);
        if (MODE == 2) { GAS f32x4* op = (GAS f32x4*)(F.out + ((size_t)(b * SEQ + t - CTX)) * 1024) + lane;
#pragma unroll
            for (int j = 0; j < 4; ++j) { const f32x4 g = ((const GAS f32x4*)gnp)[lane + 64 * j]; op[64 * j] = v[j] * rinv * g; }
            continue; }
        const GAS float* mp = MOD + ((size_t)(L * 5 + seg)) * 6144 + (MODE == 0 ? 0 : 3 * 1024);
        f32x4 h[4];
#pragma unroll
        for (int j = 0; j < 4; ++j) { const f32x4 g = ((const GAS f32x4*)gnp)[lane + 64 * j], sh = ((const GAS f32x4*)mp)[lane + 64 * j], sc = ((const GAS f32x4*)(mp + 1024))[lane + 64 * j];
            h[j] = v[j] * rinv * g * (sc + 1.0f) + sh;
            u32x2 o; o.x = pk2(h[j][0], h[j][1]); o.y = pk2(h[j][2], h[j][3]); *((GAS u32x2*)(H + (size_t)m * ldh) + lane + 64 * j) = o; }
        if (MODE == 1) {
            float lg[16];
#pragma unroll
            for (int e = 0; e < 16; ++e) { float a = 0.f;
#pragma unroll
                for (int j = 0; j < 4; ++j) { const f32x4 w = *(const LAS f32x4*)(rwl + e * 1024 + 256 * j + 4 * lane); a += (h[j][0] * w[0] + h[j][1] * w[1]) + (h[j][2] * w[2] + h[j][3] * w[3]); }
                lg[e] = wave_sum(a); }
            float aff[16], sel[16];
#pragma unroll
            for (int e = 0; e < 16; ++e) { aff[e] = sigmoid_f(lg[e]); sel[e] = aff[e] + INP(IN_ROUTER_B)[e]; }
            float best = -3.0e38f; int bg = 0; float s0 = 0.f, s1 = 0.f, s2 = 0.f, s3 = 0.f, a0 = 0.f, a1 = 0.f, a2 = 0.f, a3 = 0.f;
#pragma unroll
            for (int g = 0; g < 4; ++g) { const float x0 = sel[4 * g], x1 = sel[4 * g + 1], x2 = sel[4 * g + 2], x3 = sel[4 * g + 3];
                const float t1 = fmaxf(x0, x1), t2 = fminf(x0, x1), u1 = fmaxf(x2, x3), u2 = fminf(x2, x3);
                const float sum = fmaxf(t1, u1) + fmaxf(fminf(t1, u1), fmaxf(t2, u2));
                const bool bt = sum > best; best = bt ? sum : best; bg = bt ? g : bg;
                s0 = bt ? x0 : s0; s1 = bt ? x1 : s1; s2 = bt ? x2 : s2; s3 = bt ? x3 : s3;
                a0 = bt ? aff[4 * g] : a0; a1 = bt ? aff[4 * g + 1] : a1; a2 = bt ? aff[4 * g + 2] : a2; a3 = bt ? aff[4 * g + 3] : a3; }
            int i1 = 0; float m1 = s0; if (s1 > m1) { m1 = s1; i1 = 1; } if (s2 > m1) { m1 = s2; i1 = 2; } if (s3 > m1) { m1 = s3; i1 = 3; }
            int i2 = -1; float m2 = -3.0e38f;
            if (i1 != 0 && s0 > m2) { m2 = s0; i2 = 0; } if (i1 != 1 && s1 > m2) { m2 = s1; i2 = 1; } if (i1 != 2 && s2 > m2) { m2 = s2; i2 = 2; } if (i1 != 3 && s3 > m2) { m2 = s3; i2 = 3; }
            const float c1 = i1 == 0 ? a0 : (i1 == 1 ? a1 : (i1 == 2 ? a2 : a3)), c2 = i2 == 0 ? a0 : (i2 == 1 ? a1 : (i2 == 2 ? a2 : a3));
            const float inv = 1.0f / (c1 + c2);
            if (lane == 0) { const int e1 = bg * 4 + i1, e2 = bg * 4 + i2;
                u32x4 tk; tk.x = (unsigned)e1; tk.y = (unsigned)e2; tk.z = __float_as_uint(c1 * inv); tk.w = __float_as_uint(c2 * inv); ((GAS u32x4*)(F.ws + WS_TOK))[m] = tk;
                __hip_atomic_fetch_add(cntl + e1, 1, __ATOMIC_RELAXED, __HIP_MEMORY_SCOPE_WORKGROUP); __hip_atomic_fetch_add(cntl + e2, 1, __ATOMIC_RELAXED, __HIP_MEMORY_SCOPE_WORKGROUP); }
        }
    }
    if (MODE == 1) { __syncthreads(); if (F.tid < 16) __hip_atomic_fetch_add((GAS unsigned*)F.ws + CW_MOE + L * 2048 + (PRB ? 512 : 0) + 64 * F.tid, (unsigned)cntl[F.tid], __ATOMIC_RELAXED, __HIP_MEMORY_SCOPE_AGENT); }
}

__device__ __forceinline__ void moe_prefix(const Frame& F, int L, LAS int* pref  , LAS int* cnt  ) {
    if (F.tid < 16) cnt[F.tid] = (int)__hip_atomic_load((GAS unsigned*)F.ws + CW_MOE + L * 2048 + 64 * F.tid, __ATOMIC_RELAXED, __HIP_MEMORY_SCOPE_AGENT);
    __syncthreads();
    if (F.tid == 0) { int p = 0; for (int e = 0; e < 16; ++e) { pref[e] = p; p += (cnt[e] + 255) >> 8; } pref[16] = p; }
    __syncthreads();
}
template <int PRB = 0> PHASE_FN void slots_phase(Frame F, int L) {
    LAS int* pref = (LAS int*)F.lds; LAS int* cnt = pref + 32;
    moe_prefix(F, L, pref, cnt);
    const int gw = F.bid * NWAVES + F.wave, NGW = F.G * NWAVES, lane = F.lane;
    GAS unsigned* cursor = (GAS unsigned*)F.ws + CW_MOE + L * 2048 + 1024 + (PRB ? 32 : 0);
    GAS int* slot_tok = (GAS int*)(F.ws + WS_SLOT_TOK); GAS float* slot_gate = (GAS float*)(F.ws + WS_SLOT_GATE);
    for (int it = gw; it < NTOK / 64; it += NGW) {
        const int m = it * 64 + lane; const u32x4 tk = ((const GAS u32x4*)(F.ws + WS_TOK))[m];
#pragma unroll
        for (int k = 0; k < 2; ++k) { const int e = (int)(k ? tk.y : tk.x); int slot = 0;
            for (int ee = 0; ee < 16; ++ee) { const unsigned long long mask = __ballot(e == ee);
                if (mask) { const int n = __popcll(mask); unsigned base = 0; if (lane == 0) base = __hip_atomic_fetch_add(cursor + 64 * ee, (unsigned)n, __ATOMIC_RELAXED, __HIP_MEMORY_SCOPE_AGENT); base = __builtin_amdgcn_readfirstlane(base);
                    if (e == ee) slot = pref[ee] * 256 + (int)base + __popcll(mask & ((1ull << lane) - 1ull)); } }
            slot_tok[slot] = 2 * m + k; slot_gate[slot] = __uint_as_float(k ? tk.w : tk.z); }
    }
    for (int e = 0; e < 16; ++e) { const int lo = pref[e] * 256 + cnt[e], hi = pref[e + 1] * 256;
        for (int s_ = lo + gw * 64 + lane; s_ < hi; s_ += NGW * 64) { slot_tok[s_] = -1; slot_gate[s_] = 0.f; } }
}

PHASE_FN void du_phase(Frame F) {
    GAS bf16* H2 = (GAS bf16*)(F.ws + WS_HY);
    const size_t gt = (size_t)F.bid * NTHR + F.tid, NGT = (size_t)F.G * NTHR;
    for (size_t i = gt; i < (size_t)NTOK * 128; i += NGT) { const int m = (int)(i >> 7), c8 = (int)(i & 127); const int t = m % T;
        const bool hp = !(t == 0 || t == CTX), hn = !(t == CTX - 1 || t == T - 1);
        const u32x4 z = {0u, 0u, 0u, 0u};
        const u32x4 u = *(const GAS u32x4*)(H2 + (size_t)m * 2048 + c8 * 8), p = hp ? *(const GAS u32x4*)(H2 + (size_t)(m - 1) * 2048 + c8 * 8) : z, n = hn ? *(const GAS u32x4*)(H2 + (size_t)(m + 1) * 2048 + c8 * 8) : z;
        u32x4 o;
#pragma unroll
        for (int j = 0; j < 4; ++j) o[j] = pk2(0.5f * (bflo(p[j]) + bflo(n[j])) - bflo(u[j]), 0.5f * (bfhi(p[j]) + bfhi(n[j])) - bfhi(u[j]));
        *(GAS u32x4*)(H2 + (size_t)m * 2048 + 1024 + c8 * 8) = o; }
}

PHASE_FN void conv_phase(Frame F, int j) {
    const GAS bf16* QP = (const GAS bf16*)(F.ws + WS_MIX); GAS bf16* QK = (GAS bf16*)(F.ws + WS_HY); const GAS float* cw = INP(IN_ML_CONV) + (size_t)j * 9 * 2048;
    const size_t gt = (size_t)F.bid * NTHR + F.tid, NGT = (size_t)F.G * NTHR;
    for (size_t i = gt; i < (size_t)NTOK * 256; i += NGT) { const int m = (int)(i >> 8), c = (int)(i & 255) * 8; const int t = m % T;
        float acc[8];
#pragma unroll
        for (int q = 0; q < 8; ++q) acc[q] = 0.f;
        const int p = t - CTX, gr = p >> 6, gc = p & 63;
#pragma unroll
        for (int dr = 0; dr < 3; ++dr)
#pragma unroll
            for (int dw = 0; dw < 3; ++dw) {
                bool ok; int mm;
                if (t < CTX) { ok = (dr == 1) && (t + dw - 1 >= 0) && (t + dw - 1 < CTX); mm = m + dw - 1; }
                else { ok = (gr + dr - 1 >= 0) && (gr + dr - 1 < 128) && (gc + dw - 1 >= 0) && (gc + dw - 1 < 64); mm = m + (dr - 1) * 64 + (dw - 1); }
                if (ok) { const u32x4 x = *(const GAS u32x4*)(QP + (size_t)mm * 2048 + c); const f32x4 w0 = *(const GAS f32x4*)(cw + (dr * 3 + dw) * 2048 + c), w1 = *(const GAS f32x4*)(cw + (dr * 3 + dw) * 2048 + c + 4);
                    acc[0] += bflo(x[0]) * w0[0]; acc[1] += bfhi(x[0]) * w0[1]; acc[2] += bflo(x[1]) * w0[2]; acc[3] += bfhi(x[1]) * w0[3];
                    acc[4] += bflo(x[2]) * w1[0]; acc[5] += bfhi(x[2]) * w1[1]; acc[6] += bflo(x[3]) * w1[2]; acc[7] += bfhi(x[3]) * w1[3]; } }
        const float sc = c >= 1024 ? 0.08838834764831845f : 1.0f;
        u32x4 o;
#pragma unroll
        for (int q = 0; q < 4; ++q) o[q] = pk2(silu_f(acc[2 * q]) * sc, silu_f(acc[2 * q + 1]) * sc);
        *(GAS u32x4*)(QK + (size_t)m * 2048 + c) = o; }
}

PHASE_FN void headnorm_phase(Frame F, const GAS bf16* HSf, const GAS bf16* HSb, const GAS bf16* OG, const GAS float* hg, GAS bf16* Y) {
    const int gw = F.bid * NWAVES + F.wave, NGW = F.G * NWAVES, lane = F.lane;
    for (int m = gw; m < NTOK; m += NGW) { const size_t off = (size_t)m * 1024 + lane * 16;
        float x[16]; float ss = 0.f;
#pragma unroll
        for (int hlf = 0; hlf < 2; ++hlf) { const u32x4 a = *(const GAS u32x4*)(HSf + off + 8 * hlf), bq = *(const GAS u32x4*)(HSb + off + 8 * hlf);
#pragma unroll
            for (int q = 0; q < 4; ++q) { x[8 * hlf + 2 * q] = bflo(a[q]) + bflo(bq[q]); x[8 * hlf + 2 * q + 1] = bfhi(a[q]) + bfhi(bq[q]); } }
#pragma unroll
        for (int q = 0; q < 16; ++q) ss += x[q] * x[q];
        ss += __shfl_xor(ss, 1); ss += __shfl_xor(ss, 2); ss += __shfl_xor(ss, 4);
        const float rinv = 1.0f / sqrtf(ss * (1.0f / 128.0f) + 1e-6f);
#pragma unroll
        for (int hlf = 0; hlf < 2; ++hlf) { const u32x4 g = *(const GAS u32x4*)(OG + off + 8 * hlf); const f32x4 h0 = *(const GAS f32x4*)(hg + lane * 16 + 8 * hlf), h1 = *(const GAS f32x4*)(hg + lane * 16 + 8 * hlf + 4);
            u32x4 o;
            o[0] = pk2(x[8 * hlf + 0] * rinv * h0[0] * bflo(g[0]), x[8 * hlf + 1] * rinv * h0[1] * bfhi(g[0])); o[1] = pk2(x[8 * hlf + 2] * rinv * h0[2] * bflo(g[1]), x[8 * hlf + 3] * rinv * h0[3] * bfhi(g[1]));
            o[2] = pk2(x[8 * hlf + 4] * rinv * h1[0] * bflo(g[2]), x[8 * hlf + 5] * rinv * h1[1] * bfhi(g[2])); o[3] = pk2(x[8 * hlf + 6] * rinv * h1[2] * bflo(g[3]), x[8 * hlf + 7] * rinv * h1[3] * bfhi(g[3]));
            *(GAS u32x4*)(Y + off + 8 * hlf) = o; } }
}
PHASE_FN void rwpost_phase(Frame F, const GAS bf16* Of, const GAS bf16* Ob, const GAS float* BETA, const GAS bf16* V, const GAS bf16* Gt, GAS bf16* Y) {
    const int gw = F.bid * NWAVES + F.wave, NGW = F.G * NWAVES, lane = F.lane;
    const GAS float* lnw = INP(IN_RW_LNW); const GAS float* lnb = INP(IN_RW_LNB);
    for (int m = gw; m < NTOK; m += NGW) { const size_t off = (size_t)m * 1024 + lane * 16;
        float x[16]; float s = 0.f;
#pragma unroll
        for (int hlf = 0; hlf < 2; ++hlf) { const u32x4 a = *(const GAS u32x4*)(Of + off + 8 * hlf), bq = *(const GAS u32x4*)(Ob + off + 8 * hlf);
#pragma unroll
            for (int q = 0; q < 4; ++q) { x[8 * hlf + 2 * q] = bflo(a[q]) + bflo(bq[q]); x[8 * hlf + 2 * q + 1] = bfhi(a[q]) + bfhi(bq[q]); } }
#pragma unroll
        for (int q = 0; q < 16; ++q) s += x[q];
        s += __shfl_xor(s, 1); s += __shfl_xor(s, 2);
        const float mean = s * (1.0f / 64.0f); float vs = 0.f;
#pragma unroll
        for (int q = 0; q < 16; ++q) { x[q] -= mean; vs += x[q] * x[q]; }
        vs += __shfl_xor(vs, 1); vs += __shfl_xor(vs, 2);
        const float rinv = 1.0f / sqrtf(vs * (1.0f / 64.0f) + 64e-5f);
        const int hd = lane >> 2; const float beta = BETA[(size_t)m * 16 + hd] + BETA[((size_t)NTOK + m) * 16 + hd];
#pragma unroll
        for (int hlf = 0; hlf < 2; ++hlf) { const u32x4 vv = *(const GAS u32x4*)(V + off + 8 * hlf), gg = *(const GAS u32x4*)(Gt + off + 8 * hlf);
            const f32x4 w0 = *(const GAS f32x4*)(lnw + lane * 16 + 8 * hlf), w1 = *(const GAS f32x4*)(lnw + lane * 16 + 8 * hlf + 4), b0 = *(const GAS f32x4*)(lnb + lane * 16 + 8 * hlf), b1 = *(const GAS f32x4*)(lnb + lane * 16 + 8 * hlf + 4);
            float y[8];
#pragma unroll
            for (int q = 0; q < 4; ++q) { y[q] = x[8 * hlf + q] * rinv * w0[q] + b0[q]; y[4 + q] = x[8 * hlf + 4 + q] * rinv * w1[q] + b1[q]; }
            u32x4 o;
#pragma unroll
            for (int q = 0; q < 4; ++q) o[q] = pk2((y[2 * q] + beta * bflo(vv[q])) * bflo(gg[q]), (y[2 * q + 1] + beta * bfhi(vv[q])) * bfhi(gg[q]));
            *(GAS u32x4*)(Y + off + 8 * hlf) = o; } }
}

template <int PROBE> PHASE_FN void ml_scan_phase(Frame F, const GAS bf16* QK, const GAS bf16* V, const GAS float* GATES, GAS bf16* HS) {
    constexpr int OFF_Q = 0, OFF_K = 17408, OFF_V = 34816, OFF_VW = 39936, OFF_WKR = 45056, INB = 47360;
    LAS bf16* SS = (LAS bf16*)(F.lds + 2 * INB); LAS bf16* CS = (LAS bf16*)(F.lds + 2 * INB + 9216); LAS bf16* HO = (LAS bf16*)(F.lds + 2 * INB + 9216 + 13056);
    LAS float* SC = (LAS float*)(F.lds + 2 * INB + 9216 + 13056 + 5120);
    LAS float* sdenp = SC + 2 * 336;
    const int tid = F.tid, lane = F.lane, w = F.wave, r = lane & 15, q = lane >> 4;
    const int lrow = tid >> 3, lp = tid & 7;
    for (int unit = F.bid; unit < 256; unit += F.G) {
        const int vs = unit & 3, dir = (unit >> 2) & 1, h = (unit >> 3) & 7, b = unit >> 6;
        f32x4 Cst[2], Nst; Cst[0] = (f32x4){0.f, 0.f, 0.f, 0.f}; Cst[1] = Cst[0]; Nst = Cst[0];
        __syncthreads();
        for (int i = tid; i < 48 * 136; i += NTHR) CS[i] = 0;
        for (int i = tid; i < 2 * 16 * 72; i += NTHR) { ((LAS bf16*)(F.lds + OFF_WKR))[i % 1152] = 0; ((LAS bf16*)(F.lds + INB + OFF_WKR))[i % 1152] = 0; }
        float m_run = 0.f;
        u32x4 rq[2], rk[2], rv = {0u, 0u, 0u, 0u}; float rig = 0.f, rlf = 0.f;
#define ML_LOAD(c) do { const int row_ = seq_row(b, dir, (c) * 64 + lrow); const GAS bf16* qp_ = QK + (size_t)row_ * 2048 + h * 128; \
            rq[0] = *(const GAS u32x4*)(qp_ + 8 * lp); rq[1] = *(const GAS u32x4*)(qp_ + 8 * (lp + 8)); rk[0] = *(const GAS u32x4*)(qp_ + 1024 + 8 * lp); rk[1] = *(const GAS u32x4*)(qp_ + 1024 + 8 * (lp + 8)); \
            if (tid < 256) { const int vrow_ = seq_row(b, dir, (c) * 64 + (tid >> 2)); rv = *(const GAS u32x4*)(V + (size_t)vrow_ * 1024 + h * 128 + vs * 32 + 8 * (tid & 3)); } } while (0)
#define ML_GLOAD(c) do { const int grow_ = seq_row(b, dir, (c) * 64 + lane); rig = GATES[(size_t)grow_ * 32 + dir * 16 + h]; rlf = GATES[(size_t)grow_ * 32 + dir * 16 + 8 + h]; } while (0)
#define ML_SCALARS(buf) do { const float lf_ = logsigmoid_f(rlf); float bc_ = lf_; \
            _Pragma("unroll") for (int o_ = 1; o_ < 64; o_ <<= 1) { const float t_ = __shfl_up(bc_, o_); if (lane >= o_) bc_ += t_; } \
            const float u_ = rig - bc_; float pm_ = u_; \
            _Pragma("unroll") for (int o_ = 1; o_ < 64; o_ <<= 1) { const float t_ = __shfl_up(pm_, o_); if (lane >= o_) pm_ = fmaxf(pm_, t_); } \
            const float cc_ = fmaxf(m_run, pm_), blast_ = __shfl(bc_, 63), pmall_ = __shfl(pm_, 63), mnew_ = blast_ + fmaxf(m_run, pmall_); LAS float* sc_ = SC + (buf) * 336; \
            sc_[lane] = u_; sc_[64 + lane] = cc_; sc_[128 + lane] = __expf(m_run - cc_); sc_[192 + lane] = __expf(-(bc_ + cc_)); sc_[256 + lane] = __expf(blast_ + u_ - mnew_); \
            if (lane == 0) sc_[320] = __expf(blast_ + m_run - mnew_); m_run = mnew_; } while (0)
        ML_LOAD(0);
        if (w == 7) { ML_GLOAD(0); ML_SCALARS(0); ML_GLOAD(1); }
        __syncthreads();
        constexpr int NCH = T / 64;
        for (int c = 0; c < NCH; ++c) {
            const int pb = c & 1; LAS unsigned char* ib = F.lds + pb * INB;
            LAS bf16* QS = (LAS bf16*)(ib + OFF_Q); LAS bf16* KS = (LAS bf16*)(ib + OFF_K); LAS bf16* VS = (LAS bf16*)(ib + OFF_V); LAS bf16* VW = (LAS bf16*)(ib + OFF_VW); LAS bf16* WKR = (LAS bf16*)(ib + OFF_WKR);
            const LAS float* sc = SC + pb * 336;
            {
                *(LAS u32x4*)(QS + lrow * 136 + 8 * lp) = rq[0]; *(LAS u32x4*)(QS + lrow * 136 + 8 * (lp + 8)) = rq[1];
                *(LAS u32x4*)(KS + lrow * 136 + 8 * lp) = rk[0]; *(LAS u32x4*)(KS + lrow * 136 + 8 * (lp + 8)) = rk[1];
                if (tid < 256) { const int s_ = tid >> 2; const float wk = sc[256 + s_]; u32x4 vw;
#pragma unroll
                    for (int jj = 0; jj < 4; ++jj) vw[jj] = pk2(bflo(rv[jj]) * wk, bfhi(rv[jj]) * wk);
                    *(LAS u32x4*)(VS + s_ * 40 + 8 * (tid & 3)) = rv; *(LAS u32x4*)(VW + s_ * 40 + 8 * (tid & 3)) = vw; }
                if (tid < 64) WKR[tid] = (bf16)f2bf(sc[256 + tid]);
                if (c > 0 && tid < 256) { const int t_ = tid >> 2; const int row = seq_row(b, dir, (c - 1) * 64 + t_);
                    *(GAS u32x4*)(HS + ((size_t)dir * NTOK + row) * 1024 + h * 128 + vs * 32 + 8 * (tid & 3)) = *(const LAS u32x4*)(HO + t_ * 40 + 8 * (tid & 3)); }
                if (c + 1 < NCH && !(PROBE & 1)) ML_LOAD(c + 1);
                if (w == 7 && c + 1 < NCH) { ML_SCALARS(pb ^ 1); if (c + 2 < NCH) ML_GLOAD(c + 2); }
            }
            __syncthreads();
            {
                const int ti = w >> 1;
#pragma unroll
                for (int jj = 0; jj < 2; ++jj) { const int sj = (w & 1) * 2 + jj; f32x4 acc = {0.f, 0.f, 0.f, 0.f};
                    if (sj <= ti) acc = mm16<128>(acc, QS + 16 * ti * 136, 136, KS + 16 * sj * 136, 136, lane);
                    const int s_ = 16 * sj + r; const float us = sc[s_];
#pragma unroll
                    for (int i = 0; i < 4; ++i) { const int t_ = 16 * ti + 4 * q + i; const float val = (s_ <= t_) ? acc[i] * __expf(us - sc[64 + t_]) : 0.f;
                        const float rs = row16_sum(val); if (r == 0) sdenp[sj * 64 + t_] = rs;
                        SS[t_ * 72 + s_] = (bf16)f2bf(val); } }
            }
            __syncthreads();
            float wprev;
            {
                const int ti = w >> 1, vj = w & 1; f32x4 a1 = {0.f, 0.f, 0.f, 0.f}, a2 = a1, a3 = a1;
#pragma unroll
                for (int kk = 0; kk < 2; ++kk) a1 = __builtin_amdgcn_mfma_f32_16x16x32_bf16(row_frag(SS + 16 * ti * 72, 72, 32 * kk, lane), tr_frag(VS, 40, 32 * kk, 16 * vj, lane), a1, 0, 0, 0);
                a2 = mm16<128>(a2, QS + 16 * ti * 136, 136, CS + 16 * vj * 136, 136, lane);
                a3 = mm16<128>(a3, QS + 16 * ti * 136, 136, CS + 32 * 136, 136, lane);
#pragma unroll
                for (int i = 0; i < 4; ++i) { const int t_ = 16 * ti + 4 * q + i; const float wi = sc[128 + t_]; const float nq = row16_sum(a3[i]);
                    const float num = a1[i] + wi * a2[i], den = ((sdenp[t_] + sdenp[64 + t_]) + (sdenp[128 + t_] + sdenp[192 + t_])) + wi * nq;
                    HO[t_ * 40 + 16 * vj + r] = (bf16)f2bf(num / fmaxf(fabsf(den), sc[192 + t_])); }
                wprev = sc[320];
            }
            __syncthreads();
            {
                const int vi = w & 1; bf16x8 av[2];
#pragma unroll
                for (int kk = 0; kk < 2; ++kk) av[kk] = tr_frag(VW, 40, 32 * kk, 16 * vi, lane);
#pragma unroll
                for (int jj = 0; jj < 2; ++jj) { const int dj = (w >> 1) * 2 + jj; Cst[jj] = Cst[jj] * wprev;
#pragma unroll
                    for (int kk = 0; kk < 2; ++kk) Cst[jj] = __builtin_amdgcn_mfma_f32_16x16x32_bf16(av[kk], tr_frag(KS, 136, 32 * kk, 16 * dj, lane), Cst[jj], 0, 0, 0);
#pragma unroll
                    for (int i = 0; i < 4; ++i) CS[(16 * vi + 4 * q + i) * 136 + 16 * dj + r] = (bf16)f2bf(Cst[jj][i]); }
                Nst = Nst * wprev;
#pragma unroll
                for (int kk = 0; kk < 2; ++kk) Nst = __builtin_amdgcn_mfma_f32_16x16x32_bf16(row_frag(WKR, 72, 32 * kk, lane), tr_frag(KS, 136, 32 * kk, 16 * w, lane), Nst, 0, 0, 0);
                if (q == 0) CS[32 * 136 + 16 * w + r] = (bf16)f2bf(Nst[0]);
            }
        }
        __syncthreads();
        if (tid < 256) { const int t_ = tid >> 2; const int row = seq_row(b, dir, (NCH - 1) * 64 + t_);
            *(GAS u32x4*)(HS + ((size_t)dir * NTOK + row) * 1024 + h * 128 + vs * 32 + 8 * (tid & 3)) = *(const LAS u32x4*)(HO + t_ * 40 + 8 * (tid & 3)); }
#undef ML_LOAD
#undef ML_GLOAD
#undef ML_SCALARS
    }
}

template <int PROBE> PHASE_FN void hg_scan_phase(Frame F, const GAS bf16* Q, const GAS bf16* V, const GAS bf16* LF, GAS bf16* HSf, GAS bf16* HSb) {
    LAS bf16* QT = (LAS bf16*)(F.lds + 0); LAS bf16* QI = (LAS bf16*)(F.lds + 8704); LAS bf16* KT = (LAS bf16*)(F.lds + 17408); LAS bf16* KH = (LAS bf16*)(F.lds + 26112);
    LAS bf16* VS = (LAS bf16*)(F.lds + 34816); LAS bf16* AS = (LAS bf16*)(F.lds + 37376); LAS bf16* STs = (LAS bf16*)(F.lds + 39936); LAS bf16* HO = (LAS bf16*)(F.lds + 48640);
    LAS float* WT = (LAS float*)(F.lds + 51200); LAS float* SBL = (LAS float*)(F.lds + 55296);
    const int tid = F.tid, lane = F.lane, w = F.wave, r = lane & 15, q = lane >> 4;
    const int lrow = tid >> 4, lp = tid & 15;
    for (int unit = F.bid; unit < 256; unit += F.G) {
        const int vs = unit & 3, dir = (unit >> 2) & 1, h = (unit >> 3) & 7, b = unit >> 6;
        GAS bf16* HS = dir ? HSb : HSf; const GAS bf16* LFd = LF + (size_t)dir * NTOK * 1024;
        f32x4 Sst[2]; Sst[0] = (f32x4){0.f, 0.f, 0.f, 0.f}; Sst[1] = Sst[0];
        __syncthreads();
        for (int i = tid; i < 32 * 136; i += NTHR) STs[i] = 0;
        u32x4 rq, rl, rv = {0u, 0u, 0u, 0u};
#define HG_LOAD(c) do { const int row_ = seq_row(b, dir, (c) * 32 + lrow); rq = *(const GAS u32x4*)(Q + (size_t)row_ * 1024 + h * 128 + 8 * lp); rl = *(const GAS u32x4*)(LFd + (size_t)row_ * 1024 + h * 128 + 8 * lp); \
            if (tid < 128) { const int vrow_ = seq_row(b, dir, (c) * 32 + (tid >> 2)); rv = *(const GAS u32x4*)(V + (size_t)vrow_ * 1024 + h * 128 + vs * 32 + 8 * (tid & 3)); } } while (0)
        HG_LOAD(0);
        constexpr int NCH = T / 32;
        for (int c = 0; c < NCH; ++c) {
            float lf[8], bc[8];
#pragma unroll
            for (int jj = 0; jj < 4; ++jj) { lf[2 * jj] = bflo(rl[jj]); lf[2 * jj + 1] = bfhi(rl[jj]); }
#pragma unroll
            for (int j = 0; j < 8; ++j) { float x = lf[j]; float y = __shfl_up(x, 16); if (lane >= 16) x += y; y = __shfl_up(x, 32); if (lane >= 32) x += y; bc[j] = x; }
            if (lane >= 48) { *(LAS f32x4*)(WT + w * 128 + 8 * lp) = (f32x4){bc[0], bc[1], bc[2], bc[3]}; *(LAS f32x4*)(WT + w * 128 + 8 * lp + 4) = (f32x4){bc[4], bc[5], bc[6], bc[7]}; }
            __syncthreads();
            {
                float off[8], br[8], bl[8];
#pragma unroll
                for (int j = 0; j < 8; ++j) { off[j] = 0.f; br[j] = 0.f; bl[j] = 0.f; }
#pragma unroll
                for (int ww = 0; ww < 8; ++ww) { const f32x4 t0 = *(const LAS f32x4*)(WT + ww * 128 + 8 * lp), t1 = *(const LAS f32x4*)(WT + ww * 128 + 8 * lp + 4);
#pragma unroll
                    for (int j = 0; j < 4; ++j) { if (ww < w) { off[j] += t0[j]; off[4 + j] += t1[j]; } if (ww < 4) { br[j] += t0[j]; br[4 + j] += t1[j]; } bl[j] += t0[j]; bl[4 + j] += t1[j]; } }
                float qv[8];
#pragma unroll
                for (int jj = 0; jj < 4; ++jj) { qv[2 * jj] = bflo(rq[jj]); qv[2 * jj + 1] = bfhi(rq[jj]); }
                u32x4 oq, oi, ok, oh;
#pragma unroll
                for (int jj = 0; jj < 4; ++jj) { float a_[2], i_[2], k_[2], h_[2];
#pragma unroll
                    for (int hh = 0; hh < 2; ++hh) { const int j = 2 * jj + hh; const float bt = bc[j] + off[j]; const float key = -expm1f(lf[j]);
                        a_[hh] = qv[j] * __expf(bt - br[j]); i_[hh] = qv[j] * __expf(bt); k_[hh] = key * __expf(br[j] - bt); h_[hh] = key * __expf(bl[j] - bt); }
                    oq[jj] = pk2(a_[0], a_[1]); oi[jj] = pk2(i_[0], i_[1]); ok[jj] = pk2(k_[0], k_[1]); oh[jj] = pk2(h_[0], h_[1]); }
                *(LAS u32x4*)(QT + lrow * 136 + 8 * lp) = oq; *(LAS u32x4*)(QI + lrow * 136 + 8 * lp) = oi; *(LAS u32x4*)(KT + lrow * 136 + 8 * lp) = ok; *(LAS u32x4*)(KH + lrow * 136 + 8 * lp) = oh;
                if (lrow == 0) { *(LAS f32x4*)(SBL + 8 * lp) = (f32x4){__expf(bl[0]), __expf(bl[1]), __expf(bl[2]), __expf(bl[3])}; *(LAS f32x4*)(SBL + 8 * lp + 4) = (f32x4){__expf(bl[4]), __expf(bl[5]), __expf(bl[6]), __expf(bl[7])}; }
                if (tid < 128) { const int s_ = tid >> 2;
                    if (c > 0) { const int row = seq_row(b, dir, (c - 1) * 32 + s_); *(GAS u32x4*)(HS + (size_t)row * 1024 + h * 128 + vs * 32 + 8 * (tid & 3)) = *(const LAS u32x4*)(HO + s_ * 40 + 8 * (tid & 3)); }
                    *(LAS u32x4*)(VS + s_ * 40 + 8 * (tid & 3)) = rv; }
                if (c + 1 < NCH && !(PROBE & 1)) HG_LOAD(c + 1);
            }
            __syncthreads();
            f32x4 oacc = {0.f, 0.f, 0.f, 0.f}; const int ti = (w & 3) >> 1, xj = w & 1;
            if (w < 4) { f32x4 acc = {0.f, 0.f, 0.f, 0.f};
                if (xj <= ti) acc = mm16<128>(acc, QT + 16 * ti * 136, 136, KT + 16 * xj * 136, 136, lane);
#pragma unroll
                for (int i = 0; i < 4; ++i) { const int t_ = 16 * ti + 4 * q + i, s_ = 16 * xj + r; AS[t_ * 40 + s_] = (bf16)f2bf(s_ <= t_ ? acc[i] : 0.f); } }
            else oacc = mm16<128>(oacc, QI + 16 * ti * 136, 136, STs + 16 * xj * 136, 136, lane);
            __syncthreads();
            {
                const bf16x8 vb = tr_frag(VS, 40, 0, 16 * xj, lane);
                if (w >= 4) { oacc = __builtin_amdgcn_mfma_f32_16x16x32_bf16(row_frag(AS + 16 * ti * 40, 40, 0, lane), vb, oacc, 0, 0, 0);
#pragma unroll
                    for (int i = 0; i < 4; ++i) HO[(16 * ti + 4 * q + i) * 40 + 16 * xj + r] = (bf16)f2bf(oacc[i]); }
#pragma unroll
                for (int jj = 0; jj < 2; ++jj) { const int kj = (w >> 1) * 2 + jj; Sst[jj] = Sst[jj] * SBL[16 * kj + r];
                    Sst[jj] = __builtin_amdgcn_mfma_f32_16x16x32_bf16(vb, tr_frag(KH, 136, 0, 16 * kj, lane), Sst[jj], 0, 0, 0);
#pragma unroll
                    for (int i = 0; i < 4; ++i) STs[(16 * xj + 4 * q + i) * 136 + 16 * kj + r] = (bf16)f2bf(Sst[jj][i]); }
            }
        }
        __syncthreads();
        if (tid < 128) { const int s_ = tid >> 2; const int row = seq_row(b, dir, (NCH - 1) * 32 + s_); *(GAS u32x4*)(HS + (size_t)row * 1024 + h * 128 + vs * 32 + 8 * (tid & 3)) = *(const LAS u32x4*)(HO + s_ * 40 + 8 * (tid & 3)); }
#undef HG_LOAD
    }
}

__device__ __forceinline__ float fmix_lo(float a, unsigned b, float c) { float d; asm("v_fma_mix_f32 %0, %1, %2, %3 op_sel:[0,0,0] op_sel_hi:[0,1,0]" : "=v"(d) : "v"(a), "v"(b), "v"(c)); return d; }
__device__ __forceinline__ float fmix_hi(float a, unsigned b, float c) { float d; asm("v_fma_mix_f32 %0, %1, %2, %3 op_sel:[0,1,0] op_sel_hi:[0,1,0]" : "=v"(d) : "v"(a), "v"(b), "v"(c)); return d; }
__device__ __forceinline__ unsigned pkh2(float lo, float hi) { typedef _Float16 h2_t __attribute__((ext_vector_type(2))); h2_t v; v.x = (_Float16)lo; v.y = (_Float16)hi; return __builtin_bit_cast(unsigned, v); }
constexpr int RW_STEPB = 768;
typedef _Float16 h2_t __attribute__((ext_vector_type(2)));
template <int CTRL> __device__ __forceinline__ float dpp_add(float v) { return v + dpp_f<CTRL>(v); }
__device__ __forceinline__ float row8_sum(float v) { v = dpp_add<0xB1>(v); v = dpp_add<0x4E>(v); v = dpp_add<0x141>(v); return v; }
template <int PROBE> PHASE_FN void rw_scan_phase(Frame F, const GAS bf16* Rr, const GAS bf16* Kk, const GAS bf16* Vv, const GAS bf16* WH, const GAS bf16* AH, GAS bf16* O  , GAS float* BETA  ) {
    LAS bf16* W2T = (LAS bf16*)(F.lds + 0); LAS bf16* A2T = (LAS bf16*)(F.lds + 9216);
    LAS bf16* WHS = (LAS bf16*)(F.lds + 18432); LAS bf16* AHS = (LAS bf16*)(F.lds + 27648);
    LAS float* WPA = (LAS float*)(F.lds + 36864);
    LAS unsigned char* STEP = F.lds + 53248;
    LAS float* OP = (LAS float*)(F.lds + 102400);
    LAS float* SO = (LAS float*)(F.lds + 135168);
    LAS float* SVEC = (LAS float*)(F.lds + 143360);
    const int tid = F.tid, lane = F.lane, w = F.wave;
    constexpr int NCH = T / 32;
    for (int unit = F.bid; unit < 256; unit += F.G) {
        const int half = unit & 1, dir = (unit >> 1) & 1, h = (unit >> 2) & 15, b = unit >> 6;
        __syncthreads();
        for (int i = tid; i < 4096; i += NTHR) { const int l = i >> 6, jn = i & 63; W2T[jn * 72 + l] = (bf16)f2bf(INP(IN_RW_W2)[((size_t)(dir * 64 + l)) * 1024 + h * 64 + jn]); A2T[jn * 72 + l] = (bf16)f2bf(INP(IN_RW_A2)[((size_t)(dir * 64 + l)) * 1024 + h * 64 + jn]); }
        if (tid < 64) { SVEC[tid] = INP(IN_RW_W0)[dir * 1024 + h * 64 + tid]; SVEC[64 + tid] = INP(IN_RW_A0)[dir * 1024 + h * 64 + tid]; SVEC[128 + tid] = INP(IN_RW_KK)[h * 64 + tid];
            SVEC[192 + tid] = INP(IN_RW_KA)[h * 64 + tid]; SVEC[256 + tid] = INP(IN_RW_RK)[h * 64 + tid]; }
        __syncthreads();
        if (w >= 4) {
            const int p = w - 4, tl = lane >> 3, c8 = lane & 7, tp = 8 * p + tl, kc = 8 * c8;
            u32x4 rr, rk, rwh, rah; u32x2 rv;
#define RW_LOAD_RKV(cc) do { const size_t row_ = (size_t)seq_row(b, dir, (cc) * 32 + tp); rr = *(const GAS u32x4*)(Rr + row_ * 1024 + h * 64 + kc); rk = *(const GAS u32x4*)(Kk + row_ * 1024 + h * 64 + kc); \
                rv = *(const GAS u32x2*)(Vv + row_ * 1024 + h * 64 + half * 32 + 4 * c8); } while (0)
#define RW_LOAD_H(cc) do { const size_t row_ = (size_t)seq_row(b, dir, (cc) * 32 + tp); rwh = *(const GAS u32x4*)(WH + row_ * 128 + dir * 64 + kc); rah = *(const GAS u32x4*)(AH + row_ * 128 + dir * 64 + kc); } while (0)
#define RW_STAGE_H(buf) do { *(LAS u32x4*)(WHS + (buf) * (32 * 72) + tp * 72 + kc) = rwh; *(LAS u32x4*)(AHS + (buf) * (32 * 72) + tp * 72 + kc) = rah; } while (0)
#define RW_PREP(cc) do { const int bb_ = (cc) & 1; LAS float* wpa_ = WPA + p * 1024; const int r_ = lane & 15, q_ = lane >> 4; \
                _Pragma("unroll") for (int kt = 0; kt < 4; ++kt) { f32x4 aw_ = {0.f, 0.f, 0.f, 0.f}, aa_ = aw_; \
                    aw_ = mm16<64>(aw_, WHS + bb_ * (32 * 72) + 16 * (p >> 1) * 72, 72, W2T + 16 * kt * 72, 72, lane); aa_ = mm16<64>(aa_, AHS + bb_ * (32 * 72) + 16 * (p >> 1) * 72, 72, A2T + 16 * kt * 72, 72, lane); \
                    if ((q_ >> 1) == (p & 1)) { _Pragma("unroll") for (int i = 0; i < 4; ++i) { wpa_[(4 * (q_ & 1) + i) * 64 + 16 * kt + r_] = aw_[i]; wpa_[512 + (4 * (q_ & 1) + i) * 64 + 16 * kt + r_] = aa_[i]; } } } \
                LDS_WAIT(); \
                float wp_[8], ap_[8], kv_[8], rq_[8]; \
                _Pragma("unroll") for (int jj = 0; jj < 2; ++jj) { const f32x4 x_ = *(const LAS f32x4*)(wpa_ + tl * 64 + kc + 4 * jj) + *(const LAS f32x4*)(SVEC + kc + 4 * jj), y_ = *(const LAS f32x4*)(wpa_ + 512 + tl * 64 + kc + 4 * jj) + *(const LAS f32x4*)(SVEC + 64 + kc + 4 * jj); \
                    _Pragma("unroll") for (int i = 0; i < 4; ++i) { wp_[4 * jj + i] = x_[i]; ap_[4 * jj + i] = y_[i]; } } \
                _Pragma("unroll") for (int jj = 0; jj < 4; ++jj) { kv_[2 * jj] = bflo(rk[jj]); kv_[2 * jj + 1] = bfhi(rk[jj]); rq_[2 * jj] = bflo(rr[jj]); rq_[2 * jj + 1] = bfhi(rr[jj]); } \
                float now_[8], av_[8], kx_[8], ssq_ = 0.f, bet_ = 0.f; \
                _Pragma("unroll") for (int j = 0; j < 8; ++j) { now_[j] = __expf(-0.6065306597126334f * sigmoid_f(wp_[j])) - 1.0f; av_[j] = sigmoid_f(ap_[j]); kx_[j] = kv_[j] * SVEC[128 + kc + j]; ssq_ += kx_[j] * kx_[j]; } \
                ssq_ = row8_sum(ssq_); const float rn_ = 1.0f / sqrtf(fmaxf(ssq_, 1e-24f)); \
                u32x4 p0_, p1_, p2_, p3_, p4_; \
                _Pragma("unroll") for (int jj = 0; jj < 4; ++jj) { float nk_[2], ak_[2], kd_[2]; \
                    _Pragma("unroll") for (int hh = 0; hh < 2; ++hh) { const int j = 2 * jj + hh; const float kkn_ = kx_[j] * rn_; nk_[hh] = -kkn_; ak_[hh] = kkn_ * av_[j]; kd_[hh] = kv_[j] * (1.0f + (av_[j] - 1.0f) * SVEC[192 + kc + j]); bet_ += rq_[j] * kd_[hh] * SVEC[256 + kc + j]; } \
                    p0_[jj] = pkh2(now_[2 * jj], now_[2 * jj + 1]); p1_[jj] = pkh2(nk_[0], nk_[1]); p4_[jj] = pkh2(rq_[2 * jj], rq_[2 * jj + 1]); \
                    if (jj < 2) { p2_[2 * jj] = pkh2(ak_[0], kd_[0]); p2_[2 * jj + 1] = pkh2(ak_[1], kd_[1]); } else { p3_[2 * (jj - 2)] = pkh2(ak_[0], kd_[0]); p3_[2 * (jj - 2) + 1] = pkh2(ak_[1], kd_[1]); } } \
                bet_ = row8_sum(bet_); \
                LAS unsigned char* sp_ = STEP + bb_ * (32 * RW_STEPB) + tp * RW_STEPB + c8 * 80; \
                *(LAS u32x4*)sp_ = p0_; *(LAS u32x4*)(sp_ + 16) = p1_; *(LAS u32x4*)(sp_ + 32) = p2_; *(LAS u32x4*)(sp_ + 48) = p3_; *(LAS u32x4*)(sp_ + 64) = p4_; \
                *(LAS f32x4*)(STEP + bb_ * (32 * RW_STEPB) + tp * RW_STEPB + 640 + 16 * c8) = (f32x4){bflo(rv.x), bfhi(rv.x), bflo(rv.y), bfhi(rv.y)}; \
                if (c8 == 0 && half == 0) BETA[((size_t)dir * NTOK + seq_row(b, dir, (cc) * 32 + tp)) * 16 + h] = bet_; } while (0)
#define RW_STORE(cc) do { const size_t row_ = (size_t)seq_row(b, dir, (cc) * 32 + tp); const f32x4 o_ = *(const LAS f32x4*)(SO + ((cc) & 1) * 1024 + tp * 32 + 4 * c8); u32x2 pk_; pk_.x = pk2(o_[0], o_[1]); pk_.y = pk2(o_[2], o_[3]); \
                *(GAS u32x2*)(O + ((size_t)dir * NTOK + row_) * 1024 + h * 64 + half * 32 + 4 * c8) = pk_; } while (0)
            RW_LOAD_H(0); RW_LOAD_RKV(0); RW_STAGE_H(0); RW_LOAD_H(1);
            __syncthreads();
            RW_PREP(0); RW_STAGE_H(1); RW_LOAD_RKV(1); RW_LOAD_H(2);
            __syncthreads();
            for (int c = 0; c < NCH; ++c) {
                if (!(PROBE & 2)) {
                if (c > 0) RW_STORE(c - 1);
                if (c + 1 < NCH) { RW_PREP(c + 1); if (c + 2 < NCH) { RW_STAGE_H(c & 1); RW_LOAD_RKV(c + 2); if (c + 3 < NCH) RW_LOAD_H(c + 3); } }
                }
                __syncthreads();
            }
            RW_STORE(NCH - 1);
#undef RW_LOAD_RKV
#undef RW_LOAD_H
#undef RW_STAGE_H
#undef RW_PREP
#undef RW_STORE
        } else {
            const int row = tid >> 3, c8 = tid & 7;
            float S0 = 0.f, S1 = 0.f, S2 = 0.f, S3 = 0.f, S4 = 0.f, S5 = 0.f, S6 = 0.f, S7 = 0.f;
            __syncthreads();
            __syncthreads();
            for (int c = 0; c < NCH; ++c) {
                if (!(PROBE & 1)) {
                const LAS unsigned char* sp = STEP + (c & 1) * (32 * RW_STEPB) + c8 * 80; const LAS unsigned char* vp = STEP + (c & 1) * (32 * RW_STEPB) + 640 + 4 * row; LAS float* op = OP + row * 8 + c8;
                u32x4 a0 = *(const LAS u32x4*)sp, a1 = *(const LAS u32x4*)(sp + 16), a2 = *(const LAS u32x4*)(sp + 32), a3 = *(const LAS u32x4*)(sp + 48), a4 = *(const LAS u32x4*)(sp + 64); float vv = *(const LAS float*)vp;
#pragma unroll 4
                for (int t_ = 0; t_ < 32; ++t_) {
                    const int tn = (t_ + 1) & 31;
                    const LAS unsigned char* np = sp + tn * RW_STEPB;
                    const u32x4 n0 = *(const LAS u32x4*)np, n1 = *(const LAS u32x4*)(np + 16), n2 = *(const LAS u32x4*)(np + 32), n3 = *(const LAS u32x4*)(np + 48), n4 = *(const LAS u32x4*)(np + 64); const float vn = *(const LAS float*)(vp + tn * RW_STEPB);
                    float sa, sb, oa, ob; unsigned sv;
                    asm volatile(
                        "v_fma_mix_f32 %8, %0, %14, 0 op_sel:[0,0,0] op_sel_hi:[0,1,0]\n\t"
                        "v_fma_mix_f32 %9, %1, %14, 0 op_sel:[0,1,0] op_sel_hi:[0,1,0]\n\t"
                        "v_fma_mix_f32 %8, %2, %15, %8 op_sel:[0,0,0] op_sel_hi:[0,1,0]\n\t"
                        "v_fma_mix_f32 %9, %3, %15, %9 op_sel:[0,1,0] op_sel_hi:[0,1,0]\n\t"
                        "v_fma_mix_f32 %8, %4, %16, %8 op_sel:[0,0,0] op_sel_hi:[0,1,0]\n\t"
                        "v_fma_mix_f32 %9, %5, %16, %9 op_sel:[0,1,0] op_sel_hi:[0,1,0]\n\t"
                        "v_fma_mix_f32 %8, %6, %17, %8 op_sel:[0,0,0] op_sel_hi:[0,1,0]\n\t"
                        "v_fma_mix_f32 %9, %7, %17, %9 op_sel:[0,1,0] op_sel_hi:[0,1,0]\n\t"
                        "v_fma_mix_f32 %0, %0, %10, %0 op_sel:[0,0,0] op_sel_hi:[0,1,0]\n\t"
                        "v_fma_mix_f32 %1, %1, %10, %1 op_sel:[0,1,0] op_sel_hi:[0,1,0]\n\t"
                        "v_fma_mix_f32 %2, %2, %11, %2 op_sel:[0,0,0] op_sel_hi:[0,1,0]\n\t"
                        "v_fma_mix_f32 %3, %3, %11, %3 op_sel:[0,1,0] op_sel_hi:[0,1,0]\n\t"
                        "v_add_f32 %8, %8, %9\n\t"
                        "v_fma_mix_f32 %4, %4, %12, %4 op_sel:[0,0,0] op_sel_hi:[0,1,0]\n\t"
                        "v_fma_mix_f32 %5, %5, %12, %5 op_sel:[0,1,0] op_sel_hi:[0,1,0]\n\t"
                        "v_add_f32_dpp %8, %8, %8 quad_perm:[1,0,3,2] row_mask:0xf bank_mask:0xf bound_ctrl:1\n\t"
                        "v_fma_mix_f32 %6, %6, %13, %6 op_sel:[0,0,0] op_sel_hi:[0,1,0]\n\t"
                        "v_fma_mix_f32 %7, %7, %13, %7 op_sel:[0,1,0] op_sel_hi:[0,1,0]\n\t"
                        "v_add_f32_dpp %8, %8, %8 quad_perm:[2,3,0,1] row_mask:0xf bank_mask:0xf bound_ctrl:1\n\t"
                        "s_nop 1\n\t"
                        "v_add_f32_dpp %8, %8, %8 row_half_mirror row_mask:0xf bank_mask:0xf bound_ctrl:1\n\t"
                        "s_nop 0"
                        : "+v"(S0), "+v"(S1), "+v"(S2), "+v"(S3), "+v"(S4), "+v"(S5), "+v"(S6), "+v"(S7), "=&v"(sa), "=&v"(sb)
                        : "v"(a0[0]), "v"(a0[1]), "v"(a0[2]), "v"(a0[3]), "v"(a1[0]), "v"(a1[1]), "v"(a1[2]), "v"(a1[3]));
                    asm volatile(
                        "v_cvt_pkrtz_f16_f32 %8, %11, %12\n\t"
                        "v_dot2c_f32_f16 %0, %8, %13\n\t"
                        "v_dot2c_f32_f16 %1, %8, %14\n\t"
                        "v_dot2c_f32_f16 %2, %8, %15\n\t"
                        "v_dot2c_f32_f16 %3, %8, %16\n\t"
                        "v_dot2c_f32_f16 %4, %8, %17\n\t"
                        "v_dot2c_f32_f16 %5, %8, %18\n\t"
                        "v_dot2c_f32_f16 %6, %8, %19\n\t"
                        "v_dot2c_f32_f16 %7, %8, %20\n\t"
                        "v_fma_mix_f32 %9, %0, %21, 0 op_sel:[0,0,0] op_sel_hi:[0,1,0]\n\t"
                        "v_fma_mix_f32 %10, %1, %21, 0 op_sel:[0,1,0] op_sel_hi:[0,1,0]\n\t"
                        "v_fma_mix_f32 %9, %2, %22, %9 op_sel:[0,0,0] op_sel_hi:[0,1,0]\n\t"
                        "v_fma_mix_f32 %10, %3, %22, %10 op_sel:[0,1,0] op_sel_hi:[0,1,0]\n\t"
                        "v_fma_mix_f32 %9, %4, %23, %9 op_sel:[0,0,0] op_sel_hi:[0,1,0]\n\t"
                        "v_fma_mix_f32 %10, %5, %23, %10 op_sel:[0,1,0] op_sel_hi:[0,1,0]\n\t"
                        "v_fma_mix_f32 %9, %6, %24, %9 op_sel:[0,0,0] op_sel_hi:[0,1,0]\n\t"
                        "v_fma_mix_f32 %10, %7, %24, %10 op_sel:[0,1,0] op_sel_hi:[0,1,0]\n\t"
                        "v_add_f32 %9, %9, %10\n\t"
                        "s_nop 0"
                        : "+v"(S0), "+v"(S1), "+v"(S2), "+v"(S3), "+v"(S4), "+v"(S5), "+v"(S6), "+v"(S7), "=&v"(sv), "=&v"(oa), "=&v"(ob)
                        : "v"(sa), "v"(vv), "v"(a2[0]), "v"(a2[1]), "v"(a2[2]), "v"(a2[3]), "v"(a3[0]), "v"(a3[1]), "v"(a3[2]), "v"(a3[3]), "v"(a4[0]), "v"(a4[1]), "v"(a4[2]), "v"(a4[3]));
                    op[t_ * 256] = oa;
                    a0 = n0; a1 = n1; a2 = n2; a3 = n3; a4 = n4; vv = vn;
                }
                LDS_WAIT();
#pragma unroll
                for (int i = 0; i < 4; ++i) { const LAS f32x4* q_ = (const LAS f32x4*)(OP + ((4 * c8 + i) * 32 + row) * 8); const f32x4 x_ = q_[0] + q_[1]; SO[(c & 1) * 1024 + (4 * c8 + i) * 32 + row] = (x_[0] + x_[1]) + (x_[2] + x_[3]); }
                }
                __syncthreads();
            }
        }
    }
}

PHASE_FN void gemm_mlin(Frame F, int jl) { GAS unsigned char* MIX = F.ws + WS_MIX; GAS unsigned char* HY = F.ws + WS_HY;
    pg8::Gemm g{(const GAS bf16*)HY, (const GAS bf16*)(F.W + W_ML_WIN + jl * W_ML_WIN_SZ), NTOK, 4352, 1024}; pg8::StaticOrder So; So.init(NTOK, 4352, F.G, F.bid);
    pg8::EpiMlstmIn E{(GAS bf16*)MIX, (GAS bf16*)(MIX + 2 * ROWB), (GAS bf16*)(MIX + 3 * ROWB), (GAS float*)(MIX + 4 * ROWB), INP(IN_ML_BGATE) + jl * 32};
    pg8::gemm_phase<pg8::EpiMlstmIn, pg8::StaticOrder, GEMM_ALIGN, GEMM_SP2>(F.lds, g, So, E, F.tid); }
PHASE_FN void gemm_resid(Frame F, const GAS bf16* A, const GAS bf16* Bt, int L) {
    pg8::Gemm g{A, Bt, NTOK, 1024, 1024}; pg8::StaticOrder So; So.init(NTOK, 1024, F.G, F.bid);
    pg8::EpiResid E{(GAS float*)(F.ws + WS_S), (const GAS float*)(F.ws + WS_MOD) + (size_t)L * 5 * 6144, 2}; pg8::gemm_phase<pg8::EpiResid, pg8::StaticOrder, GEMM_ALIGN, GEMM_SP2>(F.lds, g, So, E, F.tid); }
PHASE_FN void gemm_rwin(Frame F) { GAS unsigned char* MIX = F.ws + WS_MIX; GAS unsigned char* HY = F.ws + WS_HY;
    GAS bf16* Rb = (GAS bf16*)MIX; GAS bf16* Kb = (GAS bf16*)(MIX + ROWB); GAS bf16* Vb = (GAS bf16*)(MIX + 2 * ROWB); GAS float* WH = (GAS float*)(MIX + 3 * ROWB); GAS float* AH = WH + (size_t)NTOK * 128; GAS bf16* GH = (GAS bf16*)(AH + (size_t)NTOK * 128);
    pg8::Gemm g{(const GAS bf16*)HY, (const GAS bf16*)(F.W + W_RW_IN), NTOK, 3584, 2048}; pg8::StaticOrder So; So.init(NTOK, 3584, F.G, F.bid);
    pg8::EpiRwkvIn E{Rb, Kb, Vb, WH, AH, GH}; pg8::gemm_phase<pg8::EpiRwkvIn, pg8::StaticOrder, GEMM_ALIGN, GEMM_SP2>(F.lds, g, So, E, F.tid); }
PHASE_FN void gemm_rwg(Frame F) { GAS unsigned char* MIX = F.ws + WS_MIX;
    GAS float* WH = (GAS float*)(MIX + 3 * ROWB); GAS float* AH = WH + (size_t)NTOK * 128; GAS bf16* GH = (GAS bf16*)(AH + (size_t)NTOK * 128);
    pg8::Gemm g{GH, (const GAS bf16*)(F.W + W_RW_G2), NTOK, 1024, 256}; pg8::StaticOrder So; So.init(NTOK, 1024, F.G, F.bid);
    pg8::EpiBf16Plain E{(GAS bf16*)MIX, 1024}; pg8::gemm_phase<pg8::EpiBf16Plain, pg8::StaticOrder, GEMM_ALIGN, GEMM_SP2>(F.lds, g, So, E, F.tid); }
PHASE_FN void gemm_hgin(Frame F) { GAS unsigned char* MIX = F.ws + WS_MIX; GAS unsigned char* HY = F.ws + WS_HY;
    pg8::Gemm g{(const GAS bf16*)HY, (const GAS bf16*)(F.W + W_HG_IN), NTOK, 5120, 1024}; pg8::StaticOrder So; So.init(NTOK, 5120, F.G, F.bid);
    pg8::EpiHgrnIn E{(GAS bf16*)MIX, (GAS bf16*)(MIX + ROWB), (GAS bf16*)(MIX + 2 * ROWB), (GAS bf16*)(MIX + 3 * ROWB), (size_t)NTOK * 1024, INP(IN_HG_BF), (const GAS float*)(F.ws + WS_LB)};
    pg8::gemm_phase<pg8::EpiHgrnIn, pg8::StaticOrder, GEMM_ALIGN, GEMM_SP2>(F.lds, g, So, E, F.tid); }
PHASE_FN void gemm_moe1(Frame F, int L) { GAS unsigned char* MIX = F.ws + WS_MIX; LAS int* pref = (LAS int*)(F.lds + LDS_PHASE_BYTES); moe_prefix(F, L, pref, pref + 32);
    pg8::Gemm g{(const GAS bf16*)(F.ws + WS_HY), (const GAS bf16*)(F.W + W_EX13), NSLOT, 16384, 1024, (const GAS int*)(F.ws + WS_SLOT_TOK)}; pg8::MoeOrder So{pref, F.G, F.bid};
    pg8::EpiMoe1 E{(GAS bf16*)(MIX + 140 * MiB)}; pg8::gemm_phase<pg8::EpiMoe1, pg8::MoeOrder, GEMM_ALIGN, GEMM_SP2, true>(F.lds, g, So, E, F.tid); }
PHASE_FN void gemm_moe2(Frame F, int L) { GAS unsigned char* MIX = F.ws + WS_MIX; LAS int* pref = (LAS int*)(F.lds + LDS_PHASE_BYTES); moe_prefix(F, L, pref, pref + 32);
    pg8::Gemm g{(const GAS bf16*)(MIX + 140 * MiB), (const GAS bf16*)(F.W + W_EX2), NSLOT, 16384, 512}; pg8::MoeOrder So{pref, F.G, F.bid};
    pg8::EpiMoe2 E{(GAS bf16*)(MIX + 210 * MiB), (const GAS int*)(F.ws + WS_SLOT_TOK), (const GAS float*)(F.ws + WS_SLOT_GATE)};
    pg8::gemm_phase<pg8::EpiMoe2, pg8::MoeOrder, GEMM_ALIGN, GEMM_SP2>(F.lds, g, So, E, F.tid); }

#ifndef MK_PER_PHASE
#define MK_PER_PHASE 0
#endif
constexpr int PH_PER_LAYER = 12, PH_LAYER0 = 2, PH_FINAL = PH_LAYER0 + DEPTH * PH_PER_LAYER, N_PHASES = PH_FINAL + 1;
__global__ void __launch_bounds__(NTHR, 2) fwd_kernel(Args args) {
    extern __shared__ __attribute__((aligned(16))) unsigned char lds_raw[];
    Frame F;
    F.lds = (LAS unsigned char*)lds_raw; F.out = (GAS float*)args.out; F.ws = (GAS unsigned char*)args.ws; F.W = (GAS unsigned char*)args.wts;
    F.tid = threadIdx.x; F.lane = F.tid & 63; F.wave = __builtin_amdgcn_readfirstlane(F.tid >> 6); F.bid = blockIdx.x; F.G = gridDim.x;
    volatile LAS unsigned* MISC = (volatile LAS unsigned*)(F.lds + MISC_OFF);
    if (F.tid < 32) MISC[F.tid] = 0u;
    if (F.tid < 42) ((LAS unsigned long long*)(F.lds + PTAB_OFF))[F.tid] = (unsigned long long)args.in[F.tid];
    __syncthreads();
    const int lo = args.ph_lo, hi = args.ph_hi;
    XcdBarrier bar; bar.bar = (unsigned*)args.ws + CW_BAR; bar.x = 0; bar.st = MISC + 8;
    if (hi - lo > 1) bar = xcd_barrier_post((unsigned*)args.ws + CW_BAR, MISC + 8);
#define IN(k) (lo <= (k) && (k) < hi)
#define SEAM(k) do { if ((k) + 1 < hi) xcd_barrier(bar); } while (0)
#ifndef DUP_MASK
#define DUP_MASK 0
#endif
#ifndef PRB_MASK
#define PRB_MASK 0
#endif
#define PRB(bit, stmt) do { if ((PRB_MASK >> (bit)) & 1) { stmt; xcd_barrier(bar); } } while (0)
#define DUP(bit, stmt) do { stmt; if ((DUP_MASK >> (bit)) & 1) { xcd_barrier(bar); stmt; } } while (0)

    if (IN(0)) { PRB(0, pre_phase(fresh(F))); pre_phase(fresh(F)); SEAM(0); }
    if (IN(1)) { PRB(0, modsum_phase(fresh(F))); modsum_phase(fresh(F)); SEAM(1); }

    for (int L = 0; L < DEPTH; ++L) {
        const int kind = L % 3, jl = L / 3, pb = PH_LAYER0 + L * PH_PER_LAYER;
        if (IN(pb + 0)) { DUP(6, expert_weights(fresh(F), L)); if ((PRB_MASK >> 1) & 1) { norm_phase<0, 1>(fresh(F), L, L > 0, kind == 1 ? 2048 : 1024); xcd_barrier(bar); } norm_phase<0>(fresh(F), L, L > 0, kind == 1 ? 2048 : 1024); SEAM(pb + 0); }
        if (kind == 0) {
            if (IN(pb + 2)) { DUP(3, gemm_mlin(fresh(F), jl)); SEAM(pb + 2); }
            if (IN(pb + 3)) { DUP(7, conv_phase(fresh(F), jl)); SEAM(pb + 3); }
            if (IN(pb + 4)) { const Frame Fp = fresh(F); GAS unsigned char* MIX = Fp.ws + WS_MIX;
#ifndef SC_PROBE
#define SC_PROBE 0
#endif
                if (SC_PROBE) { ml_scan_phase<SC_PROBE>(Fp, (const GAS bf16*)(Fp.ws + WS_HY), (const GAS bf16*)(MIX + 2 * ROWB), (const GAS float*)(MIX + 4 * ROWB), (GAS bf16*)MIX); xcd_barrier(bar); }
                DUP(0, ml_scan_phase<0>(Fp, (const GAS bf16*)(Fp.ws + WS_HY), (const GAS bf16*)(MIX + 2 * ROWB), (const GAS float*)(MIX + 4 * ROWB), (GAS bf16*)MIX)); SEAM(pb + 4); }
            if (IN(pb + 6)) { const Frame Fp = fresh(F); GAS unsigned char* MIX = Fp.ws + WS_MIX;
                PRB(4, headnorm_phase(Fp, (const GAS bf16*)MIX, (const GAS bf16*)(MIX + ROWB), (const GAS bf16*)(MIX + 3 * ROWB), ldptr(Fp, IN_ML_HEADG) + jl * 1024, (GAS bf16*)(Fp.ws + WS_HY + ROWB)));
                headnorm_phase(Fp, (const GAS bf16*)MIX, (const GAS bf16*)(MIX + ROWB), (const GAS bf16*)(MIX + 3 * ROWB), ldptr(Fp, IN_ML_HEADG) + jl * 1024, (GAS bf16*)(Fp.ws + WS_HY + ROWB)); SEAM(pb + 6); }
            if (IN(pb + 7)) { const Frame Fp = fresh(F); gemm_resid(Fp, (const GAS bf16*)(Fp.ws + WS_HY + ROWB), (const GAS bf16*)(Fp.W + W_ML_WOUT + jl * 2 * MiB), L); SEAM(pb + 7); }
        } else if (kind == 1) {
            if (IN(pb + 1)) { PRB(4, du_phase(fresh(F))); du_phase(fresh(F)); SEAM(pb + 1); }
            if (IN(pb + 2)) { DUP(3, gemm_rwin(fresh(F))); SEAM(pb + 2); }
            if (IN(pb + 4)) { const Frame Fp = fresh(F); GAS unsigned char* MIX = Fp.ws + WS_MIX; GAS float* WH = (GAS float*)(MIX + 3 * ROWB); GAS float* AH = WH + (size_t)NTOK * 128; GAS float* BETA = (GAS float*)((GAS bf16*)(AH + (size_t)NTOK * 128) + (size_t)NTOK * 256);

#ifndef RW_PROBE
#define RW_PROBE 0
#endif
                if (RW_PROBE) { rw_scan_phase<RW_PROBE>(Fp, (const GAS bf16*)MIX, (const GAS bf16*)(MIX + ROWB), (const GAS bf16*)(MIX + 2 * ROWB), (const GAS bf16*)WH, (const GAS bf16*)AH, (GAS bf16*)(Fp.ws + WS_HY), BETA); xcd_barrier(bar); }
                DUP(1, rw_scan_phase<0>(Fp, (const GAS bf16*)MIX, (const GAS bf16*)(MIX + ROWB), (const GAS bf16*)(MIX + 2 * ROWB), (const GAS bf16*)WH, (const GAS bf16*)AH, (GAS bf16*)(Fp.ws + WS_HY), BETA)); SEAM(pb + 4); }
            if (IN(pb + 5)) { PRB(4, gemm_rwg(fresh(F))); gemm_rwg(fresh(F)); SEAM(pb + 5); }
            if (IN(pb + 6)) { const Frame Fp = fresh(F); GAS unsigned char* MIX = Fp.ws + WS_MIX; GAS float* WH = (GAS float*)(MIX + 3 * ROWB); GAS float* AH = WH + (size_t)NTOK * 128; GAS float* BETA = (GAS float*)((GAS bf16*)(AH + (size_t)NTOK * 128) + (size_t)NTOK * 256);
                PRB(4, rwpost_phase(Fp, (const GAS bf16*)(Fp.ws + WS_HY), (const GAS bf16*)(Fp.ws + WS_HY + ROWB), BETA, (const GAS bf16*)(MIX + 2 * ROWB), (const GAS bf16*)MIX, (GAS bf16*)(MIX + ROWB)));
                rwpost_phase(Fp, (const GAS bf16*)(Fp.ws + WS_HY), (const GAS bf16*)(Fp.ws + WS_HY + ROWB), BETA, (const GAS bf16*)(MIX + 2 * ROWB), (const GAS bf16*)MIX, (GAS bf16*)(MIX + ROWB)); SEAM(pb + 6); }
            if (IN(pb + 7)) { const Frame Fp = fresh(F); gemm_resid(Fp, (const GAS bf16*)(Fp.ws + WS_MIX + ROWB), (const GAS bf16*)(Fp.W + W_RW_WOUT), L); SEAM(pb + 7); }
        } else {
            if (IN(pb + 2)) { DUP(3, gemm_hgin(fresh(F))); SEAM(pb + 2); }
            if (IN(pb + 4)) { const Frame Fp = fresh(F); GAS unsigned char* MIX = Fp.ws + WS_MIX;
                if (SC_PROBE) { hg_scan_phase<SC_PROBE>(Fp, (const GAS bf16*)MIX, (const GAS bf16*)(MIX + ROWB), (const GAS bf16*)(MIX + 3 * ROWB), (GAS bf16*)(Fp.ws + WS_HY + ROWB), (GAS bf16*)(Fp.ws + WS_HY)); xcd_barrier(bar); }
                DUP(2, hg_scan_phase<0>(Fp, (const GAS bf16*)MIX, (const GAS bf16*)(MIX + ROWB), (const GAS bf16*)(MIX + 3 * ROWB), (GAS bf16*)(Fp.ws + WS_HY + ROWB), (GAS bf16*)(Fp.ws + WS_HY))); SEAM(pb + 4); }
            if (IN(pb + 6)) { const Frame Fp = fresh(F); GAS unsigned char* MIX = Fp.ws + WS_MIX;
                headnorm_phase(Fp, (const GAS bf16*)(Fp.ws + WS_HY + ROWB), (const GAS bf16*)(Fp.ws + WS_HY), (const GAS bf16*)(MIX + 2 * ROWB), ldptr(Fp, IN_HG_HEADG), (GAS bf16*)(Fp.ws + WS_HY + ROWB)); SEAM(pb + 6); }
            if (IN(pb + 7)) { const Frame Fp = fresh(F); gemm_resid(Fp, (const GAS bf16*)(Fp.ws + WS_HY + ROWB), (const GAS bf16*)(Fp.W + W_HG_WOUT), L); SEAM(pb + 7); }
        }
        if (IN(pb + 8)) { if ((PRB_MASK >> 2) & 1) { norm_phase<1, 1>(fresh(F), L, false, 1024); xcd_barrier(bar); } norm_phase<1>(fresh(F), L, false, 1024); SEAM(pb + 8); }
        if (IN(pb + 9)) { if ((PRB_MASK >> 3) & 1) { slots_phase<1>(fresh(F), L); xcd_barrier(bar); } slots_phase<0>(fresh(F), L); SEAM(pb + 9); }
        if (IN(pb + 10)) { DUP(4, gemm_moe1(fresh(F), L)); SEAM(pb + 10); }
        if (IN(pb + 11)) { DUP(5, gemm_moe2(fresh(F), L)); SEAM(pb + 11); }
    }
    if (IN(PH_FINAL)) norm_phase<2>(fresh(F), 0, true, 1024);
#undef IN
#undef SEAM
}

extern "C" void kernel_launch(void* const* d_in, const int* in_sizes, int n_in, void* d_out, int out_size, void* d_ws, size_t ws_size, hipStream_t stream) {
    static int grid = 0;
    if (grid == 0) {
        if (n_in != 42 || out_size != NB * SEQ * D || ws_size < WS_END) { fprintf(stderr, "kernel_launch: unexpected problem (n_in %d, out %d, ws %zu)\n", n_in, out_size, ws_size); grid = -1; return; }
        int dev = 0, cus = 0, per_cu = 0;
        if (hipGetDevice(&dev) != hipSuccess || hipDeviceGetAttribute(&cus, hipDeviceAttributeMultiprocessorCount, dev) != hipSuccess) { grid = -1; return; }
        if (hipFuncSetAttribute((const void*)fwd_kernel, hipFuncAttributeMaxDynamicSharedMemorySize, LDS_BYTES) != hipSuccess) { fprintf(stderr, "kernel_launch: hipFuncSetAttribute failed\n"); grid = -1; return; }
        if (hipOccupancyMaxActiveBlocksPerMultiprocessor(&per_cu, (const void*)fwd_kernel, NTHR, LDS_BYTES) != hipSuccess || per_cu < 1) { fprintf(stderr, "kernel_launch: occupancy query reports %d\n", per_cu); (void)hipGetLastError(); grid = -1; return; }
        grid = cus;
    }
    if (grid < 0) return;
    (void)hipMemsetAsync(d_ws, 0, CTL_ZERO_BYTES, stream);
    Args a{};
    for (int i = 0; i < 42; ++i) a.in[i] = (const float*)d_in[i];
    a.out = (float*)d_out; a.ws = (unsigned char*)d_ws;
    a.wts = (ws_size >= WS_END + W_BYTES) ? (unsigned char*)d_ws + WS_END : (unsigned char*)d_out;
#if MK_PER_PHASE
    for (int p = 0; p < N_PHASES; ++p) { a.ph_lo = p; a.ph_hi = p + 1; hipLaunchKernelGGL(fwd_kernel, dim3(grid), dim3(NTHR), LDS_BYTES, stream, a); }
#else
    a.ph_lo = 0; a.ph_hi = N_PHASES;
    hipLaunchKernelGGL(fwd_kernel, dim3(grid), dim3(NTHR), LDS_BYTES, stream, a);
#endif
}
```

```cpp
#include <hip/hip_runtime.h>
#include <cstdio>
#include <cstdint>

__device__ __forceinline__ float sigmoid_f(float x) { return 1.0f / (1.0f + __expf(-x)); }
__device__ __forceinline__ float silu_f(float x) { return x / (1.0f + __expf(-x)); }
__device__ __forceinline__ float logsigmoid_f(float x) { return fminf(x, 0.f) - log1pf(__expf(-fabsf(x))); }
#define GAS __attribute__((address_space(1)))
namespace pg8 {
#define PG8_LAS __attribute__((address_space(3)))
typedef unsigned short bf16_t;
typedef short bf16x8 __attribute__((ext_vector_type(8)));
typedef float f32x4 __attribute__((ext_vector_type(4)));
typedef unsigned u32x4 __attribute__((ext_vector_type(4)));
constexpr int BM = 256, BK = 64, HALF = 128, HTB = HALF * BK * 2  , STAGE_BYTES = 8 * HTB, NXCD = 8, WGM = 8;

__host__ __device__ __forceinline__ int lds_byte(int r, int c) { const int st = (r >> 4) * 2 + (c >> 5), rr = r & 15, cc = c & 31, ob = rr * 64 + cc * 2; return st * 1024 + (ob ^ (((ob >> 9) & 1) << 5)); }
__host__ __device__ __forceinline__ void stage_rc(int b, int& R, int& C) { const int st = b / 1024, sb = b % 1024, swz = sb ^ (((sb >> 9) & 1) << 5); R = (st >> 1) * 16 + swz / 64; C = (st & 1) * 32 + (swz % 64) / 2; }
__host__ __device__ __forceinline__ int perm32(int rho) { const int n = rho >> 4, i = rho & 15; return 8 * (i >> 2) + 4 * n + (i & 3); }

struct Unit { int pm, pn; };
struct Gemm { const GAS bf16_t* A; const GAS bf16_t* Bt; int M, N, K; const GAS int* gidx; };

struct StaticOrder {
    int nM, nN, nwg, G, c;
    __host__ __device__ void init(int M, int N, int G_, int c_) { nM = M / BM; nN = N / BM; nwg = nM * nN; G = G_; c = c_; }
    __host__ __device__ bool next(int i, Unit& u) const {
        const long L = (long)i * G + c; if (L >= nwg) return false;
        int wgid = (int)L; { const int q = nwg / NXCD, r = nwg % NXCD, xcd = wgid % NXCD, off = wgid / NXCD; wgid = (xcd < r ? xcd * (q + 1) : r * (q + 1) + (xcd - r) * q) + off; }
        const int nig = WGM * nN, gid = wgid / nig, fm = gid * WGM, gsz = (nM - fm) < WGM ? (nM - fm) : WGM;
        u.pm = fm + ((wgid % nig) % gsz); u.pn = (wgid % nig) / gsz; return true;
    }
    __device__ __forceinline__ void a_ready(const Unit&) const {}
    __device__ __forceinline__ void done(const Unit&) const {}
};
__device__ __forceinline__ unsigned cvt_pk_bf16(float lo, float hi) { unsigned r; asm volatile("v_cvt_pk_bf16_f32 %0, %1, %2" : "=v"(r) : "v"(lo), "v"(hi)); return r; }
typedef unsigned u32x2 __attribute__((ext_vector_type(2)));
__device__ __forceinline__ void st8(GAS bf16_t* p, f32x4 v0, f32x4 v1) { u32x4 w; w.x = cvt_pk_bf16(v0[0], v0[1]); w.y = cvt_pk_bf16(v0[2], v0[3]); w.z = cvt_pk_bf16(v1[0], v1[1]); w.w = cvt_pk_bf16(v1[2], v1[3]); *(GAS u32x4*)p = w; }
template <int ACT> __device__ __forceinline__ f32x4 act4(f32x4 v) {
    if (ACT == 1) { v[0] = sigmoid_f(v[0]); v[1] = sigmoid_f(v[1]); v[2] = sigmoid_f(v[2]); v[3] = sigmoid_f(v[3]); }
    if (ACT == 2) { v[0] = silu_f(v[0]); v[1] = silu_f(v[1]); v[2] = silu_f(v[2]); v[3] = silu_f(v[3]); }
    return v; }
template <int ACT> __device__ __forceinline__ void store_tile_bf16(const f32x4 (&acc)[2][2][4][2], GAS bf16_t* base, int ld, int row0, int cw) {
#pragma unroll
    for (int ai = 0; ai < 2; ++ai)
#pragma unroll
        for (int m = 0; m < 4; ++m) { GAS bf16_t* rp = base + (size_t)(row0 + ai * HALF + m * 16) * ld + cw;
#pragma unroll
            for (int bj = 0; bj < 2; ++bj) st8(rp + bj * HALF, act4<ACT>(acc[ai][bj][m][0]), act4<ACT>(acc[ai][bj][m][1])); }
}
struct EpiBf16Plain { static constexpr bool PERM = true, AFTER_DRAIN = false; GAS bf16_t* O; int ldc;
    __device__ __forceinline__ void operator()(const f32x4 (&acc)[2][2][4][2], const Unit& u, int wr, int wc, int fr, int fq) const {
        store_tile_bf16<0>(acc, O + u.pn * BM, ldc, u.pm * BM + wr * 64 + fr, wc * 32 + 8 * fq); }
};
struct EpiMlstmIn { static constexpr bool PERM = true, AFTER_DRAIN = false;
    GAS bf16_t* QKPRE; GAS bf16_t* V; GAS bf16_t* OG; GAS float* GATES; const GAS float* bgate;
    __device__ __forceinline__ void operator()(const f32x4 (&acc)[2][2][4][2], const Unit& u, int wr, int wc, int fr, int fq) const {
        const int row0 = u.pm * BM + wr * 64 + fr, cw = wc * 32 + 8 * fq;
        if (u.pn < 8) store_tile_bf16<0>(acc, QKPRE + u.pn * BM, 2048, row0, cw);
        else if (u.pn < 12) store_tile_bf16<0>(acc, V + (u.pn - 8) * BM, 1024, row0, cw);
        else if (u.pn < 16) store_tile_bf16<1>(acc, OG + (u.pn - 12) * BM, 1024, row0, cw);
        else if (wc == 0) {
            const f32x4 b0 = *(const GAS f32x4*)(bgate + 8 * fq), b1 = *(const GAS f32x4*)(bgate + 8 * fq + 4);
#pragma unroll
            for (int ai = 0; ai < 2; ++ai)
#pragma unroll
                for (int m = 0; m < 4; ++m) { GAS float* gp = GATES + (size_t)(row0 + ai * HALF + m * 16) * 32 + 8 * fq;
                    *(GAS f32x4*)gp = acc[ai][0][m][0] + b0; *(GAS f32x4*)(gp + 4) = acc[ai][0][m][1] + b1; }
        }
    }
};
struct EpiRwkvIn { static constexpr bool PERM = true, AFTER_DRAIN = false;
    GAS bf16_t* R; GAS bf16_t* Kk; GAS bf16_t* V; GAS float* WH; GAS float* AH; GAS bf16_t* GH;
    __device__ __forceinline__ void operator()(const f32x4 (&acc)[2][2][4][2], const Unit& u, int wr, int wc, int fr, int fq) const {
        const int row0 = u.pm * BM + wr * 64 + fr, cw = wc * 32 + 8 * fq;
        if (u.pn < 4) store_tile_bf16<0>(acc, R + u.pn * BM, 1024, row0, cw);
        else if (u.pn < 8) store_tile_bf16<0>(acc, Kk + (u.pn - 4) * BM, 1024, row0, cw);
        else if (u.pn < 12) store_tile_bf16<0>(acc, V + (u.pn - 8) * BM, 1024, row0, cw);
        else if (u.pn == 12) {
#pragma unroll
            for (int ai = 0; ai < 2; ++ai)
#pragma unroll
                for (int m = 0; m < 4; ++m) { const size_t r = (size_t)(row0 + ai * HALF + m * 16);
                    f32x4 t0 = acc[ai][0][m][0], t1 = acc[ai][0][m][1];
#pragma unroll
                    for (int j = 0; j < 4; ++j) { t0[j] = tanhf(t0[j]); t1[j] = tanhf(t1[j]); }
                    st8((GAS bf16_t*)WH + r * 128 + cw, t0, t1); st8((GAS bf16_t*)AH + r * 128 + cw, acc[ai][1][m][0], acc[ai][1][m][1]); }
        } else {
#pragma unroll
            for (int ai = 0; ai < 2; ++ai)
#pragma unroll
                for (int m = 0; m < 4; ++m) { GAS bf16_t* rp = GH + (size_t)(row0 + ai * HALF + m * 16) * 256 + cw;
                    st8(rp, act4<1>(acc[ai][0][m][0]), act4<1>(acc[ai][0][m][1])); *(GAS u32x4*)(rp + HALF) = (u32x4){0u, 0u, 0u, 0u}; }
        }
    }
};
struct EpiHgrnIn { static constexpr bool PERM = true, AFTER_DRAIN = false;
    GAS bf16_t* Q; GAS bf16_t* V; GAS bf16_t* OG; GAS bf16_t* LF; size_t lf_stride; const GAS float* bf; const GAS float* lb;
    __device__ __forceinline__ void operator()(const f32x4 (&acc)[2][2][4][2], const Unit& u, int wr, int wc, int fr, int fq) const {
        const int row0 = u.pm * BM + wr * 64 + fr, cw = wc * 32 + 8 * fq;
        if (u.pn < 4) store_tile_bf16<2>(acc, Q + u.pn * BM, 1024, row0, cw);
        else if (u.pn < 8) store_tile_bf16<0>(acc, V + (u.pn - 4) * BM, 1024, row0, cw);
        else if (u.pn < 12) store_tile_bf16<2>(acc, OG + (u.pn - 8) * BM, 1024, row0, cw);
        else {
            const int dir = (u.pn - 12) >> 2, ct = ((u.pn - 12) & 3) * BM; GAS bf16_t* base = LF + (size_t)dir * lf_stride + ct;
            f32x4 bb[2][2], ll[2][2];
#pragma unroll
            for (int bj = 0; bj < 2; ++bj)
#pragma unroll
                for (int n = 0; n < 2; ++n) { bb[bj][n] = *(const GAS f32x4*)(bf + dir * 1024 + ct + bj * HALF + cw + 4 * n); ll[bj][n] = *(const GAS f32x4*)(lb + ct + bj * HALF + cw + 4 * n); }
#pragma unroll
            for (int ai = 0; ai < 2; ++ai)
#pragma unroll
                for (int m = 0; m < 4; ++m) { GAS bf16_t* rp = base + (size_t)(row0 + ai * HALF + m * 16) * 1024 + cw;
#pragma unroll
                    for (int bj = 0; bj < 2; ++bj) { f32x4 o[2];
#pragma unroll
                        for (int n = 0; n < 2; ++n)
#pragma unroll
                            for (int j = 0; j < 4; ++j) { const float l = ll[bj][n][j]; o[n][j] = __logf(l + (1.f - l) * sigmoid_f(acc[ai][bj][m][n][j] + bb[bj][n][j])); }
                        st8(rp + bj * HALF, o[0], o[1]); } }
        }
    }
};
struct EpiResid { static constexpr bool PERM = false, AFTER_DRAIN = false;
    GAS float* S; const GAS float* mod; int gate_idx;
    __device__ __forceinline__ void operator()(const f32x4 (&acc)[2][2][4][2], const Unit& u, int wr, int wc, int fr, int fq) const {
        const int b = u.pm / 33, seg = (u.pm - b * 33 == 0) ? 0 : 1 + b;
        const int row0 = u.pm * BM + wr * 64 + fr, col0 = u.pn * BM + wc * 32 + 4 * fq;
        const GAS float* gp = mod + seg * 6144 + gate_idx * 1024 + col0;
        f32x4 gv[2][2];
#pragma unroll
        for (int bj = 0; bj < 2; ++bj)
#pragma unroll
            for (int n = 0; n < 2; ++n) gv[bj][n] = *(const GAS f32x4*)(gp + bj * HALF + n * 16);
#pragma unroll
        for (int ai = 0; ai < 2; ++ai)
#pragma unroll
            for (int m = 0; m < 4; ++m) { GAS float* rowp = S + (size_t)(row0 + ai * HALF + m * 16) * 1024 + col0;
#pragma unroll
                for (int bj = 0; bj < 2; ++bj)
#pragma unroll
                    for (int n = 0; n < 2; ++n) { GAS f32x4* p = (GAS f32x4*)(rowp + bj * HALF + n * 16); *p = *p + acc[ai][bj][m][n] * gv[bj][n]; } }
    }
};
struct EpiMoe1 { static constexpr bool PERM = true, AFTER_DRAIN = false; GAS bf16_t* ACT;
    __device__ __forceinline__ void operator()(const f32x4 (&acc)[2][2][4][2], const Unit& u, int wr, int wc, int fr, int fq) const {
        const int row0 = u.pm * BM + wr * 64 + fr, pnl = u.pn & 3, c0 = pnl * 128 + wc * 16 + 4 * fq;
#pragma unroll
        for (int ai = 0; ai < 2; ++ai)
#pragma unroll
            for (int m = 0; m < 4; ++m) { GAS bf16_t* rp = ACT + (size_t)(row0 + ai * HALF + m * 16) * 512 + c0;
#pragma unroll
                for (int bj = 0; bj < 2; ++bj) { const f32x4 a = acc[ai][bj][m][0], b = acc[ai][bj][m][1];
                    u32x2 w; w.x = cvt_pk_bf16(silu_f(a[0]) * b[0], silu_f(a[1]) * b[1]); w.y = cvt_pk_bf16(silu_f(a[2]) * b[2], silu_f(a[3]) * b[3]);
                    *(GAS u32x2*)(rp + bj * 64) = w; } }
    }
};
struct EpiMoe2 { static constexpr bool PERM = true, AFTER_DRAIN = false; GAS bf16_t* YM; const GAS int* slot_tok; const GAS float* slot_gate;
    __device__ __forceinline__ void operator()(const f32x4 (&acc)[2][2][4][2], const Unit& u, int wr, int wc, int fr, int fq) const {
        const int row0 = u.pm * BM + wr * 64 + fr, col0 = (u.pn & 3) * BM + wc * 32 + 8 * fq;
#pragma unroll
        for (int ai = 0; ai < 2; ++ai)
#pragma unroll
            for (int m = 0; m < 4; ++m) { const int slot = row0 + ai * HALF + m * 16; const int dst = slot_tok[slot]; const float g = slot_gate[slot];
                if (dst >= 0) { GAS bf16_t* rp = YM + (size_t)dst * 1024 + col0;
#pragma unroll
                    for (int bj = 0; bj < 2; ++bj) st8(rp + bj * HALF, acc[ai][bj][m][0] * g, acc[ai][bj][m][1] * g); } }
    }
};
struct MoeOrder { const PG8_LAS int* pref; int G, c;
    __device__ __forceinline__ bool next(int i, Unit& u) const {
        const int L = i * G + c, nt = pref[16]; if (L >= nt * 4) return false;
        const int tile = L >> 2; int e = 0;
#pragma unroll
        for (int j = 1; j < 16; ++j) e += (tile >= pref[j]) ? 1 : 0;
        u.pm = tile; u.pn = e * 4 + (L & 3); return true; }
    __device__ __forceinline__ void a_ready(const Unit&) const {}
    __device__ __forceinline__ void done(const Unit&) const {}
};
template <class Epi, class Sched, bool ALIGN_EPI = false, bool SP2 = false, bool GATHER = false>
__device__ __forceinline__ void gemm_phase(PG8_LAS unsigned char* lds, const Gemm g, const Sched& S, const Epi& E, const int tid_in) {
    int tid_ = tid_in; asm volatile("" : "+v"(tid_));
    const int tid = tid_, wid = __builtin_amdgcn_readfirstlane(tid >> 6), lane = tid & 63, wr = wid >> 2, wc = wid & 3, fr = lane & 15, fq = lane >> 4;
    const int K = g.K, nt = K / BK;
    unsigned voffA[2], voffB[2];
#pragma unroll
    for (int i = 0; i < 2; ++i) { int R, C; stage_rc(tid * 16 + i * 8192, R, C); const int Rb = Epi::PERM ? ((R & ~31) + perm32(R & 31)) : R;
        voffA[i] = (unsigned)(R * K + C) * 2u; voffB[i] = (unsigned)(Rb * K + C) * 2u; }
    unsigned offc[2][2], offn[2][2];
#define PG8_GOFF(dst, unit) do { _Pragma("unroll") for (int _h = 0; _h < 2; ++_h) _Pragma("unroll") for (int _i = 0; _i < 2; ++_i) { int _R, _C; stage_rc(tid * 16 + _i * 8192, _R, _C); \
        const int _t = g.gidx[(unit).pm * BM + _h * HALF + _R]; dst[_h][_i] = (unsigned)(((_t < 0 ? 0 : (_t >> 1)) * K + _C) * 2); } } while (0)
    const size_t kstep = (size_t)(BK * 2);
    const size_t hstep = (size_t)HALF * K * 2;
    const size_t tstep = 2 * hstep;
    if constexpr (!GATHER) {
#pragma unroll
        for (int h_ = 0; h_ < 2; ++h_)
#pragma unroll
            for (int i = 0; i < 2; ++i) { offc[h_][i] = voffA[i] + (unsigned)(h_ * hstep); offn[h_][i] = offc[h_][i]; } }
    const unsigned ldsw = (unsigned)wid * 1024u;
    const int aoff = lds_byte(wr * 64 + fr, fq * 8), boff = lds_byte(wc * 32 + fr, fq * 8);
#define PG8_SA(b, h) (((b) * 2 + (h)) * HTB)
#define PG8_SB(b, h) ((4 + (b) * 2 + (h)) * HTB)
#define PG8_STAGE(bufoff, gbase, voff) do { _Pragma("unroll") for (int _i = 0; _i < 2; ++_i) \
        __builtin_amdgcn_global_load_lds((const unsigned*)((const char*)(gbase) + (voff)[_i]), (PG8_LAS unsigned*)(lds + (bufoff) + ldsw + _i * 8192), 16, 0, 0); } while (0)
#define PG8_STAGE_A(bufoff, gbase, off2) do { _Pragma("unroll") for (int _i = 0; _i < 2; ++_i) \
        __builtin_amdgcn_global_load_lds((const unsigned*)((const char*)(gbase) + (off2)[_i]), (PG8_LAS unsigned*)(lds + (bufoff) + ldsw + _i * 8192), 16, 0, 0); } while (0)
#define PG8_LDA(dst, b, h) do { _Pragma("unroll") for (int m = 0; m < 4; ++m) _Pragma("unroll") for (int k = 0; k < 2; ++k) dst[m][k] = *(const PG8_LAS bf16x8*)(lds + PG8_SA(b, h) + aoff + m * 2048 + k * 1024); } while (0)
#define PG8_LDB(dst, b, h) do { _Pragma("unroll") for (int n = 0; n < 2; ++n) _Pragma("unroll") for (int k = 0; k < 2; ++k) dst[n][k] = *(const PG8_LAS bf16x8*)(lds + PG8_SB(b, h) + boff + n * 2048 + k * 1024); } while (0)
#define PG8_MMA(ai, bj, At, Bt) do { __builtin_amdgcn_s_setprio(1); _Pragma("unroll") for (int m = 0; m < 4; ++m) _Pragma("unroll") for (int n = 0; n < 2; ++n) _Pragma("unroll") for (int k = 0; k < 2; ++k) \
        acc[ai][bj][m][n] = __builtin_amdgcn_mfma_f32_16x16x32_bf16(Bt[n][k], At[m][k], acc[ai][bj][m][n], 0, 0, 0); __builtin_amdgcn_s_setprio(0); } while (0)
#define PG8_WAIT_V(n) asm volatile("s_waitcnt vmcnt(" #n ")" ::: "memory")
#define PG8_WAIT_L(n) asm volatile("s_waitcnt lgkmcnt(" #n ")" ::: "memory")
#define PG8_BAR __builtin_amdgcn_s_barrier()
#define PG8_SCHED __builtin_amdgcn_sched_barrier(0)
    Unit cur, nxt; int ui = 0;
    if (!S.next(0, cur)) return;
    f32x4 acc[2][2][4][2];
#pragma unroll
    for (int a = 0; a < 2; ++a)
#pragma unroll
        for (int b = 0; b < 2; ++b)
#pragma unroll
            for (int m = 0; m < 4; ++m)
#pragma unroll
                for (int n = 0; n < 2; ++n) acc[a][b][m][n] = (f32x4){0.f, 0.f, 0.f, 0.f};
    bf16x8 At[4][2], B0[2][2], B1[2][2];
    const char* cA = (const char*)g.A + (GATHER ? (size_t)0 : (size_t)cur.pm * tstep); const char* cB = (const char*)g.Bt + (size_t)cur.pn * tstep;
    S.a_ready(cur);
    if constexpr (GATHER) PG8_GOFF(offc, cur);
    if constexpr (SP2) {
        PG8_STAGE(PG8_SB(0, 0), cB, voffB); PG8_STAGE(PG8_SB(0, 1), cB + hstep, voffB); PG8_STAGE_A(PG8_SA(0, 0), cA, offc[0]); PG8_STAGE_A(PG8_SA(0, 1), cA, offc[1]);
        if (wr == 1) PG8_BAR;
        PG8_WAIT_V(2); PG8_BAR;
        PG8_STAGE(PG8_SB(1, 0), cB + kstep, voffB); PG8_STAGE_A(PG8_SA(1, 0), cA + kstep, offc[0]); PG8_STAGE(PG8_SB(1, 1), cB + hstep + kstep, voffB);
        PG8_WAIT_V(6); PG8_BAR;
    } else {
        PG8_STAGE(PG8_SB(0, 0), cB, voffB); PG8_STAGE_A(PG8_SA(0, 0), cA, offc[0]); PG8_STAGE(PG8_SB(0, 1), cB + hstep, voffB); PG8_STAGE_A(PG8_SA(0, 1), cA, offc[1]);
        if (wr == 1) PG8_BAR;
        PG8_WAIT_V(4); PG8_BAR;
        PG8_STAGE(PG8_SB(1, 0), cB + kstep, voffB); PG8_STAGE_A(PG8_SA(1, 0), cA + kstep, offc[0]); PG8_STAGE(PG8_SB(1, 1), cB + hstep + kstep, voffB);
        PG8_WAIT_V(6); PG8_BAR;
    }
    for (;;) {
        const bool has_next = S.next(ui + 1, nxt);
        const char* nA = (has_next && !GATHER) ? (const char*)g.A + (size_t)nxt.pm * tstep : cA; const char* nB = has_next ? (const char*)g.Bt + (size_t)nxt.pn * tstep : cB;
        if constexpr (GATHER) { if (has_next) PG8_GOFF(offn, nxt); else {
#pragma unroll
            for (int h_ = 0; h_ < 2; ++h_)
#pragma unroll
                for (int i = 0; i < 2; ++i) offn[h_][i] = offc[h_][i]; } }
        for (int t = 0; t < nt; t += 2) {
            const bool last = (t == nt - 2);
            const char* a1 = cA + (size_t)(t + 1) * kstep;
            const char* a2 = last ? nA : cA + (size_t)(t + 2) * kstep; const char* b2 = last ? nB : cB + (size_t)(t + 2) * kstep;
            const char* a3 = a2 + kstep; const char* b3 = b2 + kstep;
            if (last && has_next) S.a_ready(nxt);
            if constexpr (SP2) {
            PG8_LDB(B0, 0, 0); PG8_LDB(B1, 0, 1); PG8_SCHED; PG8_LDA(At, 0, 0); PG8_STAGE_A(PG8_SA(1, 1), a1, offc[1]); if constexpr (GATHER) { if (last) { offc[0][0] = offn[0][0]; offc[0][1] = offn[0][1]; offc[1][0] = offn[1][0]; offc[1][1] = offn[1][1]; } }
            PG8_WAIT_V(8); PG8_WAIT_L(0); PG8_BAR; PG8_MMA(0, 0, At, B0); PG8_MMA(0, 1, At, B1); PG8_BAR; PG8_SCHED;
            PG8_LDA(At, 0, 1); PG8_STAGE(PG8_SB(0, 0), b2, voffB); PG8_STAGE(PG8_SB(0, 1), b2 + hstep, voffB); PG8_STAGE_A(PG8_SA(0, 0), a2, offc[0]);
            PG8_WAIT_V(8); PG8_WAIT_L(0); PG8_BAR; PG8_MMA(1, 0, At, B0); PG8_MMA(1, 1, At, B1); PG8_BAR; PG8_SCHED;
            PG8_LDB(B0, 1, 0); PG8_LDB(B1, 1, 1); PG8_SCHED; PG8_LDA(At, 1, 0); PG8_STAGE_A(PG8_SA(0, 1), a2, offc[1]);
            PG8_WAIT_V(8); PG8_WAIT_L(0); PG8_BAR; PG8_MMA(0, 0, At, B0); PG8_MMA(0, 1, At, B1); PG8_BAR; PG8_SCHED;
            PG8_LDA(At, 1, 1); PG8_STAGE(PG8_SB(1, 0), b3, voffB); PG8_STAGE(PG8_SB(1, 1), b3 + hstep, voffB); PG8_STAGE_A(PG8_SA(1, 0), a3, offc[0]);
            PG8_WAIT_V(8); PG8_WAIT_L(0); PG8_BAR; PG8_MMA(1, 0, At, B0); PG8_MMA(1, 1, At, B1); PG8_BAR; PG8_SCHED;
            } else {
            PG8_LDB(B0, 0, 0); PG8_SCHED; PG8_LDA(At, 0, 0); PG8_STAGE_A(PG8_SA(1, 1), a1, offc[1]); if constexpr (GATHER) { if (last) { offc[0][0] = offn[0][0]; offc[0][1] = offn[0][1]; offc[1][0] = offn[1][0]; offc[1][1] = offn[1][1]; } }
            PG8_WAIT_L(8); PG8_BAR; PG8_WAIT_L(0); PG8_MMA(0, 0, At, B0); PG8_BAR; PG8_SCHED;
            PG8_LDB(B1, 0, 1); PG8_STAGE(PG8_SB(0, 0), b2, voffB);
            PG8_BAR; PG8_WAIT_L(0); PG8_MMA(0, 1, At, B1); PG8_BAR;
            PG8_LDA(At, 0, 1); PG8_STAGE_A(PG8_SA(0, 0), a2, offc[0]);
            PG8_BAR; PG8_WAIT_L(0); PG8_MMA(1, 0, At, B0); PG8_BAR; PG8_SCHED;
            PG8_STAGE(PG8_SB(0, 1), b2 + hstep, voffB);
            PG8_WAIT_V(6); PG8_BAR; PG8_MMA(1, 1, At, B1); PG8_BAR;
            PG8_LDB(B0, 1, 0); PG8_SCHED; PG8_LDA(At, 1, 0); PG8_STAGE_A(PG8_SA(0, 1), a2, offc[1]);
            PG8_WAIT_L(8); PG8_BAR; PG8_WAIT_L(0); PG8_MMA(0, 0, At, B0); PG8_BAR; PG8_SCHED;
            PG8_LDB(B1, 1, 1); PG8_STAGE(PG8_SB(1, 0), b3, voffB);
            PG8_BAR; PG8_WAIT_L(0); PG8_MMA(0, 1, At, B1); PG8_BAR;
            PG8_LDA(At, 1, 1); PG8_STAGE_A(PG8_SA(1, 0), a3, offc[0]);
            PG8_BAR; PG8_WAIT_L(0); PG8_MMA(1, 0, At, B0); PG8_BAR; PG8_SCHED;
            PG8_STAGE(PG8_SB(1, 1), b3 + hstep, voffB);
            PG8_WAIT_V(6); PG8_BAR; PG8_MMA(1, 1, At, B1); PG8_BAR;
            }
        }
        if constexpr (ALIGN_EPI) { if (wr == 0) PG8_BAR; }
        if constexpr (!Epi::AFTER_DRAIN) { E(acc, cur, wr, wc, fr, fq); S.done(cur); }
        if (!has_next) break;
#pragma unroll
        for (int a = 0; a < 2; ++a)
#pragma unroll
            for (int b = 0; b < 2; ++b)
#pragma unroll
                for (int m = 0; m < 4; ++m)
#pragma unroll
                    for (int n = 0; n < 2; ++n) acc[a][b][m][n] = (f32x4){0.f, 0.f, 0.f, 0.f};
        cur = nxt; cA = nA; cB = nB; ++ui;

        if constexpr (ALIGN_EPI) { if (wr == 1) PG8_BAR; }
    }
    PG8_WAIT_V(0);
    if constexpr (!ALIGN_EPI) { if (wr == 0) PG8_BAR; }
    PG8_BAR;
    if constexpr (Epi::AFTER_DRAIN) { E.fused(acc, cur, wr, wc, fr, fq, lds, wid, lane); S.done(cur); }
#undef PG8_SA
#undef PG8_SB
#undef PG8_STAGE
#undef PG8_STAGE_A
#undef PG8_GOFF
#undef PG8_LDA
#undef PG8_LDB
#undef PG8_MMA
#undef PG8_WAIT_V
#undef PG8_WAIT_L
#undef PG8_BAR
#undef PG8_SCHED
}
}

#define LAS __attribute__((address_space(3)))
#ifndef PHASE_FN
#define PHASE_FN __device__ __forceinline__
#endif
#ifndef GEMM_SP2
#define GEMM_SP2 true
#endif
#ifndef GEMM_ALIGN
#define GEMM_ALIGN false
#endif
typedef unsigned short bf16;
typedef pg8::bf16x8 bf16x8;
typedef pg8::f32x4 f32x4;
typedef pg8::u32x4 u32x4;
typedef pg8::u32x2 u32x2;
constexpr int D = 1024, NB = 4, SEQ = 8192, CTX = 256, T = CTX + SEQ, NTOK = NB * T, DEPTH = 4;
constexpr int NWAVES = 8, NTHR = 512;
constexpr int NSLOT = 71680;
constexpr size_t MiB = 1u << 20;
constexpr size_t CTL_ZERO_BYTES = 2 * MiB;
constexpr int CW_BAR = 1024;
constexpr int CW_MOE = 8192;
constexpr size_t WS_MOD = 1 * MiB;
constexpr size_t WS_LB = 2 * MiB;
constexpr size_t WS_TOK = 2 * MiB + 65536;
constexpr size_t WS_SLOT_TOK = 3 * MiB;
constexpr size_t WS_SLOT_GATE = 3 * MiB + 524288;
constexpr size_t WS_S = 4 * MiB;
constexpr size_t WS_HY = 136 * MiB;
constexpr size_t WS_MIX = 268 * MiB;
constexpr size_t WS_END = 610 * MiB;
constexpr size_t ROWB = (size_t)NTOK * 1024 * 2;
constexpr size_t W_ML_WIN = 0, W_ML_WIN_SZ = (size_t)4352 * 1024 * 2;
constexpr size_t W_ML_WOUT = 17 * MiB;
constexpr size_t W_RW_IN = 21 * MiB;
constexpr size_t W_RW_G2 = 35 * MiB;
constexpr size_t W_RW_WOUT = 36 * MiB;
constexpr size_t W_HG_IN = 38 * MiB;
constexpr size_t W_HG_WOUT = 48 * MiB;
constexpr size_t W_EX13 = 50 * MiB;
constexpr size_t W_EX2 = 82 * MiB;
constexpr size_t W_BYTES = 98 * MiB;
constexpr int LDS_PHASE_BYTES = 131072;
constexpr int LDS_BYTES = 163840;
constexpr int MISC_OFF = LDS_BYTES - 2048;

#define VM_WAIT() asm volatile("s_waitcnt vmcnt(0)" ::: "memory")
#define LDS_WAIT() asm volatile("s_waitcnt lgkmcnt(0)" ::: "memory")
typedef float f32x2_t __attribute__((ext_vector_type(2))); typedef __bf16 bf16x2_t __attribute__((ext_vector_type(2)));
__device__ __forceinline__ unsigned pk2(float lo, float hi) { f32x2_t v = {lo, hi}; bf16x2_t b = __builtin_convertvector(v, bf16x2_t); return __builtin_bit_cast(unsigned, b); }
__device__ __forceinline__ unsigned f2bf(float f) { return pk2(f, f) & 0xffffu; }
__device__ __forceinline__ float bf2f(unsigned b) { return __builtin_bit_cast(float, b << 16); }
__device__ __forceinline__ float bflo(unsigned w) { return __builtin_bit_cast(float, w << 16); }
__device__ __forceinline__ float bfhi(unsigned w) { return __builtin_bit_cast(float, w & 0xffff0000u); }
__device__ __forceinline__ float wave_sum(float v) {
#pragma unroll
    for (int o = 1; o < 64; o <<= 1) v += __shfl_xor(v, o);
    return v; }
__device__ __forceinline__ float wave_max(float v) {
#pragma unroll
    for (int o = 1; o < 64; o <<= 1) v = fmaxf(v, __shfl_xor(v, o));
    return v; }
template <int CTRL> __device__ __forceinline__ float dpp_f(float v) { return __builtin_bit_cast(float, __builtin_amdgcn_update_dpp(0, __builtin_bit_cast(int, v), CTRL, 0xF, 0xF, false)); }
__device__ __forceinline__ float row16_sum(float v) { v += dpp_f<0xB1>(v); v += dpp_f<0x4E>(v); v += dpp_f<0x124>(v); v += dpp_f<0x128>(v); return v; }
template <int CTRL, int ROWMASK> __device__ __forceinline__ float dpp_keep(float old, float v) { return __builtin_bit_cast(float, __builtin_amdgcn_update_dpp(__builtin_bit_cast(int, old), __builtin_bit_cast(int, v), CTRL, ROWMASK, 0xF, false)); }
__device__ __forceinline__ float wave_scan_add(float v) {
    v += dpp_keep<0x111, 0xF>(0.f, v); v += dpp_keep<0x112, 0xF>(0.f, v); v += dpp_keep<0x114, 0xF>(0.f, v); v += dpp_keep<0x118, 0xF>(0.f, v);
    v += dpp_keep<0x142, 0xA>(0.f, v); v += dpp_keep<0x143, 0xC>(0.f, v); return v; }
__device__ __forceinline__ float wave_scan_max(float v) {
    v = fmaxf(v, dpp_keep<0x111, 0xF>(v, v)); v = fmaxf(v, dpp_keep<0x112, 0xF>(v, v)); v = fmaxf(v, dpp_keep<0x114, 0xF>(v, v)); v = fmaxf(v, dpp_keep<0x118, 0xF>(v, v));
    v = fmaxf(v, dpp_keep<0x142, 0xA>(v, v)); v = fmaxf(v, dpp_keep<0x143, 0xC>(v, v)); return v; }
__device__ __forceinline__ float lane63(float v) { return __builtin_bit_cast(float, __builtin_amdgcn_readlane(__builtin_bit_cast(int, v), 63)); }
template <int K> __device__ __forceinline__ f32x4 mm16(f32x4 acc, const LAS bf16* A, int lda, const LAS bf16* Bt, int ldb, int lane) {
    const int r = lane & 15, q = lane >> 4;
#pragma unroll
    for (int kk = 0; kk < K / 32; ++kk) {
        const bf16x8 a = *(const LAS bf16x8*)(A + r * lda + kk * 32 + q * 8);
        const bf16x8 b = *(const LAS bf16x8*)(Bt + r * ldb + kk * 32 + q * 8);
        acc = __builtin_amdgcn_mfma_f32_16x16x32_bf16(a, b, acc, 0, 0, 0); }
    return acc; }
typedef short s16x4 __attribute__((ext_vector_type(4)));
__device__ __forceinline__ bf16x8 tr_frag(const LAS bf16* X, int ld, int k0, int n0, int lane) {
    const int g = lane >> 4, a = (lane & 15) >> 2, p = lane & 3;
    const LAS bf16* p0 = X + (k0 + 8 * g + a) * ld + n0 + 4 * p;
    const s16x4 lo = __builtin_amdgcn_ds_read_tr16_b64_v4i16((LAS s16x4*)p0), hi = __builtin_amdgcn_ds_read_tr16_b64_v4i16((LAS s16x4*)(p0 + 4 * ld));
    return (bf16x8){lo[0], lo[1], lo[2], lo[3], hi[0], hi[1], hi[2], hi[3]}; }
__device__ __forceinline__ bf16x8 row_frag(const LAS bf16* A, int ld, int k0, int lane) { return *(const LAS bf16x8*)(A + (lane & 15) * ld + k0 + (lane >> 4) * 8); }
__device__ __forceinline__ int seq_row(int b, int dir, int i) {
    const int tt = (i < CTX) ? (dir ? CTX - 1 - i : i) : CTX + (dir ? SEQ - 1 - (i - CTX) : (i - CTX));
    return b * T + tt; }

#define XB_TMO      128
#define XB_XCNT(j)  (256  + 64 * (j))
#define XB_XSUB(j)  (1280 + 64 * (j))
#define XB_XGEN(j)  (2304 + 64 * (j))
#define XB_TOP      3328
#define XB_TOPGEN   3392
#define XCD_BAR_WORDS 3456
#define XB_SPIN_CAP (1u << 18)

__device__ __forceinline__ unsigned xb_ld(unsigned* p)              { return __hip_atomic_load(p, __ATOMIC_RELAXED, __HIP_MEMORY_SCOPE_AGENT); }
__device__ __forceinline__ unsigned xb_add(unsigned* p, unsigned v) { return __hip_atomic_fetch_add(p, v, __ATOMIC_RELAXED, __HIP_MEMORY_SCOPE_AGENT); }
__device__ __forceinline__ unsigned xb_xcc_id() { return (unsigned)__builtin_amdgcn_s_getreg((3 << 11) | 20) & 0xFu; }
#define XB_SPIN(cond, bar) do { unsigned _sp = 0; while (cond) { __builtin_amdgcn_s_sleep(1); \
    if ((++_sp & 255u) == 0u) { if (xb_ld(&(bar)[XB_TMO])) break; if (_sp > XB_SPIN_CAP) { atomicAdd(&(bar)[XB_TMO], 1u); break; } } } } while (0)

struct XcdBarrier {
    unsigned* bar; unsigned x;
    volatile LAS unsigned* st;
};

__device__ __forceinline__ XcdBarrier xcd_barrier_post(unsigned* bar, volatile LAS unsigned* st) {
    XcdBarrier b; b.bar = bar; b.x = xb_xcc_id(); b.st = st;
    if (threadIdx.x == 0) (void)xb_add(&bar[XB_XCNT(b.x)], 1u);
    return b;
}
__device__ __forceinline__ void xcd_barrier_complete(unsigned* bar, unsigned x, unsigned& nloc, unsigned& nx) {
    const unsigned G = gridDim.x * gridDim.y * gridDim.z;
    unsigned sum, cnt, mine, sp = 0u;
    for (;;) {
        sum = 0u; cnt = 0u; mine = 0u;
#pragma unroll
        for (unsigned j = 0; j < 16; ++j) { const unsigned c = xb_ld(&bar[XB_XCNT(j)]); sum += c; cnt += (c > 0u) ? 1u : 0u; mine = (j == x) ? c : mine; }
        if (sum == G) break;
        __builtin_amdgcn_s_sleep(1);
        if ((++sp & 255u) == 0u) { if (xb_ld(&bar[XB_TMO])) break; if (sp > XB_SPIN_CAP) { atomicAdd(&bar[XB_TMO], 1u); break; } }
    }
    nloc = mine > 0u ? mine : 1u; nx = cnt > 0u ? cnt : 1u;
}

__device__ __forceinline__ void xcd_barrier(const XcdBarrier& b) {
    asm volatile("s_waitcnt vmcnt(0)" ::: "memory");
    __syncthreads();
    if (threadIdx.x == 0) {
        unsigned* bar = b.bar;
        __builtin_amdgcn_s_waitcnt(0);
        unsigned nloc = b.st[0], nx = b.st[1];
        if (nloc == 0u) { xcd_barrier_complete(bar, b.x, nloc, nx); b.st[0] = nloc; b.st[1] = nx; }
        const unsigned old = xb_add(&bar[XB_XSUB(b.x)], 1u);
        const unsigned gen = old / nloc;
        if (old + 1u == (gen + 1u) * nloc) {
            __builtin_amdgcn_fence(__ATOMIC_RELEASE, "agent");
            asm volatile("s_waitcnt vmcnt(0)" ::: "memory");
            const unsigned og = xb_add(&bar[XB_TOP], 1u);
            const unsigned tg = og / nx;
            if (og + 1u == (tg + 1u) * nx) xb_add(&bar[XB_TOPGEN], 1u);
            else XB_SPIN(xb_ld(&bar[XB_TOPGEN]) == tg, bar);
            __builtin_amdgcn_fence(__ATOMIC_ACQUIRE, "agent");
            xb_add(&bar[XB_XGEN(b.x)], 1u);
            asm volatile("s_waitcnt vmcnt(0)" ::: "memory");
        } else {
            XB_SPIN(xb_ld(&bar[XB_XGEN(b.x)]) == gen, bar);
            __builtin_amdgcn_fence(__ATOMIC_ACQUIRE, "agent");
            asm volatile("s_waitcnt vmcnt(0)" ::: "memory");
        }
    }
    __syncthreads();
}

struct Args { const float* in[42]; float* out; unsigned char* ws; unsigned char* wts; int ph_lo, ph_hi; };
struct Frame {
    LAS unsigned char* lds; GAS float* out; GAS unsigned char* ws; GAS unsigned char* W;
    int tid, lane, wave, bid, G;
};
constexpr int PTAB_OFF = MISC_OFF + 512;
__device__ __forceinline__ const GAS float* ldptr(const Frame& F, int i) { const unsigned long long v = ((const LAS unsigned long long*)(F.lds + PTAB_OFF))[i];
    const unsigned lo = __builtin_amdgcn_readfirstlane((unsigned)v), hi = __builtin_amdgcn_readfirstlane((unsigned)(v >> 32)); return (const GAS float*)(((unsigned long long)hi << 32) | lo); }
#define INP(i) ldptr(F, (i))
__device__ __forceinline__ Frame fresh(const Frame& F0) { Frame F = F0; int t; asm volatile("v_mbcnt_lo_u32_b32 %0, -1, 0\n\tv_mbcnt_hi_u32_b32 %0, -1, %0\n\tv_lshl_add_u32 %0, %1, 6, %0" : "=&v"(t) : "s"(F0.wave));     F.tid = t; F.lane = t & 63; F.wave = __builtin_amdgcn_readfirstlane(t >> 6);
    asm volatile("" : "+s"(F.bid), "+s"(F.G), "+s"(F.ws), "+s"(F.W), "+s"(F.out)); return F; }
enum { IN_X = 0, IN_C, IN_CTX, IN_CCTX, IN_ADAW, IN_ADAB, IN_NMIX, IN_NFFN, IN_NOUT, IN_ML_WIN, IN_ML_WGATE, IN_ML_BGATE, IN_ML_CONV, IN_ML_HEADG, IN_ML_WOUT,
       IN_RW_MU, IN_RW_WRKV, IN_RW_W0, IN_RW_W1, IN_RW_W2, IN_RW_A0, IN_RW_A1, IN_RW_A2, IN_RW_G1, IN_RW_G2, IN_RW_KK, IN_RW_KA, IN_RW_RK, IN_RW_LNW, IN_RW_LNB, IN_RW_WOUT,
       IN_HG_WIN, IN_HG_WF, IN_HG_BF, IN_HG_LB, IN_HG_HEADG, IN_HG_WOUT, IN_ROUTER_W, IN_ROUTER_B, IN_EX_W1, IN_EX_W3, IN_EX_W2 };

template <int MAP> __device__ __forceinline__ int rowmap(int n) { return MAP == 0 ? n : (MAP == 1 ? 8 * (n >> 2) + (n & 3) : 8 * (n >> 2) + 4 + (n & 3)); }
template <int MAP> __device__ __forceinline__ void tr_item(const GAS float* W, int ldw, int nblk, GAS bf16* WT, int ldd, int row_off, int k_off, const GAS float* kscale, LAS float* scr, int item, int lane) {
    const int kb = item / nblk, nb = item - kb * nblk, k0 = 64 * kb, n0 = 32 * nb;
#pragma unroll 8
    for (int i = 0; i < 32; ++i) { const int kk = 2 * i + (lane >> 5); float v = W[(size_t)(k0 + kk) * ldw + n0 + (lane & 31)]; if (kscale) v *= kscale[k0 + kk]; scr[kk * 33 + (lane & 31)] = v; }
    LDS_WAIT(); asm volatile("" ::: "memory");
    const int c = lane & 7;
#pragma unroll
    for (int j = 0; j < 4; ++j) { const int n = (lane >> 3) + 8 * j; const LAS float* s = scr + (8 * c) * 33 + n;
        u32x4 o; o.x = pk2(s[0 * 33], s[1 * 33]); o.y = pk2(s[2 * 33], s[3 * 33]); o.z = pk2(s[4 * 33], s[5 * 33]); o.w = pk2(s[6 * 33], s[7 * 33]);
        *(GAS u32x4*)(WT + (size_t)(row_off + rowmap<MAP>(n0 + n)) * ldd + k_off + k0 + 8 * c) = o; }
    LDS_WAIT(); asm volatile("" ::: "memory");
}
#define TRJOB(MAP, cnt, ...) if (r < (cnt)) { tr_item<MAP>(__VA_ARGS__, scr, r, F.lane); continue; } r -= (cnt);

PHASE_FN void pre_phase(Frame F) {
    LAS float* scr = (LAS float*)(F.lds + F.wave * 16384);
    const int gw = F.bid * NWAVES + F.wave, NGW = F.G * NWAVES;
    const size_t gt = (size_t)F.bid * NTHR + F.tid, NGT = (size_t)F.G * NTHR;
    GAS bf16* W = (GAS bf16*)F.W;
    constexpr int NITEMS = 2 * 2048 + 2 * 512 + 6 * 512 + 4 * 32 + 4 * 32 + 2 * 64 + 64 + 512 + 1536 + 2 * 512 + 512;
    for (int it = gw; it < NITEMS; it += NGW) {
        int r = it;
        TRJOB(0, 2048, INP(IN_ML_WIN), 4096, 128, (GAS bf16*)(F.W + W_ML_WIN), 1024, 0, 0, nullptr)
        TRJOB(0, 2048, INP(IN_ML_WIN) + (size_t)1024 * 4096, 4096, 128, (GAS bf16*)(F.W + W_ML_WIN + W_ML_WIN_SZ), 1024, 0, 0, nullptr)
        TRJOB(0, 512, INP(IN_ML_WOUT), 1024, 32, (GAS bf16*)(F.W + W_ML_WOUT), 1024, 0, 0, nullptr)
        TRJOB(0, 512, INP(IN_ML_WOUT) + (size_t)1024 * 1024, 1024, 32, (GAS bf16*)(F.W + W_ML_WOUT + 2 * MiB), 1024, 0, 0, nullptr)
        GAS bf16* RWIN = (GAS bf16*)(F.W + W_RW_IN); const GAS float* mu = INP(IN_RW_MU);
        if (r < 6 * 512) { const int idx = r / 1024, ps = (r / 512) & 1, rr = r & 511;
            tr_item<0>(INP(IN_RW_WRKV) + (size_t)idx * 1024 * 1024, 1024, 32, RWIN, 2048, idx * 1024, ps * 1024, ps ? mu + idx * 1024 : nullptr, scr, rr, F.lane); continue; } r -= 6 * 512;
        if (r < 4 * 32) { const int dir = r / 64, ps = (r / 32) & 1, rr = r & 31;
            tr_item<0>(INP(IN_RW_W1) + (size_t)dir * 1024 * 64, 64, 2, RWIN, 2048, 3072 + dir * 64, ps * 1024, ps ? mu + 3 * 1024 : nullptr, scr, rr, F.lane); continue; } r -= 4 * 32;
        if (r < 4 * 32) { const int dir = r / 64, ps = (r / 32) & 1, rr = r & 31;
            tr_item<0>(INP(IN_RW_A1) + (size_t)dir * 1024 * 64, 64, 2, RWIN, 2048, 3200 + dir * 64, ps * 1024, ps ? mu + 4 * 1024 : nullptr, scr, rr, F.lane); continue; } r -= 4 * 32;
        if (r < 2 * 64) { const int ps = r / 64, rr = r & 63;
            tr_item<0>(INP(IN_RW_G1), 128, 4, RWIN, 2048, 3328, ps * 1024, ps ? mu + 5 * 1024 : nullptr, scr, rr, F.lane); continue; } r -= 2 * 64;
        TRJOB(0, 64, INP(IN_RW_G2), 1024, 32, (GAS bf16*)(F.W + W_RW_G2), 256, 0, 0, nullptr)
        TRJOB(0, 512, INP(IN_RW_WOUT), 1024, 32, (GAS bf16*)(F.W + W_RW_WOUT), 1024, 0, 0, nullptr)
        TRJOB(0, 1536, INP(IN_HG_WIN), 3072, 96, (GAS bf16*)(F.W + W_HG_IN), 1024, 0, 0, nullptr)
        TRJOB(0, 512, INP(IN_HG_WF), 1024, 32, (GAS bf16*)(F.W + W_HG_IN), 1024, 3072, 0, nullptr)
        TRJOB(0, 512, INP(IN_HG_WF) + (size_t)1024 * 1024, 1024, 32, (GAS bf16*)(F.W + W_HG_IN), 1024, 4096, 0, nullptr)
        TRJOB(0, 512, INP(IN_HG_WOUT), 1024, 32, (GAS bf16*)(F.W + W_HG_WOUT), 1024, 0, 0, nullptr)
    }
    for (size_t i = gt; i < (size_t)2 * 256 * 1024; i += NGT) { const int j = (int)(i >> 18), rr = (int)((i >> 10) & 255), k = (int)(i & 1023);
        float v = 0.f; if (rr < 32) { const int dir = rr >> 4, g = rr & 15; v = INP(IN_ML_WGATE)[((size_t)(j * 2 + dir) * 1024 + k) * 16 + g]; }
        ((GAS bf16*)(F.W + W_ML_WIN + j * W_ML_WIN_SZ))[(size_t)(4096 + rr) * 1024 + k] = (bf16)f2bf(v); }
    for (size_t i = gt; i < (size_t)128 * 2048; i += NGT) ((GAS bf16*)(F.W + W_RW_IN))[(size_t)3456 * 2048 + i] = 0;
    for (size_t i = gt; i < (size_t)1024 * 128; i += NGT) ((GAS bf16*)(F.W + W_RW_G2))[(i >> 7) * 256 + 128 + (i & 127)] = 0;
    if (F.bid == 0) for (int c = F.tid; c < 1024; c += NTHR) { const GAS float* lg = INP(IN_HG_LB) + c; const float l0 = lg[0], l1 = lg[1024], l2 = lg[2048], l3 = lg[3072];
        const float mx = fmaxf(fmaxf(l0, l1), fmaxf(l2, l3)); const float e0 = __expf(l0 - mx), e1 = __expf(l1 - mx), e2 = __expf(l2 - mx), e3 = __expf(l3 - mx);
        ((GAS float*)(F.ws + WS_LB))[c] = (e1 + e2) / (e0 + e1 + e2 + e3); }
    { GAS f32x4* S4 = (GAS f32x4*)(F.ws + WS_S);
      for (size_t i = gt; i < (size_t)NTOK * 256; i += NGT) { const int m = (int)(i >> 8), c4 = (int)(i & 255); const int b = m / T, t = m - b * T;
          const GAS float* src = (t < CTX) ? INP(IN_CTX) + ((size_t)(b * CTX + t)) * 1024 : INP(IN_X) + ((size_t)(b * SEQ + t - CTX)) * 1024;
          S4[i] = ((const GAS f32x4*)src)[c4]; } }
    { LAS float* sc = (LAS float*)(F.lds + 8448); GAS float* MODP = (GAS float*)(F.ws + WS_MIX);
      for (int it = F.bid; it < 768; it += F.G) { const int i = it / 192, rem = it - i * 192, kc = rem / 12, jb = rem - kc * 12;
          __syncthreads();
          if (F.tid < 320) { const int seg = F.tid >> 6, kk = F.tid & 63; const float cv = seg == 0 ? INP(IN_CCTX)[kc * 64 + kk] : INP(IN_C)[(seg - 1) * 1024 + kc * 64 + kk]; sc[F.tid] = silu_f(cv); }
          __syncthreads();
          const int j = jb * 512 + F.tid; const GAS float* wp = INP(IN_ADAW) + ((size_t)i * 1024 + kc * 64) * 6144 + j;
          float a0 = 0.f, a1 = 0.f, a2 = 0.f, a3 = 0.f, a4 = 0.f;
#pragma unroll 8
          for (int kk = 0; kk < 64; ++kk) { const float w = wp[(size_t)kk * 6144]; a0 += sc[kk] * w; a1 += sc[64 + kk] * w; a2 += sc[128 + kk] * w; a3 += sc[192 + kk] * w; a4 += sc[256 + kk] * w; }
          GAS float* mp = MODP + ((size_t)kc * 4 + i) * 5 * 6144 + j;
          mp[0] = a0; mp[6144] = a1; mp[2 * 6144] = a2; mp[3 * 6144] = a3; mp[4 * 6144] = a4; } }
}
PHASE_FN void modsum_phase(Frame F) {
    const GAS float* MODP = (const GAS float*)(F.ws + WS_MIX); GAS float* MOD = (GAS float*)(F.ws + WS_MOD);
    for (int idx = F.bid * NTHR + F.tid; idx < 4 * 5 * 6144; idx += F.G * NTHR) { const int i = idx / (5 * 6144), j = idx % 6144;
        float a = INP(IN_ADAB)[i * 6144 + j];
#pragma unroll
        for (int kc = 0; kc < 16; ++kc) a += MODP[(size_t)kc * 4 * 5 * 6144 + idx];
        MOD[idx] = a; }
}
struct ExwItem { const GAS float* src; GAS bf16* dst; int ldw, ldd, map; };
__device__ __forceinline__ ExwItem exw_item(const Frame& F, const GAS float* w1, const GAS float* w3, const GAS float* w2, int it) {
    const int which = it >> 12, e = (it >> 8) & 15, rr = it & 255; ExwItem x;
    if (which < 2) { const int kb = rr >> 4, nb = rr & 15; x.src = (which ? w3 : w1) + (size_t)e * 1024 * 512 + (size_t)(64 * kb) * 512 + 32 * nb; x.ldw = 512; x.ldd = 1024; x.map = which + 1;
        x.dst = (GAS bf16*)(F.W + W_EX13) + (size_t)(e * 1024 + 2 * (32 * nb)) * 1024 + 64 * kb; }
    else { const int kb = rr >> 5, nb = rr & 31; x.src = w2 + (size_t)e * 512 * 1024 + (size_t)(64 * kb) * 1024 + 32 * nb; x.ldw = 1024; x.ldd = 512; x.map = 0;
        x.dst = (GAS bf16*)(F.W + W_EX2) + (size_t)(e * 1024 + 32 * nb) * 512 + 64 * kb; }
    return x; }
PHASE_FN void expert_weights(Frame F, int L) {
    LAS float* scr = (LAS float*)(F.lds + F.wave * 16384);
    const int gw = F.bid * NWAVES + F.wave, NGW = F.G * NWAVES, lane = F.lane;
    const GAS float* w1 = INP(IN_EX_W1) + (size_t)L * 16 * 1024 * 512; const GAS float* w3 = INP(IN_EX_W3) + (size_t)L * 16 * 1024 * 512; const GAS float* w2 = INP(IN_EX_W2) + (size_t)L * 16 * 512 * 1024;
    const int lk = lane >> 3, ln = (lane & 7) * 4;
    f32x4 v[8]; int it = gw;
    if (it < 3 * 4096) { const ExwItem x = exw_item(F, w1, w3, w2, it);
#pragma unroll
        for (int i = 0; i < 8; ++i) v[i] = *(const GAS f32x4*)(x.src + (size_t)(lk + 8 * i) * x.ldw + ln); }
    for (; it < 3 * 4096; it += NGW) {
        const ExwItem x = exw_item(F, w1, w3, w2, it);
#pragma unroll
        for (int i = 0; i < 8; ++i) { LAS float* d = scr + (lk + 8 * i) * 33 + ln; d[0] = v[i][0]; d[1] = v[i][1]; d[2] = v[i][2]; d[3] = v[i][3]; }
        if (it + NGW < 3 * 4096) { const ExwItem y = exw_item(F, w1, w3, w2, it + NGW);
#pragma unroll
            for (int i = 0; i < 8; ++i) v[i] = *(const GAS f32x4*)(y.src + (size_t)(lk + 8 * i) * y.ldw + ln); }
        LDS_WAIT(); asm volatile("" ::: "memory");
        const int c = lane & 7;
#pragma unroll
        for (int j = 0; j < 4; ++j) { const int n = (lane >> 3) + 8 * j; const LAS float* s_ = scr + (8 * c) * 33 + n;
            u32x4 o; o.x = pk2(s_[0 * 33], s_[1 * 33]); o.y = pk2(s_[2 * 33], s_[3 * 33]); o.z = pk2(s_[4 * 33], s_[5 * 33]); o.w = pk2(s_[6 * 33], s_[7 * 33]);
            const int drow = x.map == 0 ? n : 2 * (n & ~3) + (n & 3) + (x.map == 2 ? 4 : 0);
            *(GAS u32x4*)(x.dst + (size_t)drow * x.ldd + 8 * c) = o; }
        LDS_WAIT(); asm volatile("" ::: "memory");
    }
}

template <int MODE, int PRB = 0> PHASE_FN void norm_phase(Frame F, int L, bool add_moe, int ldh) {
    GAS float* S = (GAS float*)(F.ws + WS_S); GAS bf16* H = (GAS bf16*)(F.ws + WS_HY); const GAS bf16* YM = (const GAS bf16*)(F.ws + WS_MIX + 210 * MiB);
    const GAS float* MOD = (const GAS float*)(F.ws + WS_MOD);
    const int gw = F.bid * NWAVES + F.wave, NGW = F.G * NWAVES, lane = F.lane;
    LAS float* rwl = (LAS float*)F.lds;
    LAS int* cntl = (LAS int*)(F.lds + 65536);
    if (MODE == 1) {
        for (int i = F.tid; i < 16384; i += NTHR) { const int c = i >> 4, e = i & 15; rwl[e * 1024 + c] = INP(IN_ROUTER_W)[i]; }
        if (F.tid < 16) cntl[F.tid] = 0;
        __syncthreads();
    }
    const GAS float* gnp = MODE == 0 ? INP(IN_NMIX) + L * 1024 : (MODE == 1 ? INP(IN_NFFN) + L * 1024 : INP(IN_NOUT));
    for (int m = gw; m < NTOK; m += NGW) {
        const int b = m / T, t = m - b * T, seg = t < CTX ? 0 : 1 + b;
        if (MODE == 2 && t < CTX) continue;
        f32x4 v[4]; GAS f32x4* sp = (GAS f32x4*)(S + (size_t)m * 1024) + lane;
#pragma unroll
        for (int j = 0; j < 4; ++j) v[j] = sp[64 * j];
        if (add_moe) {
            const GAS float* gp = MOD + ((size_t)((MODE == 2 ? 3 : L - 1) * 5 + seg)) * 6144 + 5 * 1024;
            const GAS u32x2* ya = (const GAS u32x2*)(YM + (size_t)(2 * m) * 1024) + lane; const GAS u32x2* yb = ya + 256;
#pragma unroll
            for (int j = 0; j < 4; ++j) { const u32x2 a = ya[64 * j], bq = yb[64 * j]; const f32x4 g = ((const GAS f32x4*)gp)[lane + 64 * j];
                v[j][0] += g[0] * (bflo(a.x) + bflo(bq.x)); v[j][1] += g[1] * (bfhi(a.x) + bfhi(bq.x)); v[j][2] += g[2] * (bflo(a.y) + bflo(bq.y)); v[j][3] += g[3] * (bfhi(a.y) + bfhi(bq.y)); }
            if (MODE != 2 && !PRB) {
#pragma unroll
                for (int j = 0; j < 4; ++j) sp[64 * j] = v[j]; }
        }
        float ss = 0.f;
#pragma unroll
        for (int j = 0; j < 4; ++j) ss += (v[j][0] * v[j][0] + v[j][1] * v[j][1]) + (v[j][2] * v[j][2] + v[j][3] * v[j][3]);
        const float rinv = 1.0f / sqrtf(wave_sum(ss) * (1.0f / 1024.0f) + 1e-6f);
        if (MODE == 2) { GAS f32x4* op = (GAS f32x4*)(F.out + ((size_t)(b * SEQ + t - CTX)) * 1024) + lane;
#pragma unroll
            for (int j = 0; j < 4; ++j) { const f32x4 g = ((const GAS f32x4*)gnp)[lane + 64 * j]; op[64 * j] = v[j] * rinv * g; }
            continue; }
        const GAS float* mp = MOD + ((size_t)(L * 5 + seg)) * 6144 + (MODE == 0 ? 0 : 3 * 1024);
        f32x4 h[4];
#pragma unroll
        for (int j = 0; j < 4; ++j) { const f32x4 g = ((const GAS f32x4*)gnp)[lane + 64 * j], sh = ((const GAS f32x4*)mp)[lane + 64 * j], sc = ((const GAS f32x4*)(mp + 1024))[lane + 64 * j];
            h[j] = v[j] * rinv * g * (sc + 1.0f) + sh;
            u32x2 o; o.x = pk2(h[j][0], h[j][1]); o.y = pk2(h[j][2], h[j][3]); *((GAS u32x2*)(H + (size_t)m * ldh) + lane + 64 * j) = o; }
        if (MODE == 1) {
            float lg[16];
#pragma unroll
            for (int e = 0; e < 16; ++e) { float a = 0.f;
#pragma unroll
                for (int j = 0; j < 4; ++j) { const f32x4 w = *(const LAS f32x4*)(rwl + e * 1024 + 256 * j + 4 * lane); a += (h[j][0] * w[0] + h[j][1] * w[1]) + (h[j][2] * w[2] + h[j][3] * w[3]); }
                lg[e] = wave_sum(a); }
            float aff[16], sel[16];
#pragma unroll
            for (int e = 0; e < 16; ++e) { aff[e] = sigmoid_f(lg[e]); sel[e] = aff[e] + INP(IN_ROUTER_B)[e]; }
            float best = -3.0e38f; int bg = 0; float s0 = 0.f, s1 = 0.f, s2 = 0.f, s3 = 0.f, a0 = 0.f, a1 = 0.f, a2 = 0.f, a3 = 0.f;
#pragma unroll
            for (int g = 0; g < 4; ++g) { const float x0 = sel[4 * g], x1 = sel[4 * g + 1], x2 = sel[4 * g + 2], x3 = sel[4 * g + 3];
                const float t1 = fmaxf(x0, x1), t2 = fminf(x0, x1), u1 = fmaxf(x2, x3), u2 = fminf(x2, x3);
                const float sum = fmaxf(t1, u1) + fmaxf(fminf(t1, u1), fmaxf(t2, u2));
                const bool bt = sum > best; best = bt ? sum : best; bg = bt ? g : bg;
                s0 = bt ? x0 : s0; s1 = bt ? x1 : s1; s2 = bt ? x2 : s2; s3 = bt ? x3 : s3;
                a0 = bt ? aff[4 * g] : a0; a1 = bt ? aff[4 * g + 1] : a1; a2 = bt ? aff[4 * g + 2] : a2; a3 = bt ? aff[4 * g + 3] : a3; }
            int i1 = 0; float m1 = s0; if (s1 > m1) { m1 = s1; i1 = 1; } if (s2 > m1) { m1 = s2; i1 = 2; } if (s3 > m1) { m1 = s3; i1 = 3; }
            int i2 = -1; float m2 = -3.0e38f;
            if (i1 != 0 && s0 > m2) { m2 = s0; i2 = 0; } if (i1 != 1 && s1 > m2) { m2 = s1; i2 = 1; } if (i1 != 2 && s2 > m2) { m2 = s2; i2 = 2; } if (i1 != 3 && s3 > m2) { m2 = s3; i2 = 3; }
            const float c1 = i1 == 0 ? a0 : (i1 == 1 ? a1 : (i1 == 2 ? a2 : a3)), c2 = i2 == 0 ? a0 : (i2 == 1 ? a1 : (i2 == 2 ? a2 : a3));
            const float inv = 1.0f / (c1 + c2);
            if (lane == 0) { const int e1 = bg * 4 + i1, e2 = bg * 4 + i2;
                u32x4 tk; tk.x = (unsigned)e1; tk.y = (unsigned)e2; tk.z = __float_as_uint(c1 * inv); tk.w = __float_as_uint(c2 * inv); ((GAS u32x4*)(F.ws + WS_TOK))[m] = tk;
                __hip_atomic_fetch_add(cntl + e1, 1, __ATOMIC_RELAXED, __HIP_MEMORY_SCOPE_WORKGROUP); __hip_atomic_fetch_add(cntl + e2, 1, __ATOMIC_RELAXED, __HIP_MEMORY_SCOPE_WORKGROUP); }
        }
    }
    if (MODE == 1) { __syncthreads(); if (F.tid < 16) __hip_atomic_fetch_add((GAS unsigned*)F.ws + CW_MOE + L * 2048 + (PRB ? 512 : 0) + 64 * F.tid, (unsigned)cntl[F.tid], __ATOMIC_RELAXED, __HIP_MEMORY_SCOPE_AGENT); }
}

__device__ __forceinline__ void moe_prefix(const Frame& F, int L, LAS int* pref  , LAS int* cnt  ) {
    if (F.tid < 16) cnt[F.tid] = (int)__hip_atomic_load((GAS unsigned*)F.ws + CW_MOE + L * 2048 + 64 * F.tid, __ATOMIC_RELAXED, __HIP_MEMORY_SCOPE_AGENT);
    __syncthreads();
    if (F.tid == 0) { int p = 0; for (int e = 0; e < 16; ++e) { pref[e] = p; p += (cnt[e] + 255) >> 8; } pref[16] = p; }
    __syncthreads();
}
template <int PRB = 0> PHASE_FN void slots_phase(Frame F, int L) {
    LAS int* pref = (LAS int*)F.lds; LAS int* cnt = pref + 32;
    moe_prefix(F, L, pref, cnt);
    const int gw = F.bid * NWAVES + F.wave, NGW = F.G * NWAVES, lane = F.lane;
    GAS unsigned* cursor = (GAS unsigned*)F.ws + CW_MOE + L * 2048 + 1024 + (PRB ? 32 : 0);
    GAS int* slot_tok = (GAS int*)(F.ws + WS_SLOT_TOK); GAS float* slot_gate = (GAS float*)(F.ws + WS_SLOT_GATE);
    for (int it = gw; it < NTOK / 64; it += NGW) {
        const int m = it * 64 + lane; const u32x4 tk = ((const GAS u32x4*)(F.ws + WS_TOK))[m];
#pragma unroll
        for (int k = 0; k < 2; ++k) { const int e = (int)(k ? tk.y : tk.x); int slot = 0;
            for (int ee = 0; ee < 16; ++ee) { const unsigned long long mask = __ballot(e == ee);
                if (mask) { const int n = __popcll(mask); unsigned base = 0; if (lane == 0) base = __hip_atomic_fetch_add(cursor + 64 * ee, (unsigned)n, __ATOMIC_RELAXED, __HIP_MEMORY_SCOPE_AGENT); base = __builtin_amdgcn_readfirstlane(base);
                    if (e == ee) slot = pref[ee] * 256 + (int)base + __popcll(mask & ((1ull << lane) - 1ull)); } }
            slot_tok[slot] = 2 * m + k; slot_gate[slot] = __uint_as_float(k ? tk.w : tk.z); }
    }
    for (int e = 0; e < 16; ++e) { const int lo = pref[e] * 256 + cnt[e], hi = pref[e + 1] * 256;
        for (int s_ = lo + gw * 64 + lane; s_ < hi; s_ += NGW * 64) { slot_tok[s_] = -1; slot_gate[s_] = 0.f; } }
}

PHASE_FN void du_phase(Frame F) {
    GAS bf16* H2 = (GAS bf16*)(F.ws + WS_HY);
    const size_t gt = (size_t)F.bid * NTHR + F.tid, NGT = (size_t)F.G * NTHR;
    for (size_t i = gt; i < (size_t)NTOK * 128; i += NGT) { const int m = (int)(i >> 7), c8 = (int)(i & 127); const int t = m % T;
        const bool hp = !(t == 0 || t == CTX), hn = !(t == CTX - 1 || t == T - 1);
        const u32x4 z = {0u, 0u, 0u, 0u};
        const u32x4 u = *(const GAS u32x4*)(H2 + (size_t)m * 2048 + c8 * 8), p = hp ? *(const GAS u32x4*)(H2 + (size_t)(m - 1) * 2048 + c8 * 8) : z, n = hn ? *(const GAS u32x4*)(H2 + (size_t)(m + 1) * 2048 + c8 * 8) : z;
        u32x4 o;
#pragma unroll
        for (int j = 0; j < 4; ++j) o[j] = pk2(0.5f * (bflo(p[j]) + bflo(n[j])) - bflo(u[j]), 0.5f * (bfhi(p[j]) + bfhi(n[j])) - bfhi(u[j]));
        *(GAS u32x4*)(H2 + (size_t)m * 2048 + 1024 + c8 * 8) = o; }
}

PHASE_FN void conv_phase(Frame F, int j) {
    const GAS bf16* QP = (const GAS bf16*)(F.ws + WS_MIX); GAS bf16* QK = (GAS bf16*)(F.ws + WS_HY); const GAS float* cw = INP(IN_ML_CONV) + (size_t)j * 9 * 2048;
    const size_t gt = (size_t)F.bid * NTHR + F.tid, NGT = (size_t)F.G * NTHR;
    for (size_t i = gt; i < (size_t)NTOK * 256; i += NGT) { const int m = (int)(i >> 8), c = (int)(i & 255) * 8; const int t = m % T;
        float acc[8];
#pragma unroll
        for (int q = 0; q < 8; ++q) acc[q] = 0.f;
        const int p = t - CTX, gr = p >> 6, gc = p & 63;
#pragma unroll
        for (int dr = 0; dr < 3; ++dr)
#pragma unroll
            for (int dw = 0; dw < 3; ++dw) {
                bool ok; int mm;
                if (t < CTX) { ok = (dr == 1) && (t + dw - 1 >= 0) && (t + dw - 1 < CTX); mm = m + dw - 1; }
                else { ok = (gr + dr - 1 >= 0) && (gr + dr - 1 < 128) && (gc + dw - 1 >= 0) && (gc + dw - 1 < 64); mm = m + (dr - 1) * 64 + (dw - 1); }
                if (ok) { const u32x4 x = *(const GAS u32x4*)(QP + (size_t)mm * 2048 + c); const f32x4 w0 = *(const GAS f32x4*)(cw + (dr * 3 + dw) * 2048 + c), w1 = *(const GAS f32x4*)(cw + (dr * 3 + dw) * 2048 + c + 4);
                    acc[0] += bflo(x[0]) * w0[0]; acc[1] += bfhi(x[0]) * w0[1]; acc[2] += bflo(x[1]) * w0[2]; acc[3] += bfhi(x[1]) * w0[3];
                    acc[4] += bflo(x[2]) * w1[0]; acc[5] += bfhi(x[2]) * w1[1]; acc[6] += bflo(x[3]) * w1[2]; acc[7] += bfhi(x[3]) * w1[3]; } }
        const float sc = c >= 1024 ? 0.08838834764831845f : 1.0f;
        u32x4 o;
#pragma unroll
        for (int q = 0; q < 4; ++q) o[q] = pk2(silu_f(acc[2 * q]) * sc, silu_f(acc[2 * q + 1]) * sc);
        *(GAS u32x4*)(QK + (size_t)m * 2048 + c) = o; }
}

PHASE_FN void headnorm_phase(Frame F, const GAS bf16* HSf, const GAS bf16* HSb, const GAS bf16* OG, const GAS float* hg, GAS bf16* Y) {
    const int gw = F.bid * NWAVES + F.wave, NGW = F.G * NWAVES, lane = F.lane;
    for (int m = gw; m < NTOK; m += NGW) { const size_t off = (size_t)m * 1024 + lane * 16;
        float x[16]; float ss = 0.f;
#pragma unroll
        for (int hlf = 0; hlf < 2; ++hlf) { const u32x4 a = *(const GAS u32x4*)(HSf + off + 8 * hlf), bq = *(const GAS u32x4*)(HSb + off + 8 * hlf);
#pragma unroll
            for (int q = 0; q < 4; ++q) { x[8 * hlf + 2 * q] = bflo(a[q]) + bflo(bq[q]); x[8 * hlf + 2 * q + 1] = bfhi(a[q]) + bfhi(bq[q]); } }
#pragma unroll
        for (int q = 0; q < 16; ++q) ss += x[q] * x[q];
        ss += __shfl_xor(ss, 1); ss += __shfl_xor(ss, 2); ss += __shfl_xor(ss, 4);
        const float rinv = 1.0f / sqrtf(ss * (1.0f / 128.0f) + 1e-6f);
#pragma unroll
        for (int hlf = 0; hlf < 2; ++hlf) { const u32x4 g = *(const GAS u32x4*)(OG + off + 8 * hlf); const f32x4 h0 = *(const GAS f32x4*)(hg + lane * 16 + 8 * hlf), h1 = *(const GAS f32x4*)(hg + lane * 16 + 8 * hlf + 4);
            u32x4 o;
            o[0] = pk2(x[8 * hlf + 0] * rinv * h0[0] * bflo(g[0]), x[8 * hlf + 1] * rinv * h0[1] * bfhi(g[0])); o[1] = pk2(x[8 * hlf + 2] * rinv * h0[2] * bflo(g[1]), x[8 * hlf + 3] * rinv * h0[3] * bfhi(g[1]));
            o[2] = pk2(x[8 * hlf + 4] * rinv * h1[0] * bflo(g[2]), x[8 * hlf + 5] * rinv * h1[1] * bfhi(g[2])); o[3] = pk2(x[8 * hlf + 6] * rinv * h1[2] * bflo(g[3]), x[8 * hlf + 7] * rinv * h1[3] * bfhi(g[3]));
            *(GAS u32x4*)(Y + off + 8 * hlf) = o; } }
}
PHASE_FN void rwpost_phase(Frame F, const GAS bf16* Of, const GAS bf16* Ob, const GAS float* BETA, const GAS bf16* V, const GAS bf16* Gt, GAS bf16* Y) {
    const int gw = F.bid * NWAVES + F.wave, NGW = F.G * NWAVES, lane = F.lane;
    const GAS float* lnw = INP(IN_RW_LNW); const GAS float* lnb = INP(IN_RW_LNB);
    for (int m = gw; m < NTOK; m += NGW) { const size_t off = (size_t)m * 1024 + lane * 16;
        float x[16]; float s = 0.f;
#pragma unroll
        for (int hlf = 0; hlf < 2; ++hlf) { const u32x4 a = *(const GAS u32x4*)(Of + off + 8 * hlf), bq = *(const GAS u32x4*)(Ob + off + 8 * hlf);
#pragma unroll
            for (int q = 0; q < 4; ++q) { x[8 * hlf + 2 * q] = bflo(a[q]) + bflo(bq[q]); x[8 * hlf + 2 * q + 1] = bfhi(a[q]) + bfhi(bq[q]); } }
#pragma unroll
        for (int q = 0; q < 16; ++q) s += x[q];
        s += __shfl_xor(s, 1); s += __shfl_xor(s, 2);
        const float mean = s * (1.0f / 64.0f); float vs = 0.f;
#pragma unroll
        for (int q = 0; q < 16; ++q) { x[q] -= mean; vs += x[q] * x[q]; }
        vs += __shfl_xor(vs, 1); vs += __shfl_xor(vs, 2);
        const float rinv = 1.0f / sqrtf(vs * (1.0f / 64.0f) + 64e-5f);
        const int hd = lane >> 2; const float beta = BETA[(size_t)m * 16 + hd] + BETA[((size_t)NTOK + m) * 16 + hd];
#pragma unroll
        for (int hlf = 0; hlf < 2; ++hlf) { const u32x4 vv = *(const GAS u32x4*)(V + off + 8 * hlf), gg = *(const GAS u32x4*)(Gt + off + 8 * hlf);
            const f32x4 w0 = *(const GAS f32x4*)(lnw + lane * 16 + 8 * hlf), w1 = *(const GAS f32x4*)(lnw + lane * 16 + 8 * hlf + 4), b0 = *(const GAS f32x4*)(lnb + lane * 16 + 8 * hlf), b1 = *(const GAS f32x4*)(lnb + lane * 16 + 8 * hlf + 4);
            float y[8];
#pragma unroll
            for (int q = 0; q < 4; ++q) { y[q] = x[8 * hlf + q] * rinv * w0[q] + b0[q]; y[4 + q] = x[8 * hlf + 4 + q] * rinv * w1[q] + b1[q]; }
            u32x4 o;
#pragma unroll
            for (int q = 0; q < 4; ++q) o[q] = pk2((y[2 * q] + beta * bflo(vv[q])) * bflo(gg[q]), (y[2 * q + 1] + beta * bfhi(vv[q])) * bfhi(gg[q]));
            *(GAS u32x4*)(Y + off + 8 * hlf) = o; } }
}

__device__ __forceinline__ void group_barrier(LAS unsigned* ctr, unsigned target, int lane) {
    LDS_WAIT();
    if (lane == 0) __hip_atomic_fetch_add(ctr, 1u, __ATOMIC_RELAXED, __HIP_MEMORY_SCOPE_WORKGROUP);
    while ((unsigned)__builtin_amdgcn_readfirstlane((int)__hip_atomic_load(ctr, __ATOMIC_RELAXED, __HIP_MEMORY_SCOPE_WORKGROUP)) < target) __builtin_amdgcn_s_sleep(1);
    asm volatile("" ::: "memory");
}
template <int PROBE> PHASE_FN void ml_scan_phase(Frame F, const GAS bf16* QK, const GAS bf16* V, const GAS float* GATES, GAS bf16* HS) {
    constexpr int OFF_Q = 0, OFF_K = 17408, OFF_V = 34816, OFF_VW = 39936, OFF_WKR = 45056, INB = 47360;
    constexpr int O_SS = 2 * INB, O_CS = O_SS + 2 * 9216, O_HO = O_CS + 2 * 13056, O_SC = O_HO + 2 * 5120, O_DEN = O_SC + 3 * 1344, O_CTR = O_DEN + 2 * 1024;
    LAS float* SCb = (LAS float*)(F.lds + O_SC);
    LAS unsigned* actr = (LAS unsigned*)(F.lds + O_CTR);
    const int tid = F.tid, lane = F.lane, w = F.wave, r = lane & 15, q = lane >> 4;
    constexpr int NCH = T / 64;
    for (int unit = F.bid; unit < 256; unit += F.G) {
        const int vs = unit & 3, dir = (unit >> 2) & 1, h = (unit >> 3) & 7, b = unit >> 6;
        __syncthreads();
        for (int i = tid; i < (O_CTR + 16) / 4; i += NTHR) ((LAS unsigned*)F.lds)[i] = 0u;
        __syncthreads();
        if (w >= 4) {
            const int a = w - 4, ptid = tid - 256, lrow = ptid >> 2, lp = ptid & 3; unsigned abar = 0;
            float m_run = 0.f; u32x4 rq[4], rk[4], rv; float rig = 0.f, rlf = 0.f;
#define ML_LOAD(cc) do { const int row_ = seq_row(b, dir, (cc) * 64 + lrow); const GAS bf16* qp_ = QK + (size_t)row_ * 2048 + h * 128; \
                _Pragma("unroll") for (int j_ = 0; j_ < 4; ++j_) { rq[j_] = *(const GAS u32x4*)(qp_ + 8 * (lp + 4 * j_)); rk[j_] = *(const GAS u32x4*)(qp_ + 1024 + 8 * (lp + 4 * j_)); } \
                rv = *(const GAS u32x4*)(V + (size_t)row_ * 1024 + h * 128 + vs * 32 + 8 * lp); } while (0)
#define ML_GLOAD(cc) do { const int grow_ = seq_row(b, dir, (cc) * 64 + lane); rig = GATES[(size_t)grow_ * 32 + dir * 16 + h]; rlf = GATES[(size_t)grow_ * 32 + dir * 16 + 8 + h]; } while (0)
#define ML_SCALARS(cc) do { const float lf_ = logsigmoid_f(rlf); const float bc_ = wave_scan_add(lf_); const float u_ = rig - bc_; const float pm_ = wave_scan_max(u_); \
                const float cc_ = fmaxf(m_run, pm_), blast_ = lane63(bc_), pmall_ = lane63(pm_), mnew_ = blast_ + fmaxf(m_run, pmall_); LAS float* sc_ = SCb + ((cc) % 3) * 336; \
                sc_[lane] = u_; sc_[64 + lane] = cc_; sc_[128 + lane] = __expf(m_run - cc_); sc_[192 + lane] = __expf(-(bc_ + cc_)); sc_[256 + lane] = __expf(blast_ + u_ - mnew_); \
                if (lane == 0) sc_[320] = __expf(blast_ + m_run - mnew_); m_run = mnew_; } while (0)
#define ML_STAGE(cc) do { LAS unsigned char* ib_ = F.lds + ((cc) & 1) * INB; const LAS float* sc_ = SCb + ((cc) % 3) * 336; \
                _Pragma("unroll") for (int j_ = 0; j_ < 4; ++j_) { *(LAS u32x4*)((LAS bf16*)(ib_ + OFF_Q) + lrow * 136 + 8 * (lp + 4 * j_)) = rq[j_]; *(LAS u32x4*)((LAS bf16*)(ib_ + OFF_K) + lrow * 136 + 8 * (lp + 4 * j_)) = rk[j_]; } \
                const float wk_ = sc_[256 + lrow]; u32x4 vw_; _Pragma("unroll") for (int j_ = 0; j_ < 4; ++j_) vw_[j_] = pk2(bflo(rv[j_]) * wk_, bfhi(rv[j_]) * wk_); \
                *(LAS u32x4*)((LAS bf16*)(ib_ + OFF_V) + lrow * 40 + 8 * lp) = rv; *(LAS u32x4*)((LAS bf16*)(ib_ + OFF_VW) + lrow * 40 + 8 * lp) = vw_; \
                if (ptid < 64) ((LAS bf16*)(ib_ + OFF_WKR))[ptid] = (bf16)f2bf(sc_[256 + ptid]); } while (0)
#define ML_STILE(cc, ti_, sj_) do { const LAS unsigned char* ib_ = F.lds + ((cc) & 1) * INB; const LAS float* sc_ = SCb + ((cc) % 3) * 336; LAS bf16* ss_ = (LAS bf16*)(F.lds + O_SS + ((cc) & 1) * 9216); LAS float* dn_ = (LAS float*)(F.lds + O_DEN + ((cc) & 1) * 1024); \
                f32x4 acc_ = {0.f, 0.f, 0.f, 0.f}; acc_ = mm16<128>(acc_, (const LAS bf16*)(ib_ + OFF_Q) + 16 * (ti_) * 136, 136, (const LAS bf16*)(ib_ + OFF_K) + 16 * (sj_) * 136, 136, lane); \
                const int s_ = 16 * (sj_) + r; const float us_ = sc_[s_]; \
                _Pragma("unroll") for (int i_ = 0; i_ < 4; ++i_) { const int t_ = 16 * (ti_) + 4 * q + i_; const float val_ = (s_ <= t_) ? acc_[i_] * __expf(us_ - sc_[64 + t_]) : 0.f; \
                    const float rs_ = row16_sum(val_); if (r == 0) dn_[(sj_) * 64 + t_] = rs_; ss_[t_ * 72 + s_] = (bf16)f2bf(val_); } } while (0)
#define ML_STILES(cc) do { if (a == 0) { ML_STILE(cc, 3, 0); ML_STILE(cc, 3, 1); ML_STILE(cc, 0, 0); } else if (a == 1) { ML_STILE(cc, 3, 2); ML_STILE(cc, 3, 3); ML_STILE(cc, 1, 0); } \
                else if (a == 2) { ML_STILE(cc, 2, 0); ML_STILE(cc, 2, 1); } else { ML_STILE(cc, 2, 2); ML_STILE(cc, 1, 1); } } while (0)
#define ML_HSTORE(cc) do { const int row_ = seq_row(b, dir, (cc) * 64 + lrow); *(GAS u32x4*)(HS + ((size_t)dir * NTOK + row_) * 1024 + h * 128 + vs * 32 + 8 * lp) = *(const LAS u32x4*)((const LAS bf16*)(F.lds + O_HO + ((cc) & 1) * 5120) + lrow * 40 + 8 * lp); } while (0)
            ML_LOAD(0);
            if (a == 3) { ML_GLOAD(0); ML_SCALARS(0); ML_GLOAD(1); ML_SCALARS(1); ML_GLOAD(2); }
            group_barrier(actr, 4 * (++abar), lane);
            ML_STAGE(0); ML_LOAD(1);
            group_barrier(actr, 4 * (++abar), lane);
            ML_STILES(0);
            __syncthreads();
            for (int c = 0; c < NCH; ++c) {
                if (c + 1 < NCH && !(PROBE & 2)) {
                    ML_STAGE(c + 1);
                    if (c >= 1) ML_HSTORE(c - 1);
                    if (c + 2 < NCH) ML_LOAD(c + 2);
                    group_barrier(actr, 4 * (++abar), lane);
                    ML_STILES(c + 1);
                    if (a == 3 && c + 2 < NCH) { ML_SCALARS(c + 2); if (c + 3 < NCH) ML_GLOAD(c + 3); }
                } else if (c >= 1) ML_HSTORE(c - 1);
                __syncthreads();
            }
            ML_HSTORE(NCH - 1);
#undef ML_LOAD
#undef ML_GLOAD
#undef ML_SCALARS
#undef ML_STAGE
#undef ML_STILE
#undef ML_STILES
#undef ML_HSTORE
        } else {
            f32x4 Cst[2][2], Nst[2];
#pragma unroll
            for (int i = 0; i < 2; ++i) { Nst[i] = (f32x4){0.f, 0.f, 0.f, 0.f}; Cst[i][0] = Nst[i]; Cst[i][1] = Nst[i]; }
            __syncthreads();
            for (int c = 0; c < NCH; ++c) {
                if (!(PROBE & 1)) {
                const LAS unsigned char* ib = F.lds + (c & 1) * INB;
                const LAS bf16* QS = (const LAS bf16*)(ib + OFF_Q); const LAS bf16* KS = (const LAS bf16*)(ib + OFF_K); const LAS bf16* VS = (const LAS bf16*)(ib + OFF_V); const LAS bf16* VW = (const LAS bf16*)(ib + OFF_VW); const LAS bf16* WKR = (const LAS bf16*)(ib + OFF_WKR);
                const LAS bf16* SS = (const LAS bf16*)(F.lds + O_SS + (c & 1) * 9216); const LAS bf16* CSr = (const LAS bf16*)(F.lds + O_CS + (c & 1) * 13056); LAS bf16* CSw = (LAS bf16*)(F.lds + O_CS + ((c + 1) & 1) * 13056);
                LAS bf16* HO = (LAS bf16*)(F.lds + O_HO + (c & 1) * 5120); const LAS float* sc = SCb + (c % 3) * 336; const LAS float* dn = (const LAS float*)(F.lds + O_DEN + (c & 1) * 1024);
                {   const int ti = w; f32x4 a1[2], a2[2], a3 = {0.f, 0.f, 0.f, 0.f};
#pragma unroll
                    for (int vj = 0; vj < 2; ++vj) { a1[vj] = (f32x4){0.f, 0.f, 0.f, 0.f}; a2[vj] = a1[vj]; }
#pragma unroll
                    for (int kk = 0; kk < 2; ++kk) { const bf16x8 sf = row_frag(SS + 16 * ti * 72, 72, 32 * kk, lane);
#pragma unroll
                        for (int vj = 0; vj < 2; ++vj) a1[vj] = __builtin_amdgcn_mfma_f32_16x16x32_bf16(sf, tr_frag(VS, 40, 32 * kk, 16 * vj, lane), a1[vj], 0, 0, 0); }
#pragma unroll
                    for (int kk = 0; kk < 4; ++kk) { const bf16x8 qf = row_frag(QS + 16 * ti * 136, 136, 32 * kk, lane);
#pragma unroll
                        for (int vj = 0; vj < 2; ++vj) a2[vj] = __builtin_amdgcn_mfma_f32_16x16x32_bf16(qf, row_frag(CSr + 16 * vj * 136, 136, 32 * kk, lane), a2[vj], 0, 0, 0);
                        a3 = __builtin_amdgcn_mfma_f32_16x16x32_bf16(qf, row_frag(CSr + 32 * 136, 136, 32 * kk, lane), a3, 0, 0, 0); }
#pragma unroll
                    for (int i = 0; i < 4; ++i) { const int t_ = 16 * ti + 4 * q + i; const float wi = sc[128 + t_]; const float nq = row16_sum(a3[i]);
                        const float den = ((dn[t_] + dn[64 + t_]) + (dn[128 + t_] + dn[192 + t_])) + wi * nq; const float rd = 1.0f / fmaxf(fabsf(den), sc[192 + t_]);
#pragma unroll
                        for (int vj = 0; vj < 2; ++vj) HO[t_ * 40 + 16 * vj + r] = (bf16)f2bf((a1[vj][i] + wi * a2[vj][i]) * rd); } }
                {   const float wprev = sc[320]; bf16x8 av[2][2], wf[2];
#pragma unroll
                    for (int kk = 0; kk < 2; ++kk) { av[0][kk] = tr_frag(VW, 40, 32 * kk, 0, lane); av[1][kk] = tr_frag(VW, 40, 32 * kk, 16, lane); wf[kk] = row_frag(WKR, 72, 32 * kk, lane); }
#pragma unroll
                    for (int jj = 0; jj < 2; ++jj) { const int dj = 2 * w + jj; Cst[0][jj] = Cst[0][jj] * wprev; Cst[1][jj] = Cst[1][jj] * wprev; Nst[jj] = Nst[jj] * wprev;
#pragma unroll
                        for (int kk = 0; kk < 2; ++kk) { const bf16x8 kf = tr_frag(KS, 136, 32 * kk, 16 * dj, lane);
                            Cst[0][jj] = __builtin_amdgcn_mfma_f32_16x16x32_bf16(av[0][kk], kf, Cst[0][jj], 0, 0, 0); Cst[1][jj] = __builtin_amdgcn_mfma_f32_16x16x32_bf16(av[1][kk], kf, Cst[1][jj], 0, 0, 0);
                            Nst[jj] = __builtin_amdgcn_mfma_f32_16x16x32_bf16(wf[kk], kf, Nst[jj], 0, 0, 0); }
#pragma unroll
                        for (int vi = 0; vi < 2; ++vi)
#pragma unroll
                            for (int i = 0; i < 4; ++i) CSw[(16 * vi + 4 * q + i) * 136 + 16 * dj + r] = (bf16)f2bf(Cst[vi][jj][i]);
                        if (q == 0) CSw[32 * 136 + 16 * dj + r] = (bf16)f2bf(Nst[jj][0]); } }
                }
                __syncthreads();
            }
        }
    }
}

template <int PROBE> PHASE_FN void hg_scan_phase(Frame F, const GAS bf16* Q, const GAS bf16* V, const GAS bf16* LF, GAS bf16* HSf, GAS bf16* HSb) {
    constexpr int O_QT = 0, O_KT = 17408, O_IN = 34816, INB = 39936  , O_AS = O_IN + 2 * INB, O_ST = O_AS + 2 * 9216, O_HO = O_ST + 2 * 8704, O_SBL = O_HO + 5120, O_WT = O_SBL + 1024, O_CTR = O_WT + 2048;
    LAS unsigned* actr = (LAS unsigned*)(F.lds + O_CTR);
    const int tid = F.tid, lane = F.lane, w = F.wave, r = lane & 15, q = lane >> 4;
    constexpr int NCH = T / 64;
    for (int unit = F.bid; unit < 256; unit += F.G) {
        const int vs = unit & 3, dir = (unit >> 2) & 1, h = (unit >> 3) & 7, b = unit >> 6;
        GAS bf16* HS = dir ? HSb : HSf; const GAS bf16* LFd = LF + (size_t)dir * NTOK * 1024;
        __syncthreads();
        for (int i = tid; i < (O_CTR + 16) / 4; i += NTHR) ((LAS unsigned*)F.lds)[i] = 0u;
        __syncthreads();
        if (w >= 4) {
            const int a = w - 4, ptid = tid - 256, g4 = ptid >> 4, lp = ptid & 15; unsigned abar = 0;
            u32x4 rq[4], rl[4], rv;
#define HG_LOAD(cc) do { _Pragma("unroll") for (int j_ = 0; j_ < 4; ++j_) { const int row_ = seq_row(b, dir, (cc) * 64 + 4 * g4 + j_); rq[j_] = *(const GAS u32x4*)(Q + (size_t)row_ * 1024 + h * 128 + 8 * lp); rl[j_] = *(const GAS u32x4*)(LFd + (size_t)row_ * 1024 + h * 128 + 8 * lp); } \
                const int vrow_ = seq_row(b, dir, (cc) * 64 + (ptid >> 2)); rv = *(const GAS u32x4*)(V + (size_t)vrow_ * 1024 + h * 128 + vs * 32 + 8 * (ptid & 3)); } while (0)
#define HG_ATILE(cc, ti_, sj_) do { LAS bf16* as_ = (LAS bf16*)(F.lds + O_AS + ((cc) & 1) * 9216); f32x4 acc_ = {0.f, 0.f, 0.f, 0.f}; \
                acc_ = mm16<128>(acc_, (const LAS bf16*)(F.lds + O_QT) + 16 * (ti_) * 136, 136, (const LAS bf16*)(F.lds + O_KT) + 16 * (sj_) * 136, 136, lane); \
                _Pragma("unroll") for (int i_ = 0; i_ < 4; ++i_) { const int t_ = 16 * (ti_) + 4 * q + i_, s_ = 16 * (sj_) + r; as_[t_ * 72 + s_] = (bf16)f2bf(s_ <= t_ ? acc_[i_] : 0.f); } } while (0)
#define HG_ATILES(cc) do { if (a == 0) { HG_ATILE(cc, 3, 0); HG_ATILE(cc, 3, 1); HG_ATILE(cc, 0, 0); } else if (a == 1) { HG_ATILE(cc, 3, 2); HG_ATILE(cc, 3, 3); HG_ATILE(cc, 1, 0); } \
                else if (a == 2) { HG_ATILE(cc, 2, 0); HG_ATILE(cc, 2, 1); } else { HG_ATILE(cc, 2, 2); HG_ATILE(cc, 1, 1); } } while (0)
#define HG_PREP(cc) do { LAS float* wt_ = (LAS float*)(F.lds + O_WT); LAS unsigned char* ib_ = F.lds + O_IN + ((cc) & 1) * INB; \
                float lf_[4][8], bc_[4][8]; \
                _Pragma("unroll") for (int j_ = 0; j_ < 4; ++j_) _Pragma("unroll") for (int k_ = 0; k_ < 4; ++k_) { lf_[j_][2 * k_] = bflo(rl[j_][k_]); lf_[j_][2 * k_ + 1] = bfhi(rl[j_][k_]); } \
                _Pragma("unroll") for (int k_ = 0; k_ < 8; ++k_) { float run_ = 0.f; _Pragma("unroll") for (int j_ = 0; j_ < 4; ++j_) { run_ += lf_[j_][k_]; bc_[j_][k_] = run_; } \
                    float x_ = run_; float y_ = __shfl_up(x_, 16); if (lane >= 16) x_ += y_; y_ = __shfl_up(x_, 32); if (lane >= 32) x_ += y_; const float ex_ = x_ - run_; \
                    _Pragma("unroll") for (int j_ = 0; j_ < 4; ++j_) bc_[j_][k_] += ex_; \
                    if (lane >= 48) wt_[a * 128 + 8 * lp + k_] = x_; } \
                group_barrier(actr, 4 * (++abar), lane); \
                float br_[8], bl_[8]; \
                _Pragma("unroll") for (int k_ = 0; k_ < 8; ++k_) { const float t0_ = wt_[8 * lp + k_], t1_ = wt_[128 + 8 * lp + k_], t2_ = wt_[256 + 8 * lp + k_], t3_ = wt_[384 + 8 * lp + k_]; \
                    const float off_ = (a > 0 ? t0_ : 0.f) + (a > 1 ? t1_ : 0.f) + (a > 2 ? t2_ : 0.f); br_[k_] = t0_ + t1_; bl_[k_] = (t0_ + t1_) + (t2_ + t3_); \
                    _Pragma("unroll") for (int j_ = 0; j_ < 4; ++j_) bc_[j_][k_] += off_; } \
                _Pragma("unroll") for (int j_ = 0; j_ < 4; ++j_) { const int t_ = 4 * g4 + j_; u32x4 oq_, oi_, ok_, oh_; \
                    _Pragma("unroll") for (int k_ = 0; k_ < 4; ++k_) { float a2_[2], i2_[2], k2_[2], h2_[2]; \
                        _Pragma("unroll") for (int hh_ = 0; hh_ < 2; ++hh_) { const int c_ = 2 * k_ + hh_; const float bt_ = bc_[j_][c_], key_ = 1.0f - __expf(lf_[j_][c_]), qv_ = hh_ ? bfhi(rq[j_][k_]) : bflo(rq[j_][k_]); \
                            a2_[hh_] = qv_ * __expf(bt_ - br_[c_]); i2_[hh_] = qv_ * __expf(bt_); k2_[hh_] = key_ * __expf(br_[c_] - bt_); h2_[hh_] = key_ * __expf(bl_[c_] - bt_); } \
                        oq_[k_] = pk2(a2_[0], a2_[1]); oi_[k_] = pk2(i2_[0], i2_[1]); ok_[k_] = pk2(k2_[0], k2_[1]); oh_[k_] = pk2(h2_[0], h2_[1]); } \
                    *(LAS u32x4*)((LAS bf16*)(F.lds + O_QT) + t_ * 136 + 8 * lp) = oq_; *(LAS u32x4*)((LAS bf16*)(F.lds + O_KT) + t_ * 136 + 8 * lp) = ok_; \
                    *(LAS u32x4*)((LAS bf16*)ib_ + t_ * 136 + 8 * lp) = oi_; *(LAS u32x4*)((LAS bf16*)(ib_ + 17408) + t_ * 136 + 8 * lp) = oh_; } \
                *(LAS u32x4*)((LAS bf16*)(ib_ + 34816) + (ptid >> 2) * 40 + 8 * (ptid & 3)) = rv; \
                if (g4 == 0) { LAS float* sbl_ = (LAS float*)(F.lds + O_SBL) + ((cc) & 1) * 128; _Pragma("unroll") for (int k_ = 0; k_ < 8; ++k_) sbl_[8 * lp + k_] = __expf(bl_[k_]); } } while (0)
            HG_LOAD(0);
            HG_PREP(0); HG_LOAD(1);
            group_barrier(actr, 4 * (++abar), lane);
            HG_ATILES(0);
            __syncthreads();
            for (int c = 0; c < NCH; ++c) {
                if (c + 1 < NCH && !(PROBE & 2)) {
                    group_barrier(actr, 4 * (++abar), lane);
                    HG_PREP(c + 1);
                    if (c + 2 < NCH) HG_LOAD(c + 2);
                    group_barrier(actr, 4 * (++abar), lane);
                    HG_ATILES(c + 1);
                }
                __syncthreads();
            }
#undef HG_LOAD
#undef HG_ATILE
#undef HG_ATILES
#undef HG_PREP
        } else {
            f32x4 Sst[2][2];
#pragma unroll
            for (int i = 0; i < 2; ++i) { Sst[i][0] = (f32x4){0.f, 0.f, 0.f, 0.f}; Sst[i][1] = Sst[i][0]; }
            __syncthreads();
            for (int c = 0; c < NCH; ++c) {
                if (!(PROBE & 1)) {
                const LAS unsigned char* ib = F.lds + O_IN + (c & 1) * INB;
                const LAS bf16* QI = (const LAS bf16*)ib; const LAS bf16* KH = (const LAS bf16*)(ib + 17408); const LAS bf16* VS = (const LAS bf16*)(ib + 34816);
                const LAS bf16* AS = (const LAS bf16*)(F.lds + O_AS + (c & 1) * 9216); const LAS bf16* STr = (const LAS bf16*)(F.lds + O_ST + (c & 1) * 8704); LAS bf16* STw = (LAS bf16*)(F.lds + O_ST + ((c + 1) & 1) * 8704);
                LAS bf16* HO = (LAS bf16*)(F.lds + O_HO); const LAS float* sbl = (const LAS float*)(F.lds + O_SBL) + (c & 1) * 128;
                {   const int ti = w; f32x4 o[2]; o[0] = (f32x4){0.f, 0.f, 0.f, 0.f}; o[1] = o[0];
#pragma unroll
                    for (int kk = 0; kk < 2; ++kk) { const bf16x8 af = row_frag(AS + 16 * ti * 72, 72, 32 * kk, lane);
#pragma unroll
                        for (int vj = 0; vj < 2; ++vj) o[vj] = __builtin_amdgcn_mfma_f32_16x16x32_bf16(af, tr_frag(VS, 40, 32 * kk, 16 * vj, lane), o[vj], 0, 0, 0); }
#pragma unroll
                    for (int kk = 0; kk < 4; ++kk) { const bf16x8 qf = row_frag(QI + 16 * ti * 136, 136, 32 * kk, lane);
#pragma unroll
                        for (int vj = 0; vj < 2; ++vj) o[vj] = __builtin_amdgcn_mfma_f32_16x16x32_bf16(qf, row_frag(STr + 16 * vj * 136, 136, 32 * kk, lane), o[vj], 0, 0, 0); }
#pragma unroll
                    for (int i = 0; i < 4; ++i)
#pragma unroll
                        for (int vj = 0; vj < 2; ++vj) HO[(16 * ti + 4 * q + i) * 40 + 16 * vj + r] = (bf16)f2bf(o[vj][i]);
                    LDS_WAIT();
                    { const int t_ = 16 * ti + (lane >> 2); const int row = seq_row(b, dir, c * 64 + t_); *(GAS u32x4*)(HS + (size_t)row * 1024 + h * 128 + vs * 32 + 8 * (lane & 3)) = *(const LAS u32x4*)(HO + t_ * 40 + 8 * (lane & 3)); } }
                {   bf16x8 av[2][2];
#pragma unroll
                    for (int kk = 0; kk < 2; ++kk) { av[0][kk] = tr_frag(VS, 40, 32 * kk, 0, lane); av[1][kk] = tr_frag(VS, 40, 32 * kk, 16, lane); }
#pragma unroll
                    for (int jj = 0; jj < 2; ++jj) { const int kj = 2 * w + jj; const float sb = sbl[16 * kj + r]; Sst[0][jj] = Sst[0][jj] * sb; Sst[1][jj] = Sst[1][jj] * sb;
#pragma unroll
                        for (int kk = 0; kk < 2; ++kk) { const bf16x8 kf = tr_frag(KH, 136, 32 * kk, 16 * kj, lane);
                            Sst[0][jj] = __builtin_amdgcn_mfma_f32_16x16x32_bf16(av[0][kk], kf, Sst[0][jj], 0, 0, 0); Sst[1][jj] = __builtin_amdgcn_mfma_f32_16x16x32_bf16(av[1][kk], kf, Sst[1][jj], 0, 0, 0); }
#pragma unroll
                        for (int vi = 0; vi < 2; ++vi)
#pragma unroll
                            for (int i = 0; i < 4; ++i) STw[(16 * vi + 4 * q + i) * 136 + 16 * kj + r] = (bf16)f2bf(Sst[vi][jj][i]); } }
                }
                __syncthreads();
            }
        }
    }
}

__device__ __forceinline__ float fmix_lo(float a, unsigned b, float c) { float d; asm("v_fma_mix_f32 %0, %1, %2, %3 op_sel:[0,0,0] op_sel_hi:[0,1,0]" : "=v"(d) : "v"(a), "v"(b), "v"(c)); return d; }
__device__ __forceinline__ float fmix_hi(float a, unsigned b, float c) { float d; asm("v_fma_mix_f32 %0, %1, %2, %3 op_sel:[0,1,0] op_sel_hi:[0,1,0]" : "=v"(d) : "v"(a), "v"(b), "v"(c)); return d; }
__device__ __forceinline__ unsigned pkh2(float lo, float hi) { typedef _Float16 h2_t __attribute__((ext_vector_type(2))); h2_t v; v.x = (_Float16)lo; v.y = (_Float16)hi; return __builtin_bit_cast(unsigned, v); }
constexpr int RW_STEPB = 768;
typedef _Float16 h2_t __attribute__((ext_vector_type(2)));
template <int CTRL> __device__ __forceinline__ float dpp_add(float v) { return v + dpp_f<CTRL>(v); }
__device__ __forceinline__ float row8_sum(float v) { v = dpp_add<0xB1>(v); v = dpp_add<0x4E>(v); v = dpp_add<0x141>(v); return v; }
template <int PROBE> PHASE_FN void rw_scan_phase(Frame F, const GAS bf16* Rr, const GAS bf16* Kk, const GAS bf16* Vv, const GAS bf16* WH, const GAS bf16* AH, GAS bf16* O  , GAS float* BETA  ) {
    LAS bf16* W2T = (LAS bf16*)(F.lds + 0); LAS bf16* A2T = (LAS bf16*)(F.lds + 9216);
    LAS bf16* WHS = (LAS bf16*)(F.lds + 18432); LAS bf16* AHS = (LAS bf16*)(F.lds + 27648);
    LAS float* WPA = (LAS float*)(F.lds + 36864);
    LAS unsigned char* STEP = F.lds + 53248;
    LAS float* OP = (LAS float*)(F.lds + 102400);
    LAS float* SO = (LAS float*)(F.lds + 135168);
    LAS float* SVEC = (LAS float*)(F.lds + 143360);
    const int tid = F.tid, lane = F.lane, w = F.wave;
    constexpr int NCH = T / 32;
    for (int unit = F.bid; unit < 256; unit += F.G) {
        const int half = unit & 1, dir = (unit >> 1) & 1, h = (unit >> 2) & 15, b = unit >> 6;
        __syncthreads();
        for (int i = tid; i < 4096; i += NTHR) { const int l = i >> 6, jn = i & 63; W2T[jn * 72 + l] = (bf16)f2bf(INP(IN_RW_W2)[((size_t)(dir * 64 + l)) * 1024 + h * 64 + jn]); A2T[jn * 72 + l] = (bf16)f2bf(INP(IN_RW_A2)[((size_t)(dir * 64 + l)) * 1024 + h * 64 + jn]); }
        if (tid < 64) { SVEC[tid] = INP(IN_RW_W0)[dir * 1024 + h * 64 + tid]; SVEC[64 + tid] = INP(IN_RW_A0)[dir * 1024 + h * 64 + tid]; SVEC[128 + tid] = INP(IN_RW_KK)[h * 64 + tid];
            SVEC[192 + tid] = INP(IN_RW_KA)[h * 64 + tid]; SVEC[256 + tid] = INP(IN_RW_RK)[h * 64 + tid]; }
        __syncthreads();
        if (w >= 4) {
            const int p = w - 4, tl = lane >> 3, c8 = lane & 7, tp = 8 * p + tl, kc = 8 * c8;
            u32x4 rr, rk, rwh, rah; u32x2 rv;
#define RW_LOAD_RKV(cc) do { const size_t row_ = (size_t)seq_row(b, dir, (cc) * 32 + tp); rr = *(const GAS u32x4*)(Rr + row_ * 1024 + h * 64 + kc); rk = *(const GAS u32x4*)(Kk + row_ * 1024 + h * 64 + kc); \
                rv = *(const GAS u32x2*)(Vv + row_ * 1024 + h * 64 + half * 32 + 4 * c8); } while (0)
#define RW_LOAD_H(cc) do { const size_t row_ = (size_t)seq_row(b, dir, (cc) * 32 + tp); rwh = *(const GAS u32x4*)(WH + row_ * 128 + dir * 64 + kc); rah = *(const GAS u32x4*)(AH + row_ * 128 + dir * 64 + kc); } while (0)
#define RW_STAGE_H(buf) do { *(LAS u32x4*)(WHS + (buf) * (32 * 72) + tp * 72 + kc) = rwh; *(LAS u32x4*)(AHS + (buf) * (32 * 72) + tp * 72 + kc) = rah; } while (0)
#define RW_PREP(cc) do { const int bb_ = (cc) & 1; LAS float* wpa_ = WPA + p * 1024; const int r_ = lane & 15, q_ = lane >> 4; \
                _Pragma("unroll") for (int kt = 0; kt < 4; ++kt) { f32x4 aw_ = {0.f, 0.f, 0.f, 0.f}, aa_ = aw_; \
                    aw_ = mm16<64>(aw_, WHS + bb_ * (32 * 72) + 16 * (p >> 1) * 72, 72, W2T + 16 * kt * 72, 72, lane); aa_ = mm16<64>(aa_, AHS + bb_ * (32 * 72) + 16 * (p >> 1) * 72, 72, A2T + 16 * kt * 72, 72, lane); \
                    if ((q_ >> 1) == (p & 1)) { _Pragma("unroll") for (int i = 0; i < 4; ++i) { wpa_[(4 * (q_ & 1) + i) * 64 + 16 * kt + r_] = aw_[i]; wpa_[512 + (4 * (q_ & 1) + i) * 64 + 16 * kt + r_] = aa_[i]; } } } \
                LDS_WAIT(); \
                float wp_[8], ap_[8], kv_[8], rq_[8]; \
                _Pragma("unroll") for (int jj = 0; jj < 2; ++jj) { const f32x4 x_ = *(const LAS f32x4*)(wpa_ + tl * 64 + kc + 4 * jj) + *(const LAS f32x4*)(SVEC + kc + 4 * jj), y_ = *(const LAS f32x4*)(wpa_ + 512 + tl * 64 + kc + 4 * jj) + *(const LAS f32x4*)(SVEC + 64 + kc + 4 * jj); \
                    _Pragma("unroll") for (int i = 0; i < 4; ++i) { wp_[4 * jj + i] = x_[i]; ap_[4 * jj + i] = y_[i]; } } \
                _Pragma("unroll") for (int jj = 0; jj < 4; ++jj) { kv_[2 * jj] = bflo(rk[jj]); kv_[2 * jj + 1] = bfhi(rk[jj]); rq_[2 * jj] = bflo(rr[jj]); rq_[2 * jj + 1] = bfhi(rr[jj]); } \
                float now_[8], av_[8], kx_[8], ssq_ = 0.f, bet_ = 0.f; \
                _Pragma("unroll") for (int j = 0; j < 8; ++j) { now_[j] = __expf(-0.6065306597126334f * sigmoid_f(wp_[j])) - 1.0f; av_[j] = sigmoid_f(ap_[j]); kx_[j] = kv_[j] * SVEC[128 + kc + j]; ssq_ += kx_[j] * kx_[j]; } \
                ssq_ = row8_sum(ssq_); const float rn_ = 1.0f / sqrtf(fmaxf(ssq_, 1e-24f)); \
                u32x4 p0_, p1_, p2_, p3_, p4_; \
                _Pragma("unroll") for (int jj = 0; jj < 4; ++jj) { float nk_[2], ak_[2], kd_[2]; \
                    _Pragma("unroll") for (int hh = 0; hh < 2; ++hh) { const int j = 2 * jj + hh; const float kkn_ = kx_[j] * rn_; nk_[hh] = -kkn_; ak_[hh] = kkn_ * av_[j]; kd_[hh] = kv_[j] * (1.0f + (av_[j] - 1.0f) * SVEC[192 + kc + j]); bet_ += rq_[j] * kd_[hh] * SVEC[256 + kc + j]; } \
                    p0_[jj] = pkh2(now_[2 * jj], now_[2 * jj + 1]); p1_[jj] = pkh2(nk_[0], nk_[1]); p4_[jj] = pkh2(rq_[2 * jj], rq_[2 * jj + 1]); \
                    if (jj < 2) { p2_[2 * jj] = pkh2(ak_[0], kd_[0]); p2_[2 * jj + 1] = pkh2(ak_[1], kd_[1]); } else { p3_[2 * (jj - 2)] = pkh2(ak_[0], kd_[0]); p3_[2 * (jj - 2) + 1] = pkh2(ak_[1], kd_[1]); } } \
                bet_ = row8_sum(bet_); \
                LAS unsigned char* sp_ = STEP + bb_ * (32 * RW_STEPB) + tp * RW_STEPB + c8 * 80; \
                *(LAS u32x4*)sp_ = p0_; *(LAS u32x4*)(sp_ + 16) = p1_; *(LAS u32x4*)(sp_ + 32) = p2_; *(LAS u32x4*)(sp_ + 48) = p3_; *(LAS u32x4*)(sp_ + 64) = p4_; \
                *(LAS f32x4*)(STEP + bb_ * (32 * RW_STEPB) + tp * RW_STEPB + 640 + 16 * c8) = (f32x4){bflo(rv.x), bfhi(rv.x), bflo(rv.y), bfhi(rv.y)}; \
                if (c8 == 0 && half == 0) BETA[((size_t)dir * NTOK + seq_row(b, dir, (cc) * 32 + tp)) * 16 + h] = bet_; } while (0)
#define RW_STORE(cc) do { const size_t row_ = (size_t)seq_row(b, dir, (cc) * 32 + tp); const f32x4 o_ = *(const LAS f32x4*)(SO + ((cc) & 1) * 1024 + tp * 32 + 4 * c8); u32x2 pk_; pk_.x = pk2(o_[0], o_[1]); pk_.y = pk2(o_[2], o_[3]); \
                *(GAS u32x2*)(O + ((size_t)dir * NTOK + row_) * 1024 + h * 64 + half * 32 + 4 * c8) = pk_; } while (0)
            RW_LOAD_H(0); RW_LOAD_RKV(0); RW_STAGE_H(0); RW_LOAD_H(1);
            __syncthreads();
            RW_PREP(0); RW_STAGE_H(1); RW_LOAD_RKV(1); RW_LOAD_H(2);
            __syncthreads();
            for (int c = 0; c < NCH; ++c) {
                if (!(PROBE & 2)) {
                if (c > 0) RW_STORE(c - 1);
                if (c + 1 < NCH) { RW_PREP(c + 1); if (c + 2 < NCH) { RW_STAGE_H(c & 1); RW_LOAD_RKV(c + 2); if (c + 3 < NCH) RW_LOAD_H(c + 3); } }
                }
                __syncthreads();
            }
            RW_STORE(NCH - 1);
#undef RW_LOAD_RKV
#undef RW_LOAD_H
#undef RW_STAGE_H
#undef RW_PREP
#undef RW_STORE
        } else {
            const int row = tid >> 3, c8 = tid & 7;
            float S0 = 0.f, S1 = 0.f, S2 = 0.f, S3 = 0.f, S4 = 0.f, S5 = 0.f, S6 = 0.f, S7 = 0.f;
            __syncthreads();
            __syncthreads();
            for (int c = 0; c < NCH; ++c) {
                if (!(PROBE & 1)) {
                const LAS unsigned char* sp = STEP + (c & 1) * (32 * RW_STEPB) + c8 * 80; const LAS unsigned char* vp = STEP + (c & 1) * (32 * RW_STEPB) + 640 + 4 * row; LAS float* op = OP + row * 8 + c8;
                u32x4 a0 = *(const LAS u32x4*)sp, a1 = *(const LAS u32x4*)(sp + 16), a2 = *(const LAS u32x4*)(sp + 32), a3 = *(const LAS u32x4*)(sp + 48), a4 = *(const LAS u32x4*)(sp + 64); float vv = *(const LAS float*)vp;
#pragma unroll 4
                for (int t_ = 0; t_ < 32; ++t_) {
                    const int tn = (t_ + 1) & 31;
                    const LAS unsigned char* np = sp + tn * RW_STEPB;
                    const u32x4 n0 = *(const LAS u32x4*)np, n1 = *(const LAS u32x4*)(np + 16), n2 = *(const LAS u32x4*)(np + 32), n3 = *(const LAS u32x4*)(np + 48), n4 = *(const LAS u32x4*)(np + 64); const float vn = *(const LAS float*)(vp + tn * RW_STEPB);
                    float sa, sb, oa, ob; unsigned sv;
                    asm volatile(
                        "v_fma_mix_f32 %8, %0, %14, 0 op_sel:[0,0,0] op_sel_hi:[0,1,0]\n\t"
                        "v_fma_mix_f32 %9, %1, %14, 0 op_sel:[0,1,0] op_sel_hi:[0,1,0]\n\t"
                        "v_fma_mix_f32 %8, %2, %15, %8 op_sel:[0,0,0] op_sel_hi:[0,1,0]\n\t"
                        "v_fma_mix_f32 %9, %3, %15, %9 op_sel:[0,1,0] op_sel_hi:[0,1,0]\n\t"
                        "v_fma_mix_f32 %8, %4, %16, %8 op_sel:[0,0,0] op_sel_hi:[0,1,0]\n\t"
                        "v_fma_mix_f32 %9, %5, %16, %9 op_sel:[0,1,0] op_sel_hi:[0,1,0]\n\t"
                        "v_fma_mix_f32 %8, %6, %17, %8 op_sel:[0,0,0] op_sel_hi:[0,1,0]\n\t"
                        "v_fma_mix_f32 %9, %7, %17, %9 op_sel:[0,1,0] op_sel_hi:[0,1,0]\n\t"
                        "v_fma_mix_f32 %0, %0, %10, %0 op_sel:[0,0,0] op_sel_hi:[0,1,0]\n\t"
                        "v_fma_mix_f32 %1, %1, %10, %1 op_sel:[0,1,0] op_sel_hi:[0,1,0]\n\t"
                        "v_fma_mix_f32 %2, %2, %11, %2 op_sel:[0,0,0] op_sel_hi:[0,1,0]\n\t"
                        "v_fma_mix_f32 %3, %3, %11, %3 op_sel:[0,1,0] op_sel_hi:[0,1,0]\n\t"
                        "v_add_f32 %8, %8, %9\n\t"
                        "v_fma_mix_f32 %4, %4, %12, %4 op_sel:[0,0,0] op_sel_hi:[0,1,0]\n\t"
                        "v_fma_mix_f32 %5, %5, %12, %5 op_sel:[0,1,0] op_sel_hi:[0,1,0]\n\t"
                        "v_add_f32_dpp %8, %8, %8 quad_perm:[1,0,3,2] row_mask:0xf bank_mask:0xf bound_ctrl:1\n\t"
                        "v_fma_mix_f32 %6, %6, %13, %6 op_sel:[0,0,0] op_sel_hi:[0,1,0]\n\t"
                        "v_fma_mix_f32 %7, %7, %13, %7 op_sel:[0,1,0] op_sel_hi:[0,1,0]\n\t"
                        "v_add_f32_dpp %8, %8, %8 quad_perm:[2,3,0,1] row_mask:0xf bank_mask:0xf bound_ctrl:1\n\t"
                        "s_nop 1\n\t"
                        "v_add_f32_dpp %8, %8, %8 row_half_mirror row_mask:0xf bank_mask:0xf bound_ctrl:1\n\t"
                        "s_nop 0"
                        : "+v"(S0), "+v"(S1), "+v"(S2), "+v"(S3), "+v"(S4), "+v"(S5), "+v"(S6), "+v"(S7), "=&v"(sa), "=&v"(sb)
                        : "v"(a0[0]), "v"(a0[1]), "v"(a0[2]), "v"(a0[3]), "v"(a1[0]), "v"(a1[1]), "v"(a1[2]), "v"(a1[3]));
                    asm volatile(
                        "v_cvt_pkrtz_f16_f32 %8, %11, %12\n\t"
                        "v_dot2c_f32_f16 %0, %8, %13\n\t"
                        "v_dot2c_f32_f16 %1, %8, %14\n\t"
                        "v_dot2c_f32_f16 %2, %8, %15\n\t"
                        "v_dot2c_f32_f16 %3, %8, %16\n\t"
                        "v_dot2c_f32_f16 %4, %8, %17\n\t"
                        "v_dot2c_f32_f16 %5, %8, %18\n\t"
                        "v_dot2c_f32_f16 %6, %8, %19\n\t"
                        "v_dot2c_f32_f16 %7, %8, %20\n\t"
                        "v_fma_mix_f32 %9, %0, %21, 0 op_sel:[0,0,0] op_sel_hi:[0,1,0]\n\t"
                        "v_fma_mix_f32 %10, %1, %21, 0 op_sel:[0,1,0] op_sel_hi:[0,1,0]\n\t"
                        "v_fma_mix_f32 %9, %2, %22, %9 op_sel:[0,0,0] op_sel_hi:[0,1,0]\n\t"
                        "v_fma_mix_f32 %10, %3, %22, %10 op_sel:[0,1,0] op_sel_hi:[0,1,0]\n\t"
                        "v_fma_mix_f32 %9, %4, %23, %9 op_sel:[0,0,0] op_sel_hi:[0,1,0]\n\t"
                        "v_fma_mix_f32 %10, %5, %23, %10 op_sel:[0,1,0] op_sel_hi:[0,1,0]\n\t"
                        "v_fma_mix_f32 %9, %6, %24, %9 op_sel:[0,0,0] op_sel_hi:[0,1,0]\n\t"
                        "v_fma_mix_f32 %10, %7, %24, %10 op_sel:[0,1,0] op_sel_hi:[0,1,0]\n\t"
                        "v_add_f32 %9, %9, %10\n\t"
                        "s_nop 0"
                        : "+v"(S0), "+v"(S1), "+v"(S2), "+v"(S3), "+v"(S4), "+v"(S5), "+v"(S6), "+v"(S7), "=&v"(sv), "=&v"(oa), "=&v"(ob)
                        : "v"(sa), "v"(vv), "v"(a2[0]), "v"(a2[1]), "v"(a2[2]), "v"(a2[3]), "v"(a3[0]), "v"(a3[1]), "v"(a3[2]), "v"(a3[3]), "v"(a4[0]), "v"(a4[1]), "v"(a4[2]), "v"(a4[3]));
                    op[t_ * 256] = oa;
                    a0 = n0; a1 = n1; a2 = n2; a3 = n3; a4 = n4; vv = vn;
                }
                LDS_WAIT();
#pragma unroll
                for (int i = 0; i < 4; ++i) { const LAS f32x4* q_ = (const LAS f32x4*)(OP + ((4 * c8 + i) * 32 + row) * 8); const f32x4 x_ = q_[0] + q_[1]; SO[(c & 1) * 1024 + (4 * c8 + i) * 32 + row] = (x_[0] + x_[1]) + (x_[2] + x_[3]); }
                }
                __syncthreads();
            }
        }
    }
}

PHASE_FN void gemm_mlin(Frame F, int jl) { GAS unsigned char* MIX = F.ws + WS_MIX; GAS unsigned char* HY = F.ws + WS_HY;
    pg8::Gemm g{(const GAS bf16*)HY, (const GAS bf16*)(F.W + W_ML_WIN + jl * W_ML_WIN_SZ), NTOK, 4352, 1024}; pg8::StaticOrder So; So.init(NTOK, 4352, F.G, F.bid);
    pg8::EpiMlstmIn E{(GAS bf16*)MIX, (GAS bf16*)(MIX + 2 * ROWB), (GAS bf16*)(MIX + 3 * ROWB), (GAS float*)(MIX + 4 * ROWB), INP(IN_ML_BGATE) + jl * 32};
    pg8::gemm_phase<pg8::EpiMlstmIn, pg8::StaticOrder, GEMM_ALIGN, GEMM_SP2>(F.lds, g, So, E, F.tid); }
PHASE_FN void gemm_resid(Frame F, const GAS bf16* A, const GAS bf16* Bt, int L) {
    pg8::Gemm g{A, Bt, NTOK, 1024, 1024}; pg8::StaticOrder So; So.init(NTOK, 1024, F.G, F.bid);
    pg8::EpiResid E{(GAS float*)(F.ws + WS_S), (const GAS float*)(F.ws + WS_MOD) + (size_t)L * 5 * 6144, 2}; pg8::gemm_phase<pg8::EpiResid, pg8::StaticOrder, GEMM_ALIGN, GEMM_SP2>(F.lds, g, So, E, F.tid); }
PHASE_FN void gemm_rwin(Frame F) { GAS unsigned char* MIX = F.ws + WS_MIX; GAS unsigned char* HY = F.ws + WS_HY;
    GAS bf16* Rb = (GAS bf16*)MIX; GAS bf16* Kb = (GAS bf16*)(MIX + ROWB); GAS bf16* Vb = (GAS bf16*)(MIX + 2 * ROWB); GAS float* WH = (GAS float*)(MIX + 3 * ROWB); GAS float* AH = WH + (size_t)NTOK * 128; GAS bf16* GH = (GAS bf16*)(AH + (size_t)NTOK * 128);
    pg8::Gemm g{(const GAS bf16*)HY, (const GAS bf16*)(F.W + W_RW_IN), NTOK, 3584, 2048}; pg8::StaticOrder So; So.init(NTOK, 3584, F.G, F.bid);
    pg8::EpiRwkvIn E{Rb, Kb, Vb, WH, AH, GH}; pg8::gemm_phase<pg8::EpiRwkvIn, pg8::StaticOrder, GEMM_ALIGN, GEMM_SP2>(F.lds, g, So, E, F.tid); }
PHASE_FN void gemm_rwg(Frame F) { GAS unsigned char* MIX = F.ws + WS_MIX;
    GAS float* WH = (GAS float*)(MIX + 3 * ROWB); GAS float* AH = WH + (size_t)NTOK * 128; GAS bf16* GH = (GAS bf16*)(AH + (size_t)NTOK * 128);
    pg8::Gemm g{GH, (const GAS bf16*)(F.W + W_RW_G2), NTOK, 1024, 256}; pg8::StaticOrder So; So.init(NTOK, 1024, F.G, F.bid);
    pg8::EpiBf16Plain E{(GAS bf16*)MIX, 1024}; pg8::gemm_phase<pg8::EpiBf16Plain, pg8::StaticOrder, GEMM_ALIGN, GEMM_SP2>(F.lds, g, So, E, F.tid); }
PHASE_FN void gemm_hgin(Frame F) { GAS unsigned char* MIX = F.ws + WS_MIX; GAS unsigned char* HY = F.ws + WS_HY;
    pg8::Gemm g{(const GAS bf16*)HY, (const GAS bf16*)(F.W + W_HG_IN), NTOK, 5120, 1024}; pg8::StaticOrder So; So.init(NTOK, 5120, F.G, F.bid);
    pg8::EpiHgrnIn E{(GAS bf16*)MIX, (GAS bf16*)(MIX + ROWB), (GAS bf16*)(MIX + 2 * ROWB), (GAS bf16*)(MIX + 3 * ROWB), (size_t)NTOK * 1024, INP(IN_HG_BF), (const GAS float*)(F.ws + WS_LB)};
    pg8::gemm_phase<pg8::EpiHgrnIn, pg8::StaticOrder, GEMM_ALIGN, GEMM_SP2>(F.lds, g, So, E, F.tid); }
PHASE_FN void gemm_moe1(Frame F, int L) { GAS unsigned char* MIX = F.ws + WS_MIX; LAS int* pref = (LAS int*)(F.lds + LDS_PHASE_BYTES); moe_prefix(F, L, pref, pref + 32);
    pg8::Gemm g{(const GAS bf16*)(F.ws + WS_HY), (const GAS bf16*)(F.W + W_EX13), NSLOT, 16384, 1024, (const GAS int*)(F.ws + WS_SLOT_TOK)}; pg8::MoeOrder So{pref, F.G, F.bid};
    pg8::EpiMoe1 E{(GAS bf16*)(MIX + 140 * MiB)}; pg8::gemm_phase<pg8::EpiMoe1, pg8::MoeOrder, GEMM_ALIGN, GEMM_SP2, true>(F.lds, g, So, E, F.tid); }
PHASE_FN void gemm_moe2(Frame F, int L) { GAS unsigned char* MIX = F.ws + WS_MIX; LAS int* pref = (LAS int*)(F.lds + LDS_PHASE_BYTES); moe_prefix(F, L, pref, pref + 32);
    pg8::Gemm g{(const GAS bf16*)(MIX + 140 * MiB), (const GAS bf16*)(F.W + W_EX2), NSLOT, 16384, 512}; pg8::MoeOrder So{pref, F.G, F.bid};
    pg8::EpiMoe2 E{(GAS bf16*)(MIX + 210 * MiB), (const GAS int*)(F.ws + WS_SLOT_TOK), (const GAS float*)(F.ws + WS_SLOT_GATE)};
    pg8::gemm_phase<pg8::EpiMoe2, pg8::MoeOrder, GEMM_ALIGN, GEMM_SP2>(F.lds, g, So, E, F.tid); }

#ifndef MK_PER_PHASE
#define MK_PER_PHASE 0
#endif
constexpr int PH_PER_LAYER = 12, PH_LAYER0 = 2, PH_FINAL = PH_LAYER0 + DEPTH * PH_PER_LAYER, N_PHASES = PH_FINAL + 1;
__global__ void __launch_bounds__(NTHR, 2) fwd_kernel(Args args) {
    extern __shared__ __attribute__((aligned(16))) unsigned char lds_raw[];
    Frame F;
    F.lds = (LAS unsigned char*)lds_raw; F.out = (GAS float*)args.out; F.ws = (GAS unsigned char*)args.ws; F.W = (GAS unsigned char*)args.wts;
    F.tid = threadIdx.x; F.lane = F.tid & 63; F.wave = __builtin_amdgcn_readfirstlane(F.tid >> 6); F.bid = blockIdx.x; F.G = gridDim.x;
    volatile LAS unsigned* MISC = (volatile LAS unsigned*)(F.lds + MISC_OFF);
    if (F.tid < 32) MISC[F.tid] = 0u;
    if (F.tid < 42) ((LAS unsigned long long*)(F.lds + PTAB_OFF))[F.tid] = (unsigned long long)args.in[F.tid];
    __syncthreads();
    const int lo = args.ph_lo, hi = args.ph_hi;
    XcdBarrier bar; bar.bar = (unsigned*)args.ws + CW_BAR; bar.x = 0; bar.st = MISC + 8;
    if (hi - lo > 1) bar = xcd_barrier_post((unsigned*)args.ws + CW_BAR, MISC + 8);
#define IN(k) (lo <= (k) && (k) < hi)
#ifndef EXTRA_BARS
#define EXTRA_BARS 0
#endif
#define SEAM(k) do { if ((k) + 1 < hi) { xcd_barrier(bar); for (int eb_ = 0; eb_ < EXTRA_BARS; ++eb_) xcd_barrier(bar); } } while (0)
#ifndef DUP_MASK
#define DUP_MASK 0
#endif
#ifndef PRB_MASK
#define PRB_MASK 0
#endif
#define PRB(bit, stmt) do { if ((PRB_MASK >> (bit)) & 1) { stmt; xcd_barrier(bar); } } while (0)
#define DUP(bit, stmt) do { stmt; if ((DUP_MASK >> (bit)) & 1) { xcd_barrier(bar); stmt; } } while (0)

    if (IN(0)) { PRB(0, pre_phase(fresh(F))); pre_phase(fresh(F)); SEAM(0); }
    if (IN(1)) { PRB(0, modsum_phase(fresh(F))); modsum_phase(fresh(F)); SEAM(1); }

    for (int L = 0; L < DEPTH; ++L) {
        const int kind = L % 3, jl = L / 3, pb = PH_LAYER0 + L * PH_PER_LAYER;
        if (IN(pb + 0)) { DUP(6, expert_weights(fresh(F), L)); if ((PRB_MASK >> 1) & 1) { norm_phase<0, 1>(fresh(F), L, L > 0, kind == 1 ? 2048 : 1024); xcd_barrier(bar); } norm_phase<0>(fresh(F), L, L > 0, kind == 1 ? 2048 : 1024); SEAM(pb + 0); }
        if (kind == 0) {
            if (IN(pb + 2)) { DUP(3, gemm_mlin(fresh(F), jl)); SEAM(pb + 2); }
            if (IN(pb + 3)) { DUP(7, conv_phase(fresh(F), jl)); SEAM(pb + 3); }
            if (IN(pb + 4)) { const Frame Fp = fresh(F); GAS unsigned char* MIX = Fp.ws + WS_MIX;
#ifndef SC_PROBE
#define SC_PROBE 0
#endif
                if (SC_PROBE) { ml_scan_phase<SC_PROBE>(Fp, (const GAS bf16*)(Fp.ws + WS_HY), (const GAS bf16*)(MIX + 2 * ROWB), (const GAS float*)(MIX + 4 * ROWB), (GAS bf16*)MIX); xcd_barrier(bar); }
                DUP(0, ml_scan_phase<0>(Fp, (const GAS bf16*)(Fp.ws + WS_HY), (const GAS bf16*)(MIX + 2 * ROWB), (const GAS float*)(MIX + 4 * ROWB), (GAS bf16*)MIX)); SEAM(pb + 4); }
            if (IN(pb + 6)) { const Frame Fp = fresh(F); GAS unsigned char* MIX = Fp.ws + WS_MIX;
                PRB(4, headnorm_phase(Fp, (const GAS bf16*)MIX, (const GAS bf16*)(MIX + ROWB), (const GAS bf16*)(MIX + 3 * ROWB), ldptr(Fp, IN_ML_HEADG) + jl * 1024, (GAS bf16*)(Fp.ws + WS_HY + ROWB)));
                headnorm_phase(Fp, (const GAS bf16*)MIX, (const GAS bf16*)(MIX + ROWB), (const GAS bf16*)(MIX + 3 * ROWB), ldptr(Fp, IN_ML_HEADG) + jl * 1024, (GAS bf16*)(Fp.ws + WS_HY + ROWB)); SEAM(pb + 6); }
            if (IN(pb + 7)) { const Frame Fp = fresh(F); gemm_resid(Fp, (const GAS bf16*)(Fp.ws + WS_HY + ROWB), (const GAS bf16*)(Fp.W + W_ML_WOUT + jl * 2 * MiB), L); SEAM(pb + 7); }
        } else if (kind == 1) {
            if (IN(pb + 1)) { PRB(4, du_phase(fresh(F))); du_phase(fresh(F)); SEAM(pb + 1); }
            if (IN(pb + 2)) { DUP(3, gemm_rwin(fresh(F))); SEAM(pb + 2); }
            if (IN(pb + 4)) { const Frame Fp = fresh(F); GAS unsigned char* MIX = Fp.ws + WS_MIX; GAS float* WH = (GAS float*)(MIX + 3 * ROWB); GAS float* AH = WH + (size_t)NTOK * 128; GAS float* BETA = (GAS float*)((GAS bf16*)(AH + (size_t)NTOK * 128) + (size_t)NTOK * 256);

#ifndef RW_PROBE
#define RW_PROBE 0
#endif
                if (RW_PROBE) { rw_scan_phase<RW_PROBE>(Fp, (const GAS bf16*)MIX, (const GAS bf16*)(MIX + ROWB), (const GAS bf16*)(MIX + 2 * ROWB), (const GAS bf16*)WH, (const GAS bf16*)AH, (GAS bf16*)(Fp.ws + WS_HY), BETA); xcd_barrier(bar); }
                DUP(1, rw_scan_phase<0>(Fp, (const GAS bf16*)MIX, (const GAS bf16*)(MIX + ROWB), (const GAS bf16*)(MIX + 2 * ROWB), (const GAS bf16*)WH, (const GAS bf16*)AH, (GAS bf16*)(Fp.ws + WS_HY), BETA)); SEAM(pb + 4); }
            if (IN(pb + 5)) { PRB(4, gemm_rwg(fresh(F))); gemm_rwg(fresh(F)); SEAM(pb + 5); }
            if (IN(pb + 6)) { const Frame Fp = fresh(F); GAS unsigned char* MIX = Fp.ws + WS_MIX; GAS float* WH = (GAS float*)(MIX + 3 * ROWB); GAS float* AH = WH + (size_t)NTOK * 128; GAS float* BETA = (GAS float*)((GAS bf16*)(AH + (size_t)NTOK * 128) + (size_t)NTOK * 256);
                PRB(4, rwpost_phase(Fp, (const GAS bf16*)(Fp.ws + WS_HY), (const GAS bf16*)(Fp.ws + WS_HY + ROWB), BETA, (const GAS bf16*)(MIX + 2 * ROWB), (const GAS bf16*)MIX, (GAS bf16*)(MIX + ROWB)));
                rwpost_phase(Fp, (const GAS bf16*)(Fp.ws + WS_HY), (const GAS bf16*)(Fp.ws + WS_HY + ROWB), BETA, (const GAS bf16*)(MIX + 2 * ROWB), (const GAS bf16*)MIX, (GAS bf16*)(MIX + ROWB)); SEAM(pb + 6); }
            if (IN(pb + 7)) { const Frame Fp = fresh(F); gemm_resid(Fp, (const GAS bf16*)(Fp.ws + WS_MIX + ROWB), (const GAS bf16*)(Fp.W + W_RW_WOUT), L); SEAM(pb + 7); }
        } else {
            if (IN(pb + 2)) { DUP(3, gemm_hgin(fresh(F))); SEAM(pb + 2); }
            if (IN(pb + 4)) { const Frame Fp = fresh(F); GAS unsigned char* MIX = Fp.ws + WS_MIX;
                if (SC_PROBE) { hg_scan_phase<SC_PROBE>(Fp, (const GAS bf16*)MIX, (const GAS bf16*)(MIX + ROWB), (const GAS bf16*)(MIX + 3 * ROWB), (GAS bf16*)(Fp.ws + WS_HY + ROWB), (GAS bf16*)(Fp.ws + WS_HY)); xcd_barrier(bar); }
                DUP(2, hg_scan_phase<0>(Fp, (const GAS bf16*)MIX, (const GAS bf16*)(MIX + ROWB), (const GAS bf16*)(MIX + 3 * ROWB), (GAS bf16*)(Fp.ws + WS_HY + ROWB), (GAS bf16*)(Fp.ws + WS_HY))); SEAM(pb + 4); }
            if (IN(pb + 6)) { const Frame Fp = fresh(F); GAS unsigned char* MIX = Fp.ws + WS_MIX;
                headnorm_phase(Fp, (const GAS bf16*)(Fp.ws + WS_HY + ROWB), (const GAS bf16*)(Fp.ws + WS_HY), (const GAS bf16*)(MIX + 2 * ROWB), ldptr(Fp, IN_HG_HEADG), (GAS bf16*)(Fp.ws + WS_HY + ROWB)); SEAM(pb + 6); }
            if (IN(pb + 7)) { const Frame Fp = fresh(F); gemm_resid(Fp, (const GAS bf16*)(Fp.ws + WS_HY + ROWB), (const GAS bf16*)(Fp.W + W_HG_WOUT), L); SEAM(pb + 7); }
        }
        if (IN(pb + 8)) { if ((PRB_MASK >> 2) & 1) { norm_phase<1, 1>(fresh(F), L, false, 1024); xcd_barrier(bar); } norm_phase<1>(fresh(F), L, false, 1024); SEAM(pb + 8); }
        if (IN(pb + 9)) { if ((PRB_MASK >> 3) & 1) { slots_phase<1>(fresh(F), L); xcd_barrier(bar); } slots_phase<0>(fresh(F), L); SEAM(pb + 9); }
        if (IN(pb + 10)) { DUP(4, gemm_moe1(fresh(F), L)); SEAM(pb + 10); }
        if (IN(pb + 11)) { DUP(5, gemm_moe2(fresh(F), L)); SEAM(pb + 11); }
    }
    if (IN(PH_FINAL)) norm_phase<2>(fresh(F), 0, true, 1024);
#undef IN
#undef SEAM
}

extern "C" void kernel_launch(void* const* d_in, const int* in_sizes, int n_in, void* d_out, int out_size, void* d_ws, size_t ws_size, hipStream_t stream) {
    static int grid = 0;
    if (grid == 0) {
        if (n_in != 42 || out_size != NB * SEQ * D || ws_size < WS_END) { fprintf(stderr, "kernel_launch: unexpected problem (n_in %d, out %d, ws %zu)\n", n_in, out_size, ws_size); grid = -1; return; }
        int dev = 0, cus = 0, per_cu = 0;
        if (hipGetDevice(&dev) != hipSuccess || hipDeviceGetAttribute(&cus, hipDeviceAttributeMultiprocessorCount, dev) != hipSuccess) { grid = -1; return; }
        if (hipFuncSetAttribute((const void*)fwd_kernel, hipFuncAttributeMaxDynamicSharedMemorySize, LDS_BYTES) != hipSuccess) { fprintf(stderr, "kernel_launch: hipFuncSetAttribute failed\n"); grid = -1; return; }
        if (hipOccupancyMaxActiveBlocksPerMultiprocessor(&per_cu, (const void*)fwd_kernel, NTHR, LDS_BYTES) != hipSuccess || per_cu < 1) { fprintf(stderr, "kernel_launch: occupancy query reports %d\n", per_cu); (void)hipGetLastError(); grid = -1; return; }
        grid = cus;
    }
    if (grid < 0) return;
    (void)hipMemsetAsync(d_ws, 0, CTL_ZERO_BYTES, stream);
    Args a{};
    for (int i = 0; i < 42; ++i) a.in[i] = (const float*)d_in[i];
    a.out = (float*)d_out; a.ws = (unsigned char*)d_ws;
    a.wts = (ws_size >= WS_END + W_BYTES) ? (unsigned char*)d_ws + WS_END : (unsigned char*)d_out;
#if MK_PER_PHASE
    for (int p = 0; p < N_PHASES; ++p) { a.ph_lo = p; a.ph_hi = p + 1; hipLaunchKernelGGL(fwd_kernel, dim3(grid), dim3(NTHR), LDS_BYTES, stream, a); }
#else
    a.ph_lo = 0; a.ph_hi = N_PHASES;
    hipLaunchKernelGGL(fwd_kernel, dim3(grid), dim3(NTHR), LDS_BYTES, stream, a);
#endif
}
```

```cpp
#include <hip/hip_runtime.h>
#include <cstdio>
#include <cstdint>

__device__ __forceinline__ float sigmoid_f(float x) { return 1.0f / (1.0f + __expf(-x)); }
__device__ __forceinline__ float silu_f(float x) { return x / (1.0f + __expf(-x)); }
__device__ __forceinline__ float logsigmoid_f(float x) { return fminf(x, 0.f) - __logf(1.0f + __expf(-fabsf(x))); }
#define GAS __attribute__((address_space(1)))
namespace pg8 {
#define PG8_LAS __attribute__((address_space(3)))
typedef unsigned short bf16_t;
typedef short bf16x8 __attribute__((ext_vector_type(8)));
typedef float f32x4 __attribute__((ext_vector_type(4)));
typedef unsigned u32x4 __attribute__((ext_vector_type(4)));
constexpr int BM = 256, BK = 64, HALF = 128, HTB = HALF * BK * 2  , STAGE_BYTES = 8 * HTB, NXCD = 8, WGM = 8;

__host__ __device__ __forceinline__ int lds_byte(int r, int c) { const int st = (r >> 4) * 2 + (c >> 5), rr = r & 15, cc = c & 31, ob = rr * 64 + cc * 2; return st * 1024 + (ob ^ (((ob >> 9) & 1) << 5)); }
__host__ __device__ __forceinline__ void stage_rc(int b, int& R, int& C) { const int st = b / 1024, sb = b % 1024, swz = sb ^ (((sb >> 9) & 1) << 5); R = (st >> 1) * 16 + swz / 64; C = (st & 1) * 32 + (swz % 64) / 2; }
__host__ __device__ __forceinline__ int perm32(int rho) { const int n = rho >> 4, i = rho & 15; return 8 * (i >> 2) + 4 * n + (i & 3); }

struct Unit { int pm, pn; };
struct Gemm { const GAS bf16_t* A; const GAS bf16_t* Bt; int M, N, K; const GAS int* gidx; };

struct StaticOrder {
    int nM, nN, nwg, G, c;
    __host__ __device__ void init(int M, int N, int G_, int c_) { nM = M / BM; nN = N / BM; nwg = nM * nN; G = G_; c = c_; }
    __host__ __device__ bool next(int i, Unit& u) const {
        const long L = (long)i * G + c; if (L >= nwg) return false;
        int wgid = (int)L; { const int q = nwg / NXCD, r = nwg % NXCD, xcd = wgid % NXCD, off = wgid / NXCD; wgid = (xcd < r ? xcd * (q + 1) : r * (q + 1) + (xcd - r) * q) + off; }
        const int nig = WGM * nN, gid = wgid / nig, fm = gid * WGM, gsz = (nM - fm) < WGM ? (nM - fm) : WGM;
        u.pm = fm + ((wgid % nig) % gsz); u.pn = (wgid % nig) / gsz; return true;
    }
    __device__ __forceinline__ void a_ready(const Unit&) const {}
    __device__ __forceinline__ void done(const Unit&) const {}
};
__device__ __forceinline__ unsigned cvt_pk_bf16(float lo, float hi) { unsigned r; asm volatile("v_cvt_pk_bf16_f32 %0, %1, %2" : "=v"(r) : "v"(lo), "v"(hi)); return r; }
typedef unsigned u32x2 __attribute__((ext_vector_type(2)));
__device__ __forceinline__ void st8(GAS bf16_t* p, f32x4 v0, f32x4 v1) { u32x4 w; w.x = cvt_pk_bf16(v0[0], v0[1]); w.y = cvt_pk_bf16(v0[2], v0[3]); w.z = cvt_pk_bf16(v1[0], v1[1]); w.w = cvt_pk_bf16(v1[2], v1[3]); *(GAS u32x4*)p = w; }
template <int ACT> __device__ __forceinline__ f32x4 act4(f32x4 v) {
    if (ACT == 1) { v[0] = sigmoid_f(v[0]); v[1] = sigmoid_f(v[1]); v[2] = sigmoid_f(v[2]); v[3] = sigmoid_f(v[3]); }
    if (ACT == 2) { v[0] = silu_f(v[0]); v[1] = silu_f(v[1]); v[2] = silu_f(v[2]); v[3] = silu_f(v[3]); }
    return v; }
template <int ACT> __device__ __forceinline__ void store_tile_bf16(const f32x4 (&acc)[2][2][4][2], GAS bf16_t* base, int ld, int row0, int cw) {
#pragma unroll
    for (int ai = 0; ai < 2; ++ai)
#pragma unroll
        for (int m = 0; m < 4; ++m) { GAS bf16_t* rp = base + (size_t)(row0 + ai * HALF + m * 16) * ld + cw;
#pragma unroll
            for (int bj = 0; bj < 2; ++bj) st8(rp + bj * HALF, act4<ACT>(acc[ai][bj][m][0]), act4<ACT>(acc[ai][bj][m][1])); }
}
struct EpiBf16Plain { static constexpr bool PERM = true, AFTER_DRAIN = false; GAS bf16_t* O; int ldc;
    __device__ __forceinline__ void operator()(const f32x4 (&acc)[2][2][4][2], const Unit& u, int wr, int wc, int fr, int fq) const {
        store_tile_bf16<0>(acc, O + u.pn * BM, ldc, u.pm * BM + wr * 64 + fr, wc * 32 + 8 * fq); }
};
struct EpiMlstmIn { static constexpr bool PERM = true, AFTER_DRAIN = false;
    GAS bf16_t* QKPRE; GAS bf16_t* V; GAS bf16_t* OG; GAS float* GATES; const GAS float* bgate;
    __device__ __forceinline__ void operator()(const f32x4 (&acc)[2][2][4][2], const Unit& u, int wr, int wc, int fr, int fq) const {
        const int row0 = u.pm * BM + wr * 64 + fr, cw = wc * 32 + 8 * fq;
        if (u.pn < 8) store_tile_bf16<0>(acc, QKPRE + u.pn * BM, 2048, row0, cw);
        else if (u.pn < 12) store_tile_bf16<0>(acc, V + (u.pn - 8) * BM, 1024, row0, cw);
        else if (u.pn < 16) store_tile_bf16<1>(acc, OG + (u.pn - 12) * BM, 1024, row0, cw);
        else if (wc == 0) {
            const f32x4 b0 = *(const GAS f32x4*)(bgate + 8 * fq), b1 = *(const GAS f32x4*)(bgate + 8 * fq + 4);
#pragma unroll
            for (int ai = 0; ai < 2; ++ai)
#pragma unroll
                for (int m = 0; m < 4; ++m) { GAS float* gp = GATES + (size_t)(row0 + ai * HALF + m * 16) * 32 + 8 * fq;
                    *(GAS f32x4*)gp = acc[ai][0][m][0] + b0; *(GAS f32x4*)(gp + 4) = acc[ai][0][m][1] + b1; }
        }
    }
};
struct EpiRwkvIn { static constexpr bool PERM = true, AFTER_DRAIN = false;
    GAS bf16_t* R; GAS bf16_t* Kk; GAS bf16_t* V; GAS float* WH; GAS float* AH; GAS bf16_t* GH;
    __device__ __forceinline__ void operator()(const f32x4 (&acc)[2][2][4][2], const Unit& u, int wr, int wc, int fr, int fq) const {
        const int row0 = u.pm * BM + wr * 64 + fr, cw = wc * 32 + 8 * fq;
        if (u.pn < 4) store_tile_bf16<0>(acc, R + u.pn * BM, 1024, row0, cw);
        else if (u.pn < 8) store_tile_bf16<0>(acc, Kk + (u.pn - 4) * BM, 1024, row0, cw);
        else if (u.pn < 12) store_tile_bf16<0>(acc, V + (u.pn - 8) * BM, 1024, row0, cw);
        else if (u.pn == 12) {
#pragma unroll
            for (int ai = 0; ai < 2; ++ai)
#pragma unroll
                for (int m = 0; m < 4; ++m) { const size_t r = (size_t)(row0 + ai * HALF + m * 16);
                    f32x4 t0 = acc[ai][0][m][0], t1 = acc[ai][0][m][1];
#pragma unroll
                    for (int j = 0; j < 4; ++j) { t0[j] = tanhf(t0[j]); t1[j] = tanhf(t1[j]); }
                    st8((GAS bf16_t*)WH + r * 128 + cw, t0, t1); st8((GAS bf16_t*)AH + r * 128 + cw, acc[ai][1][m][0], acc[ai][1][m][1]); }
        } else {
#pragma unroll
            for (int ai = 0; ai < 2; ++ai)
#pragma unroll
                for (int m = 0; m < 4; ++m) { GAS bf16_t* rp = GH + (size_t)(row0 + ai * HALF + m * 16) * 256 + cw;
                    st8(rp, act4<1>(acc[ai][0][m][0]), act4<1>(acc[ai][0][m][1])); *(GAS u32x4*)(rp + HALF) = (u32x4){0u, 0u, 0u, 0u}; }
        }
    }
};
struct EpiHgrnIn { static constexpr bool PERM = true, AFTER_DRAIN = false;
    GAS bf16_t* Q; GAS bf16_t* V; GAS bf16_t* OG; GAS bf16_t* LF; size_t lf_stride; const GAS float* bf; const GAS float* lb;
    __device__ __forceinline__ void operator()(const f32x4 (&acc)[2][2][4][2], const Unit& u, int wr, int wc, int fr, int fq) const {
        const int row0 = u.pm * BM + wr * 64 + fr, cw = wc * 32 + 8 * fq;
        if (u.pn < 4) store_tile_bf16<2>(acc, Q + u.pn * BM, 1024, row0, cw);
        else if (u.pn < 8) store_tile_bf16<0>(acc, V + (u.pn - 4) * BM, 1024, row0, cw);
        else if (u.pn < 12) store_tile_bf16<2>(acc, OG + (u.pn - 8) * BM, 1024, row0, cw);
        else {
            const int dir = (u.pn - 12) >> 2, ct = ((u.pn - 12) & 3) * BM; GAS bf16_t* base = LF + (size_t)dir * lf_stride + ct;
            f32x4 bb[2][2], ll[2][2];
#pragma unroll
            for (int bj = 0; bj < 2; ++bj)
#pragma unroll
                for (int n = 0; n < 2; ++n) { bb[bj][n] = *(const GAS f32x4*)(bf + dir * 1024 + ct + bj * HALF + cw + 4 * n); ll[bj][n] = *(const GAS f32x4*)(lb + ct + bj * HALF + cw + 4 * n); }
#pragma unroll
            for (int ai = 0; ai < 2; ++ai)
#pragma unroll
                for (int m = 0; m < 4; ++m) { GAS bf16_t* rp = base + (size_t)(row0 + ai * HALF + m * 16) * 1024 + cw;
#pragma unroll
                    for (int bj = 0; bj < 2; ++bj) { f32x4 o[2];
#pragma unroll
                        for (int n = 0; n < 2; ++n)
#pragma unroll
                            for (int j = 0; j < 4; ++j) { const float l = ll[bj][n][j]; o[n][j] = __logf(l + (1.f - l) * sigmoid_f(acc[ai][bj][m][n][j] + bb[bj][n][j])); }
                        st8(rp + bj * HALF, o[0], o[1]); } }
        }
    }
};
struct EpiResid { static constexpr bool PERM = false, AFTER_DRAIN = false;
    GAS float* S; const GAS float* mod; int gate_idx;
    __device__ __forceinline__ void operator()(const f32x4 (&acc)[2][2][4][2], const Unit& u, int wr, int wc, int fr, int fq) const {
        const int b = u.pm / 33, seg = (u.pm - b * 33 == 0) ? 0 : 1 + b;
        const int row0 = u.pm * BM + wr * 64 + fr, col0 = u.pn * BM + wc * 32 + 4 * fq;
        const GAS float* gp = mod + seg * 6144 + gate_idx * 1024 + col0;
        f32x4 gv[2][2];
#pragma unroll
        for (int bj = 0; bj < 2; ++bj)
#pragma unroll
            for (int n = 0; n < 2; ++n) gv[bj][n] = *(const GAS f32x4*)(gp + bj * HALF + n * 16);
#pragma unroll
        for (int ai = 0; ai < 2; ++ai)
#pragma unroll
            for (int m = 0; m < 4; ++m) { GAS float* rowp = S + (size_t)(row0 + ai * HALF + m * 16) * 1024 + col0;
#pragma unroll
                for (int bj = 0; bj < 2; ++bj)
#pragma unroll
                    for (int n = 0; n < 2; ++n) { GAS f32x4* p = (GAS f32x4*)(rowp + bj * HALF + n * 16); *p = *p + acc[ai][bj][m][n] * gv[bj][n]; } }
    }
};
struct EpiMoe1 { static constexpr bool PERM = true, AFTER_DRAIN = false; GAS bf16_t* ACT;
    __device__ __forceinline__ void operator()(const f32x4 (&acc)[2][2][4][2], const Unit& u, int wr, int wc, int fr, int fq) const {
        const int row0 = u.pm * BM + wr * 64 + fr, pnl = u.pn & 3, c0 = pnl * 128 + wc * 16 + 4 * fq;
#pragma unroll
        for (int ai = 0; ai < 2; ++ai)
#pragma unroll
            for (int m = 0; m < 4; ++m) { GAS bf16_t* rp = ACT + (size_t)(row0 + ai * HALF + m * 16) * 512 + c0;
#pragma unroll
                for (int bj = 0; bj < 2; ++bj) { const f32x4 a = acc[ai][bj][m][0], b = acc[ai][bj][m][1];
                    u32x2 w; w.x = cvt_pk_bf16(silu_f(a[0]) * b[0], silu_f(a[1]) * b[1]); w.y = cvt_pk_bf16(silu_f(a[2]) * b[2], silu_f(a[3]) * b[3]);
                    *(GAS u32x2*)(rp + bj * 64) = w; } }
    }
};
struct EpiMoe2 { static constexpr bool PERM = true, AFTER_DRAIN = false; GAS bf16_t* YM; const GAS int* slot_tok; const GAS float* slot_gate;
    __device__ __forceinline__ void operator()(const f32x4 (&acc)[2][2][4][2], const Unit& u, int wr, int wc, int fr, int fq) const {
        const int row0 = u.pm * BM + wr * 64 + fr, col0 = (u.pn & 3) * BM + wc * 32 + 8 * fq;
#pragma unroll
        for (int ai = 0; ai < 2; ++ai)
#pragma unroll
            for (int m = 0; m < 4; ++m) { const int slot = row0 + ai * HALF + m * 16; const int dst = slot_tok[slot]; const float g = slot_gate[slot];
                if (dst >= 0) { GAS bf16_t* rp = YM + (size_t)dst * 1024 + col0;
#pragma unroll
                    for (int bj = 0; bj < 2; ++bj) st8(rp + bj * HALF, acc[ai][bj][m][0] * g, acc[ai][bj][m][1] * g); } }
    }
};
struct MoeOrder { const PG8_LAS int* pref; int G, c;
    __device__ __forceinline__ bool next(int i, Unit& u) const {
        const int L = i * G + c, nt = pref[16]; if (L >= nt * 4) return false;
        const int tile = L >> 2; int e = 0;
#pragma unroll
        for (int j = 1; j < 16; ++j) e += (tile >= pref[j]) ? 1 : 0;
        u.pm = tile; u.pn = e * 4 + (L & 3); return true; }
    __device__ __forceinline__ void a_ready(const Unit&) const {}
    __device__ __forceinline__ void done(const Unit&) const {}
};
template <class Epi, class Sched, bool ALIGN_EPI = false, bool SP2 = false, bool GATHER = false>
__device__ __forceinline__ void gemm_phase(PG8_LAS unsigned char* lds, const Gemm g, const Sched& S, const Epi& E, const int tid_in) {
    int tid_ = tid_in; asm volatile("" : "+v"(tid_));
    const int tid = tid_, wid = __builtin_amdgcn_readfirstlane(tid >> 6), lane = tid & 63, wr = wid >> 2, wc = wid & 3, fr = lane & 15, fq = lane >> 4;
    const int K = g.K, nt = K / BK;
    unsigned voffA[2], voffB[2];
#pragma unroll
    for (int i = 0; i < 2; ++i) { int R, C; stage_rc(tid * 16 + i * 8192, R, C); const int Rb = Epi::PERM ? ((R & ~31) + perm32(R & 31)) : R;
        voffA[i] = (unsigned)(R * K + C) * 2u; voffB[i] = (unsigned)(Rb * K + C) * 2u; }
    unsigned offc[2][2], offn[2][2];
#define PG8_GOFF(dst, unit) do { _Pragma("unroll") for (int _h = 0; _h < 2; ++_h) _Pragma("unroll") for (int _i = 0; _i < 2; ++_i) { int _R, _C; stage_rc(tid * 16 + _i * 8192, _R, _C); \
        const int _t = g.gidx[(unit).pm * BM + _h * HALF + _R]; dst[_h][_i] = (unsigned)(((_t < 0 ? 0 : (_t >> 1)) * K + _C) * 2); } } while (0)
    const size_t kstep = (size_t)(BK * 2);
    const size_t hstep = (size_t)HALF * K * 2;
    const size_t tstep = 2 * hstep;
    if constexpr (!GATHER) {
#pragma unroll
        for (int h_ = 0; h_ < 2; ++h_)
#pragma unroll
            for (int i = 0; i < 2; ++i) { offc[h_][i] = voffA[i] + (unsigned)(h_ * hstep); offn[h_][i] = offc[h_][i]; } }
    const unsigned ldsw = (unsigned)wid * 1024u;
    const int aoff = lds_byte(wr * 64 + fr, fq * 8), boff = lds_byte(wc * 32 + fr, fq * 8);
#define PG8_SA(b, h) (((b) * 2 + (h)) * HTB)
#define PG8_SB(b, h) ((4 + (b) * 2 + (h)) * HTB)
#define PG8_STAGE(bufoff, gbase, voff) do { _Pragma("unroll") for (int _i = 0; _i < 2; ++_i) \
        __builtin_amdgcn_global_load_lds((const unsigned*)((const char*)(gbase) + (voff)[_i]), (PG8_LAS unsigned*)(lds + (bufoff) + ldsw + _i * 8192), 16, 0, 0); } while (0)
#define PG8_STAGE_A(bufoff, gbase, off2) do { _Pragma("unroll") for (int _i = 0; _i < 2; ++_i) \
        __builtin_amdgcn_global_load_lds((const unsigned*)((const char*)(gbase) + (off2)[_i]), (PG8_LAS unsigned*)(lds + (bufoff) + ldsw + _i * 8192), 16, 0, 0); } while (0)
#define PG8_LDA(dst, b, h) do { _Pragma("unroll") for (int m = 0; m < 4; ++m) _Pragma("unroll") for (int k = 0; k < 2; ++k) dst[m][k] = *(const PG8_LAS bf16x8*)(lds + PG8_SA(b, h) + aoff + m * 2048 + k * 1024); } while (0)
#define PG8_LDB(dst, b, h) do { _Pragma("unroll") for (int n = 0; n < 2; ++n) _Pragma("unroll") for (int k = 0; k < 2; ++k) dst[n][k] = *(const PG8_LAS bf16x8*)(lds + PG8_SB(b, h) + boff + n * 2048 + k * 1024); } while (0)
#define PG8_MMA(ai, bj, At, Bt) do { __builtin_amdgcn_s_setprio(1); _Pragma("unroll") for (int m = 0; m < 4; ++m) _Pragma("unroll") for (int n = 0; n < 2; ++n) _Pragma("unroll") for (int k = 0; k < 2; ++k) \
        acc[ai][bj][m][n] = __builtin_amdgcn_mfma_f32_16x16x32_bf16(Bt[n][k], At[m][k], acc[ai][bj][m][n], 0, 0, 0); __builtin_amdgcn_s_setprio(0); } while (0)
#define PG8_WAIT_V(n) asm volatile("s_waitcnt vmcnt(" #n ")" ::: "memory")
#define PG8_WAIT_L(n) asm volatile("s_waitcnt lgkmcnt(" #n ")" ::: "memory")
#define PG8_BAR __builtin_amdgcn_s_barrier()
#define PG8_SCHED __builtin_amdgcn_sched_barrier(0)
    Unit cur, nxt; int ui = 0;
    if (!S.next(0, cur)) return;
    f32x4 acc[2][2][4][2];
#pragma unroll
    for (int a = 0; a < 2; ++a)
#pragma unroll
        for (int b = 0; b < 2; ++b)
#pragma unroll
            for (int m = 0; m < 4; ++m)
#pragma unroll
                for (int n = 0; n < 2; ++n) acc[a][b][m][n] = (f32x4){0.f, 0.f, 0.f, 0.f};
    bf16x8 At[4][2], B0[2][2], B1[2][2];
    const char* cA = (const char*)g.A + (GATHER ? (size_t)0 : (size_t)cur.pm * tstep); const char* cB = (const char*)g.Bt + (size_t)cur.pn * tstep;
    S.a_ready(cur);
    if constexpr (GATHER) PG8_GOFF(offc, cur);
    if constexpr (SP2) {
        PG8_STAGE(PG8_SB(0, 0), cB, voffB); PG8_STAGE(PG8_SB(0, 1), cB + hstep, voffB); PG8_STAGE_A(PG8_SA(0, 0), cA, offc[0]); PG8_STAGE_A(PG8_SA(0, 1), cA, offc[1]);
        if (wr == 1) PG8_BAR;
        PG8_WAIT_V(2); PG8_BAR;
        PG8_STAGE(PG8_SB(1, 0), cB + kstep, voffB); PG8_STAGE_A(PG8_SA(1, 0), cA + kstep, offc[0]); PG8_STAGE(PG8_SB(1, 1), cB + hstep + kstep, voffB);
        PG8_WAIT_V(6); PG8_BAR;
    } else {
        PG8_STAGE(PG8_SB(0, 0), cB, voffB); PG8_STAGE_A(PG8_SA(0, 0), cA, offc[0]); PG8_STAGE(PG8_SB(0, 1), cB + hstep, voffB); PG8_STAGE_A(PG8_SA(0, 1), cA, offc[1]);
        if (wr == 1) PG8_BAR;
        PG8_WAIT_V(4); PG8_BAR;
        PG8_STAGE(PG8_SB(1, 0), cB + kstep, voffB); PG8_STAGE_A(PG8_SA(1, 0), cA + kstep, offc[0]); PG8_STAGE(PG8_SB(1, 1), cB + hstep + kstep, voffB);
        PG8_WAIT_V(6); PG8_BAR;
    }
    for (;;) {
        const bool has_next = S.next(ui + 1, nxt);
        const char* nA = (has_next && !GATHER) ? (const char*)g.A + (size_t)nxt.pm * tstep : cA; const char* nB = has_next ? (const char*)g.Bt + (size_t)nxt.pn * tstep : cB;
        if constexpr (GATHER) { if (has_next) PG8_GOFF(offn, nxt); else {
#pragma unroll
            for (int h_ = 0; h_ < 2; ++h_)
#pragma unroll
                for (int i = 0; i < 2; ++i) offn[h_][i] = offc[h_][i]; } }
        for (int t = 0; t < nt; t += 2) {
            const bool last = (t == nt - 2);
            const char* a1 = cA + (size_t)(t + 1) * kstep;
            const char* a2 = last ? nA : cA + (size_t)(t + 2) * kstep; const char* b2 = last ? nB : cB + (size_t)(t + 2) * kstep;
            const char* a3 = a2 + kstep; const char* b3 = b2 + kstep;
            if (last && has_next) S.a_ready(nxt);
            if constexpr (SP2) {
            PG8_LDB(B0, 0, 0); PG8_LDB(B1, 0, 1); PG8_SCHED; PG8_LDA(At, 0, 0); PG8_STAGE_A(PG8_SA(1, 1), a1, offc[1]); if constexpr (GATHER) { if (last) { offc[0][0] = offn[0][0]; offc[0][1] = offn[0][1]; offc[1][0] = offn[1][0]; offc[1][1] = offn[1][1]; } }
            PG8_WAIT_V(8); PG8_WAIT_L(0); PG8_BAR; PG8_MMA(0, 0, At, B0); PG8_MMA(0, 1, At, B1); PG8_BAR; PG8_SCHED;
            PG8_LDA(At, 0, 1); PG8_STAGE(PG8_SB(0, 0), b2, voffB); PG8_STAGE(PG8_SB(0, 1), b2 + hstep, voffB); PG8_STAGE_A(PG8_SA(0, 0), a2, offc[0]);
            PG8_WAIT_V(8); PG8_WAIT_L(0); PG8_BAR; PG8_MMA(1, 0, At, B0); PG8_MMA(1, 1, At, B1); PG8_BAR; PG8_SCHED;
            PG8_LDB(B0, 1, 0); PG8_LDB(B1, 1, 1); PG8_SCHED; PG8_LDA(At, 1, 0); PG8_STAGE_A(PG8_SA(0, 1), a2, offc[1]);
            PG8_WAIT_V(8); PG8_WAIT_L(0); PG8_BAR; PG8_MMA(0, 0, At, B0); PG8_MMA(0, 1, At, B1); PG8_BAR; PG8_SCHED;
            PG8_LDA(At, 1, 1); PG8_STAGE(PG8_SB(1, 0), b3, voffB); PG8_STAGE(PG8_SB(1, 1), b3 + hstep, voffB); PG8_STAGE_A(PG8_SA(1, 0), a3, offc[0]);
            PG8_WAIT_V(8); PG8_WAIT_L(0); PG8_BAR; PG8_MMA(1, 0, At, B0); PG8_MMA(1, 1, At, B1); PG8_BAR; PG8_SCHED;
            } else {
            PG8_LDB(B0, 0, 0); PG8_SCHED; PG8_LDA(At, 0, 0); PG8_STAGE_A(PG8_SA(1, 1), a1, offc[1]); if constexpr (GATHER) { if (last) { offc[0][0] = offn[0][0]; offc[0][1] = offn[0][1]; offc[1][0] = offn[1][0]; offc[1][1] = offn[1][1]; } }
            PG8_WAIT_L(8); PG8_BAR; PG8_WAIT_L(0); PG8_MMA(0, 0, At, B0); PG8_BAR; PG8_SCHED;
            PG8_LDB(B1, 0, 1); PG8_STAGE(PG8_SB(0, 0), b2, voffB);
            PG8_BAR; PG8_WAIT_L(0); PG8_MMA(0, 1, At, B1); PG8_BAR;
            PG8_LDA(At, 0, 1); PG8_STAGE_A(PG8_SA(0, 0), a2, offc[0]);
            PG8_BAR; PG8_WAIT_L(0); PG8_MMA(1, 0, At, B0); PG8_BAR; PG8_SCHED;
            PG8_STAGE(PG8_SB(0, 1), b2 + hstep, voffB);
            PG8_WAIT_V(6); PG8_BAR; PG8_MMA(1, 1, At, B1); PG8_BAR;
            PG8_LDB(B0, 1, 0); PG8_SCHED; PG8_LDA(At, 1, 0); PG8_STAGE_A(PG8_SA(0, 1), a2, offc[1]);
            PG8_WAIT_L(8); PG8_BAR; PG8_WAIT_L(0); PG8_MMA(0, 0, At, B0); PG8_BAR; PG8_SCHED;
            PG8_LDB(B1, 1, 1); PG8_STAGE(PG8_SB(1, 0), b3, voffB);
            PG8_BAR; PG8_WAIT_L(0); PG8_MMA(0, 1, At, B1); PG8_BAR;
            PG8_LDA(At, 1, 1); PG8_STAGE_A(PG8_SA(1, 0), a3, offc[0]);
            PG8_BAR; PG8_WAIT_L(0); PG8_MMA(1, 0, At, B0); PG8_BAR; PG8_SCHED;
            PG8_STAGE(PG8_SB(1, 1), b3 + hstep, voffB);
            PG8_WAIT_V(6); PG8_BAR; PG8_MMA(1, 1, At, B1); PG8_BAR;
            }
        }
        if constexpr (ALIGN_EPI) { if (wr == 0) PG8_BAR; }
        if constexpr (!Epi::AFTER_DRAIN) { E(acc, cur, wr, wc, fr, fq); S.done(cur); }
        if (!has_next) break;
#pragma unroll
        for (int a = 0; a < 2; ++a)
#pragma unroll
            for (int b = 0; b < 2; ++b)
#pragma unroll
                for (int m = 0; m < 4; ++m)
#pragma unroll
                    for (int n = 0; n < 2; ++n) acc[a][b][m][n] = (f32x4){0.f, 0.f, 0.f, 0.f};
        cur = nxt; cA = nA; cB = nB; ++ui;

        if constexpr (ALIGN_EPI) { if (wr == 1) PG8_BAR; }
    }
    PG8_WAIT_V(0);
    if constexpr (!ALIGN_EPI) { if (wr == 0) PG8_BAR; }
    PG8_BAR;
    if constexpr (Epi::AFTER_DRAIN) { E.fused(acc, cur, wr, wc, fr, fq, lds, wid, lane); S.done(cur); }
#undef PG8_SA
#undef PG8_SB
#undef PG8_STAGE
#undef PG8_STAGE_A
#undef PG8_GOFF
#undef PG8_LDA
#undef PG8_LDB
#undef PG8_MMA
#undef PG8_WAIT_V
#undef PG8_WAIT_L
#undef PG8_BAR
#undef PG8_SCHED
}
}

#define LAS __attribute__((address_space(3)))
#ifndef PHASE_FN
#define PHASE_FN __device__ __forceinline__
#endif
#ifndef GEMM_SP2
#define GEMM_SP2 true
#endif
#ifndef GEMM_ALIGN
#define GEMM_ALIGN false
#endif
typedef unsigned short bf16;
typedef pg8::bf16x8 bf16x8;
typedef pg8::f32x4 f32x4;
typedef pg8::u32x4 u32x4;
typedef pg8::u32x2 u32x2;
constexpr int D = 1024, NB = 4, SEQ = 8192, CTX = 256, T = CTX + SEQ, NTOK = NB * T, DEPTH = 4;
constexpr int NWAVES = 8, NTHR = 512;
constexpr int NSLOT = 71680;
constexpr size_t MiB = 1u << 20;
constexpr size_t CTL_ZERO_BYTES = 2 * MiB;
constexpr int CW_BAR = 1024;
constexpr int CW_MOE = 8192;
constexpr size_t WS_MOD = 1 * MiB;
constexpr size_t WS_LB = 2 * MiB;
constexpr size_t WS_TOK = 2 * MiB + 65536;
constexpr size_t WS_SLOT_TOK = 3 * MiB;
constexpr size_t WS_SLOT_GATE = 3 * MiB + 524288;
constexpr size_t WS_S = 4 * MiB;
constexpr size_t WS_HY = 136 * MiB;
constexpr size_t WS_MIX = 268 * MiB;
constexpr size_t WS_END = 610 * MiB;
constexpr size_t ROWB = (size_t)NTOK * 1024 * 2;
constexpr size_t W_ML_WIN = 0, W_ML_WIN_SZ = (size_t)4352 * 1024 * 2;
constexpr size_t W_ML_WOUT = 17 * MiB;
constexpr size_t W_RW_IN = 21 * MiB;
constexpr size_t W_RW_G2 = 35 * MiB;
constexpr size_t W_RW_WOUT = 36 * MiB;
constexpr size_t W_HG_IN = 38 * MiB;
constexpr size_t W_HG_WOUT = 48 * MiB;
constexpr size_t W_EX13 = 50 * MiB;
constexpr size_t W_EX2 = 82 * MiB;
constexpr size_t W_BYTES = 98 * MiB;
constexpr int LDS_PHASE_BYTES = 131072;
constexpr int LDS_BYTES = 163840;
constexpr int MISC_OFF = LDS_BYTES - 2048;

#define VM_WAIT() asm volatile("s_waitcnt vmcnt(0)" ::: "memory")
#define LDS_WAIT() asm volatile("s_waitcnt lgkmcnt(0)" ::: "memory")
typedef float f32x2_t __attribute__((ext_vector_type(2))); typedef __bf16 bf16x2_t __attribute__((ext_vector_type(2)));
__device__ __forceinline__ unsigned pk2(float lo, float hi) { f32x2_t v = {lo, hi}; bf16x2_t b = __builtin_convertvector(v, bf16x2_t); return __builtin_bit_cast(unsigned, b); }
__device__ __forceinline__ unsigned f2bf(float f) { return pk2(f, f) & 0xffffu; }
__device__ __forceinline__ float bf2f(unsigned b) { return __builtin_bit_cast(float, b << 16); }
__device__ __forceinline__ float bflo(unsigned w) { return __builtin_bit_cast(float, w << 16); }
__device__ __forceinline__ float bfhi(unsigned w) { return __builtin_bit_cast(float, w & 0xffff0000u); }
__device__ __forceinline__ float wave_sum(float v) {
#pragma unroll
    for (int o = 1; o < 64; o <<= 1) v += __shfl_xor(v, o);
    return v; }
__device__ __forceinline__ float wave_max(float v) {
#pragma unroll
    for (int o = 1; o < 64; o <<= 1) v = fmaxf(v, __shfl_xor(v, o));
    return v; }
template <int CTRL> __device__ __forceinline__ float dpp_f(float v) { return __builtin_bit_cast(float, __builtin_amdgcn_update_dpp(0, __builtin_bit_cast(int, v), CTRL, 0xF, 0xF, false)); }
__device__ __forceinline__ float row16_sum(float v) { v += dpp_f<0xB1>(v); v += dpp_f<0x4E>(v); v += dpp_f<0x124>(v); v += dpp_f<0x128>(v); return v; }
template <int CTRL, int ROWMASK> __device__ __forceinline__ float dpp_keep(float old, float v) { return __builtin_bit_cast(float, __builtin_amdgcn_update_dpp(__builtin_bit_cast(int, old), __builtin_bit_cast(int, v), CTRL, ROWMASK, 0xF, false)); }
__device__ __forceinline__ float wave_scan_add(float v) {
    v += dpp_keep<0x111, 0xF>(0.f, v); v += dpp_keep<0x112, 0xF>(0.f, v); v += dpp_keep<0x114, 0xF>(0.f, v); v += dpp_keep<0x118, 0xF>(0.f, v);
    v += dpp_keep<0x142, 0xA>(0.f, v); v += dpp_keep<0x143, 0xC>(0.f, v); return v; }
__device__ __forceinline__ float wave_scan_max(float v) {
    v = fmaxf(v, dpp_keep<0x111, 0xF>(v, v)); v = fmaxf(v, dpp_keep<0x112, 0xF>(v, v)); v = fmaxf(v, dpp_keep<0x114, 0xF>(v, v)); v = fmaxf(v, dpp_keep<0x118, 0xF>(v, v));
    v = fmaxf(v, dpp_keep<0x142, 0xA>(v, v)); v = fmaxf(v, dpp_keep<0x143, 0xC>(v, v)); return v; }
__device__ __forceinline__ float lane63(float v) { return __builtin_bit_cast(float, __builtin_amdgcn_readlane(__builtin_bit_cast(int, v), 63)); }
template <int K> __device__ __forceinline__ f32x4 mm16(f32x4 acc, const LAS bf16* A, int lda, const LAS bf16* Bt, int ldb, int lane) {
    const int r = lane & 15, q = lane >> 4;
#pragma unroll
    for (int kk = 0; kk < K / 32; ++kk) {
        const bf16x8 a = *(const LAS bf16x8*)(A + r * lda + kk * 32 + q * 8);
        const bf16x8 b = *(const LAS bf16x8*)(Bt + r * ldb + kk * 32 + q * 8);
        acc = __builtin_amdgcn_mfma_f32_16x16x32_bf16(a, b, acc, 0, 0, 0); }
    return acc; }
typedef short s16x4 __attribute__((ext_vector_type(4)));
__device__ __forceinline__ bf16x8 tr_frag(const LAS bf16* X, int ld, int k0, int n0, int lane) {
    const int g = lane >> 4, a = (lane & 15) >> 2, p = lane & 3;
    const LAS bf16* p0 = X + (k0 + 8 * g + a) * ld + n0 + 4 * p;
    const s16x4 lo = __builtin_amdgcn_ds_read_tr16_b64_v4i16((LAS s16x4*)p0), hi = __builtin_amdgcn_ds_read_tr16_b64_v4i16((LAS s16x4*)(p0 + 4 * ld));
    return (bf16x8){lo[0], lo[1], lo[2], lo[3], hi[0], hi[1], hi[2], hi[3]}; }
__device__ __forceinline__ bf16x8 row_frag(const LAS bf16* A, int ld, int k0, int lane) { return *(const LAS bf16x8*)(A + (lane & 15) * ld + k0 + (lane >> 4) * 8); }
__device__ __forceinline__ int seq_row(int b, int dir, int i) {
    const int tt = (i < CTX) ? (dir ? CTX - 1 - i : i) : CTX + (dir ? SEQ - 1 - (i - CTX) : (i - CTX));
    return b * T + tt; }

#define XB_TMO      128
#define XB_XCNT(j)  (256  + 64 * (j))
#define XB_XSUB(j)  (1280 + 64 * (j))
#define XB_XGEN(j)  (2304 + 64 * (j))
#define XB_TOP      3328
#define XB_TOPGEN   3392
#define XCD_BAR_WORDS 3456
#define XB_SPIN_CAP (1u << 18)

__device__ __forceinline__ unsigned xb_ld(unsigned* p)              { return __hip_atomic_load(p, __ATOMIC_RELAXED, __HIP_MEMORY_SCOPE_AGENT); }
__device__ __forceinline__ unsigned xb_add(unsigned* p, unsigned v) { return __hip_atomic_fetch_add(p, v, __ATOMIC_RELAXED, __HIP_MEMORY_SCOPE_AGENT); }
__device__ __forceinline__ unsigned xb_xcc_id() { return (unsigned)__builtin_amdgcn_s_getreg((3 << 11) | 20) & 0xFu; }
#define XB_SPIN(cond, bar) do { unsigned _sp = 0; while (cond) { __builtin_amdgcn_s_sleep(1); \
    if ((++_sp & 255u) == 0u) { if (xb_ld(&(bar)[XB_TMO])) break; if (_sp > XB_SPIN_CAP) { atomicAdd(&(bar)[XB_TMO], 1u); break; } } } } while (0)

struct XcdBarrier {
    unsigned* bar; unsigned x;
    volatile LAS unsigned* st;
};

__device__ __forceinline__ XcdBarrier xcd_barrier_post(unsigned* bar, volatile LAS unsigned* st) {
    XcdBarrier b; b.bar = bar; b.x = xb_xcc_id(); b.st = st;
    if (threadIdx.x == 0) (void)xb_add(&bar[XB_XCNT(b.x)], 1u);
    return b;
}
__device__ __forceinline__ void xcd_barrier_complete(unsigned* bar, unsigned x, unsigned& nloc, unsigned& nx) {
    const unsigned G = gridDim.x * gridDim.y * gridDim.z;
    unsigned sum, cnt, mine, sp = 0u;
    for (;;) {
        sum = 0u; cnt = 0u; mine = 0u;
#pragma unroll
        for (unsigned j = 0; j < 16; ++j) { const unsigned c = xb_ld(&bar[XB_XCNT(j)]); sum += c; cnt += (c > 0u) ? 1u : 0u; mine = (j == x) ? c : mine; }
        if (sum == G) break;
        __builtin_amdgcn_s_sleep(1);
        if ((++sp & 255u) == 0u) { if (xb_ld(&bar[XB_TMO])) break; if (sp > XB_SPIN_CAP) { atomicAdd(&bar[XB_TMO], 1u); break; } }
    }
    nloc = mine > 0u ? mine : 1u; nx = cnt > 0u ? cnt : 1u;
}

__device__ __forceinline__ void xcd_barrier(const XcdBarrier& b) {
    asm volatile("s_waitcnt vmcnt(0)" ::: "memory");
    __syncthreads();
    if (threadIdx.x == 0) {
        unsigned* bar = b.bar;
        __builtin_amdgcn_s_waitcnt(0);
        unsigned nloc = b.st[0], nx = b.st[1];
        if (nloc == 0u) { xcd_barrier_complete(bar, b.x, nloc, nx); b.st[0] = nloc; b.st[1] = nx; }
        const unsigned old = xb_add(&bar[XB_XSUB(b.x)], 1u);
        const unsigned gen = old / nloc;
        if (old + 1u == (gen + 1u) * nloc) {
            __builtin_amdgcn_fence(__ATOMIC_RELEASE, "agent");
            asm volatile("s_waitcnt vmcnt(0)" ::: "memory");
            const unsigned og = xb_add(&bar[XB_TOP], 1u);
            const unsigned tg = og / nx;
            if (og + 1u == (tg + 1u) * nx) xb_add(&bar[XB_TOPGEN], 1u);
            else XB_SPIN(xb_ld(&bar[XB_TOPGEN]) == tg, bar);
            __builtin_amdgcn_fence(__ATOMIC_ACQUIRE, "agent");
            xb_add(&bar[XB_XGEN(b.x)], 1u);
            asm volatile("s_waitcnt vmcnt(0)" ::: "memory");
        } else {
            XB_SPIN(xb_ld(&bar[XB_XGEN(b.x)]) == gen, bar);
            __builtin_amdgcn_fence(__ATOMIC_ACQUIRE, "agent");
            asm volatile("s_waitcnt vmcnt(0)" ::: "memory");
        }
    }
    __syncthreads();
}

struct Args { const float* in[42]; float* out; unsigned char* ws; unsigned char* wts; int ph_lo, ph_hi; };
struct Frame {
    LAS unsigned char* lds; GAS float* out; GAS unsigned char* ws; GAS unsigned char* W;
    int tid, lane, wave, bid, G;
};
constexpr int PTAB_OFF = MISC_OFF + 512;
__device__ __forceinline__ const GAS float* ldptr(const Frame& F, int i) { const unsigned long long v = ((const LAS unsigned long long*)(F.lds + PTAB_OFF))[i];
    const unsigned lo = __builtin_amdgcn_readfirstlane((unsigned)v), hi = __builtin_amdgcn_readfirstlane((unsigned)(v >> 32)); return (const GAS float*)(((unsigned long long)hi << 32) | lo); }
#define INP(i) ldptr(F, (i))
__device__ __forceinline__ Frame fresh(const Frame& F0) { Frame F = F0; int t; asm volatile("v_mbcnt_lo_u32_b32 %0, -1, 0\n\tv_mbcnt_hi_u32_b32 %0, -1, %0\n\tv_lshl_add_u32 %0, %1, 6, %0" : "=&v"(t) : "s"(F0.wave));     F.tid = t; F.lane = t & 63; F.wave = __builtin_amdgcn_readfirstlane(t >> 6);
    asm volatile("" : "+s"(F.bid), "+s"(F.G), "+s"(F.ws), "+s"(F.W), "+s"(F.out)); return F; }
enum { IN_X = 0, IN_C, IN_CTX, IN_CCTX, IN_ADAW, IN_ADAB, IN_NMIX, IN_NFFN, IN_NOUT, IN_ML_WIN, IN_ML_WGATE, IN_ML_BGATE, IN_ML_CONV, IN_ML_HEADG, IN_ML_WOUT,
       IN_RW_MU, IN_RW_WRKV, IN_RW_W0, IN_RW_W1, IN_RW_W2, IN_RW_A0, IN_RW_A1, IN_RW_A2, IN_RW_G1, IN_RW_G2, IN_RW_KK, IN_RW_KA, IN_RW_RK, IN_RW_LNW, IN_RW_LNB, IN_RW_WOUT,
       IN_HG_WIN, IN_HG_WF, IN_HG_BF, IN_HG_LB, IN_HG_HEADG, IN_HG_WOUT, IN_ROUTER_W, IN_ROUTER_B, IN_EX_W1, IN_EX_W3, IN_EX_W2 };

template <int MAP> __device__ __forceinline__ int rowmap(int n) { return MAP == 0 ? n : (MAP == 1 ? 8 * (n >> 2) + (n & 3) : 8 * (n >> 2) + 4 + (n & 3)); }
template <int MAP> __device__ __forceinline__ void tr_item(const GAS float* W, int ldw, int nblk, GAS bf16* WT, int ldd, int row_off, int k_off, const GAS float* kscale, LAS float* scr, int item, int lane) {
    const int kb = item / nblk, nb = item - kb * nblk, k0 = 64 * kb, n0 = 32 * nb;
#pragma unroll 8
    for (int i = 0; i < 32; ++i) { const int kk = 2 * i + (lane >> 5); float v = W[(size_t)(k0 + kk) * ldw + n0 + (lane & 31)]; if (kscale) v *= kscale[k0 + kk]; scr[kk * 33 + (lane & 31)] = v; }
    LDS_WAIT(); asm volatile("" ::: "memory");
    const int c = lane & 7;
#pragma unroll
    for (int j = 0; j < 4; ++j) { const int n = (lane >> 3) + 8 * j; const LAS float* s = scr + (8 * c) * 33 + n;
        u32x4 o; o.x = pk2(s[0 * 33], s[1 * 33]); o.y = pk2(s[2 * 33], s[3 * 33]); o.z = pk2(s[4 * 33], s[5 * 33]); o.w = pk2(s[6 * 33], s[7 * 33]);
        *(GAS u32x4*)(WT + (size_t)(row_off + rowmap<MAP>(n0 + n)) * ldd + k_off + k0 + 8 * c) = o; }
    LDS_WAIT(); asm volatile("" ::: "memory");
}
#define TRJOB(MAP, cnt, ...) if (r < (cnt)) { tr_item<MAP>(__VA_ARGS__, scr, r, F.lane); continue; } r -= (cnt);

PHASE_FN void pre_phase(Frame F) {
    LAS float* scr = (LAS float*)(F.lds + F.wave * 16384);
    const int gw = F.bid * NWAVES + F.wave, NGW = F.G * NWAVES;
    const size_t gt = (size_t)F.bid * NTHR + F.tid, NGT = (size_t)F.G * NTHR;
    GAS bf16* W = (GAS bf16*)F.W;
    constexpr int NITEMS = 2 * 2048 + 2 * 512 + 6 * 512 + 4 * 32 + 4 * 32 + 2 * 64 + 64 + 512 + 1536 + 2 * 512 + 512;
    for (int it = gw; it < NITEMS; it += NGW) {
        int r = it;
        TRJOB(0, 2048, INP(IN_ML_WIN), 4096, 128, (GAS bf16*)(F.W + W_ML_WIN), 1024, 0, 0, nullptr)
        TRJOB(0, 2048, INP(IN_ML_WIN) + (size_t)1024 * 4096, 4096, 128, (GAS bf16*)(F.W + W_ML_WIN + W_ML_WIN_SZ), 1024, 0, 0, nullptr)
        TRJOB(0, 512, INP(IN_ML_WOUT), 1024, 32, (GAS bf16*)(F.W + W_ML_WOUT), 1024, 0, 0, nullptr)
        TRJOB(0, 512, INP(IN_ML_WOUT) + (size_t)1024 * 1024, 1024, 32, (GAS bf16*)(F.W + W_ML_WOUT + 2 * MiB), 1024, 0, 0, nullptr)
        GAS bf16* RWIN = (GAS bf16*)(F.W + W_RW_IN); const GAS float* mu = INP(IN_RW_MU);
        if (r < 6 * 512) { const int idx = r / 1024, ps = (r / 512) & 1, rr = r & 511;
            tr_item<0>(INP(IN_RW_WRKV) + (size_t)idx * 1024 * 1024, 1024, 32, RWIN, 2048, idx * 1024, ps * 1024, ps ? mu + idx * 1024 : nullptr, scr, rr, F.lane); continue; } r -= 6 * 512;
        if (r < 4 * 32) { const int dir = r / 64, ps = (r / 32) & 1, rr = r & 31;
            tr_item<0>(INP(IN_RW_W1) + (size_t)dir * 1024 * 64, 64, 2, RWIN, 2048, 3072 + dir * 64, ps * 1024, ps ? mu + 3 * 1024 : nullptr, scr, rr, F.lane); continue; } r -= 4 * 32;
        if (r < 4 * 32) { const int dir = r / 64, ps = (r / 32) & 1, rr = r & 31;
            tr_item<0>(INP(IN_RW_A1) + (size_t)dir * 1024 * 64, 64, 2, RWIN, 2048, 3200 + dir * 64, ps * 1024, ps ? mu + 4 * 1024 : nullptr, scr, rr, F.lane); continue; } r -= 4 * 32;
        if (r < 2 * 64) { const int ps = r / 64, rr = r & 63;
            tr_item<0>(INP(IN_RW_G1), 128, 4, RWIN, 2048, 3328, ps * 1024, ps ? mu + 5 * 1024 : nullptr, scr, rr, F.lane); continue; } r -= 2 * 64;
        TRJOB(0, 64, INP(IN_RW_G2), 1024, 32, (GAS bf16*)(F.W + W_RW_G2), 256, 0, 0, nullptr)
        TRJOB(0, 512, INP(IN_RW_WOUT), 1024, 32, (GAS bf16*)(F.W + W_RW_WOUT), 1024, 0, 0, nullptr)
        TRJOB(0, 1536, INP(IN_HG_WIN), 3072, 96, (GAS bf16*)(F.W + W_HG_IN), 1024, 0, 0, nullptr)
        TRJOB(0, 512, INP(IN_HG_WF), 1024, 32, (GAS bf16*)(F.W + W_HG_IN), 1024, 3072, 0, nullptr)
        TRJOB(0, 512, INP(IN_HG_WF) + (size_t)1024 * 1024, 1024, 32, (GAS bf16*)(F.W + W_HG_IN), 1024, 4096, 0, nullptr)
        TRJOB(0, 512, INP(IN_HG_WOUT), 1024, 32, (GAS bf16*)(F.W + W_HG_WOUT), 1024, 0, 0, nullptr)
    }
    for (size_t i = gt; i < (size_t)2 * 256 * 1024; i += NGT) { const int j = (int)(i >> 18), rr = (int)((i >> 10) & 255), k = (int)(i & 1023);
        float v = 0.f; if (rr < 32) { const int dir = rr >> 4, g = rr & 15; v = INP(IN_ML_WGATE)[((size_t)(j * 2 + dir) * 1024 + k) * 16 + g]; }
        ((GAS bf16*)(F.W + W_ML_WIN + j * W_ML_WIN_SZ))[(size_t)(4096 + rr) * 1024 + k] = (bf16)f2bf(v); }
    for (size_t i = gt; i < (size_t)128 * 2048; i += NGT) ((GAS bf16*)(F.W + W_RW_IN))[(size_t)3456 * 2048 + i] = 0;
    for (size_t i = gt; i < (size_t)1024 * 128; i += NGT) ((GAS bf16*)(F.W + W_RW_G2))[(i >> 7) * 256 + 128 + (i & 127)] = 0;
    if (F.bid == 0) for (int c = F.tid; c < 1024; c += NTHR) { const GAS float* lg = INP(IN_HG_LB) + c; const float l0 = lg[0], l1 = lg[1024], l2 = lg[2048], l3 = lg[3072];
        const float mx = fmaxf(fmaxf(l0, l1), fmaxf(l2, l3)); const float e0 = __expf(l0 - mx), e1 = __expf(l1 - mx), e2 = __expf(l2 - mx), e3 = __expf(l3 - mx);
        ((GAS float*)(F.ws + WS_LB))[c] = (e1 + e2) / (e0 + e1 + e2 + e3); }
    { GAS f32x4* S4 = (GAS f32x4*)(F.ws + WS_S);
      for (size_t i = gt; i < (size_t)NTOK * 256; i += NGT) { const int m = (int)(i >> 8), c4 = (int)(i & 255); const int b = m / T, t = m - b * T;
          const GAS float* src = (t < CTX) ? INP(IN_CTX) + ((size_t)(b * CTX + t)) * 1024 : INP(IN_X) + ((size_t)(b * SEQ + t - CTX)) * 1024;
          S4[i] = ((const GAS f32x4*)src)[c4]; } }
    { LAS float* sc = (LAS float*)(F.lds + 8448); GAS float* MODP = (GAS float*)(F.ws + WS_MIX);
      for (int it = F.bid; it < 768; it += F.G) { const int i = it / 192, rem = it - i * 192, kc = rem / 12, jb = rem - kc * 12;
          __syncthreads();
          if (F.tid < 320) { const int seg = F.tid >> 6, kk = F.tid & 63; const float cv = seg == 0 ? INP(IN_CCTX)[kc * 64 + kk] : INP(IN_C)[(seg - 1) * 1024 + kc * 64 + kk]; sc[F.tid] = silu_f(cv); }
          __syncthreads();
          const int j = jb * 512 + F.tid; const GAS float* wp = INP(IN_ADAW) + ((size_t)i * 1024 + kc * 64) * 6144 + j;
          float a0 = 0.f, a1 = 0.f, a2 = 0.f, a3 = 0.f, a4 = 0.f;
#pragma unroll 8
          for (int kk = 0; kk < 64; ++kk) { const float w = wp[(size_t)kk * 6144]; a0 += sc[kk] * w; a1 += sc[64 + kk] * w; a2 += sc[128 + kk] * w; a3 += sc[192 + kk] * w; a4 += sc[256 + kk] * w; }
          GAS float* mp = MODP + ((size_t)kc * 4 + i) * 5 * 6144 + j;
          mp[0] = a0; mp[6144] = a1; mp[2 * 6144] = a2; mp[3 * 6144] = a3; mp[4 * 6144] = a4; } }
}
PHASE_FN void modsum_phase(Frame F) {
    const GAS float* MODP = (const GAS float*)(F.ws + WS_MIX); GAS float* MOD = (GAS float*)(F.ws + WS_MOD);
    for (int idx = F.bid * NTHR + F.tid; idx < 4 * 5 * 6144; idx += F.G * NTHR) { const int i = idx / (5 * 6144), j = idx % 6144;
        float a = INP(IN_ADAB)[i * 6144 + j];
#pragma unroll
        for (int kc = 0; kc < 16; ++kc) a += MODP[(size_t)kc * 4 * 5 * 6144 + idx];
        MOD[idx] = a; }
}
struct ExwItem { const GAS float* src; GAS bf16* dst; int ldw, ldd, map; };
__device__ __forceinline__ ExwItem exw_item(const Frame& F, const GAS float* w1, const GAS float* w3, const GAS float* w2, int it) {
    const int which = it >> 12, e = (it >> 8) & 15, rr = it & 255; ExwItem x;
    if (which < 2) { const int kb = rr >> 4, nb = rr & 15; x.src = (which ? w3 : w1) + (size_t)e * 1024 * 512 + (size_t)(64 * kb) * 512 + 32 * nb; x.ldw = 512; x.ldd = 1024; x.map = which + 1;
        x.dst = (GAS bf16*)(F.W + W_EX13) + (size_t)(e * 1024 + 2 * (32 * nb)) * 1024 + 64 * kb; }
    else { const int kb = rr >> 5, nb = rr & 31; x.src = w2 + (size_t)e * 512 * 1024 + (size_t)(64 * kb) * 1024 + 32 * nb; x.ldw = 1024; x.ldd = 512; x.map = 0;
        x.dst = (GAS bf16*)(F.W + W_EX2) + (size_t)(e * 1024 + 32 * nb) * 512 + 64 * kb; }
    return x; }
PHASE_FN void expert_weights(Frame F, int L) {
    LAS float* scr = (LAS float*)(F.lds + F.wave * 16384);
    const int gw = F.bid * NWAVES + F.wave, NGW = F.G * NWAVES, lane = F.lane;
    const GAS float* w1 = INP(IN_EX_W1) + (size_t)L * 16 * 1024 * 512; const GAS float* w3 = INP(IN_EX_W3) + (size_t)L * 16 * 1024 * 512; const GAS float* w2 = INP(IN_EX_W2) + (size_t)L * 16 * 512 * 1024;
    const int lk = lane >> 3, ln = (lane & 7) * 4;
    f32x4 v[8]; int it = gw;
    if (it < 3 * 4096) { const ExwItem x = exw_item(F, w1, w3, w2, it);
#pragma unroll
        for (int i = 0; i < 8; ++i) v[i] = *(const GAS f32x4*)(x.src + (size_t)(lk + 8 * i) * x.ldw + ln); }
    for (; it < 3 * 4096; it += NGW) {
        const ExwItem x = exw_item(F, w1, w3, w2, it);
#pragma unroll
        for (int i = 0; i < 8; ++i) { LAS float* d = scr + (lk + 8 * i) * 33 + ln; d[0] = v[i][0]; d[1] = v[i][1]; d[2] = v[i][2]; d[3] = v[i][3]; }
        if (it + NGW < 3 * 4096) { const ExwItem y = exw_item(F, w1, w3, w2, it + NGW);
#pragma unroll
            for (int i = 0; i < 8; ++i) v[i] = *(const GAS f32x4*)(y.src + (size_t)(lk + 8 * i) * y.ldw + ln); }
        LDS_WAIT(); asm volatile("" ::: "memory");
        const int c = lane & 7;
#pragma unroll
        for (int j = 0; j < 4; ++j) { const int n = (lane >> 3) + 8 * j; const LAS float* s_ = scr + (8 * c) * 33 + n;
            u32x4 o; o.x = pk2(s_[0 * 33], s_[1 * 33]); o.y = pk2(s_[2 * 33], s_[3 * 33]); o.z = pk2(s_[4 * 33], s_[5 * 33]); o.w = pk2(s_[6 * 33], s_[7 * 33]);
            const int drow = x.map == 0 ? n : 2 * (n & ~3) + (n & 3) + (x.map == 2 ? 4 : 0);
            *(GAS u32x4*)(x.dst + (size_t)drow * x.ldd + 8 * c) = o; }
        LDS_WAIT(); asm volatile("" ::: "memory");
    }
}

template <int MODE, int PRB = 0> PHASE_FN void norm_phase(Frame F, int L, bool add_moe, int ldh) {
    GAS float* S = (GAS float*)(F.ws + WS_S); GAS bf16* H = (GAS bf16*)(F.ws + WS_HY); const GAS bf16* YM = (const GAS bf16*)(F.ws + WS_MIX + 210 * MiB);
    const GAS float* MOD = (const GAS float*)(F.ws + WS_MOD);
    const int gw = F.bid * NWAVES + F.wave, NGW = F.G * NWAVES, lane = F.lane;
    LAS float* rwl = (LAS float*)F.lds;
    LAS int* cntl = (LAS int*)(F.lds + 65536);
    if (MODE == 1) {
        for (int i = F.tid; i < 16384; i += NTHR) { const int c = i >> 4, e = i & 15; rwl[e * 1024 + c] = INP(IN_ROUTER_W)[i]; }
        if (F.tid < 16) cntl[F.tid] = 0;
        __syncthreads();
    }
    const GAS float* gnp = MODE == 0 ? INP(IN_NMIX) + L * 1024 : (MODE == 1 ? INP(IN_NFFN) + L * 1024 : INP(IN_NOUT));
    for (int m = gw; m < NTOK; m += NGW) {
        const int b = m / T, t = m - b * T, seg = t < CTX ? 0 : 1 + b;
        if (MODE == 2 && t < CTX) continue;
        f32x4 v[4]; GAS f32x4* sp = (GAS f32x4*)(S + (size_t)m * 1024) + lane;
#pragma unroll
        for (int j = 0; j < 4; ++j) v[j] = sp[64 * j];
        if (add_moe) {
            const GAS float* gp = MOD + ((size_t)((MODE == 2 ? 3 : L - 1) * 5 + seg)) * 6144 + 5 * 1024;
            const GAS u32x2* ya = (const GAS u32x2*)(YM + (size_t)(2 * m) * 1024) + lane; const GAS u32x2* yb = ya + 256;
#pragma unroll
            for (int j = 0; j < 4; ++j) { const u32x2 a = ya[64 * j], bq = yb[64 * j]; const f32x4 g = ((const GAS f32x4*)gp)[lane + 64 * j];
                v[j][0] += g[0] * (bflo(a.x) + bflo(bq.x)); v[j][1] += g[1] * (bfhi(a.x) + bfhi(bq.x)); v[j][2] += g[2] * (bflo(a.y) + bflo(bq.y)); v[j][3] += g[3] * (bfhi(a.y) + bfhi(bq.y)); }
            if (MODE != 2 && !PRB) {
#pragma unroll
                for (int j = 0; j < 4; ++j) sp[64 * j] = v[j]; }
        }
        float ss = 0.f;
#pragma unroll
        for (int j = 0; j < 4; ++j) ss += (v[j][0] * v[j][0] + v[j][1] * v[j][1]) + (v[j][2] * v[j][2] + v[j][3] * v[j][3]);
        const float rinv = 1.0f / sqrtf(wave_sum(ss) * (1.0f / 1024.0f) + 1e-6f);
        if (MODE == 2) { GAS f32x4* op = (GAS f32x4*)(F.out + ((size_t)(b * SEQ + t - CTX)) * 1024) + lane;
#pragma unroll
            for (int j = 0; j < 4; ++j) { const f32x4 g = ((const GAS f32x4*)gnp)[lane + 64 * j]; op[64 * j] = v[j] * rinv * g; }
            continue; }
        const GAS float* mp = MOD + ((size_t)(L * 5 + seg)) * 6144 + (MODE == 0 ? 0 : 3 * 1024);
        f32x4 h[4];
#pragma unroll
        for (int j = 0; j < 4; ++j) { const f32x4 g = ((const GAS f32x4*)gnp)[lane + 64 * j], sh = ((const GAS f32x4*)mp)[lane + 64 * j], sc = ((const GAS f32x4*)(mp + 1024))[lane + 64 * j];
            h[j] = v[j] * rinv * g * (sc + 1.0f) + sh;
            u32x2 o; o.x = pk2(h[j][0], h[j][1]); o.y = pk2(h[j][2], h[j][3]); *((GAS u32x2*)(H + (size_t)m * ldh) + lane + 64 * j) = o; }
        if (MODE == 1) {
            float lg[16];
#pragma unroll
            for (int e = 0; e < 16; ++e) { float a = 0.f;
#pragma unroll
                for (int j = 0; j < 4; ++j) { const f32x4 w = *(const LAS f32x4*)(rwl + e * 1024 + 256 * j + 4 * lane); a += (h[j][0] * w[0] + h[j][1] * w[1]) + (h[j][2] * w[2] + h[j][3] * w[3]); }
                lg[e] = wave_sum(a); }
            float aff[16], sel[16];
#pragma unroll
            for (int e = 0; e < 16; ++e) { aff[e] = sigmoid_f(lg[e]); sel[e] = aff[e] + INP(IN_ROUTER_B)[e]; }
            float best = -3.0e38f; int bg = 0; float s0 = 0.f, s1 = 0.f, s2 = 0.f, s3 = 0.f, a0 = 0.f, a1 = 0.f, a2 = 0.f, a3 = 0.f;
#pragma unroll
            for (int g = 0; g < 4; ++g) { const float x0 = sel[4 * g], x1 = sel[4 * g + 1], x2 = sel[4 * g + 2], x3 = sel[4 * g + 3];
                const float t1 = fmaxf(x0, x1), t2 = fminf(x0, x1), u1 = fmaxf(x2, x3), u2 = fminf(x2, x3);
                const float sum = fmaxf(t1, u1) + fmaxf(fminf(t1, u1), fmaxf(t2, u2));
                const bool bt = sum > best; best = bt ? sum : best; bg = bt ? g : bg;
                s0 = bt ? x0 : s0; s1 = bt ? x1 : s1; s2 = bt ? x2 : s2; s3 = bt ? x3 : s3;
                a0 = bt ? aff[4 * g] : a0; a1 = bt ? aff[4 * g + 1] : a1; a2 = bt ? aff[4 * g + 2] : a2; a3 = bt ? aff[4 * g + 3] : a3; }
            int i1 = 0; float m1 = s0; if (s1 > m1) { m1 = s1; i1 = 1; } if (s2 > m1) { m1 = s2; i1 = 2; } if (s3 > m1) { m1 = s3; i1 = 3; }
            int i2 = -1; float m2 = -3.0e38f;
            if (i1 != 0 && s0 > m2) { m2 = s0; i2 = 0; } if (i1 != 1 && s1 > m2) { m2 = s1; i2 = 1; } if (i1 != 2 && s2 > m2) { m2 = s2; i2 = 2; } if (i1 != 3 && s3 > m2) { m2 = s3; i2 = 3; }
            const float c1 = i1 == 0 ? a0 : (i1 == 1 ? a1 : (i1 == 2 ? a2 : a3)), c2 = i2 == 0 ? a0 : (i2 == 1 ? a1 : (i2 == 2 ? a2 : a3));
            const float inv = 1.0f / (c1 + c2);
            if (lane == 0) { const int e1 = bg * 4 + i1, e2 = bg * 4 + i2;
                u32x4 tk; tk.x = (unsigned)e1; tk.y = (unsigned)e2; tk.z = __float_as_uint(c1 * inv); tk.w = __float_as_uint(c2 * inv); ((GAS u32x4*)(F.ws + WS_TOK))[m] = tk;
                __hip_atomic_fetch_add(cntl + e1, 1, __ATOMIC_RELAXED, __HIP_MEMORY_SCOPE_WORKGROUP); __hip_atomic_fetch_add(cntl + e2, 1, __ATOMIC_RELAXED, __HIP_MEMORY_SCOPE_WORKGROUP); }
        }
    }
    if (MODE == 1) { __syncthreads(); if (F.tid < 16) __hip_atomic_fetch_add((GAS unsigned*)F.ws + CW_MOE + L * 2048 + (PRB ? 512 : 0) + 64 * F.tid, (unsigned)cntl[F.tid], __ATOMIC_RELAXED, __HIP_MEMORY_SCOPE_AGENT); }
}

__device__ __forceinline__ void moe_prefix(const Frame& F, int L, LAS int* pref  , LAS int* cnt  ) {
    if (F.tid < 16) cnt[F.tid] = (int)__hip_atomic_load((GAS unsigned*)F.ws + CW_MOE + L * 2048 + 64 * F.tid, __ATOMIC_RELAXED, __HIP_MEMORY_SCOPE_AGENT);
    __syncthreads();
    if (F.tid == 0) { int p = 0; for (int e = 0; e < 16; ++e) { pref[e] = p; p += (cnt[e] + 255) >> 8; } pref[16] = p; }
    __syncthreads();
}
template <int PRB = 0> PHASE_FN void slots_phase(Frame F, int L) {
    LAS int* pref = (LAS int*)F.lds; LAS int* cnt = pref + 32;
    moe_prefix(F, L, pref, cnt);
    const int gw = F.bid * NWAVES + F.wave, NGW = F.G * NWAVES, lane = F.lane;
    GAS unsigned* cursor = (GAS unsigned*)F.ws + CW_MOE + L * 2048 + 1024 + (PRB ? 32 : 0);
    GAS int* slot_tok = (GAS int*)(F.ws + WS_SLOT_TOK); GAS float* slot_gate = (GAS float*)(F.ws + WS_SLOT_GATE);
    for (int it = gw; it < NTOK / 64; it += NGW) {
        const int m = it * 64 + lane; const u32x4 tk = ((const GAS u32x4*)(F.ws + WS_TOK))[m];
#pragma unroll
        for (int k = 0; k < 2; ++k) { const int e = (int)(k ? tk.y : tk.x); int slot = 0;
            for (int ee = 0; ee < 16; ++ee) { const unsigned long long mask = __ballot(e == ee);
                if (mask) { const int n = __popcll(mask); unsigned base = 0; if (lane == 0) base = __hip_atomic_fetch_add(cursor + 64 * ee, (unsigned)n, __ATOMIC_RELAXED, __HIP_MEMORY_SCOPE_AGENT); base = __builtin_amdgcn_readfirstlane(base);
                    if (e == ee) slot = pref[ee] * 256 + (int)base + __popcll(mask & ((1ull << lane) - 1ull)); } }
            slot_tok[slot] = 2 * m + k; slot_gate[slot] = __uint_as_float(k ? tk.w : tk.z); }
    }
    for (int e = 0; e < 16; ++e) { const int lo = pref[e] * 256 + cnt[e], hi = pref[e + 1] * 256;
        for (int s_ = lo + gw * 64 + lane; s_ < hi; s_ += NGW * 64) { slot_tok[s_] = -1; slot_gate[s_] = 0.f; } }
}

PHASE_FN void du_phase(Frame F) {
    GAS bf16* H2 = (GAS bf16*)(F.ws + WS_HY);
    const size_t gt = (size_t)F.bid * NTHR + F.tid, NGT = (size_t)F.G * NTHR;
    for (size_t i = gt; i < (size_t)NTOK * 128; i += NGT) { const int m = (int)(i >> 7), c8 = (int)(i & 127); const int t = m % T;
        const bool hp = !(t == 0 || t == CTX), hn = !(t == CTX - 1 || t == T - 1);
        const u32x4 z = {0u, 0u, 0u, 0u};
        const u32x4 u = *(const GAS u32x4*)(H2 + (size_t)m * 2048 + c8 * 8), p = hp ? *(const GAS u32x4*)(H2 + (size_t)(m - 1) * 2048 + c8 * 8) : z, n = hn ? *(const GAS u32x4*)(H2 + (size_t)(m + 1) * 2048 + c8 * 8) : z;
        u32x4 o;
#pragma unroll
        for (int j = 0; j < 4; ++j) o[j] = pk2(0.5f * (bflo(p[j]) + bflo(n[j])) - bflo(u[j]), 0.5f * (bfhi(p[j]) + bfhi(n[j])) - bfhi(u[j]));
        *(GAS u32x4*)(H2 + (size_t)m * 2048 + 1024 + c8 * 8) = o; }
}

PHASE_FN void conv_phase(Frame F, int j) {
    const GAS bf16* QP = (const GAS bf16*)(F.ws + WS_MIX); GAS bf16* QK = (GAS bf16*)(F.ws + WS_HY); const GAS float* cw = INP(IN_ML_CONV) + (size_t)j * 9 * 2048;
    const size_t gt = (size_t)F.bid * NTHR + F.tid, NGT = (size_t)F.G * NTHR;
    for (size_t i = gt; i < (size_t)NTOK * 256; i += NGT) { const int m = (int)(i >> 8), c = (int)(i & 255) * 8; const int t = m % T;
        float acc[8];
#pragma unroll
        for (int q = 0; q < 8; ++q) acc[q] = 0.f;
        const int p = t - CTX, gr = p >> 6, gc = p & 63;
#pragma unroll
        for (int dr = 0; dr < 3; ++dr)
#pragma unroll
            for (int dw = 0; dw < 3; ++dw) {
                bool ok; int mm;
                if (t < CTX) { ok = (dr == 1) && (t + dw - 1 >= 0) && (t + dw - 1 < CTX); mm = m + dw - 1; }
                else { ok = (gr + dr - 1 >= 0) && (gr + dr - 1 < 128) && (gc + dw - 1 >= 0) && (gc + dw - 1 < 64); mm = m + (dr - 1) * 64 + (dw - 1); }
                if (ok) { const u32x4 x = *(const GAS u32x4*)(QP + (size_t)mm * 2048 + c); const f32x4 w0 = *(const GAS f32x4*)(cw + (dr * 3 + dw) * 2048 + c), w1 = *(const GAS f32x4*)(cw + (dr * 3 + dw) * 2048 + c + 4);
                    acc[0] += bflo(x[0]) * w0[0]; acc[1] += bfhi(x[0]) * w0[1]; acc[2] += bflo(x[1]) * w0[2]; acc[3] += bfhi(x[1]) * w0[3];
                    acc[4] += bflo(x[2]) * w1[0]; acc[5] += bfhi(x[2]) * w1[1]; acc[6] += bflo(x[3]) * w1[2]; acc[7] += bfhi(x[3]) * w1[3]; } }
        const float sc = c >= 1024 ? 0.08838834764831845f : 1.0f;
        u32x4 o;
#pragma unroll
        for (int q = 0; q < 4; ++q) o[q] = pk2(silu_f(acc[2 * q]) * sc, silu_f(acc[2 * q + 1]) * sc);
        *(GAS u32x4*)(QK + (size_t)m * 2048 + c) = o; }
}

PHASE_FN void headnorm_phase(Frame F, const GAS bf16* HSf, const GAS bf16* HSb, const GAS bf16* OG, const GAS float* hg, GAS bf16* Y) {
    const int gw = F.bid * NWAVES + F.wave, NGW = F.G * NWAVES, lane = F.lane;
    for (int m = gw; m < NTOK; m += NGW) { const size_t off = (size_t)m * 1024 + lane * 16;
        float x[16]; float ss = 0.f;
#pragma unroll
        for (int hlf = 0; hlf < 2; ++hlf) { const u32x4 a = *(const GAS u32x4*)(HSf + off + 8 * hlf), bq = *(const GAS u32x4*)(HSb + off + 8 * hlf);
#pragma unroll
            for (int q = 0; q < 4; ++q) { x[8 * hlf + 2 * q] = bflo(a[q]) + bflo(bq[q]); x[8 * hlf + 2 * q + 1] = bfhi(a[q]) + bfhi(bq[q]); } }
#pragma unroll
        for (int q = 0; q < 16; ++q) ss += x[q] * x[q];
        ss += __shfl_xor(ss, 1); ss += __shfl_xor(ss, 2); ss += __shfl_xor(ss, 4);
        const float rinv = 1.0f / sqrtf(ss * (1.0f / 128.0f) + 1e-6f);
#pragma unroll
        for (int hlf = 0; hlf < 2; ++hlf) { const u32x4 g = *(const GAS u32x4*)(OG + off + 8 * hlf); const f32x4 h0 = *(const GAS f32x4*)(hg + lane * 16 + 8 * hlf), h1 = *(const GAS f32x4*)(hg + lane * 16 + 8 * hlf + 4);
            u32x4 o;
            o[0] = pk2(x[8 * hlf + 0] * rinv * h0[0] * bflo(g[0]), x[8 * hlf + 1] * rinv * h0[1] * bfhi(g[0])); o[1] = pk2(x[8 * hlf + 2] * rinv * h0[2] * bflo(g[1]), x[8 * hlf + 3] * rinv * h0[3] * bfhi(g[1]));
            o[2] = pk2(x[8 * hlf + 4] * rinv * h1[0] * bflo(g[2]), x[8 * hlf + 5] * rinv * h1[1] * bfhi(g[2])); o[3] = pk2(x[8 * hlf + 6] * rinv * h1[2] * bflo(g[3]), x[8 * hlf + 7] * rinv * h1[3] * bfhi(g[3]));
            *(GAS u32x4*)(Y + off + 8 * hlf) = o; } }
}
PHASE_FN void rwpost_phase(Frame F, const GAS bf16* Of, const GAS bf16* Ob, const GAS float* BETA, const GAS bf16* V, const GAS bf16* Gt, GAS bf16* Y) {
    const int gw = F.bid * NWAVES + F.wave, NGW = F.G * NWAVES, lane = F.lane;
    const GAS float* lnw = INP(IN_RW_LNW); const GAS float* lnb = INP(IN_RW_LNB);
    for (int m = gw; m < NTOK; m += NGW) { const size_t off = (size_t)m * 1024 + lane * 16;
        float x[16]; float s = 0.f;
#pragma unroll
        for (int hlf = 0; hlf < 2; ++hlf) { const u32x4 a = *(const GAS u32x4*)(Of + off + 8 * hlf), bq = *(const GAS u32x4*)(Ob + off + 8 * hlf);
#pragma unroll
            for (int q = 0; q < 4; ++q) { x[8 * hlf + 2 * q] = bflo(a[q]) + bflo(bq[q]); x[8 * hlf + 2 * q + 1] = bfhi(a[q]) + bfhi(bq[q]); } }
#pragma unroll
        for (int q = 0; q < 16; ++q) s += x[q];
        s += __shfl_xor(s, 1); s += __shfl_xor(s, 2);
        const float mean = s * (1.0f / 64.0f); float vs = 0.f;
#pragma unroll
        for (int q = 0; q < 16; ++q) { x[q] -= mean; vs += x[q] * x[q]; }
        vs += __shfl_xor(vs, 1); vs += __shfl_xor(vs, 2);
        const float rinv = 1.0f / sqrtf(vs * (1.0f / 64.0f) + 64e-5f);
        const int hd = lane >> 2; const float beta = BETA[(size_t)m * 16 + hd] + BETA[((size_t)NTOK + m) * 16 + hd];
#pragma unroll
        for (int hlf = 0; hlf < 2; ++hlf) { const u32x4 vv = *(const GAS u32x4*)(V + off + 8 * hlf), gg = *(const GAS u32x4*)(Gt + off + 8 * hlf);
            const f32x4 w0 = *(const GAS f32x4*)(lnw + lane * 16 + 8 * hlf), w1 = *(const GAS f32x4*)(lnw + lane * 16 + 8 * hlf + 4), b0 = *(const GAS f32x4*)(lnb + lane * 16 + 8 * hlf), b1 = *(const GAS f32x4*)(lnb + lane * 16 + 8 * hlf + 4);
            float y[8];
#pragma unroll
            for (int q = 0; q < 4; ++q) { y[q] = x[8 * hlf + q] * rinv * w0[q] + b0[q]; y[4 + q] = x[8 * hlf + 4 + q] * rinv * w1[q] + b1[q]; }
            u32x4 o;
#pragma unroll
            for (int q = 0; q < 4; ++q) o[q] = pk2((y[2 * q] + beta * bflo(vv[q])) * bflo(gg[q]), (y[2 * q + 1] + beta * bfhi(vv[q])) * bfhi(gg[q]));
            *(GAS u32x4*)(Y + off + 8 * hlf) = o; } }
}

__device__ __forceinline__ void group_barrier(LAS unsigned* ctr, unsigned target, int lane) {
    LDS_WAIT();
    if (lane == 0) __hip_atomic_fetch_add(ctr, 1u, __ATOMIC_RELAXED, __HIP_MEMORY_SCOPE_WORKGROUP);
    while ((unsigned)__builtin_amdgcn_readfirstlane((int)__hip_atomic_load(ctr, __ATOMIC_RELAXED, __HIP_MEMORY_SCOPE_WORKGROUP)) < target) __builtin_amdgcn_s_sleep(1);
    asm volatile("" ::: "memory");
}
template <int PROBE> PHASE_FN void ml_scan_phase(Frame F, const GAS bf16* QK, const GAS bf16* V, const GAS float* GATES, GAS bf16* HS) {
    constexpr int OFF_Q = 0, OFF_K = 17408, OFF_V = 34816, OFF_VW = 40960, OFF_WKR = 46080, INB = 48384;
    constexpr int O_SS = 2 * INB, O_CS = O_SS + 2 * 9216, O_HO = O_CS + 2 * 13056, O_SC = O_HO + 2 * 5120, O_CTR = O_SC + 3 * 1344;
    LAS float* SCb = (LAS float*)(F.lds + O_SC);
    LAS unsigned* actr = (LAS unsigned*)(F.lds + O_CTR);
    const int tid = F.tid, lane = F.lane, w = F.wave, r = lane & 15, q = lane >> 4;
    constexpr int NCH = T / 64;
    for (int unit = F.bid; unit < 256; unit += F.G) {
        const int un = (F.G == 256) ? ((((unit & 7) * 8 + (unit >> 5)) << 2) | ((unit >> 3) & 3)) : unit;
        const int vs = un & 3, dir = (un >> 2) & 1, h = (un >> 3) & 7, b = un >> 6;
        __syncthreads();
        for (int i = tid; i < (O_CTR + 16) / 4; i += NTHR) ((LAS unsigned*)F.lds)[i] = 0u;
        __syncthreads();
        if (tid < 128) ((LAS bf16*)(F.lds + (tid >> 6) * INB + OFF_V))[(tid & 63) * 48 + 32] = (bf16)0x3f80;
        __syncthreads();
        if (w >= 4) {
            const int a = w - 4, ptid = tid - 256, lrow = ptid >> 2, lp = ptid & 3; unsigned abar = 0;
            float m_run = 0.f; u32x4 rq[4], rk[4], rv; float rig = 0.f, rlf = 0.f;
#define ML_LOAD(cc) do { const int row_ = seq_row(b, dir, (cc) * 64 + lrow); const GAS bf16* qp_ = QK + (size_t)row_ * 2048 + h * 128; \
                _Pragma("unroll") for (int j_ = 0; j_ < 4; ++j_) { rq[j_] = *(const GAS u32x4*)(qp_ + 8 * (lp + 4 * j_)); rk[j_] = *(const GAS u32x4*)(qp_ + 1024 + 8 * (lp + 4 * j_)); } \
                rv = *(const GAS u32x4*)(V + (size_t)row_ * 1024 + h * 128 + vs * 32 + 8 * lp); } while (0)
#define ML_GLOAD(cc) do { const int grow_ = seq_row(b, dir, (cc) * 64 + lane); rig = GATES[(size_t)grow_ * 32 + dir * 16 + h]; rlf = GATES[(size_t)grow_ * 32 + dir * 16 + 8 + h]; } while (0)
#define ML_SCALARS(cc) do { const float lf_ = logsigmoid_f(rlf); const float bc_ = wave_scan_add(lf_); const float u_ = rig - bc_; const float pm_ = wave_scan_max(u_); \
                const float cc_ = fmaxf(m_run, pm_), blast_ = lane63(bc_), pmall_ = lane63(pm_), mnew_ = blast_ + fmaxf(m_run, pmall_); LAS float* sc_ = SCb + ((cc) % 3) * 336; \
                sc_[lane] = u_; sc_[64 + lane] = cc_; sc_[128 + lane] = __expf(m_run - cc_); sc_[192 + lane] = __expf(-(bc_ + cc_)); sc_[256 + lane] = __expf(blast_ + u_ - mnew_); \
                if (lane == 0) sc_[320] = __expf(blast_ + m_run - mnew_); m_run = mnew_; } while (0)
#define ML_STAGE(cc) do { LAS unsigned char* ib_ = F.lds + ((cc) & 1) * INB; const LAS float* sc_ = SCb + ((cc) % 3) * 336; \
                _Pragma("unroll") for (int j_ = 0; j_ < 4; ++j_) { *(LAS u32x4*)((LAS bf16*)(ib_ + OFF_Q) + lrow * 136 + 8 * (lp + 4 * j_)) = rq[j_]; *(LAS u32x4*)((LAS bf16*)(ib_ + OFF_K) + lrow * 136 + 8 * (lp + 4 * j_)) = rk[j_]; } \
                const float wk_ = sc_[256 + lrow]; u32x4 vw_; _Pragma("unroll") for (int j_ = 0; j_ < 4; ++j_) vw_[j_] = pk2(bflo(rv[j_]) * wk_, bfhi(rv[j_]) * wk_); \
                *(LAS u32x4*)((LAS bf16*)(ib_ + OFF_V) + lrow * 48 + 8 * lp) = rv; *(LAS u32x4*)((LAS bf16*)(ib_ + OFF_VW) + lrow * 40 + 8 * lp) = vw_; \
                if (ptid < 64) ((LAS bf16*)(ib_ + OFF_WKR))[ptid] = (bf16)f2bf(sc_[256 + ptid]); } while (0)
#define ML_STILE(cc, ti_, sj_) do { const LAS unsigned char* ib_ = F.lds + ((cc) & 1) * INB; const LAS float* sc_ = SCb + ((cc) % 3) * 336; LAS bf16* ss_ = (LAS bf16*)(F.lds + O_SS + ((cc) & 1) * 9216); \
                f32x4 acc_ = {0.f, 0.f, 0.f, 0.f}; acc_ = mm16<128>(acc_, (const LAS bf16*)(ib_ + OFF_Q) + 16 * (ti_) * 136, 136, (const LAS bf16*)(ib_ + OFF_K) + 16 * (sj_) * 136, 136, lane); \
                const int s_ = 16 * (sj_) + r; const float us_ = sc_[s_]; \
                _Pragma("unroll") for (int i_ = 0; i_ < 4; ++i_) { const int t_ = 16 * (ti_) + 4 * q + i_; ss_[t_ * 72 + s_] = (bf16)f2bf((s_ <= t_) ? acc_[i_] * __expf(us_ - sc_[64 + t_]) : 0.f); } } while (0)
#define ML_STILES(cc) do { if (a == 0) { ML_STILE(cc, 3, 0); ML_STILE(cc, 3, 1); ML_STILE(cc, 0, 0); } else if (a == 1) { ML_STILE(cc, 3, 2); ML_STILE(cc, 3, 3); ML_STILE(cc, 1, 0); } \
                else if (a == 2) { ML_STILE(cc, 2, 0); ML_STILE(cc, 2, 1); ML_STILE(cc, 2, 2); } else { ML_STILE(cc, 1, 1); } } while (0)
#define ML_HSTORE(cc) do { const int row_ = seq_row(b, dir, (cc) * 64 + lrow); *(GAS u32x4*)(HS + ((size_t)dir * NTOK + row_) * 1024 + h * 128 + vs * 32 + 8 * lp) = *(const LAS u32x4*)((const LAS bf16*)(F.lds + O_HO + ((cc) & 1) * 5120) + lrow * 40 + 8 * lp); } while (0)
            ML_LOAD(0);
            if (a == 3) { ML_GLOAD(0); ML_SCALARS(0); ML_GLOAD(1); ML_SCALARS(1); ML_GLOAD(2); }
            group_barrier(actr, 4 * (++abar), lane);
            ML_STAGE(0); ML_LOAD(1);
            group_barrier(actr, 4 * (++abar), lane);
            ML_STILES(0);
            __syncthreads();
            for (int c = 0; c < NCH; ++c) {
                if (c + 1 < NCH && !(PROBE & 2)) {
                    if (!(PROBE & 8)) { ML_STAGE(c + 1);
                    if (c >= 1) ML_HSTORE(c - 1);
                    if (c + 2 < NCH) ML_LOAD(c + 2); }
                    group_barrier(actr, 4 * (++abar), lane);
                    if (!(PROBE & 4)) ML_STILES(c + 1);
                    if (!(PROBE & 16)) { if (a == 3 && c + 2 < NCH) { ML_SCALARS(c + 2); if (c + 3 < NCH) ML_GLOAD(c + 3); } }
                } else if (c >= 1) ML_HSTORE(c - 1);
                __syncthreads();
            }
            ML_HSTORE(NCH - 1);
#undef ML_LOAD
#undef ML_GLOAD
#undef ML_SCALARS
#undef ML_STAGE
#undef ML_STILE
#undef ML_STILES
#undef ML_HSTORE
        } else {
            f32x4 Cst[2][2], Nst[2];
#pragma unroll
            for (int i = 0; i < 2; ++i) { Nst[i] = (f32x4){0.f, 0.f, 0.f, 0.f}; Cst[i][0] = Nst[i]; Cst[i][1] = Nst[i]; }
            __syncthreads();
            for (int c = 0; c < NCH; ++c) {
                if (!(PROBE & 1)) {
                const LAS unsigned char* ib = F.lds + (c & 1) * INB;
                const LAS bf16* QS = (const LAS bf16*)(ib + OFF_Q); const LAS bf16* KS = (const LAS bf16*)(ib + OFF_K); const LAS bf16* VS = (const LAS bf16*)(ib + OFF_V); const LAS bf16* VW = (const LAS bf16*)(ib + OFF_VW); const LAS bf16* WKR = (const LAS bf16*)(ib + OFF_WKR);
                const LAS bf16* SS = (const LAS bf16*)(F.lds + O_SS + (c & 1) * 9216); const LAS bf16* CSr = (const LAS bf16*)(F.lds + O_CS + (c & 1) * 13056); LAS bf16* CSw = (LAS bf16*)(F.lds + O_CS + ((c + 1) & 1) * 13056);
                LAS bf16* HO = (LAS bf16*)(F.lds + O_HO + (c & 1) * 5120); const LAS float* sc = SCb + (c % 3) * 336;
                {   const int ti = w; f32x4 a1[2], a2[2], a3 = {0.f, 0.f, 0.f, 0.f}, a1x = a3;
#pragma unroll
                    for (int vj = 0; vj < 2; ++vj) { a1[vj] = (f32x4){0.f, 0.f, 0.f, 0.f}; a2[vj] = a1[vj]; }
#pragma unroll
                    for (int kk = 0; kk < 2; ++kk) { const bf16x8 sf = row_frag(SS + 16 * ti * 72, 72, 32 * kk, lane);
#pragma unroll
                        for (int vj = 0; vj < 2; ++vj) a1[vj] = __builtin_amdgcn_mfma_f32_16x16x32_bf16(sf, tr_frag(VS, 48, 32 * kk, 16 * vj, lane), a1[vj], 0, 0, 0);
                        a1x = __builtin_amdgcn_mfma_f32_16x16x32_bf16(sf, tr_frag(VS, 48, 32 * kk, 32, lane), a1x, 0, 0, 0); }
#pragma unroll
                    for (int kk = 0; kk < 4; ++kk) { const bf16x8 qf = row_frag(QS + 16 * ti * 136, 136, 32 * kk, lane);
#pragma unroll
                        for (int vj = 0; vj < 2; ++vj) a2[vj] = __builtin_amdgcn_mfma_f32_16x16x32_bf16(qf, row_frag(CSr + 16 * vj * 136, 136, 32 * kk, lane), a2[vj], 0, 0, 0);
                        a3 = __builtin_amdgcn_mfma_f32_16x16x32_bf16(qf, row_frag(CSr + 32 * 136, 136, 32 * kk, lane), a3, 0, 0, 0); }
#pragma unroll
                    for (int i = 0; i < 4; ++i) { const int t_ = 16 * ti + 4 * q + i; const float wi = sc[128 + t_];
                        const float den = row16_sum(a1x[i] + wi * a3[i]); const float rd = 1.0f / fmaxf(fabsf(den), sc[192 + t_]);
#pragma unroll
                        for (int vj = 0; vj < 2; ++vj) HO[t_ * 40 + 16 * vj + r] = (bf16)f2bf((a1[vj][i] + wi * a2[vj][i]) * rd); } }
                {   const float wprev = sc[320]; bf16x8 av[2][2], wf[2];
#pragma unroll
                    for (int kk = 0; kk < 2; ++kk) { av[0][kk] = tr_frag(VW, 40, 32 * kk, 0, lane); av[1][kk] = tr_frag(VW, 40, 32 * kk, 16, lane); wf[kk] = row_frag(WKR, 72, 32 * kk, lane); }
#pragma unroll
                    for (int jj = 0; jj < 2; ++jj) { const int dj = 2 * w + jj; Cst[0][jj] = Cst[0][jj] * wprev; Cst[1][jj] = Cst[1][jj] * wprev; Nst[jj] = Nst[jj] * wprev;
#pragma unroll
                        for (int kk = 0; kk < 2; ++kk) { const bf16x8 kf = tr_frag(KS, 136, 32 * kk, 16 * dj, lane);
                            Cst[0][jj] = __builtin_amdgcn_mfma_f32_16x16x32_bf16(av[0][kk], kf, Cst[0][jj], 0, 0, 0); Cst[1][jj] = __builtin_amdgcn_mfma_f32_16x16x32_bf16(av[1][kk], kf, Cst[1][jj], 0, 0, 0);
                            Nst[jj] = __builtin_amdgcn_mfma_f32_16x16x32_bf16(wf[kk], kf, Nst[jj], 0, 0, 0); }
#pragma unroll
                        for (int vi = 0; vi < 2; ++vi)
#pragma unroll
                            for (int i = 0; i < 4; ++i) CSw[(16 * vi + 4 * q + i) * 136 + 16 * dj + r] = (bf16)f2bf(Cst[vi][jj][i]);
                        if (q == 0) CSw[32 * 136 + 16 * dj + r] = (bf16)f2bf(Nst[jj][0]); } }
                }
                __syncthreads();
            }
        }
    }
}

template <int PROBE> PHASE_FN void hg_scan_phase(Frame F, const GAS bf16* Q, const GAS bf16* V, const GAS bf16* LF, GAS bf16* HSf, GAS bf16* HSb) {
    constexpr int O_QT = 0, O_KT = 17408, O_IN = 34816, INB = 39936  , O_AS = O_IN + 2 * INB, O_ST = O_AS + 2 * 9216, O_HO = O_ST + 2 * 8704, O_SBL = O_HO + 5120, O_WT = O_SBL + 1024, O_CTR = O_WT + 2048;
    LAS unsigned* actr = (LAS unsigned*)(F.lds + O_CTR);
    const int tid = F.tid, lane = F.lane, w = F.wave, r = lane & 15, q = lane >> 4;
    constexpr int NCH = T / 64;
    for (int unit = F.bid; unit < 256; unit += F.G) {
        const int un = (F.G == 256) ? ((((unit & 7) * 8 + (unit >> 5)) << 2) | ((unit >> 3) & 3)) : unit;
        const int vs = un & 3, dir = (un >> 2) & 1, h = (un >> 3) & 7, b = un >> 6;
        GAS bf16* HS = dir ? HSb : HSf; const GAS bf16* LFd = LF + (size_t)dir * NTOK * 1024;
        __syncthreads();
        for (int i = tid; i < (O_CTR + 16) / 4; i += NTHR) ((LAS unsigned*)F.lds)[i] = 0u;
        __syncthreads();
        if (w >= 4) {
            const int a = w - 4, ptid = tid - 256, g4 = ptid >> 4, lp = ptid & 15; unsigned abar = 0;
            u32x4 rq[4], rl[4], rv;
#define HG_LOAD(cc) do { _Pragma("unroll") for (int j_ = 0; j_ < 4; ++j_) { const int row_ = seq_row(b, dir, (cc) * 64 + 4 * g4 + j_); rq[j_] = *(const GAS u32x4*)(Q + (size_t)row_ * 1024 + h * 128 + 8 * lp); rl[j_] = *(const GAS u32x4*)(LFd + (size_t)row_ * 1024 + h * 128 + 8 * lp); } \
                const int vrow_ = seq_row(b, dir, (cc) * 64 + (ptid >> 2)); rv = *(const GAS u32x4*)(V + (size_t)vrow_ * 1024 + h * 128 + vs * 32 + 8 * (ptid & 3)); } while (0)
#define HG_ATILE(cc, ti_, sj_) do { LAS bf16* as_ = (LAS bf16*)(F.lds + O_AS + ((cc) & 1) * 9216); f32x4 acc_ = {0.f, 0.f, 0.f, 0.f}; \
                acc_ = mm16<128>(acc_, (const LAS bf16*)(F.lds + O_QT) + 16 * (ti_) * 136, 136, (const LAS bf16*)(F.lds + O_KT) + 16 * (sj_) * 136, 136, lane); \
                _Pragma("unroll") for (int i_ = 0; i_ < 4; ++i_) { const int t_ = 16 * (ti_) + 4 * q + i_, s_ = 16 * (sj_) + r; as_[t_ * 72 + s_] = (bf16)f2bf(s_ <= t_ ? acc_[i_] : 0.f); } } while (0)
#define HG_ATILES(cc) do { if (a == 0) { HG_ATILE(cc, 3, 0); HG_ATILE(cc, 3, 1); HG_ATILE(cc, 0, 0); } else if (a == 1) { HG_ATILE(cc, 3, 2); HG_ATILE(cc, 3, 3); HG_ATILE(cc, 1, 0); } \
                else if (a == 2) { HG_ATILE(cc, 2, 0); HG_ATILE(cc, 2, 1); } else { HG_ATILE(cc, 2, 2); HG_ATILE(cc, 1, 1); } } while (0)
#define HG_PREP(cc) do { LAS float* wt_ = (LAS float*)(F.lds + O_WT); LAS unsigned char* ib_ = F.lds + O_IN + ((cc) & 1) * INB; \
                float lf_[4][8], bc_[4][8]; \
                _Pragma("unroll") for (int j_ = 0; j_ < 4; ++j_) _Pragma("unroll") for (int k_ = 0; k_ < 4; ++k_) { lf_[j_][2 * k_] = bflo(rl[j_][k_]); lf_[j_][2 * k_ + 1] = bfhi(rl[j_][k_]); } \
                _Pragma("unroll") for (int k_ = 0; k_ < 8; ++k_) { float run_ = 0.f; _Pragma("unroll") for (int j_ = 0; j_ < 4; ++j_) { run_ += lf_[j_][k_]; bc_[j_][k_] = run_; } \
                    float x_ = run_; float y_ = __shfl_up(x_, 16); if (lane >= 16) x_ += y_; y_ = __shfl_up(x_, 32); if (lane >= 32) x_ += y_; const float ex_ = x_ - run_; \
                    _Pragma("unroll") for (int j_ = 0; j_ < 4; ++j_) bc_[j_][k_] += ex_; \
                    if (lane >= 48) wt_[a * 128 + 8 * lp + k_] = x_; } \
                group_barrier(actr, 4 * (++abar), lane); \
                float br_[8], bl_[8]; \
                _Pragma("unroll") for (int k_ = 0; k_ < 8; ++k_) { const float t0_ = wt_[8 * lp + k_], t1_ = wt_[128 + 8 * lp + k_], t2_ = wt_[256 + 8 * lp + k_], t3_ = wt_[384 + 8 * lp + k_]; \
                    const float off_ = (a > 0 ? t0_ : 0.f) + (a > 1 ? t1_ : 0.f) + (a > 2 ? t2_ : 0.f); br_[k_] = t0_ + t1_; bl_[k_] = (t0_ + t1_) + (t2_ + t3_); \
                    _Pragma("unroll") for (int j_ = 0; j_ < 4; ++j_) bc_[j_][k_] += off_; } \
                _Pragma("unroll") for (int j_ = 0; j_ < 4; ++j_) { const int t_ = 4 * g4 + j_; u32x4 oq_, oi_, ok_, oh_; \
                    _Pragma("unroll") for (int k_ = 0; k_ < 4; ++k_) { float a2_[2], i2_[2], k2_[2], h2_[2]; \
                        _Pragma("unroll") for (int hh_ = 0; hh_ < 2; ++hh_) { const int c_ = 2 * k_ + hh_; const float bt_ = bc_[j_][c_], key_ = 1.0f - __expf(lf_[j_][c_]), qv_ = hh_ ? bfhi(rq[j_][k_]) : bflo(rq[j_][k_]); \
                            a2_[hh_] = qv_ * __expf(bt_ - br_[c_]); i2_[hh_] = qv_ * __expf(bt_); k2_[hh_] = key_ * __expf(br_[c_] - bt_); h2_[hh_] = key_ * __expf(bl_[c_] - bt_); } \
                        oq_[k_] = pk2(a2_[0], a2_[1]); oi_[k_] = pk2(i2_[0], i2_[1]); ok_[k_] = pk2(k2_[0], k2_[1]); oh_[k_] = pk2(h2_[0], h2_[1]); } \
                    *(LAS u32x4*)((LAS bf16*)(F.lds + O_QT) + t_ * 136 + 8 * lp) = oq_; *(LAS u32x4*)((LAS bf16*)(F.lds + O_KT) + t_ * 136 + 8 * lp) = ok_; \
                    *(LAS u32x4*)((LAS bf16*)ib_ + t_ * 136 + 8 * lp) = oi_; *(LAS u32x4*)((LAS bf16*)(ib_ + 17408) + t_ * 136 + 8 * lp) = oh_; } \
                *(LAS u32x4*)((LAS bf16*)(ib_ + 34816) + (ptid >> 2) * 40 + 8 * (ptid & 3)) = rv; \
                if (g4 == 0) { LAS float* sbl_ = (LAS float*)(F.lds + O_SBL) + ((cc) & 1) * 128; _Pragma("unroll") for (int k_ = 0; k_ < 8; ++k_) sbl_[8 * lp + k_] = __expf(bl_[k_]); } } while (0)
            HG_LOAD(0);
            HG_PREP(0); HG_LOAD(1);
            group_barrier(actr, 4 * (++abar), lane);
            HG_ATILES(0);
            __syncthreads();
            for (int c = 0; c < NCH; ++c) {
                if (c + 1 < NCH && !(PROBE & 2)) {
                    group_barrier(actr, 4 * (++abar), lane);
                    HG_PREP(c + 1);
                    if (c + 2 < NCH) HG_LOAD(c + 2);
                    group_barrier(actr, 4 * (++abar), lane);
                    HG_ATILES(c + 1);
                }
                __syncthreads();
            }
#undef HG_LOAD
#undef HG_ATILE
#undef HG_ATILES
#undef HG_PREP
        } else {
            f32x4 Sst[2][2];
#pragma unroll
            for (int i = 0; i < 2; ++i) { Sst[i][0] = (f32x4){0.f, 0.f, 0.f, 0.f}; Sst[i][1] = Sst[i][0]; }
            __syncthreads();
            for (int c = 0; c < NCH; ++c) {
                if (!(PROBE & 1)) {
                const LAS unsigned char* ib = F.lds + O_IN + (c & 1) * INB;
                const LAS bf16* QI = (const LAS bf16*)ib; const LAS bf16* KH = (const LAS bf16*)(ib + 17408); const LAS bf16* VS = (const LAS bf16*)(ib + 34816);
                const LAS bf16* AS = (const LAS bf16*)(F.lds + O_AS + (c & 1) * 9216); const LAS bf16* STr = (const LAS bf16*)(F.lds + O_ST + (c & 1) * 8704); LAS bf16* STw = (LAS bf16*)(F.lds + O_ST + ((c + 1) & 1) * 8704);
                LAS bf16* HO = (LAS bf16*)(F.lds + O_HO); const LAS float* sbl = (const LAS float*)(F.lds + O_SBL) + (c & 1) * 128;
                {   const int ti = w; f32x4 o[2]; o[0] = (f32x4){0.f, 0.f, 0.f, 0.f}; o[1] = o[0];
#pragma unroll
                    for (int kk = 0; kk < 2; ++kk) { const bf16x8 af = row_frag(AS + 16 * ti * 72, 72, 32 * kk, lane);
#pragma unroll
                        for (int vj = 0; vj < 2; ++vj) o[vj] = __builtin_amdgcn_mfma_f32_16x16x32_bf16(af, tr_frag(VS, 40, 32 * kk, 16 * vj, lane), o[vj], 0, 0, 0); }
#pragma unroll
                    for (int kk = 0; kk < 4; ++kk) { const bf16x8 qf = row_frag(QI + 16 * ti * 136, 136, 32 * kk, lane);
#pragma unroll
                        for (int vj = 0; vj < 2; ++vj) o[vj] = __builtin_amdgcn_mfma_f32_16x16x32_bf16(qf, row_frag(STr + 16 * vj * 136, 136, 32 * kk, lane), o[vj], 0, 0, 0); }
#pragma unroll
                    for (int i = 0; i < 4; ++i)
#pragma unroll
                        for (int vj = 0; vj < 2; ++vj) HO[(16 * ti + 4 * q + i) * 40 + 16 * vj + r] = (bf16)f2bf(o[vj][i]);
                    LDS_WAIT();
                    { const int t_ = 16 * ti + (lane >> 2); const int row = seq_row(b, dir, c * 64 + t_); *(GAS u32x4*)(HS + (size_t)row * 1024 + h * 128 + vs * 32 + 8 * (lane & 3)) = *(const LAS u32x4*)(HO + t_ * 40 + 8 * (lane & 3)); } }
                {   bf16x8 av[2][2];
#pragma unroll
                    for (int kk = 0; kk < 2; ++kk) { av[0][kk] = tr_frag(VS, 40, 32 * kk, 0, lane); av[1][kk] = tr_frag(VS, 40, 32 * kk, 16, lane); }
#pragma unroll
                    for (int jj = 0; jj < 2; ++jj) { const int kj = 2 * w + jj; const float sb = sbl[16 * kj + r]; Sst[0][jj] = Sst[0][jj] * sb; Sst[1][jj] = Sst[1][jj] * sb;
#pragma unroll
                        for (int kk = 0; kk < 2; ++kk) { const bf16x8 kf = tr_frag(KH, 136, 32 * kk, 16 * kj, lane);
                            Sst[0][jj] = __builtin_amdgcn_mfma_f32_16x16x32_bf16(av[0][kk], kf, Sst[0][jj], 0, 0, 0); Sst[1][jj] = __builtin_amdgcn_mfma_f32_16x16x32_bf16(av[1][kk], kf, Sst[1][jj], 0, 0, 0); }
#pragma unroll
                        for (int vi = 0; vi < 2; ++vi)
#pragma unroll
                            for (int i = 0; i < 4; ++i) STw[(16 * vi + 4 * q + i) * 136 + 16 * kj + r] = (bf16)f2bf(Sst[vi][jj][i]); } }
                }
                __syncthreads();
            }
        }
    }
}

__device__ __forceinline__ float fmix_lo(float a, unsigned b, float c) { float d; asm("v_fma_mix_f32 %0, %1, %2, %3 op_sel:[0,0,0] op_sel_hi:[0,1,0]" : "=v"(d) : "v"(a), "v"(b), "v"(c)); return d; }
__device__ __forceinline__ float fmix_hi(float a, unsigned b, float c) { float d; asm("v_fma_mix_f32 %0, %1, %2, %3 op_sel:[0,1,0] op_sel_hi:[0,1,0]" : "=v"(d) : "v"(a), "v"(b), "v"(c)); return d; }
__device__ __forceinline__ unsigned pkh2(float lo, float hi) { typedef _Float16 h2_t __attribute__((ext_vector_type(2))); h2_t v; v.x = (_Float16)lo; v.y = (_Float16)hi; return __builtin_bit_cast(unsigned, v); }
constexpr int RW_STEPB = 768;
typedef _Float16 h2_t __attribute__((ext_vector_type(2)));
template <int CTRL> __device__ __forceinline__ float dpp_add(float v) { return v + dpp_f<CTRL>(v); }
__device__ __forceinline__ float row8_sum(float v) { v = dpp_add<0xB1>(v); v = dpp_add<0x4E>(v); v = dpp_add<0x141>(v); return v; }
template <int PROBE> PHASE_FN void rw_scan_phase(Frame F, const GAS bf16* Rr, const GAS bf16* Kk, const GAS bf16* Vv, const GAS bf16* WH, const GAS bf16* AH, GAS bf16* O  , GAS float* BETA  ) {
    LAS bf16* W2T = (LAS bf16*)(F.lds + 0); LAS bf16* A2T = (LAS bf16*)(F.lds + 9216);
    LAS bf16* WHS = (LAS bf16*)(F.lds + 18432); LAS bf16* AHS = (LAS bf16*)(F.lds + 27648);
    LAS float* WPA = (LAS float*)(F.lds + 36864);
    LAS unsigned char* STEP = F.lds + 53248;
    LAS float* OP = (LAS float*)(F.lds + 102400);
    LAS float* SO = (LAS float*)(F.lds + 135168);
    LAS float* SVEC = (LAS float*)(F.lds + 143360);
    const int tid = F.tid, lane = F.lane, w = F.wave;
    constexpr int NCH = T / 32;
    for (int unit = F.bid; unit < 256; unit += F.G) {
        const int un = (F.G == 256) ? ((((unit & 7) * 16 + (unit >> 4)) << 1) | ((unit >> 3) & 1)) : unit;
        const int half = un & 1, dir = (un >> 1) & 1, h = (un >> 2) & 15, b = un >> 6;
        __syncthreads();
        for (int i = tid; i < 4096; i += NTHR) { const int l = i >> 6, jn = i & 63; W2T[jn * 72 + l] = (bf16)f2bf(INP(IN_RW_W2)[((size_t)(dir * 64 + l)) * 1024 + h * 64 + jn]); A2T[jn * 72 + l] = (bf16)f2bf(INP(IN_RW_A2)[((size_t)(dir * 64 + l)) * 1024 + h * 64 + jn]); }
        if (tid < 64) { SVEC[tid] = INP(IN_RW_W0)[dir * 1024 + h * 64 + tid]; SVEC[64 + tid] = INP(IN_RW_A0)[dir * 1024 + h * 64 + tid]; SVEC[128 + tid] = INP(IN_RW_KK)[h * 64 + tid];
            SVEC[192 + tid] = INP(IN_RW_KA)[h * 64 + tid]; SVEC[256 + tid] = INP(IN_RW_RK)[h * 64 + tid]; }
        __syncthreads();
        if (w >= 4) {
            const int p = w - 4, tl = lane >> 3, c8 = lane & 7, tp = 8 * p + tl, kc = 8 * c8;
            u32x4 rr, rk, rwh, rah; u32x2 rv;
#define RW_LOAD_RKV(cc) do { const size_t row_ = (size_t)seq_row(b, dir, (cc) * 32 + tp); rr = *(const GAS u32x4*)(Rr + row_ * 1024 + h * 64 + kc); rk = *(const GAS u32x4*)(Kk + row_ * 1024 + h * 64 + kc); \
                rv = *(const GAS u32x2*)(Vv + row_ * 1024 + h * 64 + half * 32 + 4 * c8); } while (0)
#define RW_LOAD_H(cc) do { const size_t row_ = (size_t)seq_row(b, dir, (cc) * 32 + tp); rwh = *(const GAS u32x4*)(WH + row_ * 128 + dir * 64 + kc); rah = *(const GAS u32x4*)(AH + row_ * 128 + dir * 64 + kc); } while (0)
#define RW_STAGE_H(buf) do { *(LAS u32x4*)(WHS + (buf) * (32 * 72) + tp * 72 + kc) = rwh; *(LAS u32x4*)(AHS + (buf) * (32 * 72) + tp * 72 + kc) = rah; } while (0)
#define RW_PREP(cc) do { const int bb_ = (cc) & 1; LAS float* wpa_ = WPA + p * 1024; const int r_ = lane & 15, q_ = lane >> 4; \
                _Pragma("unroll") for (int kt = 0; kt < 4; ++kt) { f32x4 aw_ = {0.f, 0.f, 0.f, 0.f}, aa_ = aw_; \
                    aw_ = mm16<64>(aw_, WHS + bb_ * (32 * 72) + 16 * (p >> 1) * 72, 72, W2T + 16 * kt * 72, 72, lane); aa_ = mm16<64>(aa_, AHS + bb_ * (32 * 72) + 16 * (p >> 1) * 72, 72, A2T + 16 * kt * 72, 72, lane); \
                    if ((q_ >> 1) == (p & 1)) { _Pragma("unroll") for (int i = 0; i < 4; ++i) { wpa_[(4 * (q_ & 1) + i) * 64 + 16 * kt + r_] = aw_[i]; wpa_[512 + (4 * (q_ & 1) + i) * 64 + 16 * kt + r_] = aa_[i]; } } } \
                LDS_WAIT(); \
                float wp_[8], ap_[8], kv_[8], rq_[8]; \
                _Pragma("unroll") for (int jj = 0; jj < 2; ++jj) { const f32x4 x_ = *(const LAS f32x4*)(wpa_ + tl * 64 + kc + 4 * jj) + *(const LAS f32x4*)(SVEC + kc + 4 * jj), y_ = *(const LAS f32x4*)(wpa_ + 512 + tl * 64 + kc + 4 * jj) + *(const LAS f32x4*)(SVEC + 64 + kc + 4 * jj); \
                    _Pragma("unroll") for (int i = 0; i < 4; ++i) { wp_[4 * jj + i] = x_[i]; ap_[4 * jj + i] = y_[i]; } } \
                _Pragma("unroll") for (int jj = 0; jj < 4; ++jj) { kv_[2 * jj] = bflo(rk[jj]); kv_[2 * jj + 1] = bfhi(rk[jj]); rq_[2 * jj] = bflo(rr[jj]); rq_[2 * jj + 1] = bfhi(rr[jj]); } \
                float now_[8], av_[8], kx_[8], ssq_ = 0.f, bet_ = 0.f; \
                _Pragma("unroll") for (int j = 0; j < 8; ++j) { now_[j] = __expf(-0.6065306597126334f * sigmoid_f(wp_[j])) - 1.0f; av_[j] = sigmoid_f(ap_[j]); kx_[j] = kv_[j] * SVEC[128 + kc + j]; ssq_ += kx_[j] * kx_[j]; } \
                ssq_ = row8_sum(ssq_); const float rn_ = 1.0f / sqrtf(fmaxf(ssq_, 1e-24f)); \
                u32x4 p0_, p1_, p2_, p3_, p4_; \
                _Pragma("unroll") for (int jj = 0; jj < 4; ++jj) { float nk_[2], ak_[2], kd_[2]; \
                    _Pragma("unroll") for (int hh = 0; hh < 2; ++hh) { const int j = 2 * jj + hh; const float kkn_ = kx_[j] * rn_; nk_[hh] = -kkn_; ak_[hh] = kkn_ * av_[j]; kd_[hh] = kv_[j] * (1.0f + (av_[j] - 1.0f) * SVEC[192 + kc + j]); bet_ += rq_[j] * kd_[hh] * SVEC[256 + kc + j]; } \
                    p0_[jj] = pkh2(now_[2 * jj], now_[2 * jj + 1]); p1_[jj] = pkh2(nk_[0], nk_[1]); p4_[jj] = pkh2(rq_[2 * jj], rq_[2 * jj + 1]); \
                    if (jj < 2) { p2_[2 * jj] = pkh2(ak_[0], kd_[0]); p2_[2 * jj + 1] = pkh2(ak_[1], kd_[1]); } else { p3_[2 * (jj - 2)] = pkh2(ak_[0], kd_[0]); p3_[2 * (jj - 2) + 1] = pkh2(ak_[1], kd_[1]); } } \
                bet_ = row8_sum(bet_); \
                LAS unsigned char* sp_ = STEP + bb_ * (32 * RW_STEPB) + tp * RW_STEPB + c8 * 80; \
                *(LAS u32x4*)sp_ = p0_; *(LAS u32x4*)(sp_ + 16) = p1_; *(LAS u32x4*)(sp_ + 32) = p2_; *(LAS u32x4*)(sp_ + 48) = p3_; *(LAS u32x4*)(sp_ + 64) = p4_; \
                *(LAS f32x4*)(STEP + bb_ * (32 * RW_STEPB) + tp * RW_STEPB + 640 + 16 * c8) = (f32x4){bflo(rv.x), bfhi(rv.x), bflo(rv.y), bfhi(rv.y)}; \
                if (c8 == 0 && half == 0) BETA[((size_t)dir * NTOK + seq_row(b, dir, (cc) * 32 + tp)) * 16 + h] = bet_; } while (0)
#define RW_STORE(cc) do { const size_t row_ = (size_t)seq_row(b, dir, (cc) * 32 + tp); const f32x4 o_ = *(const LAS f32x4*)(SO + ((cc) & 1) * 1024 + tp * 32 + 4 * c8); u32x2 pk_; pk_.x = pk2(o_[0], o_[1]); pk_.y = pk2(o_[2], o_[3]); \
                *(GAS u32x2*)(O + ((size_t)dir * NTOK + row_) * 1024 + h * 64 + half * 32 + 4 * c8) = pk_; } while (0)
            RW_LOAD_H(0); RW_LOAD_RKV(0); RW_STAGE_H(0); RW_LOAD_H(1);
            __syncthreads();
            RW_PREP(0); RW_STAGE_H(1); RW_LOAD_RKV(1); RW_LOAD_H(2);
            __syncthreads();
            for (int c = 0; c < NCH; ++c) {
                if (!(PROBE & 2)) {
                if (c > 0) RW_STORE(c - 1);
                if (c + 1 < NCH) { RW_PREP(c + 1); if (c + 2 < NCH) { RW_STAGE_H(c & 1); RW_LOAD_RKV(c + 2); if (c + 3 < NCH) RW_LOAD_H(c + 3); } }
                }
                __syncthreads();
            }
            RW_STORE(NCH - 1);
#undef RW_LOAD_RKV
#undef RW_LOAD_H
#undef RW_STAGE_H
#undef RW_PREP
#undef RW_STORE
        } else {
            const int row = tid >> 3, c8 = tid & 7;
            float S0 = 0.f, S1 = 0.f, S2 = 0.f, S3 = 0.f, S4 = 0.f, S5 = 0.f, S6 = 0.f, S7 = 0.f;
            __syncthreads();
            __syncthreads();
            for (int c = 0; c < NCH; ++c) {
                if (!(PROBE & 1)) {
                const LAS unsigned char* sp = STEP + (c & 1) * (32 * RW_STEPB) + c8 * 80; const LAS unsigned char* vp = STEP + (c & 1) * (32 * RW_STEPB) + 640 + 4 * row; LAS float* op = OP + row * 8 + c8;
                u32x4 a0 = *(const LAS u32x4*)sp, a1 = *(const LAS u32x4*)(sp + 16), a2 = *(const LAS u32x4*)(sp + 32), a3 = *(const LAS u32x4*)(sp + 48), a4 = *(const LAS u32x4*)(sp + 64); float vv = *(const LAS float*)vp;
#pragma unroll 4
                for (int t_ = 0; t_ < 32; ++t_) {
                    const int tn = (t_ + 1) & 31;
                    const LAS unsigned char* np = sp + tn * RW_STEPB;
                    const u32x4 n0 = *(const LAS u32x4*)np, n1 = *(const LAS u32x4*)(np + 16), n2 = *(const LAS u32x4*)(np + 32), n3 = *(const LAS u32x4*)(np + 48), n4 = *(const LAS u32x4*)(np + 64); const float vn = *(const LAS float*)(vp + tn * RW_STEPB);
                    float sa, sb, oa, ob; unsigned sv;
                    asm volatile(
                        "v_fma_mix_f32 %8, %0, %14, 0 op_sel:[0,0,0] op_sel_hi:[0,1,0]\n\t"
                        "v_fma_mix_f32 %9, %1, %14, 0 op_sel:[0,1,0] op_sel_hi:[0,1,0]\n\t"
                        "v_fma_mix_f32 %8, %2, %15, %8 op_sel:[0,0,0] op_sel_hi:[0,1,0]\n\t"
                        "v_fma_mix_f32 %9, %3, %15, %9 op_sel:[0,1,0] op_sel_hi:[0,1,0]\n\t"
                        "v_fma_mix_f32 %8, %4, %16, %8 op_sel:[0,0,0] op_sel_hi:[0,1,0]\n\t"
                        "v_fma_mix_f32 %9, %5, %16, %9 op_sel:[0,1,0] op_sel_hi:[0,1,0]\n\t"
                        "v_fma_mix_f32 %8, %6, %17, %8 op_sel:[0,0,0] op_sel_hi:[0,1,0]\n\t"
                        "v_fma_mix_f32 %9, %7, %17, %9 op_sel:[0,1,0] op_sel_hi:[0,1,0]\n\t"
                        "v_fma_mix_f32 %0, %0, %10, %0 op_sel:[0,0,0] op_sel_hi:[0,1,0]\n\t"
                        "v_fma_mix_f32 %1, %1, %10, %1 op_sel:[0,1,0] op_sel_hi:[0,1,0]\n\t"
                        "v_fma_mix_f32 %2, %2, %11, %2 op_sel:[0,0,0] op_sel_hi:[0,1,0]\n\t"
                        "v_fma_mix_f32 %3, %3, %11, %3 op_sel:[0,1,0] op_sel_hi:[0,1,0]\n\t"
                        "v_add_f32 %8, %8, %9\n\t"
                        "v_fma_mix_f32 %4, %4, %12, %4 op_sel:[0,0,0] op_sel_hi:[0,1,0]\n\t"
                        "v_fma_mix_f32 %5, %5, %12, %5 op_sel:[0,1,0] op_sel_hi:[0,1,0]\n\t"
                        "v_add_f32_dpp %8, %8, %8 quad_perm:[1,0,3,2] row_mask:0xf bank_mask:0xf bound_ctrl:1\n\t"
                        "v_fma_mix_f32 %6, %6, %13, %6 op_sel:[0,0,0] op_sel_hi:[0,1,0]\n\t"
                        "v_fma_mix_f32 %7, %7, %13, %7 op_sel:[0,1,0] op_sel_hi:[0,1,0]\n\t"
                        "v_add_f32_dpp %8, %8, %8 quad_perm:[2,3,0,1] row_mask:0xf bank_mask:0xf bound_ctrl:1\n\t"
                        "s_nop 1\n\t"
                        "v_add_f32_dpp %8, %8, %8 row_half_mirror row_mask:0xf bank_mask:0xf bound_ctrl:1\n\t"
                        "s_nop 0"
                        : "+v"(S0), "+v"(S1), "+v"(S2), "+v"(S3), "+v"(S4), "+v"(S5), "+v"(S6), "+v"(S7), "=&v"(sa), "=&v"(sb)
                        : "v"(a0[0]), "v"(a0[1]), "v"(a0[2]), "v"(a0[3]), "v"(a1[0]), "v"(a1[1]), "v"(a1[2]), "v"(a1[3]));
                    asm volatile(
                        "v_cvt_pkrtz_f16_f32 %8, %11, %12\n\t"
                        "v_dot2c_f32_f16 %0, %8, %13\n\t"
                        "v_dot2c_f32_f16 %1, %8, %14\n\t"
                        "v_dot2c_f32_f16 %2, %8, %15\n\t"
                        "v_dot2c_f32_f16 %3, %8, %16\n\t"
                        "v_dot2c_f32_f16 %4, %8, %17\n\t"
                        "v_dot2c_f32_f16 %5, %8, %18\n\t"
                        "v_dot2c_f32_f16 %6, %8, %19\n\t"
                        "v_dot2c_f32_f16 %7, %8, %20\n\t"
                        "v_fma_mix_f32 %9, %0, %21, 0 op_sel:[0,0,0] op_sel_hi:[0,1,0]\n\t"
                        "v_fma_mix_f32 %10, %1, %21, 0 op_sel:[0,1,0] op_sel_hi:[0,1,0]\n\t"
                        "v_fma_mix_f32 %9, %2, %22, %9 op_sel:[0,0,0] op_sel_hi:[0,1,0]\n\t"
                        "v_fma_mix_f32 %10, %3, %22, %10 op_sel:[0,1,0] op_sel_hi:[0,1,0]\n\t"
                        "v_fma_mix_f32 %9, %4, %23, %9 op_sel:[0,0,0] op_sel_hi:[0,1,0]\n\t"
                        "v_fma_mix_f32 %10, %5, %23, %10 op_sel:[0,1,0] op_sel_hi:[0,1,0]\n\t"
                        "v_fma_mix_f32 %9, %6, %24, %9 op_sel:[0,0,0] op_sel_hi:[0,1,0]\n\t"
                        "v_fma_mix_f32 %10, %7, %24, %10 op_sel:[0,1,0] op_sel_hi:[0,1,0]\n\t"
                        "v_add_f32 %9, %9, %10\n\t"
                        "s_nop 0"
                        : "+v"(S0), "+v"(S1), "+v"(S2), "+v"(S3), "+v"(S4), "+v"(S5), "+v"(S6), "+v"(S7), "=&v"(sv), "=&v"(oa), "=&v"(ob)
                        : "v"(sa), "v"(vv), "v"(a2[0]), "v"(a2[1]), "v"(a2[2]), "v"(a2[3]), "v"(a3[0]), "v"(a3[1]), "v"(a3[2]), "v"(a3[3]), "v"(a4[0]), "v"(a4[1]), "v"(a4[2]), "v"(a4[3]));
                    op[t_ * 256] = oa;
                    a0 = n0; a1 = n1; a2 = n2; a3 = n3; a4 = n4; vv = vn;
                }
                LDS_WAIT();
#pragma unroll
                for (int i = 0; i < 4; ++i) { const LAS f32x4* q_ = (const LAS f32x4*)(OP + ((4 * c8 + i) * 32 + row) * 8); const f32x4 x_ = q_[0] + q_[1]; SO[(c & 1) * 1024 + (4 * c8 + i) * 32 + row] = (x_[0] + x_[1]) + (x_[2] + x_[3]); }
                }
                __syncthreads();
            }
        }
    }
}

PHASE_FN void gemm_mlin(Frame F, int jl) { GAS unsigned char* MIX = F.ws + WS_MIX; GAS unsigned char* HY = F.ws + WS_HY;
    pg8::Gemm g{(const GAS bf16*)HY, (const GAS bf16*)(F.W + W_ML_WIN + jl * W_ML_WIN_SZ), NTOK, 4352, 1024}; pg8::StaticOrder So; So.init(NTOK, 4352, F.G, F.bid);
    pg8::EpiMlstmIn E{(GAS bf16*)MIX, (GAS bf16*)(MIX + 2 * ROWB), (GAS bf16*)(MIX + 3 * ROWB), (GAS float*)(MIX + 4 * ROWB), INP(IN_ML_BGATE) + jl * 32};
    pg8::gemm_phase<pg8::EpiMlstmIn, pg8::StaticOrder, true, GEMM_SP2>(F.lds, g, So, E, F.tid); }
PHASE_FN void gemm_resid(Frame F, const GAS bf16* A, const GAS bf16* Bt, int L) {
    pg8::Gemm g{A, Bt, NTOK, 1024, 1024}; pg8::StaticOrder So; So.init(NTOK, 1024, F.G, F.bid);
    pg8::EpiResid E{(GAS float*)(F.ws + WS_S), (const GAS float*)(F.ws + WS_MOD) + (size_t)L * 5 * 6144, 2}; pg8::gemm_phase<pg8::EpiResid, pg8::StaticOrder, true, GEMM_SP2>(F.lds, g, So, E, F.tid); }
PHASE_FN void gemm_rwin(Frame F) { GAS unsigned char* MIX = F.ws + WS_MIX; GAS unsigned char* HY = F.ws + WS_HY;
    GAS bf16* Rb = (GAS bf16*)MIX; GAS bf16* Kb = (GAS bf16*)(MIX + ROWB); GAS bf16* Vb = (GAS bf16*)(MIX + 2 * ROWB); GAS float* WH = (GAS float*)(MIX + 3 * ROWB); GAS float* AH = WH + (size_t)NTOK * 128; GAS bf16* GH = (GAS bf16*)(AH + (size_t)NTOK * 128);
    pg8::Gemm g{(const GAS bf16*)HY, (const GAS bf16*)(F.W + W_RW_IN), NTOK, 3584, 2048}; pg8::StaticOrder So; So.init(NTOK, 3584, F.G, F.bid);
    pg8::EpiRwkvIn E{Rb, Kb, Vb, WH, AH, GH}; pg8::gemm_phase<pg8::EpiRwkvIn, pg8::StaticOrder, true, GEMM_SP2>(F.lds, g, So, E, F.tid); }
PHASE_FN void gemm_rwg(Frame F) { GAS unsigned char* MIX = F.ws + WS_MIX;
    GAS float* WH = (GAS float*)(MIX + 3 * ROWB); GAS float* AH = WH + (size_t)NTOK * 128; GAS bf16* GH = (GAS bf16*)(AH + (size_t)NTOK * 128);
    pg8::Gemm g{GH, (const GAS bf16*)(F.W + W_RW_G2), NTOK, 1024, 256}; pg8::StaticOrder So; So.init(NTOK, 1024, F.G, F.bid);
    pg8::EpiBf16Plain E{(GAS bf16*)MIX, 1024}; pg8::gemm_phase<pg8::EpiBf16Plain, pg8::StaticOrder, GEMM_ALIGN, GEMM_SP2>(F.lds, g, So, E, F.tid); }
PHASE_FN void gemm_hgin(Frame F) { GAS unsigned char* MIX = F.ws + WS_MIX; GAS unsigned char* HY = F.ws + WS_HY;
    pg8::Gemm g{(const GAS bf16*)HY, (const GAS bf16*)(F.W + W_HG_IN), NTOK, 5120, 1024}; pg8::StaticOrder So; So.init(NTOK, 5120, F.G, F.bid);
    pg8::EpiHgrnIn E{(GAS bf16*)MIX, (GAS bf16*)(MIX + ROWB), (GAS bf16*)(MIX + 2 * ROWB), (GAS bf16*)(MIX + 3 * ROWB), (size_t)NTOK * 1024, INP(IN_HG_BF), (const GAS float*)(F.ws + WS_LB)};
    pg8::gemm_phase<pg8::EpiHgrnIn, pg8::StaticOrder, true, GEMM_SP2>(F.lds, g, So, E, F.tid); }
PHASE_FN void gemm_moe1(Frame F, int L) { GAS unsigned char* MIX = F.ws + WS_MIX; LAS int* pref = (LAS int*)(F.lds + LDS_PHASE_BYTES); moe_prefix(F, L, pref, pref + 32);
    pg8::Gemm g{(const GAS bf16*)(F.ws + WS_HY), (const GAS bf16*)(F.W + W_EX13), NSLOT, 16384, 1024, (const GAS int*)(F.ws + WS_SLOT_TOK)}; pg8::MoeOrder So{pref, F.G, F.bid};
    pg8::EpiMoe1 E{(GAS bf16*)(MIX + 140 * MiB)}; pg8::gemm_phase<pg8::EpiMoe1, pg8::MoeOrder, true, GEMM_SP2, true>(F.lds, g, So, E, F.tid); }
PHASE_FN void gemm_moe2(Frame F, int L) { GAS unsigned char* MIX = F.ws + WS_MIX; LAS int* pref = (LAS int*)(F.lds + LDS_PHASE_BYTES); moe_prefix(F, L, pref, pref + 32);
    pg8::Gemm g{(const GAS bf16*)(MIX + 140 * MiB), (const GAS bf16*)(F.W + W_EX2), NSLOT, 16384, 512}; pg8::MoeOrder So{pref, F.G, F.bid};
    pg8::EpiMoe2 E{(GAS bf16*)(MIX + 210 * MiB), (const GAS int*)(F.ws + WS_SLOT_TOK), (const GAS float*)(F.ws + WS_SLOT_GATE)};
    pg8::gemm_phase<pg8::EpiMoe2, pg8::MoeOrder, true, GEMM_SP2>(F.lds, g, So, E, F.tid); }

#ifndef MK_PER_PHASE
#define MK_PER_PHASE 0
#endif
constexpr int PH_PER_LAYER = 12, PH_LAYER0 = 2, PH_FINAL = PH_LAYER0 + DEPTH * PH_PER_LAYER, N_PHASES = PH_FINAL + 1;
__global__ void __launch_bounds__(NTHR, 2) fwd_kernel(Args args) {
    extern __shared__ __attribute__((aligned(16))) unsigned char lds_raw[];
    Frame F;
    F.lds = (LAS unsigned char*)lds_raw; F.out = (GAS float*)args.out; F.ws = (GAS unsigned char*)args.ws; F.W = (GAS unsigned char*)args.wts;
    F.tid = threadIdx.x; F.lane = F.tid & 63; F.wave = __builtin_amdgcn_readfirstlane(F.tid >> 6); F.bid = blockIdx.x; F.G = gridDim.x;
    volatile LAS unsigned* MISC = (volatile LAS unsigned*)(F.lds + MISC_OFF);
    if (F.tid < 32) MISC[F.tid] = 0u;
    if (F.tid < 42) ((LAS unsigned long long*)(F.lds + PTAB_OFF))[F.tid] = (unsigned long long)args.in[F.tid];
    __syncthreads();
    const int lo = args.ph_lo, hi = args.ph_hi;
    XcdBarrier bar; bar.bar = (unsigned*)args.ws + CW_BAR; bar.x = 0; bar.st = MISC + 8;
    if (hi - lo > 1) bar = xcd_barrier_post((unsigned*)args.ws + CW_BAR, MISC + 8);
#define IN(k) (lo <= (k) && (k) < hi)
#ifndef EXTRA_BARS
#define EXTRA_BARS 0
#endif
#define SEAM(k) do { if ((k) + 1 < hi) { xcd_barrier(bar); for (int eb_ = 0; eb_ < EXTRA_BARS; ++eb_) xcd_barrier(bar); } } while (0)
#ifndef DUP_MASK
#define DUP_MASK 0
#endif
#ifndef PRB_MASK
#define PRB_MASK 0
#endif
#define PRB(bit, stmt) do { if ((PRB_MASK >> (bit)) & 1) { stmt; xcd_barrier(bar); } } while (0)
#define DUP(bit, stmt) do { stmt; if ((DUP_MASK >> (bit)) & 1) { xcd_barrier(bar); stmt; } } while (0)

    if (IN(0)) { PRB(0, pre_phase(fresh(F))); pre_phase(fresh(F)); SEAM(0); }
    if (IN(1)) { PRB(0, modsum_phase(fresh(F))); modsum_phase(fresh(F)); SEAM(1); }

    for (int L = 0; L < DEPTH; ++L) {
        const int kind = L % 3, jl = L / 3, pb = PH_LAYER0 + L * PH_PER_LAYER;
        if (IN(pb + 0)) { DUP(6, expert_weights(fresh(F), L)); if ((PRB_MASK >> 1) & 1) { norm_phase<0, 1>(fresh(F), L, L > 0, kind == 1 ? 2048 : 1024); xcd_barrier(bar); } norm_phase<0>(fresh(F), L, L > 0, kind == 1 ? 2048 : 1024); SEAM(pb + 0); }
        if (kind == 0) {
            if (IN(pb + 2)) { DUP(3, gemm_mlin(fresh(F), jl)); SEAM(pb + 2); }
            if (IN(pb + 3)) { DUP(7, conv_phase(fresh(F), jl)); SEAM(pb + 3); }
            if (IN(pb + 4)) { const Frame Fp = fresh(F); GAS unsigned char* MIX = Fp.ws + WS_MIX;
#ifndef SC_PROBE
#define SC_PROBE 0
#endif
#ifndef HG_PROBE
#define HG_PROBE 0
#endif
                if (SC_PROBE) { ml_scan_phase<SC_PROBE>(Fp, (const GAS bf16*)(Fp.ws + WS_HY), (const GAS bf16*)(MIX + 2 * ROWB), (const GAS float*)(MIX + 4 * ROWB), (GAS bf16*)MIX); xcd_barrier(bar); }
                DUP(0, ml_scan_phase<0>(Fp, (const GAS bf16*)(Fp.ws + WS_HY), (const GAS bf16*)(MIX + 2 * ROWB), (const GAS float*)(MIX + 4 * ROWB), (GAS bf16*)MIX)); SEAM(pb + 4); }
            if (IN(pb + 6)) { const Frame Fp = fresh(F); GAS unsigned char* MIX = Fp.ws + WS_MIX;
                PRB(4, headnorm_phase(Fp, (const GAS bf16*)MIX, (const GAS bf16*)(MIX + ROWB), (const GAS bf16*)(MIX + 3 * ROWB), ldptr(Fp, IN_ML_HEADG) + jl * 1024, (GAS bf16*)(Fp.ws + WS_HY + ROWB)));
                headnorm_phase(Fp, (const GAS bf16*)MIX, (const GAS bf16*)(MIX + ROWB), (const GAS bf16*)(MIX + 3 * ROWB), ldptr(Fp, IN_ML_HEADG) + jl * 1024, (GAS bf16*)(Fp.ws + WS_HY + ROWB)); SEAM(pb + 6); }
            if (IN(pb + 7)) { const Frame Fp = fresh(F); gemm_resid(Fp, (const GAS bf16*)(Fp.ws + WS_HY + ROWB), (const GAS bf16*)(Fp.W + W_ML_WOUT + jl * 2 * MiB), L); SEAM(pb + 7); }
        } else if (kind == 1) {
            if (IN(pb + 1)) { PRB(4, du_phase(fresh(F))); du_phase(fresh(F)); SEAM(pb + 1); }
            if (IN(pb + 2)) { DUP(3, gemm_rwin(fresh(F))); SEAM(pb + 2); }
            if (IN(pb + 4)) { const Frame Fp = fresh(F); GAS unsigned char* MIX = Fp.ws + WS_MIX; GAS float* WH = (GAS float*)(MIX + 3 * ROWB); GAS float* AH = WH + (size_t)NTOK * 128; GAS float* BETA = (GAS float*)((GAS bf16*)(AH + (size_t)NTOK * 128) + (size_t)NTOK * 256);

#ifndef RW_PROBE
#define RW_PROBE 0
#endif
                if (RW_PROBE) { rw_scan_phase<RW_PROBE>(Fp, (const GAS bf16*)MIX, (const GAS bf16*)(MIX + ROWB), (const GAS bf16*)(MIX + 2 * ROWB), (const GAS bf16*)WH, (const GAS bf16*)AH, (GAS bf16*)(Fp.ws + WS_HY), BETA); xcd_barrier(bar); }
                DUP(1, rw_scan_phase<0>(Fp, (const GAS bf16*)MIX, (const GAS bf16*)(MIX + ROWB), (const GAS bf16*)(MIX + 2 * ROWB), (const GAS bf16*)WH, (const GAS bf16*)AH, (GAS bf16*)(Fp.ws + WS_HY), BETA)); SEAM(pb + 4); }
            if (IN(pb + 5)) { PRB(4, gemm_rwg(fresh(F))); gemm_rwg(fresh(F)); SEAM(pb + 5); }
            if (IN(pb + 6)) { const Frame Fp = fresh(F); GAS unsigned char* MIX = Fp.ws + WS_MIX; GAS float* WH = (GAS float*)(MIX + 3 * ROWB); GAS float* AH = WH + (size_t)NTOK * 128; GAS float* BETA = (GAS float*)((GAS bf16*)(AH + (size_t)NTOK * 128) + (size_t)NTOK * 256);
                PRB(4, rwpost_phase(Fp, (const GAS bf16*)(Fp.ws + WS_HY), (const GAS bf16*)(Fp.ws + WS_HY + ROWB), BETA, (const GAS bf16*)(MIX + 2 * ROWB), (const GAS bf16*)MIX, (GAS bf16*)(MIX + ROWB)));
                rwpost_phase(Fp, (const GAS bf16*)(Fp.ws + WS_HY), (const GAS bf16*)(Fp.ws + WS_HY + ROWB), BETA, (const GAS bf16*)(MIX + 2 * ROWB), (const GAS bf16*)MIX, (GAS bf16*)(MIX + ROWB)); SEAM(pb + 6); }
            if (IN(pb + 7)) { const Frame Fp = fresh(F); gemm_resid(Fp, (const GAS bf16*)(Fp.ws + WS_MIX + ROWB), (const GAS bf16*)(Fp.W + W_RW_WOUT), L); SEAM(pb + 7); }
        } else {
            if (IN(pb + 2)) { DUP(3, gemm_hgin(fresh(F))); SEAM(pb + 2); }
            if (IN(pb + 4)) { const Frame Fp = fresh(F); GAS unsigned char* MIX = Fp.ws + WS_MIX;
                if (HG_PROBE) { hg_scan_phase<HG_PROBE>(Fp, (const GAS bf16*)MIX, (const GAS bf16*)(MIX + ROWB), (const GAS bf16*)(MIX + 3 * ROWB), (GAS bf16*)(Fp.ws + WS_HY + ROWB), (GAS bf16*)(Fp.ws + WS_HY)); xcd_barrier(bar); }
                DUP(2, hg_scan_phase<0>(Fp, (const GAS bf16*)MIX, (const GAS bf16*)(MIX + ROWB), (const GAS bf16*)(MIX + 3 * ROWB), (GAS bf16*)(Fp.ws + WS_HY + ROWB), (GAS bf16*)(Fp.ws + WS_HY))); SEAM(pb + 4); }
            if (IN(pb + 6)) { const Frame Fp = fresh(F); GAS unsigned char* MIX = Fp.ws + WS_MIX;
                headnorm_phase(Fp, (const GAS bf16*)(Fp.ws + WS_HY + ROWB), (const GAS bf16*)(Fp.ws + WS_HY), (const GAS bf16*)(MIX + 2 * ROWB), ldptr(Fp, IN_HG_HEADG), (GAS bf16*)(Fp.ws + WS_HY + ROWB)); SEAM(pb + 6); }
            if (IN(pb + 7)) { const Frame Fp = fresh(F); gemm_resid(Fp, (const GAS bf16*)(Fp.ws + WS_HY + ROWB), (const GAS bf16*)(Fp.W + W_HG_WOUT), L); SEAM(pb + 7); }
        }
        if (IN(pb + 8)) { if ((PRB_MASK >> 2) & 1) { norm_phase<1, 1>(fresh(F), L, false, 1024); xcd_barrier(bar); } norm_phase<1>(fresh(F), L, false, 1024); SEAM(pb + 8); }
        if (IN(pb + 9)) { if ((PRB_MASK >> 3) & 1) { slots_phase<1>(fresh(F), L); xcd_barrier(bar); } slots_phase<0>(fresh(F), L); SEAM(pb + 9); }
        if (IN(pb + 10)) { DUP(4, gemm_moe1(fresh(F), L)); SEAM(pb + 10); }
        if (IN(pb + 11)) { DUP(5, gemm_moe2(fresh(F), L)); SEAM(pb + 11); }
    }
    if (IN(PH_FINAL)) norm_phase<2>(fresh(F), 0, true, 1024);
#undef IN
#undef SEAM
}

extern "C" void kernel_launch(void* const* d_in, const int* in_sizes, int n_in, void* d_out, int out_size, void* d_ws, size_t ws_size, hipStream_t stream) {
    static int grid = 0;
    if (grid == 0) {
        if (n_in != 42 || out_size != NB * SEQ * D || ws_size < WS_END) { fprintf(stderr, "kernel_launch: unexpected problem (n_in %d, out %d, ws %zu)\n", n_in, out_size, ws_size); grid = -1; return; }
        int dev = 0, cus = 0, per_cu = 0;
        if (hipGetDevice(&dev) != hipSuccess || hipDeviceGetAttribute(&cus, hipDeviceAttributeMultiprocessorCount, dev) != hipSuccess) { grid = -1; return; }
        if (hipFuncSetAttribute((const void*)fwd_kernel, hipFuncAttributeMaxDynamicSharedMemorySize, LDS_BYTES) != hipSuccess) { fprintf(stderr, "kernel_launch: hipFuncSetAttribute failed\n"); grid = -1; return; }
        if (hipOccupancyMaxActiveBlocksPerMultiprocessor(&per_cu, (const void*)fwd_kernel, NTHR, LDS_BYTES) != hipSuccess || per_cu < 1) { fprintf(stderr, "kernel_launch: occupancy query reports %d\n", per_cu); (void)hipGetLastError(); grid = -1; return; }
        grid = cus;
    }
    if (grid < 0) return;
    (void)hipMemsetAsync(d_ws, 0, CTL_ZERO_BYTES, stream);
    Args a{};
    for (int i = 0; i < 42; ++i) a.in[i] = (const float*)d_in[i];
    a.out = (float*)d_out; a.ws = (unsigned char*)d_ws;
    a.wts = (ws_size >= WS_END + W_BYTES) ? (unsigned char*)d_ws + WS_END : (unsigned char*)d_out;
#if MK_PER_PHASE
    for (int p = 0; p < N_PHASES; ++p) { a.ph_lo = p; a.ph_hi = p + 1; hipLaunchKernelGGL(fwd_kernel, dim3(grid), dim3(NTHR), LDS_BYTES, stream, a); }
#else
    a.ph_lo = 0; a.ph_hi = N_PHASES;
    hipLaunchKernelGGL(fwd_kernel, dim3(grid), dim3(NTHR), LDS_BYTES, stream, a);
#endif
}
```

```cpp
#include <hip/hip_runtime.h>
#include <cstdio>
#include <cstdint>

__device__ __forceinline__ float sigmoid_f(float x) { return __builtin_amdgcn_rcpf(1.0f + __expf(-x)); }
__device__ __forceinline__ float silu_f(float x) { return x * __builtin_amdgcn_rcpf(1.0f + __expf(-x)); }
__device__ __forceinline__ float logsigmoid_f(float x) { return fminf(x, 0.f) - __logf(1.0f + __expf(-fabsf(x))); }
#define GAS __attribute__((address_space(1)))
#ifndef S_BF16
#define S_BF16 1
#endif
namespace pg8 {
#define PG8_LAS __attribute__((address_space(3)))
typedef unsigned short bf16_t;
typedef short bf16x8 __attribute__((ext_vector_type(8)));
typedef float f32x4 __attribute__((ext_vector_type(4)));
typedef unsigned u32x4 __attribute__((ext_vector_type(4)));
constexpr int BM = 256, BK = 64, HALF = 128, HTB = HALF * BK * 2  , STAGE_BYTES = 8 * HTB, NXCD = 8, WGM = 8;

__host__ __device__ __forceinline__ int lds_byte(int r, int c) { const int st = (r >> 4) * 2 + (c >> 5), rr = r & 15, cc = c & 31, ob = rr * 64 + cc * 2; return st * 1024 + (ob ^ (((ob >> 9) & 1) << 5)); }
__host__ __device__ __forceinline__ void stage_rc(int b, int& R, int& C) { const int st = b / 1024, sb = b % 1024, swz = sb ^ (((sb >> 9) & 1) << 5); R = (st >> 1) * 16 + swz / 64; C = (st & 1) * 32 + (swz % 64) / 2; }
__host__ __device__ __forceinline__ int perm32(int rho) { const int n = rho >> 4, i = rho & 15; return 8 * (i >> 2) + 4 * n + (i & 3); }

struct Unit { int pm, pn; };
struct Gemm { const GAS bf16_t* A; const GAS bf16_t* Bt; int M, N, K; const GAS int* gidx; };

struct StaticOrder {
    int nM, nN, nwg, G, c;
    __host__ __device__ void init(int M, int N, int G_, int c_) { nM = M / BM; nN = N / BM; nwg = nM * nN; G = G_; c = c_; }
    __host__ __device__ bool next(int i, Unit& u) const {
        const long L = (long)i * G + c; if (L >= nwg) return false;
        int wgid = (int)L; { const int q = nwg / NXCD, r = nwg % NXCD, xcd = wgid % NXCD, off = wgid / NXCD; wgid = (xcd < r ? xcd * (q + 1) : r * (q + 1) + (xcd - r) * q) + off; }
        const int nig = WGM * nN, gid = wgid / nig, fm = gid * WGM, gsz = (nM - fm) < WGM ? (nM - fm) : WGM;
        u.pm = fm + ((wgid % nig) % gsz); u.pn = (wgid % nig) / gsz; return true;
    }
    __device__ __forceinline__ void a_ready(const Unit&) const {}
    __device__ __forceinline__ void done(const Unit&) const {}
};
typedef float f32x2_pg8 __attribute__((ext_vector_type(2))); typedef __bf16 bf16x2_pg8 __attribute__((ext_vector_type(2)));
__device__ __forceinline__ unsigned cvt_pk_bf16(float lo, float hi) { f32x2_pg8 v = {lo, hi}; bf16x2_pg8 b = __builtin_convertvector(v, bf16x2_pg8); return __builtin_bit_cast(unsigned, b); }
typedef unsigned u32x2 __attribute__((ext_vector_type(2)));
__device__ __forceinline__ void st8(GAS bf16_t* p, f32x4 v0, f32x4 v1) { u32x4 w; w.x = cvt_pk_bf16(v0[0], v0[1]); w.y = cvt_pk_bf16(v0[2], v0[3]); w.z = cvt_pk_bf16(v1[0], v1[1]); w.w = cvt_pk_bf16(v1[2], v1[3]); *(GAS u32x4*)p = w; }
template <int ACT> __device__ __forceinline__ f32x4 act4(f32x4 v) {
    if (ACT == 1) { v[0] = sigmoid_f(v[0]); v[1] = sigmoid_f(v[1]); v[2] = sigmoid_f(v[2]); v[3] = sigmoid_f(v[3]); }
    if (ACT == 2) { v[0] = silu_f(v[0]); v[1] = silu_f(v[1]); v[2] = silu_f(v[2]); v[3] = silu_f(v[3]); }
    return v; }
template <int ACT> __device__ __forceinline__ void store_tile_bf16(const f32x4 (&acc)[2][2][4][2], GAS bf16_t* base, int ld, int row0, int cw) {
#pragma unroll
    for (int ai = 0; ai < 2; ++ai)
#pragma unroll
        for (int m = 0; m < 4; ++m) { GAS bf16_t* rp = base + (size_t)(row0 + ai * HALF + m * 16) * ld + cw;
#pragma unroll
            for (int bj = 0; bj < 2; ++bj) st8(rp + bj * HALF, act4<ACT>(acc[ai][bj][m][0]), act4<ACT>(acc[ai][bj][m][1])); }
}
struct EpiBf16Plain { static constexpr bool PERM = true, AFTER_DRAIN = false; GAS bf16_t* O; int ldc;
    __device__ __forceinline__ void operator()(const f32x4 (&acc)[2][2][4][2], const Unit& u, int wr, int wc, int fr, int fq) const {
        store_tile_bf16<0>(acc, O + u.pn * BM, ldc, u.pm * BM + wr * 64 + fr, wc * 32 + 8 * fq); }
};
struct EpiMlstmIn { static constexpr bool PERM = true, AFTER_DRAIN = false;
    GAS bf16_t* QKPRE; GAS bf16_t* V; GAS bf16_t* OG; GAS float* GATES; const GAS float* bgate;
    __device__ __forceinline__ void operator()(const f32x4 (&acc)[2][2][4][2], const Unit& u, int wr, int wc, int fr, int fq) const {
        const int row0 = u.pm * BM + wr * 64 + fr, cw = wc * 32 + 8 * fq;
        if (u.pn < 8) store_tile_bf16<0>(acc, QKPRE + u.pn * BM, 2048, row0, cw);
        else if (u.pn < 12) store_tile_bf16<0>(acc, V + (u.pn - 8) * BM, 1024, row0, cw);
        else if (u.pn < 16) store_tile_bf16<1>(acc, OG + (u.pn - 12) * BM, 1024, row0, cw);
        else if (wc == 0) {
            const f32x4 b0 = *(const GAS f32x4*)(bgate + 8 * fq), b1 = *(const GAS f32x4*)(bgate + 8 * fq + 4);
#pragma unroll
            for (int ai = 0; ai < 2; ++ai)
#pragma unroll
                for (int m = 0; m < 4; ++m) { GAS float* gp = GATES + (size_t)(row0 + ai * HALF + m * 16) * 32 + 8 * fq;
                    *(GAS f32x4*)gp = acc[ai][0][m][0] + b0; *(GAS f32x4*)(gp + 4) = acc[ai][0][m][1] + b1; }
        }
    }
};
struct EpiRwkvIn { static constexpr bool PERM = true, AFTER_DRAIN = false;
    GAS bf16_t* R; GAS bf16_t* Kk; GAS bf16_t* V; GAS float* WH; GAS float* AH; GAS bf16_t* GH;
    __device__ __forceinline__ void operator()(const f32x4 (&acc)[2][2][4][2], const Unit& u, int wr, int wc, int fr, int fq) const {
        const int row0 = u.pm * BM + wr * 64 + fr, cw = wc * 32 + 8 * fq;
        if (u.pn < 4) store_tile_bf16<0>(acc, R + u.pn * BM, 1024, row0, cw);
        else if (u.pn < 8) store_tile_bf16<0>(acc, Kk + (u.pn - 4) * BM, 1024, row0, cw);
        else if (u.pn < 12) store_tile_bf16<0>(acc, V + (u.pn - 8) * BM, 1024, row0, cw);
        else if (u.pn == 12) {
#pragma unroll
            for (int ai = 0; ai < 2; ++ai)
#pragma unroll
                for (int m = 0; m < 4; ++m) { const size_t r = (size_t)(row0 + ai * HALF + m * 16);
                    f32x4 t0 = acc[ai][0][m][0], t1 = acc[ai][0][m][1];
#pragma unroll
                    for (int j = 0; j < 4; ++j) { t0[j] = tanhf(t0[j]); t1[j] = tanhf(t1[j]); }
                    st8((GAS bf16_t*)WH + r * 128 + cw, t0, t1); st8((GAS bf16_t*)AH + r * 128 + cw, acc[ai][1][m][0], acc[ai][1][m][1]); }
        } else {
#pragma unroll
            for (int ai = 0; ai < 2; ++ai)
#pragma unroll
                for (int m = 0; m < 4; ++m) { GAS bf16_t* rp = GH + (size_t)(row0 + ai * HALF + m * 16) * 256 + cw;
                    st8(rp, act4<1>(acc[ai][0][m][0]), act4<1>(acc[ai][0][m][1])); *(GAS u32x4*)(rp + HALF) = (u32x4){0u, 0u, 0u, 0u}; }
        }
    }
};
struct EpiHgrnIn { static constexpr bool PERM = true, AFTER_DRAIN = false;
    GAS bf16_t* Q; GAS bf16_t* V; GAS bf16_t* OG; GAS bf16_t* LF; size_t lf_stride; const GAS float* bf; const GAS float* lb;
    __device__ __forceinline__ void operator()(const f32x4 (&acc)[2][2][4][2], const Unit& u, int wr, int wc, int fr, int fq) const {
        const int row0 = u.pm * BM + wr * 64 + fr, cw = wc * 32 + 8 * fq;
        if (u.pn < 4) store_tile_bf16<2>(acc, Q + u.pn * BM, 1024, row0, cw);
        else if (u.pn < 8) store_tile_bf16<0>(acc, V + (u.pn - 4) * BM, 1024, row0, cw);
        else if (u.pn < 12) store_tile_bf16<2>(acc, OG + (u.pn - 8) * BM, 1024, row0, cw);
        else {
            const int dir = (u.pn - 12) >> 2, ct = ((u.pn - 12) & 3) * BM; GAS bf16_t* base = LF + (size_t)dir * lf_stride + ct;
            f32x4 bb[2][2], ll[2][2];
#pragma unroll
            for (int bj = 0; bj < 2; ++bj)
#pragma unroll
                for (int n = 0; n < 2; ++n) { bb[bj][n] = *(const GAS f32x4*)(bf + dir * 1024 + ct + bj * HALF + cw + 4 * n); ll[bj][n] = *(const GAS f32x4*)(lb + ct + bj * HALF + cw + 4 * n); }
#pragma unroll
            for (int ai = 0; ai < 2; ++ai)
#pragma unroll
                for (int m = 0; m < 4; ++m) { GAS bf16_t* rp = base + (size_t)(row0 + ai * HALF + m * 16) * 1024 + cw;
#pragma unroll
                    for (int bj = 0; bj < 2; ++bj) { f32x4 o[2];
#pragma unroll
                        for (int n = 0; n < 2; ++n)
#pragma unroll
                            for (int j = 0; j < 4; ++j) { const float l = ll[bj][n][j]; o[n][j] = __logf(l + (1.f - l) * sigmoid_f(acc[ai][bj][m][n][j] + bb[bj][n][j])); }
                        st8(rp + bj * HALF, o[0], o[1]); } }
        }
    }
};
struct EpiResid { static constexpr bool PERM = S_BF16 ? true : false, AFTER_DRAIN = false;
    GAS unsigned char* S; const GAS float* mod; int gate_idx; int dry;
    __device__ __forceinline__ void operator()(const f32x4 (&acc)[2][2][4][2], const Unit& u, int wr, int wc, int fr, int fq) const {
        const int b = u.pm / 33, seg = (u.pm - b * 33 == 0) ? 0 : 1 + b;
        if (S_BF16) {
            const int row0 = u.pm * BM + wr * 64 + fr, col0 = u.pn * BM + wc * 32 + 8 * fq;
            const GAS float* gp = mod + seg * 6144 + gate_idx * 1024 + col0;
            f32x4 gv[2][2];
#pragma unroll
            for (int bj = 0; bj < 2; ++bj)
#pragma unroll
                for (int n = 0; n < 2; ++n) gv[bj][n] = *(const GAS f32x4*)(gp + bj * HALF + n * 4);
#pragma unroll
            for (int ai = 0; ai < 2; ++ai)
#pragma unroll
                for (int m = 0; m < 4; ++m) { GAS bf16_t* rowp = (GAS bf16_t*)S + (size_t)(row0 + ai * HALF + m * 16) * 1024 + col0;
#pragma unroll
                    for (int bj = 0; bj < 2; ++bj) { GAS u32x4* p = (GAS u32x4*)(rowp + bj * HALF); const u32x4 o = *p;
                        f32x4 v0 = {__builtin_bit_cast(float, o.x << 16), __builtin_bit_cast(float, o.x & 0xffff0000u), __builtin_bit_cast(float, o.y << 16), __builtin_bit_cast(float, o.y & 0xffff0000u)};
                        f32x4 v1 = {__builtin_bit_cast(float, o.z << 16), __builtin_bit_cast(float, o.z & 0xffff0000u), __builtin_bit_cast(float, o.w << 16), __builtin_bit_cast(float, o.w & 0xffff0000u)};
                        v0 += acc[ai][bj][m][0] * gv[bj][0]; v1 += acc[ai][bj][m][1] * gv[bj][1];
                        if (!dry || v0[0] == 1.2345e33f) st8(rowp + bj * HALF, v0, v1); } }
        } else {
            const int row0 = u.pm * BM + wr * 64 + fr, col0 = u.pn * BM + wc * 32 + 4 * fq;
            const GAS float* gp = mod + seg * 6144 + gate_idx * 1024 + col0;
            f32x4 gv[2][2];
#pragma unroll
            for (int bj = 0; bj < 2; ++bj)
#pragma unroll
                for (int n = 0; n < 2; ++n) gv[bj][n] = *(const GAS f32x4*)(gp + bj * HALF + n * 16);
#pragma unroll
            for (int ai = 0; ai < 2; ++ai)
#pragma unroll
                for (int m = 0; m < 4; ++m) { GAS float* rowp = (GAS float*)S + (size_t)(row0 + ai * HALF + m * 16) * 1024 + col0;
#pragma unroll
                    for (int bj = 0; bj < 2; ++bj)
#pragma unroll
                        for (int n = 0; n < 2; ++n) { GAS f32x4* p = (GAS f32x4*)(rowp + bj * HALF + n * 16); const f32x4 v_ = *p + acc[ai][bj][m][n] * gv[bj][n]; if (!dry || v_[0] == 1.2345e33f) *p = v_; } }
        }
    }
};
struct EpiMoe1 { static constexpr bool PERM = true, AFTER_DRAIN = false; GAS bf16_t* ACT;
    __device__ __forceinline__ void operator()(const f32x4 (&acc)[2][2][4][2], const Unit& u, int wr, int wc, int fr, int fq) const {
        const int row0 = u.pm * BM + wr * 64 + fr, pnl = u.pn & 3, c0 = pnl * 128 + wc * 16 + 4 * fq;
#pragma unroll
        for (int ai = 0; ai < 2; ++ai)
#pragma unroll
            for (int m = 0; m < 4; ++m) { GAS bf16_t* rp = ACT + (size_t)(row0 + ai * HALF + m * 16) * 512 + c0;
#pragma unroll
                for (int bj = 0; bj < 2; ++bj) { const f32x4 a = acc[ai][bj][m][0], b = acc[ai][bj][m][1];
                    u32x2 w; w.x = cvt_pk_bf16(silu_f(a[0]) * b[0], silu_f(a[1]) * b[1]); w.y = cvt_pk_bf16(silu_f(a[2]) * b[2], silu_f(a[3]) * b[3]);
                    *(GAS u32x2*)(rp + bj * 64) = w; } }
    }
};
struct EpiMoe2 { static constexpr bool PERM = true, AFTER_DRAIN = false; GAS bf16_t* YM; const GAS int* slot_tok; const GAS float* slot_gate;
    __device__ __forceinline__ void operator()(const f32x4 (&acc)[2][2][4][2], const Unit& u, int wr, int wc, int fr, int fq) const {
        const int row0 = u.pm * BM + wr * 64 + fr, col0 = (u.pn & 3) * BM + wc * 32 + 8 * fq;
#pragma unroll
        for (int ai = 0; ai < 2; ++ai)
#pragma unroll
            for (int m = 0; m < 4; ++m) { const int slot = row0 + ai * HALF + m * 16; const int dst = slot_tok[slot]; const float g = slot_gate[slot];
                if (dst >= 0) { GAS bf16_t* rp = YM + (size_t)dst * 1024 + col0;
#pragma unroll
                    for (int bj = 0; bj < 2; ++bj) st8(rp + bj * HALF, acc[ai][bj][m][0] * g, acc[ai][bj][m][1] * g); } }
    }
};
struct MoeOrder { const PG8_LAS int* pref; int G, c;
    __device__ __forceinline__ bool next(int i, Unit& u) const {
        const int L = i * G + c, nt = pref[16]; if (L >= nt * 4) return false;
        const int tile = L >> 2; int e = 0;
#pragma unroll
        for (int j = 1; j < 16; ++j) e += (tile >= pref[j]) ? 1 : 0;
        u.pm = tile; u.pn = e * 4 + (L & 3); return true; }
    __device__ __forceinline__ void a_ready(const Unit&) const {}
    __device__ __forceinline__ void done(const Unit&) const {}
};
template <class Epi, class Sched, bool ALIGN_EPI = false, bool SP2 = false, bool GATHER = false>
__device__ __forceinline__ void gemm_phase(PG8_LAS unsigned char* lds, const Gemm g, const Sched& S, const Epi& E, const int tid_in) {
    int tid_ = tid_in; asm volatile("" : "+v"(tid_));
    const int tid = tid_, wid = __builtin_amdgcn_readfirstlane(tid >> 6), lane = tid & 63, wr = wid >> 2, wc = wid & 3, fr = lane & 15, fq = lane >> 4;
    const int K = g.K, nt = K / BK;
    unsigned voffA[2], voffB[2];
#pragma unroll
    for (int i = 0; i < 2; ++i) { int R, C; stage_rc(tid * 16 + i * 8192, R, C); const int Rb = Epi::PERM ? ((R & ~31) + perm32(R & 31)) : R;
        voffA[i] = (unsigned)(R * K + C) * 2u; voffB[i] = (unsigned)(Rb * K + C) * 2u; }
    unsigned offc[2][2], offn[2][2];
#define PG8_GOFF(dst, unit) do { _Pragma("unroll") for (int _h = 0; _h < 2; ++_h) _Pragma("unroll") for (int _i = 0; _i < 2; ++_i) { int _R, _C; stage_rc(tid * 16 + _i * 8192, _R, _C); \
        const int _t = g.gidx[(unit).pm * BM + _h * HALF + _R]; dst[_h][_i] = (unsigned)(((_t < 0 ? 0 : (_t >> 1)) * K + _C) * 2); } } while (0)
    const size_t kstep = (size_t)(BK * 2);
    const size_t hstep = (size_t)HALF * K * 2;
    const size_t tstep = 2 * hstep;
    if constexpr (!GATHER) {
#pragma unroll
        for (int h_ = 0; h_ < 2; ++h_)
#pragma unroll
            for (int i = 0; i < 2; ++i) { offc[h_][i] = voffA[i] + (unsigned)(h_ * hstep); offn[h_][i] = offc[h_][i]; } }
    const unsigned ldsw = (unsigned)wid * 1024u;
    const int aoff = lds_byte(wr * 64 + fr, fq * 8), boff = lds_byte(wc * 32 + fr, fq * 8);
#define PG8_SA(b, h) (((b) * 2 + (h)) * HTB)
#define PG8_SB(b, h) ((4 + (b) * 2 + (h)) * HTB)
#define PG8_STAGE(bufoff, gbase, voff) do { _Pragma("unroll") for (int _i = 0; _i < 2; ++_i) \
        __builtin_amdgcn_global_load_lds((const unsigned*)((const char*)(gbase) + (voff)[_i]), (PG8_LAS unsigned*)(lds + (bufoff) + ldsw + _i * 8192), 16, 0, 0); } while (0)
#define PG8_STAGE_A(bufoff, gbase, off2) do { _Pragma("unroll") for (int _i = 0; _i < 2; ++_i) \
        __builtin_amdgcn_global_load_lds((const unsigned*)((const char*)(gbase) + (off2)[_i]), (PG8_LAS unsigned*)(lds + (bufoff) + ldsw + _i * 8192), 16, 0, 0); } while (0)
#define PG8_LDA(dst, b, h) do { _Pragma("unroll") for (int m = 0; m < 4; ++m) _Pragma("unroll") for (int k = 0; k < 2; ++k) dst[m][k] = *(const PG8_LAS bf16x8*)(lds + PG8_SA(b, h) + aoff + m * 2048 + k * 1024); } while (0)
#define PG8_LDB(dst, b, h) do { _Pragma("unroll") for (int n = 0; n < 2; ++n) _Pragma("unroll") for (int k = 0; k < 2; ++k) dst[n][k] = *(const PG8_LAS bf16x8*)(lds + PG8_SB(b, h) + boff + n * 2048 + k * 1024); } while (0)
#define PG8_MMA(ai, bj, At, Bt) do { __builtin_amdgcn_s_setprio(1); _Pragma("unroll") for (int m = 0; m < 4; ++m) _Pragma("unroll") for (int n = 0; n < 2; ++n) _Pragma("unroll") for (int k = 0; k < 2; ++k) \
        acc[ai][bj][m][n] = __builtin_amdgcn_mfma_f32_16x16x32_bf16(Bt[n][k], At[m][k], acc[ai][bj][m][n], 0, 0, 0); __builtin_amdgcn_s_setprio(0); } while (0)
#define PG8_WAIT_V(n) asm volatile("s_waitcnt vmcnt(" #n ")" ::: "memory")
#define PG8_WAIT_L(n) asm volatile("s_waitcnt lgkmcnt(" #n ")" ::: "memory")
#define PG8_BAR __builtin_amdgcn_s_barrier()
#define PG8_SCHED __builtin_amdgcn_sched_barrier(0)
    Unit cur, nxt; int ui = 0;
    if (!S.next(0, cur)) return;
    f32x4 acc[2][2][4][2];
#pragma unroll
    for (int a = 0; a < 2; ++a)
#pragma unroll
        for (int b = 0; b < 2; ++b)
#pragma unroll
            for (int m = 0; m < 4; ++m)
#pragma unroll
                for (int n = 0; n < 2; ++n) acc[a][b][m][n] = (f32x4){0.f, 0.f, 0.f, 0.f};
    bf16x8 At[4][2], B0[2][2], B1[2][2];
    const char* cA = (const char*)g.A + (GATHER ? (size_t)0 : (size_t)cur.pm * tstep); const char* cB = (const char*)g.Bt + (size_t)cur.pn * tstep;
    S.a_ready(cur);
    if constexpr (GATHER) PG8_GOFF(offc, cur);
    if constexpr (SP2) {
        PG8_STAGE(PG8_SB(0, 0), cB, voffB); PG8_STAGE(PG8_SB(0, 1), cB + hstep, voffB); PG8_STAGE_A(PG8_SA(0, 0), cA, offc[0]); PG8_STAGE_A(PG8_SA(0, 1), cA, offc[1]);
        if (wr == 1) PG8_BAR;
        PG8_WAIT_V(2); PG8_BAR;
        PG8_STAGE(PG8_SB(1, 0), cB + kstep, voffB); PG8_STAGE_A(PG8_SA(1, 0), cA + kstep, offc[0]); PG8_STAGE(PG8_SB(1, 1), cB + hstep + kstep, voffB);
        PG8_WAIT_V(6); PG8_BAR;
    } else {
        PG8_STAGE(PG8_SB(0, 0), cB, voffB); PG8_STAGE_A(PG8_SA(0, 0), cA, offc[0]); PG8_STAGE(PG8_SB(0, 1), cB + hstep, voffB); PG8_STAGE_A(PG8_SA(0, 1), cA, offc[1]);
        if (wr == 1) PG8_BAR;
        PG8_WAIT_V(4); PG8_BAR;
        PG8_STAGE(PG8_SB(1, 0), cB + kstep, voffB); PG8_STAGE_A(PG8_SA(1, 0), cA + kstep, offc[0]); PG8_STAGE(PG8_SB(1, 1), cB + hstep + kstep, voffB);
        PG8_WAIT_V(6); PG8_BAR;
    }
    for (;;) {
        const bool has_next = S.next(ui + 1, nxt);
        const char* nA = (has_next && !GATHER) ? (const char*)g.A + (size_t)nxt.pm * tstep : cA; const char* nB = has_next ? (const char*)g.Bt + (size_t)nxt.pn * tstep : cB;
        if constexpr (GATHER) { if (has_next) PG8_GOFF(offn, nxt); else {
#pragma unroll
            for (int h_ = 0; h_ < 2; ++h_)
#pragma unroll
                for (int i = 0; i < 2; ++i) offn[h_][i] = offc[h_][i]; } }
        for (int t = 0; t < nt; t += 2) {
            const bool last = (t == nt - 2);
            const char* a1 = cA + (size_t)(t + 1) * kstep;
            const char* a2 = last ? nA : cA + (size_t)(t + 2) * kstep; const char* b2 = last ? nB : cB + (size_t)(t + 2) * kstep;
            const char* a3 = a2 + kstep; const char* b3 = b2 + kstep;
            if (last && has_next) S.a_ready(nxt);
            if constexpr (SP2) {
            PG8_LDB(B0, 0, 0); PG8_LDB(B1, 0, 1); PG8_SCHED; PG8_LDA(At, 0, 0); PG8_STAGE_A(PG8_SA(1, 1), a1, offc[1]); if constexpr (GATHER) { if (last) { offc[0][0] = offn[0][0]; offc[0][1] = offn[0][1]; offc[1][0] = offn[1][0]; offc[1][1] = offn[1][1]; } }
            PG8_WAIT_V(8); PG8_WAIT_L(0); PG8_BAR; PG8_MMA(0, 0, At, B0); PG8_MMA(0, 1, At, B1); PG8_BAR; PG8_SCHED;
            PG8_LDA(At, 0, 1); PG8_STAGE(PG8_SB(0, 0), b2, voffB); PG8_STAGE(PG8_SB(0, 1), b2 + hstep, voffB); PG8_STAGE_A(PG8_SA(0, 0), a2, offc[0]);
            PG8_WAIT_V(8); PG8_WAIT_L(0); PG8_BAR; PG8_MMA(1, 0, At, B0); PG8_MMA(1, 1, At, B1); PG8_BAR; PG8_SCHED;
            PG8_LDB(B0, 1, 0); PG8_LDB(B1, 1, 1); PG8_SCHED; PG8_LDA(At, 1, 0); PG8_STAGE_A(PG8_SA(0, 1), a2, offc[1]);
            PG8_WAIT_V(8); PG8_WAIT_L(0); PG8_BAR; PG8_MMA(0, 0, At, B0); PG8_MMA(0, 1, At, B1); PG8_BAR; PG8_SCHED;
            PG8_LDA(At, 1, 1); PG8_STAGE(PG8_SB(1, 0), b3, voffB); PG8_STAGE(PG8_SB(1, 1), b3 + hstep, voffB); PG8_STAGE_A(PG8_SA(1, 0), a3, offc[0]);
            PG8_WAIT_V(8); PG8_WAIT_L(0); PG8_BAR; PG8_MMA(1, 0, At, B0); PG8_MMA(1, 1, At, B1); PG8_BAR; PG8_SCHED;
            } else {
            PG8_LDB(B0, 0, 0); PG8_SCHED; PG8_LDA(At, 0, 0); PG8_STAGE_A(PG8_SA(1, 1), a1, offc[1]); if constexpr (GATHER) { if (last) { offc[0][0] = offn[0][0]; offc[0][1] = offn[0][1]; offc[1][0] = offn[1][0]; offc[1][1] = offn[1][1]; } }
            PG8_WAIT_L(8); PG8_BAR; PG8_WAIT_L(0); PG8_MMA(0, 0, At, B0); PG8_BAR; PG8_SCHED;
            PG8_LDB(B1, 0, 1); PG8_STAGE(PG8_SB(0, 0), b2, voffB);
            PG8_BAR; PG8_WAIT_L(0); PG8_MMA(0, 1, At, B1); PG8_BAR;
            PG8_LDA(At, 0, 1); PG8_STAGE_A(PG8_SA(0, 0), a2, offc[0]);
            PG8_BAR; PG8_WAIT_L(0); PG8_MMA(1, 0, At, B0); PG8_BAR; PG8_SCHED;
            PG8_STAGE(PG8_SB(0, 1), b2 + hstep, voffB);
            PG8_WAIT_V(6); PG8_BAR; PG8_MMA(1, 1, At, B1); PG8_BAR;
            PG8_LDB(B0, 1, 0); PG8_SCHED; PG8_LDA(At, 1, 0); PG8_STAGE_A(PG8_SA(0, 1), a2, offc[1]);
            PG8_WAIT_L(8); PG8_BAR; PG8_WAIT_L(0); PG8_MMA(0, 0, At, B0); PG8_BAR; PG8_SCHED;
            PG8_LDB(B1, 1, 1); PG8_STAGE(PG8_SB(1, 0), b3, voffB);
            PG8_BAR; PG8_WAIT_L(0); PG8_MMA(0, 1, At, B1); PG8_BAR;
            PG8_LDA(At, 1, 1); PG8_STAGE_A(PG8_SA(1, 0), a3, offc[0]);
            PG8_BAR; PG8_WAIT_L(0); PG8_MMA(1, 0, At, B0); PG8_BAR; PG8_SCHED;
            PG8_STAGE(PG8_SB(1, 1), b3 + hstep, voffB);
            PG8_WAIT_V(6); PG8_BAR; PG8_MMA(1, 1, At, B1); PG8_BAR;
            }
        }
        if constexpr (ALIGN_EPI) { if (wr == 0) PG8_BAR; }
        if constexpr (!Epi::AFTER_DRAIN) { E(acc, cur, wr, wc, fr, fq); S.done(cur); }
        if (!has_next) break;
#pragma unroll
        for (int a = 0; a < 2; ++a)
#pragma unroll
            for (int b = 0; b < 2; ++b)
#pragma unroll
                for (int m = 0; m < 4; ++m)
#pragma unroll
                    for (int n = 0; n < 2; ++n) acc[a][b][m][n] = (f32x4){0.f, 0.f, 0.f, 0.f};
        cur = nxt; cA = nA; cB = nB; ++ui;

        if constexpr (ALIGN_EPI) { if (wr == 1) PG8_BAR; }
    }
    PG8_WAIT_V(0);
    if constexpr (!ALIGN_EPI) { if (wr == 0) PG8_BAR; }
    PG8_BAR;
    if constexpr (Epi::AFTER_DRAIN) { E.fused(acc, cur, wr, wc, fr, fq, lds, wid, lane); S.done(cur); }
#undef PG8_SA
#undef PG8_SB
#undef PG8_STAGE
#undef PG8_STAGE_A
#undef PG8_GOFF
#undef PG8_LDA
#undef PG8_LDB
#undef PG8_MMA
#undef PG8_WAIT_V
#undef PG8_WAIT_L
#undef PG8_BAR
#undef PG8_SCHED
}
}

#define LAS __attribute__((address_space(3)))
#ifndef PHASE_FN
#define PHASE_FN __device__ __forceinline__
#endif
#ifndef GEMM_SP2
#define GEMM_SP2 true
#endif
#ifndef GEMM_ALIGN
#define GEMM_ALIGN false
#endif
typedef unsigned short bf16;
typedef pg8::bf16x8 bf16x8;
typedef pg8::f32x4 f32x4;
typedef pg8::u32x4 u32x4;
typedef pg8::u32x2 u32x2;
constexpr int D = 1024, NB = 4, SEQ = 8192, CTX = 256, T = CTX + SEQ, NTOK = NB * T, DEPTH = 4;
constexpr int NWAVES = 8, NTHR = 512;
constexpr int NSLOT = 71680;
constexpr size_t MiB = 1u << 20;
constexpr size_t CTL_ZERO_BYTES = 2 * MiB;
constexpr int CW_BAR = 1024;
constexpr int CW_MOE = 8192;
constexpr size_t WS_MOD = 1 * MiB;
constexpr size_t WS_LB = 2 * MiB;
constexpr size_t WS_TOK = 2 * MiB + 65536;
constexpr size_t WS_SLOT_TOK = 3 * MiB;
constexpr size_t WS_SLOT_GATE = 3 * MiB + 524288;
constexpr size_t WS_S = 4 * MiB;
constexpr size_t WS_HY = 136 * MiB;
constexpr size_t WS_MIX = 268 * MiB;
constexpr size_t WS_END = 610 * MiB;
constexpr size_t ROWB = (size_t)NTOK * 1024 * 2;
constexpr size_t W_ML_WIN = 0, W_ML_WIN_SZ = (size_t)4352 * 1024 * 2;
constexpr size_t W_ML_WOUT = 17 * MiB;
constexpr size_t W_RW_IN = 21 * MiB;
constexpr size_t W_RW_G2 = 35 * MiB;
constexpr size_t W_RW_WOUT = 36 * MiB;
constexpr size_t W_HG_IN = 38 * MiB;
constexpr size_t W_HG_WOUT = 48 * MiB;
constexpr size_t W_EX13 = 50 * MiB;
constexpr size_t W_EX2 = 82 * MiB;
constexpr size_t W_BYTES = 98 * MiB;
constexpr int LDS_PHASE_BYTES = 131072;
constexpr int LDS_BYTES = 163840;
constexpr int MISC_OFF = LDS_BYTES - 2048;

#define VM_WAIT() asm volatile("s_waitcnt vmcnt(0)" ::: "memory")
#define LDS_WAIT() asm volatile("s_waitcnt lgkmcnt(0)" ::: "memory")
typedef float f32x2_t __attribute__((ext_vector_type(2))); typedef __bf16 bf16x2_t __attribute__((ext_vector_type(2)));
__device__ __forceinline__ unsigned pk2(float lo, float hi) { f32x2_t v = {lo, hi}; bf16x2_t b = __builtin_convertvector(v, bf16x2_t); return __builtin_bit_cast(unsigned, b); }
__device__ __forceinline__ unsigned f2bf(float f) { return pk2(f, f) & 0xffffu; }
__device__ __forceinline__ float bf2f(unsigned b) { return __builtin_bit_cast(float, b << 16); }
__device__ __forceinline__ float bflo(unsigned w) { return __builtin_bit_cast(float, w << 16); }
__device__ __forceinline__ float bfhi(unsigned w) { return __builtin_bit_cast(float, w & 0xffff0000u); }
__device__ __forceinline__ float wave_sum(float v) {
#pragma unroll
    for (int o = 1; o < 64; o <<= 1) v += __shfl_xor(v, o);
    return v; }
__device__ __forceinline__ float wave_max(float v) {
#pragma unroll
    for (int o = 1; o < 64; o <<= 1) v = fmaxf(v, __shfl_xor(v, o));
    return v; }
template <int CTRL> __device__ __forceinline__ float dpp_f(float v) { return __builtin_bit_cast(float, __builtin_amdgcn_update_dpp(0, __builtin_bit_cast(int, v), CTRL, 0xF, 0xF, false)); }
__device__ __forceinline__ float row16_sum(float v) { v += dpp_f<0xB1>(v); v += dpp_f<0x4E>(v); v += dpp_f<0x124>(v); v += dpp_f<0x128>(v); return v; }
template <int CTRL, int ROWMASK> __device__ __forceinline__ float dpp_keep(float old, float v) { return __builtin_bit_cast(float, __builtin_amdgcn_update_dpp(__builtin_bit_cast(int, old), __builtin_bit_cast(int, v), CTRL, ROWMASK, 0xF, false)); }
__device__ __forceinline__ float wave_scan_add(float v) {
    v += dpp_keep<0x111, 0xF>(0.f, v); v += dpp_keep<0x112, 0xF>(0.f, v); v += dpp_keep<0x114, 0xF>(0.f, v); v += dpp_keep<0x118, 0xF>(0.f, v);
    v += dpp_keep<0x142, 0xA>(0.f, v); v += dpp_keep<0x143, 0xC>(0.f, v); return v; }
__device__ __forceinline__ float wave_scan_max(float v) {
    v = fmaxf(v, dpp_keep<0x111, 0xF>(v, v)); v = fmaxf(v, dpp_keep<0x112, 0xF>(v, v)); v = fmaxf(v, dpp_keep<0x114, 0xF>(v, v)); v = fmaxf(v, dpp_keep<0x118, 0xF>(v, v));
    v = fmaxf(v, dpp_keep<0x142, 0xA>(v, v)); v = fmaxf(v, dpp_keep<0x143, 0xC>(v, v)); return v; }
__device__ __forceinline__ float wave_sum_dpp(float v) { v = row16_sum(v); v += dpp_keep<0x142, 0xA>(0.f, v); v += dpp_keep<0x143, 0xC>(0.f, v); return __builtin_bit_cast(float, __builtin_amdgcn_readlane(__builtin_bit_cast(int, v), 63)); }
__device__ __forceinline__ float lane63(float v) { return __builtin_bit_cast(float, __builtin_amdgcn_readlane(__builtin_bit_cast(int, v), 63)); }
template <int K> __device__ __forceinline__ f32x4 mm16(f32x4 acc, const LAS bf16* A, int lda, const LAS bf16* Bt, int ldb, int lane) {
    const int r = lane & 15, q = lane >> 4;
#pragma unroll
    for (int kk = 0; kk < K / 32; ++kk) {
        const bf16x8 a = *(const LAS bf16x8*)(A + r * lda + kk * 32 + q * 8);
        const bf16x8 b = *(const LAS bf16x8*)(Bt + r * ldb + kk * 32 + q * 8);
        acc = __builtin_amdgcn_mfma_f32_16x16x32_bf16(a, b, acc, 0, 0, 0); }
    return acc; }
typedef short s16x4 __attribute__((ext_vector_type(4)));
__device__ __forceinline__ bf16x8 tr_frag(const LAS bf16* X, int ld, int k0, int n0, int lane) {
    const int g = lane >> 4, a = (lane & 15) >> 2, p = lane & 3;
    const LAS bf16* p0 = X + (k0 + 8 * g + a) * ld + n0 + 4 * p;
    const s16x4 lo = __builtin_amdgcn_ds_read_tr16_b64_v4i16((LAS s16x4*)p0), hi = __builtin_amdgcn_ds_read_tr16_b64_v4i16((LAS s16x4*)(p0 + 4 * ld));
    return (bf16x8){lo[0], lo[1], lo[2], lo[3], hi[0], hi[1], hi[2], hi[3]}; }
__device__ __forceinline__ bf16x8 row_frag(const LAS bf16* A, int ld, int k0, int lane) { return *(const LAS bf16x8*)(A + (lane & 15) * ld + k0 + (lane >> 4) * 8); }
__device__ __forceinline__ f32x4 ldS4(const GAS unsigned char* S, size_t vi) {
    if (S_BF16) { const u32x2 w = ((const GAS u32x2*)S)[vi]; return (f32x4){bflo(w.x), bfhi(w.x), bflo(w.y), bfhi(w.y)}; }
    return ((const GAS f32x4*)S)[vi]; }
__device__ __forceinline__ void stS4(GAS unsigned char* S, size_t vi, f32x4 v) {
    if (S_BF16) { u32x2 w; w.x = pk2(v[0], v[1]); w.y = pk2(v[2], v[3]); ((GAS u32x2*)S)[vi] = w; }
    else ((GAS f32x4*)S)[vi] = v; }
__device__ __forceinline__ int seq_row(int b, int dir, int i) {
    const int tt = (i < CTX) ? (dir ? CTX - 1 - i : i) : CTX + (dir ? SEQ - 1 - (i - CTX) : (i - CTX));
    return b * T + tt; }

#define XB_TMO      128
#define XB_XCNT(j)  (256  + 64 * (j))
#define XB_XSUB(j)  (1280 + 64 * (j))
#define XB_XGEN(j)  (2304 + 64 * (j))
#define XB_TOP      3328
#define XB_TOPGEN   3392
#define XCD_BAR_WORDS 3456
#define XB_SPIN_CAP (1u << 18)

__device__ __forceinline__ unsigned xb_ld(unsigned* p)              { return __hip_atomic_load(p, __ATOMIC_RELAXED, __HIP_MEMORY_SCOPE_AGENT); }
__device__ __forceinline__ unsigned xb_add(unsigned* p, unsigned v) { return __hip_atomic_fetch_add(p, v, __ATOMIC_RELAXED, __HIP_MEMORY_SCOPE_AGENT); }
__device__ __forceinline__ unsigned xb_xcc_id() { return (unsigned)__builtin_amdgcn_s_getreg((3 << 11) | 20) & 0xFu; }
#define XB_SPIN(cond, bar) do { unsigned _sp = 0; while (cond) { __builtin_amdgcn_s_sleep(1); \
    if ((++_sp & 255u) == 0u) { if (xb_ld(&(bar)[XB_TMO])) break; if (_sp > XB_SPIN_CAP) { atomicAdd(&(bar)[XB_TMO], 1u); break; } } } } while (0)

struct XcdBarrier {
    unsigned* bar; unsigned x;
    volatile LAS unsigned* st;
};

__device__ __forceinline__ XcdBarrier xcd_barrier_post(unsigned* bar, volatile LAS unsigned* st) {
    XcdBarrier b; b.bar = bar; b.x = xb_xcc_id(); b.st = st;
    if (threadIdx.x == 0) (void)xb_add(&bar[XB_XCNT(b.x)], 1u);
    return b;
}
__device__ __forceinline__ void xcd_barrier_complete(unsigned* bar, unsigned x, unsigned& nloc, unsigned& nx) {
    const unsigned G = gridDim.x * gridDim.y * gridDim.z;
    unsigned sum, cnt, mine, sp = 0u;
    for (;;) {
        sum = 0u; cnt = 0u; mine = 0u;
#pragma unroll
        for (unsigned j = 0; j < 16; ++j) { const unsigned c = xb_ld(&bar[XB_XCNT(j)]); sum += c; cnt += (c > 0u) ? 1u : 0u; mine = (j == x) ? c : mine; }
        if (sum == G) break;
        __builtin_amdgcn_s_sleep(1);
        if ((++sp & 255u) == 0u) { if (xb_ld(&bar[XB_TMO])) break; if (sp > XB_SPIN_CAP) { atomicAdd(&bar[XB_TMO], 1u); break; } }
    }
    nloc = mine > 0u ? mine : 1u; nx = cnt > 0u ? cnt : 1u;
}

__device__ __forceinline__ void xcd_barrier(const XcdBarrier& b) {
    asm volatile("s_waitcnt vmcnt(0)" ::: "memory");
    __syncthreads();
    if (threadIdx.x == 0) {
        unsigned* bar = b.bar;
        __builtin_amdgcn_s_waitcnt(0);
        unsigned nloc = b.st[0], nx = b.st[1];
        if (nloc == 0u) { xcd_barrier_complete(bar, b.x, nloc, nx); b.st[0] = nloc; b.st[1] = nx; }
        const unsigned old = xb_add(&bar[XB_XSUB(b.x)], 1u);
        const unsigned gen = old / nloc;
        if (old + 1u == (gen + 1u) * nloc) {
            __builtin_amdgcn_fence(__ATOMIC_RELEASE, "agent");
            asm volatile("s_waitcnt vmcnt(0)" ::: "memory");
            const unsigned og = xb_add(&bar[XB_TOP], 1u);
            const unsigned tg = og / nx;
            if (og + 1u == (tg + 1u) * nx) xb_add(&bar[XB_TOPGEN], 1u);
            else XB_SPIN(xb_ld(&bar[XB_TOPGEN]) == tg, bar);
            __builtin_amdgcn_fence(__ATOMIC_ACQUIRE, "agent");
            xb_add(&bar[XB_XGEN(b.x)], 1u);
            asm volatile("s_waitcnt vmcnt(0)" ::: "memory");
        } else {
            XB_SPIN(xb_ld(&bar[XB_XGEN(b.x)]) == gen, bar);
            __builtin_amdgcn_fence(__ATOMIC_ACQUIRE, "agent");
            asm volatile("s_waitcnt vmcnt(0)" ::: "memory");
        }
    }
    __syncthreads();
}

struct Args { const float* in[42]; float* out; unsigned char* ws; unsigned char* wts; int ph_lo, ph_hi; };
struct Frame {
    LAS unsigned char* lds; GAS float* out; GAS unsigned char* ws; GAS unsigned char* W;
    int tid, lane, wave, bid, G;
};
constexpr int PTAB_OFF = MISC_OFF + 512;
__device__ __forceinline__ const GAS float* ldptr(const Frame& F, int i) { const unsigned long long v = ((const LAS unsigned long long*)(F.lds + PTAB_OFF))[i];
    const unsigned lo = __builtin_amdgcn_readfirstlane((unsigned)v), hi = __builtin_amdgcn_readfirstlane((unsigned)(v >> 32)); return (const GAS float*)(((unsigned long long)hi << 32) | lo); }
#define INP(i) ldptr(F, (i))
__device__ __forceinline__ Frame fresh(const Frame& F0) { Frame F = F0; int t; asm volatile("v_mbcnt_lo_u32_b32 %0, -1, 0\n\tv_mbcnt_hi_u32_b32 %0, -1, %0\n\tv_lshl_add_u32 %0, %1, 6, %0" : "=&v"(t) : "s"(F0.wave));     F.tid = t; F.lane = t & 63; F.wave = __builtin_amdgcn_readfirstlane(t >> 6);
    asm volatile("" : "+s"(F.bid), "+s"(F.G), "+s"(F.ws), "+s"(F.W), "+s"(F.out)); return F; }
enum { IN_X = 0, IN_C, IN_CTX, IN_CCTX, IN_ADAW, IN_ADAB, IN_NMIX, IN_NFFN, IN_NOUT, IN_ML_WIN, IN_ML_WGATE, IN_ML_BGATE, IN_ML_CONV, IN_ML_HEADG, IN_ML_WOUT,
       IN_RW_MU, IN_RW_WRKV, IN_RW_W0, IN_RW_W1, IN_RW_W2, IN_RW_A0, IN_RW_A1, IN_RW_A2, IN_RW_G1, IN_RW_G2, IN_RW_KK, IN_RW_KA, IN_RW_RK, IN_RW_LNW, IN_RW_LNB, IN_RW_WOUT,
       IN_HG_WIN, IN_HG_WF, IN_HG_BF, IN_HG_LB, IN_HG_HEADG, IN_HG_WOUT, IN_ROUTER_W, IN_ROUTER_B, IN_EX_W1, IN_EX_W3, IN_EX_W2 };

template <int MAP> __device__ __forceinline__ int rowmap(int n) { return MAP == 0 ? n : (MAP == 1 ? 8 * (n >> 2) + (n & 3) : 8 * (n >> 2) + 4 + (n & 3)); }
template <int MAP> __device__ __forceinline__ void tr_item(const GAS float* W, int ldw, int nblk, GAS bf16* WT, int ldd, int row_off, int k_off, const GAS float* kscale, LAS float* scr, int item, int lane) {
    const int kb = item / nblk, nb = item - kb * nblk, k0 = 64 * kb, n0 = 32 * nb;
#pragma unroll 8
    for (int i = 0; i < 32; ++i) { const int kk = 2 * i + (lane >> 5); float v = W[(size_t)(k0 + kk) * ldw + n0 + (lane & 31)]; if (kscale) v *= kscale[k0 + kk]; scr[kk * 33 + (lane & 31)] = v; }
    LDS_WAIT(); asm volatile("" ::: "memory");
    const int c = lane & 7;
#pragma unroll
    for (int j = 0; j < 4; ++j) { const int n = (lane >> 3) + 8 * j; const LAS float* s = scr + (8 * c) * 33 + n;
        u32x4 o; o.x = pk2(s[0 * 33], s[1 * 33]); o.y = pk2(s[2 * 33], s[3 * 33]); o.z = pk2(s[4 * 33], s[5 * 33]); o.w = pk2(s[6 * 33], s[7 * 33]);
        *(GAS u32x4*)(WT + (size_t)(row_off + rowmap<MAP>(n0 + n)) * ldd + k_off + k0 + 8 * c) = o; }
    LDS_WAIT(); asm volatile("" ::: "memory");
}
#define TRJOB(MAP, cnt, ...) if (r < (cnt)) { tr_item<MAP>(__VA_ARGS__, scr, r, F.lane); continue; } r -= (cnt);

PHASE_FN void pre_phase(Frame F) {
    LAS float* scr = (LAS float*)(F.lds + F.wave * 16384);
    const int gw = F.bid * NWAVES + F.wave, NGW = F.G * NWAVES;
    const size_t gt = (size_t)F.bid * NTHR + F.tid, NGT = (size_t)F.G * NTHR;
    GAS bf16* W = (GAS bf16*)F.W;
    constexpr int NITEMS = 2 * 2048 + 2 * 512 + 6 * 512 + 4 * 32 + 4 * 32 + 2 * 64 + 64 + 512 + 1536 + 2 * 512 + 512;
    for (int it = gw; it < NITEMS; it += NGW) {
        int r = it;
        TRJOB(0, 2048, INP(IN_ML_WIN), 4096, 128, (GAS bf16*)(F.W + W_ML_WIN), 1024, 0, 0, nullptr)
        TRJOB(0, 2048, INP(IN_ML_WIN) + (size_t)1024 * 4096, 4096, 128, (GAS bf16*)(F.W + W_ML_WIN + W_ML_WIN_SZ), 1024, 0, 0, nullptr)
        TRJOB(0, 512, INP(IN_ML_WOUT), 1024, 32, (GAS bf16*)(F.W + W_ML_WOUT), 1024, 0, 0, nullptr)
        TRJOB(0, 512, INP(IN_ML_WOUT) + (size_t)1024 * 1024, 1024, 32, (GAS bf16*)(F.W + W_ML_WOUT + 2 * MiB), 1024, 0, 0, nullptr)
        GAS bf16* RWIN = (GAS bf16*)(F.W + W_RW_IN); const GAS float* mu = INP(IN_RW_MU);
        if (r < 6 * 512) { const int idx = r / 1024, ps = (r / 512) & 1, rr = r & 511;
            tr_item<0>(INP(IN_RW_WRKV) + (size_t)idx * 1024 * 1024, 1024, 32, RWIN, 2048, idx * 1024, ps * 1024, ps ? mu + idx * 1024 : nullptr, scr, rr, F.lane); continue; } r -= 6 * 512;
        if (r < 4 * 32) { const int dir = r / 64, ps = (r / 32) & 1, rr = r & 31;
            tr_item<0>(INP(IN_RW_W1) + (size_t)dir * 1024 * 64, 64, 2, RWIN, 2048, 3072 + dir * 64, ps * 1024, ps ? mu + 3 * 1024 : nullptr, scr, rr, F.lane); continue; } r -= 4 * 32;
        if (r < 4 * 32) { const int dir = r / 64, ps = (r / 32) & 1, rr = r & 31;
            tr_item<0>(INP(IN_RW_A1) + (size_t)dir * 1024 * 64, 64, 2, RWIN, 2048, 3200 + dir * 64, ps * 1024, ps ? mu + 4 * 1024 : nullptr, scr, rr, F.lane); continue; } r -= 4 * 32;
        if (r < 2 * 64) { const int ps = r / 64, rr = r & 63;
            tr_item<0>(INP(IN_RW_G1), 128, 4, RWIN, 2048, 3328, ps * 1024, ps ? mu + 5 * 1024 : nullptr, scr, rr, F.lane); continue; } r -= 2 * 64;
        TRJOB(0, 64, INP(IN_RW_G2), 1024, 32, (GAS bf16*)(F.W + W_RW_G2), 256, 0, 0, nullptr)
        TRJOB(0, 512, INP(IN_RW_WOUT), 1024, 32, (GAS bf16*)(F.W + W_RW_WOUT), 1024, 0, 0, nullptr)
        TRJOB(0, 1536, INP(IN_HG_WIN), 3072, 96, (GAS bf16*)(F.W + W_HG_IN), 1024, 0, 0, nullptr)
        TRJOB(0, 512, INP(IN_HG_WF), 1024, 32, (GAS bf16*)(F.W + W_HG_IN), 1024, 3072, 0, nullptr)
        TRJOB(0, 512, INP(IN_HG_WF) + (size_t)1024 * 1024, 1024, 32, (GAS bf16*)(F.W + W_HG_IN), 1024, 4096, 0, nullptr)
        TRJOB(0, 512, INP(IN_HG_WOUT), 1024, 32, (GAS bf16*)(F.W + W_HG_WOUT), 1024, 0, 0, nullptr)
    }
    for (size_t i = gt; i < (size_t)2 * 256 * 1024; i += NGT) { const int j = (int)(i >> 18), rr = (int)((i >> 10) & 255), k = (int)(i & 1023);
        float v = 0.f; if (rr < 32) { const int dir = rr >> 4, g = rr & 15; v = INP(IN_ML_WGATE)[((size_t)(j * 2 + dir) * 1024 + k) * 16 + g]; }
        ((GAS bf16*)(F.W + W_ML_WIN + j * W_ML_WIN_SZ))[(size_t)(4096 + rr) * 1024 + k] = (bf16)f2bf(v); }
    for (size_t i = gt; i < (size_t)128 * 2048; i += NGT) ((GAS bf16*)(F.W + W_RW_IN))[(size_t)3456 * 2048 + i] = 0;
    for (size_t i = gt; i < (size_t)1024 * 128; i += NGT) ((GAS bf16*)(F.W + W_RW_G2))[(i >> 7) * 256 + 128 + (i & 127)] = 0;
    if (F.bid == 0) for (int c = F.tid; c < 1024; c += NTHR) { const GAS float* lg = INP(IN_HG_LB) + c; const float l0 = lg[0], l1 = lg[1024], l2 = lg[2048], l3 = lg[3072];
        const float mx = fmaxf(fmaxf(l0, l1), fmaxf(l2, l3)); const float e0 = __expf(l0 - mx), e1 = __expf(l1 - mx), e2 = __expf(l2 - mx), e3 = __expf(l3 - mx);
        ((GAS float*)(F.ws + WS_LB))[c] = (e1 + e2) / (e0 + e1 + e2 + e3); }
    { GAS unsigned char* S4 = F.ws + WS_S;
      for (size_t i = gt; i < (size_t)NTOK * 256; i += NGT) { const int m = (int)(i >> 8), c4 = (int)(i & 255); const int b = m / T, t = m - b * T;
          const GAS float* src = (t < CTX) ? INP(IN_CTX) + ((size_t)(b * CTX + t)) * 1024 : INP(IN_X) + ((size_t)(b * SEQ + t - CTX)) * 1024;
          stS4(S4, i, ((const GAS f32x4*)src)[c4]); } }
    { LAS float* sc = (LAS float*)(F.lds + 8448); GAS float* MODP = (GAS float*)(F.ws + WS_MIX);
      for (int it = F.bid; it < 768; it += F.G) { const int i = it / 192, rem = it - i * 192, kc = rem / 12, jb = rem - kc * 12;
          __syncthreads();
          if (F.tid < 320) { const int seg = F.tid >> 6, kk = F.tid & 63; const float cv = seg == 0 ? INP(IN_CCTX)[kc * 64 + kk] : INP(IN_C)[(seg - 1) * 1024 + kc * 64 + kk]; sc[F.tid] = silu_f(cv); }
          __syncthreads();
          const int j = jb * 512 + F.tid; const GAS float* wp = INP(IN_ADAW) + ((size_t)i * 1024 + kc * 64) * 6144 + j;
          float a0 = 0.f, a1 = 0.f, a2 = 0.f, a3 = 0.f, a4 = 0.f;
#pragma unroll 8
          for (int kk = 0; kk < 64; ++kk) { const float w = wp[(size_t)kk * 6144]; a0 += sc[kk] * w; a1 += sc[64 + kk] * w; a2 += sc[128 + kk] * w; a3 += sc[192 + kk] * w; a4 += sc[256 + kk] * w; }
          GAS float* mp = MODP + ((size_t)kc * 4 + i) * 5 * 6144 + j;
          mp[0] = a0; mp[6144] = a1; mp[2 * 6144] = a2; mp[3 * 6144] = a3; mp[4 * 6144] = a4; } }
}
PHASE_FN void modsum_phase(Frame F) {
    const GAS float* MODP = (const GAS float*)(F.ws + WS_MIX); GAS float* MOD = (GAS float*)(F.ws + WS_MOD);
    for (int idx = F.bid * NTHR + F.tid; idx < 4 * 5 * 6144; idx += F.G * NTHR) { const int i = idx / (5 * 6144), j = idx % 6144;
        float a = INP(IN_ADAB)[i * 6144 + j];
#pragma unroll
        for (int kc = 0; kc < 16; ++kc) a += MODP[(size_t)kc * 4 * 5 * 6144 + idx];
        MOD[idx] = a; }
}
struct ExwItem { const GAS float* src; GAS bf16* dst; int ldw, ldd, map; };
__device__ __forceinline__ ExwItem exw_item(const Frame& F, const GAS float* w1, const GAS float* w3, const GAS float* w2, int it) {
    const int which = it >> 12, e = (it >> 8) & 15, rr = it & 255; ExwItem x;
    if (which < 2) { const int kb = rr >> 4, nb = rr & 15; x.src = (which ? w3 : w1) + (size_t)e * 1024 * 512 + (size_t)(64 * kb) * 512 + 32 * nb; x.ldw = 512; x.ldd = 1024; x.map = which + 1;
        x.dst = (GAS bf16*)(F.W + W_EX13) + (size_t)(e * 1024 + 2 * (32 * nb)) * 1024 + 64 * kb; }
    else { const int kb = rr >> 5, nb = rr & 31; x.src = w2 + (size_t)e * 512 * 1024 + (size_t)(64 * kb) * 1024 + 32 * nb; x.ldw = 1024; x.ldd = 512; x.map = 0;
        x.dst = (GAS bf16*)(F.W + W_EX2) + (size_t)(e * 1024 + 32 * nb) * 512 + 64 * kb; }
    return x; }
PHASE_FN void expert_weights(Frame F, int L) {
    LAS float* scr = (LAS float*)(F.lds + F.wave * 16384);
    const int gw = F.bid * NWAVES + F.wave, NGW = F.G * NWAVES, lane = F.lane;
    const GAS float* w1 = INP(IN_EX_W1) + (size_t)L * 16 * 1024 * 512; const GAS float* w3 = INP(IN_EX_W3) + (size_t)L * 16 * 1024 * 512; const GAS float* w2 = INP(IN_EX_W2) + (size_t)L * 16 * 512 * 1024;
    const int lk = lane >> 3, ln = (lane & 7) * 4;
    f32x4 v[8]; int it = gw;
    if (it < 3 * 4096) { const ExwItem x = exw_item(F, w1, w3, w2, it);
#pragma unroll
        for (int i = 0; i < 8; ++i) v[i] = *(const GAS f32x4*)(x.src + (size_t)(lk + 8 * i) * x.ldw + ln); }
    for (; it < 3 * 4096; it += NGW) {
        const ExwItem x = exw_item(F, w1, w3, w2, it);
#pragma unroll
        for (int i = 0; i < 8; ++i) { LAS float* d = scr + (lk + 8 * i) * 33 + ln; d[0] = v[i][0]; d[1] = v[i][1]; d[2] = v[i][2]; d[3] = v[i][3]; }
        if (it + NGW < 3 * 4096) { const ExwItem y = exw_item(F, w1, w3, w2, it + NGW);
#pragma unroll
            for (int i = 0; i < 8; ++i) v[i] = *(const GAS f32x4*)(y.src + (size_t)(lk + 8 * i) * y.ldw + ln); }
        LDS_WAIT(); asm volatile("" ::: "memory");
        const int c = lane & 7;
#pragma unroll
        for (int j = 0; j < 4; ++j) { const int n = (lane >> 3) + 8 * j; const LAS float* s_ = scr + (8 * c) * 33 + n;
            u32x4 o; o.x = pk2(s_[0 * 33], s_[1 * 33]); o.y = pk2(s_[2 * 33], s_[3 * 33]); o.z = pk2(s_[4 * 33], s_[5 * 33]); o.w = pk2(s_[6 * 33], s_[7 * 33]);
            const int drow = x.map == 0 ? n : 2 * (n & ~3) + (n & 3) + (x.map == 2 ? 4 : 0);
            *(GAS u32x4*)(x.dst + (size_t)drow * x.ldd + 8 * c) = o; }
        LDS_WAIT(); asm volatile("" ::: "memory");
    }
}

template <int MODE, int PRB = 0> PHASE_FN void norm_phase(Frame F, int L, bool add_moe, int ldh) {
    GAS unsigned char* S = F.ws + WS_S; GAS bf16* H = (GAS bf16*)(F.ws + WS_HY); const GAS bf16* YM = (const GAS bf16*)(F.ws + WS_MIX + 210 * MiB);
    const GAS float* MOD = (const GAS float*)(F.ws + WS_MOD);
    const int gw = F.bid * NWAVES + F.wave, NGW = F.G * NWAVES, lane = F.lane;
    LAS float* rwl = (LAS float*)F.lds;
    LAS int* cntl = (LAS int*)(F.lds + 65536);
    if (MODE == 1) {
        for (int i = F.tid; i < 16384; i += NTHR) { const int c = i >> 4, e = i & 15; rwl[e * 1024 + c] = INP(IN_ROUTER_W)[i]; }
        if (F.tid < 16) cntl[F.tid] = 0;
        __syncthreads();
    }
    const GAS float* gnp = MODE == 0 ? INP(IN_NMIX) + L * 1024 : (MODE == 1 ? INP(IN_NFFN) + L * 1024 : INP(IN_NOUT));
    for (int m = gw; m < NTOK; m += NGW) {
        const int b = m / T, t = m - b * T, seg = t < CTX ? 0 : 1 + b;
        if (MODE == 2 && t < CTX) continue;
        f32x4 v[4]; const size_t sp = (size_t)m * 256 + lane;
#pragma unroll
        for (int j = 0; j < 4; ++j) v[j] = ldS4(S, sp + 64 * j);
        if (add_moe) {
            const GAS float* gp = MOD + ((size_t)((MODE == 2 ? 3 : L - 1) * 5 + seg)) * 6144 + 5 * 1024;
            const GAS u32x2* ya = (const GAS u32x2*)(YM + (size_t)(2 * m) * 1024) + lane; const GAS u32x2* yb = ya + 256;
#pragma unroll
            for (int j = 0; j < 4; ++j) { const u32x2 a = ya[64 * j], bq = yb[64 * j]; const f32x4 g = ((const GAS f32x4*)gp)[lane + 64 * j];
                v[j][0] += g[0] * (bflo(a.x) + bflo(bq.x)); v[j][1] += g[1] * (bfhi(a.x) + bfhi(bq.x)); v[j][2] += g[2] * (bflo(a.y) + bflo(bq.y)); v[j][3] += g[3] * (bfhi(a.y) + bfhi(bq.y)); }
            if (MODE != 2 && !PRB) {
#pragma unroll
                for (int j = 0; j < 4; ++j) stS4(S, sp + 64 * j, v[j]); }
        }
        float ss = 0.f;
#pragma unroll
        for (int j = 0; j < 4; ++j) ss += (v[j][0] * v[j][0] + v[j][1] * v[j][1]) + (v[j][2] * v[j][2] + v[j][3] * v[j][3]);
        const float rinv = __builtin_amdgcn_rsqf(wave_sum_dpp(ss) * (1.0f / 1024.0f) + 1e-6f);
        if (MODE == 2) { GAS f32x4* op = (GAS f32x4*)(F.out + ((size_t)(b * SEQ + t - CTX)) * 1024) + lane;
#pragma unroll
            for (int j = 0; j < 4; ++j) { const f32x4 g = ((const GAS f32x4*)gnp)[lane + 64 * j]; op[64 * j] = v[j] * rinv * g; }
            continue; }
        const GAS float* mp = MOD + ((size_t)(L * 5 + seg)) * 6144 + (MODE == 0 ? 0 : 3 * 1024);
        f32x4 h[4];
#pragma unroll
        for (int j = 0; j < 4; ++j) { const f32x4 g = ((const GAS f32x4*)gnp)[lane + 64 * j], sh = ((const GAS f32x4*)mp)[lane + 64 * j], sc = ((const GAS f32x4*)(mp + 1024))[lane + 64 * j];
            h[j] = v[j] * rinv * g * (sc + 1.0f) + sh;
            u32x2 o; o.x = pk2(h[j][0], h[j][1]); o.y = pk2(h[j][2], h[j][3]); *((GAS u32x2*)(H + (size_t)m * ldh) + lane + 64 * j) = o; }
        if (MODE == 1) {
            float lg[16];
#pragma unroll
            for (int e = 0; e < 16; ++e) { float a = 0.f;
#pragma unroll
                for (int j = 0; j < 4; ++j) { const f32x4 w = *(const LAS f32x4*)(rwl + e * 1024 + 256 * j + 4 * lane); a += (h[j][0] * w[0] + h[j][1] * w[1]) + (h[j][2] * w[2] + h[j][3] * w[3]); }
                lg[e] = wave_sum_dpp(a); }
            float aff[16], sel[16];
#pragma unroll
            for (int e = 0; e < 16; ++e) { aff[e] = sigmoid_f(lg[e]); sel[e] = aff[e] + INP(IN_ROUTER_B)[e]; }
            float best = -3.0e38f; int bg = 0; float s0 = 0.f, s1 = 0.f, s2 = 0.f, s3 = 0.f, a0 = 0.f, a1 = 0.f, a2 = 0.f, a3 = 0.f;
#pragma unroll
            for (int g = 0; g < 4; ++g) { const float x0 = sel[4 * g], x1 = sel[4 * g + 1], x2 = sel[4 * g + 2], x3 = sel[4 * g + 3];
                const float t1 = fmaxf(x0, x1), t2 = fminf(x0, x1), u1 = fmaxf(x2, x3), u2 = fminf(x2, x3);
                const float sum = fmaxf(t1, u1) + fmaxf(fminf(t1, u1), fmaxf(t2, u2));
                const bool bt = sum > best; best = bt ? sum : best; bg = bt ? g : bg;
                s0 = bt ? x0 : s0; s1 = bt ? x1 : s1; s2 = bt ? x2 : s2; s3 = bt ? x3 : s3;
                a0 = bt ? aff[4 * g] : a0; a1 = bt ? aff[4 * g + 1] : a1; a2 = bt ? aff[4 * g + 2] : a2; a3 = bt ? aff[4 * g + 3] : a3; }
            int i1 = 0; float m1 = s0; if (s1 > m1) { m1 = s1; i1 = 1; } if (s2 > m1) { m1 = s2; i1 = 2; } if (s3 > m1) { m1 = s3; i1 = 3; }
            int i2 = -1; float m2 = -3.0e38f;
            if (i1 != 0 && s0 > m2) { m2 = s0; i2 = 0; } if (i1 != 1 && s1 > m2) { m2 = s1; i2 = 1; } if (i1 != 2 && s2 > m2) { m2 = s2; i2 = 2; } if (i1 != 3 && s3 > m2) { m2 = s3; i2 = 3; }
            const float c1 = i1 == 0 ? a0 : (i1 == 1 ? a1 : (i1 == 2 ? a2 : a3)), c2 = i2 == 0 ? a0 : (i2 == 1 ? a1 : (i2 == 2 ? a2 : a3));
            const float inv = 1.0f / (c1 + c2);
            if (lane == 0) { const int e1 = bg * 4 + i1, e2 = bg * 4 + i2;
                u32x4 tk; tk.x = (unsigned)e1; tk.y = (unsigned)e2; tk.z = __float_as_uint(c1 * inv); tk.w = __float_as_uint(c2 * inv); ((GAS u32x4*)(F.ws + WS_TOK))[m] = tk;
                __hip_atomic_fetch_add(cntl + e1, 1, __ATOMIC_RELAXED, __HIP_MEMORY_SCOPE_WORKGROUP); __hip_atomic_fetch_add(cntl + e2, 1, __ATOMIC_RELAXED, __HIP_MEMORY_SCOPE_WORKGROUP); }
        }
    }
    if (MODE == 1) { __syncthreads(); if (F.tid < 16) __hip_atomic_fetch_add((GAS unsigned*)F.ws + CW_MOE + L * 2048 + (PRB ? 32 : 0) + 64 * F.tid, (unsigned)cntl[F.tid], __ATOMIC_RELAXED, __HIP_MEMORY_SCOPE_AGENT); }
}

template <int PRB = 0> PHASE_FN void route_phase(Frame F, int L) {
    const GAS unsigned char* S = F.ws + WS_S; GAS bf16* H = (GAS bf16*)(F.ws + WS_HY); const GAS float* MOD = (const GAS float*)(F.ws + WS_MOD);
    const int gw = F.bid * NWAVES + F.wave, NGW = F.G * NWAVES, lane = F.lane, hl = lane & 31, hi = lane >> 5;
    LAS float* rwl = (LAS float*)F.lds;
    LAS int* cntl = (LAS int*)(F.lds + 65536);
    for (int i = F.tid; i < 16384; i += NTHR) { const int c = i >> 4, e = i & 15; rwl[e * 1024 + c] = INP(IN_ROUTER_W)[i]; }
    if (F.tid < 16) cntl[F.tid] = 0;
    __syncthreads();
    const GAS float* gnp = INP(IN_NFFN) + L * 1024; const GAS float* rbp = INP(IN_ROUTER_B);
    constexpr int NP = NTOK / 2; const int pq = NP / NGW, pr = NP - pq * NGW; const int p0 = gw * pq + (gw < pr ? gw : pr), pn = pq + (gw < pr ? 1 : 0);
    f32x4 vn[8], Av[8], Bv[8]; int curseg = -1;
    if (pn > 0) { const size_t sp0 = (size_t)(2 * p0 + hi) * 256 + hl;
#pragma unroll
        for (int j = 0; j < 8; ++j) vn[j] = ldS4(S, sp0 + 32 * j); }
    for (int mp = p0; mp < p0 + pn; ++mp) {
        const int m = 2 * mp + hi; const int b = m / T, t = m - b * T, seg = t < CTX ? 0 : 1 + b;
        f32x4 v[8];
        float ss = 0.f;
#pragma unroll
        for (int j = 0; j < 8; ++j) { v[j] = vn[j]; ss += (v[j][0] * v[j][0] + v[j][1] * v[j][1]) + (v[j][2] * v[j][2] + v[j][3] * v[j][3]); }
        if (mp + 1 < p0 + pn) { const size_t spn = (size_t)(2 * (mp + 1) + hi) * 256 + hl;
#pragma unroll
            for (int j = 0; j < 8; ++j) vn[j] = ldS4(S, spn + 32 * j); }
        if (__builtin_amdgcn_readfirstlane(seg) != curseg) { curseg = __builtin_amdgcn_readfirstlane(seg); const GAS float* mpv = MOD + ((size_t)(L * 5 + curseg)) * 6144 + 3 * 1024;
#pragma unroll
            for (int j = 0; j < 8; ++j) { const f32x4 g = ((const GAS f32x4*)gnp)[hl + 32 * j], sh = ((const GAS f32x4*)mpv)[hl + 32 * j], scl = ((const GAS f32x4*)(mpv + 1024))[hl + 32 * j]; Av[j] = g * (scl + 1.0f); Bv[j] = sh; } }
        ss = row16_sum(ss); ss += dpp_keep<0x142, 0xA>(0.f, ss);
        { const float s0 = __builtin_bit_cast(float, __builtin_amdgcn_readlane(__builtin_bit_cast(int, ss), 31)), s1 = __builtin_bit_cast(float, __builtin_amdgcn_readlane(__builtin_bit_cast(int, ss), 63)); ss = hi ? s1 : s0; }
        const float rinv = __builtin_amdgcn_rsqf(ss * (1.0f / 1024.0f) + 1e-6f);
#pragma unroll
        for (int j = 0; j < 8; ++j) { v[j] = v[j] * rinv * Av[j] + Bv[j];
            u32x2 o; o.x = pk2(v[j][0], v[j][1]); o.y = pk2(v[j][2], v[j][3]); *((GAS u32x2*)(H + (size_t)m * 1024) + hl + 32 * j) = o; }
        float lg[16];
#pragma unroll
        for (int e = 0; e < 16; ++e) { float a = 0.f, a2 = 0.f;
#pragma unroll
            for (int j = 0; j < 8; ++j) { const f32x4 w = *(const LAS f32x4*)(rwl + e * 1024 + 128 * j + 4 * hl); a = fmaf(v[j][0], w[0], a); a2 = fmaf(v[j][1], w[1], a2); a = fmaf(v[j][2], w[2], a); a2 = fmaf(v[j][3], w[3], a2); }
            a += a2; a = row16_sum(a); a += dpp_keep<0x142, 0xA>(0.f, a);
            const float a0 = __builtin_bit_cast(float, __builtin_amdgcn_readlane(__builtin_bit_cast(int, a), 31)), a1 = __builtin_bit_cast(float, __builtin_amdgcn_readlane(__builtin_bit_cast(int, a), 63));
            lg[e] = hi ? a1 : a0; }
        float aff[16], sel[16];
#pragma unroll
        for (int e = 0; e < 16; ++e) { aff[e] = sigmoid_f(lg[e]); sel[e] = aff[e] + rbp[e]; }
        float best = -3.0e38f; int bg = 0; float s0 = 0.f, s1 = 0.f, s2 = 0.f, s3 = 0.f, a0 = 0.f, a1 = 0.f, a2 = 0.f, a3 = 0.f;
#pragma unroll
        for (int g = 0; g < 4; ++g) { const float x0 = sel[4 * g], x1 = sel[4 * g + 1], x2 = sel[4 * g + 2], x3 = sel[4 * g + 3];
            const float t1 = fmaxf(x0, x1), t2 = fminf(x0, x1), u1 = fmaxf(x2, x3), u2 = fminf(x2, x3);
            const float sum = fmaxf(t1, u1) + fmaxf(fminf(t1, u1), fmaxf(t2, u2));
            const bool bt = sum > best; best = bt ? sum : best; bg = bt ? g : bg;
            s0 = bt ? x0 : s0; s1 = bt ? x1 : s1; s2 = bt ? x2 : s2; s3 = bt ? x3 : s3;
            a0 = bt ? aff[4 * g] : a0; a1 = bt ? aff[4 * g + 1] : a1; a2 = bt ? aff[4 * g + 2] : a2; a3 = bt ? aff[4 * g + 3] : a3; }
        int i1 = 0; float m1 = s0; if (s1 > m1) { m1 = s1; i1 = 1; } if (s2 > m1) { m1 = s2; i1 = 2; } if (s3 > m1) { m1 = s3; i1 = 3; }
        int i2 = -1; float m2 = -3.0e38f;
        if (i1 != 0 && s0 > m2) { m2 = s0; i2 = 0; } if (i1 != 1 && s1 > m2) { m2 = s1; i2 = 1; } if (i1 != 2 && s2 > m2) { m2 = s2; i2 = 2; } if (i1 != 3 && s3 > m2) { m2 = s3; i2 = 3; }
        const float c1 = i1 == 0 ? a0 : (i1 == 1 ? a1 : (i1 == 2 ? a2 : a3)), c2 = i2 == 0 ? a0 : (i2 == 1 ? a1 : (i2 == 2 ? a2 : a3));
        const float inv = __builtin_amdgcn_rcpf(c1 + c2);
        if (hl == 0) { const int e1 = bg * 4 + i1, e2 = bg * 4 + i2;
            u32x4 tk; tk.x = (unsigned)e1; tk.y = (unsigned)e2; tk.z = __float_as_uint(c1 * inv); tk.w = __float_as_uint(c2 * inv); ((GAS u32x4*)(F.ws + WS_TOK))[m] = tk;
            __hip_atomic_fetch_add(cntl + e1, 1, __ATOMIC_RELAXED, __HIP_MEMORY_SCOPE_WORKGROUP); __hip_atomic_fetch_add(cntl + e2, 1, __ATOMIC_RELAXED, __HIP_MEMORY_SCOPE_WORKGROUP); }
    }
    __syncthreads();
    if (F.tid < 16) __hip_atomic_fetch_add((GAS unsigned*)F.ws + CW_MOE + L * 2048 + (PRB ? 32 : 0) + 64 * F.tid, (unsigned)cntl[F.tid], __ATOMIC_RELAXED, __HIP_MEMORY_SCOPE_AGENT);
}

__device__ __forceinline__ float qsum4r(float x) { float a = x, b = x; asm volatile("s_nop 1\n\tv_permlane16_swap_b32 %0, %1\n\ts_nop 1" : "+v"(a), "+v"(b)); const float y = a + b; float c = y, d = y; asm volatile("s_nop 1\n\tv_permlane32_swap_b32 %0, %1\n\ts_nop 1" : "+v"(c), "+v"(d)); return c + d; }
template <int PRB = 0> PHASE_FN void route2_phase(Frame F, int L) {
    const int nb = NTOK / F.G + (F.bid < NTOK % F.G ? 1 : 0), R0 = F.bid * (NTOK / F.G) + (F.bid < NTOK % F.G ? F.bid : NTOK % F.G);
    if (!S_BF16 || nb > 256) { route_phase<PRB>(F, L); return; }
    const GAS unsigned char* S = F.ws + WS_S; GAS bf16* H = (GAS bf16*)(F.ws + WS_HY); const GAS float* MOD = (const GAS float*)(F.ws + WS_MOD);
    constexpr int WP = 1032;
    LAS bf16* WHi = (LAS bf16*)F.lds; LAS bf16* WLo = WHi + 16 * WP;
    LAS float* MA = (LAS float*)(F.lds + 66048);
    LAS float* LG = (LAS float*)(F.lds + 82432);
    LAS int* cntl = (LAS int*)(F.lds + 90624);
    const int tid = F.tid, lane = F.lane, w = F.wave, r = lane & 15, q = lane >> 4;
    const int bF = R0 / T, tF = R0 - bF * T, sF = tF < CTX ? 0 : 1 + bF, bL = (R0 + nb - 1) / T, tL = (R0 + nb - 1) - bL * T, sL = tL < CTX ? 0 : 1 + bL;
    const GAS float* gnp = INP(IN_NFFN) + L * 1024; const GAS float* rbp = INP(IN_ROUTER_B);
    for (int c = tid; c < 1024; c += NTHR) { const GAS f32x4* src = (const GAS f32x4*)(INP(IN_ROUTER_W) + c * 16);
#pragma unroll
        for (int e4 = 0; e4 < 4; ++e4) { const f32x4 v = src[e4];
#pragma unroll
            for (int j = 0; j < 4; ++j) { const unsigned hi = f2bf(v[j]); WHi[(4 * e4 + j) * WP + c] = (bf16)hi; WLo[(4 * e4 + j) * WP + c] = (bf16)f2bf(v[j] - bf2f(hi)); } } }
    for (int i = tid; i < 2048; i += NTHR) { const int sl = i >> 10, c = i & 1023; const GAS float* mpv = MOD + ((size_t)(L * 5 + (sl ? sL : sF))) * 6144 + 3 * 1024;
        MA[sl * 2048 + c] = gnp[c] * (mpv[1024 + c] + 1.0f); MA[sl * 2048 + 1024 + c] = mpv[c]; }
    if (tid < 16) cntl[tid] = 0;
    __syncthreads();
    const int nw = nb / NWAVES + (w < nb % NWAVES ? 1 : 0), wr0 = R0 + w * (nb / NWAVES) + (w < nb % NWAVES ? w : nb % NWAVES);
    for (int t0 = 0; t0 < nw; t0 += 16) {
        const int nrow = (nw - t0) < 16 ? (nw - t0) : 16;
        const int row = wr0 + t0 + (r < nrow ? r : nrow - 1);
        u32x4 vs[32]; { const GAS u32x4* sp = (const GAS u32x4*)(S + (size_t)row * 2048) + q;
#pragma unroll
            for (int kk = 0; kk < 32; ++kk) vs[kk] = sp[4 * kk]; }
        float ss = 0.f;
#pragma unroll
        for (int kk = 0; kk < 32; ++kk) {
#pragma unroll
            for (int j = 0; j < 4; ++j) { const float xl = bflo(vs[kk][j]), xh = bfhi(vs[kk][j]); ss = __builtin_fmaf(xl, xl, ss); ss = __builtin_fmaf(xh, xh, ss);
                asm volatile("" : "+v"(vs[kk][j])); } }
        const float rinv = __builtin_amdgcn_rsqf(qsum4r(ss) * (1.0f / 1024.0f) + 1e-6f);
        const int b_ = row / T, t_ = row - b_ * T, seg = t_ < CTX ? 0 : 1 + b_; const LAS float* ma = MA + (seg == sF ? 0 : 2048) + 8 * q;
        const LAS bf16* whp = WHi + r * WP + 8 * q; const LAS bf16* wlp = WLo + r * WP + 8 * q; GAS bf16* hp_ = H + (size_t)row * 1024 + 8 * q;
        f32x4 acc = {0.f, 0.f, 0.f, 0.f};
#pragma unroll
        for (int kk = 0; kk < 32; ++kk) {
            const f32x4 A0 = *(const LAS f32x4*)(ma + 32 * kk), A1 = *(const LAS f32x4*)(ma + 32 * kk + 4), B0 = *(const LAS f32x4*)(ma + 1024 + 32 * kk), B1 = *(const LAS f32x4*)(ma + 1024 + 32 * kk + 4);
            const bf16x8 bh = *(const LAS bf16x8*)(whp + 32 * kk), bl = *(const LAS bf16x8*)(wlp + 32 * kk);
            const u32x4 x = vs[kk];
            const f32x4 h0 = (f32x4){bflo(x.x), bfhi(x.x), bflo(x.y), bfhi(x.y)} * rinv * A0 + B0, h1 = (f32x4){bflo(x.z), bfhi(x.z), bflo(x.w), bfhi(x.w)} * rinv * A1 + B1;
            u32x4 hi; hi.x = pk2(h0[0], h0[1]); hi.y = pk2(h0[2], h0[3]); hi.z = pk2(h1[0], h1[1]); hi.w = pk2(h1[2], h1[3]);
            const f32x4 l0 = h0 - (f32x4){bflo(hi.x), bfhi(hi.x), bflo(hi.y), bfhi(hi.y)}, l1 = h1 - (f32x4){bflo(hi.z), bfhi(hi.z), bflo(hi.w), bfhi(hi.w)};
            u32x4 lo; lo.x = pk2(l0[0], l0[1]); lo.y = pk2(l0[2], l0[3]); lo.z = pk2(l1[0], l1[1]); lo.w = pk2(l1[2], l1[3]);
            const bf16x8 ah = __builtin_bit_cast(bf16x8, hi), al = __builtin_bit_cast(bf16x8, lo);
            acc = __builtin_amdgcn_mfma_f32_16x16x32_bf16(ah, bh, acc, 0, 0, 0); acc = __builtin_amdgcn_mfma_f32_16x16x32_bf16(ah, bl, acc, 0, 0, 0); acc = __builtin_amdgcn_mfma_f32_16x16x32_bf16(al, bh, acc, 0, 0, 0);

            if (r < nrow) *(GAS u32x4*)(hp_ + 32 * kk) = hi; }
        LAS float* lgw = LG + w * 256;
#pragma unroll
        for (int i = 0; i < 4; ++i) lgw[(4 * q + i) * 16 + r] = acc[i];
        LDS_WAIT();
        if (lane < nrow) { const int m = wr0 + t0 + lane;
            float lg[16];
#pragma unroll
            for (int e4 = 0; e4 < 4; ++e4) { const f32x4 v = *(const LAS f32x4*)(lgw + lane * 16 + 4 * e4); lg[4 * e4] = v[0]; lg[4 * e4 + 1] = v[1]; lg[4 * e4 + 2] = v[2]; lg[4 * e4 + 3] = v[3]; }
            float aff[16], sel[16];
#pragma unroll
            for (int e = 0; e < 16; ++e) { aff[e] = sigmoid_f(lg[e]); sel[e] = aff[e] + rbp[e]; }
            float best = -3.0e38f; int bg = 0; float s0 = 0.f, s1 = 0.f, s2 = 0.f, s3 = 0.f, a0 = 0.f, a1 = 0.f, a2 = 0.f, a3 = 0.f;
#pragma unroll
            for (int g = 0; g < 4; ++g) { const float x0 = sel[4 * g], x1 = sel[4 * g + 1], x2 = sel[4 * g + 2], x3 = sel[4 * g + 3];
                const float t1 = fmaxf(x0, x1), t2 = fminf(x0, x1), u1 = fmaxf(x2, x3), u2 = fminf(x2, x3);
                const float sum = fmaxf(t1, u1) + fmaxf(fminf(t1, u1), fmaxf(t2, u2));
                const bool bt = sum > best; best = bt ? sum : best; bg = bt ? g : bg;
                s0 = bt ? x0 : s0; s1 = bt ? x1 : s1; s2 = bt ? x2 : s2; s3 = bt ? x3 : s3;
                a0 = bt ? aff[4 * g] : a0; a1 = bt ? aff[4 * g + 1] : a1; a2 = bt ? aff[4 * g + 2] : a2; a3 = bt ? aff[4 * g + 3] : a3; }
            int i1 = 0; float m1 = s0; if (s1 > m1) { m1 = s1; i1 = 1; } if (s2 > m1) { m1 = s2; i1 = 2; } if (s3 > m1) { m1 = s3; i1 = 3; }
            int i2 = -1; float m2 = -3.0e38f;
            if (i1 != 0 && s0 > m2) { m2 = s0; i2 = 0; } if (i1 != 1 && s1 > m2) { m2 = s1; i2 = 1; } if (i1 != 2 && s2 > m2) { m2 = s2; i2 = 2; } if (i1 != 3 && s3 > m2) { m2 = s3; i2 = 3; }
            const float c1 = i1 == 0 ? a0 : (i1 == 1 ? a1 : (i1 == 2 ? a2 : a3)), c2 = i2 == 0 ? a0 : (i2 == 1 ? a1 : (i2 == 2 ? a2 : a3));
            const float inv = __builtin_amdgcn_rcpf(c1 + c2);
            const int e1 = bg * 4 + i1, e2 = bg * 4 + i2;
            u32x4 tk; tk.x = (unsigned)e1; tk.y = (unsigned)e2; tk.z = __float_as_uint(c1 * inv); tk.w = __float_as_uint(c2 * inv); ((GAS u32x4*)(F.ws + WS_TOK))[m] = tk;
            __hip_atomic_fetch_add(cntl + e1, 1, __ATOMIC_RELAXED, __HIP_MEMORY_SCOPE_WORKGROUP); __hip_atomic_fetch_add(cntl + e2, 1, __ATOMIC_RELAXED, __HIP_MEMORY_SCOPE_WORKGROUP); }
        LDS_WAIT();
    }
    __syncthreads();
    if (F.tid < 16) __hip_atomic_fetch_add((GAS unsigned*)F.ws + CW_MOE + L * 2048 + (PRB ? 32 : 0) + 64 * F.tid, (unsigned)cntl[F.tid], __ATOMIC_RELAXED, __HIP_MEMORY_SCOPE_AGENT);
}

__device__ __forceinline__ void moe_prefix(const Frame& F, int L, LAS int* pref  , LAS int* cnt  ) {
    if (F.tid < 16) cnt[F.tid] = (int)__hip_atomic_load((GAS unsigned*)F.ws + CW_MOE + L * 2048 + 64 * F.tid, __ATOMIC_RELAXED, __HIP_MEMORY_SCOPE_AGENT);
    __syncthreads();
    if (F.tid == 0) { int p = 0; for (int e = 0; e < 16; ++e) { pref[e] = p; p += (cnt[e] + 255) >> 8; } pref[16] = p; }
    __syncthreads();
}
template <int PRB = 0> PHASE_FN void slots_phase(Frame F, int L) {
    LAS int* pref = (LAS int*)F.lds; LAS int* cnt = pref + 32;
    moe_prefix(F, L, pref, cnt);
    const int gw = F.bid * NWAVES + F.wave, NGW = F.G * NWAVES, lane = F.lane;
    GAS unsigned* cursor = (GAS unsigned*)F.ws + CW_MOE + L * 2048 + 1024 + (PRB ? 32 : 0);
    GAS int* slot_tok = (GAS int*)(F.ws + WS_SLOT_TOK); GAS float* slot_gate = (GAS float*)(F.ws + WS_SLOT_GATE);
    constexpr int SG = 4, NSW = (NTOK / 64 + SG - 1) / SG;
    if (F.wave == 0) for (int sw = F.bid; sw < NSW; sw += F.G) {
        u32x4 tk[SG]; int off0[SG], off1[SG]; int n_run = 0; const unsigned long long below = (1ull << lane) - 1ull;
#pragma unroll
        for (int j = 0; j < SG; ++j) { const int it = sw * SG + j; tk[j] = (it < NTOK / 64) ? ((const GAS u32x4*)(F.ws + WS_TOK))[it * 64 + lane] : (u32x4){99u, 99u, 0u, 0u}; }
#pragma unroll
        for (int j = 0; j < SG; ++j) { const int e0 = (int)tk[j].x, e1 = (int)tk[j].y; int n_me = 0, rank0 = 0, rank1 = 0;
#pragma unroll
            for (int ee = 0; ee < 16; ++ee) { const unsigned long long m0 = __ballot(e0 == ee), m1 = __ballot(e1 == ee);
                if (lane == ee) n_me = __popcll(m0); if (lane == 16 + ee) n_me = __popcll(m1);
                if (e0 == ee) rank0 = __popcll(m0 & below); if (e1 == ee) rank1 = __popcll(m1 & below); }
            off0[j] = __builtin_amdgcn_ds_bpermute((e0 & 15) << 2, n_run) + rank0; off1[j] = __builtin_amdgcn_ds_bpermute((16 + (e1 & 15)) << 2, n_run) + rank1; n_run += n_me; }
        unsigned base = 0; if (lane < 32 && n_run > 0) base = __hip_atomic_fetch_add(cursor + 64 * (lane & 15), (unsigned)n_run, __ATOMIC_RELAXED, __HIP_MEMORY_SCOPE_AGENT);
#pragma unroll
        for (int j = 0; j < SG; ++j) { const int it = sw * SG + j; const int e0 = (int)tk[j].x, e1 = (int)tk[j].y, m = it * 64 + lane;
            const int b0 = __builtin_amdgcn_ds_bpermute((e0 & 15) << 2, (int)base), b1 = __builtin_amdgcn_ds_bpermute((16 + (e1 & 15)) << 2, (int)base);
            if (it < NTOK / 64) { const int s0 = pref[e0] * 256 + b0 + off0[j], s1 = pref[e1] * 256 + b1 + off1[j];
                slot_tok[s0] = 2 * m; slot_gate[s0] = __uint_as_float(tk[j].z); slot_tok[s1] = 2 * m + 1; slot_gate[s1] = __uint_as_float(tk[j].w); } }
    }
    for (int e = 0; e < 16; ++e) { const int lo = pref[e] * 256 + cnt[e], hi = pref[e + 1] * 256;
        for (int s_ = lo + gw * 64 + lane; s_ < hi; s_ += NGW * 64) { slot_tok[s_] = -1; slot_gate[s_] = 0.f; } }
}

PHASE_FN void du_phase(Frame F) {
    GAS bf16* H2 = (GAS bf16*)(F.ws + WS_HY);
    const size_t gt = (size_t)F.bid * NTHR + F.tid, NGT = (size_t)F.G * NTHR;
    for (size_t i = gt; i < (size_t)NTOK * 128; i += NGT) { const int m = (int)(i >> 7), c8 = (int)(i & 127); const int t = m % T;
        const bool hp = !(t == 0 || t == CTX), hn = !(t == CTX - 1 || t == T - 1);
        const u32x4 z = {0u, 0u, 0u, 0u};
        const u32x4 u = *(const GAS u32x4*)(H2 + (size_t)m * 2048 + c8 * 8), p = hp ? *(const GAS u32x4*)(H2 + (size_t)(m - 1) * 2048 + c8 * 8) : z, n = hn ? *(const GAS u32x4*)(H2 + (size_t)(m + 1) * 2048 + c8 * 8) : z;
        u32x4 o;
#pragma unroll
        for (int j = 0; j < 4; ++j) o[j] = pk2(0.5f * (bflo(p[j]) + bflo(n[j])) - bflo(u[j]), 0.5f * (bfhi(p[j]) + bfhi(n[j])) - bfhi(u[j]));
        *(GAS u32x4*)(H2 + (size_t)m * 2048 + 1024 + c8 * 8) = o; }
}

PHASE_FN void conv_phase(Frame F, int j) {
    const GAS bf16* QP = (const GAS bf16*)(F.ws + WS_MIX); GAS bf16* QK = (GAS bf16*)(F.ws + WS_HY); const GAS float* cw = INP(IN_ML_CONV) + (size_t)j * 9 * 2048;
    const int groups = F.G >> 2; if (F.bid >= groups * 4 || groups == 0) return;
    const int q4 = F.bid & 3, c = (q4 * 64 + (F.tid & 63)) * 8, oct = F.tid >> 6;
    float wgt[9][8];
#pragma unroll
    for (int tp = 0; tp < 9; ++tp) { const f32x4 w0 = *(const GAS f32x4*)(cw + tp * 2048 + c), w1 = *(const GAS f32x4*)(cw + tp * 2048 + c + 4);
#pragma unroll
        for (int e = 0; e < 4; ++e) { wgt[tp][e] = w0[e]; wgt[tp][4 + e] = w1[e]; } }
    const float sc = c >= 1024 ? 0.08838834764831845f : 1.0f;
    for (int rr = F.bid >> 2; rr < NB * 132; rr += groups) {
        const int b = rr / 132, lr = rr - b * 132; const bool isctx = lr < 4;
        const int m0 = b * T + (isctx ? 64 * lr : CTX + (lr - 4) * 64);
        const bool rok0 = !isctx && lr > 4, rok2 = !isctx && lr < 131;
        const bool lok = isctx && lr > 0, rgk = isctx && lr < 3;
        const int w0 = 8 * oct;
        const u32x4 z = {0u, 0u, 0u, 0u};
        u32x4 x[3][3];
#define CV_COL(dst, wc) do { const bool cok_ = ((wc) >= 0 && (wc) < 64) || ((wc) < 0 && lok) || ((wc) >= 64 && rgk); const GAS bf16* p_ = QP + (size_t)(m0 + (wc)) * 2048 + c; \
            dst[0] = (cok_ && rok0) ? *(const GAS u32x4*)(p_ - 64 * 2048) : z; dst[1] = cok_ ? *(const GAS u32x4*)p_ : z; dst[2] = (cok_ && rok2) ? *(const GAS u32x4*)(p_ + 64 * 2048) : z; } while (0)
        { u32x4 t_[3]; CV_COL(t_, w0 - 1); x[0][0] = t_[0]; x[1][0] = t_[1]; x[2][0] = t_[2]; CV_COL(t_, w0); x[0][1] = t_[0]; x[1][1] = t_[1]; x[2][1] = t_[2]; }
#pragma unroll
        for (int k = 0; k < 8; ++k) {
            { u32x4 t_[3]; CV_COL(t_, w0 + k + 1); x[0][2] = t_[0]; x[1][2] = t_[1]; x[2][2] = t_[2]; }
            float acc[8];
#pragma unroll
            for (int e = 0; e < 8; ++e) acc[e] = 0.f;
#pragma unroll
            for (int dr = 0; dr < 3; ++dr)
#pragma unroll
                for (int dw = 0; dw < 3; ++dw) { const u32x4 v = x[dr][dw]; const int tp = dr * 3 + dw;
                    acc[0] += bflo(v[0]) * wgt[tp][0]; acc[1] += bfhi(v[0]) * wgt[tp][1]; acc[2] += bflo(v[1]) * wgt[tp][2]; acc[3] += bfhi(v[1]) * wgt[tp][3];
                    acc[4] += bflo(v[2]) * wgt[tp][4]; acc[5] += bfhi(v[2]) * wgt[tp][5]; acc[6] += bflo(v[3]) * wgt[tp][6]; acc[7] += bfhi(v[3]) * wgt[tp][7]; }
            u32x4 o;
#pragma unroll
            for (int e = 0; e < 4; ++e) o[e] = pk2(silu_f(acc[2 * e]) * sc, silu_f(acc[2 * e + 1]) * sc);
            *(GAS u32x4*)(QK + (size_t)(m0 + w0 + k) * 2048 + c) = o;
#pragma unroll
            for (int dr = 0; dr < 3; ++dr) { x[dr][0] = x[dr][1]; x[dr][1] = x[dr][2]; }
        }
#undef CV_COL
    }
}

PHASE_FN void headnorm_phase(Frame F, const GAS bf16* HSf, const GAS bf16* HSb, const GAS bf16* OG, const GAS float* hg, GAS bf16* Y) {
    const int gw = F.bid * NWAVES + F.wave, NGW = F.G * NWAVES, lane = F.lane;
    for (int m = gw; m < NTOK; m += NGW) { const size_t off = (size_t)m * 1024 + lane * 16;
        float x[16]; float ss = 0.f;
#pragma unroll
        for (int hlf = 0; hlf < 2; ++hlf) { const u32x4 a = *(const GAS u32x4*)(HSf + off + 8 * hlf), bq = *(const GAS u32x4*)(HSb + off + 8 * hlf);
#pragma unroll
            for (int q = 0; q < 4; ++q) { x[8 * hlf + 2 * q] = bflo(a[q]) + bflo(bq[q]); x[8 * hlf + 2 * q + 1] = bfhi(a[q]) + bfhi(bq[q]); } }
#pragma unroll
        for (int q = 0; q < 16; ++q) ss += x[q] * x[q];
        ss += dpp_f<0xB1>(ss); ss += dpp_f<0x4E>(ss); ss += dpp_f<0x141>(ss);
        const float rinv = __builtin_amdgcn_rsqf(ss * (1.0f / 128.0f) + 1e-6f);
#pragma unroll
        for (int hlf = 0; hlf < 2; ++hlf) { const u32x4 g = *(const GAS u32x4*)(OG + off + 8 * hlf); const f32x4 h0 = *(const GAS f32x4*)(hg + lane * 16 + 8 * hlf), h1 = *(const GAS f32x4*)(hg + lane * 16 + 8 * hlf + 4);
            u32x4 o;
            o[0] = pk2(x[8 * hlf + 0] * rinv * h0[0] * bflo(g[0]), x[8 * hlf + 1] * rinv * h0[1] * bfhi(g[0])); o[1] = pk2(x[8 * hlf + 2] * rinv * h0[2] * bflo(g[1]), x[8 * hlf + 3] * rinv * h0[3] * bfhi(g[1]));
            o[2] = pk2(x[8 * hlf + 4] * rinv * h1[0] * bflo(g[2]), x[8 * hlf + 5] * rinv * h1[1] * bfhi(g[2])); o[3] = pk2(x[8 * hlf + 6] * rinv * h1[2] * bflo(g[3]), x[8 * hlf + 7] * rinv * h1[3] * bfhi(g[3]));
            *(GAS u32x4*)(Y + off + 8 * hlf) = o; } }
}
PHASE_FN void rwpost_phase(Frame F, const GAS bf16* Of, const GAS bf16* Ob, const GAS float* BETA, const GAS bf16* V, const GAS bf16* Gt, GAS bf16* Y) {
    const int gw = F.bid * NWAVES + F.wave, NGW = F.G * NWAVES, lane = F.lane;
    const GAS float* lnw = INP(IN_RW_LNW); const GAS float* lnb = INP(IN_RW_LNB);
    for (int m = gw; m < NTOK; m += NGW) { const size_t off = (size_t)m * 1024 + lane * 16;
        float x[16]; float s = 0.f;
#pragma unroll
        for (int hlf = 0; hlf < 2; ++hlf) { const u32x4 a = *(const GAS u32x4*)(Of + off + 8 * hlf), bq = *(const GAS u32x4*)(Ob + off + 8 * hlf);
#pragma unroll
            for (int q = 0; q < 4; ++q) { x[8 * hlf + 2 * q] = bflo(a[q]) + bflo(bq[q]); x[8 * hlf + 2 * q + 1] = bfhi(a[q]) + bfhi(bq[q]); } }
#pragma unroll
        for (int q = 0; q < 16; ++q) s += x[q];
        s += dpp_f<0xB1>(s); s += dpp_f<0x4E>(s);
        const float mean = s * (1.0f / 64.0f); float vs = 0.f;
#pragma unroll
        for (int q = 0; q < 16; ++q) { x[q] -= mean; vs += x[q] * x[q]; }
        vs += dpp_f<0xB1>(vs); vs += dpp_f<0x4E>(vs);
        const float rinv = __builtin_amdgcn_rsqf(vs * (1.0f / 64.0f) + 64e-5f);
        const int hd = lane >> 2; const float beta = BETA[(size_t)m * 16 + hd] + BETA[((size_t)NTOK + m) * 16 + hd];
#pragma unroll
        for (int hlf = 0; hlf < 2; ++hlf) { const u32x4 vv = *(const GAS u32x4*)(V + off + 8 * hlf), gg = *(const GAS u32x4*)(Gt + off + 8 * hlf);
            const f32x4 w0 = *(const GAS f32x4*)(lnw + lane * 16 + 8 * hlf), w1 = *(const GAS f32x4*)(lnw + lane * 16 + 8 * hlf + 4), b0 = *(const GAS f32x4*)(lnb + lane * 16 + 8 * hlf), b1 = *(const GAS f32x4*)(lnb + lane * 16 + 8 * hlf + 4);
            float y[8];
#pragma unroll
            for (int q = 0; q < 4; ++q) { y[q] = x[8 * hlf + q] * rinv * w0[q] + b0[q]; y[4 + q] = x[8 * hlf + 4 + q] * rinv * w1[q] + b1[q]; }
            u32x4 o;
#pragma unroll
            for (int q = 0; q < 4; ++q) o[q] = pk2((y[2 * q] + beta * bflo(vv[q])) * bflo(gg[q]), (y[2 * q + 1] + beta * bfhi(vv[q])) * bfhi(gg[q]));
            *(GAS u32x4*)(Y + off + 8 * hlf) = o; } }
}

__device__ __forceinline__ void group_barrier(LAS unsigned* ctr, unsigned target, int lane) {
    LDS_WAIT();
    if (lane == 0) __hip_atomic_fetch_add(ctr, 1u, __ATOMIC_RELAXED, __HIP_MEMORY_SCOPE_WORKGROUP);
    while ((unsigned)__builtin_amdgcn_readfirstlane((int)__hip_atomic_load(ctr, __ATOMIC_RELAXED, __HIP_MEMORY_SCOPE_WORKGROUP)) < target) __builtin_amdgcn_s_sleep(1);
    asm volatile("" ::: "memory");
}
template <int PROBE> PHASE_FN void ml_scan_phase(Frame F, const GAS bf16* QK, const GAS bf16* V, const GAS float* GATES, GAS bf16* HS) {
    constexpr int OFF_Q = 0, OFF_K = 17408, OFF_V = 34816, OFF_VW = 40960, OFF_WKR = 46080, INB = 48384;
    constexpr int O_SS = 2 * INB, O_CS = O_SS + 2 * 9216, O_HO = O_CS + 2 * 13056, O_SC = O_HO + 2 * 5120, O_CTR = O_SC + 3 * 1344;
    LAS float* SCb = (LAS float*)(F.lds + O_SC);
    LAS unsigned* actr = (LAS unsigned*)(F.lds + O_CTR);
    const int tid = F.tid, w = F.wave; int lane = F.lane, r = lane & 15, q = lane >> 4;
    constexpr int NCH = T / 64;
    for (int unit = F.bid; unit < 256; unit += F.G) {
        const int un = (F.G == 256) ? ((((unit & 7) * 8 + (unit >> 5)) << 2) | ((unit >> 3) & 3)) : unit;
        const int vs = un & 3, dir = (un >> 2) & 1, h = (un >> 3) & 7, b = un >> 6;
        __syncthreads();
        for (int i = tid; i < (O_CTR + 16) / 4; i += NTHR) ((LAS unsigned*)F.lds)[i] = 0u;
        __syncthreads();
        if (tid < 128) ((LAS bf16*)(F.lds + (tid >> 6) * INB + OFF_V))[(tid & 63) * 48 + 32] = (bf16)0x3f80;
        __syncthreads();
        if (w >= 4) {
            const int a = w - 4, ptid = tid - 256; unsigned abar = 0; int lrow = ptid >> 2, lp = ptid & 3;
#define ML_RELAUNDER() asm volatile("" : "+v"(lrow), "+v"(lp), "+v"(lane), "+v"(r), "+v"(q))
            float m_run = 0.f; u32x4 rq0[4], rk0[4], rv0, rq1[4], rk1[4], rv1; float rig = 0.f, rlf = 0.f;
#define ML_LOAD(cc, S) do { const int row_ = seq_row(b, dir, (cc) * 64 + lrow); const GAS bf16* qp_ = QK + (size_t)row_ * 2048 + h * 128; \
                _Pragma("unroll") for (int j_ = 0; j_ < 4; ++j_) { rq##S[j_] = *(const GAS u32x4*)(qp_ + 8 * (lp + 4 * j_)); rk##S[j_] = *(const GAS u32x4*)(qp_ + 1024 + 8 * (lp + 4 * j_)); } \
                rv##S = *(const GAS u32x4*)(V + (size_t)row_ * 1024 + h * 128 + vs * 32 + 8 * lp); } while (0)
#define ML_GLOAD(cc) do { const int grow_ = seq_row(b, dir, (cc) * 64 + lane); rig = GATES[(size_t)grow_ * 32 + dir * 16 + h]; rlf = GATES[(size_t)grow_ * 32 + dir * 16 + 8 + h]; } while (0)
#define ML_SCALARS(cc) do { const float lf_ = logsigmoid_f(rlf); const float bc_ = wave_scan_add(lf_); const float u_ = rig - bc_; const float pm_ = wave_scan_max(u_); \
                const float cc_ = fmaxf(m_run, pm_), blast_ = lane63(bc_), pmall_ = lane63(pm_), mnew_ = blast_ + fmaxf(m_run, pmall_); LAS float* sc_ = SCb + ((cc) % 3) * 336; \
                sc_[lane] = u_; sc_[64 + lane] = cc_; sc_[128 + lane] = __expf(m_run - cc_); sc_[192 + lane] = __expf(-(bc_ + cc_)); sc_[256 + lane] = __expf(blast_ + u_ - mnew_); \
                if (lane == 0) sc_[320] = __expf(blast_ + m_run - mnew_); m_run = mnew_; } while (0)
#define ML_STAGE(cc, S) do { LAS unsigned char* ib_ = F.lds + ((cc) & 1) * INB; const LAS float* sc_ = SCb + ((cc) % 3) * 336; \
                _Pragma("unroll") for (int j_ = 0; j_ < 4; ++j_) { *(LAS u32x4*)((LAS bf16*)(ib_ + OFF_Q) + lrow * 136 + 8 * (lp + 4 * j_)) = rq##S[j_]; *(LAS u32x4*)((LAS bf16*)(ib_ + OFF_K) + lrow * 136 + 8 * (lp + 4 * j_)) = rk##S[j_]; } \
                const float wk_ = sc_[256 + lrow]; u32x4 vw_; _Pragma("unroll") for (int j_ = 0; j_ < 4; ++j_) vw_[j_] = pk2(bflo(rv##S[j_]) * wk_, bfhi(rv##S[j_]) * wk_); \
                *(LAS u32x4*)((LAS bf16*)(ib_ + OFF_V) + lrow * 48 + 8 * lp) = rv##S; *(LAS u32x4*)((LAS bf16*)(ib_ + OFF_VW) + lrow * 40 + 8 * lp) = vw_; \
                if (ptid < 64) ((LAS bf16*)(ib_ + OFF_WKR))[ptid] = (bf16)f2bf(sc_[256 + ptid]); } while (0)
#define ML_STILE(cc, ti_, sj_) do { const LAS unsigned char* ib_ = F.lds + ((cc) & 1) * INB; const LAS float* sc_ = SCb + ((cc) % 3) * 336; LAS bf16* ss_ = (LAS bf16*)(F.lds + O_SS + ((cc) & 1) * 9216); \
                f32x4 acc_ = {0.f, 0.f, 0.f, 0.f}; acc_ = mm16<128>(acc_, (const LAS bf16*)(ib_ + OFF_Q) + 16 * (ti_) * 136, 136, (const LAS bf16*)(ib_ + OFF_K) + 16 * (sj_) * 136, 136, lane); \
                const int s_ = 16 * (sj_) + r; const float us_ = sc_[s_]; \
                _Pragma("unroll") for (int i_ = 0; i_ < 4; ++i_) { const int t_ = 16 * (ti_) + 4 * q + i_; ss_[t_ * 72 + s_] = (bf16)f2bf((s_ <= t_) ? acc_[i_] * __expf(us_ - sc_[64 + t_]) : 0.f); } } while (0)
#define ML_STILES(cc) do { if (a == 0) { ML_STILE(cc, 3, 0); ML_STILE(cc, 3, 1); ML_STILE(cc, 0, 0); } else if (a == 1) { ML_STILE(cc, 3, 2); ML_STILE(cc, 3, 3); ML_STILE(cc, 1, 0); } \
                else if (a == 2) { ML_STILE(cc, 2, 0); ML_STILE(cc, 2, 1); ML_STILE(cc, 2, 2); } else { ML_STILE(cc, 1, 1); } } while (0)
#define ML_HSTORE(cc) do { const int row_ = seq_row(b, dir, (cc) * 64 + lrow); *(GAS u32x4*)(HS + ((size_t)dir * NTOK + row_) * 1024 + h * 128 + vs * 32 + 8 * lp) = *(const LAS u32x4*)((const LAS bf16*)(F.lds + O_HO + ((cc) & 1) * 5120) + lrow * 40 + 8 * lp); } while (0)
            ML_LOAD(0, 0); ML_LOAD(1, 1);
            if (a == 3) { ML_GLOAD(0); ML_SCALARS(0); ML_GLOAD(1); ML_SCALARS(1); ML_GLOAD(2); }
            group_barrier(actr, 4 * (++abar), lane);
            ML_STAGE(0, 0); ML_LOAD(2, 0);
            group_barrier(actr, 4 * (++abar), lane);
            ML_STILES(0);
            __syncthreads();
            for (int c = 0; c < NCH; ++c) {
                if (c + 1 < NCH && !(PROBE & 2)) {
                    ML_RELAUNDER();
                    if (!(PROBE & 8)) {
                    if (c & 1) { ML_STAGE(c + 1, 0); if (c + 3 < NCH) ML_LOAD(c + 3, 0); } else { ML_STAGE(c + 1, 1); if (c + 3 < NCH) ML_LOAD(c + 3, 1); }
                    if (c >= 1) ML_HSTORE(c - 1); }
                    group_barrier(actr, 4 * (++abar), lane);
                    if (!(PROBE & 4)) ML_STILES(c + 1);
                    if (!(PROBE & 16)) { if (a == 3 && c + 2 < NCH) { ML_SCALARS(c + 2); if (c + 3 < NCH) ML_GLOAD(c + 3); } }
                } else if (c >= 1) ML_HSTORE(c - 1);
                __syncthreads();
            }
            ML_HSTORE(NCH - 1);
#undef ML_LOAD
#undef ML_RELAUNDER
#undef ML_GLOAD
#undef ML_SCALARS
#undef ML_STAGE
#undef ML_STILE
#undef ML_STILES
#undef ML_HSTORE
        } else {
            f32x4 Cst[2][2], Nst[2];
#pragma unroll
            for (int i = 0; i < 2; ++i) { Nst[i] = (f32x4){0.f, 0.f, 0.f, 0.f}; Cst[i][0] = Nst[i]; Cst[i][1] = Nst[i]; }
            __syncthreads();
            for (int c = 0; c < NCH; ++c) {
                if (!(PROBE & 1)) {
                const LAS unsigned char* ib = F.lds + (c & 1) * INB;
                const LAS bf16* QS = (const LAS bf16*)(ib + OFF_Q); const LAS bf16* KS = (const LAS bf16*)(ib + OFF_K); const LAS bf16* VS = (const LAS bf16*)(ib + OFF_V); const LAS bf16* VW = (const LAS bf16*)(ib + OFF_VW); const LAS bf16* WKR = (const LAS bf16*)(ib + OFF_WKR);
                const LAS bf16* SS = (const LAS bf16*)(F.lds + O_SS + (c & 1) * 9216); const LAS bf16* CSr = (const LAS bf16*)(F.lds + O_CS + (c & 1) * 13056); LAS bf16* CSw = (LAS bf16*)(F.lds + O_CS + ((c + 1) & 1) * 13056);
                LAS bf16* HO = (LAS bf16*)(F.lds + O_HO + (c & 1) * 5120); const LAS float* sc = SCb + (c % 3) * 336;
                {   const int ti = w; f32x4 a1[2], a2[2], a3 = {0.f, 0.f, 0.f, 0.f}, a1x = a3;
#pragma unroll
                    for (int vj = 0; vj < 2; ++vj) { a1[vj] = (f32x4){0.f, 0.f, 0.f, 0.f}; a2[vj] = a1[vj]; }
#pragma unroll
                    for (int kk = 0; kk < 2; ++kk) { const bf16x8 sf = row_frag(SS + 16 * ti * 72, 72, 32 * kk, lane);
#pragma unroll
                        for (int vj = 0; vj < 2; ++vj) a1[vj] = __builtin_amdgcn_mfma_f32_16x16x32_bf16(sf, tr_frag(VS, 48, 32 * kk, 16 * vj, lane), a1[vj], 0, 0, 0);
                        a1x = __builtin_amdgcn_mfma_f32_16x16x32_bf16(sf, tr_frag(VS, 48, 32 * kk, 32, lane), a1x, 0, 0, 0); }
#pragma unroll
                    for (int kk = 0; kk < 4; ++kk) { const bf16x8 qf = row_frag(QS + 16 * ti * 136, 136, 32 * kk, lane);
#pragma unroll
                        for (int vj = 0; vj < 2; ++vj) a2[vj] = __builtin_amdgcn_mfma_f32_16x16x32_bf16(qf, row_frag(CSr + 16 * vj * 136, 136, 32 * kk, lane), a2[vj], 0, 0, 0);
                        a3 = __builtin_amdgcn_mfma_f32_16x16x32_bf16(qf, row_frag(CSr + 32 * 136, 136, 32 * kk, lane), a3, 0, 0, 0); }
#pragma unroll
                    for (int i = 0; i < 4; ++i) { const int t_ = 16 * ti + 4 * q + i; const float wi = sc[128 + t_];
                        const float den = row16_sum(a1x[i] + wi * a3[i]); const float rd = __builtin_amdgcn_rcpf(fmaxf(fabsf(den), sc[192 + t_]));
#pragma unroll
                        for (int vj = 0; vj < 2; ++vj) HO[t_ * 40 + 16 * vj + r] = (bf16)f2bf((a1[vj][i] + wi * a2[vj][i]) * rd); } }
                {   const float wprev = sc[320]; bf16x8 av[2][2], wf[2];
#pragma unroll
                    for (int kk = 0; kk < 2; ++kk) { av[0][kk] = tr_frag(VW, 40, 32 * kk, 0, lane); av[1][kk] = tr_frag(VW, 40, 32 * kk, 16, lane); wf[kk] = row_frag(WKR, 72, 32 * kk, lane); }
#pragma unroll
                    for (int jj = 0; jj < 2; ++jj) { const int dj = 2 * w + jj; Cst[0][jj] = Cst[0][jj] * wprev; Cst[1][jj] = Cst[1][jj] * wprev; Nst[jj] = Nst[jj] * wprev;
#pragma unroll
                        for (int kk = 0; kk < 2; ++kk) { const bf16x8 kf = tr_frag(KS, 136, 32 * kk, 16 * dj, lane);
                            Cst[0][jj] = __builtin_amdgcn_mfma_f32_16x16x32_bf16(av[0][kk], kf, Cst[0][jj], 0, 0, 0); Cst[1][jj] = __builtin_amdgcn_mfma_f32_16x16x32_bf16(av[1][kk], kf, Cst[1][jj], 0, 0, 0);
                            Nst[jj] = __builtin_amdgcn_mfma_f32_16x16x32_bf16(wf[kk], kf, Nst[jj], 0, 0, 0); }
#pragma unroll
                        for (int vi = 0; vi < 2; ++vi)
#pragma unroll
                            for (int i = 0; i < 4; ++i) CSw[(16 * vi + 4 * q + i) * 136 + 16 * dj + r] = (bf16)f2bf(Cst[vi][jj][i]);
                        if (q == 0) CSw[32 * 136 + 16 * dj + r] = (bf16)f2bf(Nst[jj][0]); } }
                }
                __syncthreads();
            }
        }
    }
}

template <int PROBE> PHASE_FN void hg_scan_phase(Frame F, const GAS bf16* Q, const GAS bf16* V, const GAS bf16* LF, GAS bf16* HSf, GAS bf16* HSb) {
    constexpr int O_QT = 0, O_KT = 17408, O_IN = 34816, INB = 39936  , O_AS = O_IN + 2 * INB, O_ST = O_AS + 2 * 9216, O_HO = O_ST + 2 * 8704, O_SBL = O_HO + 5120, O_WT = O_SBL + 1024, O_CTR = O_WT + 2048;
    LAS unsigned* actr = (LAS unsigned*)(F.lds + O_CTR);
    const int tid = F.tid, lane = F.lane, w = F.wave, r = lane & 15, q = lane >> 4;
    constexpr int NCH = T / 64;
    for (int unit = F.bid; unit < 256; unit += F.G) {
        const int un = (F.G == 256) ? ((((unit & 7) * 8 + (unit >> 5)) << 2) | ((unit >> 3) & 3)) : unit;
        const int vs = un & 3, dir = (un >> 2) & 1, h = (un >> 3) & 7, b = un >> 6;
        GAS bf16* HS = dir ? HSb : HSf; const GAS bf16* LFd = LF + (size_t)dir * NTOK * 1024;
        __syncthreads();
        for (int i = tid; i < (O_CTR + 16) / 4; i += NTHR) ((LAS unsigned*)F.lds)[i] = 0u;
        __syncthreads();
        if (w >= 4) {
            const int a = w - 4, ptid = tid - 256, g4 = lane & 15, lp = 4 * a + (lane >> 4); unsigned abar = 0;
            u32x4 rq0[4], rl0[4], rv0;
#define HG_LOAD(cc, S) do { _Pragma("unroll") for (int j_ = 0; j_ < 4; ++j_) { const int row_ = seq_row(b, dir, (cc) * 64 + 4 * g4 + j_); rq##S[j_] = *(const GAS u32x4*)(Q + (size_t)row_ * 1024 + h * 128 + 8 * lp); rl##S[j_] = *(const GAS u32x4*)(LFd + (size_t)row_ * 1024 + h * 128 + 8 * lp); } \
                const int vrow_ = seq_row(b, dir, (cc) * 64 + (ptid >> 2)); rv##S = *(const GAS u32x4*)(V + (size_t)vrow_ * 1024 + h * 128 + vs * 32 + 8 * (ptid & 3)); } while (0)
#define HG_ATILE(cc, ti_, sj_) do { LAS bf16* as_ = (LAS bf16*)(F.lds + O_AS + ((cc) & 1) * 9216); f32x4 acc_ = {0.f, 0.f, 0.f, 0.f}; \
                acc_ = mm16<128>(acc_, (const LAS bf16*)(F.lds + O_QT) + 16 * (ti_) * 136, 136, (const LAS bf16*)(F.lds + O_KT) + 16 * (sj_) * 136, 136, lane); \
                _Pragma("unroll") for (int i_ = 0; i_ < 4; ++i_) { const int t_ = 16 * (ti_) + 4 * q + i_, s_ = 16 * (sj_) + r; as_[t_ * 72 + s_] = (bf16)f2bf(s_ <= t_ ? acc_[i_] : 0.f); } } while (0)
#define HG_ATILES(cc) do { if (a == 0) { HG_ATILE(cc, 3, 0); HG_ATILE(cc, 3, 1); HG_ATILE(cc, 0, 0); } else if (a == 1) { HG_ATILE(cc, 3, 2); HG_ATILE(cc, 3, 3); HG_ATILE(cc, 1, 0); } \
                else if (a == 2) { HG_ATILE(cc, 2, 0); HG_ATILE(cc, 2, 1); } else { HG_ATILE(cc, 2, 2); HG_ATILE(cc, 1, 1); } } while (0)
#define HG_PREP(cc, S) do { LAS unsigned char* ib_ = F.lds + O_IN + ((cc) & 1) * INB; \
                float lf_[4][8], bc_[4][8]; \
                _Pragma("unroll") for (int j_ = 0; j_ < 4; ++j_) _Pragma("unroll") for (int k_ = 0; k_ < 4; ++k_) { lf_[j_][2 * k_] = 1.4426950408889634f * bflo(rl##S[j_][k_]); lf_[j_][2 * k_ + 1] = 1.4426950408889634f * bfhi(rl##S[j_][k_]); }     \
                float br_[8], bl_[8]; \
                _Pragma("unroll") for (int k_ = 0; k_ < 8; ++k_) { float run_ = 0.f; _Pragma("unroll") for (int j_ = 0; j_ < 4; ++j_) { run_ += lf_[j_][k_]; bc_[j_][k_] = run_; } \
                    float x_ = run_; x_ += dpp_keep<0x111, 0xF>(0.f, x_); x_ += dpp_keep<0x112, 0xF>(0.f, x_); x_ += dpp_keep<0x114, 0xF>(0.f, x_); x_ += dpp_keep<0x118, 0xF>(0.f, x_);     \
                    const float ex_ = x_ - run_; _Pragma("unroll") for (int j_ = 0; j_ < 4; ++j_) bc_[j_][k_] += ex_; \
                    br_[k_] = __builtin_bit_cast(float, __builtin_amdgcn_ds_bpermute(((lane & 48) | 7) << 2, __builtin_bit_cast(int, x_))); bl_[k_] = __builtin_bit_cast(float, __builtin_amdgcn_ds_bpermute(((lane & 48) | 15) << 2, __builtin_bit_cast(int, x_))); } \
                _Pragma("unroll") for (int j_ = 0; j_ < 4; ++j_) { const int t_ = 4 * g4 + j_; u32x4 oq_, oi_, ok_, oh_; \
                    _Pragma("unroll") for (int k_ = 0; k_ < 4; ++k_) { float a2_[2], i2_[2], k2_[2], h2_[2]; \
                        _Pragma("unroll") for (int hh_ = 0; hh_ < 2; ++hh_) { const int c_ = 2 * k_ + hh_; const float bt_ = bc_[j_][c_], key_ = 1.0f - __builtin_amdgcn_exp2f(lf_[j_][c_]), qv_ = hh_ ? bfhi(rq##S[j_][k_]) : bflo(rq##S[j_][k_]); \
                            a2_[hh_] = qv_ * __builtin_amdgcn_exp2f(fminf(bt_ - br_[c_], 115.f)); i2_[hh_] = qv_ * __builtin_amdgcn_exp2f(bt_); k2_[hh_] = key_ * __builtin_amdgcn_exp2f(fminf(br_[c_] - bt_, 115.f)); h2_[hh_] = key_ * __builtin_amdgcn_exp2f(bl_[c_] - bt_); } \
                        oq_[k_] = pk2(a2_[0], a2_[1]); oi_[k_] = pk2(i2_[0], i2_[1]); ok_[k_] = pk2(k2_[0], k2_[1]); oh_[k_] = pk2(h2_[0], h2_[1]); } \
                    *(LAS u32x4*)((LAS bf16*)(F.lds + O_QT) + t_ * 136 + 8 * lp) = oq_; *(LAS u32x4*)((LAS bf16*)(F.lds + O_KT) + t_ * 136 + 8 * lp) = ok_; \
                    *(LAS u32x4*)((LAS bf16*)ib_ + t_ * 136 + 8 * lp) = oi_; *(LAS u32x4*)((LAS bf16*)(ib_ + 17408) + t_ * 136 + 8 * lp) = oh_; } \
                *(LAS u32x4*)((LAS bf16*)(ib_ + 34816) + (ptid >> 2) * 40 + 8 * (ptid & 3)) = rv##S; \
                if (g4 == 0) { LAS float* sbl_ = (LAS float*)(F.lds + O_SBL) + ((cc) & 1) * 128; _Pragma("unroll") for (int k_ = 0; k_ < 8; ++k_) sbl_[8 * lp + k_] = __builtin_amdgcn_exp2f(bl_[k_]); } } while (0)
            HG_LOAD(0, 0);
            HG_PREP(0, 0); HG_LOAD(1, 0);
            group_barrier(actr, 4 * (++abar), lane);
            HG_ATILES(0);
            __syncthreads();
            for (int c = 0; c < NCH; ++c) {
                if (c + 1 < NCH && !(PROBE & 2)) {
                    HG_PREP(c + 1, 0);
                    if (c + 2 < NCH) HG_LOAD(c + 2, 0);
                    group_barrier(actr, 4 * (++abar), lane);
                    HG_ATILES(c + 1);
                }
                __syncthreads();
            }
#undef HG_LOAD
#undef HG_ATILE
#undef HG_ATILES
#undef HG_PREP
        } else {
            f32x4 Sst[2][2];
#pragma unroll
            for (int i = 0; i < 2; ++i) { Sst[i][0] = (f32x4){0.f, 0.f, 0.f, 0.f}; Sst[i][1] = Sst[i][0]; }
            __syncthreads();
            for (int c = 0; c < NCH; ++c) {
                if (!(PROBE & 1)) {
                const LAS unsigned char* ib = F.lds + O_IN + (c & 1) * INB;
                const LAS bf16* QI = (const LAS bf16*)ib; const LAS bf16* KH = (const LAS bf16*)(ib + 17408); const LAS bf16* VS = (const LAS bf16*)(ib + 34816);
                const LAS bf16* AS = (const LAS bf16*)(F.lds + O_AS + (c & 1) * 9216); const LAS bf16* STr = (const LAS bf16*)(F.lds + O_ST + (c & 1) * 8704); LAS bf16* STw = (LAS bf16*)(F.lds + O_ST + ((c + 1) & 1) * 8704);
                LAS bf16* HO = (LAS bf16*)(F.lds + O_HO); const LAS float* sbl = (const LAS float*)(F.lds + O_SBL) + (c & 1) * 128;
                {   const int ti = w; f32x4 o[2]; o[0] = (f32x4){0.f, 0.f, 0.f, 0.f}; o[1] = o[0];
#pragma unroll
                    for (int kk = 0; kk < 2; ++kk) { const bf16x8 af = row_frag(AS + 16 * ti * 72, 72, 32 * kk, lane);
#pragma unroll
                        for (int vj = 0; vj < 2; ++vj) o[vj] = __builtin_amdgcn_mfma_f32_16x16x32_bf16(af, tr_frag(VS, 40, 32 * kk, 16 * vj, lane), o[vj], 0, 0, 0); }
#pragma unroll
                    for (int kk = 0; kk < 4; ++kk) { const bf16x8 qf = row_frag(QI + 16 * ti * 136, 136, 32 * kk, lane);
#pragma unroll
                        for (int vj = 0; vj < 2; ++vj) o[vj] = __builtin_amdgcn_mfma_f32_16x16x32_bf16(qf, row_frag(STr + 16 * vj * 136, 136, 32 * kk, lane), o[vj], 0, 0, 0); }
#pragma unroll
                    for (int i = 0; i < 4; ++i)
#pragma unroll
                        for (int vj = 0; vj < 2; ++vj) HO[(16 * ti + 4 * q + i) * 40 + 16 * vj + r] = (bf16)f2bf(o[vj][i]);
                    LDS_WAIT();
                    { const int t_ = 16 * ti + (lane >> 2); const int row = seq_row(b, dir, c * 64 + t_); *(GAS u32x4*)(HS + (size_t)row * 1024 + h * 128 + vs * 32 + 8 * (lane & 3)) = *(const LAS u32x4*)(HO + t_ * 40 + 8 * (lane & 3)); } }
                {   bf16x8 av[2][2];
#pragma unroll
                    for (int kk = 0; kk < 2; ++kk) { av[0][kk] = tr_frag(VS, 40, 32 * kk, 0, lane); av[1][kk] = tr_frag(VS, 40, 32 * kk, 16, lane); }
#pragma unroll
                    for (int jj = 0; jj < 2; ++jj) { const int kj = 2 * w + jj; const float sb = sbl[16 * kj + r]; Sst[0][jj] = Sst[0][jj] * sb; Sst[1][jj] = Sst[1][jj] * sb;
#pragma unroll
                        for (int kk = 0; kk < 2; ++kk) { const bf16x8 kf = tr_frag(KH, 136, 32 * kk, 16 * kj, lane);
                            Sst[0][jj] = __builtin_amdgcn_mfma_f32_16x16x32_bf16(av[0][kk], kf, Sst[0][jj], 0, 0, 0); Sst[1][jj] = __builtin_amdgcn_mfma_f32_16x16x32_bf16(av[1][kk], kf, Sst[1][jj], 0, 0, 0); }
#pragma unroll
                        for (int vi = 0; vi < 2; ++vi)
#pragma unroll
                            for (int i = 0; i < 4; ++i) STw[(16 * vi + 4 * q + i) * 136 + 16 * kj + r] = (bf16)f2bf(Sst[vi][jj][i]); } }
                }
                __syncthreads();
            }
        }
    }
}

__device__ __forceinline__ void gflag_wait(const LAS unsigned* ctr, unsigned target) { while ((unsigned)__builtin_amdgcn_readfirstlane((int)__hip_atomic_load(ctr, __ATOMIC_RELAXED, __HIP_MEMORY_SCOPE_WORKGROUP)) < target) __builtin_amdgcn_s_sleep(1); asm volatile("" ::: "memory"); }
__device__ __forceinline__ void gflag_post(LAS unsigned* ctr, int lane) { LDS_WAIT(); if (lane == 0) __hip_atomic_fetch_add(ctr, 1u, __ATOMIC_RELAXED, __HIP_MEMORY_SCOPE_WORKGROUP); }
template <int PROBE> PHASE_FN void hg_scan3_phase(Frame F, const GAS bf16* Q, const GAS bf16* V, const GAS bf16* LF, GAS bf16* HSf, GAS bf16* HSb) {
    constexpr int O_QT = 0, O_KT = 17408, O_IN = 34816, INB = 39936  , O_AS = O_IN + 2 * INB, O_ST = O_AS + 2 * 9216, O_HO = O_ST + 2 * 8704, O_SBL = O_HO + 5120, O_WT = O_SBL + 1024, O_CTR = O_WT + 2048;
    LAS unsigned* QKR = (LAS unsigned*)(F.lds + O_CTR);
    const int tid = F.tid, lane = F.lane, w = F.wave, r = lane & 15, q = lane >> 4;
    constexpr int NCH = T / 64;
    for (int unit = F.bid; unit < 256; unit += F.G) {
        const int un = (F.G == 256) ? ((((unit & 7) * 8 + (unit >> 5)) << 2) | ((unit >> 3) & 3)) : unit;
        const int vs = un & 3, dir = (un >> 2) & 1, h = (un >> 3) & 7, b = un >> 6;
        GAS bf16* HS = dir ? HSb : HSf; const GAS bf16* LFd = LF + (size_t)dir * NTOK * 1024;
        __syncthreads();
        for (int i = tid; i < (O_CTR + 16) / 4; i += NTHR) ((LAS unsigned*)F.lds)[i] = 0u;
        __syncthreads();
        if (w >= 4) {
            const int a = w - 4, ptid = tid - 256, g4 = lane & 15, lp = 4 * a + (lane >> 4);
            u32x4 rq0[4], rl0[4], rv0, rq1[4], rl1[4], rv1;
#define HG_LOAD(cc, S) do { _Pragma("unroll") for (int j_ = 0; j_ < 4; ++j_) { const int row_ = seq_row(b, dir, (cc) * 64 + 4 * g4 + j_); rq##S[j_] = *(const GAS u32x4*)(Q + (size_t)row_ * 1024 + h * 128 + 8 * lp); rl##S[j_] = *(const GAS u32x4*)(LFd + (size_t)row_ * 1024 + h * 128 + 8 * lp); } \
                const int vrow_ = seq_row(b, dir, (cc) * 64 + (ptid >> 2)); rv##S = *(const GAS u32x4*)(V + (size_t)vrow_ * 1024 + h * 128 + vs * 32 + 8 * (ptid & 3)); } while (0)
#define HG_PREP(cc, S) do { const u32x4 vcur_ = rv##S; LAS unsigned char* ib_ = F.lds + O_IN + ((cc) & 1) * INB; \
                float lf_[4][8], bc_[4][8]; \
                _Pragma("unroll") for (int j_ = 0; j_ < 4; ++j_) _Pragma("unroll") for (int k_ = 0; k_ < 4; ++k_) { lf_[j_][2 * k_] = 1.4426950408889634f * bflo(rl##S[j_][k_]); lf_[j_][2 * k_ + 1] = 1.4426950408889634f * bfhi(rl##S[j_][k_]); }     \
                float br_[8], bl_[8]; \
                _Pragma("unroll") for (int k_ = 0; k_ < 8; ++k_) { float run_ = 0.f; _Pragma("unroll") for (int j_ = 0; j_ < 4; ++j_) { run_ += lf_[j_][k_]; bc_[j_][k_] = run_; } \
                    float x_ = run_; x_ += dpp_keep<0x111, 0xF>(0.f, x_); x_ += dpp_keep<0x112, 0xF>(0.f, x_); x_ += dpp_keep<0x114, 0xF>(0.f, x_); x_ += dpp_keep<0x118, 0xF>(0.f, x_);     \
                    const float ex_ = x_ - run_; _Pragma("unroll") for (int j_ = 0; j_ < 4; ++j_) bc_[j_][k_] += ex_; \
                    br_[k_] = __builtin_bit_cast(float, __builtin_amdgcn_ds_bpermute(((lane & 48) | 7) << 2, __builtin_bit_cast(int, x_))); bl_[k_] = __builtin_bit_cast(float, __builtin_amdgcn_ds_bpermute(((lane & 48) | 15) << 2, __builtin_bit_cast(int, x_))); } \
                gflag_wait(QKR + 1, 4u * (unsigned)(cc));                                  \
                if ((cc) >= 2) gflag_wait(QKR + 2, 4u * (unsigned)((cc) - 1));             \
                _Pragma("unroll") for (int j_ = 0; j_ < 4; ++j_) { const int t_ = 4 * g4 + j_; u32x4 oq_, oi_, ok_, oh_; \
                    _Pragma("unroll") for (int k_ = 0; k_ < 4; ++k_) { float a2_[2], i2_[2], k2_[2], h2_[2]; \
                        _Pragma("unroll") for (int hh_ = 0; hh_ < 2; ++hh_) { const int c_ = 2 * k_ + hh_; const float bt_ = bc_[j_][c_], key_ = 1.0f - __builtin_amdgcn_exp2f(lf_[j_][c_]), qv_ = hh_ ? bfhi(rq##S[j_][k_]) : bflo(rq##S[j_][k_]); \
                            a2_[hh_] = qv_ * __builtin_amdgcn_exp2f(fminf(bt_ - br_[c_], 115.f)); i2_[hh_] = qv_ * __builtin_amdgcn_exp2f(bt_); k2_[hh_] = key_ * __builtin_amdgcn_exp2f(fminf(br_[c_] - bt_, 115.f)); h2_[hh_] = key_ * __builtin_amdgcn_exp2f(bl_[c_] - bt_); } \
                        oq_[k_] = pk2(a2_[0], a2_[1]); oi_[k_] = pk2(i2_[0], i2_[1]); ok_[k_] = pk2(k2_[0], k2_[1]); oh_[k_] = pk2(h2_[0], h2_[1]); } \
                    *(LAS u32x4*)((LAS bf16*)(F.lds + O_QT) + t_ * 136 + 8 * lp) = oq_; *(LAS u32x4*)((LAS bf16*)(F.lds + O_KT) + t_ * 136 + 8 * lp) = ok_; \
                    *(LAS u32x4*)((LAS bf16*)ib_ + t_ * 136 + 8 * lp) = oi_; *(LAS u32x4*)((LAS bf16*)(ib_ + 17408) + t_ * 136 + 8 * lp) = oh_; } \
                *(LAS u32x4*)((LAS bf16*)(ib_ + 34816) + (ptid >> 2) * 40 + 8 * (ptid & 3)) = vcur_; \
                if (g4 == 0) { LAS float* sbl_ = (LAS float*)(F.lds + O_SBL) + ((cc) & 1) * 128; _Pragma("unroll") for (int k_ = 0; k_ < 8; ++k_) sbl_[8 * lp + k_] = __builtin_amdgcn_exp2f(bl_[k_]); } } while (0)
            HG_LOAD(0, 0); HG_LOAD(1, 1);
#define HG_ASTEP(pp, S) do { if (!(PROBE & 2)) HG_PREP(pp, S); else { gflag_wait(QKR + 1, 4u * (unsigned)(pp)); if ((pp) >= 2) gflag_wait(QKR + 2, 4u * (unsigned)((pp) - 1)); } \
                gflag_post(QKR, lane); if ((pp) + 2 < NCH) HG_LOAD((pp) + 2, S); } while (0)
            for (int p = 0; p < NCH; p += 2) { HG_ASTEP(p, 0); HG_ASTEP(p + 1, 1); }
#undef HG_ASTEP
#undef HG_LOAD
#undef HG_PREP
        } else {
            const int a = w;
#define HG_ATILE(cc, ti_, sj_) do { LAS bf16* as_ = (LAS bf16*)(F.lds + O_AS + ((cc) & 1) * 9216); f32x4 acc_ = {0.f, 0.f, 0.f, 0.f}; \
                acc_ = mm16<128>(acc_, (const LAS bf16*)(F.lds + O_QT) + 16 * (ti_) * 136, 136, (const LAS bf16*)(F.lds + O_KT) + 16 * (sj_) * 136, 136, lane); \
                _Pragma("unroll") for (int i_ = 0; i_ < 4; ++i_) { const int t_ = 16 * (ti_) + 4 * q + i_, s_ = 16 * (sj_) + r; as_[t_ * 72 + s_] = (bf16)f2bf(s_ <= t_ ? acc_[i_] : 0.f); } } while (0)
#define HG_ATILES(cc) do { if (a == 0) { HG_ATILE(cc, 3, 0); HG_ATILE(cc, 3, 1); HG_ATILE(cc, 0, 0); } else if (a == 1) { HG_ATILE(cc, 3, 2); HG_ATILE(cc, 3, 3); HG_ATILE(cc, 1, 0); } \
                else if (a == 2) { HG_ATILE(cc, 2, 0); HG_ATILE(cc, 2, 1); } else { HG_ATILE(cc, 2, 2); HG_ATILE(cc, 1, 1); } } while (0)

            f32x4 Sst[2][2];
#pragma unroll
            for (int i = 0; i < 2; ++i) { Sst[i][0] = (f32x4){0.f, 0.f, 0.f, 0.f}; Sst[i][1] = Sst[i][0]; }
            gflag_wait(QKR, 4u); HG_ATILES(0); gflag_post(QKR + 1, lane);
            for (int c = 0; c < NCH; ++c) {
                gflag_wait(QKR + 1, 4u * (unsigned)(c + 1)); gflag_wait(QKR + 2, 4u * (unsigned)c);
                if (!(PROBE & 1)) {
                const LAS unsigned char* ib = F.lds + O_IN + (c & 1) * INB;
                const LAS bf16* QI = (const LAS bf16*)ib; const LAS bf16* KH = (const LAS bf16*)(ib + 17408); const LAS bf16* VS = (const LAS bf16*)(ib + 34816);
                const LAS bf16* AS = (const LAS bf16*)(F.lds + O_AS + (c & 1) * 9216); const LAS bf16* STr = (const LAS bf16*)(F.lds + O_ST + (c & 1) * 8704); LAS bf16* STw = (LAS bf16*)(F.lds + O_ST + ((c + 1) & 1) * 8704);
                LAS bf16* HO = (LAS bf16*)(F.lds + O_HO); const LAS float* sbl = (const LAS float*)(F.lds + O_SBL) + (c & 1) * 128;
                {   const int ti = w; f32x4 o[2]; o[0] = (f32x4){0.f, 0.f, 0.f, 0.f}; o[1] = o[0];
#pragma unroll
                    for (int kk = 0; kk < 2; ++kk) { const bf16x8 af = row_frag(AS + 16 * ti * 72, 72, 32 * kk, lane);
#pragma unroll
                        for (int vj = 0; vj < 2; ++vj) o[vj] = __builtin_amdgcn_mfma_f32_16x16x32_bf16(af, tr_frag(VS, 40, 32 * kk, 16 * vj, lane), o[vj], 0, 0, 0); }
#pragma unroll
                    for (int kk = 0; kk < 4; ++kk) { const bf16x8 qf = row_frag(QI + 16 * ti * 136, 136, 32 * kk, lane);
#pragma unroll
                        for (int vj = 0; vj < 2; ++vj) o[vj] = __builtin_amdgcn_mfma_f32_16x16x32_bf16(qf, row_frag(STr + 16 * vj * 136, 136, 32 * kk, lane), o[vj], 0, 0, 0); }
#pragma unroll
                    for (int i = 0; i < 4; ++i)
#pragma unroll
                        for (int vj = 0; vj < 2; ++vj) HO[(16 * ti + 4 * q + i) * 40 + 16 * vj + r] = (bf16)f2bf(o[vj][i]);
                    LDS_WAIT();
                    { const int t_ = 16 * ti + (lane >> 2); const int row = seq_row(b, dir, c * 64 + t_); *(GAS u32x4*)(HS + (size_t)row * 1024 + h * 128 + vs * 32 + 8 * (lane & 3)) = *(const LAS u32x4*)(HO + t_ * 40 + 8 * (lane & 3)); } }
                {   bf16x8 av[2][2];
#pragma unroll
                    for (int kk = 0; kk < 2; ++kk) { av[0][kk] = tr_frag(VS, 40, 32 * kk, 0, lane); av[1][kk] = tr_frag(VS, 40, 32 * kk, 16, lane); }
#pragma unroll
                    for (int jj = 0; jj < 2; ++jj) { const int kj = 2 * w + jj; const float sb = sbl[16 * kj + r]; Sst[0][jj] = Sst[0][jj] * sb; Sst[1][jj] = Sst[1][jj] * sb;
#pragma unroll
                        for (int kk = 0; kk < 2; ++kk) { const bf16x8 kf = tr_frag(KH, 136, 32 * kk, 16 * kj, lane);
                            Sst[0][jj] = __builtin_amdgcn_mfma_f32_16x16x32_bf16(av[0][kk], kf, Sst[0][jj], 0, 0, 0); Sst[1][jj] = __builtin_amdgcn_mfma_f32_16x16x32_bf16(av[1][kk], kf, Sst[1][jj], 0, 0, 0); }
#pragma unroll
                        for (int vi = 0; vi < 2; ++vi)
#pragma unroll
                            for (int i = 0; i < 4; ++i) STw[(16 * vi + 4 * q + i) * 136 + 16 * kj + r] = (bf16)f2bf(Sst[vi][jj][i]); } }
                }
                gflag_post(QKR + 2, lane);
                if (c + 1 < NCH) { gflag_wait(QKR, 4u * (unsigned)(c + 2)); HG_ATILES(c + 1); gflag_post(QKR + 1, lane); }
            }
#undef HG_ATILE
#undef HG_ATILES

        }
    }
}

template <int PROBE> PHASE_FN void ml_scan3_phase(Frame F, const GAS bf16* QK, const GAS bf16* V, const GAS float* GATES, GAS bf16* HS) {
    constexpr int OFF_Q = 0, OFF_K = 17408, OFF_V = 34816, OFF_VW = 40960, OFF_WKR = 46080, INB = 48384;
    constexpr int O_SS = 2 * INB, O_CS = O_SS + 2 * 9216, O_HO = O_CS + 2 * 13056, O_SC = O_HO + 2 * 5120, O_CTR = O_SC + 4 * 1344; static_assert(O_CTR + 16 <= MISC_OFF, "ml_scan3 LDS map");
    LAS float* SCb = (LAS float*)(F.lds + O_SC);
    LAS unsigned* CT = (LAS unsigned*)(F.lds + O_CTR);
    const int tid = F.tid, w = F.wave; int lane = F.lane, r = lane & 15, q = lane >> 4;
    constexpr int NCH = T / 64;
    for (int unit = F.bid; unit < 256; unit += F.G) {
        const int un = (F.G == 256) ? ((((unit & 7) * 8 + (unit >> 5)) << 2) | ((unit >> 3) & 3)) : unit;
        const int vs = un & 3, dir = (un >> 2) & 1, h = (un >> 3) & 7, b = un >> 6;
        __syncthreads();
        for (int i = tid; i < (O_CTR + 16) / 4; i += NTHR) ((LAS unsigned*)F.lds)[i] = 0u;
        __syncthreads();
        if (tid < 128) ((LAS bf16*)(F.lds + (tid >> 6) * INB + OFF_V))[(tid & 63) * 48 + 32] = (bf16)0x3f80;
        __syncthreads();
        if (w >= 4) {
            const int a = w - 4, ptid = tid - 256; int lrow = ptid >> 2, lp = ptid & 3;
#define ML_RELAUNDER() asm volatile("" : "+v"(lrow), "+v"(lp), "+v"(lane), "+v"(r), "+v"(q))
            float m_run = 0.f; u32x4 rq0[4], rk0[4], rv0, rq1[4], rk1[4], rv1; float rig = 0.f, rlf = 0.f;
#define ML_LOAD(cc, S) do { const int row_ = seq_row(b, dir, (cc) * 64 + lrow); const GAS bf16* qp_ = QK + (size_t)row_ * 2048 + h * 128; \
                _Pragma("unroll") for (int j_ = 0; j_ < 4; ++j_) { rq##S[j_] = *(const GAS u32x4*)(qp_ + 8 * (lp + 4 * j_)); rk##S[j_] = *(const GAS u32x4*)(qp_ + 1024 + 8 * (lp + 4 * j_)); } \
                rv##S = *(const GAS u32x4*)(V + (size_t)row_ * 1024 + h * 128 + vs * 32 + 8 * lp); } while (0)
#define ML_GLOAD(cc) do { const int grow_ = seq_row(b, dir, (cc) * 64 + lane); rig = GATES[(size_t)grow_ * 32 + dir * 16 + h]; rlf = GATES[(size_t)grow_ * 32 + dir * 16 + 8 + h]; } while (0)
#define ML_SCALARS(cc) do { const float lf_ = logsigmoid_f(rlf); const float bc_ = wave_scan_add(lf_); const float u_ = rig - bc_; const float pm_ = wave_scan_max(u_); \
                const float cc_ = fmaxf(m_run, pm_), blast_ = lane63(bc_), pmall_ = lane63(pm_), mnew_ = blast_ + fmaxf(m_run, pmall_); LAS float* sc_ = SCb + ((cc) & 3) * 336; \
                sc_[lane] = u_; sc_[64 + lane] = cc_; sc_[128 + lane] = __expf(m_run - cc_); sc_[192 + lane] = __expf(-(bc_ + cc_)); sc_[256 + lane] = __expf(blast_ + u_ - mnew_); \
                if (lane == 0) sc_[320] = __expf(blast_ + m_run - mnew_); m_run = mnew_; } while (0)
#define ML_STAGE(cc, S) do { LAS unsigned char* ib_ = F.lds + ((cc) & 1) * INB; const LAS float* sc_ = SCb + ((cc) & 3) * 336; \
                _Pragma("unroll") for (int j_ = 0; j_ < 4; ++j_) { *(LAS u32x4*)((LAS bf16*)(ib_ + OFF_Q) + lrow * 136 + 8 * (lp + 4 * j_)) = rq##S[j_]; *(LAS u32x4*)((LAS bf16*)(ib_ + OFF_K) + lrow * 136 + 8 * (lp + 4 * j_)) = rk##S[j_]; } \
                const float wk_ = sc_[256 + lrow]; u32x4 vw_; _Pragma("unroll") for (int j_ = 0; j_ < 4; ++j_) vw_[j_] = pk2(bflo(rv##S[j_]) * wk_, bfhi(rv##S[j_]) * wk_); \
                *(LAS u32x4*)((LAS bf16*)(ib_ + OFF_V) + lrow * 48 + 8 * lp) = rv##S; *(LAS u32x4*)((LAS bf16*)(ib_ + OFF_VW) + lrow * 40 + 8 * lp) = vw_; \
                if (ptid < 64) ((LAS bf16*)(ib_ + OFF_WKR))[ptid] = (bf16)f2bf(sc_[256 + ptid]); } while (0)
            ML_LOAD(0, 0); ML_LOAD(1, 1);
            if (a == 3) { ML_GLOAD(0); ML_SCALARS(0); gflag_post(CT + 3, lane); ML_GLOAD(1); ML_SCALARS(1); gflag_post(CT + 3, lane); ML_GLOAD(2); }
#define ML_ASTEP(pp, S) do { ML_RELAUNDER(); \
                if ((pp) >= 2) gflag_wait(CT + 2, 4u * (unsigned)((pp) - 1));              \
                gflag_wait(CT + 3, (unsigned)((pp) + 1));                                  \
                if (!(PROBE & 2)) ML_STAGE(pp, S); \
                gflag_post(CT, lane); \
                if ((pp) + 2 < NCH && !(PROBE & 2)) ML_LOAD((pp) + 2, S); \
                if (a == 3 && (pp) + 2 < NCH) { ML_SCALARS((pp) + 2); gflag_post(CT + 3, lane); if ((pp) + 3 < NCH) ML_GLOAD((pp) + 3); } } while (0)
            for (int p = 0; p < NCH; p += 2) { ML_ASTEP(p, 0); ML_ASTEP(p + 1, 1); }
#undef ML_ASTEP
#undef ML_LOAD
#undef ML_RELAUNDER
#undef ML_GLOAD
#undef ML_SCALARS
#undef ML_STAGE
        } else {
            const int a = w;
#define ML_STILE(cc, ti_, sj_) do { const LAS unsigned char* ib_ = F.lds + ((cc) & 1) * INB; const LAS float* sc_ = SCb + ((cc) & 3) * 336; LAS bf16* ss_ = (LAS bf16*)(F.lds + O_SS + ((cc) & 1) * 9216); \
                f32x4 acc_ = {0.f, 0.f, 0.f, 0.f}; acc_ = mm16<128>(acc_, (const LAS bf16*)(ib_ + OFF_Q) + 16 * (ti_) * 136, 136, (const LAS bf16*)(ib_ + OFF_K) + 16 * (sj_) * 136, 136, lane); \
                const int s_ = 16 * (sj_) + r; const float us_ = sc_[s_]; \
                _Pragma("unroll") for (int i_ = 0; i_ < 4; ++i_) { const int t_ = 16 * (ti_) + 4 * q + i_; ss_[t_ * 72 + s_] = (bf16)f2bf((s_ <= t_) ? acc_[i_] * __expf(us_ - sc_[64 + t_]) : 0.f); } } while (0)
#define ML_STILES(cc) do { if (a == 0) { ML_STILE(cc, 3, 0); ML_STILE(cc, 3, 1); } else if (a == 1) { ML_STILE(cc, 3, 2); ML_STILE(cc, 3, 3); ML_STILE(cc, 1, 0); } \
                else if (a == 2) { ML_STILE(cc, 2, 0); ML_STILE(cc, 2, 1); ML_STILE(cc, 2, 2); } else { ML_STILE(cc, 1, 1); ML_STILE(cc, 0, 0); } } while (0)

            f32x4 Cst[2][2], Nst[2];
#pragma unroll
            for (int i = 0; i < 2; ++i) { Nst[i] = (f32x4){0.f, 0.f, 0.f, 0.f}; Cst[i][0] = Nst[i]; Cst[i][1] = Nst[i]; }
            gflag_wait(CT, 4u); ML_STILES(0); gflag_post(CT + 1, lane);
            for (int c = 0; c < NCH; ++c) {
                gflag_wait(CT + 1, 4u * (unsigned)(c + 1)); gflag_wait(CT + 2, 4u * (unsigned)c);
                if (!(PROBE & 1)) {
                const LAS unsigned char* ib = F.lds + (c & 1) * INB;
                const LAS bf16* QS = (const LAS bf16*)(ib + OFF_Q); const LAS bf16* KS = (const LAS bf16*)(ib + OFF_K); const LAS bf16* VS = (const LAS bf16*)(ib + OFF_V); const LAS bf16* VW = (const LAS bf16*)(ib + OFF_VW); const LAS bf16* WKR = (const LAS bf16*)(ib + OFF_WKR);
                const LAS bf16* SS = (const LAS bf16*)(F.lds + O_SS + (c & 1) * 9216); const LAS bf16* CSr = (const LAS bf16*)(F.lds + O_CS + (c & 1) * 13056); LAS bf16* CSw = (LAS bf16*)(F.lds + O_CS + ((c + 1) & 1) * 13056);
                LAS bf16* HO = (LAS bf16*)(F.lds + O_HO + (c & 1) * 5120); const LAS float* sc = SCb + (c & 3) * 336;
                {   const int ti = w; f32x4 a1[2], a2[2], a3 = {0.f, 0.f, 0.f, 0.f}, a1x = a3;
#pragma unroll
                    for (int vj = 0; vj < 2; ++vj) { a1[vj] = (f32x4){0.f, 0.f, 0.f, 0.f}; a2[vj] = a1[vj]; }
#pragma unroll
                    for (int kk = 0; kk < 2; ++kk) { const bf16x8 sf = row_frag(SS + 16 * ti * 72, 72, 32 * kk, lane);
#pragma unroll
                        for (int vj = 0; vj < 2; ++vj) a1[vj] = __builtin_amdgcn_mfma_f32_16x16x32_bf16(sf, tr_frag(VS, 48, 32 * kk, 16 * vj, lane), a1[vj], 0, 0, 0);
                        a1x = __builtin_amdgcn_mfma_f32_16x16x32_bf16(sf, tr_frag(VS, 48, 32 * kk, 32, lane), a1x, 0, 0, 0); }
#pragma unroll
                    for (int kk = 0; kk < 4; ++kk) { const bf16x8 qf = row_frag(QS + 16 * ti * 136, 136, 32 * kk, lane);
#pragma unroll
                        for (int vj = 0; vj < 2; ++vj) a2[vj] = __builtin_amdgcn_mfma_f32_16x16x32_bf16(qf, row_frag(CSr + 16 * vj * 136, 136, 32 * kk, lane), a2[vj], 0, 0, 0);
                        a3 = __builtin_amdgcn_mfma_f32_16x16x32_bf16(qf, row_frag(CSr + 32 * 136, 136, 32 * kk, lane), a3, 0, 0, 0); }
#pragma unroll
                    for (int i = 0; i < 4; ++i) { const int t_ = 16 * ti + 4 * q + i; const float wi = sc[128 + t_];
                        const float den = row16_sum(a1x[i] + wi * a3[i]); const float rd = __builtin_amdgcn_rcpf(fmaxf(fabsf(den), sc[192 + t_]));
#pragma unroll
                        for (int vj = 0; vj < 2; ++vj) HO[t_ * 40 + 16 * vj + r] = (bf16)f2bf((a1[vj][i] + wi * a2[vj][i]) * rd); }
                    LDS_WAIT();
                    { const int t_ = 16 * ti + (lane >> 2); const int row_ = seq_row(b, dir, c * 64 + t_);
                      *(GAS u32x4*)(HS + ((size_t)dir * NTOK + row_) * 1024 + h * 128 + vs * 32 + 8 * (lane & 3)) = *(const LAS u32x4*)(HO + t_ * 40 + 8 * (lane & 3)); } }
                {   const float wprev = sc[320]; bf16x8 av[2][2], wf[2];
#pragma unroll
                    for (int kk = 0; kk < 2; ++kk) { av[0][kk] = tr_frag(VW, 40, 32 * kk, 0, lane); av[1][kk] = tr_frag(VW, 40, 32 * kk, 16, lane); wf[kk] = row_frag(WKR, 72, 32 * kk, lane); }
#pragma unroll
                    for (int jj = 0; jj < 2; ++jj) { const int dj = 2 * w + jj; Cst[0][jj] = Cst[0][jj] * wprev; Cst[1][jj] = Cst[1][jj] * wprev; Nst[jj] = Nst[jj] * wprev;
#pragma unroll
                        for (int kk = 0; kk < 2; ++kk) { const bf16x8 kf = tr_frag(KS, 136, 32 * kk, 16 * dj, lane);
                            Cst[0][jj] = __builtin_amdgcn_mfma_f32_16x16x32_bf16(av[0][kk], kf, Cst[0][jj], 0, 0, 0); Cst[1][jj] = __builtin_amdgcn_mfma_f32_16x16x32_bf16(av[1][kk], kf, Cst[1][jj], 0, 0, 0);
                            Nst[jj] = __builtin_amdgcn_mfma_f32_16x16x32_bf16(wf[kk], kf, Nst[jj], 0, 0, 0); }
#pragma unroll
                        for (int vi = 0; vi < 2; ++vi)
#pragma unroll
                            for (int i = 0; i < 4; ++i) CSw[(16 * vi + 4 * q + i) * 136 + 16 * dj + r] = (bf16)f2bf(Cst[vi][jj][i]);
                        if (q == 0) CSw[32 * 136 + 16 * dj + r] = (bf16)f2bf(Nst[jj][0]); } }
                }
                gflag_post(CT + 2, lane);
                if (c + 1 < NCH) { gflag_wait(CT, 4u * (unsigned)(c + 2)); ML_STILES(c + 1); gflag_post(CT + 1, lane); }
            }
#undef ML_STILE
#undef ML_STILES

        }
    }
}


constexpr int R2_NS = 8, R2_SLOT = 13312;
constexpr int R2_NK = 0, R2_RT = 2304, R2_AKL = 4608, R2_KDL = 6912, R2_TM = 9216, R2_PP = 10496, R2_VI = 11776, R2_GL = 13056;
constexpr int R2_W2T = 0, R2_A2T = 9216, R2_SVEC = 18432, R2_FLAG = 19712, R2_RING = 20480;
static_assert(R2_RING + R2_NS * R2_SLOT <= MISC_OFF, "rw_scan2 LDS map");
__device__ __forceinline__ unsigned lds_ld(const LAS unsigned* p) { return (unsigned)__builtin_amdgcn_readfirstlane((int)__hip_atomic_load(p, __ATOMIC_RELAXED, __HIP_MEMORY_SCOPE_WORKGROUP)); }
__device__ __forceinline__ f32x4 mfma16(s16x4 a, s16x4 b, f32x4 c) { return __builtin_amdgcn_mfma_f32_16x16x16bf16_1k(a, b, c, 0, 0, 0); }
__device__ __forceinline__ s16x4 pk4(float a, float b, float c, float d) { u32x2 v; v.x = pk2(a, b); v.y = pk2(c, d); return __builtin_bit_cast(s16x4, v); }
__device__ __forceinline__ s16x4 pk4(f32x4 v) { return pk4(v[0], v[1], v[2], v[3]); }
__device__ __forceinline__ s16x4 tr4(const LAS bf16* X, int ld, int k0, int n0, int lane) { const int g = lane >> 4, a = (lane & 15) >> 2, p = lane & 3; return __builtin_amdgcn_ds_read_tr16_b64_v4i16((LAS s16x4*)(X + (k0 + 4 * g + a) * ld + n0 + 4 * p)); }
__device__ __forceinline__ f32x4 mmT(f32x4 X, f32x4 Y, f32x4 C) {
#pragma unroll
    for (int i = 0; i < 4; ++i) C = __builtin_amdgcn_mfma_f32_16x16x4f32(X[i], Y[i], C, 0, 0, 0);
    return C; }
__device__ __forceinline__ float qsum4(float x) { float a = x, b = x; asm volatile("s_nop 1\n\tv_permlane16_swap_b32 %0, %1\n\ts_nop 1" : "+v"(a), "+v"(b)); const float y = a + b; float c = y, d = y; asm volatile("s_nop 1\n\tv_permlane32_swap_b32 %0, %1\n\ts_nop 1" : "+v"(c), "+v"(d)); return c + d; }
__device__ __forceinline__ float rdlane(float v, int l) { return __builtin_bit_cast(float, __builtin_amdgcn_readlane(__builtin_bit_cast(int, v), l)); }
template <int PROBE> PHASE_FN void rw_scan2_phase(Frame F, const GAS bf16* Rr, const GAS bf16* Kk, const GAS bf16* Vv, const GAS bf16* WH, const GAS bf16* AH, GAS bf16* O  , GAS float* BETA  ) {
    LAS bf16* W2T = (LAS bf16*)(F.lds + R2_W2T); LAS bf16* A2T = (LAS bf16*)(F.lds + R2_A2T); LAS float* SVEC = (LAS float*)(F.lds + R2_SVEC);
    LAS unsigned* ready = (LAS unsigned*)(F.lds + R2_FLAG); LAS unsigned* done = ready + 8; LAS unsigned* nextc = ready + 12;
    const int tid = F.tid, w = F.wave;
    constexpr int NCK = T / 16;
    for (int unit = F.bid; unit < 256; unit += F.G) {
        const int un = (F.G == 256) ? ((((unit & 7) * 16 + (unit >> 4)) << 1) | ((unit >> 3) & 1)) : unit;
        const int half = un & 1, dir = (un >> 1) & 1, h = (un >> 2) & 15, b = un >> 6;
        __syncthreads();
        for (int i = tid; i < 4096; i += NTHR) { const int l = i >> 6, jn = i & 63; W2T[jn * 72 + l] = (bf16)f2bf(-1.4426950408889634f * INP(IN_RW_W2)[((size_t)(dir * 64 + l)) * 1024 + h * 64 + jn]); A2T[jn * 72 + l] = (bf16)f2bf(-1.4426950408889634f * INP(IN_RW_A2)[((size_t)(dir * 64 + l)) * 1024 + h * 64 + jn]); }
        if (tid < 64) { SVEC[tid] = -1.4426950408889634f * INP(IN_RW_W0)[dir * 1024 + h * 64 + tid]; SVEC[64 + tid] = -1.4426950408889634f * INP(IN_RW_A0)[dir * 1024 + h * 64 + tid]; SVEC[128 + tid] = INP(IN_RW_KK)[h * 64 + tid];
            SVEC[192 + tid] = INP(IN_RW_KA)[h * 64 + tid]; SVEC[256 + tid] = INP(IN_RW_RK)[h * 64 + tid]; }
        if (tid < 16) ready[tid] = 0u;
        __syncthreads();
        if (w >= 2) {
            f32x4 ckk[4], cka[4], crk[4];
            { const int q0 = F.lane >> 4;
#pragma unroll
              for (int kt = 0; kt < 4; ++kt) { const int k0 = 16 * kt + 4 * q0; ckk[kt] = *(const LAS f32x4*)(SVEC + 128 + k0); cka[kt] = *(const LAS f32x4*)(SVEC + 192 + k0); crk[kt] = *(const LAS f32x4*)(SVEC + 256 + k0); } }
            u32x2 gr[4], gk[4]; u32x4 gw[2], ga[2], gv;
#define R2_LOAD(cc) do { const int r_ = F.lane & 15, q_ = F.lane >> 4; const size_t row_ = (size_t)seq_row(b, dir, (cc) * 16 + r_); \
                _Pragma("unroll") for (int kt = 0; kt < 4; ++kt) { gr[kt] = *(const GAS u32x2*)(Rr + row_ * 1024 + h * 64 + 16 * kt + 4 * q_); gk[kt] = *(const GAS u32x2*)(Kk + row_ * 1024 + h * 64 + 16 * kt + 4 * q_); } \
                _Pragma("unroll") for (int kk = 0; kk < 2; ++kk) { gw[kk] = *(const GAS u32x4*)(WH + row_ * 128 + dir * 64 + 32 * kk + 8 * q_); ga[kk] = *(const GAS u32x4*)(AH + row_ * 128 + dir * 64 + 32 * kk + 8 * q_); } \
                gv = *(const GAS u32x4*)(Vv + row_ * 1024 + h * 64 + half * 32 + 8 * q_); } while (0)
#define R2_GRAB(dst) do { unsigned v_ = 0u; if (F.lane == 0) v_ = __hip_atomic_fetch_add(nextc, 1u, __ATOMIC_RELAXED, __HIP_MEMORY_SCOPE_WORKGROUP); dst = __builtin_amdgcn_readfirstlane((int)v_); } while (0)
            int c, cn; R2_GRAB(c);
            if (c < NCK) R2_LOAD(c);
            for (; c < NCK; c = cn) {
                R2_GRAB(cn);
                int lane_ = F.lane; asm volatile("" : "+v"(lane_)); const int lane = lane_, r = lane & 15, q = lane >> 4;
                LAS unsigned char* sl = F.lds + R2_RING + (c & (R2_NS - 1)) * R2_SLOT;
                LAS bf16* NKs = (LAS bf16*)(sl + R2_NK); LAS bf16* RTs = (LAS bf16*)(sl + R2_RT); LAS bf16* AKL = (LAS bf16*)(sl + R2_AKL); LAS bf16* KDL = (LAS bf16*)(sl + R2_KDL);
                LAS bf16* TM = (LAS bf16*)(sl + R2_TM); LAS bf16* PP = (LAS bf16*)(sl + R2_PP); LAS bf16* VI = (LAS bf16*)(sl + R2_VI); LAS float* GL = (LAS float*)(sl + R2_GL);
                if (c >= R2_NS) { const unsigned need = (unsigned)(c - R2_NS + 1); while (lds_ld(done) < need || lds_ld(done + 1) < need) __builtin_amdgcn_s_sleep(1); }
                asm volatile("" ::: "memory");
                if (!(PROBE & 2)) {
                VM_WAIT();
                const u32x2 pr0 = gr[0], pr1 = gr[1], pr2 = gr[2], pr3 = gr[3], pk0 = gk[0], pk1 = gk[1], pk2_ = gk[2], pk3 = gk[3];
                const bf16x8 whf0 = __builtin_bit_cast(bf16x8, gw[0]), whf1 = __builtin_bit_cast(bf16x8, gw[1]), ahf0 = __builtin_bit_cast(bf16x8, ga[0]), ahf1 = __builtin_bit_cast(bf16x8, ga[1]);
                *(LAS u32x4*)(VI + r * 40 + 8 * q) = gv;
                asm volatile("" ::: "memory");
                if (cn < NCK && !(PROBE & 32)) R2_LOAD(cn);
                f32x4 accw[4], acca[4];
#pragma unroll
                for (int kh = 0; kh < 2; ++kh) { bf16x8 fw[2][2], fa[2][2];
#pragma unroll
                    for (int k2 = 0; k2 < 2; ++k2) { const int kt = 2 * kh + k2; accw[kt] = *(const LAS f32x4*)(SVEC + 16 * kt + 4 * q); acca[kt] = *(const LAS f32x4*)(SVEC + 64 + 16 * kt + 4 * q);
#pragma unroll
                        for (int kk = 0; kk < 2; ++kk) { fw[k2][kk] = *(const LAS bf16x8*)(W2T + (16 * kt + r) * 72 + 32 * kk + 8 * q); fa[k2][kk] = *(const LAS bf16x8*)(A2T + (16 * kt + r) * 72 + 32 * kk + 8 * q); } }
                    LDS_WAIT();
#pragma unroll
                    for (int k2 = 0; k2 < 2; ++k2) { const int kt = 2 * kh + k2;
                        accw[kt] = __builtin_amdgcn_mfma_f32_16x16x32_bf16(fw[k2][0], whf0, accw[kt], 0, 0, 0); accw[kt] = __builtin_amdgcn_mfma_f32_16x16x32_bf16(fw[k2][1], whf1, accw[kt], 0, 0, 0);
                        acca[kt] = __builtin_amdgcn_mfma_f32_16x16x32_bf16(fa[k2][0], ahf0, acca[kt], 0, 0, 0); acca[kt] = __builtin_amdgcn_mfma_f32_16x16x32_bf16(fa[k2][1], ahf1, acca[kt], 0, 0, 0); } }
                const u32x2 prk[4] = {pr0, pr1, pr2, pr3}, pkk[4] = {pk0, pk1, pk2_, pk3};
                float rn;
                { float ssq = 0.f;
#pragma unroll
                  for (int kt = 0; kt < 4; ++kt) { const float x0 = bflo(pkk[kt].x) * ckk[kt][0], x1 = bfhi(pkk[kt].x) * ckk[kt][1], x2 = bflo(pkk[kt].y) * ckk[kt][2], x3 = bfhi(pkk[kt].y) * ckk[kt][3]; ssq += x0 * x0 + x1 * x1 + x2 * x2 + x3 * x3; }
                  rn = __builtin_amdgcn_rsqf(fmaxf(qsum4(ssq), 1e-24f)); }
                float bet = 0.f; f32x4 g1 = {0.f, 0.f, 0.f, 0.f}, g2 = g1, g3 = g1, g4 = g1, g1t = g1;
                if (PROBE & 8) { g1 = accw[0] + acca[1]; g2 = accw[1] + acca[0]; g3 = accw[2] + acca[3]; g4 = accw[3]; g1t = acca[2]; bet = rn; } else
#pragma unroll
                for (int kt = 0; kt < 4; ++kt) {
                    const int k0 = 16 * kt + 4 * q;
                    const float kv[4] = {bflo(pkk[kt].x), bfhi(pkk[kt].x), bflo(pkk[kt].y), bfhi(pkk[kt].y)}, rv[4] = {bflo(prk[kt].x), bfhi(prk[kt].x), bflo(prk[kt].y), bfhi(prk[kt].y)};
                    float nk[4], rt[4], aki[4], kdi[4]; f32x4 glv;
#pragma unroll
                    for (int i = 0; i < 4; ++i) { const float lw = -0.8750387749145276f * __builtin_amdgcn_rcpf(1.0f + __builtin_amdgcn_exp2f(accw[kt][i]));
                        float cs = lw; cs += dpp_keep<0x111, 0xF>(0.f, cs); cs += dpp_keep<0x112, 0xF>(0.f, cs); cs += dpp_keep<0x114, 0xF>(0.f, cs); cs += dpp_keep<0x118, 0xF>(0.f, cs);
                        const float e_in = __builtin_amdgcn_exp2f(cs), e_iv = __builtin_amdgcn_rcpf(e_in), e_ex = dpp_keep<0x111, 0xF>(1.0f, e_in);
                        const float av = __builtin_amdgcn_rcpf(1.0f + __builtin_amdgcn_exp2f(acca[kt][i])), kkn = kv[i] * ckk[kt][i] * rn, akk = kkn * av, kd = kv[i] * __builtin_fmaf(av, cka[kt][i], 1.0f - cka[kt][i]);
                        bet += rv[i] * kd * crk[kt][i];
                        nk[i] = kkn * e_ex; rt[i] = rv[i] * e_in; aki[i] = akk * e_iv; kdi[i] = kd * e_iv; glv[i] = e_in; }
                    const s16x4 nkp = pk4(nk[0], nk[1], nk[2], nk[3]), rtp = pk4(rt[0], rt[1], rt[2], rt[3]), akip = pk4(aki[0], aki[1], aki[2], aki[3]), kdip = pk4(kdi[0], kdi[1], kdi[2], kdi[3]);
                    *(LAS s16x4*)(NKs + r * 72 + k0) = nkp; *(LAS s16x4*)(RTs + r * 72 + k0) = rtp; *(LAS s16x4*)(AKL + r * 72 + k0) = akip; *(LAS s16x4*)(KDL + r * 72 + k0) = kdip;
                    if (r == 15) *(LAS f32x4*)(GL + k0) = glv;
                    g1 = mfma16(nkp, akip, g1); g2 = mfma16(nkp, kdip, g2); g3 = mfma16(rtp, akip, g3); g4 = mfma16(rtp, kdip, g4); g1t = mfma16(akip, nkp, g1t); }
                bet = qsum4(bet);
                if (q == 0 && half == 0) BETA[((size_t)dir * NTOK + seq_row(b, dir, c * 16 + r)) * 16 + h] = bet;
                f32x4 Nn, Qn, W1;
#pragma unroll
                for (int i = 0; i < 4; ++i) { const int t_ = 4 * q + i; PP[t_ * 40 + r] = (bf16)f2bf(r <= t_ ? g3[i] : 0.f); PP[t_ * 40 + 16 + r] = (bf16)f2bf(r <= t_ ? g4[i] : 0.f); g2[i] = r < t_ ? g2[i] : 0.f;
                    Nn[i] = r < t_ ? -g1[i] : 0.f; Qn[i] = t_ < r ? -g1t[i] : 0.f; W1[i] = Qn[i] + (t_ == r ? 1.0f : 0.f); }
                if (PROBE & 4) { *(LAS s16x4*)(TM + r * 40 + 4 * q) = pk4(Nn + Qn + W1 + g2); } else
                { const f32x4 z4 = {0.f, 0.f, 0.f, 0.f};
                  const f32x4 Q2 = mmT(Nn, Qn, z4), N2 = mmT(Qn, Nn, z4); const f32x4 W2 = mmT(N2, W1, W1);
                  const f32x4 Q4 = mmT(N2, Q2, z4), N4 = mmT(Q2, N2, z4); const f32x4 W3 = mmT(N4, W2, W2);
                  const f32x4 N8 = mmT(Q4, N4, z4); const f32x4 W4 = mmT(N8, W3, W3);
                  const f32x4 Mp = mmT(W4, g2, z4);
                  *(LAS s16x4*)(TM + r * 40 + 4 * q) = pk4(-W4[0], -W4[1], -W4[2], -W4[3]);
#pragma unroll
                  for (int i = 0; i < 4; ++i) TM[(4 * q + i) * 40 + 16 + r] = (bf16)f2bf(-Mp[i]); }
                }
                LDS_WAIT();
                if (F.lane == 0) __hip_atomic_store(ready + (c & (R2_NS - 1)), (unsigned)(c + 1), __ATOMIC_RELAXED, __HIP_MEMORY_SCOPE_WORKGROUP);
            }
#undef R2_LOAD
#undef R2_GRAB
        } else {
            const int cw = w;
            f32x4 ST[4]; s16x4 Sb[4];
#pragma unroll
            for (int kt = 0; kt < 4; ++kt) { ST[kt] = (f32x4){0.f, 0.f, 0.f, 0.f}; Sb[kt] = (s16x4){0, 0, 0, 0}; }
#define R2C_DECL(S) s16x4 S##nk[4], S##rt[4], S##akl[4], S##kdl[4], S##vf, S##tn, S##mu, S##g3, S##g4; f32x4 S##gl[4]
#define R2C_READ(S, cc) do { int lane_ = F.lane; asm volatile("" : "+v"(lane_)); const int lane = lane_, r = lane & 15, q = lane >> 4; \
                LAS unsigned char* sl = F.lds + R2_RING + ((cc) & (R2_NS - 1)) * R2_SLOT; \
                const LAS bf16* NKs = (const LAS bf16*)(sl + R2_NK); const LAS bf16* RTs = (const LAS bf16*)(sl + R2_RT); const LAS bf16* AKL = (const LAS bf16*)(sl + R2_AKL); const LAS bf16* KDL = (const LAS bf16*)(sl + R2_KDL); \
                const LAS bf16* TM = (const LAS bf16*)(sl + R2_TM); const LAS bf16* PP = (const LAS bf16*)(sl + R2_PP); const LAS bf16* VI = (const LAS bf16*)(sl + R2_VI); const LAS float* GL = (const LAS float*)(sl + R2_GL); \
                while (lds_ld(ready + ((cc) & (R2_NS - 1))) != (unsigned)((cc) + 1)) __builtin_amdgcn_s_sleep(1); \
                asm volatile("" ::: "memory"); \
                _Pragma("unroll") for (int kt = 0; kt < 4; ++kt) { S##nk[kt] = *(const LAS s16x4*)(NKs + r * 72 + 16 * kt + 4 * q); S##rt[kt] = *(const LAS s16x4*)(RTs + r * 72 + 16 * kt + 4 * q); } \
                S##vf = tr4(VI, 40, 0, 16 * cw, lane); S##tn = *(const LAS s16x4*)(TM + r * 40 + 4 * q); S##mu = *(const LAS s16x4*)(TM + r * 40 + 16 + 4 * q); \
                _Pragma("unroll") for (int kt = 0; kt < 4; ++kt) { S##kdl[kt] = tr4(KDL, 72, 0, 16 * kt, lane); S##gl[kt] = *(const LAS f32x4*)(GL + 16 * kt + 4 * q); S##akl[kt] = tr4(AKL, 72, 0, 16 * kt, lane); } \
                S##g3 = *(const LAS s16x4*)(PP + r * 40 + 4 * q); S##g4 = *(const LAS s16x4*)(PP + r * 40 + 16 + 4 * q); } while (0)
#define R2C_CHAIN(S, cc) do { f32x4 xa = {0.f, 0.f, 0.f, 0.f}, ot = xa, ua = xa; \
                _Pragma("unroll") for (int kt = 0; kt < 4; ++kt) xa = mfma16(S##nk[kt], Sb[kt], xa);                             \
                ua = mfma16(S##mu, S##vf, ua); \
                _Pragma("unroll") for (int kt = 0; kt < 4; ++kt) ot = mfma16(Sb[kt], S##rt[kt], ot);                             \
                _Pragma("unroll") for (int kt = 0; kt < 4; ++kt) ST[kt] = mfma16(S##kdl[kt], S##vf, ST[kt]); \
                ua = mfma16(S##tn, pk4(xa), ua);                                                                                 \
                ot = mfma16(S##vf, S##g4, ot); \
                const s16x4 ub = pk4(ua); \
                _Pragma("unroll") for (int kt = 0; kt < 4; ++kt) { ST[kt] = mfma16(S##akl[kt], ub, ST[kt]) * S##gl[kt]; Sb[kt] = pk4(ST[kt]); }     \
                ot = mfma16(ub, S##g3, ot); \
                { const int r_ = F.lane & 15, q_ = F.lane >> 4; u32x2 pk_; pk_.x = pk2(ot[0], ot[1]); pk_.y = pk2(ot[2], ot[3]); \
                  *(GAS u32x2*)(O + ((size_t)dir * NTOK + (size_t)seq_row(b, dir, (cc) * 16 + r_)) * 1024 + h * 64 + half * 32 + 16 * cw + 4 * q_) = pk_; } } while (0)
#define R2C_DONE(cc) do { LDS_WAIT(); if (F.lane == 0) __hip_atomic_store(done + cw, (unsigned)((cc) + 1), __ATOMIC_RELAXED, __HIP_MEMORY_SCOPE_WORKGROUP); } while (0)
            R2C_DECL(A_); R2C_DECL(B_);
            __builtin_amdgcn_s_setprio(3);
            if (!(PROBE & 1)) {
                R2C_READ(A_, 0);
                for (int c = 0; c < NCK; c += 2) {
                    R2C_DONE(c); R2C_READ(B_, c + 1); R2C_CHAIN(A_, c);
                    R2C_DONE(c + 1); if (c + 2 < NCK) R2C_READ(A_, c + 2); R2C_CHAIN(B_, c + 1);
                }
            } else {
                for (int c = 0; c < NCK; ++c) { while (lds_ld(ready + (c & (R2_NS - 1))) != (unsigned)(c + 1)) __builtin_amdgcn_s_sleep(1); R2C_DONE(c); }
            }
            __builtin_amdgcn_s_setprio(0);
#undef R2C_DECL
#undef R2C_READ
#undef R2C_CHAIN
#undef R2C_DONE
        }
    }
}

__device__ __forceinline__ float fmix_lo(float a, unsigned b, float c) { float d; asm("v_fma_mix_f32 %0, %1, %2, %3 op_sel:[0,0,0] op_sel_hi:[0,1,0]" : "=v"(d) : "v"(a), "v"(b), "v"(c)); return d; }
__device__ __forceinline__ float fmix_hi(float a, unsigned b, float c) { float d; asm("v_fma_mix_f32 %0, %1, %2, %3 op_sel:[0,1,0] op_sel_hi:[0,1,0]" : "=v"(d) : "v"(a), "v"(b), "v"(c)); return d; }
__device__ __forceinline__ unsigned pkh2(float lo, float hi) { typedef _Float16 h2_t __attribute__((ext_vector_type(2))); h2_t v; v.x = (_Float16)lo; v.y = (_Float16)hi; return __builtin_bit_cast(unsigned, v); }
constexpr int RW_STEPB = 768;
typedef _Float16 h2_t __attribute__((ext_vector_type(2)));
template <int CTRL> __device__ __forceinline__ float dpp_add(float v) { return v + dpp_f<CTRL>(v); }
__device__ __forceinline__ float row8_sum(float v) { v = dpp_add<0xB1>(v); v = dpp_add<0x4E>(v); v = dpp_add<0x141>(v); return v; }
template <int PROBE> PHASE_FN void rw_scan_phase(Frame F, const GAS bf16* Rr, const GAS bf16* Kk, const GAS bf16* Vv, const GAS bf16* WH, const GAS bf16* AH, GAS bf16* O  , GAS float* BETA  ) {
    LAS bf16* W2T = (LAS bf16*)(F.lds + 0); LAS bf16* A2T = (LAS bf16*)(F.lds + 9216);
    LAS bf16* WHS = (LAS bf16*)(F.lds + 18432); LAS bf16* AHS = (LAS bf16*)(F.lds + 27648);
    LAS float* WPA = (LAS float*)(F.lds + 36864);
    LAS unsigned char* STEP = F.lds + 53248;
    LAS float* OP = (LAS float*)(F.lds + 102400);
    LAS float* SO = (LAS float*)(F.lds + 135168);
    LAS float* SVEC = (LAS float*)(F.lds + 143360);
    const int tid = F.tid, lane = F.lane, w = F.wave;
    constexpr int NCH = T / 32;
    for (int unit = F.bid; unit < 256; unit += F.G) {
        const int un = (F.G == 256) ? ((((unit & 7) * 16 + (unit >> 4)) << 1) | ((unit >> 3) & 1)) : unit;
        const int half = un & 1, dir = (un >> 1) & 1, h = (un >> 2) & 15, b = un >> 6;
        __syncthreads();
        for (int i = tid; i < 4096; i += NTHR) { const int l = i >> 6, jn = i & 63; W2T[jn * 72 + l] = (bf16)f2bf(INP(IN_RW_W2)[((size_t)(dir * 64 + l)) * 1024 + h * 64 + jn]); A2T[jn * 72 + l] = (bf16)f2bf(INP(IN_RW_A2)[((size_t)(dir * 64 + l)) * 1024 + h * 64 + jn]); }
        if (tid < 64) { SVEC[tid] = INP(IN_RW_W0)[dir * 1024 + h * 64 + tid]; SVEC[64 + tid] = INP(IN_RW_A0)[dir * 1024 + h * 64 + tid]; SVEC[128 + tid] = INP(IN_RW_KK)[h * 64 + tid];
            SVEC[192 + tid] = INP(IN_RW_KA)[h * 64 + tid]; SVEC[256 + tid] = INP(IN_RW_RK)[h * 64 + tid]; }
        __syncthreads();
        if (w >= 4) {
            const int p = w - 4, tl = lane >> 3, c8 = lane & 7, tp = 8 * p + tl, kc = 8 * c8;
            u32x4 rr, rk, rwh, rah; u32x2 rv;
#define RW_LOAD_RKV(cc) do { const size_t row_ = (size_t)seq_row(b, dir, (cc) * 32 + tp); rr = *(const GAS u32x4*)(Rr + row_ * 1024 + h * 64 + kc); rk = *(const GAS u32x4*)(Kk + row_ * 1024 + h * 64 + kc); \
                rv = *(const GAS u32x2*)(Vv + row_ * 1024 + h * 64 + half * 32 + 4 * c8); } while (0)
#define RW_LOAD_H(cc) do { const size_t row_ = (size_t)seq_row(b, dir, (cc) * 32 + tp); rwh = *(const GAS u32x4*)(WH + row_ * 128 + dir * 64 + kc); rah = *(const GAS u32x4*)(AH + row_ * 128 + dir * 64 + kc); } while (0)
#define RW_STAGE_H(buf) do { *(LAS u32x4*)(WHS + (buf) * (32 * 72) + tp * 72 + kc) = rwh; *(LAS u32x4*)(AHS + (buf) * (32 * 72) + tp * 72 + kc) = rah; } while (0)
#define RW_PREP(cc) do { const int bb_ = (cc) & 1; LAS float* wpa_ = WPA + p * 1024; const int r_ = lane & 15, q_ = lane >> 4; \
                _Pragma("unroll") for (int kt = 0; kt < 4; ++kt) { f32x4 aw_ = {0.f, 0.f, 0.f, 0.f}, aa_ = aw_; \
                    aw_ = mm16<64>(aw_, WHS + bb_ * (32 * 72) + 16 * (p >> 1) * 72, 72, W2T + 16 * kt * 72, 72, lane); aa_ = mm16<64>(aa_, AHS + bb_ * (32 * 72) + 16 * (p >> 1) * 72, 72, A2T + 16 * kt * 72, 72, lane); \
                    if ((q_ >> 1) == (p & 1)) { _Pragma("unroll") for (int i = 0; i < 4; ++i) { wpa_[(4 * (q_ & 1) + i) * 64 + 16 * kt + r_] = aw_[i]; wpa_[512 + (4 * (q_ & 1) + i) * 64 + 16 * kt + r_] = aa_[i]; } } } \
                LDS_WAIT(); \
                float wp_[8], ap_[8], kv_[8], rq_[8]; \
                _Pragma("unroll") for (int jj = 0; jj < 2; ++jj) { const f32x4 x_ = *(const LAS f32x4*)(wpa_ + tl * 64 + kc + 4 * jj) + *(const LAS f32x4*)(SVEC + kc + 4 * jj), y_ = *(const LAS f32x4*)(wpa_ + 512 + tl * 64 + kc + 4 * jj) + *(const LAS f32x4*)(SVEC + 64 + kc + 4 * jj); \
                    _Pragma("unroll") for (int i = 0; i < 4; ++i) { wp_[4 * jj + i] = x_[i]; ap_[4 * jj + i] = y_[i]; } } \
                _Pragma("unroll") for (int jj = 0; jj < 4; ++jj) { kv_[2 * jj] = bflo(rk[jj]); kv_[2 * jj + 1] = bfhi(rk[jj]); rq_[2 * jj] = bflo(rr[jj]); rq_[2 * jj + 1] = bfhi(rr[jj]); } \
                float now_[8], av_[8], kx_[8], gin_[8], gex_[8], ginv_[8], ssq_ = 0.f, bet_ = 0.f; \
                _Pragma("unroll") for (int j = 0; j < 8; ++j) { const float lw_ = -0.6065306597126334f * sigmoid_f(wp_[j]);     \
                    float cs_ = lw_; float y_ = __shfl_up(cs_, 8); if (tl >= 1) cs_ += y_; y_ = __shfl_up(cs_, 16); if (tl >= 2) cs_ += y_; y_ = __shfl_up(cs_, 32); if (tl >= 4) cs_ += y_;     \
                    gin_[j] = __expf(cs_); gex_[j] = __expf(cs_ - lw_); ginv_[j] = __expf(-cs_); now_[j] = gin_[j] - 1.0f;     \
                    av_[j] = sigmoid_f(ap_[j]); kx_[j] = kv_[j] * SVEC[128 + kc + j]; ssq_ += kx_[j] * kx_[j]; } \
                ssq_ = row8_sum(ssq_); const float rn_ = __builtin_amdgcn_rsqf(fmaxf(ssq_, 1e-24f)); \
                u32x4 p0_, p1_, p2_, p3_, p4_; \
                _Pragma("unroll") for (int jj = 0; jj < 4; ++jj) { float nk_[2], ak_[2], kd_[2], rs_[2]; \
                    _Pragma("unroll") for (int hh = 0; hh < 2; ++hh) { const int j = 2 * jj + hh; const float kkn_ = kx_[j] * rn_; nk_[hh] = -kkn_ * gex_[j]; ak_[hh] = kkn_ * av_[j] * ginv_[j]; const float kdt_ = kv_[j] * (1.0f + (av_[j] - 1.0f) * SVEC[192 + kc + j]); kd_[hh] = kdt_ * ginv_[j]; bet_ += rq_[j] * kdt_ * SVEC[256 + kc + j]; rs_[hh] = rq_[j] * gin_[j]; } \
                    p0_[jj] = pkh2(now_[2 * jj], now_[2 * jj + 1]); p1_[jj] = pkh2(nk_[0], nk_[1]); p4_[jj] = pkh2(rs_[0], rs_[1]); \
                    if (jj < 2) { p2_[2 * jj] = pkh2(ak_[0], kd_[0]); p2_[2 * jj + 1] = pkh2(ak_[1], kd_[1]); } else { p3_[2 * (jj - 2)] = pkh2(ak_[0], kd_[0]); p3_[2 * (jj - 2) + 1] = pkh2(ak_[1], kd_[1]); } } \
                bet_ = row8_sum(bet_); \
                LAS unsigned char* sp_ = STEP + bb_ * (32 * RW_STEPB) + tp * RW_STEPB + c8 * 80; \
                *(LAS u32x4*)sp_ = p0_; *(LAS u32x4*)(sp_ + 16) = p1_; *(LAS u32x4*)(sp_ + 32) = p2_; *(LAS u32x4*)(sp_ + 48) = p3_; *(LAS u32x4*)(sp_ + 64) = p4_; \
                *(LAS f32x4*)(STEP + bb_ * (32 * RW_STEPB) + tp * RW_STEPB + 640 + 16 * c8) = (f32x4){bflo(rv.x), bfhi(rv.x), bflo(rv.y), bfhi(rv.y)}; \
                if (c8 == 0 && half == 0) BETA[((size_t)dir * NTOK + seq_row(b, dir, (cc) * 32 + tp)) * 16 + h] = bet_; } while (0)
#define RW_STORE(cc) do { const size_t row_ = (size_t)seq_row(b, dir, (cc) * 32 + tp); const f32x4 o_ = *(const LAS f32x4*)(SO + ((cc) & 1) * 1024 + tp * 32 + 4 * c8); u32x2 pk_; pk_.x = pk2(o_[0], o_[1]); pk_.y = pk2(o_[2], o_[3]); \
                *(GAS u32x2*)(O + ((size_t)dir * NTOK + row_) * 1024 + h * 64 + half * 32 + 4 * c8) = pk_; } while (0)
            RW_LOAD_H(0); RW_LOAD_RKV(0); RW_STAGE_H(0); RW_LOAD_H(1);
            __syncthreads();
            RW_PREP(0); RW_STAGE_H(1); RW_LOAD_RKV(1); RW_LOAD_H(2);
            __syncthreads();
            for (int c = 0; c < NCH; ++c) {
                if (!(PROBE & 2)) {
                if (c > 0) RW_STORE(c - 1);
                if (c + 1 < NCH) { RW_PREP(c + 1); if (c + 2 < NCH) { RW_STAGE_H(c & 1); RW_LOAD_RKV(c + 2); if (c + 3 < NCH) RW_LOAD_H(c + 3); } }
                }
                __syncthreads();
            }
            RW_STORE(NCH - 1);
#undef RW_LOAD_RKV
#undef RW_LOAD_H
#undef RW_STAGE_H
#undef RW_PREP
#undef RW_STORE
        } else {
            const int row = tid >> 3, c8 = tid & 7;
            float S0 = 0.f, S1 = 0.f, S2 = 0.f, S3 = 0.f, S4 = 0.f, S5 = 0.f, S6 = 0.f, S7 = 0.f;
            __syncthreads();
            __syncthreads();
            for (int c = 0; c < NCH; ++c) {
                if (!(PROBE & 1)) {
                const LAS unsigned char* sp = STEP + (c & 1) * (32 * RW_STEPB) + c8 * 80; const LAS unsigned char* vp = STEP + (c & 1) * (32 * RW_STEPB) + 640 + 4 * row; LAS float* op = OP + row * 8 + c8;
                u32x4 a0 = *(const LAS u32x4*)sp, a1 = *(const LAS u32x4*)(sp + 16), a2 = *(const LAS u32x4*)(sp + 32), a3 = *(const LAS u32x4*)(sp + 48), a4 = *(const LAS u32x4*)(sp + 64); float vv = *(const LAS float*)vp;
#pragma unroll 8
                for (int t_ = 0; t_ < 32; ++t_) {
                    const int tn = (t_ + 1) & 31;
                    const LAS unsigned char* np = sp + tn * RW_STEPB;
                    const u32x4 n0 = *(const LAS u32x4*)np, n1 = *(const LAS u32x4*)(np + 16), n2 = *(const LAS u32x4*)(np + 32), n3 = *(const LAS u32x4*)(np + 48), n4 = *(const LAS u32x4*)(np + 64); const float vn = *(const LAS float*)(vp + tn * RW_STEPB);
                    float sa, sb, oa, ob; unsigned sv;
                    asm volatile(
                        "v_fma_mix_f32 %8, %0, %10, 0 op_sel:[0,0,0] op_sel_hi:[0,1,0]\n\t"
                        "v_fma_mix_f32 %9, %1, %10, 0 op_sel:[0,1,0] op_sel_hi:[0,1,0]\n\t"
                        "v_fma_mix_f32 %8, %2, %11, %8 op_sel:[0,0,0] op_sel_hi:[0,1,0]\n\t"
                        "v_fma_mix_f32 %9, %3, %11, %9 op_sel:[0,1,0] op_sel_hi:[0,1,0]\n\t"
                        "v_fma_mix_f32 %8, %4, %12, %8 op_sel:[0,0,0] op_sel_hi:[0,1,0]\n\t"
                        "v_fma_mix_f32 %9, %5, %12, %9 op_sel:[0,1,0] op_sel_hi:[0,1,0]\n\t"
                        "v_fma_mix_f32 %8, %6, %13, %8 op_sel:[0,0,0] op_sel_hi:[0,1,0]\n\t"
                        "v_fma_mix_f32 %9, %7, %13, %9 op_sel:[0,1,0] op_sel_hi:[0,1,0]\n\t"
                        "s_nop 0\n\t"
                        "v_add_f32 %8, %8, %9\n\t"
                        "s_nop 1\n\t"
                        "v_add_f32_dpp %8, %8, %8 quad_perm:[1,0,3,2] row_mask:0xf bank_mask:0xf bound_ctrl:1\n\t"
                        "s_nop 1\n\t"
                        "v_add_f32_dpp %8, %8, %8 quad_perm:[2,3,0,1] row_mask:0xf bank_mask:0xf bound_ctrl:1\n\t"
                        "s_nop 1\n\t"
                        "v_add_f32_dpp %8, %8, %8 row_half_mirror row_mask:0xf bank_mask:0xf bound_ctrl:1\n\t"
                        "s_nop 0"
                        : "+v"(S0), "+v"(S1), "+v"(S2), "+v"(S3), "+v"(S4), "+v"(S5), "+v"(S6), "+v"(S7), "=&v"(sa), "=&v"(sb)
                        : "v"(a1[0]), "v"(a1[1]), "v"(a1[2]), "v"(a1[3]));
                    if (PROBE & 4) asm volatile(
                        "v_cvt_pkrtz_f16_f32 %8, %9, %10\n\t"
                        "v_dot2c_f32_f16 %0, %8, %11\n\t"
                        "v_dot2c_f32_f16 %1, %8, %12\n\t"
                        "v_dot2c_f32_f16 %2, %8, %13\n\t"
                        "v_dot2c_f32_f16 %3, %8, %14\n\t"
                        "v_dot2c_f32_f16 %4, %8, %15\n\t"
                        "v_dot2c_f32_f16 %5, %8, %16\n\t"
                        "v_dot2c_f32_f16 %6, %8, %17\n\t"
                        "v_dot2c_f32_f16 %7, %8, %18\n\t"
                        "s_nop 2"
                        : "+v"(S0), "+v"(S1), "+v"(S2), "+v"(S3), "+v"(S4), "+v"(S5), "+v"(S6), "+v"(S7), "=&v"(sv)
                        : "v"(sa), "v"(vv), "v"(a2[0]), "v"(a2[1]), "v"(a2[2]), "v"(a2[3]), "v"(a3[0]), "v"(a3[1]), "v"(a3[2]), "v"(a3[3]));
                    else
                    asm volatile(
                        "v_cvt_pkrtz_f16_f32 %8, %11, %12\n\t"
                        "v_dot2c_f32_f16 %0, %8, %13\n\t"
                        "v_dot2c_f32_f16 %1, %8, %14\n\t"
                        "v_dot2c_f32_f16 %2, %8, %15\n\t"
                        "v_dot2c_f32_f16 %3, %8, %16\n\t"
                        "v_dot2c_f32_f16 %4, %8, %17\n\t"
                        "v_dot2c_f32_f16 %5, %8, %18\n\t"
                        "v_dot2c_f32_f16 %6, %8, %19\n\t"
                        "v_dot2c_f32_f16 %7, %8, %20\n\t"
                        "v_fma_mix_f32 %9, %0, %21, 0 op_sel:[0,0,0] op_sel_hi:[0,1,0]\n\t"
                        "v_fma_mix_f32 %10, %1, %21, 0 op_sel:[0,1,0] op_sel_hi:[0,1,0]\n\t"
                        "v_fma_mix_f32 %9, %2, %22, %9 op_sel:[0,0,0] op_sel_hi:[0,1,0]\n\t"
                        "v_fma_mix_f32 %10, %3, %22, %10 op_sel:[0,1,0] op_sel_hi:[0,1,0]\n\t"
                        "v_fma_mix_f32 %9, %4, %23, %9 op_sel:[0,0,0] op_sel_hi:[0,1,0]\n\t"
                        "v_fma_mix_f32 %10, %5, %23, %10 op_sel:[0,1,0] op_sel_hi:[0,1,0]\n\t"
                        "v_fma_mix_f32 %9, %6, %24, %9 op_sel:[0,0,0] op_sel_hi:[0,1,0]\n\t"
                        "v_fma_mix_f32 %10, %7, %24, %10 op_sel:[0,1,0] op_sel_hi:[0,1,0]\n\t"
                        "v_add_f32 %9, %9, %10\n\t"
                        "s_nop 0"
                        : "+v"(S0), "+v"(S1), "+v"(S2), "+v"(S3), "+v"(S4), "+v"(S5), "+v"(S6), "+v"(S7), "=&v"(sv), "=&v"(oa), "=&v"(ob)
                        : "v"(sa), "v"(vv), "v"(a2[0]), "v"(a2[1]), "v"(a2[2]), "v"(a2[3]), "v"(a3[0]), "v"(a3[1]), "v"(a3[2]), "v"(a3[3]), "v"(a4[0]), "v"(a4[1]), "v"(a4[2]), "v"(a4[3]));
                    if ((t_ & 7) == 7)
                        asm volatile(
                            "s_nop 1\n\t"
                            "v_fma_mix_f32 %0, %0, %8, %0 op_sel:[0,0,0] op_sel_hi:[0,1,0]\n\t"
                            "v_fma_mix_f32 %1, %1, %8, %1 op_sel:[0,1,0] op_sel_hi:[0,1,0]\n\t"
                            "v_fma_mix_f32 %2, %2, %9, %2 op_sel:[0,0,0] op_sel_hi:[0,1,0]\n\t"
                            "v_fma_mix_f32 %3, %3, %9, %3 op_sel:[0,1,0] op_sel_hi:[0,1,0]\n\t"
                            "v_fma_mix_f32 %4, %4, %10, %4 op_sel:[0,0,0] op_sel_hi:[0,1,0]\n\t"
                            "v_fma_mix_f32 %5, %5, %10, %5 op_sel:[0,1,0] op_sel_hi:[0,1,0]\n\t"
                            "v_fma_mix_f32 %6, %6, %11, %6 op_sel:[0,0,0] op_sel_hi:[0,1,0]\n\t"
                            "v_fma_mix_f32 %7, %7, %11, %7 op_sel:[0,1,0] op_sel_hi:[0,1,0]\n\t"
                            "s_nop 0"
                            : "+v"(S0), "+v"(S1), "+v"(S2), "+v"(S3), "+v"(S4), "+v"(S5), "+v"(S6), "+v"(S7)
                            : "v"(a0[0]), "v"(a0[1]), "v"(a0[2]), "v"(a0[3]));
                    if (!(PROBE & 4)) op[t_ * 256] = oa;
                    a0 = n0; a1 = n1; a2 = n2; a3 = n3; a4 = n4; vv = vn;
                }
                LDS_WAIT();
#pragma unroll
                for (int i = 0; i < 4; ++i) { const LAS f32x4* q_ = (const LAS f32x4*)(OP + ((4 * c8 + i) * 32 + row) * 8); const f32x4 x_ = q_[0] + q_[1]; SO[(c & 1) * 1024 + (4 * c8 + i) * 32 + row] = (x_[0] + x_[1]) + (x_[2] + x_[3]); }
                }
                __syncthreads();
            }
        }
    }
}

PHASE_FN void gemm_mlin(Frame F, int jl) { GAS unsigned char* MIX = F.ws + WS_MIX; GAS unsigned char* HY = F.ws + WS_HY;
    pg8::Gemm g{(const GAS bf16*)HY, (const GAS bf16*)(F.W + W_ML_WIN + jl * W_ML_WIN_SZ), NTOK, 4352, 1024}; pg8::StaticOrder So; So.init(NTOK, 4352, F.G, F.bid);
    pg8::EpiMlstmIn E{(GAS bf16*)MIX, (GAS bf16*)(MIX + 2 * ROWB), (GAS bf16*)(MIX + 3 * ROWB), (GAS float*)(MIX + 4 * ROWB), INP(IN_ML_BGATE) + jl * 32};
    pg8::gemm_phase<pg8::EpiMlstmIn, pg8::StaticOrder, true, GEMM_SP2>(F.lds, g, So, E, F.tid); }
PHASE_FN void gemm_resid(Frame F, const GAS bf16* A, const GAS bf16* Bt, int L, int dry = 0) {
    pg8::Gemm g{A, Bt, NTOK, 1024, 1024}; pg8::StaticOrder So; So.init(NTOK, 1024, F.G, F.bid);
    pg8::EpiResid E{F.ws + WS_S, (const GAS float*)(F.ws + WS_MOD) + (size_t)L * 5 * 6144, 2, dry}; pg8::gemm_phase<pg8::EpiResid, pg8::StaticOrder, true, GEMM_SP2>(F.lds, g, So, E, F.tid); }
PHASE_FN void gemm_rwin(Frame F) { GAS unsigned char* MIX = F.ws + WS_MIX; GAS unsigned char* HY = F.ws + WS_HY;
    GAS bf16* Rb = (GAS bf16*)MIX; GAS bf16* Kb = (GAS bf16*)(MIX + ROWB); GAS bf16* Vb = (GAS bf16*)(MIX + 2 * ROWB); GAS float* WH = (GAS float*)(MIX + 3 * ROWB); GAS float* AH = WH + (size_t)NTOK * 128; GAS bf16* GH = (GAS bf16*)(AH + (size_t)NTOK * 128);
    pg8::Gemm g{(const GAS bf16*)HY, (const GAS bf16*)(F.W + W_RW_IN), NTOK, 3584, 2048}; pg8::StaticOrder So; So.init(NTOK, 3584, F.G, F.bid);
    pg8::EpiRwkvIn E{Rb, Kb, Vb, WH, AH, GH}; pg8::gemm_phase<pg8::EpiRwkvIn, pg8::StaticOrder, true, GEMM_SP2>(F.lds, g, So, E, F.tid); }
PHASE_FN void gemm_rwg(Frame F) { GAS unsigned char* MIX = F.ws + WS_MIX;
    GAS float* WH = (GAS float*)(MIX + 3 * ROWB); GAS float* AH = WH + (size_t)NTOK * 128; GAS bf16* GH = (GAS bf16*)(AH + (size_t)NTOK * 128);
    pg8::Gemm g{GH, (const GAS bf16*)(F.W + W_RW_G2), NTOK, 1024, 256}; pg8::StaticOrder So; So.init(NTOK, 1024, F.G, F.bid);
    pg8::EpiBf16Plain E{(GAS bf16*)MIX, 1024}; pg8::gemm_phase<pg8::EpiBf16Plain, pg8::StaticOrder, GEMM_ALIGN, GEMM_SP2>(F.lds, g, So, E, F.tid); }
PHASE_FN void gemm_hgin(Frame F) { GAS unsigned char* MIX = F.ws + WS_MIX; GAS unsigned char* HY = F.ws + WS_HY;
    pg8::Gemm g{(const GAS bf16*)HY, (const GAS bf16*)(F.W + W_HG_IN), NTOK, 5120, 1024}; pg8::StaticOrder So; So.init(NTOK, 5120, F.G, F.bid);
    pg8::EpiHgrnIn E{(GAS bf16*)MIX, (GAS bf16*)(MIX + ROWB), (GAS bf16*)(MIX + 2 * ROWB), (GAS bf16*)(MIX + 3 * ROWB), (size_t)NTOK * 1024, INP(IN_HG_BF), (const GAS float*)(F.ws + WS_LB)};
    pg8::gemm_phase<pg8::EpiHgrnIn, pg8::StaticOrder, true, GEMM_SP2>(F.lds, g, So, E, F.tid); }
PHASE_FN void gemm_moe1(Frame F, int L) { GAS unsigned char* MIX = F.ws + WS_MIX; LAS int* pref = (LAS int*)(F.lds + LDS_PHASE_BYTES); moe_prefix(F, L, pref, pref + 32);
    pg8::Gemm g{(const GAS bf16*)(F.ws + WS_HY), (const GAS bf16*)(F.W + W_EX13), NSLOT, 16384, 1024, (const GAS int*)(F.ws + WS_SLOT_TOK)}; pg8::MoeOrder So{pref, F.G, F.bid};
    pg8::EpiMoe1 E{(GAS bf16*)(MIX + 140 * MiB)}; pg8::gemm_phase<pg8::EpiMoe1, pg8::MoeOrder, true, GEMM_SP2, true>(F.lds, g, So, E, F.tid); }
PHASE_FN void gemm_moe2(Frame F, int L) { GAS unsigned char* MIX = F.ws + WS_MIX; LAS int* pref = (LAS int*)(F.lds + LDS_PHASE_BYTES); moe_prefix(F, L, pref, pref + 32);
    pg8::Gemm g{(const GAS bf16*)(MIX + 140 * MiB), (const GAS bf16*)(F.W + W_EX2), NSLOT, 16384, 512}; pg8::MoeOrder So{pref, F.G, F.bid};
    pg8::EpiMoe2 E{(GAS bf16*)(MIX + 210 * MiB), (const GAS int*)(F.ws + WS_SLOT_TOK), (const GAS float*)(F.ws + WS_SLOT_GATE)};
    pg8::gemm_phase<pg8::EpiMoe2, pg8::MoeOrder, true, GEMM_SP2>(F.lds, g, So, E, F.tid); }

#ifndef MK_PER_PHASE
#define MK_PER_PHASE 0
#endif
constexpr int PH_PER_LAYER = 12, PH_LAYER0 = 2, PH_FINAL = PH_LAYER0 + DEPTH * PH_PER_LAYER, N_PHASES = PH_FINAL + 1;
__global__ void __launch_bounds__(NTHR, 2) fwd_kernel(Args args) {
    extern __shared__ __attribute__((aligned(16))) unsigned char lds_raw[];
    Frame F;
    F.lds = (LAS unsigned char*)lds_raw; F.out = (GAS float*)args.out; F.ws = (GAS unsigned char*)args.ws; F.W = (GAS unsigned char*)args.wts;
    F.tid = threadIdx.x; F.lane = F.tid & 63; F.wave = __builtin_amdgcn_readfirstlane(F.tid >> 6); F.bid = blockIdx.x; F.G = gridDim.x;
    volatile LAS unsigned* MISC = (volatile LAS unsigned*)(F.lds + MISC_OFF);
    if (F.tid < 32) MISC[F.tid] = 0u;
    if (F.tid < 42) ((LAS unsigned long long*)(F.lds + PTAB_OFF))[F.tid] = (unsigned long long)args.in[F.tid];
    __syncthreads();
    const int lo = args.ph_lo, hi = args.ph_hi;
    XcdBarrier bar; bar.bar = (unsigned*)args.ws + CW_BAR; bar.x = 0; bar.st = MISC + 8;
    if (hi - lo > 1) bar = xcd_barrier_post((unsigned*)args.ws + CW_BAR, MISC + 8);
#define IN(k) (lo <= (k) && (k) < hi)
#ifndef EXTRA_BARS
#define EXTRA_BARS 0
#endif
#define SEAM(k) do { if ((k) + 1 < hi) { xcd_barrier(bar); for (int eb_ = 0; eb_ < EXTRA_BARS; ++eb_) xcd_barrier(bar); } } while (0)
#ifndef DUP_MASK
#define DUP_MASK 0
#endif
#ifndef PRB_MASK
#define PRB_MASK 0
#endif
#define PRB(bit, stmt) do { if ((PRB_MASK >> (bit)) & 1) { stmt; xcd_barrier(bar); } } while (0)
#define DUP(bit, stmt) do { stmt; if ((DUP_MASK >> (bit)) & 1) { xcd_barrier(bar); stmt; } } while (0)

    if (IN(0)) { PRB(0, pre_phase(fresh(F))); pre_phase(fresh(F)); SEAM(0); }
    if (IN(1)) { PRB(0, modsum_phase(fresh(F))); modsum_phase(fresh(F)); SEAM(1); }

    for (int L = 0; L < DEPTH; ++L) {
        const int kind = L % 3, jl = L / 3, pb = PH_LAYER0 + L * PH_PER_LAYER;
        if (IN(pb + 0)) { DUP(6, expert_weights(fresh(F), L)); if ((PRB_MASK >> 1) & 1) { norm_phase<0, 1>(fresh(F), L, L > 0, kind == 1 ? 2048 : 1024); xcd_barrier(bar); } norm_phase<0>(fresh(F), L, L > 0, kind == 1 ? 2048 : 1024); SEAM(pb + 0); }
        if (kind == 0) {
            if (IN(pb + 2)) { DUP(3, gemm_mlin(fresh(F), jl)); SEAM(pb + 2); }
            if (IN(pb + 3)) { DUP(7, conv_phase(fresh(F), jl)); SEAM(pb + 3); }
            if (IN(pb + 4)) { const Frame Fp = fresh(F); GAS unsigned char* MIX = Fp.ws + WS_MIX;
#ifndef SC_PROBE
#define SC_PROBE 0
#endif
#ifndef ML_SCAN
#define ML_SCAN ml_scan3_phase
#endif
#ifndef HG_SCAN
#define HG_SCAN hg_scan3_phase
#endif
#ifndef HG_PROBE
#define HG_PROBE 0
#endif
                if (SC_PROBE) { ML_SCAN<SC_PROBE>(Fp, (const GAS bf16*)(Fp.ws + WS_HY), (const GAS bf16*)(MIX + 2 * ROWB), (const GAS float*)(MIX + 4 * ROWB), (GAS bf16*)MIX); xcd_barrier(bar); }
                DUP(0, ML_SCAN<0>(Fp, (const GAS bf16*)(Fp.ws + WS_HY), (const GAS bf16*)(MIX + 2 * ROWB), (const GAS float*)(MIX + 4 * ROWB), (GAS bf16*)MIX)); SEAM(pb + 4); }
            if (IN(pb + 6)) { const Frame Fp = fresh(F); GAS unsigned char* MIX = Fp.ws + WS_MIX;
                PRB(4, headnorm_phase(Fp, (const GAS bf16*)MIX, (const GAS bf16*)(MIX + ROWB), (const GAS bf16*)(MIX + 3 * ROWB), ldptr(Fp, IN_ML_HEADG) + jl * 1024, (GAS bf16*)(Fp.ws + WS_HY + ROWB)));
                headnorm_phase(Fp, (const GAS bf16*)MIX, (const GAS bf16*)(MIX + ROWB), (const GAS bf16*)(MIX + 3 * ROWB), ldptr(Fp, IN_ML_HEADG) + jl * 1024, (GAS bf16*)(Fp.ws + WS_HY + ROWB)); SEAM(pb + 6); }
            if (IN(pb + 7)) { const Frame Fp = fresh(F); PRB(5, gemm_resid(Fp, (const GAS bf16*)(Fp.ws + WS_HY + ROWB), (const GAS bf16*)(Fp.W + W_ML_WOUT + jl * 2 * MiB), L, 1)); gemm_resid(Fp, (const GAS bf16*)(Fp.ws + WS_HY + ROWB), (const GAS bf16*)(Fp.W + W_ML_WOUT + jl * 2 * MiB), L); SEAM(pb + 7); }
        } else if (kind == 1) {
            if (IN(pb + 1)) { PRB(4, du_phase(fresh(F))); du_phase(fresh(F)); SEAM(pb + 1); }
            if (IN(pb + 2)) { DUP(3, gemm_rwin(fresh(F))); SEAM(pb + 2); }
            if (IN(pb + 4)) { const Frame Fp = fresh(F); GAS unsigned char* MIX = Fp.ws + WS_MIX; GAS float* WH = (GAS float*)(MIX + 3 * ROWB); GAS float* AH = WH + (size_t)NTOK * 128; GAS float* BETA = (GAS float*)((GAS bf16*)(AH + (size_t)NTOK * 128) + (size_t)NTOK * 256);

#ifndef RW_PROBE
#define RW_PROBE 0
#endif
#ifndef RW_SCAN
#define RW_SCAN rw_scan2_phase
#endif
                if (RW_PROBE) { RW_SCAN<RW_PROBE>(Fp, (const GAS bf16*)MIX, (const GAS bf16*)(MIX + ROWB), (const GAS bf16*)(MIX + 2 * ROWB), (const GAS bf16*)WH, (const GAS bf16*)AH, (GAS bf16*)(Fp.ws + WS_HY), BETA); xcd_barrier(bar); }
                DUP(1, RW_SCAN<0>(Fp, (const GAS bf16*)MIX, (const GAS bf16*)(MIX + ROWB), (const GAS bf16*)(MIX + 2 * ROWB), (const GAS bf16*)WH, (const GAS bf16*)AH, (GAS bf16*)(Fp.ws + WS_HY), BETA)); SEAM(pb + 4); }
            if (IN(pb + 5)) { PRB(4, gemm_rwg(fresh(F))); gemm_rwg(fresh(F)); SEAM(pb + 5); }
            if (IN(pb + 6)) { const Frame Fp = fresh(F); GAS unsigned char* MIX = Fp.ws + WS_MIX; GAS float* WH = (GAS float*)(MIX + 3 * ROWB); GAS float* AH = WH + (size_t)NTOK * 128; GAS float* BETA = (GAS float*)((GAS bf16*)(AH + (size_t)NTOK * 128) + (size_t)NTOK * 256);
                PRB(4, rwpost_phase(Fp, (const GAS bf16*)(Fp.ws + WS_HY), (const GAS bf16*)(Fp.ws + WS_HY + ROWB), BETA, (const GAS bf16*)(MIX + 2 * ROWB), (const GAS bf16*)MIX, (GAS bf16*)(MIX + ROWB)));
                rwpost_phase(Fp, (const GAS bf16*)(Fp.ws + WS_HY), (const GAS bf16*)(Fp.ws + WS_HY + ROWB), BETA, (const GAS bf16*)(MIX + 2 * ROWB), (const GAS bf16*)MIX, (GAS bf16*)(MIX + ROWB)); SEAM(pb + 6); }
            if (IN(pb + 7)) { const Frame Fp = fresh(F); PRB(5, gemm_resid(Fp, (const GAS bf16*)(Fp.ws + WS_MIX + ROWB), (const GAS bf16*)(Fp.W + W_RW_WOUT), L, 1)); gemm_resid(Fp, (const GAS bf16*)(Fp.ws + WS_MIX + ROWB), (const GAS bf16*)(Fp.W + W_RW_WOUT), L); SEAM(pb + 7); }
        } else {
            if (IN(pb + 2)) { DUP(3, gemm_hgin(fresh(F))); SEAM(pb + 2); }
            if (IN(pb + 4)) { const Frame Fp = fresh(F); GAS unsigned char* MIX = Fp.ws + WS_MIX;
                if (HG_PROBE) { HG_SCAN<HG_PROBE>(Fp, (const GAS bf16*)MIX, (const GAS bf16*)(MIX + ROWB), (const GAS bf16*)(MIX + 3 * ROWB), (GAS bf16*)(Fp.ws + WS_HY + ROWB), (GAS bf16*)(Fp.ws + WS_HY)); xcd_barrier(bar); }
                DUP(2, HG_SCAN<0>(Fp, (const GAS bf16*)MIX, (const GAS bf16*)(MIX + ROWB), (const GAS bf16*)(MIX + 3 * ROWB), (GAS bf16*)(Fp.ws + WS_HY + ROWB), (GAS bf16*)(Fp.ws + WS_HY))); SEAM(pb + 4); }
            if (IN(pb + 6)) { const Frame Fp = fresh(F); GAS unsigned char* MIX = Fp.ws + WS_MIX;
                headnorm_phase(Fp, (const GAS bf16*)(Fp.ws + WS_HY + ROWB), (const GAS bf16*)(Fp.ws + WS_HY), (const GAS bf16*)(MIX + 2 * ROWB), ldptr(Fp, IN_HG_HEADG), (GAS bf16*)(Fp.ws + WS_HY + ROWB)); SEAM(pb + 6); }
            if (IN(pb + 7)) { const Frame Fp = fresh(F); PRB(5, gemm_resid(Fp, (const GAS bf16*)(Fp.ws + WS_HY + ROWB), (const GAS bf16*)(Fp.W + W_HG_WOUT), L, 1)); gemm_resid(Fp, (const GAS bf16*)(Fp.ws + WS_HY + ROWB), (const GAS bf16*)(Fp.W + W_HG_WOUT), L); SEAM(pb + 7); }
        }
        if (IN(pb + 8)) { if ((PRB_MASK >> 2) & 1) { route2_phase<1>(fresh(F), L); xcd_barrier(bar); } route2_phase<0>(fresh(F), L);
            SEAM(pb + 8); }
        if (IN(pb + 9)) { if ((PRB_MASK >> 3) & 1) { slots_phase<1>(fresh(F), L); xcd_barrier(bar); } slots_phase<0>(fresh(F), L); SEAM(pb + 9); }
        if (IN(pb + 10)) { DUP(4, gemm_moe1(fresh(F), L)); SEAM(pb + 10); }
        if (IN(pb + 11)) { DUP(5, gemm_moe2(fresh(F), L)); SEAM(pb + 11); }
    }
    if (IN(PH_FINAL)) norm_phase<2>(fresh(F), 0, true, 1024);
#undef IN
#undef SEAM
}

extern "C" void kernel_launch(void* const* d_in, const int* in_sizes, int n_in, void* d_out, int out_size, void* d_ws, size_t ws_size, hipStream_t stream) {
    static int grid = 0;
    if (grid == 0) {
        if (n_in != 42 || out_size != NB * SEQ * D || ws_size < WS_END) { fprintf(stderr, "kernel_launch: unexpected problem (n_in %d, out %d, ws %zu)\n", n_in, out_size, ws_size); grid = -1; return; }
        int dev = 0, cus = 0, per_cu = 0;
        if (hipGetDevice(&dev) != hipSuccess || hipDeviceGetAttribute(&cus, hipDeviceAttributeMultiprocessorCount, dev) != hipSuccess) { grid = -1; return; }
        if (hipFuncSetAttribute((const void*)fwd_kernel, hipFuncAttributeMaxDynamicSharedMemorySize, LDS_BYTES) != hipSuccess) { fprintf(stderr, "kernel_launch: hipFuncSetAttribute failed\n"); grid = -1; return; }
        if (hipOccupancyMaxActiveBlocksPerMultiprocessor(&per_cu, (const void*)fwd_kernel, NTHR, LDS_BYTES) != hipSuccess || per_cu < 1) { fprintf(stderr, "kernel_launch: occupancy query reports %d\n", per_cu); (void)hipGetLastError(); grid = -1; return; }
        grid = cus;
    }
    if (grid < 0) return;
    (void)hipMemsetAsync(d_ws, 0, CTL_ZERO_BYTES, stream);
    Args a{};
    for (int i = 0; i < 42; ++i) a.in[i] = (const float*)d_in[i];
    a.out = (float*)d_out; a.ws = (unsigned char*)d_ws;
    a.wts = (ws_size >= WS_END + W_BYTES) ? (unsigned char*)d_ws + WS_END : (unsigned char*)d_out;
#if MK_PER_PHASE
    for (int p = 0; p < N_PHASES; ++p) { a.ph_lo = p; a.ph_hi = p + 1; hipLaunchKernelGGL(fwd_kernel, dim3(grid), dim3(NTHR), LDS_BYTES, stream, a); }
#else
    a.ph_lo = 0; a.ph_hi = N_PHASES;
    hipLaunchKernelGGL(fwd_kernel, dim3(grid), dim3(NTHR), LDS_BYTES, stream, a);
#endif
}
```

```cpp
#include <hip/hip_runtime.h>
#include <cstdio>
#include <cstdint>

__device__ __forceinline__ float sigmoid_f(float x) { return __builtin_amdgcn_rcpf(1.0f + __expf(-x)); }
__device__ __forceinline__ float silu_f(float x) { return x * __builtin_amdgcn_rcpf(1.0f + __expf(-x)); }
__device__ __forceinline__ float logsigmoid_f(float x) { return fminf(x, 0.f) - __logf(1.0f + __expf(-fabsf(x))); }
#define GAS __attribute__((address_space(1)))
#ifndef S_BF16
#define S_BF16 1
#endif
namespace pg8 {
#define PG8_LAS __attribute__((address_space(3)))
typedef unsigned short bf16_t;
typedef short bf16x8 __attribute__((ext_vector_type(8)));
typedef float f32x4 __attribute__((ext_vector_type(4)));
typedef unsigned u32x4 __attribute__((ext_vector_type(4)));
constexpr int BM = 256, BK = 64, HALF = 128, HTB = HALF * BK * 2  , STAGE_BYTES = 8 * HTB, NXCD = 8, WGM = 8;

__host__ __device__ __forceinline__ int lds_byte(int r, int c) { const int st = (r >> 4) * 2 + (c >> 5), rr = r & 15, cc = c & 31, ob = rr * 64 + cc * 2; return st * 1024 + (ob ^ (((ob >> 9) & 1) << 5)); }
__host__ __device__ __forceinline__ void stage_rc(int b, int& R, int& C) { const int st = b / 1024, sb = b % 1024, swz = sb ^ (((sb >> 9) & 1) << 5); R = (st >> 1) * 16 + swz / 64; C = (st & 1) * 32 + (swz % 64) / 2; }
__host__ __device__ __forceinline__ int perm32(int rho) { const int n = rho >> 4, i = rho & 15; return 8 * (i >> 2) + 4 * n + (i & 3); }

struct Unit { int pm, pn; };
struct Gemm { const GAS bf16_t* A; const GAS bf16_t* Bt; int M, N, K; const GAS int* gidx; };

struct StaticOrder {
    int nM, nN, nwg, G, c;
    __host__ __device__ void init(int M, int N, int G_, int c_) { nM = M / BM; nN = N / BM; nwg = nM * nN; G = G_; c = c_; }
    __host__ __device__ bool next(int i, Unit& u) const {
        const long L = (long)i * G + c; if (L >= nwg) return false;
        int wgid = (int)L; { const int q = nwg / NXCD, r = nwg % NXCD, xcd = wgid % NXCD, off = wgid / NXCD; wgid = (xcd < r ? xcd * (q + 1) : r * (q + 1) + (xcd - r) * q) + off; }
        const int nig = WGM * nN, gid = wgid / nig, fm = gid * WGM, gsz = (nM - fm) < WGM ? (nM - fm) : WGM;
        u.pm = fm + ((wgid % nig) % gsz); u.pn = (wgid % nig) / gsz; return true;
    }
    __device__ __forceinline__ void a_ready(const Unit&) const {}
    __device__ __forceinline__ void done(const Unit&) const {}
};
typedef float f32x2_pg8 __attribute__((ext_vector_type(2))); typedef __bf16 bf16x2_pg8 __attribute__((ext_vector_type(2)));
__device__ __forceinline__ unsigned cvt_pk_bf16(float lo, float hi) { f32x2_pg8 v = {lo, hi}; bf16x2_pg8 b = __builtin_convertvector(v, bf16x2_pg8); return __builtin_bit_cast(unsigned, b); }
typedef unsigned u32x2 __attribute__((ext_vector_type(2)));
__device__ __forceinline__ void st8(GAS bf16_t* p, f32x4 v0, f32x4 v1) { u32x4 w; w.x = cvt_pk_bf16(v0[0], v0[1]); w.y = cvt_pk_bf16(v0[2], v0[3]); w.z = cvt_pk_bf16(v1[0], v1[1]); w.w = cvt_pk_bf16(v1[2], v1[3]); *(GAS u32x4*)p = w; }
template <int ACT> __device__ __forceinline__ f32x4 act4(f32x4 v) {
    if (ACT == 1) { v[0] = sigmoid_f(v[0]); v[1] = sigmoid_f(v[1]); v[2] = sigmoid_f(v[2]); v[3] = sigmoid_f(v[3]); }
    if (ACT == 2) { v[0] = silu_f(v[0]); v[1] = silu_f(v[1]); v[2] = silu_f(v[2]); v[3] = silu_f(v[3]); }
    return v; }
template <int ACT> __device__ __forceinline__ void store_tile_bf16(const f32x4 (&acc)[2][2][4][2], GAS bf16_t* base, int ld, int row0, int cw) {
#pragma unroll
    for (int ai = 0; ai < 2; ++ai)
#pragma unroll
        for (int m = 0; m < 4; ++m) { GAS bf16_t* rp = base + (size_t)(row0 + ai * HALF + m * 16) * ld + cw;
#pragma unroll
            for (int bj = 0; bj < 2; ++bj) st8(rp + bj * HALF, act4<ACT>(acc[ai][bj][m][0]), act4<ACT>(acc[ai][bj][m][1])); }
}
struct EpiBf16Plain { static constexpr bool PERM = true, AFTER_DRAIN = false; GAS bf16_t* O; int ldc;
    __device__ __forceinline__ void operator()(const f32x4 (&acc)[2][2][4][2], const Unit& u, int wr, int wc, int fr, int fq) const {
        store_tile_bf16<0>(acc, O + u.pn * BM, ldc, u.pm * BM + wr * 64 + fr, wc * 32 + 8 * fq); }
};
struct EpiMlstmIn { static constexpr bool PERM = true, AFTER_DRAIN = false;
    GAS bf16_t* QKPRE; GAS bf16_t* V; GAS bf16_t* OG; GAS float* GATES; const GAS float* bgate;
    __device__ __forceinline__ void operator()(const f32x4 (&acc)[2][2][4][2], const Unit& u, int wr, int wc, int fr, int fq) const {
        const int row0 = u.pm * BM + wr * 64 + fr, cw = wc * 32 + 8 * fq;
        if (u.pn < 8) store_tile_bf16<0>(acc, QKPRE + u.pn * BM, 2048, row0, cw);
        else if (u.pn < 12) store_tile_bf16<0>(acc, V + (u.pn - 8) * BM, 1024, row0, cw);
        else if (u.pn < 16) store_tile_bf16<1>(acc, OG + (u.pn - 12) * BM, 1024, row0, cw);
        else if (wc == 0) {
            const f32x4 b0 = *(const GAS f32x4*)(bgate + 8 * fq), b1 = *(const GAS f32x4*)(bgate + 8 * fq + 4);
#pragma unroll
            for (int ai = 0; ai < 2; ++ai)
#pragma unroll
                for (int m = 0; m < 4; ++m) { GAS float* gp = GATES + (size_t)(row0 + ai * HALF + m * 16) * 32 + 8 * fq;
                    *(GAS f32x4*)gp = acc[ai][0][m][0] + b0; *(GAS f32x4*)(gp + 4) = acc[ai][0][m][1] + b1; }
        }
    }
};
struct EpiRwkvIn { static constexpr bool PERM = true, AFTER_DRAIN = false;
    GAS bf16_t* R; GAS bf16_t* Kk; GAS bf16_t* V; GAS float* WH; GAS float* AH; GAS bf16_t* GH;
    __device__ __forceinline__ void operator()(const f32x4 (&acc)[2][2][4][2], const Unit& u, int wr, int wc, int fr, int fq) const {
        const int row0 = u.pm * BM + wr * 64 + fr, cw = wc * 32 + 8 * fq;
        if (u.pn < 4) store_tile_bf16<0>(acc, R + u.pn * BM, 1024, row0, cw);
        else if (u.pn < 8) store_tile_bf16<0>(acc, Kk + (u.pn - 4) * BM, 1024, row0, cw);
        else if (u.pn < 12) store_tile_bf16<0>(acc, V + (u.pn - 8) * BM, 1024, row0, cw);
        else if (u.pn == 12) {
#pragma unroll
            for (int ai = 0; ai < 2; ++ai)
#pragma unroll
                for (int m = 0; m < 4; ++m) { const size_t r = (size_t)(row0 + ai * HALF + m * 16);
                    f32x4 t0 = acc[ai][0][m][0], t1 = acc[ai][0][m][1];
#pragma unroll
                    for (int j = 0; j < 4; ++j) { t0[j] = tanhf(t0[j]); t1[j] = tanhf(t1[j]); }
                    st8((GAS bf16_t*)WH + r * 128 + cw, t0, t1); st8((GAS bf16_t*)AH + r * 128 + cw, acc[ai][1][m][0], acc[ai][1][m][1]); }
        } else {
#pragma unroll
            for (int ai = 0; ai < 2; ++ai)
#pragma unroll
                for (int m = 0; m < 4; ++m) { GAS bf16_t* rp = GH + (size_t)(row0 + ai * HALF + m * 16) * 256 + cw;
                    st8(rp, act4<1>(acc[ai][0][m][0]), act4<1>(acc[ai][0][m][1])); *(GAS u32x4*)(rp + HALF) = (u32x4){0u, 0u, 0u, 0u}; }
        }
    }
};
struct EpiHgrnIn { static constexpr bool PERM = true, AFTER_DRAIN = false;
    GAS bf16_t* Q; GAS bf16_t* V; GAS bf16_t* OG; GAS bf16_t* LF; size_t lf_stride; const GAS float* bf; const GAS float* lb;
    __device__ __forceinline__ void operator()(const f32x4 (&acc)[2][2][4][2], const Unit& u, int wr, int wc, int fr, int fq) const {
        const int row0 = u.pm * BM + wr * 64 + fr, cw = wc * 32 + 8 * fq;
        if (u.pn < 4) store_tile_bf16<2>(acc, Q + u.pn * BM, 1024, row0, cw);
        else if (u.pn < 8) store_tile_bf16<0>(acc, V + (u.pn - 4) * BM, 1024, row0, cw);
        else if (u.pn < 12) store_tile_bf16<2>(acc, OG + (u.pn - 8) * BM, 1024, row0, cw);
        else {
            const int dir = (u.pn - 12) >> 2, ct = ((u.pn - 12) & 3) * BM; GAS bf16_t* base = LF + (size_t)dir * lf_stride + ct;
            f32x4 bb[2][2], ll[2][2];
#pragma unroll
            for (int bj = 0; bj < 2; ++bj)
#pragma unroll
                for (int n = 0; n < 2; ++n) { bb[bj][n] = *(const GAS f32x4*)(bf + dir * 1024 + ct + bj * HALF + cw + 4 * n); ll[bj][n] = *(const GAS f32x4*)(lb + ct + bj * HALF + cw + 4 * n); }
#pragma unroll
            for (int ai = 0; ai < 2; ++ai)
#pragma unroll
                for (int m = 0; m < 4; ++m) { GAS bf16_t* rp = base + (size_t)(row0 + ai * HALF + m * 16) * 1024 + cw;
#pragma unroll
                    for (int bj = 0; bj < 2; ++bj) { f32x4 o[2];
#pragma unroll
                        for (int n = 0; n < 2; ++n)
#pragma unroll
                            for (int j = 0; j < 4; ++j) { const float l = ll[bj][n][j]; o[n][j] = __logf(l + (1.f - l) * sigmoid_f(acc[ai][bj][m][n][j] + bb[bj][n][j])); }
                        st8(rp + bj * HALF, o[0], o[1]); } }
        }
    }
};
struct EpiResid { static constexpr bool PERM = S_BF16 ? true : false, AFTER_DRAIN = false;
    GAS unsigned char* S; const GAS float* mod; int gate_idx; int dry;
    __device__ __forceinline__ void operator()(const f32x4 (&acc)[2][2][4][2], const Unit& u, int wr, int wc, int fr, int fq) const {
        const int b = u.pm / 33, seg = (u.pm - b * 33 == 0) ? 0 : 1 + b;
        if (S_BF16) {
            const int row0 = u.pm * BM + wr * 64 + fr, col0 = u.pn * BM + wc * 32 + 8 * fq;
            const GAS float* gp = mod + seg * 6144 + gate_idx * 1024 + col0;
            f32x4 gv[2][2];
#pragma unroll
            for (int bj = 0; bj < 2; ++bj)
#pragma unroll
                for (int n = 0; n < 2; ++n) gv[bj][n] = *(const GAS f32x4*)(gp + bj * HALF + n * 4);
#pragma unroll
            for (int ai = 0; ai < 2; ++ai)
#pragma unroll
                for (int m = 0; m < 4; ++m) { GAS bf16_t* rowp = (GAS bf16_t*)S + (size_t)(row0 + ai * HALF + m * 16) * 1024 + col0;
#pragma unroll
                    for (int bj = 0; bj < 2; ++bj) { GAS u32x4* p = (GAS u32x4*)(rowp + bj * HALF); const u32x4 o = *p;
                        f32x4 v0 = {__builtin_bit_cast(float, o.x << 16), __builtin_bit_cast(float, o.x & 0xffff0000u), __builtin_bit_cast(float, o.y << 16), __builtin_bit_cast(float, o.y & 0xffff0000u)};
                        f32x4 v1 = {__builtin_bit_cast(float, o.z << 16), __builtin_bit_cast(float, o.z & 0xffff0000u), __builtin_bit_cast(float, o.w << 16), __builtin_bit_cast(float, o.w & 0xffff0000u)};
                        v0 += acc[ai][bj][m][0] * gv[bj][0]; v1 += acc[ai][bj][m][1] * gv[bj][1];
                        if (!dry || v0[0] == 1.2345e33f) st8(rowp + bj * HALF, v0, v1); } }
        } else {
            const int row0 = u.pm * BM + wr * 64 + fr, col0 = u.pn * BM + wc * 32 + 4 * fq;
            const GAS float* gp = mod + seg * 6144 + gate_idx * 1024 + col0;
            f32x4 gv[2][2];
#pragma unroll
            for (int bj = 0; bj < 2; ++bj)
#pragma unroll
                for (int n = 0; n < 2; ++n) gv[bj][n] = *(const GAS f32x4*)(gp + bj * HALF + n * 16);
#pragma unroll
            for (int ai = 0; ai < 2; ++ai)
#pragma unroll
                for (int m = 0; m < 4; ++m) { GAS float* rowp = (GAS float*)S + (size_t)(row0 + ai * HALF + m * 16) * 1024 + col0;
#pragma unroll
                    for (int bj = 0; bj < 2; ++bj)
#pragma unroll
                        for (int n = 0; n < 2; ++n) { GAS f32x4* p = (GAS f32x4*)(rowp + bj * HALF + n * 16); const f32x4 v_ = *p + acc[ai][bj][m][n] * gv[bj][n]; if (!dry || v_[0] == 1.2345e33f) *p = v_; } }
        }
    }
};
struct EpiMoe1 { static constexpr bool PERM = true, AFTER_DRAIN = false; GAS bf16_t* ACT;
    __device__ __forceinline__ void operator()(const f32x4 (&acc)[2][2][4][2], const Unit& u, int wr, int wc, int fr, int fq) const {
        const int row0 = u.pm * BM + wr * 64 + fr, pnl = u.pn & 3, c0 = pnl * 128 + wc * 16 + 4 * fq;
#pragma unroll
        for (int ai = 0; ai < 2; ++ai)
#pragma unroll
            for (int m = 0; m < 4; ++m) { GAS bf16_t* rp = ACT + (size_t)(row0 + ai * HALF + m * 16) * 512 + c0;
#pragma unroll
                for (int bj = 0; bj < 2; ++bj) { const f32x4 a = acc[ai][bj][m][0], b = acc[ai][bj][m][1];
                    u32x2 w; w.x = cvt_pk_bf16(silu_f(a[0]) * b[0], silu_f(a[1]) * b[1]); w.y = cvt_pk_bf16(silu_f(a[2]) * b[2], silu_f(a[3]) * b[3]);
                    *(GAS u32x2*)(rp + bj * 64) = w; } }
    }
};
struct EpiMoe2 { static constexpr bool PERM = true, AFTER_DRAIN = false; GAS bf16_t* YM; const GAS int* slot_tok; const GAS float* slot_gate;
    __device__ __forceinline__ void operator()(const f32x4 (&acc)[2][2][4][2], const Unit& u, int wr, int wc, int fr, int fq) const {
        const int row0 = u.pm * BM + wr * 64 + fr, col0 = (u.pn & 3) * BM + wc * 32 + 8 * fq;
#pragma unroll
        for (int ai = 0; ai < 2; ++ai)
#pragma unroll
            for (int m = 0; m < 4; ++m) { const int slot = row0 + ai * HALF + m * 16; const int dst = slot_tok[slot]; const float g = slot_gate[slot];
                if (dst >= 0) { GAS bf16_t* rp = YM + (size_t)dst * 1024 + col0;
#pragma unroll
                    for (int bj = 0; bj < 2; ++bj) st8(rp + bj * HALF, acc[ai][bj][m][0] * g, acc[ai][bj][m][1] * g); } }
    }
};
struct MoeOrder { const PG8_LAS int* pref; int G, c;
    __device__ __forceinline__ bool next(int i, Unit& u) const {
        const int L = i * G + c, nt = pref[16]; if (L >= nt * 4) return false;
        const int tile = L >> 2; int e = 0;
#pragma unroll
        for (int j = 1; j < 16; ++j) e += (tile >= pref[j]) ? 1 : 0;
        u.pm = tile; u.pn = e * 4 + (L & 3); return true; }
    __device__ __forceinline__ void a_ready(const Unit&) const {}
    __device__ __forceinline__ void done(const Unit&) const {}
};
template <class Epi, class Sched, bool ALIGN_EPI = false, bool SP2 = false, bool GATHER = false>
__device__ __forceinline__ void gemm_phase(PG8_LAS unsigned char* lds, const Gemm g, const Sched& S, const Epi& E, const int tid_in) {
    int tid_ = tid_in; asm volatile("" : "+v"(tid_));
    const int tid = tid_, wid = __builtin_amdgcn_readfirstlane(tid >> 6), lane = tid & 63, wr = wid >> 2, wc = wid & 3, fr = lane & 15, fq = lane >> 4;
    const int K = g.K, nt = K / BK;
    unsigned voffA[2], voffB[2];
#pragma unroll
    for (int i = 0; i < 2; ++i) { int R, C; stage_rc(tid * 16 + i * 8192, R, C); const int Rb = Epi::PERM ? ((R & ~31) + perm32(R & 31)) : R;
        voffA[i] = (unsigned)(R * K + C) * 2u; voffB[i] = (unsigned)(Rb * K + C) * 2u; }
    unsigned offc[2][2], offn[2][2];
#define PG8_GOFF(dst, unit) do { _Pragma("unroll") for (int _h = 0; _h < 2; ++_h) _Pragma("unroll") for (int _i = 0; _i < 2; ++_i) { int _R, _C; stage_rc(tid * 16 + _i * 8192, _R, _C); \
        const int _t = g.gidx[(unit).pm * BM + _h * HALF + _R]; dst[_h][_i] = (unsigned)(((_t < 0 ? 0 : (_t >> 1)) * K + _C) * 2); } } while (0)
    const size_t kstep = (size_t)(BK * 2);
    const size_t hstep = (size_t)HALF * K * 2;
    const size_t tstep = 2 * hstep;
    if constexpr (!GATHER) {
#pragma unroll
        for (int h_ = 0; h_ < 2; ++h_)
#pragma unroll
            for (int i = 0; i < 2; ++i) { offc[h_][i] = voffA[i] + (unsigned)(h_ * hstep); offn[h_][i] = offc[h_][i]; } }
    const unsigned ldsw = (unsigned)wid * 1024u;
    const int aoff = lds_byte(wr * 64 + fr, fq * 8), boff = lds_byte(wc * 32 + fr, fq * 8);
#define PG8_SA(b, h) (((b) * 2 + (h)) * HTB)
#define PG8_SB(b, h) ((4 + (b) * 2 + (h)) * HTB)
#define PG8_STAGE(bufoff, gbase, voff) do { _Pragma("unroll") for (int _i = 0; _i < 2; ++_i) \
        __builtin_amdgcn_global_load_lds((const unsigned*)((const char*)(gbase) + (voff)[_i]), (PG8_LAS unsigned*)(lds + (bufoff) + ldsw + _i * 8192), 16, 0, 0); } while (0)
#define PG8_STAGE_A(bufoff, gbase, off2) do { _Pragma("unroll") for (int _i = 0; _i < 2; ++_i) \
        __builtin_amdgcn_global_load_lds((const unsigned*)((const char*)(gbase) + (off2)[_i]), (PG8_LAS unsigned*)(lds + (bufoff) + ldsw + _i * 8192), 16, 0, 0); } while (0)
#define PG8_LDA(dst, b, h) do { _Pragma("unroll") for (int m = 0; m < 4; ++m) _Pragma("unroll") for (int k = 0; k < 2; ++k) dst[m][k] = *(const PG8_LAS bf16x8*)(lds + PG8_SA(b, h) + aoff + m * 2048 + k * 1024); } while (0)
#define PG8_LDB(dst, b, h) do { _Pragma("unroll") for (int n = 0; n < 2; ++n) _Pragma("unroll") for (int k = 0; k < 2; ++k) dst[n][k] = *(const PG8_LAS bf16x8*)(lds + PG8_SB(b, h) + boff + n * 2048 + k * 1024); } while (0)
#define PG8_MMA(ai, bj, At, Bt) do { __builtin_amdgcn_s_setprio(1); _Pragma("unroll") for (int m = 0; m < 4; ++m) _Pragma("unroll") for (int n = 0; n < 2; ++n) _Pragma("unroll") for (int k = 0; k < 2; ++k) \
        acc[ai][bj][m][n] = __builtin_amdgcn_mfma_f32_16x16x32_bf16(Bt[n][k], At[m][k], acc[ai][bj][m][n], 0, 0, 0); __builtin_amdgcn_s_setprio(0); } while (0)
#define PG8_WAIT_V(n) asm volatile("s_waitcnt vmcnt(" #n ")" ::: "memory")
#define PG8_WAIT_L(n) asm volatile("s_waitcnt lgkmcnt(" #n ")" ::: "memory")
#define PG8_BAR __builtin_amdgcn_s_barrier()
#define PG8_SCHED __builtin_amdgcn_sched_barrier(0)
    Unit cur, nxt; int ui = 0;
    if (!S.next(0, cur)) return;
    f32x4 acc[2][2][4][2];
#pragma unroll
    for (int a = 0; a < 2; ++a)
#pragma unroll
        for (int b = 0; b < 2; ++b)
#pragma unroll
            for (int m = 0; m < 4; ++m)
#pragma unroll
                for (int n = 0; n < 2; ++n) acc[a][b][m][n] = (f32x4){0.f, 0.f, 0.f, 0.f};
    bf16x8 At[4][2], B0[2][2], B1[2][2];
    const char* cA = (const char*)g.A + (GATHER ? (size_t)0 : (size_t)cur.pm * tstep); const char* cB = (const char*)g.Bt + (size_t)cur.pn * tstep;
    S.a_ready(cur);
    if constexpr (GATHER) PG8_GOFF(offc, cur);
    if constexpr (SP2) {
        PG8_STAGE(PG8_SB(0, 0), cB, voffB); PG8_STAGE(PG8_SB(0, 1), cB + hstep, voffB); PG8_STAGE_A(PG8_SA(0, 0), cA, offc[0]); PG8_STAGE_A(PG8_SA(0, 1), cA, offc[1]);
        if (wr == 1) PG8_BAR;
        PG8_WAIT_V(2); PG8_BAR;
        PG8_STAGE(PG8_SB(1, 0), cB + kstep, voffB); PG8_STAGE_A(PG8_SA(1, 0), cA + kstep, offc[0]); PG8_STAGE(PG8_SB(1, 1), cB + hstep + kstep, voffB);
        PG8_WAIT_V(6); PG8_BAR;
    } else {
        PG8_STAGE(PG8_SB(0, 0), cB, voffB); PG8_STAGE_A(PG8_SA(0, 0), cA, offc[0]); PG8_STAGE(PG8_SB(0, 1), cB + hstep, voffB); PG8_STAGE_A(PG8_SA(0, 1), cA, offc[1]);
        if (wr == 1) PG8_BAR;
        PG8_WAIT_V(4); PG8_BAR;
        PG8_STAGE(PG8_SB(1, 0), cB + kstep, voffB); PG8_STAGE_A(PG8_SA(1, 0), cA + kstep, offc[0]); PG8_STAGE(PG8_SB(1, 1), cB + hstep + kstep, voffB);
        PG8_WAIT_V(6); PG8_BAR;
    }
    for (;;) {
        const bool has_next = S.next(ui + 1, nxt);
        const char* nA = (has_next && !GATHER) ? (const char*)g.A + (size_t)nxt.pm * tstep : cA; const char* nB = has_next ? (const char*)g.Bt + (size_t)nxt.pn * tstep : cB;
        if constexpr (GATHER) { if (has_next) PG8_GOFF(offn, nxt); else {
#pragma unroll
            for (int h_ = 0; h_ < 2; ++h_)
#pragma unroll
                for (int i = 0; i < 2; ++i) offn[h_][i] = offc[h_][i]; } }
        for (int t = 0; t < nt; t += 2) {
            const bool last = (t == nt - 2);
            const char* a1 = cA + (size_t)(t + 1) * kstep;
            const char* a2 = last ? nA : cA + (size_t)(t + 2) * kstep; const char* b2 = last ? nB : cB + (size_t)(t + 2) * kstep;
            const char* a3 = a2 + kstep; const char* b3 = b2 + kstep;
            if (last && has_next) S.a_ready(nxt);
            if constexpr (SP2) {
            PG8_LDB(B0, 0, 0); PG8_LDB(B1, 0, 1); PG8_SCHED; PG8_LDA(At, 0, 0); PG8_STAGE_A(PG8_SA(1, 1), a1, offc[1]); if constexpr (GATHER) { if (last) { offc[0][0] = offn[0][0]; offc[0][1] = offn[0][1]; offc[1][0] = offn[1][0]; offc[1][1] = offn[1][1]; } }
            PG8_WAIT_V(8); PG8_WAIT_L(0); PG8_BAR; PG8_MMA(0, 0, At, B0); PG8_MMA(0, 1, At, B1); PG8_BAR; PG8_SCHED;
            PG8_LDA(At, 0, 1); PG8_STAGE(PG8_SB(0, 0), b2, voffB); PG8_STAGE(PG8_SB(0, 1), b2 + hstep, voffB); PG8_STAGE_A(PG8_SA(0, 0), a2, offc[0]);
            PG8_WAIT_V(8); PG8_WAIT_L(0); PG8_BAR; PG8_MMA(1, 0, At, B0); PG8_MMA(1, 1, At, B1); PG8_BAR; PG8_SCHED;
            PG8_LDB(B0, 1, 0); PG8_LDB(B1, 1, 1); PG8_SCHED; PG8_LDA(At, 1, 0); PG8_STAGE_A(PG8_SA(0, 1), a2, offc[1]);
            PG8_WAIT_V(8); PG8_WAIT_L(0); PG8_BAR; PG8_MMA(0, 0, At, B0); PG8_MMA(0, 1, At, B1); PG8_BAR; PG8_SCHED;
            PG8_LDA(At, 1, 1); PG8_STAGE(PG8_SB(1, 0), b3, voffB); PG8_STAGE(PG8_SB(1, 1), b3 + hstep, voffB); PG8_STAGE_A(PG8_SA(1, 0), a3, offc[0]);
            PG8_WAIT_V(8); PG8_WAIT_L(0); PG8_BAR; PG8_MMA(1, 0, At, B0); PG8_MMA(1, 1, At, B1); PG8_BAR; PG8_SCHED;
            } else {
            PG8_LDB(B0, 0, 0); PG8_SCHED; PG8_LDA(At, 0, 0); PG8_STAGE_A(PG8_SA(1, 1), a1, offc[1]); if constexpr (GATHER) { if (last) { offc[0][0] = offn[0][0]; offc[0][1] = offn[0][1]; offc[1][0] = offn[1][0]; offc[1][1] = offn[1][1]; } }
            PG8_WAIT_L(8); PG8_BAR; PG8_WAIT_L(0); PG8_MMA(0, 0, At, B0); PG8_BAR; PG8_SCHED;
            PG8_LDB(B1, 0, 1); PG8_STAGE(PG8_SB(0, 0), b2, voffB);
            PG8_BAR; PG8_WAIT_L(0); PG8_MMA(0, 1, At, B1); PG8_BAR;
            PG8_LDA(At, 0, 1); PG8_STAGE_A(PG8_SA(0, 0), a2, offc[0]);
            PG8_BAR; PG8_WAIT_L(0); PG8_MMA(1, 0, At, B0); PG8_BAR; PG8_SCHED;
            PG8_STAGE(PG8_SB(0, 1), b2 + hstep, voffB);
            PG8_WAIT_V(6); PG8_BAR; PG8_MMA(1, 1, At, B1); PG8_BAR;
            PG8_LDB(B0, 1, 0); PG8_SCHED; PG8_LDA(At, 1, 0); PG8_STAGE_A(PG8_SA(0, 1), a2, offc[1]);
            PG8_WAIT_L(8); PG8_BAR; PG8_WAIT_L(0); PG8_MMA(0, 0, At, B0); PG8_BAR; PG8_SCHED;
            PG8_LDB(B1, 1, 1); PG8_STAGE(PG8_SB(1, 0), b3, voffB);
            PG8_BAR; PG8_WAIT_L(0); PG8_MMA(0, 1, At, B1); PG8_BAR;
            PG8_LDA(At, 1, 1); PG8_STAGE_A(PG8_SA(1, 0), a3, offc[0]);
            PG8_BAR; PG8_WAIT_L(0); PG8_MMA(1, 0, At, B0); PG8_BAR; PG8_SCHED;
            PG8_STAGE(PG8_SB(1, 1), b3 + hstep, voffB);
            PG8_WAIT_V(6); PG8_BAR; PG8_MMA(1, 1, At, B1); PG8_BAR;
            }
        }
        if constexpr (ALIGN_EPI) { if (wr == 0) PG8_BAR; }
        if constexpr (!Epi::AFTER_DRAIN) { E(acc, cur, wr, wc, fr, fq); S.done(cur); }
        if (!has_next) break;
#pragma unroll
        for (int a = 0; a < 2; ++a)
#pragma unroll
            for (int b = 0; b < 2; ++b)
#pragma unroll
                for (int m = 0; m < 4; ++m)
#pragma unroll
                    for (int n = 0; n < 2; ++n) acc[a][b][m][n] = (f32x4){0.f, 0.f, 0.f, 0.f};
        cur = nxt; cA = nA; cB = nB; ++ui;

        if constexpr (ALIGN_EPI) { if (wr == 1) PG8_BAR; }
    }
    PG8_WAIT_V(0);
    if constexpr (!ALIGN_EPI) { if (wr == 0) PG8_BAR; }
    PG8_BAR;
    if constexpr (Epi::AFTER_DRAIN) { E.fused(acc, cur, wr, wc, fr, fq, lds, wid, lane); S.done(cur); }
#undef PG8_SA
#undef PG8_SB
#undef PG8_STAGE
#undef PG8_STAGE_A
#undef PG8_GOFF
#undef PG8_LDA
#undef PG8_LDB
#undef PG8_MMA
#undef PG8_WAIT_V
#undef PG8_WAIT_L
#undef PG8_BAR
#undef PG8_SCHED
}
}

#define LAS __attribute__((address_space(3)))
#ifndef PHASE_FN
#define PHASE_FN __device__ __forceinline__
#endif
#ifndef GEMM_SP2
#define GEMM_SP2 true
#endif
#ifndef GEMM_ALIGN
#define GEMM_ALIGN false
#endif
typedef unsigned short bf16;
typedef pg8::bf16x8 bf16x8;
typedef pg8::f32x4 f32x4;
typedef pg8::u32x4 u32x4;
typedef pg8::u32x2 u32x2;
constexpr int D = 1024, NB = 4, SEQ = 8192, CTX = 256, T = CTX + SEQ, NTOK = NB * T, DEPTH = 4;
constexpr int NWAVES = 8, NTHR = 512;
constexpr int NSLOT = 71680;
constexpr size_t MiB = 1u << 20;
constexpr size_t CTL_ZERO_BYTES = 2 * MiB;
constexpr int CW_BAR = 1024;
constexpr int CW_MOE = 8192;
constexpr size_t WS_MOD = 1 * MiB;
constexpr size_t WS_LB = 2 * MiB;
constexpr size_t WS_TOK = 2 * MiB + 65536;
constexpr size_t WS_SLOT_TOK = 3 * MiB;
constexpr size_t WS_SLOT_GATE = 3 * MiB + 524288;
constexpr size_t WS_S = 4 * MiB;
constexpr size_t WS_HY = 136 * MiB;
constexpr size_t WS_MIX = 268 * MiB;
constexpr size_t WS_END = 610 * MiB;
constexpr size_t ROWB = (size_t)NTOK * 1024 * 2;
constexpr size_t W_ML_WIN = 0, W_ML_WIN_SZ = (size_t)4352 * 1024 * 2;
constexpr size_t W_ML_WOUT = 17 * MiB;
constexpr size_t W_RW_IN = 21 * MiB;
constexpr size_t W_RW_G2 = 35 * MiB;
constexpr size_t W_RW_WOUT = 36 * MiB;
constexpr size_t W_HG_IN = 38 * MiB;
constexpr size_t W_HG_WOUT = 48 * MiB;
constexpr size_t W_EX13 = 50 * MiB;
constexpr size_t W_EX2 = 82 * MiB;
constexpr size_t W_BYTES = 98 * MiB;
constexpr int LDS_PHASE_BYTES = 131072;
constexpr int LDS_BYTES = 163840;
constexpr int MISC_OFF = LDS_BYTES - 2048;

#define VM_WAIT() asm volatile("s_waitcnt vmcnt(0)" ::: "memory")
#define LDS_WAIT() asm volatile("s_waitcnt lgkmcnt(0)" ::: "memory")
typedef float f32x2_t __attribute__((ext_vector_type(2))); typedef __bf16 bf16x2_t __attribute__((ext_vector_type(2)));
__device__ __forceinline__ unsigned pk2(float lo, float hi) { f32x2_t v = {lo, hi}; bf16x2_t b = __builtin_convertvector(v, bf16x2_t); return __builtin_bit_cast(unsigned, b); }
__device__ __forceinline__ unsigned f2bf(float f) { return pk2(f, f) & 0xffffu; }
__device__ __forceinline__ float bf2f(unsigned b) { return __builtin_bit_cast(float, b << 16); }
__device__ __forceinline__ float bflo(unsigned w) { return __builtin_bit_cast(float, w << 16); }
__device__ __forceinline__ float bfhi(unsigned w) { return __builtin_bit_cast(float, w & 0xffff0000u); }
__device__ __forceinline__ float wave_sum(float v) {
#pragma unroll
    for (int o = 1; o < 64; o <<= 1) v += __shfl_xor(v, o);
    return v; }
__device__ __forceinline__ float wave_max(float v) {
#pragma unroll
    for (int o = 1; o < 64; o <<= 1) v = fmaxf(v, __shfl_xor(v, o));
    return v; }
template <int CTRL> __device__ __forceinline__ float dpp_f(float v) { return __builtin_bit_cast(float, __builtin_amdgcn_update_dpp(0, __builtin_bit_cast(int, v), CTRL, 0xF, 0xF, false)); }
__device__ __forceinline__ float row16_sum(float v) { v += dpp_f<0xB1>(v); v += dpp_f<0x4E>(v); v += dpp_f<0x124>(v); v += dpp_f<0x128>(v); return v; }
template <int CTRL, int ROWMASK> __device__ __forceinline__ float dpp_keep(float old, float v) { return __builtin_bit_cast(float, __builtin_amdgcn_update_dpp(__builtin_bit_cast(int, old), __builtin_bit_cast(int, v), CTRL, ROWMASK, 0xF, false)); }
__device__ __forceinline__ float wave_scan_add(float v) {
    v += dpp_keep<0x111, 0xF>(0.f, v); v += dpp_keep<0x112, 0xF>(0.f, v); v += dpp_keep<0x114, 0xF>(0.f, v); v += dpp_keep<0x118, 0xF>(0.f, v);
    v += dpp_keep<0x142, 0xA>(0.f, v); v += dpp_keep<0x143, 0xC>(0.f, v); return v; }
__device__ __forceinline__ float wave_scan_max(float v) {
    v = fmaxf(v, dpp_keep<0x111, 0xF>(v, v)); v = fmaxf(v, dpp_keep<0x112, 0xF>(v, v)); v = fmaxf(v, dpp_keep<0x114, 0xF>(v, v)); v = fmaxf(v, dpp_keep<0x118, 0xF>(v, v));
    v = fmaxf(v, dpp_keep<0x142, 0xA>(v, v)); v = fmaxf(v, dpp_keep<0x143, 0xC>(v, v)); return v; }
__device__ __forceinline__ float wave_sum_dpp(float v) { v = row16_sum(v); v += dpp_keep<0x142, 0xA>(0.f, v); v += dpp_keep<0x143, 0xC>(0.f, v); return __builtin_bit_cast(float, __builtin_amdgcn_readlane(__builtin_bit_cast(int, v), 63)); }
__device__ __forceinline__ float lane63(float v) { return __builtin_bit_cast(float, __builtin_amdgcn_readlane(__builtin_bit_cast(int, v), 63)); }
template <int K> __device__ __forceinline__ f32x4 mm16(f32x4 acc, const LAS bf16* A, int lda, const LAS bf16* Bt, int ldb, int lane) {
    const int r = lane & 15, q = lane >> 4;
#pragma unroll
    for (int kk = 0; kk < K / 32; ++kk) {
        const bf16x8 a = *(const LAS bf16x8*)(A + r * lda + kk * 32 + q * 8);
        const bf16x8 b = *(const LAS bf16x8*)(Bt + r * ldb + kk * 32 + q * 8);
        acc = __builtin_amdgcn_mfma_f32_16x16x32_bf16(a, b, acc, 0, 0, 0); }
    return acc; }
typedef short s16x4 __attribute__((ext_vector_type(4)));
__device__ __forceinline__ bf16x8 tr_frag(const LAS bf16* X, int ld, int k0, int n0, int lane) {
    const int g = lane >> 4, a = (lane & 15) >> 2, p = lane & 3;
    const LAS bf16* p0 = X + (k0 + 8 * g + a) * ld + n0 + 4 * p;
    const s16x4 lo = __builtin_amdgcn_ds_read_tr16_b64_v4i16((LAS s16x4*)p0), hi = __builtin_amdgcn_ds_read_tr16_b64_v4i16((LAS s16x4*)(p0 + 4 * ld));
    return (bf16x8){lo[0], lo[1], lo[2], lo[3], hi[0], hi[1], hi[2], hi[3]}; }
__device__ __forceinline__ bf16x8 row_frag(const LAS bf16* A, int ld, int k0, int lane) { return *(const LAS bf16x8*)(A + (lane & 15) * ld + k0 + (lane >> 4) * 8); }
__device__ __forceinline__ f32x4 ldS4(const GAS unsigned char* S, size_t vi) {
    if (S_BF16) { const u32x2 w = ((const GAS u32x2*)S)[vi]; return (f32x4){bflo(w.x), bfhi(w.x), bflo(w.y), bfhi(w.y)}; }
    return ((const GAS f32x4*)S)[vi]; }
__device__ __forceinline__ void stS4(GAS unsigned char* S, size_t vi, f32x4 v) {
    if (S_BF16) { u32x2 w; w.x = pk2(v[0], v[1]); w.y = pk2(v[2], v[3]); ((GAS u32x2*)S)[vi] = w; }
    else ((GAS f32x4*)S)[vi] = v; }
__device__ __forceinline__ int seq_row(int b, int dir, int i) {
    const int tt = (i < CTX) ? (dir ? CTX - 1 - i : i) : CTX + (dir ? SEQ - 1 - (i - CTX) : (i - CTX));
    return b * T + tt; }

#define XB_TMO      128
#define XB_XCNT(j)  (256  + 64 * (j))
#define XB_XSUB(j)  (1280 + 64 * (j))
#define XB_XGEN(j)  (2304 + 64 * (j))
#define XB_TOP      3328
#define XB_TOPGEN   3392
#define XCD_BAR_WORDS 3456
#define XB_SPIN_CAP (1u << 18)

__device__ __forceinline__ unsigned xb_ld(unsigned* p)              { return __hip_atomic_load(p, __ATOMIC_RELAXED, __HIP_MEMORY_SCOPE_AGENT); }
__device__ __forceinline__ unsigned xb_add(unsigned* p, unsigned v) { return __hip_atomic_fetch_add(p, v, __ATOMIC_RELAXED, __HIP_MEMORY_SCOPE_AGENT); }
__device__ __forceinline__ unsigned xb_xcc_id() { return (unsigned)__builtin_amdgcn_s_getreg((3 << 11) | 20) & 0xFu; }
#define XB_SPIN(cond, bar) do { unsigned _sp = 0; while (cond) { __builtin_amdgcn_s_sleep(1); \
    if ((++_sp & 255u) == 0u) { if (xb_ld(&(bar)[XB_TMO])) break; if (_sp > XB_SPIN_CAP) { atomicAdd(&(bar)[XB_TMO], 1u); break; } } } } while (0)

struct XcdBarrier {
    unsigned* bar; unsigned x;
    volatile LAS unsigned* st;
};

__device__ __forceinline__ XcdBarrier xcd_barrier_post(unsigned* bar, volatile LAS unsigned* st) {
    XcdBarrier b; b.bar = bar; b.x = xb_xcc_id(); b.st = st;
    if (threadIdx.x == 0) (void)xb_add(&bar[XB_XCNT(b.x)], 1u);
    return b;
}
__device__ __forceinline__ void xcd_barrier_complete(unsigned* bar, unsigned x, unsigned& nloc, unsigned& nx) {
    const unsigned G = gridDim.x * gridDim.y * gridDim.z;
    unsigned sum, cnt, mine, sp = 0u;
    for (;;) {
        sum = 0u; cnt = 0u; mine = 0u;
#pragma unroll
        for (unsigned j = 0; j < 16; ++j) { const unsigned c = xb_ld(&bar[XB_XCNT(j)]); sum += c; cnt += (c > 0u) ? 1u : 0u; mine = (j == x) ? c : mine; }
        if (sum == G) break;
        __builtin_amdgcn_s_sleep(1);
        if ((++sp & 255u) == 0u) { if (xb_ld(&bar[XB_TMO])) break; if (sp > XB_SPIN_CAP) { atomicAdd(&bar[XB_TMO], 1u); break; } }
    }
    nloc = mine > 0u ? mine : 1u; nx = cnt > 0u ? cnt : 1u;
}

__device__ __forceinline__ void xcd_barrier(const XcdBarrier& b) {
    asm volatile("s_waitcnt vmcnt(0)" ::: "memory");
    __syncthreads();
    if (threadIdx.x == 0) {
        unsigned* bar = b.bar;
        __builtin_amdgcn_s_waitcnt(0);
        unsigned nloc = b.st[0], nx = b.st[1];
        if (nloc == 0u) { xcd_barrier_complete(bar, b.x, nloc, nx); b.st[0] = nloc; b.st[1] = nx; }
        const unsigned old = xb_add(&bar[XB_XSUB(b.x)], 1u);
        const unsigned gen = old / nloc;
        if (old + 1u == (gen + 1u) * nloc) {
            __builtin_amdgcn_fence(__ATOMIC_RELEASE, "agent");
            asm volatile("s_waitcnt vmcnt(0)" ::: "memory");
            const unsigned og = xb_add(&bar[XB_TOP], 1u);
            const unsigned tg = og / nx;
            if (og + 1u == (tg + 1u) * nx) xb_add(&bar[XB_TOPGEN], 1u);
            else XB_SPIN(xb_ld(&bar[XB_TOPGEN]) == tg, bar);
            __builtin_amdgcn_fence(__ATOMIC_ACQUIRE, "agent");
            xb_add(&bar[XB_XGEN(b.x)], 1u);
            asm volatile("s_waitcnt vmcnt(0)" ::: "memory");
        } else {
            XB_SPIN(xb_ld(&bar[XB_XGEN(b.x)]) == gen, bar);
            __builtin_amdgcn_fence(__ATOMIC_ACQUIRE, "agent");
            asm volatile("s_waitcnt vmcnt(0)" ::: "memory");
        }
    }
    __syncthreads();
}

struct Args { const float* in[42]; float* out; unsigned char* ws; unsigned char* wts; int ph_lo, ph_hi; };
struct Frame {
    LAS unsigned char* lds; GAS float* out; GAS unsigned char* ws; GAS unsigned char* W;
    int tid, lane, wave, bid, G;
};
constexpr int PTAB_OFF = MISC_OFF + 512;
__device__ __forceinline__ const GAS float* ldptr(const Frame& F, int i) { const unsigned long long v = ((const LAS unsigned long long*)(F.lds + PTAB_OFF))[i];
    const unsigned lo = __builtin_amdgcn_readfirstlane((unsigned)v), hi = __builtin_amdgcn_readfirstlane((unsigned)(v >> 32)); return (const GAS float*)(((unsigned long long)hi << 32) | lo); }
#define INP(i) ldptr(F, (i))
__device__ __forceinline__ Frame fresh(const Frame& F0) { Frame F = F0; int t; asm volatile("v_mbcnt_lo_u32_b32 %0, -1, 0\n\tv_mbcnt_hi_u32_b32 %0, -1, %0\n\tv_lshl_add_u32 %0, %1, 6, %0" : "=&v"(t) : "s"(F0.wave));     F.tid = t; F.lane = t & 63; F.wave = __builtin_amdgcn_readfirstlane(t >> 6);
    asm volatile("" : "+s"(F.bid), "+s"(F.G), "+s"(F.ws), "+s"(F.W), "+s"(F.out)); return F; }
enum { IN_X = 0, IN_C, IN_CTX, IN_CCTX, IN_ADAW, IN_ADAB, IN_NMIX, IN_NFFN, IN_NOUT, IN_ML_WIN, IN_ML_WGATE, IN_ML_BGATE, IN_ML_CONV, IN_ML_HEADG, IN_ML_WOUT,
       IN_RW_MU, IN_RW_WRKV, IN_RW_W0, IN_RW_W1, IN_RW_W2, IN_RW_A0, IN_RW_A1, IN_RW_A2, IN_RW_G1, IN_RW_G2, IN_RW_KK, IN_RW_KA, IN_RW_RK, IN_RW_LNW, IN_RW_LNB, IN_RW_WOUT,
       IN_HG_WIN, IN_HG_WF, IN_HG_BF, IN_HG_LB, IN_HG_HEADG, IN_HG_WOUT, IN_ROUTER_W, IN_ROUTER_B, IN_EX_W1, IN_EX_W3, IN_EX_W2 };

template <int MAP> __device__ __forceinline__ int rowmap(int n) { return MAP == 0 ? n : (MAP == 1 ? 8 * (n >> 2) + (n & 3) : 8 * (n >> 2) + 4 + (n & 3)); }
template <int MAP> __device__ __forceinline__ void tr_item(const GAS float* W, int ldw, int nblk, GAS bf16* WT, int ldd, int row_off, int k_off, const GAS float* kscale, LAS float* scr, int item, int lane) {
    const int kb = item / nblk, nb = item - kb * nblk, k0 = 64 * kb, n0 = 32 * nb;
#pragma unroll 8
    for (int i = 0; i < 32; ++i) { const int kk = 2 * i + (lane >> 5); float v = W[(size_t)(k0 + kk) * ldw + n0 + (lane & 31)]; if (kscale) v *= kscale[k0 + kk]; scr[kk * 33 + (lane & 31)] = v; }
    LDS_WAIT(); asm volatile("" ::: "memory");
    const int c = lane & 7;
#pragma unroll
    for (int j = 0; j < 4; ++j) { const int n = (lane >> 3) + 8 * j; const LAS float* s = scr + (8 * c) * 33 + n;
        u32x4 o; o.x = pk2(s[0 * 33], s[1 * 33]); o.y = pk2(s[2 * 33], s[3 * 33]); o.z = pk2(s[4 * 33], s[5 * 33]); o.w = pk2(s[6 * 33], s[7 * 33]);
        *(GAS u32x4*)(WT + (size_t)(row_off + rowmap<MAP>(n0 + n)) * ldd + k_off + k0 + 8 * c) = o; }
    LDS_WAIT(); asm volatile("" ::: "memory");
}
#define TRJOB(MAP, cnt, ...) if (r < (cnt)) { tr_item<MAP>(__VA_ARGS__, scr, r, F.lane); continue; } r -= (cnt);

PHASE_FN void pre_phase(Frame F) {
    LAS float* scr = (LAS float*)(F.lds + F.wave * 16384);
    const int gw = F.bid * NWAVES + F.wave, NGW = F.G * NWAVES;
    const size_t gt = (size_t)F.bid * NTHR + F.tid, NGT = (size_t)F.G * NTHR;
    GAS bf16* W = (GAS bf16*)F.W;
    constexpr int NITEMS = 2 * 2048 + 2 * 512 + 6 * 512 + 4 * 32 + 4 * 32 + 2 * 64 + 64 + 512 + 1536 + 2 * 512 + 512;
    for (int it = gw; it < NITEMS; it += NGW) {
        int r = it;
        TRJOB(0, 2048, INP(IN_ML_WIN), 4096, 128, (GAS bf16*)(F.W + W_ML_WIN), 1024, 0, 0, nullptr)
        TRJOB(0, 2048, INP(IN_ML_WIN) + (size_t)1024 * 4096, 4096, 128, (GAS bf16*)(F.W + W_ML_WIN + W_ML_WIN_SZ), 1024, 0, 0, nullptr)
        TRJOB(0, 512, INP(IN_ML_WOUT), 1024, 32, (GAS bf16*)(F.W + W_ML_WOUT), 1024, 0, 0, nullptr)
        TRJOB(0, 512, INP(IN_ML_WOUT) + (size_t)1024 * 1024, 1024, 32, (GAS bf16*)(F.W + W_ML_WOUT + 2 * MiB), 1024, 0, 0, nullptr)
        GAS bf16* RWIN = (GAS bf16*)(F.W + W_RW_IN); const GAS float* mu = INP(IN_RW_MU);
        if (r < 6 * 512) { const int idx = r / 1024, ps = (r / 512) & 1, rr = r & 511;
            tr_item<0>(INP(IN_RW_WRKV) + (size_t)idx * 1024 * 1024, 1024, 32, RWIN, 2048, idx * 1024, ps * 1024, ps ? mu + idx * 1024 : nullptr, scr, rr, F.lane); continue; } r -= 6 * 512;
        if (r < 4 * 32) { const int dir = r / 64, ps = (r / 32) & 1, rr = r & 31;
            tr_item<0>(INP(IN_RW_W1) + (size_t)dir * 1024 * 64, 64, 2, RWIN, 2048, 3072 + dir * 64, ps * 1024, ps ? mu + 3 * 1024 : nullptr, scr, rr, F.lane); continue; } r -= 4 * 32;
        if (r < 4 * 32) { const int dir = r / 64, ps = (r / 32) & 1, rr = r & 31;
            tr_item<0>(INP(IN_RW_A1) + (size_t)dir * 1024 * 64, 64, 2, RWIN, 2048, 3200 + dir * 64, ps * 1024, ps ? mu + 4 * 1024 : nullptr, scr, rr, F.lane); continue; } r -= 4 * 32;
        if (r < 2 * 64) { const int ps = r / 64, rr = r & 63;
            tr_item<0>(INP(IN_RW_G1), 128, 4, RWIN, 2048, 3328, ps * 1024, ps ? mu + 5 * 1024 : nullptr, scr, rr, F.lane); continue; } r -= 2 * 64;
        TRJOB(0, 64, INP(IN_RW_G2), 1024, 32, (GAS bf16*)(F.W + W_RW_G2), 256, 0, 0, nullptr)
        TRJOB(0, 512, INP(IN_RW_WOUT), 1024, 32, (GAS bf16*)(F.W + W_RW_WOUT), 1024, 0, 0, nullptr)
        TRJOB(0, 1536, INP(IN_HG_WIN), 3072, 96, (GAS bf16*)(F.W + W_HG_IN), 1024, 0, 0, nullptr)
        TRJOB(0, 512, INP(IN_HG_WF), 1024, 32, (GAS bf16*)(F.W + W_HG_IN), 1024, 3072, 0, nullptr)
        TRJOB(0, 512, INP(IN_HG_WF) + (size_t)1024 * 1024, 1024, 32, (GAS bf16*)(F.W + W_HG_IN), 1024, 4096, 0, nullptr)
        TRJOB(0, 512, INP(IN_HG_WOUT), 1024, 32, (GAS bf16*)(F.W + W_HG_WOUT), 1024, 0, 0, nullptr)
    }
    for (size_t i = gt; i < (size_t)2 * 256 * 1024; i += NGT) { const int j = (int)(i >> 18), rr = (int)((i >> 10) & 255), k = (int)(i & 1023);
        float v = 0.f; if (rr < 32) { const int dir = rr >> 4, g = rr & 15; v = INP(IN_ML_WGATE)[((size_t)(j * 2 + dir) * 1024 + k) * 16 + g]; }
        ((GAS bf16*)(F.W + W_ML_WIN + j * W_ML_WIN_SZ))[(size_t)(4096 + rr) * 1024 + k] = (bf16)f2bf(v); }
    for (size_t i = gt; i < (size_t)128 * 2048; i += NGT) ((GAS bf16*)(F.W + W_RW_IN))[(size_t)3456 * 2048 + i] = 0;
    for (size_t i = gt; i < (size_t)1024 * 128; i += NGT) ((GAS bf16*)(F.W + W_RW_G2))[(i >> 7) * 256 + 128 + (i & 127)] = 0;
    if (F.bid == 0) for (int c = F.tid; c < 1024; c += NTHR) { const GAS float* lg = INP(IN_HG_LB) + c; const float l0 = lg[0], l1 = lg[1024], l2 = lg[2048], l3 = lg[3072];
        const float mx = fmaxf(fmaxf(l0, l1), fmaxf(l2, l3)); const float e0 = __expf(l0 - mx), e1 = __expf(l1 - mx), e2 = __expf(l2 - mx), e3 = __expf(l3 - mx);
        ((GAS float*)(F.ws + WS_LB))[c] = (e1 + e2) / (e0 + e1 + e2 + e3); }
    { GAS unsigned char* S4 = F.ws + WS_S;
      for (size_t i = gt; i < (size_t)NTOK * 256; i += NGT) { const int m = (int)(i >> 8), c4 = (int)(i & 255); const int b = m / T, t = m - b * T;
          const GAS float* src = (t < CTX) ? INP(IN_CTX) + ((size_t)(b * CTX + t)) * 1024 : INP(IN_X) + ((size_t)(b * SEQ + t - CTX)) * 1024;
          stS4(S4, i, ((const GAS f32x4*)src)[c4]); } }
    { LAS float* sc = (LAS float*)(F.lds + 8448); GAS float* MODP = (GAS float*)(F.ws + WS_MIX);
      for (int it = F.bid; it < 768; it += F.G) { const int i = it / 192, rem = it - i * 192, kc = rem / 12, jb = rem - kc * 12;
          __syncthreads();
          if (F.tid < 320) { const int seg = F.tid >> 6, kk = F.tid & 63; const float cv = seg == 0 ? INP(IN_CCTX)[kc * 64 + kk] : INP(IN_C)[(seg - 1) * 1024 + kc * 64 + kk]; sc[F.tid] = silu_f(cv); }
          __syncthreads();
          const int j = jb * 512 + F.tid; const GAS float* wp = INP(IN_ADAW) + ((size_t)i * 1024 + kc * 64) * 6144 + j;
          float a0 = 0.f, a1 = 0.f, a2 = 0.f, a3 = 0.f, a4 = 0.f;
#pragma unroll 8
          for (int kk = 0; kk < 64; ++kk) { const float w = wp[(size_t)kk * 6144]; a0 += sc[kk] * w; a1 += sc[64 + kk] * w; a2 += sc[128 + kk] * w; a3 += sc[192 + kk] * w; a4 += sc[256 + kk] * w; }
          GAS float* mp = MODP + ((size_t)kc * 4 + i) * 5 * 6144 + j;
          mp[0] = a0; mp[6144] = a1; mp[2 * 6144] = a2; mp[3 * 6144] = a3; mp[4 * 6144] = a4; } }
}
PHASE_FN void modsum_phase(Frame F) {
    const GAS float* MODP = (const GAS float*)(F.ws + WS_MIX); GAS float* MOD = (GAS float*)(F.ws + WS_MOD);
    for (int idx = F.bid * NTHR + F.tid; idx < 4 * 5 * 6144; idx += F.G * NTHR) { const int i = idx / (5 * 6144), j = idx % 6144;
        float a = INP(IN_ADAB)[i * 6144 + j];
#pragma unroll
        for (int kc = 0; kc < 16; ++kc) a += MODP[(size_t)kc * 4 * 5 * 6144 + idx];
        MOD[idx] = a; }
}
struct ExwItem { const GAS float* src; GAS bf16* dst; int ldw, ldd, map; };
__device__ __forceinline__ ExwItem exw_item(const Frame& F, const GAS float* w1, const GAS float* w3, const GAS float* w2, int it) {
    const int which = it >> 12, e = (it >> 8) & 15, rr = it & 255; ExwItem x;
    if (which < 2) { const int kb = rr >> 4, nb = rr & 15; x.src = (which ? w3 : w1) + (size_t)e * 1024 * 512 + (size_t)(64 * kb) * 512 + 32 * nb; x.ldw = 512; x.ldd = 1024; x.map = which + 1;
        x.dst = (GAS bf16*)(F.W + W_EX13) + (size_t)(e * 1024 + 2 * (32 * nb)) * 1024 + 64 * kb; }
    else { const int kb = rr >> 5, nb = rr & 31; x.src = w2 + (size_t)e * 512 * 1024 + (size_t)(64 * kb) * 1024 + 32 * nb; x.ldw = 1024; x.ldd = 512; x.map = 0;
        x.dst = (GAS bf16*)(F.W + W_EX2) + (size_t)(e * 1024 + 32 * nb) * 512 + 64 * kb; }
    return x; }
PHASE_FN void expert_weights(Frame F, int L) {
    LAS float* scr = (LAS float*)(F.lds + F.wave * 16384);
    const int gw = F.bid * NWAVES + F.wave, NGW = F.G * NWAVES, lane = F.lane;
    const GAS float* w1 = INP(IN_EX_W1) + (size_t)L * 16 * 1024 * 512; const GAS float* w3 = INP(IN_EX_W3) + (size_t)L * 16 * 1024 * 512; const GAS float* w2 = INP(IN_EX_W2) + (size_t)L * 16 * 512 * 1024;
    const int lk = lane >> 3, ln = (lane & 7) * 4;
    f32x4 v[8]; int it = gw;
    if (it < 3 * 4096) { const ExwItem x = exw_item(F, w1, w3, w2, it);
#pragma unroll
        for (int i = 0; i < 8; ++i) v[i] = *(const GAS f32x4*)(x.src + (size_t)(lk + 8 * i) * x.ldw + ln); }
    for (; it < 3 * 4096; it += NGW) {
        const ExwItem x = exw_item(F, w1, w3, w2, it);
#pragma unroll
        for (int i = 0; i < 8; ++i) { LAS float* d = scr + (lk + 8 * i) * 33 + ln; d[0] = v[i][0]; d[1] = v[i][1]; d[2] = v[i][2]; d[3] = v[i][3]; }
        if (it + NGW < 3 * 4096) { const ExwItem y = exw_item(F, w1, w3, w2, it + NGW);
#pragma unroll
            for (int i = 0; i < 8; ++i) v[i] = *(const GAS f32x4*)(y.src + (size_t)(lk + 8 * i) * y.ldw + ln); }
        LDS_WAIT(); asm volatile("" ::: "memory");
        const int c = lane & 7;
#pragma unroll
        for (int j = 0; j < 4; ++j) { const int n = (lane >> 3) + 8 * j; const LAS float* s_ = scr + (8 * c) * 33 + n;
            u32x4 o; o.x = pk2(s_[0 * 33], s_[1 * 33]); o.y = pk2(s_[2 * 33], s_[3 * 33]); o.z = pk2(s_[4 * 33], s_[5 * 33]); o.w = pk2(s_[6 * 33], s_[7 * 33]);
            const int drow = x.map == 0 ? n : 2 * (n & ~3) + (n & 3) + (x.map == 2 ? 4 : 0);
            *(GAS u32x4*)(x.dst + (size_t)drow * x.ldd + 8 * c) = o; }
        LDS_WAIT(); asm volatile("" ::: "memory");
    }
}

template <int MODE, int PRB = 0> PHASE_FN void norm_phase(Frame F, int L, bool add_moe, int ldh) {
    GAS unsigned char* S = F.ws + WS_S; GAS bf16* H = (GAS bf16*)(F.ws + WS_HY); const GAS bf16* YM = (const GAS bf16*)(F.ws + WS_MIX + 210 * MiB);
    const GAS float* MOD = (const GAS float*)(F.ws + WS_MOD);
    const int gw = F.bid * NWAVES + F.wave, NGW = F.G * NWAVES, lane = F.lane;
    LAS float* rwl = (LAS float*)F.lds;
    LAS int* cntl = (LAS int*)(F.lds + 65536);
    if (MODE == 1) {
        for (int i = F.tid; i < 16384; i += NTHR) { const int c = i >> 4, e = i & 15; rwl[e * 1024 + c] = INP(IN_ROUTER_W)[i]; }
        if (F.tid < 16) cntl[F.tid] = 0;
        __syncthreads();
    }
    const GAS float* gnp = MODE == 0 ? INP(IN_NMIX) + L * 1024 : (MODE == 1 ? INP(IN_NFFN) + L * 1024 : INP(IN_NOUT));
    for (int m = gw; m < NTOK; m += NGW) {
        const int b = m / T, t = m - b * T, seg = t < CTX ? 0 : 1 + b;
        if (MODE == 2 && t < CTX) continue;
        f32x4 v[4]; const size_t sp = (size_t)m * 256 + lane;
#pragma unroll
        for (int j = 0; j < 4; ++j) v[j] = ldS4(S, sp + 64 * j);
        if (add_moe) {
            const GAS float* gp = MOD + ((size_t)((MODE == 2 ? 3 : L - 1) * 5 + seg)) * 6144 + 5 * 1024;
            const GAS u32x2* ya = (const GAS u32x2*)(YM + (size_t)(2 * m) * 1024) + lane; const GAS u32x2* yb = ya + 256;
#pragma unroll
            for (int j = 0; j < 4; ++j) { const u32x2 a = ya[64 * j], bq = yb[64 * j]; const f32x4 g = ((const GAS f32x4*)gp)[lane + 64 * j];
                v[j][0] += g[0] * (bflo(a.x) + bflo(bq.x)); v[j][1] += g[1] * (bfhi(a.x) + bfhi(bq.x)); v[j][2] += g[2] * (bflo(a.y) + bflo(bq.y)); v[j][3] += g[3] * (bfhi(a.y) + bfhi(bq.y)); }
            if (MODE != 2 && !PRB) {
#pragma unroll
                for (int j = 0; j < 4; ++j) stS4(S, sp + 64 * j, v[j]); }
        }
        float ss = 0.f;
#pragma unroll
        for (int j = 0; j < 4; ++j) ss += (v[j][0] * v[j][0] + v[j][1] * v[j][1]) + (v[j][2] * v[j][2] + v[j][3] * v[j][3]);
        const float rinv = __builtin_amdgcn_rsqf(wave_sum_dpp(ss) * (1.0f / 1024.0f) + 1e-6f);
        if (MODE == 2) { GAS f32x4* op = (GAS f32x4*)(F.out + ((size_t)(b * SEQ + t - CTX)) * 1024) + lane;
#pragma unroll
            for (int j = 0; j < 4; ++j) { const f32x4 g = ((const GAS f32x4*)gnp)[lane + 64 * j]; op[64 * j] = v[j] * rinv * g; }
            continue; }
        const GAS float* mp = MOD + ((size_t)(L * 5 + seg)) * 6144 + (MODE == 0 ? 0 : 3 * 1024);
        f32x4 h[4];
#pragma unroll
        for (int j = 0; j < 4; ++j) { const f32x4 g = ((const GAS f32x4*)gnp)[lane + 64 * j], sh = ((const GAS f32x4*)mp)[lane + 64 * j], sc = ((const GAS f32x4*)(mp + 1024))[lane + 64 * j];
            h[j] = v[j] * rinv * g * (sc + 1.0f) + sh;
            u32x2 o; o.x = pk2(h[j][0], h[j][1]); o.y = pk2(h[j][2], h[j][3]); *((GAS u32x2*)(H + (size_t)m * ldh) + lane + 64 * j) = o; }
        if (MODE == 1) {
            float lg[16];
#pragma unroll
            for (int e = 0; e < 16; ++e) { float a = 0.f;
#pragma unroll
                for (int j = 0; j < 4; ++j) { const f32x4 w = *(const LAS f32x4*)(rwl + e * 1024 + 256 * j + 4 * lane); a += (h[j][0] * w[0] + h[j][1] * w[1]) + (h[j][2] * w[2] + h[j][3] * w[3]); }
                lg[e] = wave_sum_dpp(a); }
            float aff[16], sel[16];
#pragma unroll
            for (int e = 0; e < 16; ++e) { aff[e] = sigmoid_f(lg[e]); sel[e] = aff[e] + INP(IN_ROUTER_B)[e]; }
            float best = -3.0e38f; int bg = 0; float s0 = 0.f, s1 = 0.f, s2 = 0.f, s3 = 0.f, a0 = 0.f, a1 = 0.f, a2 = 0.f, a3 = 0.f;
#pragma unroll
            for (int g = 0; g < 4; ++g) { const float x0 = sel[4 * g], x1 = sel[4 * g + 1], x2 = sel[4 * g + 2], x3 = sel[4 * g + 3];
                const float t1 = fmaxf(x0, x1), t2 = fminf(x0, x1), u1 = fmaxf(x2, x3), u2 = fminf(x2, x3);
                const float sum = fmaxf(t1, u1) + fmaxf(fminf(t1, u1), fmaxf(t2, u2));
                const bool bt = sum > best; best = bt ? sum : best; bg = bt ? g : bg;
                s0 = bt ? x0 : s0; s1 = bt ? x1 : s1; s2 = bt ? x2 : s2; s3 = bt ? x3 : s3;
                a0 = bt ? aff[4 * g] : a0; a1 = bt ? aff[4 * g + 1] : a1; a2 = bt ? aff[4 * g + 2] : a2; a3 = bt ? aff[4 * g + 3] : a3; }
            int i1 = 0; float m1 = s0; if (s1 > m1) { m1 = s1; i1 = 1; } if (s2 > m1) { m1 = s2; i1 = 2; } if (s3 > m1) { m1 = s3; i1 = 3; }
            int i2 = -1; float m2 = -3.0e38f;
            if (i1 != 0 && s0 > m2) { m2 = s0; i2 = 0; } if (i1 != 1 && s1 > m2) { m2 = s1; i2 = 1; } if (i1 != 2 && s2 > m2) { m2 = s2; i2 = 2; } if (i1 != 3 && s3 > m2) { m2 = s3; i2 = 3; }
            const float c1 = i1 == 0 ? a0 : (i1 == 1 ? a1 : (i1 == 2 ? a2 : a3)), c2 = i2 == 0 ? a0 : (i2 == 1 ? a1 : (i2 == 2 ? a2 : a3));
            const float inv = 1.0f / (c1 + c2);
            if (lane == 0) { const int e1 = bg * 4 + i1, e2 = bg * 4 + i2;
                u32x4 tk; tk.x = (unsigned)e1; tk.y = (unsigned)e2; tk.z = __float_as_uint(c1 * inv); tk.w = __float_as_uint(c2 * inv); ((GAS u32x4*)(F.ws + WS_TOK))[m] = tk;
                __hip_atomic_fetch_add(cntl + e1, 1, __ATOMIC_RELAXED, __HIP_MEMORY_SCOPE_WORKGROUP); __hip_atomic_fetch_add(cntl + e2, 1, __ATOMIC_RELAXED, __HIP_MEMORY_SCOPE_WORKGROUP); }
        }
    }
    if (MODE == 1) { __syncthreads(); if (F.tid < 16) __hip_atomic_fetch_add((GAS unsigned*)F.ws + CW_MOE + L * 2048 + (PRB ? 32 : 0) + 64 * F.tid, (unsigned)cntl[F.tid], __ATOMIC_RELAXED, __HIP_MEMORY_SCOPE_AGENT); }
}

template <int PRB = 0> PHASE_FN void route_phase(Frame F, int L) {
    const GAS unsigned char* S = F.ws + WS_S; GAS bf16* H = (GAS bf16*)(F.ws + WS_HY); const GAS float* MOD = (const GAS float*)(F.ws + WS_MOD);
    const int gw = F.bid * NWAVES + F.wave, NGW = F.G * NWAVES, lane = F.lane, hl = lane & 31, hi = lane >> 5;
    LAS float* rwl = (LAS float*)F.lds;
    LAS int* cntl = (LAS int*)(F.lds + 65536);
    for (int i = F.tid; i < 16384; i += NTHR) { const int c = i >> 4, e = i & 15; rwl[e * 1024 + c] = INP(IN_ROUTER_W)[i]; }
    if (F.tid < 16) cntl[F.tid] = 0;
    __syncthreads();
    const GAS float* gnp = INP(IN_NFFN) + L * 1024; const GAS float* rbp = INP(IN_ROUTER_B);
    constexpr int NP = NTOK / 2; const int pq = NP / NGW, pr = NP - pq * NGW; const int p0 = gw * pq + (gw < pr ? gw : pr), pn = pq + (gw < pr ? 1 : 0);
    f32x4 vn[8], Av[8], Bv[8]; int curseg = -1;
    if (pn > 0) { const size_t sp0 = (size_t)(2 * p0 + hi) * 256 + hl;
#pragma unroll
        for (int j = 0; j < 8; ++j) vn[j] = ldS4(S, sp0 + 32 * j); }
    for (int mp = p0; mp < p0 + pn; ++mp) {
        const int m = 2 * mp + hi; const int b = m / T, t = m - b * T, seg = t < CTX ? 0 : 1 + b;
        f32x4 v[8];
        float ss = 0.f;
#pragma unroll
        for (int j = 0; j < 8; ++j) { v[j] = vn[j]; ss += (v[j][0] * v[j][0] + v[j][1] * v[j][1]) + (v[j][2] * v[j][2] + v[j][3] * v[j][3]); }
        if (mp + 1 < p0 + pn) { const size_t spn = (size_t)(2 * (mp + 1) + hi) * 256 + hl;
#pragma unroll
            for (int j = 0; j < 8; ++j) vn[j] = ldS4(S, spn + 32 * j); }
        if (__builtin_amdgcn_readfirstlane(seg) != curseg) { curseg = __builtin_amdgcn_readfirstlane(seg); const GAS float* mpv = MOD + ((size_t)(L * 5 + curseg)) * 6144 + 3 * 1024;
#pragma unroll
            for (int j = 0; j < 8; ++j) { const f32x4 g = ((const GAS f32x4*)gnp)[hl + 32 * j], sh = ((const GAS f32x4*)mpv)[hl + 32 * j], scl = ((const GAS f32x4*)(mpv + 1024))[hl + 32 * j]; Av[j] = g * (scl + 1.0f); Bv[j] = sh; } }
        ss = row16_sum(ss); ss += dpp_keep<0x142, 0xA>(0.f, ss);
        { const float s0 = __builtin_bit_cast(float, __builtin_amdgcn_readlane(__builtin_bit_cast(int, ss), 31)), s1 = __builtin_bit_cast(float, __builtin_amdgcn_readlane(__builtin_bit_cast(int, ss), 63)); ss = hi ? s1 : s0; }
        const float rinv = __builtin_amdgcn_rsqf(ss * (1.0f / 1024.0f) + 1e-6f);
#pragma unroll
        for (int j = 0; j < 8; ++j) { v[j] = v[j] * rinv * Av[j] + Bv[j];
            u32x2 o; o.x = pk2(v[j][0], v[j][1]); o.y = pk2(v[j][2], v[j][3]); *((GAS u32x2*)(H + (size_t)m * 1024) + hl + 32 * j) = o; }
        float lg[16];
#pragma unroll
        for (int e = 0; e < 16; ++e) { float a = 0.f, a2 = 0.f;
#pragma unroll
            for (int j = 0; j < 8; ++j) { const f32x4 w = *(const LAS f32x4*)(rwl + e * 1024 + 128 * j + 4 * hl); a = fmaf(v[j][0], w[0], a); a2 = fmaf(v[j][1], w[1], a2); a = fmaf(v[j][2], w[2], a); a2 = fmaf(v[j][3], w[3], a2); }
            a += a2; a = row16_sum(a); a += dpp_keep<0x142, 0xA>(0.f, a);
            const float a0 = __builtin_bit_cast(float, __builtin_amdgcn_readlane(__builtin_bit_cast(int, a), 31)), a1 = __builtin_bit_cast(float, __builtin_amdgcn_readlane(__builtin_bit_cast(int, a), 63));
            lg[e] = hi ? a1 : a0; }
        float aff[16], sel[16];
#pragma unroll
        for (int e = 0; e < 16; ++e) { aff[e] = sigmoid_f(lg[e]); sel[e] = aff[e] + rbp[e]; }
        float best = -3.0e38f; int bg = 0; float s0 = 0.f, s1 = 0.f, s2 = 0.f, s3 = 0.f, a0 = 0.f, a1 = 0.f, a2 = 0.f, a3 = 0.f;
#pragma unroll
        for (int g = 0; g < 4; ++g) { const float x0 = sel[4 * g], x1 = sel[4 * g + 1], x2 = sel[4 * g + 2], x3 = sel[4 * g + 3];
            const float t1 = fmaxf(x0, x1), t2 = fminf(x0, x1), u1 = fmaxf(x2, x3), u2 = fminf(x2, x3);
            const float sum = fmaxf(t1, u1) + fmaxf(fminf(t1, u1), fmaxf(t2, u2));
            const bool bt = sum > best; best = bt ? sum : best; bg = bt ? g : bg;
            s0 = bt ? x0 : s0; s1 = bt ? x1 : s1; s2 = bt ? x2 : s2; s3 = bt ? x3 : s3;
            a0 = bt ? aff[4 * g] : a0; a1 = bt ? aff[4 * g + 1] : a1; a2 = bt ? aff[4 * g + 2] : a2; a3 = bt ? aff[4 * g + 3] : a3; }
        int i1 = 0; float m1 = s0; if (s1 > m1) { m1 = s1; i1 = 1; } if (s2 > m1) { m1 = s2; i1 = 2; } if (s3 > m1) { m1 = s3; i1 = 3; }
        int i2 = -1; float m2 = -3.0e38f;
        if (i1 != 0 && s0 > m2) { m2 = s0; i2 = 0; } if (i1 != 1 && s1 > m2) { m2 = s1; i2 = 1; } if (i1 != 2 && s2 > m2) { m2 = s2; i2 = 2; } if (i1 != 3 && s3 > m2) { m2 = s3; i2 = 3; }
        const float c1 = i1 == 0 ? a0 : (i1 == 1 ? a1 : (i1 == 2 ? a2 : a3)), c2 = i2 == 0 ? a0 : (i2 == 1 ? a1 : (i2 == 2 ? a2 : a3));
        const float inv = __builtin_amdgcn_rcpf(c1 + c2);
        if (hl == 0) { const int e1 = bg * 4 + i1, e2 = bg * 4 + i2;
            u32x4 tk; tk.x = (unsigned)e1; tk.y = (unsigned)e2; tk.z = __float_as_uint(c1 * inv); tk.w = __float_as_uint(c2 * inv); ((GAS u32x4*)(F.ws + WS_TOK))[m] = tk;
            __hip_atomic_fetch_add(cntl + e1, 1, __ATOMIC_RELAXED, __HIP_MEMORY_SCOPE_WORKGROUP); __hip_atomic_fetch_add(cntl + e2, 1, __ATOMIC_RELAXED, __HIP_MEMORY_SCOPE_WORKGROUP); }
    }
    __syncthreads();
    if (F.tid < 16) __hip_atomic_fetch_add((GAS unsigned*)F.ws + CW_MOE + L * 2048 + (PRB ? 32 : 0) + 64 * F.tid, (unsigned)cntl[F.tid], __ATOMIC_RELAXED, __HIP_MEMORY_SCOPE_AGENT);
}

__device__ __forceinline__ float qsum4r(float x) { float a = x, b = x; asm volatile("s_nop 1\n\tv_permlane16_swap_b32 %0, %1\n\ts_nop 1" : "+v"(a), "+v"(b)); const float y = a + b; float c = y, d = y; asm volatile("s_nop 1\n\tv_permlane32_swap_b32 %0, %1\n\ts_nop 1" : "+v"(c), "+v"(d)); return c + d; }
template <int PRB = 0> PHASE_FN void route2_phase(Frame F, int L) {
    const int nb = NTOK / F.G + (F.bid < NTOK % F.G ? 1 : 0), R0 = F.bid * (NTOK / F.G) + (F.bid < NTOK % F.G ? F.bid : NTOK % F.G);
    if (!S_BF16 || nb > 256) { route_phase<PRB>(F, L); return; }
    const GAS unsigned char* S = F.ws + WS_S; GAS bf16* H = (GAS bf16*)(F.ws + WS_HY); const GAS float* MOD = (const GAS float*)(F.ws + WS_MOD);
    constexpr int WP = 1032;
    LAS bf16* WHi = (LAS bf16*)F.lds; LAS bf16* WLo = WHi + 16 * WP;
    LAS float* MA = (LAS float*)(F.lds + 66048);
    LAS float* LG = (LAS float*)(F.lds + 82432);
    LAS int* cntl = (LAS int*)(F.lds + 90624);
    const int tid = F.tid, lane = F.lane, w = F.wave, r = lane & 15, q = lane >> 4;
    const int bF = R0 / T, tF = R0 - bF * T, sF = tF < CTX ? 0 : 1 + bF, bL = (R0 + nb - 1) / T, tL = (R0 + nb - 1) - bL * T, sL = tL < CTX ? 0 : 1 + bL;
    const GAS float* gnp = INP(IN_NFFN) + L * 1024; const GAS float* rbp = INP(IN_ROUTER_B);
    for (int c = tid; c < 1024; c += NTHR) { const GAS f32x4* src = (const GAS f32x4*)(INP(IN_ROUTER_W) + c * 16);
#pragma unroll
        for (int e4 = 0; e4 < 4; ++e4) { const f32x4 v = src[e4];
#pragma unroll
            for (int j = 0; j < 4; ++j) { const unsigned hi = f2bf(v[j]); WHi[(4 * e4 + j) * WP + c] = (bf16)hi; WLo[(4 * e4 + j) * WP + c] = (bf16)f2bf(v[j] - bf2f(hi)); } } }
    for (int i = tid; i < 2048; i += NTHR) { const int sl = i >> 10, c = i & 1023; const GAS float* mpv = MOD + ((size_t)(L * 5 + (sl ? sL : sF))) * 6144 + 3 * 1024;
        MA[sl * 2048 + c] = gnp[c] * (mpv[1024 + c] + 1.0f); MA[sl * 2048 + 1024 + c] = mpv[c]; }
    if (tid < 16) cntl[tid] = 0;
    __syncthreads();
    const int nw = nb / NWAVES + (w < nb % NWAVES ? 1 : 0), wr0 = R0 + w * (nb / NWAVES) + (w < nb % NWAVES ? w : nb % NWAVES);
    for (int t0 = 0; t0 < nw; t0 += 16) {
        const int nrow = (nw - t0) < 16 ? (nw - t0) : 16;
        const int row = wr0 + t0 + (r < nrow ? r : nrow - 1);
        u32x4 vs[32]; { const GAS u32x4* sp = (const GAS u32x4*)(S + (size_t)row * 2048) + q;
#pragma unroll
            for (int kk = 0; kk < 32; ++kk) vs[kk] = sp[4 * kk]; }
        float ss = 0.f;
#pragma unroll
        for (int kk = 0; kk < 32; ++kk) {
#pragma unroll
            for (int j = 0; j < 4; ++j) { const float xl = bflo(vs[kk][j]), xh = bfhi(vs[kk][j]); ss = __builtin_fmaf(xl, xl, ss); ss = __builtin_fmaf(xh, xh, ss);
                asm volatile("" : "+v"(vs[kk][j])); } }
        const float rinv = __builtin_amdgcn_rsqf(qsum4r(ss) * (1.0f / 1024.0f) + 1e-6f);
        const int b_ = row / T, t_ = row - b_ * T, seg = t_ < CTX ? 0 : 1 + b_; const LAS float* ma = MA + (seg == sF ? 0 : 2048) + 8 * q;
        const LAS bf16* whp = WHi + r * WP + 8 * q; const LAS bf16* wlp = WLo + r * WP + 8 * q; GAS bf16* hp_ = H + (size_t)row * 1024 + 8 * q;
        f32x4 acc = {0.f, 0.f, 0.f, 0.f};
#pragma unroll
        for (int kk = 0; kk < 32; ++kk) {
            const f32x4 A0 = *(const LAS f32x4*)(ma + 32 * kk), A1 = *(const LAS f32x4*)(ma + 32 * kk + 4), B0 = *(const LAS f32x4*)(ma + 1024 + 32 * kk), B1 = *(const LAS f32x4*)(ma + 1024 + 32 * kk + 4);
            const bf16x8 bh = *(const LAS bf16x8*)(whp + 32 * kk), bl = *(const LAS bf16x8*)(wlp + 32 * kk);
            const u32x4 x = vs[kk];
            const f32x4 h0 = (f32x4){bflo(x.x), bfhi(x.x), bflo(x.y), bfhi(x.y)} * rinv * A0 + B0, h1 = (f32x4){bflo(x.z), bfhi(x.z), bflo(x.w), bfhi(x.w)} * rinv * A1 + B1;
            u32x4 hi; hi.x = pk2(h0[0], h0[1]); hi.y = pk2(h0[2], h0[3]); hi.z = pk2(h1[0], h1[1]); hi.w = pk2(h1[2], h1[3]);
            const f32x4 l0 = h0 - (f32x4){bflo(hi.x), bfhi(hi.x), bflo(hi.y), bfhi(hi.y)}, l1 = h1 - (f32x4){bflo(hi.z), bfhi(hi.z), bflo(hi.w), bfhi(hi.w)};
            u32x4 lo; lo.x = pk2(l0[0], l0[1]); lo.y = pk2(l0[2], l0[3]); lo.z = pk2(l1[0], l1[1]); lo.w = pk2(l1[2], l1[3]);
            const bf16x8 ah = __builtin_bit_cast(bf16x8, hi), al = __builtin_bit_cast(bf16x8, lo);
            acc = __builtin_amdgcn_mfma_f32_16x16x32_bf16(ah, bh, acc, 0, 0, 0); acc = __builtin_amdgcn_mfma_f32_16x16x32_bf16(ah, bl, acc, 0, 0, 0); acc = __builtin_amdgcn_mfma_f32_16x16x32_bf16(al, bh, acc, 0, 0, 0);

            if (r < nrow) *(GAS u32x4*)(hp_ + 32 * kk) = hi; }
        LAS float* lgw = LG + w * 256;
#pragma unroll
        for (int i = 0; i < 4; ++i) lgw[(4 * q + i) * 16 + r] = acc[i];
        LDS_WAIT();
        if (lane < nrow) { const int m = wr0 + t0 + lane;
            float lg[16];
#pragma unroll
            for (int e4 = 0; e4 < 4; ++e4) { const f32x4 v = *(const LAS f32x4*)(lgw + lane * 16 + 4 * e4); lg[4 * e4] = v[0]; lg[4 * e4 + 1] = v[1]; lg[4 * e4 + 2] = v[2]; lg[4 * e4 + 3] = v[3]; }
            float aff[16], sel[16];
#pragma unroll
            for (int e = 0; e < 16; ++e) { aff[e] = sigmoid_f(lg[e]); sel[e] = aff[e] + rbp[e]; }
            float best = -3.0e38f; int bg = 0; float s0 = 0.f, s1 = 0.f, s2 = 0.f, s3 = 0.f, a0 = 0.f, a1 = 0.f, a2 = 0.f, a3 = 0.f;
#pragma unroll
            for (int g = 0; g < 4; ++g) { const float x0 = sel[4 * g], x1 = sel[4 * g + 1], x2 = sel[4 * g + 2], x3 = sel[4 * g + 3];
                const float t1 = fmaxf(x0, x1), t2 = fminf(x0, x1), u1 = fmaxf(x2, x3), u2 = fminf(x2, x3);
                const float sum = fmaxf(t1, u1) + fmaxf(fminf(t1, u1), fmaxf(t2, u2));
                const bool bt = sum > best; best = bt ? sum : best; bg = bt ? g : bg;
                s0 = bt ? x0 : s0; s1 = bt ? x1 : s1; s2 = bt ? x2 : s2; s3 = bt ? x3 : s3;
                a0 = bt ? aff[4 * g] : a0; a1 = bt ? aff[4 * g + 1] : a1; a2 = bt ? aff[4 * g + 2] : a2; a3 = bt ? aff[4 * g + 3] : a3; }
            int i1 = 0; float m1 = s0; if (s1 > m1) { m1 = s1; i1 = 1; } if (s2 > m1) { m1 = s2; i1 = 2; } if (s3 > m1) { m1 = s3; i1 = 3; }
            int i2 = -1; float m2 = -3.0e38f;
            if (i1 != 0 && s0 > m2) { m2 = s0; i2 = 0; } if (i1 != 1 && s1 > m2) { m2 = s1; i2 = 1; } if (i1 != 2 && s2 > m2) { m2 = s2; i2 = 2; } if (i1 != 3 && s3 > m2) { m2 = s3; i2 = 3; }
            const float c1 = i1 == 0 ? a0 : (i1 == 1 ? a1 : (i1 == 2 ? a2 : a3)), c2 = i2 == 0 ? a0 : (i2 == 1 ? a1 : (i2 == 2 ? a2 : a3));
            const float inv = __builtin_amdgcn_rcpf(c1 + c2);
            const int e1 = bg * 4 + i1, e2 = bg * 4 + i2;
            u32x4 tk; tk.x = (unsigned)e1; tk.y = (unsigned)e2; tk.z = __float_as_uint(c1 * inv); tk.w = __float_as_uint(c2 * inv); ((GAS u32x4*)(F.ws + WS_TOK))[m] = tk;
            __hip_atomic_fetch_add(cntl + e1, 1, __ATOMIC_RELAXED, __HIP_MEMORY_SCOPE_WORKGROUP); __hip_atomic_fetch_add(cntl + e2, 1, __ATOMIC_RELAXED, __HIP_MEMORY_SCOPE_WORKGROUP); }
        LDS_WAIT();
    }
    __syncthreads();
    if (F.tid < 16) __hip_atomic_fetch_add((GAS unsigned*)F.ws + CW_MOE + L * 2048 + (PRB ? 32 : 0) + 64 * F.tid, (unsigned)cntl[F.tid], __ATOMIC_RELAXED, __HIP_MEMORY_SCOPE_AGENT);
}

__device__ __forceinline__ void moe_prefix(const Frame& F, int L, LAS int* pref  , LAS int* cnt  ) {
    if (F.tid < 16) cnt[F.tid] = (int)__hip_atomic_load((GAS unsigned*)F.ws + CW_MOE + L * 2048 + 64 * F.tid, __ATOMIC_RELAXED, __HIP_MEMORY_SCOPE_AGENT);
    __syncthreads();
    if (F.tid == 0) { int p = 0; for (int e = 0; e < 16; ++e) { pref[e] = p; p += (cnt[e] + 255) >> 8; } pref[16] = p; }
    __syncthreads();
}
template <int PRB = 0> PHASE_FN void slots_phase(Frame F, int L) {
    LAS int* pref = (LAS int*)F.lds; LAS int* cnt = pref + 32;
    moe_prefix(F, L, pref, cnt);
    const int gw = F.bid * NWAVES + F.wave, NGW = F.G * NWAVES, lane = F.lane;
    GAS unsigned* cursor = (GAS unsigned*)F.ws + CW_MOE + L * 2048 + 1024 + (PRB ? 32 : 0);
    GAS int* slot_tok = (GAS int*)(F.ws + WS_SLOT_TOK); GAS float* slot_gate = (GAS float*)(F.ws + WS_SLOT_GATE);
    constexpr int SG = 4, NSW = (NTOK / 64 + SG - 1) / SG;
    if (F.wave == 0) for (int sw = F.bid; sw < NSW; sw += F.G) {
        u32x4 tk[SG]; int off0[SG], off1[SG]; int n_run = 0; const unsigned long long below = (1ull << lane) - 1ull;
#pragma unroll
        for (int j = 0; j < SG; ++j) { const int it = sw * SG + j; tk[j] = (it < NTOK / 64) ? ((const GAS u32x4*)(F.ws + WS_TOK))[it * 64 + lane] : (u32x4){99u, 99u, 0u, 0u}; }
#pragma unroll
        for (int j = 0; j < SG; ++j) { const int e0 = (int)tk[j].x, e1 = (int)tk[j].y; int n_me = 0, rank0 = 0, rank1 = 0;
#pragma unroll
            for (int ee = 0; ee < 16; ++ee) { const unsigned long long m0 = __ballot(e0 == ee), m1 = __ballot(e1 == ee);
                if (lane == ee) n_me = __popcll(m0); if (lane == 16 + ee) n_me = __popcll(m1);
                if (e0 == ee) rank0 = __popcll(m0 & below); if (e1 == ee) rank1 = __popcll(m1 & below); }
            off0[j] = __builtin_amdgcn_ds_bpermute((e0 & 15) << 2, n_run) + rank0; off1[j] = __builtin_amdgcn_ds_bpermute((16 + (e1 & 15)) << 2, n_run) + rank1; n_run += n_me; }
        unsigned base = 0; if (lane < 32 && n_run > 0) base = __hip_atomic_fetch_add(cursor + 64 * (lane & 15), (unsigned)n_run, __ATOMIC_RELAXED, __HIP_MEMORY_SCOPE_AGENT);
#pragma unroll
        for (int j = 0; j < SG; ++j) { const int it = sw * SG + j; const int e0 = (int)tk[j].x, e1 = (int)tk[j].y, m = it * 64 + lane;
            const int b0 = __builtin_amdgcn_ds_bpermute((e0 & 15) << 2, (int)base), b1 = __builtin_amdgcn_ds_bpermute((16 + (e1 & 15)) << 2, (int)base);
            if (it < NTOK / 64) { const int s0 = pref[e0] * 256 + b0 + off0[j], s1 = pref[e1] * 256 + b1 + off1[j];
                slot_tok[s0] = 2 * m; slot_gate[s0] = __uint_as_float(tk[j].z); slot_tok[s1] = 2 * m + 1; slot_gate[s1] = __uint_as_float(tk[j].w); } }
    }
    for (int e = 0; e < 16; ++e) { const int lo = pref[e] * 256 + cnt[e], hi = pref[e + 1] * 256;
        for (int s_ = lo + gw * 64 + lane; s_ < hi; s_ += NGW * 64) { slot_tok[s_] = -1; slot_gate[s_] = 0.f; } }
}

PHASE_FN void du_phase(Frame F) {
    GAS bf16* H2 = (GAS bf16*)(F.ws + WS_HY);
    const size_t gt = (size_t)F.bid * NTHR + F.tid, NGT = (size_t)F.G * NTHR;
    for (size_t i = gt; i < (size_t)NTOK * 128; i += NGT) { const int m = (int)(i >> 7), c8 = (int)(i & 127); const int t = m % T;
        const bool hp = !(t == 0 || t == CTX), hn = !(t == CTX - 1 || t == T - 1);
        const u32x4 z = {0u, 0u, 0u, 0u};
        const u32x4 u = *(const GAS u32x4*)(H2 + (size_t)m * 2048 + c8 * 8), p = hp ? *(const GAS u32x4*)(H2 + (size_t)(m - 1) * 2048 + c8 * 8) : z, n = hn ? *(const GAS u32x4*)(H2 + (size_t)(m + 1) * 2048 + c8 * 8) : z;
        u32x4 o;
#pragma unroll
        for (int j = 0; j < 4; ++j) o[j] = pk2(0.5f * (bflo(p[j]) + bflo(n[j])) - bflo(u[j]), 0.5f * (bfhi(p[j]) + bfhi(n[j])) - bfhi(u[j]));
        *(GAS u32x4*)(H2 + (size_t)m * 2048 + 1024 + c8 * 8) = o; }
}

PHASE_FN void conv_phase(Frame F, int j) {
    const GAS bf16* QP = (const GAS bf16*)(F.ws + WS_MIX); GAS bf16* QK = (GAS bf16*)(F.ws + WS_HY); const GAS float* cw = INP(IN_ML_CONV) + (size_t)j * 9 * 2048;
    const int groups = F.G >> 2; if (F.bid >= groups * 4 || groups == 0) return;
    const int q4 = F.bid & 3, c = (q4 * 64 + (F.tid & 63)) * 8, oct = F.tid >> 6;
    float wgt[9][8];
#pragma unroll
    for (int tp = 0; tp < 9; ++tp) { const f32x4 w0 = *(const GAS f32x4*)(cw + tp * 2048 + c), w1 = *(const GAS f32x4*)(cw + tp * 2048 + c + 4);
#pragma unroll
        for (int e = 0; e < 4; ++e) { wgt[tp][e] = w0[e]; wgt[tp][4 + e] = w1[e]; } }
    const float sc = c >= 1024 ? 0.08838834764831845f : 1.0f;
    for (int rr = F.bid >> 2; rr < NB * 132; rr += groups) {
        const int b = rr / 132, lr = rr - b * 132; const bool isctx = lr < 4;
        const int m0 = b * T + (isctx ? 64 * lr : CTX + (lr - 4) * 64);
        const bool rok0 = !isctx && lr > 4, rok2 = !isctx && lr < 131;
        const bool lok = isctx && lr > 0, rgk = isctx && lr < 3;
        const int w0 = 8 * oct;
        const u32x4 z = {0u, 0u, 0u, 0u};
        u32x4 x[3][3];
#define CV_COL(dst, wc) do { const bool cok_ = ((wc) >= 0 && (wc) < 64) || ((wc) < 0 && lok) || ((wc) >= 64 && rgk); const GAS bf16* p_ = QP + (size_t)(m0 + (wc)) * 2048 + c; \
            dst[0] = (cok_ && rok0) ? *(const GAS u32x4*)(p_ - 64 * 2048) : z; dst[1] = cok_ ? *(const GAS u32x4*)p_ : z; dst[2] = (cok_ && rok2) ? *(const GAS u32x4*)(p_ + 64 * 2048) : z; } while (0)
        { u32x4 t_[3]; CV_COL(t_, w0 - 1); x[0][0] = t_[0]; x[1][0] = t_[1]; x[2][0] = t_[2]; CV_COL(t_, w0); x[0][1] = t_[0]; x[1][1] = t_[1]; x[2][1] = t_[2]; }
#pragma unroll
        for (int k = 0; k < 8; ++k) {
            { u32x4 t_[3]; CV_COL(t_, w0 + k + 1); x[0][2] = t_[0]; x[1][2] = t_[1]; x[2][2] = t_[2]; }
            float acc[8];
#pragma unroll
            for (int e = 0; e < 8; ++e) acc[e] = 0.f;
#pragma unroll
            for (int dr = 0; dr < 3; ++dr)
#pragma unroll
                for (int dw = 0; dw < 3; ++dw) { const u32x4 v = x[dr][dw]; const int tp = dr * 3 + dw;
                    acc[0] += bflo(v[0]) * wgt[tp][0]; acc[1] += bfhi(v[0]) * wgt[tp][1]; acc[2] += bflo(v[1]) * wgt[tp][2]; acc[3] += bfhi(v[1]) * wgt[tp][3];
                    acc[4] += bflo(v[2]) * wgt[tp][4]; acc[5] += bfhi(v[2]) * wgt[tp][5]; acc[6] += bflo(v[3]) * wgt[tp][6]; acc[7] += bfhi(v[3]) * wgt[tp][7]; }
            u32x4 o;
#pragma unroll
            for (int e = 0; e < 4; ++e) o[e] = pk2(silu_f(acc[2 * e]) * sc, silu_f(acc[2 * e + 1]) * sc);
            *(GAS u32x4*)(QK + (size_t)(m0 + w0 + k) * 2048 + c) = o;
#pragma unroll
            for (int dr = 0; dr < 3; ++dr) { x[dr][0] = x[dr][1]; x[dr][1] = x[dr][2]; }
        }
#undef CV_COL
    }
}

PHASE_FN void headnorm_phase(Frame F, const GAS bf16* HSf, const GAS bf16* HSb, const GAS bf16* OG, const GAS float* hg, GAS bf16* Y) {
    const int gw = F.bid * NWAVES + F.wave, NGW = F.G * NWAVES, lane = F.lane;
    for (int m = gw; m < NTOK; m += NGW) { const size_t off = (size_t)m * 1024 + lane * 16;
        float x[16]; float ss = 0.f;
#pragma unroll
        for (int hlf = 0; hlf < 2; ++hlf) { const u32x4 a = *(const GAS u32x4*)(HSf + off + 8 * hlf), bq = *(const GAS u32x4*)(HSb + off + 8 * hlf);
#pragma unroll
            for (int q = 0; q < 4; ++q) { x[8 * hlf + 2 * q] = bflo(a[q]) + bflo(bq[q]); x[8 * hlf + 2 * q + 1] = bfhi(a[q]) + bfhi(bq[q]); } }
#pragma unroll
        for (int q = 0; q < 16; ++q) ss += x[q] * x[q];
        ss += dpp_f<0xB1>(ss); ss += dpp_f<0x4E>(ss); ss += dpp_f<0x141>(ss);
        const float rinv = __builtin_amdgcn_rsqf(ss * (1.0f / 128.0f) + 1e-6f);
#pragma unroll
        for (int hlf = 0; hlf < 2; ++hlf) { const u32x4 g = *(const GAS u32x4*)(OG + off + 8 * hlf); const f32x4 h0 = *(const GAS f32x4*)(hg + lane * 16 + 8 * hlf), h1 = *(const GAS f32x4*)(hg + lane * 16 + 8 * hlf + 4);
            u32x4 o;
            o[0] = pk2(x[8 * hlf + 0] * rinv * h0[0] * bflo(g[0]), x[8 * hlf + 1] * rinv * h0[1] * bfhi(g[0])); o[1] = pk2(x[8 * hlf + 2] * rinv * h0[2] * bflo(g[1]), x[8 * hlf + 3] * rinv * h0[3] * bfhi(g[1]));
            o[2] = pk2(x[8 * hlf + 4] * rinv * h1[0] * bflo(g[2]), x[8 * hlf + 5] * rinv * h1[1] * bfhi(g[2])); o[3] = pk2(x[8 * hlf + 6] * rinv * h1[2] * bflo(g[3]), x[8 * hlf + 7] * rinv * h1[3] * bfhi(g[3]));
            *(GAS u32x4*)(Y + off + 8 * hlf) = o; } }
}
PHASE_FN void rwpost_phase(Frame F, const GAS bf16* Of, const GAS bf16* Ob, const GAS float* BETA, const GAS bf16* V, const GAS bf16* Gt, GAS bf16* Y) {
    const int gw = F.bid * NWAVES + F.wave, NGW = F.G * NWAVES, lane = F.lane;
    const GAS float* lnw = INP(IN_RW_LNW); const GAS float* lnb = INP(IN_RW_LNB);
    for (int m = gw; m < NTOK; m += NGW) { const size_t off = (size_t)m * 1024 + lane * 16;
        float x[16]; float s = 0.f;
#pragma unroll
        for (int hlf = 0; hlf < 2; ++hlf) { const u32x4 a = *(const GAS u32x4*)(Of + off + 8 * hlf), bq = *(const GAS u32x4*)(Ob + off + 8 * hlf);
#pragma unroll
            for (int q = 0; q < 4; ++q) { x[8 * hlf + 2 * q] = bflo(a[q]) + bflo(bq[q]); x[8 * hlf + 2 * q + 1] = bfhi(a[q]) + bfhi(bq[q]); } }
#pragma unroll
        for (int q = 0; q < 16; ++q) s += x[q];
        s += dpp_f<0xB1>(s); s += dpp_f<0x4E>(s);
        const float mean = s * (1.0f / 64.0f); float vs = 0.f;
#pragma unroll
        for (int q = 0; q < 16; ++q) { x[q] -= mean; vs += x[q] * x[q]; }
        vs += dpp_f<0xB1>(vs); vs += dpp_f<0x4E>(vs);
        const float rinv = __builtin_amdgcn_rsqf(vs * (1.0f / 64.0f) + 64e-5f);
        const int hd = lane >> 2; const float beta = BETA[(size_t)m * 16 + hd] + BETA[((size_t)NTOK + m) * 16 + hd];
#pragma unroll
        for (int hlf = 0; hlf < 2; ++hlf) { const u32x4 vv = *(const GAS u32x4*)(V + off + 8 * hlf), gg = *(const GAS u32x4*)(Gt + off + 8 * hlf);
            const f32x4 w0 = *(const GAS f32x4*)(lnw + lane * 16 + 8 * hlf), w1 = *(const GAS f32x4*)(lnw + lane * 16 + 8 * hlf + 4), b0 = *(const GAS f32x4*)(lnb + lane * 16 + 8 * hlf), b1 = *(const GAS f32x4*)(lnb + lane * 16 + 8 * hlf + 4);
            float y[8];
#pragma unroll
            for (int q = 0; q < 4; ++q) { y[q] = x[8 * hlf + q] * rinv * w0[q] + b0[q]; y[4 + q] = x[8 * hlf + 4 + q] * rinv * w1[q] + b1[q]; }
            u32x4 o;
#pragma unroll
            for (int q = 0; q < 4; ++q) o[q] = pk2((y[2 * q] + beta * bflo(vv[q])) * bflo(gg[q]), (y[2 * q + 1] + beta * bfhi(vv[q])) * bfhi(gg[q]));
            *(GAS u32x4*)(Y + off + 8 * hlf) = o; } }
}

__device__ __forceinline__ void group_barrier(LAS unsigned* ctr, unsigned target, int lane) {
    LDS_WAIT();
    if (lane == 0) __hip_atomic_fetch_add(ctr, 1u, __ATOMIC_RELAXED, __HIP_MEMORY_SCOPE_WORKGROUP);
    while ((unsigned)__builtin_amdgcn_readfirstlane((int)__hip_atomic_load(ctr, __ATOMIC_RELAXED, __HIP_MEMORY_SCOPE_WORKGROUP)) < target) __builtin_amdgcn_s_sleep(1);
    asm volatile("" ::: "memory");
}
template <int PROBE> PHASE_FN void ml_scan_phase(Frame F, const GAS bf16* QK, const GAS bf16* V, const GAS float* GATES, GAS bf16* HS) {
    constexpr int OFF_Q = 0, OFF_K = 17408, OFF_V = 34816, OFF_VW = 40960, OFF_WKR = 46080, INB = 48384;
    constexpr int O_SS = 2 * INB, O_CS = O_SS + 2 * 9216, O_HO = O_CS + 2 * 13056, O_SC = O_HO + 2 * 5120, O_CTR = O_SC + 3 * 1344;
    LAS float* SCb = (LAS float*)(F.lds + O_SC);
    LAS unsigned* actr = (LAS unsigned*)(F.lds + O_CTR);
    const int tid = F.tid, w = F.wave; int lane = F.lane, r = lane & 15, q = lane >> 4;
    constexpr int NCH = T / 64;
    for (int unit = F.bid; unit < 256; unit += F.G) {
        const int un = (F.G == 256) ? ((((unit & 7) * 8 + (unit >> 5)) << 2) | ((unit >> 3) & 3)) : unit;
        const int vs = un & 3, dir = (un >> 2) & 1, h = (un >> 3) & 7, b = un >> 6;
        __syncthreads();
        for (int i = tid; i < (O_CTR + 16) / 4; i += NTHR) ((LAS unsigned*)F.lds)[i] = 0u;
        __syncthreads();
        if (tid < 128) ((LAS bf16*)(F.lds + (tid >> 6) * INB + OFF_V))[(tid & 63) * 48 + 32] = (bf16)0x3f80;
        __syncthreads();
        if (w >= 4) {
            const int a = w - 4, ptid = tid - 256; unsigned abar = 0; int lrow = ptid >> 2, lp = ptid & 3;
#define ML_RELAUNDER() asm volatile("" : "+v"(lrow), "+v"(lp), "+v"(lane), "+v"(r), "+v"(q))
            float m_run = 0.f; u32x4 rq0[4], rk0[4], rv0, rq1[4], rk1[4], rv1; float rig = 0.f, rlf = 0.f;
#define ML_LOAD(cc, S) do { const int row_ = seq_row(b, dir, (cc) * 64 + lrow); const GAS bf16* qp_ = QK + (size_t)row_ * 2048 + h * 128; \
                _Pragma("unroll") for (int j_ = 0; j_ < 4; ++j_) { rq##S[j_] = *(const GAS u32x4*)(qp_ + 8 * (lp + 4 * j_)); rk##S[j_] = *(const GAS u32x4*)(qp_ + 1024 + 8 * (lp + 4 * j_)); } \
                rv##S = *(const GAS u32x4*)(V + (size_t)row_ * 1024 + h * 128 + vs * 32 + 8 * lp); } while (0)
#define ML_GLOAD(cc) do { const int grow_ = seq_row(b, dir, (cc) * 64 + lane); rig = GATES[(size_t)grow_ * 32 + dir * 16 + h]; rlf = GATES[(size_t)grow_ * 32 + dir * 16 + 8 + h]; } while (0)
#define ML_SCALARS(cc) do { const float lf_ = logsigmoid_f(rlf); const float bc_ = wave_scan_add(lf_); const float u_ = rig - bc_; const float pm_ = wave_scan_max(u_); \
                const float cc_ = fmaxf(m_run, pm_), blast_ = lane63(bc_), pmall_ = lane63(pm_), mnew_ = blast_ + fmaxf(m_run, pmall_); LAS float* sc_ = SCb + ((cc) % 3) * 336; \
                sc_[lane] = u_; sc_[64 + lane] = cc_; sc_[128 + lane] = __expf(m_run - cc_); sc_[192 + lane] = __expf(-(bc_ + cc_)); sc_[256 + lane] = __expf(blast_ + u_ - mnew_); \
                if (lane == 0) sc_[320] = __expf(blast_ + m_run - mnew_); m_run = mnew_; } while (0)
#define ML_STAGE(cc, S) do { LAS unsigned char* ib_ = F.lds + ((cc) & 1) * INB; const LAS float* sc_ = SCb + ((cc) % 3) * 336; \
                _Pragma("unroll") for (int j_ = 0; j_ < 4; ++j_) { *(LAS u32x4*)((LAS bf16*)(ib_ + OFF_Q) + lrow * 136 + 8 * (lp + 4 * j_)) = rq##S[j_]; *(LAS u32x4*)((LAS bf16*)(ib_ + OFF_K) + lrow * 136 + 8 * (lp + 4 * j_)) = rk##S[j_]; } \
                const float wk_ = sc_[256 + lrow]; u32x4 vw_; _Pragma("unroll") for (int j_ = 0; j_ < 4; ++j_) vw_[j_] = pk2(bflo(rv##S[j_]) * wk_, bfhi(rv##S[j_]) * wk_); \
                *(LAS u32x4*)((LAS bf16*)(ib_ + OFF_V) + lrow * 48 + 8 * lp) = rv##S; *(LAS u32x4*)((LAS bf16*)(ib_ + OFF_VW) + lrow * 40 + 8 * lp) = vw_; \
                if (ptid < 64) ((LAS bf16*)(ib_ + OFF_WKR))[ptid] = (bf16)f2bf(sc_[256 + ptid]); } while (0)
#define ML_STILE(cc, ti_, sj_) do { const LAS unsigned char* ib_ = F.lds + ((cc) & 1) * INB; const LAS float* sc_ = SCb + ((cc) % 3) * 336; LAS bf16* ss_ = (LAS bf16*)(F.lds + O_SS + ((cc) & 1) * 9216); \
                f32x4 acc_ = {0.f, 0.f, 0.f, 0.f}; acc_ = mm16<128>(acc_, (const LAS bf16*)(ib_ + OFF_Q) + 16 * (ti_) * 136, 136, (const LAS bf16*)(ib_ + OFF_K) + 16 * (sj_) * 136, 136, lane); \
                const int s_ = 16 * (sj_) + r; const float us_ = sc_[s_]; \
                _Pragma("unroll") for (int i_ = 0; i_ < 4; ++i_) { const int t_ = 16 * (ti_) + 4 * q + i_; ss_[t_ * 72 + s_] = (bf16)f2bf((s_ <= t_) ? acc_[i_] * __expf(us_ - sc_[64 + t_]) : 0.f); } } while (0)
#define ML_STILES(cc) do { if (a == 0) { ML_STILE(cc, 3, 0); ML_STILE(cc, 3, 1); ML_STILE(cc, 0, 0); } else if (a == 1) { ML_STILE(cc, 3, 2); ML_STILE(cc, 3, 3); ML_STILE(cc, 1, 0); } \
                else if (a == 2) { ML_STILE(cc, 2, 0); ML_STILE(cc, 2, 1); ML_STILE(cc, 2, 2); } else { ML_STILE(cc, 1, 1); } } while (0)
#define ML_HSTORE(cc) do { const int row_ = seq_row(b, dir, (cc) * 64 + lrow); *(GAS u32x4*)(HS + ((size_t)dir * NTOK + row_) * 1024 + h * 128 + vs * 32 + 8 * lp) = *(const LAS u32x4*)((const LAS bf16*)(F.lds + O_HO + ((cc) & 1) * 5120) + lrow * 40 + 8 * lp); } while (0)
            ML_LOAD(0, 0); ML_LOAD(1, 1);
            if (a == 3) { ML_GLOAD(0); ML_SCALARS(0); ML_GLOAD(1); ML_SCALARS(1); ML_GLOAD(2); }
            group_barrier(actr, 4 * (++abar), lane);
            ML_STAGE(0, 0); ML_LOAD(2, 0);
            group_barrier(actr, 4 * (++abar), lane);
            ML_STILES(0);
            __syncthreads();
            for (int c = 0; c < NCH; ++c) {
                if (c + 1 < NCH && !(PROBE & 2)) {
                    ML_RELAUNDER();
                    if (!(PROBE & 8)) {
                    if (c & 1) { ML_STAGE(c + 1, 0); if (c + 3 < NCH) ML_LOAD(c + 3, 0); } else { ML_STAGE(c + 1, 1); if (c + 3 < NCH) ML_LOAD(c + 3, 1); }
                    if (c >= 1) ML_HSTORE(c - 1); }
                    group_barrier(actr, 4 * (++abar), lane);
                    if (!(PROBE & 4)) ML_STILES(c + 1);
                    if (!(PROBE & 16)) { if (a == 3 && c + 2 < NCH) { ML_SCALARS(c + 2); if (c + 3 < NCH) ML_GLOAD(c + 3); } }
                } else if (c >= 1) ML_HSTORE(c - 1);
                __syncthreads();
            }
            ML_HSTORE(NCH - 1);
#undef ML_LOAD
#undef ML_RELAUNDER
#undef ML_GLOAD
#undef ML_SCALARS
#undef ML_STAGE
#undef ML_STILE
#undef ML_STILES
#undef ML_HSTORE
        } else {
            f32x4 Cst[2][2], Nst[2];
#pragma unroll
            for (int i = 0; i < 2; ++i) { Nst[i] = (f32x4){0.f, 0.f, 0.f, 0.f}; Cst[i][0] = Nst[i]; Cst[i][1] = Nst[i]; }
            __syncthreads();
            for (int c = 0; c < NCH; ++c) {
                if (!(PROBE & 1)) {
                const LAS unsigned char* ib = F.lds + (c & 1) * INB;
                const LAS bf16* QS = (const LAS bf16*)(ib + OFF_Q); const LAS bf16* KS = (const LAS bf16*)(ib + OFF_K); const LAS bf16* VS = (const LAS bf16*)(ib + OFF_V); const LAS bf16* VW = (const LAS bf16*)(ib + OFF_VW); const LAS bf16* WKR = (const LAS bf16*)(ib + OFF_WKR);
                const LAS bf16* SS = (const LAS bf16*)(F.lds + O_SS + (c & 1) * 9216); const LAS bf16* CSr = (const LAS bf16*)(F.lds + O_CS + (c & 1) * 13056); LAS bf16* CSw = (LAS bf16*)(F.lds + O_CS + ((c + 1) & 1) * 13056);
                LAS bf16* HO = (LAS bf16*)(F.lds + O_HO + (c & 1) * 5120); const LAS float* sc = SCb + (c % 3) * 336;
                {   const int ti = w; f32x4 a1[2], a2[2], a3 = {0.f, 0.f, 0.f, 0.f}, a1x = a3;
#pragma unroll
                    for (int vj = 0; vj < 2; ++vj) { a1[vj] = (f32x4){0.f, 0.f, 0.f, 0.f}; a2[vj] = a1[vj]; }
#pragma unroll
                    for (int kk = 0; kk < 2; ++kk) { const bf16x8 sf = row_frag(SS + 16 * ti * 72, 72, 32 * kk, lane);
#pragma unroll
                        for (int vj = 0; vj < 2; ++vj) a1[vj] = __builtin_amdgcn_mfma_f32_16x16x32_bf16(sf, tr_frag(VS, 48, 32 * kk, 16 * vj, lane), a1[vj], 0, 0, 0);
                        a1x = __builtin_amdgcn_mfma_f32_16x16x32_bf16(sf, tr_frag(VS, 48, 32 * kk, 32, lane), a1x, 0, 0, 0); }
#pragma unroll
                    for (int kk = 0; kk < 4; ++kk) { const bf16x8 qf = row_frag(QS + 16 * ti * 136, 136, 32 * kk, lane);
#pragma unroll
                        for (int vj = 0; vj < 2; ++vj) a2[vj] = __builtin_amdgcn_mfma_f32_16x16x32_bf16(qf, row_frag(CSr + 16 * vj * 136, 136, 32 * kk, lane), a2[vj], 0, 0, 0);
                        a3 = __builtin_amdgcn_mfma_f32_16x16x32_bf16(qf, row_frag(CSr + 32 * 136, 136, 32 * kk, lane), a3, 0, 0, 0); }
#pragma unroll
                    for (int i = 0; i < 4; ++i) { const int t_ = 16 * ti + 4 * q + i; const float wi = sc[128 + t_];
                        const float den = row16_sum(a1x[i] + wi * a3[i]); const float rd = __builtin_amdgcn_rcpf(fmaxf(fabsf(den), sc[192 + t_]));
#pragma unroll
                        for (int vj = 0; vj < 2; ++vj) HO[t_ * 40 + 16 * vj + r] = (bf16)f2bf((a1[vj][i] + wi * a2[vj][i]) * rd); } }
                {   const float wprev = sc[320]; bf16x8 av[2][2], wf[2];
#pragma unroll
                    for (int kk = 0; kk < 2; ++kk) { av[0][kk] = tr_frag(VW, 40, 32 * kk, 0, lane); av[1][kk] = tr_frag(VW, 40, 32 * kk, 16, lane); wf[kk] = row_frag(WKR, 72, 32 * kk, lane); }
#pragma unroll
                    for (int jj = 0; jj < 2; ++jj) { const int dj = 2 * w + jj; Cst[0][jj] = Cst[0][jj] * wprev; Cst[1][jj] = Cst[1][jj] * wprev; Nst[jj] = Nst[jj] * wprev;
#pragma unroll
                        for (int kk = 0; kk < 2; ++kk) { const bf16x8 kf = tr_frag(KS, 136, 32 * kk, 16 * dj, lane);
                            Cst[0][jj] = __builtin_amdgcn_mfma_f32_16x16x32_bf16(av[0][kk], kf, Cst[0][jj], 0, 0, 0); Cst[1][jj] = __builtin_amdgcn_mfma_f32_16x16x32_bf16(av[1][kk], kf, Cst[1][jj], 0, 0, 0);
                            Nst[jj] = __builtin_amdgcn_mfma_f32_16x16x32_bf16(wf[kk], kf, Nst[jj], 0, 0, 0); }
#pragma unroll
                        for (int vi = 0; vi < 2; ++vi)
#pragma unroll
                            for (int i = 0; i < 4; ++i) CSw[(16 * vi + 4 * q + i) * 136 + 16 * dj + r] = (bf16)f2bf(Cst[vi][jj][i]);
                        if (q == 0) CSw[32 * 136 + 16 * dj + r] = (bf16)f2bf(Nst[jj][0]); } }
                }
                __syncthreads();
            }
        }
    }
}

template <int PROBE> PHASE_FN void hg_scan_phase(Frame F, const GAS bf16* Q, const GAS bf16* V, const GAS bf16* LF, GAS bf16* HSf, GAS bf16* HSb) {
    constexpr int O_QT = 0, O_KT = 17408, O_IN = 34816, INB = 39936  , O_AS = O_IN + 2 * INB, O_ST = O_AS + 2 * 9216, O_HO = O_ST + 2 * 8704, O_SBL = O_HO + 5120, O_WT = O_SBL + 1024, O_CTR = O_WT + 2048;
    LAS unsigned* actr = (LAS unsigned*)(F.lds + O_CTR);
    const int tid = F.tid, lane = F.lane, w = F.wave, r = lane & 15, q = lane >> 4;
    constexpr int NCH = T / 64;
    for (int unit = F.bid; unit < 256; unit += F.G) {
        const int un = (F.G == 256) ? ((((unit & 7) * 8 + (unit >> 5)) << 2) | ((unit >> 3) & 3)) : unit;
        const int vs = un & 3, dir = (un >> 2) & 1, h = (un >> 3) & 7, b = un >> 6;
        GAS bf16* HS = dir ? HSb : HSf; const GAS bf16* LFd = LF + (size_t)dir * NTOK * 1024;
        __syncthreads();
        for (int i = tid; i < (O_CTR + 16) / 4; i += NTHR) ((LAS unsigned*)F.lds)[i] = 0u;
        __syncthreads();
        if (w >= 4) {
            const int a = w - 4, ptid = tid - 256, g4 = lane & 15, lp = 4 * a + (lane >> 4); unsigned abar = 0;
            u32x4 rq0[4], rl0[4], rv0;
#define HG_LOAD(cc, S) do { _Pragma("unroll") for (int j_ = 0; j_ < 4; ++j_) { const int row_ = seq_row(b, dir, (cc) * 64 + 4 * g4 + j_); rq##S[j_] = *(const GAS u32x4*)(Q + (size_t)row_ * 1024 + h * 128 + 8 * lp); rl##S[j_] = *(const GAS u32x4*)(LFd + (size_t)row_ * 1024 + h * 128 + 8 * lp); } \
                const int vrow_ = seq_row(b, dir, (cc) * 64 + (ptid >> 2)); rv##S = *(const GAS u32x4*)(V + (size_t)vrow_ * 1024 + h * 128 + vs * 32 + 8 * (ptid & 3)); } while (0)
#define HG_ATILE(cc, ti_, sj_) do { LAS bf16* as_ = (LAS bf16*)(F.lds + O_AS + ((cc) & 1) * 9216); f32x4 acc_ = {0.f, 0.f, 0.f, 0.f}; \
                acc_ = mm16<128>(acc_, (const LAS bf16*)(F.lds + O_QT) + 16 * (ti_) * 136, 136, (const LAS bf16*)(F.lds + O_KT) + 16 * (sj_) * 136, 136, lane); \
                _Pragma("unroll") for (int i_ = 0; i_ < 4; ++i_) { const int t_ = 16 * (ti_) + 4 * q + i_, s_ = 16 * (sj_) + r; as_[t_ * 72 + s_] = (bf16)f2bf(s_ <= t_ ? acc_[i_] : 0.f); } } while (0)
#define HG_ATILES(cc) do { if (a == 0) { HG_ATILE(cc, 3, 0); HG_ATILE(cc, 3, 1); HG_ATILE(cc, 0, 0); } else if (a == 1) { HG_ATILE(cc, 3, 2); HG_ATILE(cc, 3, 3); HG_ATILE(cc, 1, 0); } \
                else if (a == 2) { HG_ATILE(cc, 2, 0); HG_ATILE(cc, 2, 1); } else { HG_ATILE(cc, 2, 2); HG_ATILE(cc, 1, 1); } } while (0)
#define HG_PREP(cc, S) do { LAS unsigned char* ib_ = F.lds + O_IN + ((cc) & 1) * INB; \
                float lf_[4][8], bc_[4][8]; \
                _Pragma("unroll") for (int j_ = 0; j_ < 4; ++j_) _Pragma("unroll") for (int k_ = 0; k_ < 4; ++k_) { lf_[j_][2 * k_] = 1.4426950408889634f * bflo(rl##S[j_][k_]); lf_[j_][2 * k_ + 1] = 1.4426950408889634f * bfhi(rl##S[j_][k_]); }     \
                float br_[8], bl_[8]; \
                _Pragma("unroll") for (int k_ = 0; k_ < 8; ++k_) { float run_ = 0.f; _Pragma("unroll") for (int j_ = 0; j_ < 4; ++j_) { run_ += lf_[j_][k_]; bc_[j_][k_] = run_; } \
                    float x_ = run_; x_ += dpp_keep<0x111, 0xF>(0.f, x_); x_ += dpp_keep<0x112, 0xF>(0.f, x_); x_ += dpp_keep<0x114, 0xF>(0.f, x_); x_ += dpp_keep<0x118, 0xF>(0.f, x_);     \
                    const float ex_ = x_ - run_; _Pragma("unroll") for (int j_ = 0; j_ < 4; ++j_) bc_[j_][k_] += ex_; \
                    br_[k_] = __builtin_bit_cast(float, __builtin_amdgcn_ds_bpermute(((lane & 48) | 7) << 2, __builtin_bit_cast(int, x_))); bl_[k_] = __builtin_bit_cast(float, __builtin_amdgcn_ds_bpermute(((lane & 48) | 15) << 2, __builtin_bit_cast(int, x_))); } \
                _Pragma("unroll") for (int j_ = 0; j_ < 4; ++j_) { const int t_ = 4 * g4 + j_; u32x4 oq_, oi_, ok_, oh_; \
                    _Pragma("unroll") for (int k_ = 0; k_ < 4; ++k_) { float a2_[2], i2_[2], k2_[2], h2_[2]; \
                        _Pragma("unroll") for (int hh_ = 0; hh_ < 2; ++hh_) { const int c_ = 2 * k_ + hh_; const float bt_ = bc_[j_][c_], key_ = 1.0f - __builtin_amdgcn_exp2f(lf_[j_][c_]), qv_ = hh_ ? bfhi(rq##S[j_][k_]) : bflo(rq##S[j_][k_]); \
                            a2_[hh_] = qv_ * __builtin_amdgcn_exp2f(fminf(bt_ - br_[c_], 115.f)); i2_[hh_] = qv_ * __builtin_amdgcn_exp2f(bt_); k2_[hh_] = key_ * __builtin_amdgcn_exp2f(fminf(br_[c_] - bt_, 115.f)); h2_[hh_] = key_ * __builtin_amdgcn_exp2f(bl_[c_] - bt_); } \
                        oq_[k_] = pk2(a2_[0], a2_[1]); oi_[k_] = pk2(i2_[0], i2_[1]); ok_[k_] = pk2(k2_[0], k2_[1]); oh_[k_] = pk2(h2_[0], h2_[1]); } \
                    *(LAS u32x4*)((LAS bf16*)(F.lds + O_QT) + t_ * 136 + 8 * lp) = oq_; *(LAS u32x4*)((LAS bf16*)(F.lds + O_KT) + t_ * 136 + 8 * lp) = ok_; \
                    *(LAS u32x4*)((LAS bf16*)ib_ + t_ * 136 + 8 * lp) = oi_; *(LAS u32x4*)((LAS bf16*)(ib_ + 17408) + t_ * 136 + 8 * lp) = oh_; } \
                *(LAS u32x4*)((LAS bf16*)(ib_ + 34816) + (ptid >> 2) * 40 + 8 * (ptid & 3)) = rv##S; \
                if (g4 == 0) { LAS float* sbl_ = (LAS float*)(F.lds + O_SBL) + ((cc) & 1) * 128; _Pragma("unroll") for (int k_ = 0; k_ < 8; ++k_) sbl_[8 * lp + k_] = __builtin_amdgcn_exp2f(bl_[k_]); } } while (0)
            HG_LOAD(0, 0);
            HG_PREP(0, 0); HG_LOAD(1, 0);
            group_barrier(actr, 4 * (++abar), lane);
            HG_ATILES(0);
            __syncthreads();
            for (int c = 0; c < NCH; ++c) {
                if (c + 1 < NCH && !(PROBE & 2)) {
                    HG_PREP(c + 1, 0);
                    if (c + 2 < NCH) HG_LOAD(c + 2, 0);
                    group_barrier(actr, 4 * (++abar), lane);
                    HG_ATILES(c + 1);
                }
                __syncthreads();
            }
#undef HG_LOAD
#undef HG_ATILE
#undef HG_ATILES
#undef HG_PREP
        } else {
            f32x4 Sst[2][2];
#pragma unroll
            for (int i = 0; i < 2; ++i) { Sst[i][0] = (f32x4){0.f, 0.f, 0.f, 0.f}; Sst[i][1] = Sst[i][0]; }
            __syncthreads();
            for (int c = 0; c < NCH; ++c) {
                if (!(PROBE & 1)) {
                const LAS unsigned char* ib = F.lds + O_IN + (c & 1) * INB;
                const LAS bf16* QI = (const LAS bf16*)ib; const LAS bf16* KH = (const LAS bf16*)(ib + 17408); const LAS bf16* VS = (const LAS bf16*)(ib + 34816);
                const LAS bf16* AS = (const LAS bf16*)(F.lds + O_AS + (c & 1) * 9216); const LAS bf16* STr = (const LAS bf16*)(F.lds + O_ST + (c & 1) * 8704); LAS bf16* STw = (LAS bf16*)(F.lds + O_ST + ((c + 1) & 1) * 8704);
                LAS bf16* HO = (LAS bf16*)(F.lds + O_HO); const LAS float* sbl = (const LAS float*)(F.lds + O_SBL) + (c & 1) * 128;
                {   const int ti = w; f32x4 o[2]; o[0] = (f32x4){0.f, 0.f, 0.f, 0.f}; o[1] = o[0];
#pragma unroll
                    for (int kk = 0; kk < 2; ++kk) { const bf16x8 af = row_frag(AS + 16 * ti * 72, 72, 32 * kk, lane);
#pragma unroll
                        for (int vj = 0; vj < 2; ++vj) o[vj] = __builtin_amdgcn_mfma_f32_16x16x32_bf16(af, tr_frag(VS, 40, 32 * kk, 16 * vj, lane), o[vj], 0, 0, 0); }
#pragma unroll
                    for (int kk = 0; kk < 4; ++kk) { const bf16x8 qf = row_frag(QI + 16 * ti * 136, 136, 32 * kk, lane);
#pragma unroll
                        for (int vj = 0; vj < 2; ++vj) o[vj] = __builtin_amdgcn_mfma_f32_16x16x32_bf16(qf, row_frag(STr + 16 * vj * 136, 136, 32 * kk, lane), o[vj], 0, 0, 0); }
#pragma unroll
                    for (int i = 0; i < 4; ++i)
#pragma unroll
                        for (int vj = 0; vj < 2; ++vj) HO[(16 * ti + 4 * q + i) * 40 + 16 * vj + r] = (bf16)f2bf(o[vj][i]);
                    LDS_WAIT();
                    { const int t_ = 16 * ti + (lane >> 2); const int row = seq_row(b, dir, c * 64 + t_); *(GAS u32x4*)(HS + (size_t)row * 1024 + h * 128 + vs * 32 + 8 * (lane & 3)) = *(const LAS u32x4*)(HO + t_ * 40 + 8 * (lane & 3)); } }
                {   bf16x8 av[2][2];
#pragma unroll
                    for (int kk = 0; kk < 2; ++kk) { av[0][kk] = tr_frag(VS, 40, 32 * kk, 0, lane); av[1][kk] = tr_frag(VS, 40, 32 * kk, 16, lane); }
#pragma unroll
                    for (int jj = 0; jj < 2; ++jj) { const int kj = 2 * w + jj; const float sb = sbl[16 * kj + r]; Sst[0][jj] = Sst[0][jj] * sb; Sst[1][jj] = Sst[1][jj] * sb;
#pragma unroll
                        for (int kk = 0; kk < 2; ++kk) { const bf16x8 kf = tr_frag(KH, 136, 32 * kk, 16 * kj, lane);
                            Sst[0][jj] = __builtin_amdgcn_mfma_f32_16x16x32_bf16(av[0][kk], kf, Sst[0][jj], 0, 0, 0); Sst[1][jj] = __builtin_amdgcn_mfma_f32_16x16x32_bf16(av[1][kk], kf, Sst[1][jj], 0, 0, 0); }
#pragma unroll
                        for (int vi = 0; vi < 2; ++vi)
#pragma unroll
                            for (int i = 0; i < 4; ++i) STw[(16 * vi + 4 * q + i) * 136 + 16 * kj + r] = (bf16)f2bf(Sst[vi][jj][i]); } }
                }
                __syncthreads();
            }
        }
    }
}

__device__ __forceinline__ void gflag_wait(const LAS unsigned* ctr, unsigned target) { while ((unsigned)__builtin_amdgcn_readfirstlane((int)__hip_atomic_load(ctr, __ATOMIC_RELAXED, __HIP_MEMORY_SCOPE_WORKGROUP)) < target) __builtin_amdgcn_s_sleep(1); asm volatile("" ::: "memory"); }
__device__ __forceinline__ void gflag_post(LAS unsigned* ctr, int lane) { LDS_WAIT(); if (lane == 0) __hip_atomic_fetch_add(ctr, 1u, __ATOMIC_RELAXED, __HIP_MEMORY_SCOPE_WORKGROUP); }
template <int PROBE> PHASE_FN void hg_scan3_phase(Frame F, const GAS bf16* Q, const GAS bf16* V, const GAS bf16* LF, GAS bf16* HSf, GAS bf16* HSb) {
    constexpr int O_QT = 0, O_KT = 17408, O_IN = 34816, INB = 39936  , O_AS = O_IN + 2 * INB, O_ST = O_AS + 2 * 9216, O_HO = O_ST + 2 * 8704, O_SBL = O_HO + 5120, O_WT = O_SBL + 1024, O_CTR = O_WT + 2048;
    LAS unsigned* QKR = (LAS unsigned*)(F.lds + O_CTR);
    const int tid = F.tid, lane = F.lane, w = F.wave, r = lane & 15, q = lane >> 4;
    constexpr int NCH = T / 64;
    for (int unit = F.bid; unit < 256; unit += F.G) {
        const int un = (F.G == 256) ? ((((unit & 7) * 8 + (unit >> 5)) << 2) | ((unit >> 3) & 3)) : unit;
        const int vs = un & 3, dir = (un >> 2) & 1, h = (un >> 3) & 7, b = un >> 6;
        GAS bf16* HS = dir ? HSb : HSf; const GAS bf16* LFd = LF + (size_t)dir * NTOK * 1024;
        __syncthreads();
        for (int i = tid; i < (O_CTR + 16) / 4; i += NTHR) ((LAS unsigned*)F.lds)[i] = 0u;
        __syncthreads();
        if (w >= 4) {
            const int a = w - 4, ptid = tid - 256, g4 = lane & 15, lp = 4 * a + (lane >> 4);
            u32x4 rq0[4], rl0[4], rv0, rq1[4], rl1[4], rv1;
#define HG_LOAD(cc, S) do { _Pragma("unroll") for (int j_ = 0; j_ < 4; ++j_) { const int row_ = seq_row(b, dir, (cc) * 64 + 4 * g4 + j_); rq##S[j_] = *(const GAS u32x4*)(Q + (size_t)row_ * 1024 + h * 128 + 8 * lp); rl##S[j_] = *(const GAS u32x4*)(LFd + (size_t)row_ * 1024 + h * 128 + 8 * lp); } \
                const int vrow_ = seq_row(b, dir, (cc) * 64 + (ptid >> 2)); rv##S = *(const GAS u32x4*)(V + (size_t)vrow_ * 1024 + h * 128 + vs * 32 + 8 * (ptid & 3)); } while (0)
#define HG_PREP(cc, S) do { const u32x4 vcur_ = rv##S; LAS unsigned char* ib_ = F.lds + O_IN + ((cc) & 1) * INB; \
                float lf_[4][8], bc_[4][8]; \
                _Pragma("unroll") for (int j_ = 0; j_ < 4; ++j_) _Pragma("unroll") for (int k_ = 0; k_ < 4; ++k_) { lf_[j_][2 * k_] = 1.4426950408889634f * bflo(rl##S[j_][k_]); lf_[j_][2 * k_ + 1] = 1.4426950408889634f * bfhi(rl##S[j_][k_]); }     \
                float br_[8], bl_[8]; \
                _Pragma("unroll") for (int k_ = 0; k_ < 8; ++k_) { float run_ = 0.f; _Pragma("unroll") for (int j_ = 0; j_ < 4; ++j_) { run_ += lf_[j_][k_]; bc_[j_][k_] = run_; } \
                    float x_ = run_; x_ += dpp_keep<0x111, 0xF>(0.f, x_); x_ += dpp_keep<0x112, 0xF>(0.f, x_); x_ += dpp_keep<0x114, 0xF>(0.f, x_); x_ += dpp_keep<0x118, 0xF>(0.f, x_);     \
                    const float ex_ = x_ - run_; _Pragma("unroll") for (int j_ = 0; j_ < 4; ++j_) bc_[j_][k_] += ex_; \
                    br_[k_] = __builtin_bit_cast(float, __builtin_amdgcn_ds_bpermute(((lane & 48) | 7) << 2, __builtin_bit_cast(int, x_))); bl_[k_] = __builtin_bit_cast(float, __builtin_amdgcn_ds_bpermute(((lane & 48) | 15) << 2, __builtin_bit_cast(int, x_))); } \
                gflag_wait(QKR + 1, 4u * (unsigned)(cc));                                  \
                if ((cc) >= 2) gflag_wait(QKR + 2, 4u * (unsigned)((cc) - 1));             \
                _Pragma("unroll") for (int j_ = 0; j_ < 4; ++j_) { const int t_ = 4 * g4 + j_; u32x4 oq_, oi_, ok_, oh_; \
                    _Pragma("unroll") for (int k_ = 0; k_ < 4; ++k_) { float a2_[2], i2_[2], k2_[2], h2_[2]; \
                        _Pragma("unroll") for (int hh_ = 0; hh_ < 2; ++hh_) { const int c_ = 2 * k_ + hh_; const float bt_ = bc_[j_][c_], key_ = 1.0f - __builtin_amdgcn_exp2f(lf_[j_][c_]), qv_ = hh_ ? bfhi(rq##S[j_][k_]) : bflo(rq##S[j_][k_]); \
                            a2_[hh_] = qv_ * __builtin_amdgcn_exp2f(fminf(bt_ - br_[c_], 115.f)); i2_[hh_] = qv_ * __builtin_amdgcn_exp2f(bt_); k2_[hh_] = key_ * __builtin_amdgcn_exp2f(fminf(br_[c_] - bt_, 115.f)); h2_[hh_] = key_ * __builtin_amdgcn_exp2f(bl_[c_] - bt_); } \
                        oq_[k_] = pk2(a2_[0], a2_[1]); oi_[k_] = pk2(i2_[0], i2_[1]); ok_[k_] = pk2(k2_[0], k2_[1]); oh_[k_] = pk2(h2_[0], h2_[1]); } \
                    *(LAS u32x4*)((LAS bf16*)(F.lds + O_QT) + t_ * 136 + 8 * lp) = oq_; *(LAS u32x4*)((LAS bf16*)(F.lds + O_KT) + t_ * 136 + 8 * lp) = ok_; \
                    *(LAS u32x4*)((LAS bf16*)ib_ + t_ * 136 + 8 * lp) = oi_; *(LAS u32x4*)((LAS bf16*)(ib_ + 17408) + t_ * 136 + 8 * lp) = oh_; } \
                *(LAS u32x4*)((LAS bf16*)(ib_ + 34816) + (ptid >> 2) * 40 + 8 * (ptid & 3)) = vcur_; \
                if (g4 == 0) { LAS float* sbl_ = (LAS float*)(F.lds + O_SBL) + ((cc) & 1) * 128; _Pragma("unroll") for (int k_ = 0; k_ < 8; ++k_) sbl_[8 * lp + k_] = __builtin_amdgcn_exp2f(bl_[k_]); } } while (0)
            HG_LOAD(0, 0); HG_LOAD(1, 1);
#define HG_ASTEP(pp, S) do { if (!(PROBE & 2)) HG_PREP(pp, S); else { gflag_wait(QKR + 1, 4u * (unsigned)(pp)); if ((pp) >= 2) gflag_wait(QKR + 2, 4u * (unsigned)((pp) - 1)); } \
                gflag_post(QKR, lane); if ((pp) + 2 < NCH) HG_LOAD((pp) + 2, S); } while (0)
            for (int p = 0; p < NCH; p += 2) { HG_ASTEP(p, 0); HG_ASTEP(p + 1, 1); }
#undef HG_ASTEP
#undef HG_LOAD
#undef HG_PREP
        } else {
            const int a = w;
#define HG_ATILE(cc, ti_, sj_) do { LAS bf16* as_ = (LAS bf16*)(F.lds + O_AS + ((cc) & 1) * 9216); f32x4 acc_ = {0.f, 0.f, 0.f, 0.f}; \
                acc_ = mm16<128>(acc_, (const LAS bf16*)(F.lds + O_QT) + 16 * (ti_) * 136, 136, (const LAS bf16*)(F.lds + O_KT) + 16 * (sj_) * 136, 136, lane); \
                _Pragma("unroll") for (int i_ = 0; i_ < 4; ++i_) { const int t_ = 16 * (ti_) + 4 * q + i_, s_ = 16 * (sj_) + r; as_[t_ * 72 + s_] = (bf16)f2bf(s_ <= t_ ? acc_[i_] : 0.f); } } while (0)
#define HG_ATILES(cc) do { if (a == 0) { HG_ATILE(cc, 3, 0); HG_ATILE(cc, 3, 1); HG_ATILE(cc, 0, 0); } else if (a == 1) { HG_ATILE(cc, 3, 2); HG_ATILE(cc, 3, 3); HG_ATILE(cc, 1, 0); } \
                else if (a == 2) { HG_ATILE(cc, 2, 0); HG_ATILE(cc, 2, 1); } else { HG_ATILE(cc, 2, 2); HG_ATILE(cc, 1, 1); } } while (0)

            f32x4 Sst[2][2];
#pragma unroll
            for (int i = 0; i < 2; ++i) { Sst[i][0] = (f32x4){0.f, 0.f, 0.f, 0.f}; Sst[i][1] = Sst[i][0]; }
            gflag_wait(QKR, 4u); HG_ATILES(0); gflag_post(QKR + 1, lane);
            for (int c = 0; c < NCH; ++c) {
                gflag_wait(QKR + 1, 4u * (unsigned)(c + 1)); gflag_wait(QKR + 2, 4u * (unsigned)c);
                if (!(PROBE & 1)) {
                const LAS unsigned char* ib = F.lds + O_IN + (c & 1) * INB;
                const LAS bf16* QI = (const LAS bf16*)ib; const LAS bf16* KH = (const LAS bf16*)(ib + 17408); const LAS bf16* VS = (const LAS bf16*)(ib + 34816);
                const LAS bf16* AS = (const LAS bf16*)(F.lds + O_AS + (c & 1) * 9216); const LAS bf16* STr = (const LAS bf16*)(F.lds + O_ST + (c & 1) * 8704); LAS bf16* STw = (LAS bf16*)(F.lds + O_ST + ((c + 1) & 1) * 8704);
                LAS bf16* HO = (LAS bf16*)(F.lds + O_HO); const LAS float* sbl = (const LAS float*)(F.lds + O_SBL) + (c & 1) * 128;
                {   const int ti = w; f32x4 o[2]; o[0] = (f32x4){0.f, 0.f, 0.f, 0.f}; o[1] = o[0];
#pragma unroll
                    for (int kk = 0; kk < 2; ++kk) { const bf16x8 af = row_frag(AS + 16 * ti * 72, 72, 32 * kk, lane);
#pragma unroll
                        for (int vj = 0; vj < 2; ++vj) o[vj] = __builtin_amdgcn_mfma_f32_16x16x32_bf16(af, tr_frag(VS, 40, 32 * kk, 16 * vj, lane), o[vj], 0, 0, 0); }
#pragma unroll
                    for (int kk = 0; kk < 4; ++kk) { const bf16x8 qf = row_frag(QI + 16 * ti * 136, 136, 32 * kk, lane);
#pragma unroll
                        for (int vj = 0; vj < 2; ++vj) o[vj] = __builtin_amdgcn_mfma_f32_16x16x32_bf16(qf, row_frag(STr + 16 * vj * 136, 136, 32 * kk, lane), o[vj], 0, 0, 0); }
#pragma unroll
                    for (int i = 0; i < 4; ++i)
#pragma unroll
                        for (int vj = 0; vj < 2; ++vj) HO[(16 * ti + 4 * q + i) * 40 + 16 * vj + r] = (bf16)f2bf(o[vj][i]);
                    LDS_WAIT();
                    { const int t_ = 16 * ti + (lane >> 2); const int row = seq_row(b, dir, c * 64 + t_); *(GAS u32x4*)(HS + (size_t)row * 1024 + h * 128 + vs * 32 + 8 * (lane & 3)) = *(const LAS u32x4*)(HO + t_ * 40 + 8 * (lane & 3)); } }
                {   bf16x8 av[2][2];
#pragma unroll
                    for (int kk = 0; kk < 2; ++kk) { av[0][kk] = tr_frag(VS, 40, 32 * kk, 0, lane); av[1][kk] = tr_frag(VS, 40, 32 * kk, 16, lane); }
#pragma unroll
                    for (int jj = 0; jj < 2; ++jj) { const int kj = 2 * w + jj; const float sb = sbl[16 * kj + r]; Sst[0][jj] = Sst[0][jj] * sb; Sst[1][jj] = Sst[1][jj] * sb;
#pragma unroll
                        for (int kk = 0; kk < 2; ++kk) { const bf16x8 kf = tr_frag(KH, 136, 32 * kk, 16 * kj, lane);
                            Sst[0][jj] = __builtin_amdgcn_mfma_f32_16x16x32_bf16(av[0][kk], kf, Sst[0][jj], 0, 0, 0); Sst[1][jj] = __builtin_amdgcn_mfma_f32_16x16x32_bf16(av[1][kk], kf, Sst[1][jj], 0, 0, 0); }
#pragma unroll
                        for (int vi = 0; vi < 2; ++vi)
#pragma unroll
                            for (int i = 0; i < 4; ++i) STw[(16 * vi + 4 * q + i) * 136 + 16 * kj + r] = (bf16)f2bf(Sst[vi][jj][i]); } }
                }
                gflag_post(QKR + 2, lane);
                if (c + 1 < NCH) { gflag_wait(QKR, 4u * (unsigned)(c + 2)); HG_ATILES(c + 1); gflag_post(QKR + 1, lane); }
            }
#undef HG_ATILE
#undef HG_ATILES

        }
    }
}

template <int PROBE> PHASE_FN void ml_scan3_phase(Frame F, const GAS bf16* QK, const GAS bf16* V, const GAS float* GATES, GAS bf16* HS) {
    constexpr int OFF_Q = 0, OFF_K = 17408, OFF_V = 34816, OFF_VW = 40960, OFF_WKR = 46080, INB = 48384;
    constexpr int O_SS = 2 * INB, O_CS = O_SS + 2 * 9216, O_HO = O_CS + 2 * 13056, O_SC = O_HO + 2 * 5120, O_CTR = O_SC + 4 * 1344; static_assert(O_CTR + 16 <= MISC_OFF, "ml_scan3 LDS map");
    LAS float* SCb = (LAS float*)(F.lds + O_SC);
    LAS unsigned* CT = (LAS unsigned*)(F.lds + O_CTR);
    const int tid = F.tid, w = F.wave; int lane = F.lane, r = lane & 15, q = lane >> 4;
    constexpr int NCH = T / 64;
    for (int unit = F.bid; unit < 256; unit += F.G) {
        const int un = (F.G == 256) ? ((((unit & 7) * 8 + (unit >> 5)) << 2) | ((unit >> 3) & 3)) : unit;
        const int vs = un & 3, dir = (un >> 2) & 1, h = (un >> 3) & 7, b = un >> 6;
        __syncthreads();
        for (int i = tid; i < (O_CTR + 16) / 4; i += NTHR) ((LAS unsigned*)F.lds)[i] = 0u;
        __syncthreads();
        if (tid < 128) ((LAS bf16*)(F.lds + (tid >> 6) * INB + OFF_V))[(tid & 63) * 48 + 32] = (bf16)0x3f80;
        __syncthreads();
        if (w >= 4) {
            const int a = w - 4, ptid = tid - 256; int lrow = ptid >> 2, lp = ptid & 3;
#define ML_RELAUNDER() asm volatile("" : "+v"(lrow), "+v"(lp), "+v"(lane), "+v"(r), "+v"(q))
            float m_run = 0.f; u32x4 rq0[4], rk0[4], rv0, rq1[4], rk1[4], rv1; float rig = 0.f, rlf = 0.f;
#define ML_LOAD(cc, S) do { const int row_ = seq_row(b, dir, (cc) * 64 + lrow); const GAS bf16* qp_ = QK + (size_t)row_ * 2048 + h * 128; \
                _Pragma("unroll") for (int j_ = 0; j_ < 4; ++j_) { rq##S[j_] = *(const GAS u32x4*)(qp_ + 8 * (lp + 4 * j_)); rk##S[j_] = *(const GAS u32x4*)(qp_ + 1024 + 8 * (lp + 4 * j_)); } \
                rv##S = *(const GAS u32x4*)(V + (size_t)row_ * 1024 + h * 128 + vs * 32 + 8 * lp); } while (0)
#define ML_GLOAD(cc) do { const int grow_ = seq_row(b, dir, (cc) * 64 + lane); rig = GATES[(size_t)grow_ * 32 + dir * 16 + h]; rlf = GATES[(size_t)grow_ * 32 + dir * 16 + 8 + h]; } while (0)
#define ML_SCALARS(cc) do { const float lf_ = logsigmoid_f(rlf); const float bc_ = wave_scan_add(lf_); const float u_ = rig - bc_; const float pm_ = wave_scan_max(u_); \
                const float cc_ = fmaxf(m_run, pm_), blast_ = lane63(bc_), pmall_ = lane63(pm_), mnew_ = blast_ + fmaxf(m_run, pmall_); LAS float* sc_ = SCb + ((cc) & 3) * 336; \
                sc_[lane] = u_; sc_[64 + lane] = cc_; sc_[128 + lane] = __expf(m_run - cc_); sc_[192 + lane] = __expf(-(bc_ + cc_)); sc_[256 + lane] = __expf(blast_ + u_ - mnew_); \
                if (lane == 0) sc_[320] = __expf(blast_ + m_run - mnew_); m_run = mnew_; } while (0)
#define ML_STAGE(cc, S) do { LAS unsigned char* ib_ = F.lds + ((cc) & 1) * INB; const LAS float* sc_ = SCb + ((cc) & 3) * 336; \
                _Pragma("unroll") for (int j_ = 0; j_ < 4; ++j_) { *(LAS u32x4*)((LAS bf16*)(ib_ + OFF_Q) + lrow * 136 + 8 * (lp + 4 * j_)) = rq##S[j_]; *(LAS u32x4*)((LAS bf16*)(ib_ + OFF_K) + lrow * 136 + 8 * (lp + 4 * j_)) = rk##S[j_]; } \
                const float wk_ = sc_[256 + lrow]; u32x4 vw_; _Pragma("unroll") for (int j_ = 0; j_ < 4; ++j_) vw_[j_] = pk2(bflo(rv##S[j_]) * wk_, bfhi(rv##S[j_]) * wk_); \
                *(LAS u32x4*)((LAS bf16*)(ib_ + OFF_V) + lrow * 48 + 8 * lp) = rv##S; *(LAS u32x4*)((LAS bf16*)(ib_ + OFF_VW) + lrow * 40 + 8 * lp) = vw_; \
                if (ptid < 64) ((LAS bf16*)(ib_ + OFF_WKR))[ptid] = (bf16)f2bf(sc_[256 + ptid]); } while (0)
#define ML_STILE(cc, ti_, sj_) do { const LAS unsigned char* ib_ = F.lds + ((cc) & 1) * INB; const LAS float* sc_ = SCb + ((cc) & 3) * 336; LAS bf16* ss_ = (LAS bf16*)(F.lds + O_SS + ((cc) & 1) * 9216); \
                f32x4 acc_ = {0.f, 0.f, 0.f, 0.f}; acc_ = mm16<128>(acc_, (const LAS bf16*)(ib_ + OFF_Q) + 16 * (ti_) * 136, 136, (const LAS bf16*)(ib_ + OFF_K) + 16 * (sj_) * 136, 136, lane); \
                const int s_ = 16 * (sj_) + r; const float us_ = sc_[s_]; \
                _Pragma("unroll") for (int i_ = 0; i_ < 4; ++i_) { const int t_ = 16 * (ti_) + 4 * q + i_; ss_[t_ * 72 + s_] = (bf16)f2bf((s_ <= t_) ? acc_[i_] * __expf(us_ - sc_[64 + t_]) : 0.f); } } while (0)
#define ML_STILES_A(cc) do { if (a == 0) { ML_STILE(cc, 3, 0); ML_STILE(cc, 3, 1); } else if (a == 1) { ML_STILE(cc, 3, 2); } else if (a == 2) { ML_STILE(cc, 3, 3); } else { ML_STILE(cc, 0, 0); } } while (0)
            ML_LOAD(0, 0); ML_LOAD(1, 1);
            if (a == 3) { ML_GLOAD(0); ML_SCALARS(0); gflag_post(CT + 3, lane); ML_GLOAD(1); ML_SCALARS(1); gflag_post(CT + 3, lane); ML_GLOAD(2); }
#define ML_ASTEP(pp, S) do { ML_RELAUNDER(); \
                if ((pp) >= 2) gflag_wait(CT + 2, 4u * (unsigned)((pp) - 1));              \
                gflag_wait(CT + 3, (unsigned)((pp) + 1));                                  \
                if (!(PROBE & 2)) ML_STAGE(pp, S); \
                gflag_post(CT, lane); \
                if ((pp) + 2 < NCH && !(PROBE & 2)) ML_LOAD((pp) + 2, S); \
                gflag_wait(CT, 4u * (unsigned)((pp) + 1));                                 \
                if (!(PROBE & 2)) ML_STILES_A(pp); \
                gflag_post(CT + 1, lane); \
                if (a == 3 && (pp) + 2 < NCH) { ML_SCALARS((pp) + 2); gflag_post(CT + 3, lane); if ((pp) + 3 < NCH) ML_GLOAD((pp) + 3); } } while (0)
            for (int p = 0; p < NCH; p += 2) { ML_ASTEP(p, 0); ML_ASTEP(p + 1, 1); }
#undef ML_ASTEP
#undef ML_STILE
#undef ML_STILES_A
#undef ML_LOAD
#undef ML_RELAUNDER
#undef ML_GLOAD
#undef ML_SCALARS
#undef ML_STAGE
        } else {
            const int a = w;
#define ML_STILE(cc, ti_, sj_) do { const LAS unsigned char* ib_ = F.lds + ((cc) & 1) * INB; const LAS float* sc_ = SCb + ((cc) & 3) * 336; LAS bf16* ss_ = (LAS bf16*)(F.lds + O_SS + ((cc) & 1) * 9216); \
                f32x4 acc_ = {0.f, 0.f, 0.f, 0.f}; acc_ = mm16<128>(acc_, (const LAS bf16*)(ib_ + OFF_Q) + 16 * (ti_) * 136, 136, (const LAS bf16*)(ib_ + OFF_K) + 16 * (sj_) * 136, 136, lane); \
                const int s_ = 16 * (sj_) + r; const float us_ = sc_[s_]; \
                _Pragma("unroll") for (int i_ = 0; i_ < 4; ++i_) { const int t_ = 16 * (ti_) + 4 * q + i_; ss_[t_ * 72 + s_] = (bf16)f2bf((s_ <= t_) ? acc_[i_] * __expf(us_ - sc_[64 + t_]) : 0.f); } } while (0)
#define ML_STILES(cc) do { if (a == 0) { ML_STILE(cc, 2, 0); ML_STILE(cc, 2, 1); } else if (a == 1) { ML_STILE(cc, 2, 2); } else if (a == 2) { ML_STILE(cc, 1, 0); } else { ML_STILE(cc, 1, 1); } } while (0)

            f32x4 Cst[2][2], Nst[2];
#pragma unroll
            for (int i = 0; i < 2; ++i) { Nst[i] = (f32x4){0.f, 0.f, 0.f, 0.f}; Cst[i][0] = Nst[i]; Cst[i][1] = Nst[i]; }
            gflag_wait(CT, 4u); ML_STILES(0); gflag_post(CT + 1, lane);
            for (int c = 0; c < NCH; ++c) {
                gflag_wait(CT + 1, 8u * (unsigned)(c + 1)); gflag_wait(CT + 2, 4u * (unsigned)c);
                if (!(PROBE & 1)) {
                const LAS unsigned char* ib = F.lds + (c & 1) * INB;
                const LAS bf16* QS = (const LAS bf16*)(ib + OFF_Q); const LAS bf16* KS = (const LAS bf16*)(ib + OFF_K); const LAS bf16* VS = (const LAS bf16*)(ib + OFF_V); const LAS bf16* VW = (const LAS bf16*)(ib + OFF_VW); const LAS bf16* WKR = (const LAS bf16*)(ib + OFF_WKR);
                const LAS bf16* SS = (const LAS bf16*)(F.lds + O_SS + (c & 1) * 9216); const LAS bf16* CSr = (const LAS bf16*)(F.lds + O_CS + (c & 1) * 13056); LAS bf16* CSw = (LAS bf16*)(F.lds + O_CS + ((c + 1) & 1) * 13056);
                LAS bf16* HO = (LAS bf16*)(F.lds + O_HO + (c & 1) * 5120); const LAS float* sc = SCb + (c & 3) * 336;
                {   const int ti = w; f32x4 a1[2], a2[2], a3 = {0.f, 0.f, 0.f, 0.f}, a1x = a3;
#pragma unroll
                    for (int vj = 0; vj < 2; ++vj) { a1[vj] = (f32x4){0.f, 0.f, 0.f, 0.f}; a2[vj] = a1[vj]; }
#pragma unroll
                    for (int kk = 0; kk < 2; ++kk) { const bf16x8 sf = row_frag(SS + 16 * ti * 72, 72, 32 * kk, lane);
#pragma unroll
                        for (int vj = 0; vj < 2; ++vj) a1[vj] = __builtin_amdgcn_mfma_f32_16x16x32_bf16(sf, tr_frag(VS, 48, 32 * kk, 16 * vj, lane), a1[vj], 0, 0, 0);
                        a1x = __builtin_amdgcn_mfma_f32_16x16x32_bf16(sf, tr_frag(VS, 48, 32 * kk, 32, lane), a1x, 0, 0, 0); }
#pragma unroll
                    for (int kk = 0; kk < 4; ++kk) { const bf16x8 qf = row_frag(QS + 16 * ti * 136, 136, 32 * kk, lane);
#pragma unroll
                        for (int vj = 0; vj < 2; ++vj) a2[vj] = __builtin_amdgcn_mfma_f32_16x16x32_bf16(qf, row_frag(CSr + 16 * vj * 136, 136, 32 * kk, lane), a2[vj], 0, 0, 0);
                        a3 = __builtin_amdgcn_mfma_f32_16x16x32_bf16(qf, row_frag(CSr + 32 * 136, 136, 32 * kk, lane), a3, 0, 0, 0); }
#pragma unroll
                    for (int i = 0; i < 4; ++i) { const int t_ = 16 * ti + 4 * q + i; const float wi = sc[128 + t_];
                        const float den = row16_sum(a1x[i] + wi * a3[i]); const float rd = __builtin_amdgcn_rcpf(fmaxf(fabsf(den), sc[192 + t_]));
#pragma unroll
                        for (int vj = 0; vj < 2; ++vj) HO[t_ * 40 + 16 * vj + r] = (bf16)f2bf((a1[vj][i] + wi * a2[vj][i]) * rd); }
                    LDS_WAIT();
                    { const int t_ = 16 * ti + (lane >> 2); const int row_ = seq_row(b, dir, c * 64 + t_);
                      *(GAS u32x4*)(HS + ((size_t)dir * NTOK + row_) * 1024 + h * 128 + vs * 32 + 8 * (lane & 3)) = *(const LAS u32x4*)(HO + t_ * 40 + 8 * (lane & 3)); } }
                {   const float wprev = sc[320]; bf16x8 av[2][2], wf[2];
#pragma unroll
                    for (int kk = 0; kk < 2; ++kk) { av[0][kk] = tr_frag(VW, 40, 32 * kk, 0, lane); av[1][kk] = tr_frag(VW, 40, 32 * kk, 16, lane); wf[kk] = row_frag(WKR, 72, 32 * kk, lane); }
#pragma unroll
                    for (int jj = 0; jj < 2; ++jj) { const int dj = 2 * w + jj; Cst[0][jj] = Cst[0][jj] * wprev; Cst[1][jj] = Cst[1][jj] * wprev; Nst[jj] = Nst[jj] * wprev;
#pragma unroll
                        for (int kk = 0; kk < 2; ++kk) { const bf16x8 kf = tr_frag(KS, 136, 32 * kk, 16 * dj, lane);
                            Cst[0][jj] = __builtin_amdgcn_mfma_f32_16x16x32_bf16(av[0][kk], kf, Cst[0][jj], 0, 0, 0); Cst[1][jj] = __builtin_amdgcn_mfma_f32_16x16x32_bf16(av[1][kk], kf, Cst[1][jj], 0, 0, 0);
                            Nst[jj] = __builtin_amdgcn_mfma_f32_16x16x32_bf16(wf[kk], kf, Nst[jj], 0, 0, 0); }
#pragma unroll
                        for (int vi = 0; vi < 2; ++vi)
#pragma unroll
                            for (int i = 0; i < 4; ++i) CSw[(16 * vi + 4 * q + i) * 136 + 16 * dj + r] = (bf16)f2bf(Cst[vi][jj][i]);
                        if (q == 0) CSw[32 * 136 + 16 * dj + r] = (bf16)f2bf(Nst[jj][0]); } }
                }
                gflag_post(CT + 2, lane);
                if (c + 1 < NCH) { gflag_wait(CT, 4u * (unsigned)(c + 2)); ML_STILES(c + 1); gflag_post(CT + 1, lane); }
            }
#undef ML_STILE
#undef ML_STILES

        }
    }
}


constexpr int R2_NS = 8, R2_SLOT = 13312;
constexpr int R2_NK = 0, R2_RT = 2304, R2_AKL = 4608, R2_KDL = 6912, R2_TM = 9216, R2_PP = 10496, R2_VI = 11776, R2_GL = 13056;
constexpr int R2_W2T = 0, R2_A2T = 9216, R2_SVEC = 18432, R2_FLAG = 19712, R2_RING = 20480;
static_assert(R2_RING + R2_NS * R2_SLOT <= MISC_OFF, "rw_scan2 LDS map");
__device__ __forceinline__ unsigned lds_ld(const LAS unsigned* p) { return (unsigned)__builtin_amdgcn_readfirstlane((int)__hip_atomic_load(p, __ATOMIC_RELAXED, __HIP_MEMORY_SCOPE_WORKGROUP)); }
__device__ __forceinline__ f32x4 mfma16(s16x4 a, s16x4 b, f32x4 c) { return __builtin_amdgcn_mfma_f32_16x16x16bf16_1k(a, b, c, 0, 0, 0); }
__device__ __forceinline__ s16x4 pk4(float a, float b, float c, float d) { u32x2 v; v.x = pk2(a, b); v.y = pk2(c, d); return __builtin_bit_cast(s16x4, v); }
__device__ __forceinline__ s16x4 pk4(f32x4 v) { return pk4(v[0], v[1], v[2], v[3]); }
__device__ __forceinline__ s16x4 tr4(const LAS bf16* X, int ld, int k0, int n0, int lane) { const int g = lane >> 4, a = (lane & 15) >> 2, p = lane & 3; return __builtin_amdgcn_ds_read_tr16_b64_v4i16((LAS s16x4*)(X + (k0 + 4 * g + a) * ld + n0 + 4 * p)); }
__device__ __forceinline__ f32x4 mmT(f32x4 X, f32x4 Y, f32x4 C) {
#pragma unroll
    for (int i = 0; i < 4; ++i) C = __builtin_amdgcn_mfma_f32_16x16x4f32(X[i], Y[i], C, 0, 0, 0);
    return C; }
__device__ __forceinline__ float qsum4(float x) { float a = x, b = x; asm volatile("s_nop 1\n\tv_permlane16_swap_b32 %0, %1\n\ts_nop 1" : "+v"(a), "+v"(b)); const float y = a + b; float c = y, d = y; asm volatile("s_nop 1\n\tv_permlane32_swap_b32 %0, %1\n\ts_nop 1" : "+v"(c), "+v"(d)); return c + d; }
__device__ __forceinline__ float rdlane(float v, int l) { return __builtin_bit_cast(float, __builtin_amdgcn_readlane(__builtin_bit_cast(int, v), l)); }
template <int PROBE> PHASE_FN void rw_scan2_phase(Frame F, const GAS bf16* Rr, const GAS bf16* Kk, const GAS bf16* Vv, const GAS bf16* WH, const GAS bf16* AH, GAS bf16* O  , GAS float* BETA  ) {
    LAS bf16* W2T = (LAS bf16*)(F.lds + R2_W2T); LAS bf16* A2T = (LAS bf16*)(F.lds + R2_A2T); LAS float* SVEC = (LAS float*)(F.lds + R2_SVEC);
    LAS unsigned* ready = (LAS unsigned*)(F.lds + R2_FLAG); LAS unsigned* done = ready + 8; LAS unsigned* nextc = ready + 12;
    const int tid = F.tid, w = F.wave;
    constexpr int NCK = T / 16;
    for (int unit = F.bid; unit < 256; unit += F.G) {
        const int un = (F.G == 256) ? ((((unit & 7) * 16 + (unit >> 4)) << 1) | ((unit >> 3) & 1)) : unit;
        const int half = un & 1, dir = (un >> 1) & 1, h = (un >> 2) & 15, b = un >> 6;
        __syncthreads();
        for (int i = tid; i < 4096; i += NTHR) { const int l = i >> 6, jn = i & 63; W2T[jn * 72 + l] = (bf16)f2bf(-1.4426950408889634f * INP(IN_RW_W2)[((size_t)(dir * 64 + l)) * 1024 + h * 64 + jn]); A2T[jn * 72 + l] = (bf16)f2bf(-1.4426950408889634f * INP(IN_RW_A2)[((size_t)(dir * 64 + l)) * 1024 + h * 64 + jn]); }
        if (tid < 64) { SVEC[tid] = -1.4426950408889634f * INP(IN_RW_W0)[dir * 1024 + h * 64 + tid]; SVEC[64 + tid] = -1.4426950408889634f * INP(IN_RW_A0)[dir * 1024 + h * 64 + tid]; SVEC[128 + tid] = INP(IN_RW_KK)[h * 64 + tid];
            SVEC[192 + tid] = INP(IN_RW_KA)[h * 64 + tid]; SVEC[256 + tid] = INP(IN_RW_RK)[h * 64 + tid]; }
        if (tid < 16) ready[tid] = 0u;
        __syncthreads();
        if (w >= 2) {
            f32x4 ckk[4], cka[4], crk[4];
            { const int q0 = F.lane >> 4;
#pragma unroll
              for (int kt = 0; kt < 4; ++kt) { const int k0 = 16 * kt + 4 * q0; ckk[kt] = *(const LAS f32x4*)(SVEC + 128 + k0); cka[kt] = *(const LAS f32x4*)(SVEC + 192 + k0); crk[kt] = *(const LAS f32x4*)(SVEC + 256 + k0); } }
            u32x2 gr[4], gk[4]; u32x4 gw[2], ga[2], gv;
#define R2_LOAD(cc) do { const int r_ = F.lane & 15, q_ = F.lane >> 4; const size_t row_ = (size_t)seq_row(b, dir, (cc) * 16 + r_); \
                _Pragma("unroll") for (int kt = 0; kt < 4; ++kt) { gr[kt] = *(const GAS u32x2*)(Rr + row_ * 1024 + h * 64 + 16 * kt + 4 * q_); gk[kt] = *(const GAS u32x2*)(Kk + row_ * 1024 + h * 64 + 16 * kt + 4 * q_); } \
                _Pragma("unroll") for (int kk = 0; kk < 2; ++kk) { gw[kk] = *(const GAS u32x4*)(WH + row_ * 128 + dir * 64 + 32 * kk + 8 * q_); ga[kk] = *(const GAS u32x4*)(AH + row_ * 128 + dir * 64 + 32 * kk + 8 * q_); } \
                gv = *(const GAS u32x4*)(Vv + row_ * 1024 + h * 64 + half * 32 + 8 * q_); } while (0)
#define R2_GRAB(dst) do { unsigned v_ = 0u; if (F.lane == 0) v_ = __hip_atomic_fetch_add(nextc, 1u, __ATOMIC_RELAXED, __HIP_MEMORY_SCOPE_WORKGROUP); dst = __builtin_amdgcn_readfirstlane((int)v_); } while (0)
            int c, cn; R2_GRAB(c);
            if (c < NCK) R2_LOAD(c);
            for (; c < NCK; c = cn) {
                R2_GRAB(cn);
                int lane_ = F.lane; asm volatile("" : "+v"(lane_)); const int lane = lane_, r = lane & 15, q = lane >> 4;
                LAS unsigned char* sl = F.lds + R2_RING + (c & (R2_NS - 1)) * R2_SLOT;
                LAS bf16* NKs = (LAS bf16*)(sl + R2_NK); LAS bf16* RTs = (LAS bf16*)(sl + R2_RT); LAS bf16* AKL = (LAS bf16*)(sl + R2_AKL); LAS bf16* KDL = (LAS bf16*)(sl + R2_KDL);
                LAS bf16* TM = (LAS bf16*)(sl + R2_TM); LAS bf16* PP = (LAS bf16*)(sl + R2_PP); LAS bf16* VI = (LAS bf16*)(sl + R2_VI); LAS float* GL = (LAS float*)(sl + R2_GL);
                if (c >= R2_NS) { const unsigned need = (unsigned)(c - R2_NS + 1); while (lds_ld(done) < need || lds_ld(done + 1) < need) __builtin_amdgcn_s_sleep(1); }
                asm volatile("" ::: "memory");
                if (!(PROBE & 2)) {
                VM_WAIT();
                const u32x2 pr0 = gr[0], pr1 = gr[1], pr2 = gr[2], pr3 = gr[3], pk0 = gk[0], pk1 = gk[1], pk2_ = gk[2], pk3 = gk[3];
                const bf16x8 whf0 = __builtin_bit_cast(bf16x8, gw[0]), whf1 = __builtin_bit_cast(bf16x8, gw[1]), ahf0 = __builtin_bit_cast(bf16x8, ga[0]), ahf1 = __builtin_bit_cast(bf16x8, ga[1]);
                *(LAS u32x4*)(VI + r * 40 + 8 * q) = gv;
                asm volatile("" ::: "memory");
                if (cn < NCK && !(PROBE & 32)) R2_LOAD(cn);
                f32x4 accw[4], acca[4];
#pragma unroll
                for (int kh = 0; kh < 2; ++kh) { bf16x8 fw[2][2], fa[2][2];
#pragma unroll
                    for (int k2 = 0; k2 < 2; ++k2) { const int kt = 2 * kh + k2; accw[kt] = *(const LAS f32x4*)(SVEC + 16 * kt + 4 * q); acca[kt] = *(const LAS f32x4*)(SVEC + 64 + 16 * kt + 4 * q);
#pragma unroll
                        for (int kk = 0; kk < 2; ++kk) { fw[k2][kk] = *(const LAS bf16x8*)(W2T + (16 * kt + r) * 72 + 32 * kk + 8 * q); fa[k2][kk] = *(const LAS bf16x8*)(A2T + (16 * kt + r) * 72 + 32 * kk + 8 * q); } }
                    LDS_WAIT();
#pragma unroll
                    for (int k2 = 0; k2 < 2; ++k2) { const int kt = 2 * kh + k2;
                        accw[kt] = __builtin_amdgcn_mfma_f32_16x16x32_bf16(fw[k2][0], whf0, accw[kt], 0, 0, 0); accw[kt] = __builtin_amdgcn_mfma_f32_16x16x32_bf16(fw[k2][1], whf1, accw[kt], 0, 0, 0);
                        acca[kt] = __builtin_amdgcn_mfma_f32_16x16x32_bf16(fa[k2][0], ahf0, acca[kt], 0, 0, 0); acca[kt] = __builtin_amdgcn_mfma_f32_16x16x32_bf16(fa[k2][1], ahf1, acca[kt], 0, 0, 0); } }
                const u32x2 prk[4] = {pr0, pr1, pr2, pr3}, pkk[4] = {pk0, pk1, pk2_, pk3};
                float rn;
                { float ssq = 0.f;
#pragma unroll
                  for (int kt = 0; kt < 4; ++kt) { const float x0 = bflo(pkk[kt].x) * ckk[kt][0], x1 = bfhi(pkk[kt].x) * ckk[kt][1], x2 = bflo(pkk[kt].y) * ckk[kt][2], x3 = bfhi(pkk[kt].y) * ckk[kt][3]; ssq += x0 * x0 + x1 * x1 + x2 * x2 + x3 * x3; }
                  rn = __builtin_amdgcn_rsqf(fmaxf(qsum4(ssq), 1e-24f)); }
                float bet = 0.f; f32x4 g1 = {0.f, 0.f, 0.f, 0.f}, g2 = g1, g3 = g1, g4 = g1, g1t = g1;
                if (PROBE & 8) { g1 = accw[0] + acca[1]; g2 = accw[1] + acca[0]; g3 = accw[2] + acca[3]; g4 = accw[3]; g1t = acca[2]; bet = rn; } else
#pragma unroll
                for (int kt = 0; kt < 4; ++kt) {
                    const int k0 = 16 * kt + 4 * q;
                    const float kv[4] = {bflo(pkk[kt].x), bfhi(pkk[kt].x), bflo(pkk[kt].y), bfhi(pkk[kt].y)}, rv[4] = {bflo(prk[kt].x), bfhi(prk[kt].x), bflo(prk[kt].y), bfhi(prk[kt].y)};
                    float nk[4], rt[4], aki[4], kdi[4]; f32x4 glv;
#pragma unroll
                    for (int i = 0; i < 4; ++i) { const float lw = -0.8750387749145276f * __builtin_amdgcn_rcpf(1.0f + __builtin_amdgcn_exp2f(accw[kt][i]));
                        float cs = lw; cs += dpp_keep<0x111, 0xF>(0.f, cs); cs += dpp_keep<0x112, 0xF>(0.f, cs); cs += dpp_keep<0x114, 0xF>(0.f, cs); cs += dpp_keep<0x118, 0xF>(0.f, cs);
                        const float e_in = __builtin_amdgcn_exp2f(cs), e_iv = __builtin_amdgcn_rcpf(e_in), e_ex = dpp_keep<0x111, 0xF>(1.0f, e_in);
                        const float av = __builtin_amdgcn_rcpf(1.0f + __builtin_amdgcn_exp2f(acca[kt][i])), kkn = kv[i] * ckk[kt][i] * rn, akk = kkn * av, kd = kv[i] * __builtin_fmaf(av, cka[kt][i], 1.0f - cka[kt][i]);
                        bet += rv[i] * kd * crk[kt][i];
                        nk[i] = kkn * e_ex; rt[i] = rv[i] * e_in; aki[i] = akk * e_iv; kdi[i] = kd * e_iv; glv[i] = e_in; }
                    const s16x4 nkp = pk4(nk[0], nk[1], nk[2], nk[3]), rtp = pk4(rt[0], rt[1], rt[2], rt[3]), akip = pk4(aki[0], aki[1], aki[2], aki[3]), kdip = pk4(kdi[0], kdi[1], kdi[2], kdi[3]);
                    *(LAS s16x4*)(NKs + r * 72 + k0) = nkp; *(LAS s16x4*)(RTs + r * 72 + k0) = rtp; *(LAS s16x4*)(AKL + r * 72 + k0) = akip; *(LAS s16x4*)(KDL + r * 72 + k0) = kdip;
                    if (r == 15) *(LAS f32x4*)(GL + k0) = glv;
                    g1 = mfma16(nkp, akip, g1); g2 = mfma16(nkp, kdip, g2); g3 = mfma16(rtp, akip, g3); g4 = mfma16(rtp, kdip, g4); g1t = mfma16(akip, nkp, g1t); }
                bet = qsum4(bet);
                if (q == 0 && half == 0) BETA[((size_t)dir * NTOK + seq_row(b, dir, c * 16 + r)) * 16 + h] = bet;
                f32x4 Nn, Qn, W1;
#pragma unroll
                for (int i = 0; i < 4; ++i) { const int t_ = 4 * q + i; PP[t_ * 40 + r] = (bf16)f2bf(r <= t_ ? g3[i] : 0.f); PP[t_ * 40 + 16 + r] = (bf16)f2bf(r <= t_ ? g4[i] : 0.f); g2[i] = r < t_ ? g2[i] : 0.f;
                    Nn[i] = r < t_ ? -g1[i] : 0.f; Qn[i] = t_ < r ? -g1t[i] : 0.f; W1[i] = Qn[i] + (t_ == r ? 1.0f : 0.f); }
                if (PROBE & 4) { *(LAS s16x4*)(TM + r * 40 + 4 * q) = pk4(Nn + Qn + W1 + g2); } else
                { const f32x4 z4 = {0.f, 0.f, 0.f, 0.f};
                  const f32x4 Q2 = mmT(Nn, Qn, z4), N2 = mmT(Qn, Nn, z4); const f32x4 W2 = mmT(N2, W1, W1);
                  const f32x4 Q4 = mmT(N2, Q2, z4), N4 = mmT(Q2, N2, z4); const f32x4 W3 = mmT(N4, W2, W2);
                  const f32x4 N8 = mmT(Q4, N4, z4); const f32x4 W4 = mmT(N8, W3, W3);
                  const f32x4 Mp = mmT(W4, g2, z4);
                  *(LAS s16x4*)(TM + r * 40 + 4 * q) = pk4(-W4[0], -W4[1], -W4[2], -W4[3]);
#pragma unroll
                  for (int i = 0; i < 4; ++i) TM[(4 * q + i) * 40 + 16 + r] = (bf16)f2bf(-Mp[i]); }
                }
                LDS_WAIT();
                if (F.lane == 0) __hip_atomic_store(ready + (c & (R2_NS - 1)), (unsigned)(c + 1), __ATOMIC_RELAXED, __HIP_MEMORY_SCOPE_WORKGROUP);
            }
#undef R2_LOAD
#undef R2_GRAB
        } else {
            const int cw = w;
            f32x4 ST[4]; s16x4 Sb[4];
#pragma unroll
            for (int kt = 0; kt < 4; ++kt) { ST[kt] = (f32x4){0.f, 0.f, 0.f, 0.f}; Sb[kt] = (s16x4){0, 0, 0, 0}; }
#define R2C_DECL(S) s16x4 S##nk[4], S##rt[4], S##akl[4], S##kdl[4], S##vf, S##tn, S##mu, S##g3, S##g4; f32x4 S##gl[4]
#define R2C_READ(S, cc) do { int lane_ = F.lane; asm volatile("" : "+v"(lane_)); const int lane = lane_, r = lane & 15, q = lane >> 4; \
                LAS unsigned char* sl = F.lds + R2_RING + ((cc) & (R2_NS - 1)) * R2_SLOT; \
                const LAS bf16* NKs = (const LAS bf16*)(sl + R2_NK); const LAS bf16* RTs = (const LAS bf16*)(sl + R2_RT); const LAS bf16* AKL = (const LAS bf16*)(sl + R2_AKL); const LAS bf16* KDL = (const LAS bf16*)(sl + R2_KDL); \
                const LAS bf16* TM = (const LAS bf16*)(sl + R2_TM); const LAS bf16* PP = (const LAS bf16*)(sl + R2_PP); const LAS bf16* VI = (const LAS bf16*)(sl + R2_VI); const LAS float* GL = (const LAS float*)(sl + R2_GL); \
                while (lds_ld(ready + ((cc) & (R2_NS - 1))) != (unsigned)((cc) + 1)) __builtin_amdgcn_s_sleep(1); \
                asm volatile("" ::: "memory"); \
                _Pragma("unroll") for (int kt = 0; kt < 4; ++kt) { S##nk[kt] = *(const LAS s16x4*)(NKs + r * 72 + 16 * kt + 4 * q); S##rt[kt] = *(const LAS s16x4*)(RTs + r * 72 + 16 * kt + 4 * q); } \
                S##vf = tr4(VI, 40, 0, 16 * cw, lane); S##tn = *(const LAS s16x4*)(TM + r * 40 + 4 * q); S##mu = *(const LAS s16x4*)(TM + r * 40 + 16 + 4 * q); \
                _Pragma("unroll") for (int kt = 0; kt < 4; ++kt) { S##kdl[kt] = tr4(KDL, 72, 0, 16 * kt, lane); S##gl[kt] = *(const LAS f32x4*)(GL + 16 * kt + 4 * q); S##akl[kt] = tr4(AKL, 72, 0, 16 * kt, lane); } \
                S##g3 = *(const LAS s16x4*)(PP + r * 40 + 4 * q); S##g4 = *(const LAS s16x4*)(PP + r * 40 + 16 + 4 * q); } while (0)
#define R2C_CHAIN(S, cc) do { f32x4 xa = {0.f, 0.f, 0.f, 0.f}, ot = xa, ua = xa; \
                _Pragma("unroll") for (int kt = 0; kt < 4; ++kt) xa = mfma16(S##nk[kt], Sb[kt], xa);                             \
                ua = mfma16(S##mu, S##vf, ua); \
                _Pragma("unroll") for (int kt = 0; kt < 4; ++kt) ot = mfma16(Sb[kt], S##rt[kt], ot);                             \
                _Pragma("unroll") for (int kt = 0; kt < 4; ++kt) ST[kt] = mfma16(S##kdl[kt], S##vf, ST[kt]); \
                ua = mfma16(S##tn, pk4(xa), ua);                                                                                 \
                ot = mfma16(S##vf, S##g4, ot); \
                const s16x4 ub = pk4(ua); \
                _Pragma("unroll") for (int kt = 0; kt < 4; ++kt) { ST[kt] = mfma16(S##akl[kt], ub, ST[kt]) * S##gl[kt]; Sb[kt] = pk4(ST[kt]); }     \
                ot = mfma16(ub, S##g3, ot); \
                { const int r_ = F.lane & 15, q_ = F.lane >> 4; u32x2 pk_; pk_.x = pk2(ot[0], ot[1]); pk_.y = pk2(ot[2], ot[3]); \
                  *(GAS u32x2*)(O + ((size_t)dir * NTOK + (size_t)seq_row(b, dir, (cc) * 16 + r_)) * 1024 + h * 64 + half * 32 + 16 * cw + 4 * q_) = pk_; } } while (0)
#define R2C_DONE(cc) do { LDS_WAIT(); if (F.lane == 0) __hip_atomic_store(done + cw, (unsigned)((cc) + 1), __ATOMIC_RELAXED, __HIP_MEMORY_SCOPE_WORKGROUP); } while (0)
            R2C_DECL(A_); R2C_DECL(B_);
            __builtin_amdgcn_s_setprio(3);
            if (!(PROBE & 1)) {
                R2C_READ(A_, 0);
                for (int c = 0; c < NCK; c += 2) {
                    R2C_DONE(c); R2C_READ(B_, c + 1); R2C_CHAIN(A_, c);
                    R2C_DONE(c + 1); if (c + 2 < NCK) R2C_READ(A_, c + 2); R2C_CHAIN(B_, c + 1);
                }
            } else {
                for (int c = 0; c < NCK; ++c) { while (lds_ld(ready + (c & (R2_NS - 1))) != (unsigned)(c + 1)) __builtin_amdgcn_s_sleep(1); R2C_DONE(c); }
            }
            __builtin_amdgcn_s_setprio(0);
#undef R2C_DECL
#undef R2C_READ
#undef R2C_CHAIN
#undef R2C_DONE
        }
    }
}

__device__ __forceinline__ float fmix_lo(float a, unsigned b, float c) { float d; asm("v_fma_mix_f32 %0, %1, %2, %3 op_sel:[0,0,0] op_sel_hi:[0,1,0]" : "=v"(d) : "v"(a), "v"(b), "v"(c)); return d; }
__device__ __forceinline__ float fmix_hi(float a, unsigned b, float c) { float d; asm("v_fma_mix_f32 %0, %1, %2, %3 op_sel:[0,1,0] op_sel_hi:[0,1,0]" : "=v"(d) : "v"(a), "v"(b), "v"(c)); return d; }
__device__ __forceinline__ unsigned pkh2(float lo, float hi) { typedef _Float16 h2_t __attribute__((ext_vector_type(2))); h2_t v; v.x = (_Float16)lo; v.y = (_Float16)hi; return __builtin_bit_cast(unsigned, v); }
constexpr int RW_STEPB = 768;
typedef _Float16 h2_t __attribute__((ext_vector_type(2)));
template <int CTRL> __device__ __forceinline__ float dpp_add(float v) { return v + dpp_f<CTRL>(v); }
__device__ __forceinline__ float row8_sum(float v) { v = dpp_add<0xB1>(v); v = dpp_add<0x4E>(v); v = dpp_add<0x141>(v); return v; }
template <int PROBE> PHASE_FN void rw_scan_phase(Frame F, const GAS bf16* Rr, const GAS bf16* Kk, const GAS bf16* Vv, const GAS bf16* WH, const GAS bf16* AH, GAS bf16* O  , GAS float* BETA  ) {
    LAS bf16* W2T = (LAS bf16*)(F.lds + 0); LAS bf16* A2T = (LAS bf16*)(F.lds + 9216);
    LAS bf16* WHS = (LAS bf16*)(F.lds + 18432); LAS bf16* AHS = (LAS bf16*)(F.lds + 27648);
    LAS float* WPA = (LAS float*)(F.lds + 36864);
    LAS unsigned char* STEP = F.lds + 53248;
    LAS float* OP = (LAS float*)(F.lds + 102400);
    LAS float* SO = (LAS float*)(F.lds + 135168);
    LAS float* SVEC = (LAS float*)(F.lds + 143360);
    const int tid = F.tid, lane = F.lane, w = F.wave;
    constexpr int NCH = T / 32;
    for (int unit = F.bid; unit < 256; unit += F.G) {
        const int un = (F.G == 256) ? ((((unit & 7) * 16 + (unit >> 4)) << 1) | ((unit >> 3) & 1)) : unit;
        const int half = un & 1, dir = (un >> 1) & 1, h = (un >> 2) & 15, b = un >> 6;
        __syncthreads();
        for (int i = tid; i < 4096; i += NTHR) { const int l = i >> 6, jn = i & 63; W2T[jn * 72 + l] = (bf16)f2bf(INP(IN_RW_W2)[((size_t)(dir * 64 + l)) * 1024 + h * 64 + jn]); A2T[jn * 72 + l] = (bf16)f2bf(INP(IN_RW_A2)[((size_t)(dir * 64 + l)) * 1024 + h * 64 + jn]); }
        if (tid < 64) { SVEC[tid] = INP(IN_RW_W0)[dir * 1024 + h * 64 + tid]; SVEC[64 + tid] = INP(IN_RW_A0)[dir * 1024 + h * 64 + tid]; SVEC[128 + tid] = INP(IN_RW_KK)[h * 64 + tid];
            SVEC[192 + tid] = INP(IN_RW_KA)[h * 64 + tid]; SVEC[256 + tid] = INP(IN_RW_RK)[h * 64 + tid]; }
        __syncthreads();
        if (w >= 4) {
            const int p = w - 4, tl = lane >> 3, c8 = lane & 7, tp = 8 * p + tl, kc = 8 * c8;
            u32x4 rr, rk, rwh, rah; u32x2 rv;
#define RW_LOAD_RKV(cc) do { const size_t row_ = (size_t)seq_row(b, dir, (cc) * 32 + tp); rr = *(const GAS u32x4*)(Rr + row_ * 1024 + h * 64 + kc); rk = *(const GAS u32x4*)(Kk + row_ * 1024 + h * 64 + kc); \
                rv = *(const GAS u32x2*)(Vv + row_ * 1024 + h * 64 + half * 32 + 4 * c8); } while (0)
#define RW_LOAD_H(cc) do { const size_t row_ = (size_t)seq_row(b, dir, (cc) * 32 + tp); rwh = *(const GAS u32x4*)(WH + row_ * 128 + dir * 64 + kc); rah = *(const GAS u32x4*)(AH + row_ * 128 + dir * 64 + kc); } while (0)
#define RW_STAGE_H(buf) do { *(LAS u32x4*)(WHS + (buf) * (32 * 72) + tp * 72 + kc) = rwh; *(LAS u32x4*)(AHS + (buf) * (32 * 72) + tp * 72 + kc) = rah; } while (0)
#define RW_PREP(cc) do { const int bb_ = (cc) & 1; LAS float* wpa_ = WPA + p * 1024; const int r_ = lane & 15, q_ = lane >> 4; \
                _Pragma("unroll") for (int kt = 0; kt < 4; ++kt) { f32x4 aw_ = {0.f, 0.f, 0.f, 0.f}, aa_ = aw_; \
                    aw_ = mm16<64>(aw_, WHS + bb_ * (32 * 72) + 16 * (p >> 1) * 72, 72, W2T + 16 * kt * 72, 72, lane); aa_ = mm16<64>(aa_, AHS + bb_ * (32 * 72) + 16 * (p >> 1) * 72, 72, A2T + 16 * kt * 72, 72, lane); \
                    if ((q_ >> 1) == (p & 1)) { _Pragma("unroll") for (int i = 0; i < 4; ++i) { wpa_[(4 * (q_ & 1) + i) * 64 + 16 * kt + r_] = aw_[i]; wpa_[512 + (4 * (q_ & 1) + i) * 64 + 16 * kt + r_] = aa_[i]; } } } \
                LDS_WAIT(); \
                float wp_[8], ap_[8], kv_[8], rq_[8]; \
                _Pragma("unroll") for (int jj = 0; jj < 2; ++jj) { const f32x4 x_ = *(const LAS f32x4*)(wpa_ + tl * 64 + kc + 4 * jj) + *(const LAS f32x4*)(SVEC + kc + 4 * jj), y_ = *(const LAS f32x4*)(wpa_ + 512 + tl * 64 + kc + 4 * jj) + *(const LAS f32x4*)(SVEC + 64 + kc + 4 * jj); \
                    _Pragma("unroll") for (int i = 0; i < 4; ++i) { wp_[4 * jj + i] = x_[i]; ap_[4 * jj + i] = y_[i]; } } \
                _Pragma("unroll") for (int jj = 0; jj < 4; ++jj) { kv_[2 * jj] = bflo(rk[jj]); kv_[2 * jj + 1] = bfhi(rk[jj]); rq_[2 * jj] = bflo(rr[jj]); rq_[2 * jj + 1] = bfhi(rr[jj]); } \
                float now_[8], av_[8], kx_[8], gin_[8], gex_[8], ginv_[8], ssq_ = 0.f, bet_ = 0.f; \
                _Pragma("unroll") for (int j = 0; j < 8; ++j) { const float lw_ = -0.6065306597126334f * sigmoid_f(wp_[j]);     \
                    float cs_ = lw_; float y_ = __shfl_up(cs_, 8); if (tl >= 1) cs_ += y_; y_ = __shfl_up(cs_, 16); if (tl >= 2) cs_ += y_; y_ = __shfl_up(cs_, 32); if (tl >= 4) cs_ += y_;     \
                    gin_[j] = __expf(cs_); gex_[j] = __expf(cs_ - lw_); ginv_[j] = __expf(-cs_); now_[j] = gin_[j] - 1.0f;     \
                    av_[j] = sigmoid_f(ap_[j]); kx_[j] = kv_[j] * SVEC[128 + kc + j]; ssq_ += kx_[j] * kx_[j]; } \
                ssq_ = row8_sum(ssq_); const float rn_ = __builtin_amdgcn_rsqf(fmaxf(ssq_, 1e-24f)); \
                u32x4 p0_, p1_, p2_, p3_, p4_; \
                _Pragma("unroll") for (int jj = 0; jj < 4; ++jj) { float nk_[2], ak_[2], kd_[2], rs_[2]; \
                    _Pragma("unroll") for (int hh = 0; hh < 2; ++hh) { const int j = 2 * jj + hh; const float kkn_ = kx_[j] * rn_; nk_[hh] = -kkn_ * gex_[j]; ak_[hh] = kkn_ * av_[j] * ginv_[j]; const float kdt_ = kv_[j] * (1.0f + (av_[j] - 1.0f) * SVEC[192 + kc + j]); kd_[hh] = kdt_ * ginv_[j]; bet_ += rq_[j] * kdt_ * SVEC[256 + kc + j]; rs_[hh] = rq_[j] * gin_[j]; } \
                    p0_[jj] = pkh2(now_[2 * jj], now_[2 * jj + 1]); p1_[jj] = pkh2(nk_[0], nk_[1]); p4_[jj] = pkh2(rs_[0], rs_[1]); \
                    if (jj < 2) { p2_[2 * jj] = pkh2(ak_[0], kd_[0]); p2_[2 * jj + 1] = pkh2(ak_[1], kd_[1]); } else { p3_[2 * (jj - 2)] = pkh2(ak_[0], kd_[0]); p3_[2 * (jj - 2) + 1] = pkh2(ak_[1], kd_[1]); } } \
                bet_ = row8_sum(bet_); \
                LAS unsigned char* sp_ = STEP + bb_ * (32 * RW_STEPB) + tp * RW_STEPB + c8 * 80; \
                *(LAS u32x4*)sp_ = p0_; *(LAS u32x4*)(sp_ + 16) = p1_; *(LAS u32x4*)(sp_ + 32) = p2_; *(LAS u32x4*)(sp_ + 48) = p3_; *(LAS u32x4*)(sp_ + 64) = p4_; \
                *(LAS f32x4*)(STEP + bb_ * (32 * RW_STEPB) + tp * RW_STEPB + 640 + 16 * c8) = (f32x4){bflo(rv.x), bfhi(rv.x), bflo(rv.y), bfhi(rv.y)}; \
                if (c8 == 0 && half == 0) BETA[((size_t)dir * NTOK + seq_row(b, dir, (cc) * 32 + tp)) * 16 + h] = bet_; } while (0)
#define RW_STORE(cc) do { const size_t row_ = (size_t)seq_row(b, dir, (cc) * 32 + tp); const f32x4 o_ = *(const LAS f32x4*)(SO + ((cc) & 1) * 1024 + tp * 32 + 4 * c8); u32x2 pk_; pk_.x = pk2(o_[0], o_[1]); pk_.y = pk2(o_[2], o_[3]); \
                *(GAS u32x2*)(O + ((size_t)dir * NTOK + row_) * 1024 + h * 64 + half * 32 + 4 * c8) = pk_; } while (0)
            RW_LOAD_H(0); RW_LOAD_RKV(0); RW_STAGE_H(0); RW_LOAD_H(1);
            __syncthreads();
            RW_PREP(0); RW_STAGE_H(1); RW_LOAD_RKV(1); RW_LOAD_H(2);
            __syncthreads();
            for (int c = 0; c < NCH; ++c) {
                if (!(PROBE & 2)) {
                if (c > 0) RW_STORE(c - 1);
                if (c + 1 < NCH) { RW_PREP(c + 1); if (c + 2 < NCH) { RW_STAGE_H(c & 1); RW_LOAD_RKV(c + 2); if (c + 3 < NCH) RW_LOAD_H(c + 3); } }
                }
                __syncthreads();
            }
            RW_STORE(NCH - 1);
#undef RW_LOAD_RKV
#undef RW_LOAD_H
#undef RW_STAGE_H
#undef RW_PREP
#undef RW_STORE
        } else {
            const int row = tid >> 3, c8 = tid & 7;
            float S0 = 0.f, S1 = 0.f, S2 = 0.f, S3 = 0.f, S4 = 0.f, S5 = 0.f, S6 = 0.f, S7 = 0.f;
            __syncthreads();
            __syncthreads();
            for (int c = 0; c < NCH; ++c) {
                if (!(PROBE & 1)) {
                const LAS unsigned char* sp = STEP + (c & 1) * (32 * RW_STEPB) + c8 * 80; const LAS unsigned char* vp = STEP + (c & 1) * (32 * RW_STEPB) + 640 + 4 * row; LAS float* op = OP + row * 8 + c8;
                u32x4 a0 = *(const LAS u32x4*)sp, a1 = *(const LAS u32x4*)(sp + 16), a2 = *(const LAS u32x4*)(sp + 32), a3 = *(const LAS u32x4*)(sp + 48), a4 = *(const LAS u32x4*)(sp + 64); float vv = *(const LAS float*)vp;
#pragma unroll 8
                for (int t_ = 0; t_ < 32; ++t_) {
                    const int tn = (t_ + 1) & 31;
                    const LAS unsigned char* np = sp + tn * RW_STEPB;
                    const u32x4 n0 = *(const LAS u32x4*)np, n1 = *(const LAS u32x4*)(np + 16), n2 = *(const LAS u32x4*)(np + 32), n3 = *(const LAS u32x4*)(np + 48), n4 = *(const LAS u32x4*)(np + 64); const float vn = *(const LAS float*)(vp + tn * RW_STEPB);
                    float sa, sb, oa, ob; unsigned sv;
                    asm volatile(
                        "v_fma_mix_f32 %8, %0, %10, 0 op_sel:[0,0,0] op_sel_hi:[0,1,0]\n\t"
                        "v_fma_mix_f32 %9, %1, %10, 0 op_sel:[0,1,0] op_sel_hi:[0,1,0]\n\t"
                        "v_fma_mix_f32 %8, %2, %11, %8 op_sel:[0,0,0] op_sel_hi:[0,1,0]\n\t"
                        "v_fma_mix_f32 %9, %3, %11, %9 op_sel:[0,1,0] op_sel_hi:[0,1,0]\n\t"
                        "v_fma_mix_f32 %8, %4, %12, %8 op_sel:[0,0,0] op_sel_hi:[0,1,0]\n\t"
                        "v_fma_mix_f32 %9, %5, %12, %9 op_sel:[0,1,0] op_sel_hi:[0,1,0]\n\t"
                        "v_fma_mix_f32 %8, %6, %13, %8 op_sel:[0,0,0] op_sel_hi:[0,1,0]\n\t"
                        "v_fma_mix_f32 %9, %7, %13, %9 op_sel:[0,1,0] op_sel_hi:[0,1,0]\n\t"
                        "s_nop 0\n\t"
                        "v_add_f32 %8, %8, %9\n\t"
                        "s_nop 1\n\t"
                        "v_add_f32_dpp %8, %8, %8 quad_perm:[1,0,3,2] row_mask:0xf bank_mask:0xf bound_ctrl:1\n\t"
                        "s_nop 1\n\t"
                        "v_add_f32_dpp %8, %8, %8 quad_perm:[2,3,0,1] row_mask:0xf bank_mask:0xf bound_ctrl:1\n\t"
                        "s_nop 1\n\t"
                        "v_add_f32_dpp %8, %8, %8 row_half_mirror row_mask:0xf bank_mask:0xf bound_ctrl:1\n\t"
                        "s_nop 0"
                        : "+v"(S0), "+v"(S1), "+v"(S2), "+v"(S3), "+v"(S4), "+v"(S5), "+v"(S6), "+v"(S7), "=&v"(sa), "=&v"(sb)
                        : "v"(a1[0]), "v"(a1[1]), "v"(a1[2]), "v"(a1[3]));
                    if (PROBE & 4) asm volatile(
                        "v_cvt_pkrtz_f16_f32 %8, %9, %10\n\t"
                        "v_dot2c_f32_f16 %0, %8, %11\n\t"
                        "v_dot2c_f32_f16 %1, %8, %12\n\t"
                        "v_dot2c_f32_f16 %2, %8, %13\n\t"
                        "v_dot2c_f32_f16 %3, %8, %14\n\t"
                        "v_dot2c_f32_f16 %4, %8, %15\n\t"
                        "v_dot2c_f32_f16 %5, %8, %16\n\t"
                        "v_dot2c_f32_f16 %6, %8, %17\n\t"
                        "v_dot2c_f32_f16 %7, %8, %18\n\t"
                        "s_nop 2"
                        : "+v"(S0), "+v"(S1), "+v"(S2), "+v"(S3), "+v"(S4), "+v"(S5), "+v"(S6), "+v"(S7), "=&v"(sv)
                        : "v"(sa), "v"(vv), "v"(a2[0]), "v"(a2[1]), "v"(a2[2]), "v"(a2[3]), "v"(a3[0]), "v"(a3[1]), "v"(a3[2]), "v"(a3[3]));
                    else
                    asm volatile(
                        "v_cvt_pkrtz_f16_f32 %8, %11, %12\n\t"
                        "v_dot2c_f32_f16 %0, %8, %13\n\t"
                        "v_dot2c_f32_f16 %1, %8, %14\n\t"
                        "v_dot2c_f32_f16 %2, %8, %15\n\t"
                        "v_dot2c_f32_f16 %3, %8, %16\n\t"
                        "v_dot2c_f32_f16 %4, %8, %17\n\t"
                        "v_dot2c_f32_f16 %5, %8, %18\n\t"
                        "v_dot2c_f32_f16 %6, %8, %19\n\t"
                        "v_dot2c_f32_f16 %7, %8, %20\n\t"
                        "v_fma_mix_f32 %9, %0, %21, 0 op_sel:[0,0,0] op_sel_hi:[0,1,0]\n\t"
                        "v_fma_mix_f32 %10, %1, %21, 0 op_sel:[0,1,0] op_sel_hi:[0,1,0]\n\t"
                        "v_fma_mix_f32 %9, %2, %22, %9 op_sel:[0,0,0] op_sel_hi:[0,1,0]\n\t"
                        "v_fma_mix_f32 %10, %3, %22, %10 op_sel:[0,1,0] op_sel_hi:[0,1,0]\n\t"
                        "v_fma_mix_f32 %9, %4, %23, %9 op_sel:[0,0,0] op_sel_hi:[0,1,0]\n\t"
                        "v_fma_mix_f32 %10, %5, %23, %10 op_sel:[0,1,0] op_sel_hi:[0,1,0]\n\t"
                        "v_fma_mix_f32 %9, %6, %24, %9 op_sel:[0,0,0] op_sel_hi:[0,1,0]\n\t"
                        "v_fma_mix_f32 %10, %7, %24, %10 op_sel:[0,1,0] op_sel_hi:[0,1,0]\n\t"
                        "v_add_f32 %9, %9, %10\n\t"
                        "s_nop 0"
                        : "+v"(S0), "+v"(S1), "+v"(S2), "+v"(S3), "+v"(S4), "+v"(S5), "+v"(S6), "+v"(S7), "=&v"(sv), "=&v"(oa), "=&v"(ob)
                        : "v"(sa), "v"(vv), "v"(a2[0]), "v"(a2[1]), "v"(a2[2]), "v"(a2[3]), "v"(a3[0]), "v"(a3[1]), "v"(a3[2]), "v"(a3[3]), "v"(a4[0]), "v"(a4[1]), "v"(a4[2]), "v"(a4[3]));
                    if ((t_ & 7) == 7)
                        asm volatile(
                            "s_nop 1\n\t"
                            "v_fma_mix_f32 %0, %0, %8, %0 op_sel:[0,0,0] op_sel_hi:[0,1,0]\n\t"
                            "v_fma_mix_f32 %1, %1, %8, %1 op_sel:[0,1,0] op_sel_hi:[0,1,0]\n\t"
                            "v_fma_mix_f32 %2, %2, %9, %2 op_sel:[0,0,0] op_sel_hi:[0,1,0]\n\t"
                            "v_fma_mix_f32 %3, %3, %9, %3 op_sel:[0,1,0] op_sel_hi:[0,1,0]\n\t"
                            "v_fma_mix_f32 %4, %4, %10, %4 op_sel:[0,0,0] op_sel_hi:[0,1,0]\n\t"
                            "v_fma_mix_f32 %5, %5, %10, %5 op_sel:[0,1,0] op_sel_hi:[0,1,0]\n\t"
                            "v_fma_mix_f32 %6, %6, %11, %6 op_sel:[0,0,0] op_sel_hi:[0,1,0]\n\t"
                            "v_fma_mix_f32 %7, %7, %11, %7 op_sel:[0,1,0] op_sel_hi:[0,1,0]\n\t"
                            "s_nop 0"
                            : "+v"(S0), "+v"(S1), "+v"(S2), "+v"(S3), "+v"(S4), "+v"(S5), "+v"(S6), "+v"(S7)
                            : "v"(a0[0]), "v"(a0[1]), "v"(a0[2]), "v"(a0[3]));
                    if (!(PROBE & 4)) op[t_ * 256] = oa;
                    a0 = n0; a1 = n1; a2 = n2; a3 = n3; a4 = n4; vv = vn;
                }
                LDS_WAIT();
#pragma unroll
                for (int i = 0; i < 4; ++i) { const LAS f32x4* q_ = (const LAS f32x4*)(OP + ((4 * c8 + i) * 32 + row) * 8); const f32x4 x_ = q_[0] + q_[1]; SO[(c & 1) * 1024 + (4 * c8 + i) * 32 + row] = (x_[0] + x_[1]) + (x_[2] + x_[3]); }
                }
                __syncthreads();
            }
        }
    }
}

PHASE_FN void gemm_mlin(Frame F, int jl) { GAS unsigned char* MIX = F.ws + WS_MIX; GAS unsigned char* HY = F.ws + WS_HY;
    pg8::Gemm g{(const GAS bf16*)HY, (const GAS bf16*)(F.W + W_ML_WIN + jl * W_ML_WIN_SZ), NTOK, 4352, 1024}; pg8::StaticOrder So; So.init(NTOK, 4352, F.G, F.bid);
    pg8::EpiMlstmIn E{(GAS bf16*)MIX, (GAS bf16*)(MIX + 2 * ROWB), (GAS bf16*)(MIX + 3 * ROWB), (GAS float*)(MIX + 4 * ROWB), INP(IN_ML_BGATE) + jl * 32};
    pg8::gemm_phase<pg8::EpiMlstmIn, pg8::StaticOrder, true, GEMM_SP2>(F.lds, g, So, E, F.tid); }
PHASE_FN void gemm_resid(Frame F, const GAS bf16* A, const GAS bf16* Bt, int L, int dry = 0) {
    pg8::Gemm g{A, Bt, NTOK, 1024, 1024}; pg8::StaticOrder So; So.init(NTOK, 1024, F.G, F.bid);
    pg8::EpiResid E{F.ws + WS_S, (const GAS float*)(F.ws + WS_MOD) + (size_t)L * 5 * 6144, 2, dry}; pg8::gemm_phase<pg8::EpiResid, pg8::StaticOrder, true, GEMM_SP2>(F.lds, g, So, E, F.tid); }
PHASE_FN void gemm_rwin(Frame F) { GAS unsigned char* MIX = F.ws + WS_MIX; GAS unsigned char* HY = F.ws + WS_HY;
    GAS bf16* Rb = (GAS bf16*)MIX; GAS bf16* Kb = (GAS bf16*)(MIX + ROWB); GAS bf16* Vb = (GAS bf16*)(MIX + 2 * ROWB); GAS float* WH = (GAS float*)(MIX + 3 * ROWB); GAS float* AH = WH + (size_t)NTOK * 128; GAS bf16* GH = (GAS bf16*)(AH + (size_t)NTOK * 128);
    pg8::Gemm g{(const GAS bf16*)HY, (const GAS bf16*)(F.W + W_RW_IN), NTOK, 3584, 2048}; pg8::StaticOrder So; So.init(NTOK, 3584, F.G, F.bid);
    pg8::EpiRwkvIn E{Rb, Kb, Vb, WH, AH, GH}; pg8::gemm_phase<pg8::EpiRwkvIn, pg8::StaticOrder, true, GEMM_SP2>(F.lds, g, So, E, F.tid); }
PHASE_FN void gemm_rwg(Frame F) { GAS unsigned char* MIX = F.ws + WS_MIX;
    GAS float* WH = (GAS float*)(MIX + 3 * ROWB); GAS float* AH = WH + (size_t)NTOK * 128; GAS bf16* GH = (GAS bf16*)(AH + (size_t)NTOK * 128);
    pg8::Gemm g{GH, (const GAS bf16*)(F.W + W_RW_G2), NTOK, 1024, 256}; pg8::StaticOrder So; So.init(NTOK, 1024, F.G, F.bid);
    pg8::EpiBf16Plain E{(GAS bf16*)MIX, 1024}; pg8::gemm_phase<pg8::EpiBf16Plain, pg8::StaticOrder, GEMM_ALIGN, GEMM_SP2>(F.lds, g, So, E, F.tid); }
PHASE_FN void gemm_hgin(Frame F) { GAS unsigned char* MIX = F.ws + WS_MIX; GAS unsigned char* HY = F.ws + WS_HY;
    pg8::Gemm g{(const GAS bf16*)HY, (const GAS bf16*)(F.W + W_HG_IN), NTOK, 5120, 1024}; pg8::StaticOrder So; So.init(NTOK, 5120, F.G, F.bid);
    pg8::EpiHgrnIn E{(GAS bf16*)MIX, (GAS bf16*)(MIX + ROWB), (GAS bf16*)(MIX + 2 * ROWB), (GAS bf16*)(MIX + 3 * ROWB), (size_t)NTOK * 1024, INP(IN_HG_BF), (const GAS float*)(F.ws + WS_LB)};
    pg8::gemm_phase<pg8::EpiHgrnIn, pg8::StaticOrder, true, GEMM_SP2>(F.lds, g, So, E, F.tid); }
PHASE_FN void gemm_moe1(Frame F, int L) { GAS unsigned char* MIX = F.ws + WS_MIX; LAS int* pref = (LAS int*)(F.lds + LDS_PHASE_BYTES); moe_prefix(F, L, pref, pref + 32);
    pg8::Gemm g{(const GAS bf16*)(F.ws + WS_HY), (const GAS bf16*)(F.W + W_EX13), NSLOT, 16384, 1024, (const GAS int*)(F.ws + WS_SLOT_TOK)}; pg8::MoeOrder So{pref, F.G, F.bid};
    pg8::EpiMoe1 E{(GAS bf16*)(MIX + 140 * MiB)}; pg8::gemm_phase<pg8::EpiMoe1, pg8::MoeOrder, true, GEMM_SP2, true>(F.lds, g, So, E, F.tid); }
PHASE_FN void gemm_moe2(Frame F, int L) { GAS unsigned char* MIX = F.ws + WS_MIX; LAS int* pref = (LAS int*)(F.lds + LDS_PHASE_BYTES); moe_prefix(F, L, pref, pref + 32);
    pg8::Gemm g{(const GAS bf16*)(MIX + 140 * MiB), (const GAS bf16*)(F.W + W_EX2), NSLOT, 16384, 512}; pg8::MoeOrder So{pref, F.G, F.bid};
    pg8::EpiMoe2 E{(GAS bf16*)(MIX + 210 * MiB), (const GAS int*)(F.ws + WS_SLOT_TOK), (const GAS float*)(F.ws + WS_SLOT_GATE)};
    pg8::gemm_phase<pg8::EpiMoe2, pg8::MoeOrder, true, GEMM_SP2>(F.lds, g, So, E, F.tid); }

#ifndef MK_PER_PHASE
#define MK_PER_PHASE 0
#endif
constexpr int PH_PER_LAYER = 12, PH_LAYER0 = 2, PH_FINAL = PH_LAYER0 + DEPTH * PH_PER_LAYER, N_PHASES = PH_FINAL + 1;
__global__ void __launch_bounds__(NTHR, 2) fwd_kernel(Args args) {
    extern __shared__ __attribute__((aligned(16))) unsigned char lds_raw[];
    Frame F;
    F.lds = (LAS unsigned char*)lds_raw; F.out = (GAS float*)args.out; F.ws = (GAS unsigned char*)args.ws; F.W = (GAS unsigned char*)args.wts;
    F.tid = threadIdx.x; F.lane = F.tid & 63; F.wave = __builtin_amdgcn_readfirstlane(F.tid >> 6); F.bid = blockIdx.x; F.G = gridDim.x;
    volatile LAS unsigned* MISC = (volatile LAS unsigned*)(F.lds + MISC_OFF);
    if (F.tid < 32) MISC[F.tid] = 0u;
    if (F.tid < 42) ((LAS unsigned long long*)(F.lds + PTAB_OFF))[F.tid] = (unsigned long long)args.in[F.tid];
    __syncthreads();
    const int lo = args.ph_lo, hi = args.ph_hi;
    XcdBarrier bar; bar.bar = (unsigned*)args.ws + CW_BAR; bar.x = 0; bar.st = MISC + 8;
    if (hi - lo > 1) bar = xcd_barrier_post((unsigned*)args.ws + CW_BAR, MISC + 8);
#define IN(k) (lo <= (k) && (k) < hi)
#ifndef EXTRA_BARS
#define EXTRA_BARS 0
#endif
#define SEAM(k) do { if ((k) + 1 < hi) { xcd_barrier(bar); for (int eb_ = 0; eb_ < EXTRA_BARS; ++eb_) xcd_barrier(bar); } } while (0)
#ifndef DUP_MASK
#define DUP_MASK 0
#endif
#ifndef PRB_MASK
#define PRB_MASK 0
#endif
#define PRB(bit, stmt) do { if ((PRB_MASK >> (bit)) & 1) { stmt; xcd_barrier(bar); } } while (0)
#define DUP(bit, stmt) do { stmt; if ((DUP_MASK >> (bit)) & 1) { xcd_barrier(bar); stmt; } } while (0)

    if (IN(0)) { PRB(0, pre_phase(fresh(F))); pre_phase(fresh(F)); SEAM(0); }
    if (IN(1)) { PRB(0, modsum_phase(fresh(F))); modsum_phase(fresh(F)); SEAM(1); }

    for (int L = 0; L < DEPTH; ++L) {
        const int kind = L % 3, jl = L / 3, pb = PH_LAYER0 + L * PH_PER_LAYER;
        if (IN(pb + 0)) { DUP(6, expert_weights(fresh(F), L)); if ((PRB_MASK >> 1) & 1) { norm_phase<0, 1>(fresh(F), L, L > 0, kind == 1 ? 2048 : 1024); xcd_barrier(bar); } norm_phase<0>(fresh(F), L, L > 0, kind == 1 ? 2048 : 1024); SEAM(pb + 0); }
        if (kind == 0) {
            if (IN(pb + 2)) { DUP(3, gemm_mlin(fresh(F), jl)); SEAM(pb + 2); }
            if (IN(pb + 3)) { DUP(7, conv_phase(fresh(F), jl)); SEAM(pb + 3); }
            if (IN(pb + 4)) { const Frame Fp = fresh(F); GAS unsigned char* MIX = Fp.ws + WS_MIX;
#ifndef SC_PROBE
#define SC_PROBE 0
#endif
#ifndef ML_SCAN
#define ML_SCAN ml_scan3_phase
#endif
#ifndef HG_SCAN
#define HG_SCAN hg_scan3_phase
#endif
#ifndef HG_PROBE
#define HG_PROBE 0
#endif
                if (SC_PROBE) { ML_SCAN<SC_PROBE>(Fp, (const GAS bf16*)(Fp.ws + WS_HY), (const GAS bf16*)(MIX + 2 * ROWB), (const GAS float*)(MIX + 4 * ROWB), (GAS bf16*)MIX); xcd_barrier(bar); }
                DUP(0, ML_SCAN<0>(Fp, (const GAS bf16*)(Fp.ws + WS_HY), (const GAS bf16*)(MIX + 2 * ROWB), (const GAS float*)(MIX + 4 * ROWB), (GAS bf16*)MIX)); SEAM(pb + 4); }
            if (IN(pb + 6)) { const Frame Fp = fresh(F); GAS unsigned char* MIX = Fp.ws + WS_MIX;
                PRB(4, headnorm_phase(Fp, (const GAS bf16*)MIX, (const GAS bf16*)(MIX + ROWB), (const GAS bf16*)(MIX + 3 * ROWB), ldptr(Fp, IN_ML_HEADG) + jl * 1024, (GAS bf16*)(Fp.ws + WS_HY + ROWB)));
                headnorm_phase(Fp, (const GAS bf16*)MIX, (const GAS bf16*)(MIX + ROWB), (const GAS bf16*)(MIX + 3 * ROWB), ldptr(Fp, IN_ML_HEADG) + jl * 1024, (GAS bf16*)(Fp.ws + WS_HY + ROWB)); SEAM(pb + 6); }
            if (IN(pb + 7)) { const Frame Fp = fresh(F); PRB(5, gemm_resid(Fp, (const GAS bf16*)(Fp.ws + WS_HY + ROWB), (const GAS bf16*)(Fp.W + W_ML_WOUT + jl * 2 * MiB), L, 1)); gemm_resid(Fp, (const GAS bf16*)(Fp.ws + WS_HY + ROWB), (const GAS bf16*)(Fp.W + W_ML_WOUT + jl * 2 * MiB), L); SEAM(pb + 7); }
        } else if (kind == 1) {
            if (IN(pb + 1)) { PRB(4, du_phase(fresh(F))); du_phase(fresh(F)); SEAM(pb + 1); }
            if (IN(pb + 2)) { DUP(3, gemm_rwin(fresh(F))); SEAM(pb + 2); }
            if (IN(pb + 4)) { const Frame Fp = fresh(F); GAS unsigned char* MIX = Fp.ws + WS_MIX; GAS float* WH = (GAS float*)(MIX + 3 * ROWB); GAS float* AH = WH + (size_t)NTOK * 128; GAS float* BETA = (GAS float*)((GAS bf16*)(AH + (size_t)NTOK * 128) + (size_t)NTOK * 256);

#ifndef RW_PROBE
#define RW_PROBE 0
#endif
#ifndef RW_SCAN
#define RW_SCAN rw_scan2_phase
#endif
                if (RW_PROBE) { RW_SCAN<RW_PROBE>(Fp, (const GAS bf16*)MIX, (const GAS bf16*)(MIX + ROWB), (const GAS bf16*)(MIX + 2 * ROWB), (const GAS bf16*)WH, (const GAS bf16*)AH, (GAS bf16*)(Fp.ws + WS_HY), BETA); xcd_barrier(bar); }
                DUP(1, RW_SCAN<0>(Fp, (const GAS bf16*)MIX, (const GAS bf16*)(MIX + ROWB), (const GAS bf16*)(MIX + 2 * ROWB), (const GAS bf16*)WH, (const GAS bf16*)AH, (GAS bf16*)(Fp.ws + WS_HY), BETA)); SEAM(pb + 4); }
            if (IN(pb + 5)) { PRB(4, gemm_rwg(fresh(F))); gemm_rwg(fresh(F)); SEAM(pb + 5); }
            if (IN(pb + 6)) { const Frame Fp = fresh(F); GAS unsigned char* MIX = Fp.ws + WS_MIX; GAS float* WH = (GAS float*)(MIX + 3 * ROWB); GAS float* AH = WH + (size_t)NTOK * 128; GAS float* BETA = (GAS float*)((GAS bf16*)(AH + (size_t)NTOK * 128) + (size_t)NTOK * 256);
                PRB(4, rwpost_phase(Fp, (const GAS bf16*)(Fp.ws + WS_HY), (const GAS bf16*)(Fp.ws + WS_HY + ROWB), BETA, (const GAS bf16*)(MIX + 2 * ROWB), (const GAS bf16*)MIX, (GAS bf16*)(MIX + ROWB)));
                rwpost_phase(Fp, (const GAS bf16*)(Fp.ws + WS_HY), (const GAS bf16*)(Fp.ws + WS_HY + ROWB), BETA, (const GAS bf16*)(MIX + 2 * ROWB), (const GAS bf16*)MIX, (GAS bf16*)(MIX + ROWB)); SEAM(pb + 6); }
            if (IN(pb + 7)) { const Frame Fp = fresh(F); PRB(5, gemm_resid(Fp, (const GAS bf16*)(Fp.ws + WS_MIX + ROWB), (const GAS bf16*)(Fp.W + W_RW_WOUT), L, 1)); gemm_resid(Fp, (const GAS bf16*)(Fp.ws + WS_MIX + ROWB), (const GAS bf16*)(Fp.W + W_RW_WOUT), L); SEAM(pb + 7); }
        } else {
            if (IN(pb + 2)) { DUP(3, gemm_hgin(fresh(F))); SEAM(pb + 2); }
            if (IN(pb + 4)) { const Frame Fp = fresh(F); GAS unsigned char* MIX = Fp.ws + WS_MIX;
                if (HG_PROBE) { HG_SCAN<HG_PROBE>(Fp, (const GAS bf16*)MIX, (const GAS bf16*)(MIX + ROWB), (const GAS bf16*)(MIX + 3 * ROWB), (GAS bf16*)(Fp.ws + WS_HY + ROWB), (GAS bf16*)(Fp.ws + WS_HY)); xcd_barrier(bar); }
                DUP(2, HG_SCAN<0>(Fp, (const GAS bf16*)MIX, (const GAS bf16*)(MIX + ROWB), (const GAS bf16*)(MIX + 3 * ROWB), (GAS bf16*)(Fp.ws + WS_HY + ROWB), (GAS bf16*)(Fp.ws + WS_HY))); SEAM(pb + 4); }
            if (IN(pb + 6)) { const Frame Fp = fresh(F); GAS unsigned char* MIX = Fp.ws + WS_MIX;
                headnorm_phase(Fp, (const GAS bf16*)(Fp.ws + WS_HY + ROWB), (const GAS bf16*)(Fp.ws + WS_HY), (const GAS bf16*)(MIX + 2 * ROWB), ldptr(Fp, IN_HG_HEADG), (GAS bf16*)(Fp.ws + WS_HY + ROWB)); SEAM(pb + 6); }
            if (IN(pb + 7)) { const Frame Fp = fresh(F); PRB(5, gemm_resid(Fp, (const GAS bf16*)(Fp.ws + WS_HY + ROWB), (const GAS bf16*)(Fp.W + W_HG_WOUT), L, 1)); gemm_resid(Fp, (const GAS bf16*)(Fp.ws + WS_HY + ROWB), (const GAS bf16*)(Fp.W + W_HG_WOUT), L); SEAM(pb + 7); }
        }
        if (IN(pb + 8)) { if ((PRB_MASK >> 2) & 1) { route2_phase<1>(fresh(F), L); xcd_barrier(bar); } route2_phase<0>(fresh(F), L);
            SEAM(pb + 8); }
        if (IN(pb + 9)) { if ((PRB_MASK >> 3) & 1) { slots_phase<1>(fresh(F), L); xcd_barrier(bar); } slots_phase<0>(fresh(F), L); SEAM(pb + 9); }
        if (IN(pb + 10)) { DUP(4, gemm_moe1(fresh(F), L)); SEAM(pb + 10); }
        if (IN(pb + 11)) { DUP(5, gemm_moe2(fresh(F), L)); SEAM(pb + 11); }
    }
    if (IN(PH_FINAL)) norm_phase<2>(fresh(F), 0, true, 1024);
#undef IN
#undef SEAM
}

extern "C" void kernel_launch(void* const* d_in, const int* in_sizes, int n_in, void* d_out, int out_size, void* d_ws, size_t ws_size, hipStream_t stream) {
    static int grid = 0;
    if (grid == 0) {
        if (n_in != 42 || out_size != NB * SEQ * D || ws_size < WS_END) { fprintf(stderr, "kernel_launch: unexpected problem (n_in %d, out %d, ws %zu)\n", n_in, out_size, ws_size); grid = -1; return; }
        int dev = 0, cus = 0, per_cu = 0;
        if (hipGetDevice(&dev) != hipSuccess || hipDeviceGetAttribute(&cus, hipDeviceAttributeMultiprocessorCount, dev) != hipSuccess) { grid = -1; return; }
        if (hipFuncSetAttribute((const void*)fwd_kernel, hipFuncAttributeMaxDynamicSharedMemorySize, LDS_BYTES) != hipSuccess) { fprintf(stderr, "kernel_launch: hipFuncSetAttribute failed\n"); grid = -1; return; }
        if (hipOccupancyMaxActiveBlocksPerMultiprocessor(&per_cu, (const void*)fwd_kernel, NTHR, LDS_BYTES) != hipSuccess || per_cu < 1) { fprintf(stderr, "kernel_launch: occupancy query reports %d\n", per_cu); (void)hipGetLastError(); grid = -1; return; }
        grid = cus;
    }
    if (grid < 0) return;
    (void)hipMemsetAsync(d_ws, 0, CTL_ZERO_BYTES, stream);
    Args a{};
    for (int i = 0; i < 42; ++i) a.in[i] = (const float*)d_in[i];
    a.out = (float*)d_out; a.ws = (unsigned char*)d_ws;
    a.wts = (ws_size >= WS_END + W_BYTES) ? (unsigned char*)d_ws + WS_END : (unsigned char*)d_out;
#if MK_PER_PHASE
    for (int p = 0; p < N_PHASES; ++p) { a.ph_lo = p; a.ph_hi = p + 1; hipLaunchKernelGGL(fwd_kernel, dim3(grid), dim3(NTHR), LDS_BYTES, stream, a); }
#else
    a.ph_lo = 0; a.ph_hi = N_PHASES;
    hipLaunchKernelGGL(fwd_kernel, dim3(grid), dim3(NTHR), LDS_BYTES, stream, a);
#endif
}
```

```cpp
#include <hip/hip_runtime.h>
#include <cstdio>
#include <cstdint>

__device__ __forceinline__ float sigmoid_f(float x) { return __builtin_amdgcn_rcpf(1.0f + __expf(-x)); }
__device__ __forceinline__ float silu_f(float x) { return x * __builtin_amdgcn_rcpf(1.0f + __expf(-x)); }
__device__ __forceinline__ float logsigmoid_f(float x) { return fminf(x, 0.f) - __logf(1.0f + __expf(-fabsf(x))); }
#define GAS __attribute__((address_space(1)))
#ifndef S_BF16
#define S_BF16 1
#endif
namespace pg8 {
#define PG8_LAS __attribute__((address_space(3)))
typedef unsigned short bf16_t;
typedef short bf16x8 __attribute__((ext_vector_type(8)));
typedef float f32x4 __attribute__((ext_vector_type(4)));
typedef unsigned u32x4 __attribute__((ext_vector_type(4)));
constexpr int BM = 256, BK = 64, HALF = 128, HTB = HALF * BK * 2  , STAGE_BYTES = 8 * HTB, NXCD = 8, WGM = 4;

__host__ __device__ __forceinline__ int lds_byte(int r, int c) { const int st = (r >> 4) * 2 + (c >> 5), rr = r & 15, cc = c & 31, ob = rr * 64 + cc * 2; return st * 1024 + (ob ^ (((ob >> 9) & 1) << 5)); }
__host__ __device__ __forceinline__ void stage_rc(int b, int& R, int& C) { const int st = b / 1024, sb = b % 1024, swz = sb ^ (((sb >> 9) & 1) << 5); R = (st >> 1) * 16 + swz / 64; C = (st & 1) * 32 + (swz % 64) / 2; }
__host__ __device__ __forceinline__ int perm32(int rho) { const int n = rho >> 4, i = rho & 15; return 8 * (i >> 2) + 4 * n + (i & 3); }

struct Unit { int pm, pn; };
struct Gemm { const GAS bf16_t* A; const GAS bf16_t* Bt; int M, N, K; const GAS int* gidx; };

struct StaticOrder {
    int nM, nN, nwg, G, c;
    __host__ __device__ void init(int M, int N, int G_, int c_) { nM = M / BM; nN = N / BM; nwg = nM * nN; G = G_; c = c_; }
    __host__ __device__ bool next(int i, Unit& u) const {
        const long L = (long)i * G + c; if (L >= nwg) return false;
        int wgid = (int)L; { const int q = nwg / NXCD, r = nwg % NXCD, xcd = wgid % NXCD, off = wgid / NXCD; wgid = (xcd < r ? xcd * (q + 1) : r * (q + 1) + (xcd - r) * q) + off; }
        const int nig = WGM * nN, gid = wgid / nig, fm = gid * WGM, gsz = (nM - fm) < WGM ? (nM - fm) : WGM;
        u.pm = fm + ((wgid % nig) % gsz); u.pn = (wgid % nig) / gsz; return true;
    }
    __device__ __forceinline__ void a_ready(const Unit&) const {}
    __device__ __forceinline__ void done(const Unit&) const {}
};
typedef float f32x2_pg8 __attribute__((ext_vector_type(2))); typedef __bf16 bf16x2_pg8 __attribute__((ext_vector_type(2)));
__device__ __forceinline__ unsigned cvt_pk_bf16(float lo, float hi) { f32x2_pg8 v = {lo, hi}; bf16x2_pg8 b = __builtin_convertvector(v, bf16x2_pg8); return __builtin_bit_cast(unsigned, b); }
typedef unsigned u32x2 __attribute__((ext_vector_type(2)));
__device__ __forceinline__ void st8(GAS bf16_t* p, f32x4 v0, f32x4 v1) { u32x4 w; w.x = cvt_pk_bf16(v0[0], v0[1]); w.y = cvt_pk_bf16(v0[2], v0[3]); w.z = cvt_pk_bf16(v1[0], v1[1]); w.w = cvt_pk_bf16(v1[2], v1[3]); *(GAS u32x4*)p = w; }
template <int ACT> __device__ __forceinline__ f32x4 act4(f32x4 v) {
    if (ACT == 1) { v[0] = sigmoid_f(v[0]); v[1] = sigmoid_f(v[1]); v[2] = sigmoid_f(v[2]); v[3] = sigmoid_f(v[3]); }
    if (ACT == 2) { v[0] = silu_f(v[0]); v[1] = silu_f(v[1]); v[2] = silu_f(v[2]); v[3] = silu_f(v[3]); }
    return v; }
template <int ACT> __device__ __forceinline__ void store_tile_bf16(const f32x4 (&acc)[2][2][4][2], GAS bf16_t* base, int ld, int row0, int cw) {
#pragma unroll
    for (int ai = 0; ai < 2; ++ai)
#pragma unroll
        for (int m = 0; m < 4; ++m) { GAS bf16_t* rp = base + (size_t)(row0 + ai * HALF + m * 16) * ld + cw;
#pragma unroll
            for (int bj = 0; bj < 2; ++bj) st8(rp + bj * HALF, act4<ACT>(acc[ai][bj][m][0]), act4<ACT>(acc[ai][bj][m][1])); }
}
struct EpiBf16Plain { static constexpr bool PERM = true, AFTER_DRAIN = false; GAS bf16_t* O; int ldc;
    __device__ __forceinline__ void operator()(const f32x4 (&acc)[2][2][4][2], const Unit& u, int wr, int wc, int fr, int fq) const {
        store_tile_bf16<0>(acc, O + u.pn * BM, ldc, u.pm * BM + wr * 64 + fr, wc * 32 + 8 * fq); }
};
struct EpiMlstmIn { static constexpr bool PERM = true, AFTER_DRAIN = false;
    GAS bf16_t* QKPRE; GAS bf16_t* V; GAS bf16_t* OG; GAS float* GATES; const GAS float* bgate;
    __device__ __forceinline__ void operator()(const f32x4 (&acc)[2][2][4][2], const Unit& u, int wr, int wc, int fr, int fq) const {
        const int row0 = u.pm * BM + wr * 64 + fr, cw = wc * 32 + 8 * fq;
        if (u.pn < 8) store_tile_bf16<0>(acc, QKPRE + u.pn * BM, 2048, row0, cw);
        else if (u.pn < 12) store_tile_bf16<0>(acc, V + (u.pn - 8) * BM, 1024, row0, cw);
        else if (u.pn < 16) store_tile_bf16<1>(acc, OG + (u.pn - 12) * BM, 1024, row0, cw);
        else if (wc == 0) {
            const f32x4 b0 = *(const GAS f32x4*)(bgate + 8 * fq), b1 = *(const GAS f32x4*)(bgate + 8 * fq + 4);
#pragma unroll
            for (int ai = 0; ai < 2; ++ai)
#pragma unroll
                for (int m = 0; m < 4; ++m) { GAS float* gp = GATES + (size_t)(row0 + ai * HALF + m * 16) * 32 + 8 * fq;
                    *(GAS f32x4*)gp = acc[ai][0][m][0] + b0; *(GAS f32x4*)(gp + 4) = acc[ai][0][m][1] + b1; }
        }
    }
};
struct EpiRwkvIn { static constexpr bool PERM = true, AFTER_DRAIN = false;
    GAS bf16_t* R; GAS bf16_t* Kk; GAS bf16_t* V; GAS float* WH; GAS float* AH; GAS bf16_t* GH; int pn0;
    __device__ __forceinline__ void operator()(const f32x4 (&acc)[2][2][4][2], const Unit& u, int wr, int wc, int fr, int fq) const {
        const int row0 = u.pm * BM + wr * 64 + fr, cw = wc * 32 + 8 * fq, pn = u.pn + pn0;
        if (pn < 4) store_tile_bf16<0>(acc, R + pn * BM, 1024, row0, cw);
        else if (pn < 8) store_tile_bf16<0>(acc, Kk + (pn - 4) * BM, 1024, row0, cw);
        else if (pn < 12) store_tile_bf16<0>(acc, V + (pn - 8) * BM, 1024, row0, cw);
        else if (pn == 12) {
#pragma unroll
            for (int ai = 0; ai < 2; ++ai)
#pragma unroll
                for (int m = 0; m < 4; ++m) { const size_t r = (size_t)(row0 + ai * HALF + m * 16);
                    f32x4 t0 = acc[ai][0][m][0], t1 = acc[ai][0][m][1];
#pragma unroll
                    for (int j = 0; j < 4; ++j) { t0[j] = tanhf(t0[j]); t1[j] = tanhf(t1[j]); }
                    st8((GAS bf16_t*)WH + r * 128 + cw, t0, t1); st8((GAS bf16_t*)AH + r * 128 + cw, acc[ai][1][m][0], acc[ai][1][m][1]); }
        } else {
#pragma unroll
            for (int ai = 0; ai < 2; ++ai)
#pragma unroll
                for (int m = 0; m < 4; ++m) { GAS bf16_t* rp = GH + (size_t)(row0 + ai * HALF + m * 16) * 256 + cw;
                    st8(rp, act4<1>(acc[ai][0][m][0]), act4<1>(acc[ai][0][m][1])); *(GAS u32x4*)(rp + HALF) = (u32x4){0u, 0u, 0u, 0u}; }
        }
    }
};
struct EpiHgrnIn { static constexpr bool PERM = true, AFTER_DRAIN = false;
    GAS bf16_t* Q; GAS bf16_t* V; GAS bf16_t* OG; GAS bf16_t* LF; size_t lf_stride; const GAS float* bf; const GAS float* lb;
    __device__ __forceinline__ void operator()(const f32x4 (&acc)[2][2][4][2], const Unit& u, int wr, int wc, int fr, int fq) const {
        const int row0 = u.pm * BM + wr * 64 + fr, cw = wc * 32 + 8 * fq;
        if (u.pn < 4) store_tile_bf16<2>(acc, Q + u.pn * BM, 1024, row0, cw);
        else if (u.pn < 8) store_tile_bf16<0>(acc, V + (u.pn - 4) * BM, 1024, row0, cw);
        else if (u.pn < 12) store_tile_bf16<2>(acc, OG + (u.pn - 8) * BM, 1024, row0, cw);
        else {
            const int dir = (u.pn - 12) >> 2, ct = ((u.pn - 12) & 3) * BM; GAS bf16_t* base = LF + (size_t)dir * lf_stride + ct;
            f32x4 bb[2][2], ll[2][2];
#pragma unroll
            for (int bj = 0; bj < 2; ++bj)
#pragma unroll
                for (int n = 0; n < 2; ++n) { bb[bj][n] = *(const GAS f32x4*)(bf + dir * 1024 + ct + bj * HALF + cw + 4 * n); ll[bj][n] = *(const GAS f32x4*)(lb + ct + bj * HALF + cw + 4 * n); }
#pragma unroll
            for (int ai = 0; ai < 2; ++ai)
#pragma unroll
                for (int m = 0; m < 4; ++m) { GAS bf16_t* rp = base + (size_t)(row0 + ai * HALF + m * 16) * 1024 + cw;
#pragma unroll
                    for (int bj = 0; bj < 2; ++bj) { f32x4 o[2];
#pragma unroll
                        for (int n = 0; n < 2; ++n)
#pragma unroll
                            for (int j = 0; j < 4; ++j) { const float l = ll[bj][n][j]; o[n][j] = __logf(l + (1.f - l) * sigmoid_f(acc[ai][bj][m][n][j] + bb[bj][n][j])); }
                        st8(rp + bj * HALF, o[0], o[1]); } }
        }
    }
};
struct EpiResid { static constexpr bool PERM = S_BF16 ? true : false, AFTER_DRAIN = false;
    GAS unsigned char* S; const GAS float* mod; int gate_idx; int dry;
    __device__ __forceinline__ void operator()(const f32x4 (&acc)[2][2][4][2], const Unit& u, int wr, int wc, int fr, int fq) const {
        const int b = u.pm / 33, seg = (u.pm - b * 33 == 0) ? 0 : 1 + b;
        if (S_BF16) {
            const int row0 = u.pm * BM + wr * 64 + fr, col0 = u.pn * BM + wc * 32 + 8 * fq;
            const GAS float* gp = mod + seg * 6144 + gate_idx * 1024 + col0;
            f32x4 gv[2][2];
#pragma unroll
            for (int bj = 0; bj < 2; ++bj)
#pragma unroll
                for (int n = 0; n < 2; ++n) gv[bj][n] = *(const GAS f32x4*)(gp + bj * HALF + n * 4);
#pragma unroll
            for (int ai = 0; ai < 2; ++ai)
#pragma unroll
                for (int m = 0; m < 4; ++m) { GAS bf16_t* rowp = (GAS bf16_t*)S + (size_t)(row0 + ai * HALF + m * 16) * 1024 + col0;
#pragma unroll
                    for (int bj = 0; bj < 2; ++bj) { GAS u32x4* p = (GAS u32x4*)(rowp + bj * HALF); const u32x4 o = *p;
                        f32x4 v0 = {__builtin_bit_cast(float, o.x << 16), __builtin_bit_cast(float, o.x & 0xffff0000u), __builtin_bit_cast(float, o.y << 16), __builtin_bit_cast(float, o.y & 0xffff0000u)};
                        f32x4 v1 = {__builtin_bit_cast(float, o.z << 16), __builtin_bit_cast(float, o.z & 0xffff0000u), __builtin_bit_cast(float, o.w << 16), __builtin_bit_cast(float, o.w & 0xffff0000u)};
                        v0 += acc[ai][bj][m][0] * gv[bj][0]; v1 += acc[ai][bj][m][1] * gv[bj][1];
                        if (!dry || v0[0] == 1.2345e33f) st8(rowp + bj * HALF, v0, v1); } }
        } else {
            const int row0 = u.pm * BM + wr * 64 + fr, col0 = u.pn * BM + wc * 32 + 4 * fq;
            const GAS float* gp = mod + seg * 6144 + gate_idx * 1024 + col0;
            f32x4 gv[2][2];
#pragma unroll
            for (int bj = 0; bj < 2; ++bj)
#pragma unroll
                for (int n = 0; n < 2; ++n) gv[bj][n] = *(const GAS f32x4*)(gp + bj * HALF + n * 16);
#pragma unroll
            for (int ai = 0; ai < 2; ++ai)
#pragma unroll
                for (int m = 0; m < 4; ++m) { GAS float* rowp = (GAS float*)S + (size_t)(row0 + ai * HALF + m * 16) * 1024 + col0;
#pragma unroll
                    for (int bj = 0; bj < 2; ++bj)
#pragma unroll
                        for (int n = 0; n < 2; ++n) { GAS f32x4* p = (GAS f32x4*)(rowp + bj * HALF + n * 16); const f32x4 v_ = *p + acc[ai][bj][m][n] * gv[bj][n]; if (!dry || v_[0] == 1.2345e33f) *p = v_; } }
        }
    }
};
struct EpiMoe1 { static constexpr bool PERM = true, AFTER_DRAIN = false; GAS bf16_t* ACT;
    __device__ __forceinline__ void operator()(const f32x4 (&acc)[2][2][4][2], const Unit& u, int wr, int wc, int fr, int fq) const {
        const int row0 = u.pm * BM + wr * 64 + fr, pnl = u.pn & 3, c0 = pnl * 128 + wc * 16 + 4 * fq;
#pragma unroll
        for (int ai = 0; ai < 2; ++ai)
#pragma unroll
            for (int m = 0; m < 4; ++m) { GAS bf16_t* rp = ACT + (size_t)(row0 + ai * HALF + m * 16) * 512 + c0;
#pragma unroll
                for (int bj = 0; bj < 2; ++bj) { const f32x4 a = acc[ai][bj][m][0], b = acc[ai][bj][m][1];
                    u32x2 w; w.x = cvt_pk_bf16(silu_f(a[0]) * b[0], silu_f(a[1]) * b[1]); w.y = cvt_pk_bf16(silu_f(a[2]) * b[2], silu_f(a[3]) * b[3]);
                    *(GAS u32x2*)(rp + bj * 64) = w; } }
    }
};
struct EpiMoe2 { static constexpr bool PERM = true, AFTER_DRAIN = false; GAS bf16_t* YM; const GAS int* slot_tok; const GAS float* slot_gate;
    __device__ __forceinline__ void operator()(const f32x4 (&acc)[2][2][4][2], const Unit& u, int wr, int wc, int fr, int fq) const {
        const int row0 = u.pm * BM + wr * 64 + fr, col0 = (u.pn & 3) * BM + wc * 32 + 8 * fq;
#pragma unroll
        for (int ai = 0; ai < 2; ++ai)
#pragma unroll
            for (int m = 0; m < 4; ++m) { const int slot = row0 + ai * HALF + m * 16; const int dst = slot_tok[slot]; const float g = slot_gate[slot];
                if (dst >= 0) { GAS bf16_t* rp = YM + (size_t)dst * 1024 + col0;
#pragma unroll
                    for (int bj = 0; bj < 2; ++bj) st8(rp + bj * HALF, acc[ai][bj][m][0] * g, acc[ai][bj][m][1] * g); } }
    }
};
struct MoeOrder { const PG8_LAS int* pref; int G, c;
    __device__ __forceinline__ bool next(int i, Unit& u) const {
        const int L0 = i * G + c, n = pref[16] * 4; if (L0 >= n) return false;
        const int q8 = n >> 3, r8 = n & 7, xcd = L0 & 7, off = L0 >> 3; const int L = (xcd < r8 ? xcd * (q8 + 1) : r8 * (q8 + 1) + (xcd - r8) * q8) + off;
        const int tile = L >> 2; int e = 0;
#pragma unroll
        for (int j = 1; j < 16; ++j) e += (tile >= pref[j]) ? 1 : 0;
        u.pm = tile; u.pn = e * 4 + (L & 3); return true; }
    __device__ __forceinline__ void a_ready(const Unit&) const {}
    __device__ __forceinline__ void done(const Unit&) const {}
};
template <class Epi, class Sched, bool ALIGN_EPI = false, bool SP2 = false, bool GATHER = false>
__device__ __forceinline__ void gemm_phase(PG8_LAS unsigned char* lds, const Gemm g, const Sched& S, const Epi& E, const int tid_in) {
    int tid_ = tid_in; asm volatile("" : "+v"(tid_));
    const int tid = tid_, wid = __builtin_amdgcn_readfirstlane(tid >> 6), lane = tid & 63, wr = wid >> 2, wc = wid & 3, fr = lane & 15, fq = lane >> 4;
    const int K = g.K, nt = K / BK;
    unsigned voffA[2], voffB[2];
#pragma unroll
    for (int i = 0; i < 2; ++i) { int R, C; stage_rc(tid * 16 + i * 8192, R, C); const int Rb = Epi::PERM ? ((R & ~31) + perm32(R & 31)) : R;
        voffA[i] = (unsigned)(R * K + C) * 2u; voffB[i] = (unsigned)(Rb * K + C) * 2u; }
    unsigned offc[2][2], offn[2][2];
#define PG8_GOFF(dst, unit) do { _Pragma("unroll") for (int _h = 0; _h < 2; ++_h) _Pragma("unroll") for (int _i = 0; _i < 2; ++_i) { int _R, _C; stage_rc(tid * 16 + _i * 8192, _R, _C); \
        const int _t = g.gidx[(unit).pm * BM + _h * HALF + _R]; dst[_h][_i] = (unsigned)(((_t < 0 ? 0 : (_t >> 1)) * K + _C) * 2); } } while (0)
    const size_t kstep = (size_t)(BK * 2);
    const size_t hstep = (size_t)HALF * K * 2;
    const size_t tstep = 2 * hstep;
    if constexpr (!GATHER) {
#pragma unroll
        for (int h_ = 0; h_ < 2; ++h_)
#pragma unroll
            for (int i = 0; i < 2; ++i) { offc[h_][i] = voffA[i] + (unsigned)(h_ * hstep); offn[h_][i] = offc[h_][i]; } }
    const unsigned ldsw = (unsigned)wid * 1024u;
    const int aoff = lds_byte(wr * 64 + fr, fq * 8), boff = lds_byte(wc * 32 + fr, fq * 8);
#define PG8_SA(b, h) (((b) * 2 + (h)) * HTB)
#define PG8_SB(b, h) ((4 + (b) * 2 + (h)) * HTB)
#define PG8_STAGE(bufoff, gbase, voff) do { _Pragma("unroll") for (int _i = 0; _i < 2; ++_i) \
        __builtin_amdgcn_global_load_lds((const unsigned*)((const char*)(gbase) + (voff)[_i]), (PG8_LAS unsigned*)(lds + (bufoff) + ldsw + _i * 8192), 16, 0, 0); } while (0)
#define PG8_STAGE_A(bufoff, gbase, off2) do { _Pragma("unroll") for (int _i = 0; _i < 2; ++_i) \
        __builtin_amdgcn_global_load_lds((const unsigned*)((const char*)(gbase) + (off2)[_i]), (PG8_LAS unsigned*)(lds + (bufoff) + ldsw + _i * 8192), 16, 0, 0); } while (0)
#define PG8_LDA(dst, b, h) do { _Pragma("unroll") for (int m = 0; m < 4; ++m) _Pragma("unroll") for (int k = 0; k < 2; ++k) dst[m][k] = *(const PG8_LAS bf16x8*)(lds + PG8_SA(b, h) + aoff + m * 2048 + k * 1024); } while (0)
#define PG8_LDB(dst, b, h) do { _Pragma("unroll") for (int n = 0; n < 2; ++n) _Pragma("unroll") for (int k = 0; k < 2; ++k) dst[n][k] = *(const PG8_LAS bf16x8*)(lds + PG8_SB(b, h) + boff + n * 2048 + k * 1024); } while (0)
#define PG8_MMA(ai, bj, At, Bt) do { __builtin_amdgcn_s_setprio(1); _Pragma("unroll") for (int m = 0; m < 4; ++m) _Pragma("unroll") for (int n = 0; n < 2; ++n) _Pragma("unroll") for (int k = 0; k < 2; ++k) \
        acc[ai][bj][m][n] = __builtin_amdgcn_mfma_f32_16x16x32_bf16(Bt[n][k], At[m][k], acc[ai][bj][m][n], 0, 0, 0); __builtin_amdgcn_s_setprio(0); } while (0)
#define PG8_WAIT_V(n) asm volatile("s_waitcnt vmcnt(" #n ")" ::: "memory")
#define PG8_WAIT_L(n) asm volatile("s_waitcnt lgkmcnt(" #n ")" ::: "memory")
#define PG8_BAR __builtin_amdgcn_s_barrier()
#define PG8_SCHED __builtin_amdgcn_sched_barrier(0)
    Unit cur, nxt; int ui = 0;
    if (!S.next(0, cur)) return;
    f32x4 acc[2][2][4][2];
#pragma unroll
    for (int a = 0; a < 2; ++a)
#pragma unroll
        for (int b = 0; b < 2; ++b)
#pragma unroll
            for (int m = 0; m < 4; ++m)
#pragma unroll
                for (int n = 0; n < 2; ++n) acc[a][b][m][n] = (f32x4){0.f, 0.f, 0.f, 0.f};
    bf16x8 At[4][2], B0[2][2], B1[2][2];
    const char* cA = (const char*)g.A + (GATHER ? (size_t)0 : (size_t)cur.pm * tstep); const char* cB = (const char*)g.Bt + (size_t)cur.pn * tstep;
    S.a_ready(cur);
    if constexpr (GATHER) PG8_GOFF(offc, cur);
    if constexpr (SP2) {
        PG8_STAGE(PG8_SB(0, 0), cB, voffB); PG8_STAGE(PG8_SB(0, 1), cB + hstep, voffB); PG8_STAGE_A(PG8_SA(0, 0), cA, offc[0]); PG8_STAGE_A(PG8_SA(0, 1), cA, offc[1]);
        if (wr == 1) PG8_BAR;
        PG8_WAIT_V(2); PG8_BAR;
        PG8_STAGE(PG8_SB(1, 0), cB + kstep, voffB); PG8_STAGE_A(PG8_SA(1, 0), cA + kstep, offc[0]); PG8_STAGE(PG8_SB(1, 1), cB + hstep + kstep, voffB);
        PG8_WAIT_V(6); PG8_BAR;
    } else {
        PG8_STAGE(PG8_SB(0, 0), cB, voffB); PG8_STAGE_A(PG8_SA(0, 0), cA, offc[0]); PG8_STAGE(PG8_SB(0, 1), cB + hstep, voffB); PG8_STAGE_A(PG8_SA(0, 1), cA, offc[1]);
        if (wr == 1) PG8_BAR;
        PG8_WAIT_V(4); PG8_BAR;
        PG8_STAGE(PG8_SB(1, 0), cB + kstep, voffB); PG8_STAGE_A(PG8_SA(1, 0), cA + kstep, offc[0]); PG8_STAGE(PG8_SB(1, 1), cB + hstep + kstep, voffB);
        PG8_WAIT_V(6); PG8_BAR;
    }
    for (;;) {
        const bool has_next = S.next(ui + 1, nxt);
        const char* nA = (has_next && !GATHER) ? (const char*)g.A + (size_t)nxt.pm * tstep : cA; const char* nB = has_next ? (const char*)g.Bt + (size_t)nxt.pn * tstep : cB;
        if constexpr (GATHER) { if (has_next) PG8_GOFF(offn, nxt); else {
#pragma unroll
            for (int h_ = 0; h_ < 2; ++h_)
#pragma unroll
                for (int i = 0; i < 2; ++i) offn[h_][i] = offc[h_][i]; } }
        for (int t = 0; t < nt; t += 2) {
            const bool last = (t == nt - 2);
            const char* a1 = cA + (size_t)(t + 1) * kstep;
            const char* a2 = last ? nA : cA + (size_t)(t + 2) * kstep; const char* b2 = last ? nB : cB + (size_t)(t + 2) * kstep;
            const char* a3 = a2 + kstep; const char* b3 = b2 + kstep;
            if (last && has_next) S.a_ready(nxt);
            if constexpr (SP2) {
            PG8_LDB(B0, 0, 0); PG8_LDB(B1, 0, 1); PG8_SCHED; PG8_LDA(At, 0, 0); PG8_STAGE_A(PG8_SA(1, 1), a1, offc[1]); if constexpr (GATHER) { if (last) { offc[0][0] = offn[0][0]; offc[0][1] = offn[0][1]; offc[1][0] = offn[1][0]; offc[1][1] = offn[1][1]; } }
            PG8_WAIT_V(8); PG8_WAIT_L(0); PG8_BAR; PG8_MMA(0, 0, At, B0); PG8_MMA(0, 1, At, B1); PG8_BAR; PG8_SCHED;
            PG8_LDA(At, 0, 1); PG8_STAGE(PG8_SB(0, 0), b2, voffB); PG8_STAGE(PG8_SB(0, 1), b2 + hstep, voffB); PG8_STAGE_A(PG8_SA(0, 0), a2, offc[0]);
            PG8_WAIT_V(8); PG8_WAIT_L(0); PG8_BAR; PG8_MMA(1, 0, At, B0); PG8_MMA(1, 1, At, B1); PG8_BAR; PG8_SCHED;
            PG8_LDB(B0, 1, 0); PG8_LDB(B1, 1, 1); PG8_SCHED; PG8_LDA(At, 1, 0); PG8_STAGE_A(PG8_SA(0, 1), a2, offc[1]);
            PG8_WAIT_V(8); PG8_WAIT_L(0); PG8_BAR; PG8_MMA(0, 0, At, B0); PG8_MMA(0, 1, At, B1); PG8_BAR; PG8_SCHED;
            PG8_LDA(At, 1, 1); PG8_STAGE(PG8_SB(1, 0), b3, voffB); PG8_STAGE(PG8_SB(1, 1), b3 + hstep, voffB); PG8_STAGE_A(PG8_SA(1, 0), a3, offc[0]);
            PG8_WAIT_V(8); PG8_WAIT_L(0); PG8_BAR; PG8_MMA(1, 0, At, B0); PG8_MMA(1, 1, At, B1); PG8_BAR; PG8_SCHED;
            } else {
            PG8_LDB(B0, 0, 0); PG8_SCHED; PG8_LDA(At, 0, 0); PG8_STAGE_A(PG8_SA(1, 1), a1, offc[1]); if constexpr (GATHER) { if (last) { offc[0][0] = offn[0][0]; offc[0][1] = offn[0][1]; offc[1][0] = offn[1][0]; offc[1][1] = offn[1][1]; } }
            PG8_WAIT_L(8); PG8_BAR; PG8_WAIT_L(0); PG8_MMA(0, 0, At, B0); PG8_BAR; PG8_SCHED;
            PG8_LDB(B1, 0, 1); PG8_STAGE(PG8_SB(0, 0), b2, voffB);
            PG8_BAR; PG8_WAIT_L(0); PG8_MMA(0, 1, At, B1); PG8_BAR;
            PG8_LDA(At, 0, 1); PG8_STAGE_A(PG8_SA(0, 0), a2, offc[0]);
            PG8_BAR; PG8_WAIT_L(0); PG8_MMA(1, 0, At, B0); PG8_BAR; PG8_SCHED;
            PG8_STAGE(PG8_SB(0, 1), b2 + hstep, voffB);
            PG8_WAIT_V(6); PG8_BAR; PG8_MMA(1, 1, At, B1); PG8_BAR;
            PG8_LDB(B0, 1, 0); PG8_SCHED; PG8_LDA(At, 1, 0); PG8_STAGE_A(PG8_SA(0, 1), a2, offc[1]);
            PG8_WAIT_L(8); PG8_BAR; PG8_WAIT_L(0); PG8_MMA(0, 0, At, B0); PG8_BAR; PG8_SCHED;
            PG8_LDB(B1, 1, 1); PG8_STAGE(PG8_SB(1, 0), b3, voffB);
            PG8_BAR; PG8_WAIT_L(0); PG8_MMA(0, 1, At, B1); PG8_BAR;
            PG8_LDA(At, 1, 1); PG8_STAGE_A(PG8_SA(1, 0), a3, offc[0]);
            PG8_BAR; PG8_WAIT_L(0); PG8_MMA(1, 0, At, B0); PG8_BAR; PG8_SCHED;
            PG8_STAGE(PG8_SB(1, 1), b3 + hstep, voffB);
            PG8_WAIT_V(6); PG8_BAR; PG8_MMA(1, 1, At, B1); PG8_BAR;
            }
        }
        if constexpr (ALIGN_EPI) { if (wr == 0) PG8_BAR; }
        if constexpr (!Epi::AFTER_DRAIN) { E(acc, cur, wr, wc, fr, fq); S.done(cur); }
        if (!has_next) break;
#pragma unroll
        for (int a = 0; a < 2; ++a)
#pragma unroll
            for (int b = 0; b < 2; ++b)
#pragma unroll
                for (int m = 0; m < 4; ++m)
#pragma unroll
                    for (int n = 0; n < 2; ++n) acc[a][b][m][n] = (f32x4){0.f, 0.f, 0.f, 0.f};
        cur = nxt; cA = nA; cB = nB; ++ui;

        if constexpr (ALIGN_EPI) { if (wr == 1) PG8_BAR; }
    }
    PG8_WAIT_V(0);
    if constexpr (!ALIGN_EPI) { if (wr == 0) PG8_BAR; }
    PG8_BAR;
    if constexpr (Epi::AFTER_DRAIN) { E.fused(acc, cur, wr, wc, fr, fq, lds, wid, lane); S.done(cur); }
#undef PG8_SA
#undef PG8_SB
#undef PG8_STAGE
#undef PG8_STAGE_A
#undef PG8_GOFF
#undef PG8_LDA
#undef PG8_LDB
#undef PG8_MMA
#undef PG8_WAIT_V
#undef PG8_WAIT_L
#undef PG8_BAR
#undef PG8_SCHED
}
}

#define LAS __attribute__((address_space(3)))
#ifndef PHASE_FN
#define PHASE_FN __device__ __forceinline__
#endif
#ifndef GEMM_SP2
#define GEMM_SP2 true
#endif
#ifndef GEMM_ALIGN
#define GEMM_ALIGN false
#endif
typedef unsigned short bf16;
typedef pg8::bf16x8 bf16x8;
typedef pg8::f32x4 f32x4;
typedef pg8::u32x4 u32x4;
typedef pg8::u32x2 u32x2;
constexpr int D = 1024, NB = 4, SEQ = 8192, CTX = 256, T = CTX + SEQ, NTOK = NB * T, DEPTH = 4;
constexpr int NWAVES = 8, NTHR = 512;
constexpr int NSLOT = 71680;
constexpr size_t MiB = 1u << 20;
constexpr size_t CTL_ZERO_BYTES = 2 * MiB;
constexpr int CW_BAR = 1024;
constexpr int CW_MOE = 8192;
constexpr size_t WS_MOD = 1 * MiB;
constexpr size_t WS_LB = 2 * MiB;
constexpr size_t WS_TOK = 2 * MiB + 65536;
constexpr size_t WS_SLOT_TOK = 3 * MiB;
constexpr size_t WS_SLOT_GATE = 3 * MiB + 524288;
constexpr size_t WS_S = 4 * MiB;
constexpr size_t WS_HY = 136 * MiB;
constexpr size_t WS_MIX = 268 * MiB;
constexpr size_t WS_END = 610 * MiB;
constexpr size_t ROWB = (size_t)NTOK * 1024 * 2;
constexpr size_t W_ML_WIN = 0, W_ML_WIN_SZ = (size_t)4352 * 1024 * 2;
constexpr size_t W_ML_WOUT = 17 * MiB;
constexpr size_t W_RW_IN = 21 * MiB;
constexpr size_t W_RW_G2 = 35 * MiB;
constexpr size_t W_RW_WOUT = 36 * MiB;
constexpr size_t W_HG_IN = 38 * MiB;
constexpr size_t W_HG_WOUT = 48 * MiB;
constexpr size_t W_EX13 = 50 * MiB;
constexpr size_t W_EX2 = 82 * MiB;
constexpr size_t W_BYTES = 98 * MiB;
constexpr int LDS_PHASE_BYTES = 131072;
constexpr int LDS_BYTES = 163840;
constexpr int MISC_OFF = LDS_BYTES - 2048;

#define VM_WAIT() asm volatile("s_waitcnt vmcnt(0)" ::: "memory")
#define LDS_WAIT() asm volatile("s_waitcnt lgkmcnt(0)" ::: "memory")
typedef float f32x2_t __attribute__((ext_vector_type(2))); typedef __bf16 bf16x2_t __attribute__((ext_vector_type(2)));
__device__ __forceinline__ unsigned pk2(float lo, float hi) { f32x2_t v = {lo, hi}; bf16x2_t b = __builtin_convertvector(v, bf16x2_t); return __builtin_bit_cast(unsigned, b); }
__device__ __forceinline__ unsigned f2bf(float f) { return pk2(f, f) & 0xffffu; }
__device__ __forceinline__ float bf2f(unsigned b) { return __builtin_bit_cast(float, b << 16); }
__device__ __forceinline__ float bflo(unsigned w) { return __builtin_bit_cast(float, w << 16); }
__device__ __forceinline__ float bfhi(unsigned w) { return __builtin_bit_cast(float, w & 0xffff0000u); }
__device__ __forceinline__ float wave_sum(float v) {
#pragma unroll
    for (int o = 1; o < 64; o <<= 1) v += __shfl_xor(v, o);
    return v; }
__device__ __forceinline__ float wave_max(float v) {
#pragma unroll
    for (int o = 1; o < 64; o <<= 1) v = fmaxf(v, __shfl_xor(v, o));
    return v; }
template <int CTRL> __device__ __forceinline__ float dpp_f(float v) { return __builtin_bit_cast(float, __builtin_amdgcn_update_dpp(0, __builtin_bit_cast(int, v), CTRL, 0xF, 0xF, false)); }
__device__ __forceinline__ float row16_sum(float v) { v += dpp_f<0xB1>(v); v += dpp_f<0x4E>(v); v += dpp_f<0x124>(v); v += dpp_f<0x128>(v); return v; }
template <int CTRL, int ROWMASK> __device__ __forceinline__ float dpp_keep(float old, float v) { return __builtin_bit_cast(float, __builtin_amdgcn_update_dpp(__builtin_bit_cast(int, old), __builtin_bit_cast(int, v), CTRL, ROWMASK, 0xF, false)); }
__device__ __forceinline__ float wave_scan_add(float v) {
    v += dpp_keep<0x111, 0xF>(0.f, v); v += dpp_keep<0x112, 0xF>(0.f, v); v += dpp_keep<0x114, 0xF>(0.f, v); v += dpp_keep<0x118, 0xF>(0.f, v);
    v += dpp_keep<0x142, 0xA>(0.f, v); v += dpp_keep<0x143, 0xC>(0.f, v); return v; }
__device__ __forceinline__ float wave_scan_max(float v) {
    v = fmaxf(v, dpp_keep<0x111, 0xF>(v, v)); v = fmaxf(v, dpp_keep<0x112, 0xF>(v, v)); v = fmaxf(v, dpp_keep<0x114, 0xF>(v, v)); v = fmaxf(v, dpp_keep<0x118, 0xF>(v, v));
    v = fmaxf(v, dpp_keep<0x142, 0xA>(v, v)); v = fmaxf(v, dpp_keep<0x143, 0xC>(v, v)); return v; }
__device__ __forceinline__ float wave_sum_dpp(float v) { v = row16_sum(v); v += dpp_keep<0x142, 0xA>(0.f, v); v += dpp_keep<0x143, 0xC>(0.f, v); return __builtin_bit_cast(float, __builtin_amdgcn_readlane(__builtin_bit_cast(int, v), 63)); }
__device__ __forceinline__ float lane63(float v) { return __builtin_bit_cast(float, __builtin_amdgcn_readlane(__builtin_bit_cast(int, v), 63)); }
template <int K> __device__ __forceinline__ f32x4 mm16(f32x4 acc, const LAS bf16* A, int lda, const LAS bf16* Bt, int ldb, int lane) {
    const int r = lane & 15, q = lane >> 4;
#pragma unroll
    for (int kk = 0; kk < K / 32; ++kk) {
        const bf16x8 a = *(const LAS bf16x8*)(A + r * lda + kk * 32 + q * 8);
        const bf16x8 b = *(const LAS bf16x8*)(Bt + r * ldb + kk * 32 + q * 8);
        acc = __builtin_amdgcn_mfma_f32_16x16x32_bf16(a, b, acc, 0, 0, 0); }
    return acc; }
typedef short s16x4 __attribute__((ext_vector_type(4)));
__device__ __forceinline__ bf16x8 tr_frag(const LAS bf16* X, int ld, int k0, int n0, int lane) {
    const int g = lane >> 4, a = (lane & 15) >> 2, p = lane & 3;
    const LAS bf16* p0 = X + (k0 + 8 * g + a) * ld + n0 + 4 * p;
    const s16x4 lo = __builtin_amdgcn_ds_read_tr16_b64_v4i16((LAS s16x4*)p0), hi = __builtin_amdgcn_ds_read_tr16_b64_v4i16((LAS s16x4*)(p0 + 4 * ld));
    return (bf16x8){lo[0], lo[1], lo[2], lo[3], hi[0], hi[1], hi[2], hi[3]}; }
__device__ __forceinline__ bf16x8 row_frag(const LAS bf16* A, int ld, int k0, int lane) { return *(const LAS bf16x8*)(A + (lane & 15) * ld + k0 + (lane >> 4) * 8); }
__device__ __forceinline__ f32x4 ldS4(const GAS unsigned char* S, size_t vi) {
    if (S_BF16) { const u32x2 w = ((const GAS u32x2*)S)[vi]; return (f32x4){bflo(w.x), bfhi(w.x), bflo(w.y), bfhi(w.y)}; }
    return ((const GAS f32x4*)S)[vi]; }
__device__ __forceinline__ void stS4(GAS unsigned char* S, size_t vi, f32x4 v) {
    if (S_BF16) { u32x2 w; w.x = pk2(v[0], v[1]); w.y = pk2(v[2], v[3]); ((GAS u32x2*)S)[vi] = w; }
    else ((GAS f32x4*)S)[vi] = v; }
__device__ __forceinline__ int seq_row(int b, int dir, int i) {
    const int tt = (i < CTX) ? (dir ? CTX - 1 - i : i) : CTX + (dir ? SEQ - 1 - (i - CTX) : (i - CTX));
    return b * T + tt; }

#define XB_TMO      128
#define XB_XCNT(j)  (256  + 64 * (j))
#define XB_XSUB(j)  (1280 + 64 * (j))
#define XB_XGEN(j)  (2304 + 64 * (j))
#define XB_TOP      3328
#define XB_TOPGEN   3392
#define XCD_BAR_WORDS 3456
#define XB_SPIN_CAP (1u << 18)

__device__ __forceinline__ unsigned xb_ld(unsigned* p)              { return __hip_atomic_load(p, __ATOMIC_RELAXED, __HIP_MEMORY_SCOPE_AGENT); }
__device__ __forceinline__ unsigned xb_add(unsigned* p, unsigned v) { return __hip_atomic_fetch_add(p, v, __ATOMIC_RELAXED, __HIP_MEMORY_SCOPE_AGENT); }
__device__ __forceinline__ unsigned xb_xcc_id() { return (unsigned)__builtin_amdgcn_s_getreg((3 << 11) | 20) & 0xFu; }
#define XB_SPIN(cond, bar) do { unsigned _sp = 0; while (cond) { __builtin_amdgcn_s_sleep(1); \
    if ((++_sp & 255u) == 0u) { if (xb_ld(&(bar)[XB_TMO])) break; if (_sp > XB_SPIN_CAP) { atomicAdd(&(bar)[XB_TMO], 1u); break; } } } } while (0)

struct XcdBarrier {
    unsigned* bar; unsigned x;
    volatile LAS unsigned* st;
};

__device__ __forceinline__ XcdBarrier xcd_barrier_post(unsigned* bar, volatile LAS unsigned* st) {
    XcdBarrier b; b.bar = bar; b.x = xb_xcc_id(); b.st = st;
    if (threadIdx.x == 0) (void)xb_add(&bar[XB_XCNT(b.x)], 1u);
    return b;
}
__device__ __forceinline__ void xcd_barrier_complete(unsigned* bar, unsigned x, unsigned& nloc, unsigned& nx) {
    const unsigned G = gridDim.x * gridDim.y * gridDim.z;
    unsigned sum, cnt, mine, sp = 0u;
    for (;;) {
        sum = 0u; cnt = 0u; mine = 0u;
#pragma unroll
        for (unsigned j = 0; j < 16; ++j) { const unsigned c = xb_ld(&bar[XB_XCNT(j)]); sum += c; cnt += (c > 0u) ? 1u : 0u; mine = (j == x) ? c : mine; }
        if (sum == G) break;
        __builtin_amdgcn_s_sleep(1);
        if ((++sp & 255u) == 0u) { if (xb_ld(&bar[XB_TMO])) break; if (sp > XB_SPIN_CAP) { atomicAdd(&bar[XB_TMO], 1u); break; } }
    }
    nloc = mine > 0u ? mine : 1u; nx = cnt > 0u ? cnt : 1u;
}

__device__ __forceinline__ void xcd_barrier(const XcdBarrier& b) {
    asm volatile("s_waitcnt vmcnt(0)" ::: "memory");
    __syncthreads();
    if (threadIdx.x == 0) {
        unsigned* bar = b.bar;
        __builtin_amdgcn_s_waitcnt(0);
        unsigned nloc = b.st[0], nx = b.st[1];
        if (nloc == 0u) { xcd_barrier_complete(bar, b.x, nloc, nx); b.st[0] = nloc; b.st[1] = nx; }
        const unsigned old = xb_add(&bar[XB_XSUB(b.x)], 1u);
        const unsigned gen = old / nloc;
        if (old + 1u == (gen + 1u) * nloc) {
            __builtin_amdgcn_fence(__ATOMIC_RELEASE, "agent");
            asm volatile("s_waitcnt vmcnt(0)" ::: "memory");
            const unsigned og = xb_add(&bar[XB_TOP], 1u);
            const unsigned tg = og / nx;
            if (og + 1u == (tg + 1u) * nx) xb_add(&bar[XB_TOPGEN], 1u);
            else XB_SPIN(xb_ld(&bar[XB_TOPGEN]) == tg, bar);
            __builtin_amdgcn_fence(__ATOMIC_ACQUIRE, "agent");
            xb_add(&bar[XB_XGEN(b.x)], 1u);
            asm volatile("s_waitcnt vmcnt(0)" ::: "memory");
        } else {
            XB_SPIN(xb_ld(&bar[XB_XGEN(b.x)]) == gen, bar);
            __builtin_amdgcn_fence(__ATOMIC_ACQUIRE, "agent");
            asm volatile("s_waitcnt vmcnt(0)" ::: "memory");
        }
    }
    __syncthreads();
}

struct Args { const float* in[42]; float* out; unsigned char* ws; unsigned char* wts; int ph_lo, ph_hi; };
struct Frame {
    LAS unsigned char* lds; GAS float* out; GAS unsigned char* ws; GAS unsigned char* W;
    int tid, lane, wave, bid, G;
};
constexpr int PTAB_OFF = MISC_OFF + 512;
__device__ __forceinline__ const GAS float* ldptr(const Frame& F, int i) { const unsigned long long v = ((const LAS unsigned long long*)(F.lds + PTAB_OFF))[i];
    const unsigned lo = __builtin_amdgcn_readfirstlane((unsigned)v), hi = __builtin_amdgcn_readfirstlane((unsigned)(v >> 32)); return (const GAS float*)(((unsigned long long)hi << 32) | lo); }
#define INP(i) ldptr(F, (i))
__device__ __forceinline__ Frame fresh(const Frame& F0) { Frame F = F0; int t; asm volatile("v_mbcnt_lo_u32_b32 %0, -1, 0\n\tv_mbcnt_hi_u32_b32 %0, -1, %0\n\tv_lshl_add_u32 %0, %1, 6, %0" : "=&v"(t) : "s"(F0.wave));     F.tid = t; F.lane = t & 63; F.wave = __builtin_amdgcn_readfirstlane(t >> 6);
    asm volatile("" : "+s"(F.bid), "+s"(F.G), "+s"(F.ws), "+s"(F.W), "+s"(F.out)); return F; }
enum { IN_X = 0, IN_C, IN_CTX, IN_CCTX, IN_ADAW, IN_ADAB, IN_NMIX, IN_NFFN, IN_NOUT, IN_ML_WIN, IN_ML_WGATE, IN_ML_BGATE, IN_ML_CONV, IN_ML_HEADG, IN_ML_WOUT,
       IN_RW_MU, IN_RW_WRKV, IN_RW_W0, IN_RW_W1, IN_RW_W2, IN_RW_A0, IN_RW_A1, IN_RW_A2, IN_RW_G1, IN_RW_G2, IN_RW_KK, IN_RW_KA, IN_RW_RK, IN_RW_LNW, IN_RW_LNB, IN_RW_WOUT,
       IN_HG_WIN, IN_HG_WF, IN_HG_BF, IN_HG_LB, IN_HG_HEADG, IN_HG_WOUT, IN_ROUTER_W, IN_ROUTER_B, IN_EX_W1, IN_EX_W3, IN_EX_W2 };

template <int MAP> __device__ __forceinline__ int rowmap(int n) { return MAP == 0 ? n : (MAP == 1 ? 8 * (n >> 2) + (n & 3) : 8 * (n >> 2) + 4 + (n & 3)); }
template <int MAP> __device__ __forceinline__ void tr_item(const GAS float* W, int ldw, int nblk, GAS bf16* WT, int ldd, int row_off, int k_off, const GAS float* kscale, LAS float* scr, int item, int lane) {
    const int kb = item / nblk, nb = item - kb * nblk, k0 = 64 * kb, n0 = 32 * nb;
#pragma unroll 8
    for (int i = 0; i < 32; ++i) { const int kk = 2 * i + (lane >> 5); float v = W[(size_t)(k0 + kk) * ldw + n0 + (lane & 31)]; if (kscale) v *= kscale[k0 + kk]; scr[kk * 33 + (lane & 31)] = v; }
    LDS_WAIT(); asm volatile("" ::: "memory");
    const int c = lane & 7;
#pragma unroll
    for (int j = 0; j < 4; ++j) { const int n = (lane >> 3) + 8 * j; const LAS float* s = scr + (8 * c) * 33 + n;
        u32x4 o; o.x = pk2(s[0 * 33], s[1 * 33]); o.y = pk2(s[2 * 33], s[3 * 33]); o.z = pk2(s[4 * 33], s[5 * 33]); o.w = pk2(s[6 * 33], s[7 * 33]);
        *(GAS u32x4*)(WT + (size_t)(row_off + rowmap<MAP>(n0 + n)) * ldd + k_off + k0 + 8 * c) = o; }
    LDS_WAIT(); asm volatile("" ::: "memory");
}
#define TRJOB(MAP, cnt, ...) if (r < (cnt)) { tr_item<MAP>(__VA_ARGS__, scr, r, F.lane); continue; } r -= (cnt);

PHASE_FN void pre_phase(Frame F) {
    LAS float* scr = (LAS float*)(F.lds + F.wave * 16384);
    const int gw = F.bid * NWAVES + F.wave, NGW = F.G * NWAVES;
    const size_t gt = (size_t)F.bid * NTHR + F.tid, NGT = (size_t)F.G * NTHR;
    GAS bf16* W = (GAS bf16*)F.W;
    constexpr int NITEMS = 2 * 2048 + 2 * 512 + 6 * 512 + 4 * 32 + 4 * 32 + 2 * 64 + 64 + 512 + 1536 + 2 * 512 + 512;
    for (int it = gw; it < NITEMS; it += NGW) {
        int r = it;
        TRJOB(0, 2048, INP(IN_ML_WIN), 4096, 128, (GAS bf16*)(F.W + W_ML_WIN), 1024, 0, 0, nullptr)
        TRJOB(0, 2048, INP(IN_ML_WIN) + (size_t)1024 * 4096, 4096, 128, (GAS bf16*)(F.W + W_ML_WIN + W_ML_WIN_SZ), 1024, 0, 0, nullptr)
        TRJOB(0, 512, INP(IN_ML_WOUT), 1024, 32, (GAS bf16*)(F.W + W_ML_WOUT), 1024, 0, 0, nullptr)
        TRJOB(0, 512, INP(IN_ML_WOUT) + (size_t)1024 * 1024, 1024, 32, (GAS bf16*)(F.W + W_ML_WOUT + 2 * MiB), 1024, 0, 0, nullptr)
        GAS bf16* RWIN = (GAS bf16*)(F.W + W_RW_IN); const GAS float* mu = INP(IN_RW_MU);
        if (r < 6 * 512) { const int idx = r / 1024, ps = (r / 512) & 1, rr = r & 511;
            if (!ps) tr_item<0>(INP(IN_RW_WRKV) + (size_t)idx * 1024 * 1024, 1024, 32, RWIN, 1024, idx * 1024, 0, nullptr, scr, rr, F.lane);
            continue; } r -= 6 * 512;
        if (r < 4 * 32) { const int dir = r / 64, ps = (r / 32) & 1, rr = r & 31;
            tr_item<0>(INP(IN_RW_W1) + (size_t)dir * 1024 * 64, 64, 2, RWIN, 2048, 3072 + dir * 64, ps * 1024, ps ? mu + 3 * 1024 : nullptr, scr, rr, F.lane); continue; } r -= 4 * 32;
        if (r < 4 * 32) { const int dir = r / 64, ps = (r / 32) & 1, rr = r & 31;
            tr_item<0>(INP(IN_RW_A1) + (size_t)dir * 1024 * 64, 64, 2, RWIN, 2048, 3200 + dir * 64, ps * 1024, ps ? mu + 4 * 1024 : nullptr, scr, rr, F.lane); continue; } r -= 4 * 32;
        if (r < 2 * 64) { const int ps = r / 64, rr = r & 63;
            tr_item<0>(INP(IN_RW_G1), 128, 4, RWIN, 2048, 3328, ps * 1024, ps ? mu + 5 * 1024 : nullptr, scr, rr, F.lane); continue; } r -= 2 * 64;
        TRJOB(0, 64, INP(IN_RW_G2), 1024, 32, (GAS bf16*)(F.W + W_RW_G2), 256, 0, 0, nullptr)
        TRJOB(0, 512, INP(IN_RW_WOUT), 1024, 32, (GAS bf16*)(F.W + W_RW_WOUT), 1024, 0, 0, nullptr)
        TRJOB(0, 1536, INP(IN_HG_WIN), 3072, 96, (GAS bf16*)(F.W + W_HG_IN), 1024, 0, 0, nullptr)
        TRJOB(0, 512, INP(IN_HG_WF), 1024, 32, (GAS bf16*)(F.W + W_HG_IN), 1024, 3072, 0, nullptr)
        TRJOB(0, 512, INP(IN_HG_WF) + (size_t)1024 * 1024, 1024, 32, (GAS bf16*)(F.W + W_HG_IN), 1024, 4096, 0, nullptr)
        TRJOB(0, 512, INP(IN_HG_WOUT), 1024, 32, (GAS bf16*)(F.W + W_HG_WOUT), 1024, 0, 0, nullptr)
    }
    for (size_t i = gt; i < (size_t)2 * 256 * 1024; i += NGT) { const int j = (int)(i >> 18), rr = (int)((i >> 10) & 255), k = (int)(i & 1023);
        float v = 0.f; if (rr < 32) { const int dir = rr >> 4, g = rr & 15; v = INP(IN_ML_WGATE)[((size_t)(j * 2 + dir) * 1024 + k) * 16 + g]; }
        ((GAS bf16*)(F.W + W_ML_WIN + j * W_ML_WIN_SZ))[(size_t)(4096 + rr) * 1024 + k] = (bf16)f2bf(v); }
    for (size_t i = gt; i < (size_t)128 * 2048; i += NGT) ((GAS bf16*)(F.W + W_RW_IN))[(size_t)3456 * 2048 + i] = 0;
    for (size_t i = gt; i < (size_t)1024 * 128; i += NGT) ((GAS bf16*)(F.W + W_RW_G2))[(i >> 7) * 256 + 128 + (i & 127)] = 0;
    if (F.bid == 0) for (int c = F.tid; c < 1024; c += NTHR) { const GAS float* lg = INP(IN_HG_LB) + c; const float l0 = lg[0], l1 = lg[1024], l2 = lg[2048], l3 = lg[3072];
        const float mx = fmaxf(fmaxf(l0, l1), fmaxf(l2, l3)); const float e0 = __expf(l0 - mx), e1 = __expf(l1 - mx), e2 = __expf(l2 - mx), e3 = __expf(l3 - mx);
        ((GAS float*)(F.ws + WS_LB))[c] = (e1 + e2) / (e0 + e1 + e2 + e3); }
    { LAS float* sc = (LAS float*)(F.lds + 8448); GAS float* MODP = (GAS float*)(F.ws + WS_MIX);
      for (int it = F.bid; it < 768; it += F.G) { const int i = it / 192, rem = it - i * 192, kc = rem / 12, jb = rem - kc * 12;
          __syncthreads();
          if (F.tid < 320) { const int seg = F.tid >> 6, kk = F.tid & 63; const float cv = seg == 0 ? INP(IN_CCTX)[kc * 64 + kk] : INP(IN_C)[(seg - 1) * 1024 + kc * 64 + kk]; sc[F.tid] = silu_f(cv); }
          __syncthreads();
          const int j = jb * 512 + F.tid; const GAS float* wp = INP(IN_ADAW) + ((size_t)i * 1024 + kc * 64) * 6144 + j;
          float a0 = 0.f, a1 = 0.f, a2 = 0.f, a3 = 0.f, a4 = 0.f;
#pragma unroll 8
          for (int kk = 0; kk < 64; ++kk) { const float w = wp[(size_t)kk * 6144]; a0 += sc[kk] * w; a1 += sc[64 + kk] * w; a2 += sc[128 + kk] * w; a3 += sc[192 + kk] * w; a4 += sc[256 + kk] * w; }
          GAS float* mp = MODP + ((size_t)kc * 4 + i) * 5 * 6144 + j;
          mp[0] = a0; mp[6144] = a1; mp[2 * 6144] = a2; mp[3 * 6144] = a3; mp[4 * 6144] = a4; } }
}
PHASE_FN void modsum_phase(Frame F) {
    const GAS float* MODP = (const GAS float*)(F.ws + WS_MIX); GAS float* MOD = (GAS float*)(F.ws + WS_MOD);
    for (int idx = F.bid * NTHR + F.tid; idx < 4 * 5 * 6144; idx += F.G * NTHR) { const int i = idx / (5 * 6144), j = idx % 6144;
        float a = INP(IN_ADAB)[i * 6144 + j];
#pragma unroll
        for (int kc = 0; kc < 16; ++kc) a += MODP[(size_t)kc * 4 * 5 * 6144 + idx];
        MOD[idx] = a; }
}
struct ExwItem { const GAS float* src; GAS bf16* dst; int ldw, ldd, map; };
__device__ __forceinline__ ExwItem exw_item(const Frame& F, const GAS float* w1, const GAS float* w3, const GAS float* w2, int it) {
    const int which = it >> 12, e = (it >> 8) & 15, rr = it & 255; ExwItem x;
    if (which < 2) { const int kb = rr >> 4, nb = rr & 15; x.src = (which ? w3 : w1) + (size_t)e * 1024 * 512 + (size_t)(64 * kb) * 512 + 32 * nb; x.ldw = 512; x.ldd = 1024; x.map = which + 1;
        x.dst = (GAS bf16*)(F.W + W_EX13) + (size_t)(e * 1024 + 2 * (32 * nb)) * 1024 + 64 * kb; }
    else { const int kb = rr >> 5, nb = rr & 31; x.src = w2 + (size_t)e * 512 * 1024 + (size_t)(64 * kb) * 1024 + 32 * nb; x.ldw = 1024; x.ldd = 512; x.map = 0;
        x.dst = (GAS bf16*)(F.W + W_EX2) + (size_t)(e * 1024 + 32 * nb) * 512 + 64 * kb; }
    return x; }
PHASE_FN void expert_weights(Frame F, int L) {
    LAS float* scr = (LAS float*)(F.lds + F.wave * 16384);
    const int gw = F.bid * NWAVES + F.wave, NGW = F.G * NWAVES, lane = F.lane;
    const GAS float* w1 = INP(IN_EX_W1) + (size_t)L * 16 * 1024 * 512; const GAS float* w3 = INP(IN_EX_W3) + (size_t)L * 16 * 1024 * 512; const GAS float* w2 = INP(IN_EX_W2) + (size_t)L * 16 * 512 * 1024;
    const int lk = lane >> 3, ln = (lane & 7) * 4;
    f32x4 v[8]; int it = gw;
    if (it < 3 * 4096) { const ExwItem x = exw_item(F, w1, w3, w2, it);
#pragma unroll
        for (int i = 0; i < 8; ++i) v[i] = *(const GAS f32x4*)(x.src + (size_t)(lk + 8 * i) * x.ldw + ln); }
    for (; it < 3 * 4096; it += NGW) {
        const ExwItem x = exw_item(F, w1, w3, w2, it);
#pragma unroll
        for (int i = 0; i < 8; ++i) { LAS float* d = scr + (lk + 8 * i) * 33 + ln; d[0] = v[i][0]; d[1] = v[i][1]; d[2] = v[i][2]; d[3] = v[i][3]; }
        if (it + NGW < 3 * 4096) { const ExwItem y = exw_item(F, w1, w3, w2, it + NGW);
#pragma unroll
            for (int i = 0; i < 8; ++i) v[i] = *(const GAS f32x4*)(y.src + (size_t)(lk + 8 * i) * y.ldw + ln); }
        LDS_WAIT(); asm volatile("" ::: "memory");
        const int c = lane & 7;
#pragma unroll
        for (int j = 0; j < 4; ++j) { const int n = (lane >> 3) + 8 * j; const LAS float* s_ = scr + (8 * c) * 33 + n;
            u32x4 o; o.x = pk2(s_[0 * 33], s_[1 * 33]); o.y = pk2(s_[2 * 33], s_[3 * 33]); o.z = pk2(s_[4 * 33], s_[5 * 33]); o.w = pk2(s_[6 * 33], s_[7 * 33]);
            const int drow = x.map == 0 ? n : 2 * (n & ~3) + (n & 3) + (x.map == 2 ? 4 : 0);
            *(GAS u32x4*)(x.dst + (size_t)drow * x.ldd + 8 * c) = o; }
        LDS_WAIT(); asm volatile("" ::: "memory");
    }
}

template <int MODE, int PRB = 0> PHASE_FN void norm_phase(Frame F, int L, bool add_moe, int ldh, bool from_x = false) {
    GAS unsigned char* S = F.ws + WS_S; GAS bf16* H = (GAS bf16*)(F.ws + WS_HY); const GAS bf16* YM = (const GAS bf16*)(F.ws + WS_MIX + 210 * MiB);
    const GAS float* MOD = (const GAS float*)(F.ws + WS_MOD);
    const int gw = F.bid * NWAVES + F.wave, NGW = F.G * NWAVES, lane = F.lane;
    LAS float* rwl = (LAS float*)F.lds;
    LAS int* cntl = (LAS int*)(F.lds + 65536);
    if (MODE == 1) {
        for (int i = F.tid; i < 16384; i += NTHR) { const int c = i >> 4, e = i & 15; rwl[e * 1024 + c] = INP(IN_ROUTER_W)[i]; }
        if (F.tid < 16) cntl[F.tid] = 0;
        __syncthreads();
    }
    const GAS float* gnp = MODE == 0 ? INP(IN_NMIX) + L * 1024 : (MODE == 1 ? INP(IN_NFFN) + L * 1024 : INP(IN_NOUT));
    for (int m = gw; m < NTOK; m += NGW) {
        const int b = m / T, t = m - b * T, seg = t < CTX ? 0 : 1 + b;
        if (MODE == 2 && t < CTX) continue;
        f32x4 v[4]; const size_t sp = (size_t)m * 256 + lane;
        if (MODE == 0 && from_x) { const GAS f32x4* src = (const GAS f32x4*)((t < CTX) ? INP(IN_CTX) + ((size_t)(b * CTX + t)) * 1024 : INP(IN_X) + ((size_t)(b * SEQ + t - CTX)) * 1024) + lane;
#pragma unroll
            for (int j = 0; j < 4; ++j) v[j] = src[64 * j];
            if (!PRB) {
#pragma unroll
                for (int j = 0; j < 4; ++j) stS4(S, sp + 64 * j, v[j]); }
        } else {
#pragma unroll
            for (int j = 0; j < 4; ++j) v[j] = ldS4(S, sp + 64 * j); }
        if (add_moe) {
            const GAS float* gp = MOD + ((size_t)((MODE == 2 ? 3 : L - 1) * 5 + seg)) * 6144 + 5 * 1024;
            const GAS u32x2* ya = (const GAS u32x2*)(YM + (size_t)(2 * m) * 1024) + lane; const GAS u32x2* yb = ya + 256;
#pragma unroll
            for (int j = 0; j < 4; ++j) { const u32x2 a = ya[64 * j], bq = yb[64 * j]; const f32x4 g = ((const GAS f32x4*)gp)[lane + 64 * j];
                v[j][0] += g[0] * (bflo(a.x) + bflo(bq.x)); v[j][1] += g[1] * (bfhi(a.x) + bfhi(bq.x)); v[j][2] += g[2] * (bflo(a.y) + bflo(bq.y)); v[j][3] += g[3] * (bfhi(a.y) + bfhi(bq.y)); }
            if (MODE != 2 && !PRB) {
#pragma unroll
                for (int j = 0; j < 4; ++j) stS4(S, sp + 64 * j, v[j]); }
        }
        float ss = 0.f;
#pragma unroll
        for (int j = 0; j < 4; ++j) ss += (v[j][0] * v[j][0] + v[j][1] * v[j][1]) + (v[j][2] * v[j][2] + v[j][3] * v[j][3]);
        const float rinv = __builtin_amdgcn_rsqf(wave_sum_dpp(ss) * (1.0f / 1024.0f) + 1e-6f);
        if (MODE == 2) { GAS f32x4* op = (GAS f32x4*)(F.out + ((size_t)(b * SEQ + t - CTX)) * 1024) + lane;
#pragma unroll
            for (int j = 0; j < 4; ++j) { const f32x4 g = ((const GAS f32x4*)gnp)[lane + 64 * j]; op[64 * j] = v[j] * rinv * g; }
            continue; }
        const GAS float* mp = MOD + ((size_t)(L * 5 + seg)) * 6144 + (MODE == 0 ? 0 : 3 * 1024);
        f32x4 h[4];
#pragma unroll
        for (int j = 0; j < 4; ++j) { const f32x4 g = ((const GAS f32x4*)gnp)[lane + 64 * j], sh = ((const GAS f32x4*)mp)[lane + 64 * j], sc = ((const GAS f32x4*)(mp + 1024))[lane + 64 * j];
            h[j] = v[j] * rinv * g * (sc + 1.0f) + sh;
            u32x2 o; o.x = pk2(h[j][0], h[j][1]); o.y = pk2(h[j][2], h[j][3]); *((GAS u32x2*)(H + (size_t)m * ldh) + lane + 64 * j) = o; }
        if (MODE == 1) {
            float lg[16];
#pragma unroll
            for (int e = 0; e < 16; ++e) { float a = 0.f;
#pragma unroll
                for (int j = 0; j < 4; ++j) { const f32x4 w = *(const LAS f32x4*)(rwl + e * 1024 + 256 * j + 4 * lane); a += (h[j][0] * w[0] + h[j][1] * w[1]) + (h[j][2] * w[2] + h[j][3] * w[3]); }
                lg[e] = wave_sum_dpp(a); }
            float aff[16], sel[16];
#pragma unroll
            for (int e = 0; e < 16; ++e) { aff[e] = sigmoid_f(lg[e]); sel[e] = aff[e] + INP(IN_ROUTER_B)[e]; }
            float best = -3.0e38f; int bg = 0; float s0 = 0.f, s1 = 0.f, s2 = 0.f, s3 = 0.f, a0 = 0.f, a1 = 0.f, a2 = 0.f, a3 = 0.f;
#pragma unroll
            for (int g = 0; g < 4; ++g) { const float x0 = sel[4 * g], x1 = sel[4 * g + 1], x2 = sel[4 * g + 2], x3 = sel[4 * g + 3];
                const float t1 = fmaxf(x0, x1), t2 = fminf(x0, x1), u1 = fmaxf(x2, x3), u2 = fminf(x2, x3);
                const float sum = fmaxf(t1, u1) + fmaxf(fminf(t1, u1), fmaxf(t2, u2));
                const bool bt = sum > best; best = bt ? sum : best; bg = bt ? g : bg;
                s0 = bt ? x0 : s0; s1 = bt ? x1 : s1; s2 = bt ? x2 : s2; s3 = bt ? x3 : s3;
                a0 = bt ? aff[4 * g] : a0; a1 = bt ? aff[4 * g + 1] : a1; a2 = bt ? aff[4 * g + 2] : a2; a3 = bt ? aff[4 * g + 3] : a3; }
            int i1 = 0; float m1 = s0; if (s1 > m1) { m1 = s1; i1 = 1; } if (s2 > m1) { m1 = s2; i1 = 2; } if (s3 > m1) { m1 = s3; i1 = 3; }
            int i2 = -1; float m2 = -3.0e38f;
            if (i1 != 0 && s0 > m2) { m2 = s0; i2 = 0; } if (i1 != 1 && s1 > m2) { m2 = s1; i2 = 1; } if (i1 != 2 && s2 > m2) { m2 = s2; i2 = 2; } if (i1 != 3 && s3 > m2) { m2 = s3; i2 = 3; }
            const float c1 = i1 == 0 ? a0 : (i1 == 1 ? a1 : (i1 == 2 ? a2 : a3)), c2 = i2 == 0 ? a0 : (i2 == 1 ? a1 : (i2 == 2 ? a2 : a3));
            const float inv = 1.0f / (c1 + c2);
            if (lane == 0) { const int e1 = bg * 4 + i1, e2 = bg * 4 + i2;
                u32x4 tk; tk.x = (unsigned)e1; tk.y = (unsigned)e2; tk.z = __float_as_uint(c1 * inv); tk.w = __float_as_uint(c2 * inv); ((GAS u32x4*)(F.ws + WS_TOK))[m] = tk;
                __hip_atomic_fetch_add(cntl + e1, 1, __ATOMIC_RELAXED, __HIP_MEMORY_SCOPE_WORKGROUP); __hip_atomic_fetch_add(cntl + e2, 1, __ATOMIC_RELAXED, __HIP_MEMORY_SCOPE_WORKGROUP); }
        }
    }
    if (MODE == 1) { __syncthreads(); if (F.tid < 16) __hip_atomic_fetch_add((GAS unsigned*)F.ws + CW_MOE + L * 2048 + (PRB ? 32 : 0) + 64 * F.tid, (unsigned)cntl[F.tid], __ATOMIC_RELAXED, __HIP_MEMORY_SCOPE_AGENT); }
}

template <int PRB = 0> PHASE_FN void route_phase(Frame F, int L) {
    const GAS unsigned char* S = F.ws + WS_S; GAS bf16* H = (GAS bf16*)(F.ws + WS_HY); const GAS float* MOD = (const GAS float*)(F.ws + WS_MOD);
    const int gw = F.bid * NWAVES + F.wave, NGW = F.G * NWAVES, lane = F.lane, hl = lane & 31, hi = lane >> 5;
    LAS float* rwl = (LAS float*)F.lds;
    LAS int* cntl = (LAS int*)(F.lds + 65536);
    for (int i = F.tid; i < 16384; i += NTHR) { const int c = i >> 4, e = i & 15; rwl[e * 1024 + c] = INP(IN_ROUTER_W)[i]; }
    if (F.tid < 16) cntl[F.tid] = 0;
    __syncthreads();
    const GAS float* gnp = INP(IN_NFFN) + L * 1024; const GAS float* rbp = INP(IN_ROUTER_B);
    constexpr int NP = NTOK / 2; const int pq = NP / NGW, pr = NP - pq * NGW; const int p0 = gw * pq + (gw < pr ? gw : pr), pn = pq + (gw < pr ? 1 : 0);
    f32x4 vn[8], Av[8], Bv[8]; int curseg = -1;
    if (pn > 0) { const size_t sp0 = (size_t)(2 * p0 + hi) * 256 + hl;
#pragma unroll
        for (int j = 0; j < 8; ++j) vn[j] = ldS4(S, sp0 + 32 * j); }
    for (int mp = p0; mp < p0 + pn; ++mp) {
        const int m = 2 * mp + hi; const int b = m / T, t = m - b * T, seg = t < CTX ? 0 : 1 + b;
        f32x4 v[8];
        float ss = 0.f;
#pragma unroll
        for (int j = 0; j < 8; ++j) { v[j] = vn[j]; ss += (v[j][0] * v[j][0] + v[j][1] * v[j][1]) + (v[j][2] * v[j][2] + v[j][3] * v[j][3]); }
        if (mp + 1 < p0 + pn) { const size_t spn = (size_t)(2 * (mp + 1) + hi) * 256 + hl;
#pragma unroll
            for (int j = 0; j < 8; ++j) vn[j] = ldS4(S, spn + 32 * j); }
        if (__builtin_amdgcn_readfirstlane(seg) != curseg) { curseg = __builtin_amdgcn_readfirstlane(seg); const GAS float* mpv = MOD + ((size_t)(L * 5 + curseg)) * 6144 + 3 * 1024;
#pragma unroll
            for (int j = 0; j < 8; ++j) { const f32x4 g = ((const GAS f32x4*)gnp)[hl + 32 * j], sh = ((const GAS f32x4*)mpv)[hl + 32 * j], scl = ((const GAS f32x4*)(mpv + 1024))[hl + 32 * j]; Av[j] = g * (scl + 1.0f); Bv[j] = sh; } }
        ss = row16_sum(ss); ss += dpp_keep<0x142, 0xA>(0.f, ss);
        { const float s0 = __builtin_bit_cast(float, __builtin_amdgcn_readlane(__builtin_bit_cast(int, ss), 31)), s1 = __builtin_bit_cast(float, __builtin_amdgcn_readlane(__builtin_bit_cast(int, ss), 63)); ss = hi ? s1 : s0; }
        const float rinv = __builtin_amdgcn_rsqf(ss * (1.0f / 1024.0f) + 1e-6f);
#pragma unroll
        for (int j = 0; j < 8; ++j) { v[j] = v[j] * rinv * Av[j] + Bv[j];
            u32x2 o; o.x = pk2(v[j][0], v[j][1]); o.y = pk2(v[j][2], v[j][3]); *((GAS u32x2*)(H + (size_t)m * 1024) + hl + 32 * j) = o; }
        float lg[16];
#pragma unroll
        for (int e = 0; e < 16; ++e) { float a = 0.f, a2 = 0.f;
#pragma unroll
            for (int j = 0; j < 8; ++j) { const f32x4 w = *(const LAS f32x4*)(rwl + e * 1024 + 128 * j + 4 * hl); a = fmaf(v[j][0], w[0], a); a2 = fmaf(v[j][1], w[1], a2); a = fmaf(v[j][2], w[2], a); a2 = fmaf(v[j][3], w[3], a2); }
            a += a2; a = row16_sum(a); a += dpp_keep<0x142, 0xA>(0.f, a);
            const float a0 = __builtin_bit_cast(float, __builtin_amdgcn_readlane(__builtin_bit_cast(int, a), 31)), a1 = __builtin_bit_cast(float, __builtin_amdgcn_readlane(__builtin_bit_cast(int, a), 63));
            lg[e] = hi ? a1 : a0; }
        float aff[16], sel[16];
#pragma unroll
        for (int e = 0; e < 16; ++e) { aff[e] = sigmoid_f(lg[e]); sel[e] = aff[e] + rbp[e]; }
        float best = -3.0e38f; int bg = 0; float s0 = 0.f, s1 = 0.f, s2 = 0.f, s3 = 0.f, a0 = 0.f, a1 = 0.f, a2 = 0.f, a3 = 0.f;
#pragma unroll
        for (int g = 0; g < 4; ++g) { const float x0 = sel[4 * g], x1 = sel[4 * g + 1], x2 = sel[4 * g + 2], x3 = sel[4 * g + 3];
            const float t1 = fmaxf(x0, x1), t2 = fminf(x0, x1), u1 = fmaxf(x2, x3), u2 = fminf(x2, x3);
            const float sum = fmaxf(t1, u1) + fmaxf(fminf(t1, u1), fmaxf(t2, u2));
            const bool bt = sum > best; best = bt ? sum : best; bg = bt ? g : bg;
            s0 = bt ? x0 : s0; s1 = bt ? x1 : s1; s2 = bt ? x2 : s2; s3 = bt ? x3 : s3;
            a0 = bt ? aff[4 * g] : a0; a1 = bt ? aff[4 * g + 1] : a1; a2 = bt ? aff[4 * g + 2] : a2; a3 = bt ? aff[4 * g + 3] : a3; }
        int i1 = 0; float m1 = s0; if (s1 > m1) { m1 = s1; i1 = 1; } if (s2 > m1) { m1 = s2; i1 = 2; } if (s3 > m1) { m1 = s3; i1 = 3; }
        int i2 = -1; float m2 = -3.0e38f;
        if (i1 != 0 && s0 > m2) { m2 = s0; i2 = 0; } if (i1 != 1 && s1 > m2) { m2 = s1; i2 = 1; } if (i1 != 2 && s2 > m2) { m2 = s2; i2 = 2; } if (i1 != 3 && s3 > m2) { m2 = s3; i2 = 3; }
        const float c1 = i1 == 0 ? a0 : (i1 == 1 ? a1 : (i1 == 2 ? a2 : a3)), c2 = i2 == 0 ? a0 : (i2 == 1 ? a1 : (i2 == 2 ? a2 : a3));
        const float inv = __builtin_amdgcn_rcpf(c1 + c2);
        if (hl == 0) { const int e1 = bg * 4 + i1, e2 = bg * 4 + i2;
            u32x4 tk; tk.x = (unsigned)e1; tk.y = (unsigned)e2; tk.z = __float_as_uint(c1 * inv); tk.w = __float_as_uint(c2 * inv); ((GAS u32x4*)(F.ws + WS_TOK))[m] = tk;
            __hip_atomic_fetch_add(cntl + e1, 1, __ATOMIC_RELAXED, __HIP_MEMORY_SCOPE_WORKGROUP); __hip_atomic_fetch_add(cntl + e2, 1, __ATOMIC_RELAXED, __HIP_MEMORY_SCOPE_WORKGROUP); }
    }
    __syncthreads();
    if (F.tid < 16) __hip_atomic_fetch_add((GAS unsigned*)F.ws + CW_MOE + L * 2048 + (PRB ? 32 : 0) + 64 * F.tid, (unsigned)cntl[F.tid], __ATOMIC_RELAXED, __HIP_MEMORY_SCOPE_AGENT);
}

__device__ __forceinline__ float qsum4r(float x) { float a = x, b = x; asm volatile("s_nop 1\n\tv_permlane16_swap_b32 %0, %1\n\ts_nop 1" : "+v"(a), "+v"(b)); const float y = a + b; float c = y, d = y; asm volatile("s_nop 1\n\tv_permlane32_swap_b32 %0, %1\n\ts_nop 1" : "+v"(c), "+v"(d)); return c + d; }
template <int PRB = 0> PHASE_FN void route2_phase(Frame F, int L) {
    const int nb = NTOK / F.G + (F.bid < NTOK % F.G ? 1 : 0), R0 = F.bid * (NTOK / F.G) + (F.bid < NTOK % F.G ? F.bid : NTOK % F.G);
    if (!S_BF16 || nb > 256) { route_phase<PRB>(F, L); return; }
    const GAS unsigned char* S = F.ws + WS_S; GAS bf16* H = (GAS bf16*)(F.ws + WS_HY); const GAS float* MOD = (const GAS float*)(F.ws + WS_MOD);
    constexpr int WP = 1032;
    LAS bf16* WHi = (LAS bf16*)F.lds; LAS bf16* WLo = WHi + 16 * WP;
    LAS float* MA = (LAS float*)(F.lds + 66048);
    LAS float* LG = (LAS float*)(F.lds + 82432);
    LAS int* cntl = (LAS int*)(F.lds + 90624);
    const int tid = F.tid, lane = F.lane, w = F.wave, r = lane & 15, q = lane >> 4;
    const int bF = R0 / T, tF = R0 - bF * T, sF = tF < CTX ? 0 : 1 + bF, bL = (R0 + nb - 1) / T, tL = (R0 + nb - 1) - bL * T, sL = tL < CTX ? 0 : 1 + bL;
    const GAS float* gnp = INP(IN_NFFN) + L * 1024; const GAS float* rbp = INP(IN_ROUTER_B);
    for (int c = tid; c < 1024; c += NTHR) { const GAS f32x4* src = (const GAS f32x4*)(INP(IN_ROUTER_W) + c * 16);
#pragma unroll
        for (int e4 = 0; e4 < 4; ++e4) { const f32x4 v = src[e4];
#pragma unroll
            for (int j = 0; j < 4; ++j) { const unsigned hi = f2bf(v[j]); WHi[(4 * e4 + j) * WP + c] = (bf16)hi; WLo[(4 * e4 + j) * WP + c] = (bf16)f2bf(v[j] - bf2f(hi)); } } }
    for (int i = tid; i < 2048; i += NTHR) { const int sl = i >> 10, c = i & 1023; const GAS float* mpv = MOD + ((size_t)(L * 5 + (sl ? sL : sF))) * 6144 + 3 * 1024;
        MA[sl * 2048 + c] = gnp[c] * (mpv[1024 + c] + 1.0f); MA[sl * 2048 + 1024 + c] = mpv[c]; }
    if (tid < 16) cntl[tid] = 0;
    __syncthreads();
    const int nw = nb / NWAVES + (w < nb % NWAVES ? 1 : 0), wr0 = R0 + w * (nb / NWAVES) + (w < nb % NWAVES ? w : nb % NWAVES);
    for (int t0 = 0; t0 < nw; t0 += 16) {
        const int nrow = (nw - t0) < 16 ? (nw - t0) : 16;
        const int row = wr0 + t0 + (r < nrow ? r : nrow - 1);
        u32x4 vs[32]; { const GAS u32x4* sp = (const GAS u32x4*)(S + (size_t)row * 2048) + q;
#pragma unroll
            for (int kk = 0; kk < 32; ++kk) vs[kk] = sp[4 * kk]; }
        float ss = 0.f;
#pragma unroll
        for (int kk = 0; kk < 32; ++kk) {
#pragma unroll
            for (int j = 0; j < 4; ++j) { const float xl = bflo(vs[kk][j]), xh = bfhi(vs[kk][j]); ss = __builtin_fmaf(xl, xl, ss); ss = __builtin_fmaf(xh, xh, ss);
                asm volatile("" : "+v"(vs[kk][j])); } }
        const float rinv = __builtin_amdgcn_rsqf(qsum4r(ss) * (1.0f / 1024.0f) + 1e-6f);
        const int b_ = row / T, t_ = row - b_ * T, seg = t_ < CTX ? 0 : 1 + b_; const LAS float* ma = MA + (seg == sF ? 0 : 2048) + 8 * q;
        const LAS bf16* whp = WHi + r * WP + 8 * q; const LAS bf16* wlp = WLo + r * WP + 8 * q; GAS bf16* hp_ = H + (size_t)row * 1024 + 8 * q;
        f32x4 acc = {0.f, 0.f, 0.f, 0.f};
#pragma unroll
        for (int kk = 0; kk < 32; ++kk) {
            const f32x4 A0 = *(const LAS f32x4*)(ma + 32 * kk), A1 = *(const LAS f32x4*)(ma + 32 * kk + 4), B0 = *(const LAS f32x4*)(ma + 1024 + 32 * kk), B1 = *(const LAS f32x4*)(ma + 1024 + 32 * kk + 4);
            const bf16x8 bh = *(const LAS bf16x8*)(whp + 32 * kk), bl = *(const LAS bf16x8*)(wlp + 32 * kk);
            const u32x4 x = vs[kk];
            const f32x4 h0 = (f32x4){bflo(x.x), bfhi(x.x), bflo(x.y), bfhi(x.y)} * rinv * A0 + B0, h1 = (f32x4){bflo(x.z), bfhi(x.z), bflo(x.w), bfhi(x.w)} * rinv * A1 + B1;
            u32x4 hi; hi.x = pk2(h0[0], h0[1]); hi.y = pk2(h0[2], h0[3]); hi.z = pk2(h1[0], h1[1]); hi.w = pk2(h1[2], h1[3]);
            const f32x4 l0 = h0 - (f32x4){bflo(hi.x), bfhi(hi.x), bflo(hi.y), bfhi(hi.y)}, l1 = h1 - (f32x4){bflo(hi.z), bfhi(hi.z), bflo(hi.w), bfhi(hi.w)};
            u32x4 lo; lo.x = pk2(l0[0], l0[1]); lo.y = pk2(l0[2], l0[3]); lo.z = pk2(l1[0], l1[1]); lo.w = pk2(l1[2], l1[3]);
            const bf16x8 ah = __builtin_bit_cast(bf16x8, hi), al = __builtin_bit_cast(bf16x8, lo);
            acc = __builtin_amdgcn_mfma_f32_16x16x32_bf16(ah, bh, acc, 0, 0, 0); acc = __builtin_amdgcn_mfma_f32_16x16x32_bf16(ah, bl, acc, 0, 0, 0); acc = __builtin_amdgcn_mfma_f32_16x16x32_bf16(al, bh, acc, 0, 0, 0);

            if (r < nrow) *(GAS u32x4*)(hp_ + 32 * kk) = hi; }
        LAS float* lgw = LG + w * 256;
#pragma unroll
        for (int i = 0; i < 4; ++i) lgw[(4 * q + i) * 16 + r] = acc[i];
        LDS_WAIT();
        if (lane < nrow) { const int m = wr0 + t0 + lane;
            float lg[16];
#pragma unroll
            for (int e4 = 0; e4 < 4; ++e4) { const f32x4 v = *(const LAS f32x4*)(lgw + lane * 16 + 4 * e4); lg[4 * e4] = v[0]; lg[4 * e4 + 1] = v[1]; lg[4 * e4 + 2] = v[2]; lg[4 * e4 + 3] = v[3]; }
            float aff[16], sel[16];
#pragma unroll
            for (int e = 0; e < 16; ++e) { aff[e] = sigmoid_f(lg[e]); sel[e] = aff[e] + rbp[e]; }
            float best = -3.0e38f; int bg = 0; float s0 = 0.f, s1 = 0.f, s2 = 0.f, s3 = 0.f, a0 = 0.f, a1 = 0.f, a2 = 0.f, a3 = 0.f;
#pragma unroll
            for (int g = 0; g < 4; ++g) { const float x0 = sel[4 * g], x1 = sel[4 * g + 1], x2 = sel[4 * g + 2], x3 = sel[4 * g + 3];
                const float t1 = fmaxf(x0, x1), t2 = fminf(x0, x1), u1 = fmaxf(x2, x3), u2 = fminf(x2, x3);
                const float sum = fmaxf(t1, u1) + fmaxf(fminf(t1, u1), fmaxf(t2, u2));
                const bool bt = sum > best; best = bt ? sum : best; bg = bt ? g : bg;
                s0 = bt ? x0 : s0; s1 = bt ? x1 : s1; s2 = bt ? x2 : s2; s3 = bt ? x3 : s3;
                a0 = bt ? aff[4 * g] : a0; a1 = bt ? aff[4 * g + 1] : a1; a2 = bt ? aff[4 * g + 2] : a2; a3 = bt ? aff[4 * g + 3] : a3; }
            int i1 = 0; float m1 = s0; if (s1 > m1) { m1 = s1; i1 = 1; } if (s2 > m1) { m1 = s2; i1 = 2; } if (s3 > m1) { m1 = s3; i1 = 3; }
            int i2 = -1; float m2 = -3.0e38f;
            if (i1 != 0 && s0 > m2) { m2 = s0; i2 = 0; } if (i1 != 1 && s1 > m2) { m2 = s1; i2 = 1; } if (i1 != 2 && s2 > m2) { m2 = s2; i2 = 2; } if (i1 != 3 && s3 > m2) { m2 = s3; i2 = 3; }
            const float c1 = i1 == 0 ? a0 : (i1 == 1 ? a1 : (i1 == 2 ? a2 : a3)), c2 = i2 == 0 ? a0 : (i2 == 1 ? a1 : (i2 == 2 ? a2 : a3));
            const float inv = __builtin_amdgcn_rcpf(c1 + c2);
            const int e1 = bg * 4 + i1, e2 = bg * 4 + i2;
            u32x4 tk; tk.x = (unsigned)e1; tk.y = (unsigned)e2; tk.z = __float_as_uint(c1 * inv); tk.w = __float_as_uint(c2 * inv); ((GAS u32x4*)(F.ws + WS_TOK))[m] = tk;
            __hip_atomic_fetch_add(cntl + e1, 1, __ATOMIC_RELAXED, __HIP_MEMORY_SCOPE_WORKGROUP); __hip_atomic_fetch_add(cntl + e2, 1, __ATOMIC_RELAXED, __HIP_MEMORY_SCOPE_WORKGROUP); }
        LDS_WAIT();
    }
    __syncthreads();
    if (F.tid < 16) __hip_atomic_fetch_add((GAS unsigned*)F.ws + CW_MOE + L * 2048 + (PRB ? 32 : 0) + 64 * F.tid, (unsigned)cntl[F.tid], __ATOMIC_RELAXED, __HIP_MEMORY_SCOPE_AGENT);
}

__device__ __forceinline__ void moe_prefix(const Frame& F, int L, LAS int* pref  , LAS int* cnt  ) {
    if (F.tid < 16) cnt[F.tid] = (int)__hip_atomic_load((GAS unsigned*)F.ws + CW_MOE + L * 2048 + 64 * F.tid, __ATOMIC_RELAXED, __HIP_MEMORY_SCOPE_AGENT);
    __syncthreads();
    if (F.tid == 0) { int p = 0; for (int e = 0; e < 16; ++e) { pref[e] = p; p += (cnt[e] + 255) >> 8; } pref[16] = p; }
    __syncthreads();
}
template <int PRB = 0> PHASE_FN void slots_phase(Frame F, int L) {
    LAS int* pref = (LAS int*)F.lds; LAS int* cnt = pref + 32;
    moe_prefix(F, L, pref, cnt);
    const int gw = F.bid * NWAVES + F.wave, NGW = F.G * NWAVES, lane = F.lane;
    GAS unsigned* cursor = (GAS unsigned*)F.ws + CW_MOE + L * 2048 + 1024 + (PRB ? 32 : 0);
    GAS int* slot_tok = (GAS int*)(F.ws + WS_SLOT_TOK); GAS float* slot_gate = (GAS float*)(F.ws + WS_SLOT_GATE);
    constexpr int SG = 4, NSW = (NTOK / 64 + SG - 1) / SG;
    if (F.wave == 0) for (int sw = F.bid; sw < NSW; sw += F.G) {
        u32x4 tk[SG]; int off0[SG], off1[SG]; int n_run = 0; const unsigned long long below = (1ull << lane) - 1ull;
#pragma unroll
        for (int j = 0; j < SG; ++j) { const int it = sw * SG + j; tk[j] = (it < NTOK / 64) ? ((const GAS u32x4*)(F.ws + WS_TOK))[it * 64 + lane] : (u32x4){99u, 99u, 0u, 0u}; }
#pragma unroll
        for (int j = 0; j < SG; ++j) { const int e0 = (int)tk[j].x, e1 = (int)tk[j].y; int n_me = 0, rank0 = 0, rank1 = 0;
#pragma unroll
            for (int ee = 0; ee < 16; ++ee) { const unsigned long long m0 = __ballot(e0 == ee), m1 = __ballot(e1 == ee);
                if (lane == ee) n_me = __popcll(m0); if (lane == 16 + ee) n_me = __popcll(m1);
                if (e0 == ee) rank0 = __popcll(m0 & below); if (e1 == ee) rank1 = __popcll(m1 & below); }
            off0[j] = __builtin_amdgcn_ds_bpermute((e0 & 15) << 2, n_run) + rank0; off1[j] = __builtin_amdgcn_ds_bpermute((16 + (e1 & 15)) << 2, n_run) + rank1; n_run += n_me; }
        unsigned base = 0; if (lane < 32 && n_run > 0) base = __hip_atomic_fetch_add(cursor + 64 * (lane & 15), (unsigned)n_run, __ATOMIC_RELAXED, __HIP_MEMORY_SCOPE_AGENT);
#pragma unroll
        for (int j = 0; j < SG; ++j) { const int it = sw * SG + j; const int e0 = (int)tk[j].x, e1 = (int)tk[j].y, m = it * 64 + lane;
            const int b0 = __builtin_amdgcn_ds_bpermute((e0 & 15) << 2, (int)base), b1 = __builtin_amdgcn_ds_bpermute((16 + (e1 & 15)) << 2, (int)base);
            if (it < NTOK / 64) { const int s0 = pref[e0] * 256 + b0 + off0[j], s1 = pref[e1] * 256 + b1 + off1[j];
                slot_tok[s0] = 2 * m; slot_gate[s0] = __uint_as_float(tk[j].z); slot_tok[s1] = 2 * m + 1; slot_gate[s1] = __uint_as_float(tk[j].w); } }
    }
    for (int e = 0; e < 16; ++e) { const int lo = pref[e] * 256 + cnt[e], hi = pref[e + 1] * 256;
        for (int s_ = lo + gw * 64 + lane; s_ < hi; s_ += NGW * 64) { slot_tok[s_] = -1; slot_gate[s_] = 0.f; } }
}

PHASE_FN void du_phase(Frame F, GAS bf16* M0, GAS bf16* M1, GAS bf16* M2) {
    GAS bf16* H2 = (GAS bf16*)(F.ws + WS_HY); const GAS float* mu = INP(IN_RW_MU);
    const size_t gt = (size_t)F.bid * NTHR + F.tid, NGT = (size_t)F.G * NTHR;
    for (size_t i = gt; i < (size_t)NTOK * 128; i += NGT) { const int m = (int)(i >> 7), c8 = (int)(i & 127); const int t = m % T;
        const bool hp = !(t == 0 || t == CTX), hn = !(t == CTX - 1 || t == T - 1);
        const u32x4 z = {0u, 0u, 0u, 0u};
        const u32x4 u = *(const GAS u32x4*)(H2 + (size_t)m * 2048 + c8 * 8), p = hp ? *(const GAS u32x4*)(H2 + (size_t)(m - 1) * 2048 + c8 * 8) : z, n = hn ? *(const GAS u32x4*)(H2 + (size_t)(m + 1) * 2048 + c8 * 8) : z;
        float uf[8], df[8];
#pragma unroll
        for (int j = 0; j < 4; ++j) { uf[2 * j] = bflo(u[j]); uf[2 * j + 1] = bfhi(u[j]); df[2 * j] = 0.5f * (bflo(p[j]) + bflo(n[j])) - uf[2 * j]; df[2 * j + 1] = 0.5f * (bfhi(p[j]) + bfhi(n[j])) - uf[2 * j + 1]; }
        u32x4 o;
#pragma unroll
        for (int j = 0; j < 4; ++j) o[j] = pk2(df[2 * j], df[2 * j + 1]);
        *(GAS u32x4*)(H2 + (size_t)m * 2048 + 1024 + c8 * 8) = o;
#pragma unroll
        for (int idx = 0; idx < 3; ++idx) { const f32x4 m0 = *(const GAS f32x4*)(mu + idx * 1024 + c8 * 8), m1 = *(const GAS f32x4*)(mu + idx * 1024 + c8 * 8 + 4); u32x4 x;
            x.x = pk2(uf[0] + m0[0] * df[0], uf[1] + m0[1] * df[1]); x.y = pk2(uf[2] + m0[2] * df[2], uf[3] + m0[3] * df[3]); x.z = pk2(uf[4] + m1[0] * df[4], uf[5] + m1[1] * df[5]); x.w = pk2(uf[6] + m1[2] * df[6], uf[7] + m1[3] * df[7]);
            *(GAS u32x4*)((idx == 0 ? M0 : (idx == 1 ? M1 : M2)) + (size_t)m * 1024 + c8 * 8) = x; } }
}

PHASE_FN void conv_phase(Frame F, int j) {
    const GAS bf16* QP = (const GAS bf16*)(F.ws + WS_MIX); GAS bf16* QK = (GAS bf16*)(F.ws + WS_HY); const GAS float* cw = INP(IN_ML_CONV) + (size_t)j * 9 * 2048;
    const int groups = F.G >> 2; if (F.bid >= groups * 4 || groups == 0) return;
    const int q4 = F.bid & 3, c = (q4 * 64 + (F.tid & 63)) * 8, oct = F.tid >> 6;
    float wgt[9][8];
#pragma unroll
    for (int tp = 0; tp < 9; ++tp) { const f32x4 w0 = *(const GAS f32x4*)(cw + tp * 2048 + c), w1 = *(const GAS f32x4*)(cw + tp * 2048 + c + 4);
#pragma unroll
        for (int e = 0; e < 4; ++e) { wgt[tp][e] = w0[e]; wgt[tp][4 + e] = w1[e]; } }
    const float sc = c >= 1024 ? 0.08838834764831845f : 1.0f;
    const int NR_ = NB * 132, hb_ = (groups & 1) ? 0 : ((F.bid >> 2) & 1), nj_ = (groups & 1) ? groups : (groups >> 1), j0_ = (groups & 1) ? (F.bid >> 2) : (F.bid >> 3);
    const int lo_ = (groups & 1) ? 0 : hb_ * ((NR_ + 1) / 2), hi_ = (groups & 1) ? NR_ : (hb_ ? NR_ : (NR_ + 1) / 2);
    for (int rr = lo_ + j0_; rr < hi_; rr += nj_) {
        const int b = rr / 132, lr = rr - b * 132; const bool isctx = lr < 4;
        const int m0 = b * T + (isctx ? 64 * lr : CTX + (lr - 4) * 64);
        const bool rok0 = !isctx && lr > 4, rok2 = !isctx && lr < 131;
        const bool lok = isctx && lr > 0, rgk = isctx && lr < 3;
        const int w0 = 8 * oct;
        const u32x4 z = {0u, 0u, 0u, 0u};
        u32x4 x[3][3];
#define CV_COL(dst, wc) do { const bool cok_ = ((wc) >= 0 && (wc) < 64) || ((wc) < 0 && lok) || ((wc) >= 64 && rgk); const GAS bf16* p_ = QP + (size_t)(m0 + (wc)) * 2048 + c; \
            dst[0] = (cok_ && rok0) ? *(const GAS u32x4*)(p_ - 64 * 2048) : z; dst[1] = cok_ ? *(const GAS u32x4*)p_ : z; dst[2] = (cok_ && rok2) ? *(const GAS u32x4*)(p_ + 64 * 2048) : z; } while (0)
        { u32x4 t_[3]; CV_COL(t_, w0 - 1); x[0][0] = t_[0]; x[1][0] = t_[1]; x[2][0] = t_[2]; CV_COL(t_, w0); x[0][1] = t_[0]; x[1][1] = t_[1]; x[2][1] = t_[2]; }
#pragma unroll
        for (int k = 0; k < 8; ++k) {
            { u32x4 t_[3]; CV_COL(t_, w0 + k + 1); x[0][2] = t_[0]; x[1][2] = t_[1]; x[2][2] = t_[2]; }
            float acc[8];
#pragma unroll
            for (int e = 0; e < 8; ++e) acc[e] = 0.f;
#pragma unroll
            for (int dr = 0; dr < 3; ++dr)
#pragma unroll
                for (int dw = 0; dw < 3; ++dw) { const u32x4 v = x[dr][dw]; const int tp = dr * 3 + dw;
                    acc[0] += bflo(v[0]) * wgt[tp][0]; acc[1] += bfhi(v[0]) * wgt[tp][1]; acc[2] += bflo(v[1]) * wgt[tp][2]; acc[3] += bfhi(v[1]) * wgt[tp][3];
                    acc[4] += bflo(v[2]) * wgt[tp][4]; acc[5] += bfhi(v[2]) * wgt[tp][5]; acc[6] += bflo(v[3]) * wgt[tp][6]; acc[7] += bfhi(v[3]) * wgt[tp][7]; }
            u32x4 o;
#pragma unroll
            for (int e = 0; e < 4; ++e) o[e] = pk2(silu_f(acc[2 * e]) * sc, silu_f(acc[2 * e + 1]) * sc);
            *(GAS u32x4*)(QK + (size_t)(m0 + w0 + k) * 2048 + c) = o;
#pragma unroll
            for (int dr = 0; dr < 3; ++dr) { x[dr][0] = x[dr][1]; x[dr][1] = x[dr][2]; }
        }
#undef CV_COL
    }
}

PHASE_FN void headnorm_phase(Frame F, const GAS bf16* HSf, const GAS bf16* HSb, const GAS bf16* OG, const GAS float* hg, GAS bf16* Y) {
    const int gw = F.bid * NWAVES + F.wave, NGW = F.G * NWAVES, lane = F.lane;
    for (int m = gw; m < NTOK; m += NGW) { const size_t off = (size_t)m * 1024 + lane * 16;
        float x[16]; float ss = 0.f;
#pragma unroll
        for (int hlf = 0; hlf < 2; ++hlf) { const u32x4 a = *(const GAS u32x4*)(HSf + off + 8 * hlf), bq = *(const GAS u32x4*)(HSb + off + 8 * hlf);
#pragma unroll
            for (int q = 0; q < 4; ++q) { x[8 * hlf + 2 * q] = bflo(a[q]) + bflo(bq[q]); x[8 * hlf + 2 * q + 1] = bfhi(a[q]) + bfhi(bq[q]); } }
#pragma unroll
        for (int q = 0; q < 16; ++q) ss += x[q] * x[q];
        ss += dpp_f<0xB1>(ss); ss += dpp_f<0x4E>(ss); ss += dpp_f<0x141>(ss);
        const float rinv = __builtin_amdgcn_rsqf(ss * (1.0f / 128.0f) + 1e-6f);
#pragma unroll
        for (int hlf = 0; hlf < 2; ++hlf) { const u32x4 g = *(const GAS u32x4*)(OG + off + 8 * hlf); const f32x4 h0 = *(const GAS f32x4*)(hg + lane * 16 + 8 * hlf), h1 = *(const GAS f32x4*)(hg + lane * 16 + 8 * hlf + 4);
            u32x4 o;
            o[0] = pk2(x[8 * hlf + 0] * rinv * h0[0] * bflo(g[0]), x[8 * hlf + 1] * rinv * h0[1] * bfhi(g[0])); o[1] = pk2(x[8 * hlf + 2] * rinv * h0[2] * bflo(g[1]), x[8 * hlf + 3] * rinv * h0[3] * bfhi(g[1]));
            o[2] = pk2(x[8 * hlf + 4] * rinv * h1[0] * bflo(g[2]), x[8 * hlf + 5] * rinv * h1[1] * bfhi(g[2])); o[3] = pk2(x[8 * hlf + 6] * rinv * h1[2] * bflo(g[3]), x[8 * hlf + 7] * rinv * h1[3] * bfhi(g[3]));
            *(GAS u32x4*)(Y + off + 8 * hlf) = o; } }
}
PHASE_FN void rwpost_phase(Frame F, const GAS bf16* Of, const GAS bf16* Ob, const GAS float* BETA, const GAS bf16* V, const GAS bf16* Gt, GAS bf16* Y) {
    const int gw = F.bid * NWAVES + F.wave, NGW = F.G * NWAVES, lane = F.lane;
    const GAS float* lnw = INP(IN_RW_LNW); const GAS float* lnb = INP(IN_RW_LNB);
    for (int m = gw; m < NTOK; m += NGW) { const size_t off = (size_t)m * 1024 + lane * 16;
        float x[16]; float s = 0.f;
#pragma unroll
        for (int hlf = 0; hlf < 2; ++hlf) { const u32x4 a = *(const GAS u32x4*)(Of + off + 8 * hlf), bq = *(const GAS u32x4*)(Ob + off + 8 * hlf);
#pragma unroll
            for (int q = 0; q < 4; ++q) { x[8 * hlf + 2 * q] = bflo(a[q]) + bflo(bq[q]); x[8 * hlf + 2 * q + 1] = bfhi(a[q]) + bfhi(bq[q]); } }
#pragma unroll
        for (int q = 0; q < 16; ++q) s += x[q];
        s += dpp_f<0xB1>(s); s += dpp_f<0x4E>(s);
        const float mean = s * (1.0f / 64.0f); float vs = 0.f;
#pragma unroll
        for (int q = 0; q < 16; ++q) { x[q] -= mean; vs += x[q] * x[q]; }
        vs += dpp_f<0xB1>(vs); vs += dpp_f<0x4E>(vs);
        const float rinv = __builtin_amdgcn_rsqf(vs * (1.0f / 64.0f) + 64e-5f);
        const int hd = lane >> 2; const float beta = BETA[(size_t)m * 16 + hd] + BETA[((size_t)NTOK + m) * 16 + hd];
#pragma unroll
        for (int hlf = 0; hlf < 2; ++hlf) { const u32x4 vv = *(const GAS u32x4*)(V + off + 8 * hlf), gg = *(const GAS u32x4*)(Gt + off + 8 * hlf);
            const f32x4 w0 = *(const GAS f32x4*)(lnw + lane * 16 + 8 * hlf), w1 = *(const GAS f32x4*)(lnw + lane * 16 + 8 * hlf + 4), b0 = *(const GAS f32x4*)(lnb + lane * 16 + 8 * hlf), b1 = *(const GAS f32x4*)(lnb + lane * 16 + 8 * hlf + 4);
            float y[8];
#pragma unroll
            for (int q = 0; q < 4; ++q) { y[q] = x[8 * hlf + q] * rinv * w0[q] + b0[q]; y[4 + q] = x[8 * hlf + 4 + q] * rinv * w1[q] + b1[q]; }
            u32x4 o;
#pragma unroll
            for (int q = 0; q < 4; ++q) o[q] = pk2((y[2 * q] + beta * bflo(vv[q])) * bflo(gg[q]), (y[2 * q + 1] + beta * bfhi(vv[q])) * bfhi(gg[q]));
            *(GAS u32x4*)(Y + off + 8 * hlf) = o; } }
}

__device__ __forceinline__ void group_barrier(LAS unsigned* ctr, unsigned target, int lane) {
    LDS_WAIT();
    if (lane == 0) __hip_atomic_fetch_add(ctr, 1u, __ATOMIC_RELAXED, __HIP_MEMORY_SCOPE_WORKGROUP);
    while ((unsigned)__builtin_amdgcn_readfirstlane((int)__hip_atomic_load(ctr, __ATOMIC_RELAXED, __HIP_MEMORY_SCOPE_WORKGROUP)) < target) __builtin_amdgcn_s_sleep(1);
    asm volatile("" ::: "memory");
}
template <int PROBE> PHASE_FN void ml_scan_phase(Frame F, const GAS bf16* QK, const GAS bf16* V, const GAS float* GATES, GAS bf16* HS) {
    constexpr int OFF_Q = 0, OFF_K = 17408, OFF_V = 34816, OFF_VW = 40960, OFF_WKR = 46080, INB = 48384;
    constexpr int O_SS = 2 * INB, O_CS = O_SS + 2 * 9216, O_HO = O_CS + 2 * 13056, O_SC = O_HO + 2 * 5120, O_CTR = O_SC + 3 * 1344;
    LAS float* SCb = (LAS float*)(F.lds + O_SC);
    LAS unsigned* actr = (LAS unsigned*)(F.lds + O_CTR);
    const int tid = F.tid, w = F.wave; int lane = F.lane, r = lane & 15, q = lane >> 4;
    constexpr int NCH = T / 64;
    for (int unit = F.bid; unit < 256; unit += F.G) {
        const int un = (F.G == 256) ? ((((unit & 7) * 8 + (unit >> 5)) << 2) | ((unit >> 3) & 3)) : unit;
        const int vs = un & 3, dir = (un >> 2) & 1, h = (un >> 3) & 7, b = un >> 6;
        __syncthreads();
        for (int i = tid; i < (O_CTR + 16) / 4; i += NTHR) ((LAS unsigned*)F.lds)[i] = 0u;
        __syncthreads();
        if (tid < 128) ((LAS bf16*)(F.lds + (tid >> 6) * INB + OFF_V))[(tid & 63) * 48 + 32] = (bf16)0x3f80;
        __syncthreads();
        if (w >= 4) {
            const int a = w - 4, ptid = tid - 256; unsigned abar = 0; int lrow = ptid >> 2, lp = ptid & 3;
#define ML_RELAUNDER() asm volatile("" : "+v"(lrow), "+v"(lp), "+v"(lane), "+v"(r), "+v"(q))
            float m_run = 0.f; u32x4 rq0[4], rk0[4], rv0, rq1[4], rk1[4], rv1; float rig = 0.f, rlf = 0.f;
#define ML_LOAD(cc, S) do { const int row_ = seq_row(b, dir, (cc) * 64 + lrow); const GAS bf16* qp_ = QK + (size_t)row_ * 2048 + h * 128; \
                _Pragma("unroll") for (int j_ = 0; j_ < 4; ++j_) { rq##S[j_] = *(const GAS u32x4*)(qp_ + 8 * (lp + 4 * j_)); rk##S[j_] = *(const GAS u32x4*)(qp_ + 1024 + 8 * (lp + 4 * j_)); } \
                rv##S = *(const GAS u32x4*)(V + (size_t)row_ * 1024 + h * 128 + vs * 32 + 8 * lp); } while (0)
#define ML_GLOAD(cc) do { const int grow_ = seq_row(b, dir, (cc) * 64 + lane); rig = GATES[(size_t)grow_ * 32 + dir * 16 + h]; rlf = GATES[(size_t)grow_ * 32 + dir * 16 + 8 + h]; } while (0)
#define ML_SCALARS(cc) do { const float lf_ = logsigmoid_f(rlf); const float bc_ = wave_scan_add(lf_); const float u_ = rig - bc_; const float pm_ = wave_scan_max(u_); \
                const float cc_ = fmaxf(m_run, pm_), blast_ = lane63(bc_), pmall_ = lane63(pm_), mnew_ = blast_ + fmaxf(m_run, pmall_); LAS float* sc_ = SCb + ((cc) % 3) * 336; \
                sc_[lane] = u_; sc_[64 + lane] = cc_; sc_[128 + lane] = __expf(m_run - cc_); sc_[192 + lane] = __expf(-(bc_ + cc_)); sc_[256 + lane] = __expf(blast_ + u_ - mnew_); \
                if (lane == 0) sc_[320] = __expf(blast_ + m_run - mnew_); m_run = mnew_; } while (0)
#define ML_STAGE(cc, S) do { LAS unsigned char* ib_ = F.lds + ((cc) & 1) * INB; const LAS float* sc_ = SCb + ((cc) % 3) * 336; \
                _Pragma("unroll") for (int j_ = 0; j_ < 4; ++j_) { *(LAS u32x4*)((LAS bf16*)(ib_ + OFF_Q) + lrow * 136 + 8 * (lp + 4 * j_)) = rq##S[j_]; *(LAS u32x4*)((LAS bf16*)(ib_ + OFF_K) + lrow * 136 + 8 * (lp + 4 * j_)) = rk##S[j_]; } \
                const float wk_ = sc_[256 + lrow]; u32x4 vw_; _Pragma("unroll") for (int j_ = 0; j_ < 4; ++j_) vw_[j_] = pk2(bflo(rv##S[j_]) * wk_, bfhi(rv##S[j_]) * wk_); \
                *(LAS u32x4*)((LAS bf16*)(ib_ + OFF_V) + lrow * 48 + 8 * lp) = rv##S; *(LAS u32x4*)((LAS bf16*)(ib_ + OFF_VW) + lrow * 40 + 8 * lp) = vw_; \
                if (ptid < 64) ((LAS bf16*)(ib_ + OFF_WKR))[ptid] = (bf16)f2bf(sc_[256 + ptid]); } while (0)
#define ML_STILE(cc, ti_, sj_) do { const LAS unsigned char* ib_ = F.lds + ((cc) & 1) * INB; const LAS float* sc_ = SCb + ((cc) % 3) * 336; LAS bf16* ss_ = (LAS bf16*)(F.lds + O_SS + ((cc) & 1) * 9216); \
                f32x4 acc_ = {0.f, 0.f, 0.f, 0.f}; acc_ = mm16<128>(acc_, (const LAS bf16*)(ib_ + OFF_Q) + 16 * (ti_) * 136, 136, (const LAS bf16*)(ib_ + OFF_K) + 16 * (sj_) * 136, 136, lane); \
                const int s_ = 16 * (sj_) + r; const float us_ = sc_[s_]; \
                _Pragma("unroll") for (int i_ = 0; i_ < 4; ++i_) { const int t_ = 16 * (ti_) + 4 * q + i_; ss_[t_ * 72 + s_] = (bf16)f2bf((s_ <= t_) ? acc_[i_] * __expf(us_ - sc_[64 + t_]) : 0.f); } } while (0)
#define ML_STILES(cc) do { if (a == 0) { ML_STILE(cc, 3, 0); ML_STILE(cc, 3, 1); ML_STILE(cc, 0, 0); } else if (a == 1) { ML_STILE(cc, 3, 2); ML_STILE(cc, 3, 3); ML_STILE(cc, 1, 0); } \
                else if (a == 2) { ML_STILE(cc, 2, 0); ML_STILE(cc, 2, 1); ML_STILE(cc, 2, 2); } else { ML_STILE(cc, 1, 1); } } while (0)
#define ML_HSTORE(cc) do { const int row_ = seq_row(b, dir, (cc) * 64 + lrow); *(GAS u32x4*)(HS + ((size_t)dir * NTOK + row_) * 1024 + h * 128 + vs * 32 + 8 * lp) = *(const LAS u32x4*)((const LAS bf16*)(F.lds + O_HO + ((cc) & 1) * 5120) + lrow * 40 + 8 * lp); } while (0)
            ML_LOAD(0, 0); ML_LOAD(1, 1);
            if (a == 3) { ML_GLOAD(0); ML_SCALARS(0); ML_GLOAD(1); ML_SCALARS(1); ML_GLOAD(2); }
            group_barrier(actr, 4 * (++abar), lane);
            ML_STAGE(0, 0); ML_LOAD(2, 0);
            group_barrier(actr, 4 * (++abar), lane);
            ML_STILES(0);
            __syncthreads();
            for (int c = 0; c < NCH; ++c) {
                if (c + 1 < NCH && !(PROBE & 2)) {
                    ML_RELAUNDER();
                    if (!(PROBE & 8)) {
                    if (c & 1) { ML_STAGE(c + 1, 0); if (c + 3 < NCH) ML_LOAD(c + 3, 0); } else { ML_STAGE(c + 1, 1); if (c + 3 < NCH) ML_LOAD(c + 3, 1); }
                    if (c >= 1) ML_HSTORE(c - 1); }
                    group_barrier(actr, 4 * (++abar), lane);
                    if (!(PROBE & 4)) ML_STILES(c + 1);
                    if (!(PROBE & 16)) { if (a == 3 && c + 2 < NCH) { ML_SCALARS(c + 2); if (c + 3 < NCH) ML_GLOAD(c + 3); } }
                } else if (c >= 1) ML_HSTORE(c - 1);
                __syncthreads();
            }
            ML_HSTORE(NCH - 1);
#undef ML_LOAD
#undef ML_RELAUNDER
#undef ML_GLOAD
#undef ML_SCALARS
#undef ML_STAGE
#undef ML_STILE
#undef ML_STILES
#undef ML_HSTORE
        } else {
            f32x4 Cst[2][2], Nst[2];
#pragma unroll
            for (int i = 0; i < 2; ++i) { Nst[i] = (f32x4){0.f, 0.f, 0.f, 0.f}; Cst[i][0] = Nst[i]; Cst[i][1] = Nst[i]; }
            __syncthreads();
            for (int c = 0; c < NCH; ++c) {
                if (!(PROBE & 1)) {
                const LAS unsigned char* ib = F.lds + (c & 1) * INB;
                const LAS bf16* QS = (const LAS bf16*)(ib + OFF_Q); const LAS bf16* KS = (const LAS bf16*)(ib + OFF_K); const LAS bf16* VS = (const LAS bf16*)(ib + OFF_V); const LAS bf16* VW = (const LAS bf16*)(ib + OFF_VW); const LAS bf16* WKR = (const LAS bf16*)(ib + OFF_WKR);
                const LAS bf16* SS = (const LAS bf16*)(F.lds + O_SS + (c & 1) * 9216); const LAS bf16* CSr = (const LAS bf16*)(F.lds + O_CS + (c & 1) * 13056); LAS bf16* CSw = (LAS bf16*)(F.lds + O_CS + ((c + 1) & 1) * 13056);
                LAS bf16* HO = (LAS bf16*)(F.lds + O_HO + (c & 1) * 5120); const LAS float* sc = SCb + (c % 3) * 336;
                {   const int ti = w; f32x4 a1[2], a2[2], a3 = {0.f, 0.f, 0.f, 0.f}, a1x = a3;
#pragma unroll
                    for (int vj = 0; vj < 2; ++vj) { a1[vj] = (f32x4){0.f, 0.f, 0.f, 0.f}; a2[vj] = a1[vj]; }
#pragma unroll
                    for (int kk = 0; kk < 2; ++kk) { const bf16x8 sf = row_frag(SS + 16 * ti * 72, 72, 32 * kk, lane);
#pragma unroll
                        for (int vj = 0; vj < 2; ++vj) a1[vj] = __builtin_amdgcn_mfma_f32_16x16x32_bf16(sf, tr_frag(VS, 48, 32 * kk, 16 * vj, lane), a1[vj], 0, 0, 0);
                        a1x = __builtin_amdgcn_mfma_f32_16x16x32_bf16(sf, tr_frag(VS, 48, 32 * kk, 32, lane), a1x, 0, 0, 0); }
#pragma unroll
                    for (int kk = 0; kk < 4; ++kk) { const bf16x8 qf = row_frag(QS + 16 * ti * 136, 136, 32 * kk, lane);
#pragma unroll
                        for (int vj = 0; vj < 2; ++vj) a2[vj] = __builtin_amdgcn_mfma_f32_16x16x32_bf16(qf, row_frag(CSr + 16 * vj * 136, 136, 32 * kk, lane), a2[vj], 0, 0, 0);
                        a3 = __builtin_amdgcn_mfma_f32_16x16x32_bf16(qf, row_frag(CSr + 32 * 136, 136, 32 * kk, lane), a3, 0, 0, 0); }
#pragma unroll
                    for (int i = 0; i < 4; ++i) { const int t_ = 16 * ti + 4 * q + i; const float wi = sc[128 + t_];
                        const float den = row16_sum(a1x[i] + wi * a3[i]); const float rd = __builtin_amdgcn_rcpf(fmaxf(fabsf(den), sc[192 + t_]));
#pragma unroll
                        for (int vj = 0; vj < 2; ++vj) HO[t_ * 40 + 16 * vj + r] = (bf16)f2bf((a1[vj][i] + wi * a2[vj][i]) * rd); } }
                {   const float wprev = sc[320]; bf16x8 av[2][2], wf[2];
#pragma unroll
                    for (int kk = 0; kk < 2; ++kk) { av[0][kk] = tr_frag(VW, 40, 32 * kk, 0, lane); av[1][kk] = tr_frag(VW, 40, 32 * kk, 16, lane); wf[kk] = row_frag(WKR, 72, 32 * kk, lane); }
#pragma unroll
                    for (int jj = 0; jj < 2; ++jj) { const int dj = 2 * w + jj; Cst[0][jj] = Cst[0][jj] * wprev; Cst[1][jj] = Cst[1][jj] * wprev; Nst[jj] = Nst[jj] * wprev;
#pragma unroll
                        for (int kk = 0; kk < 2; ++kk) { const bf16x8 kf = tr_frag(KS, 136, 32 * kk, 16 * dj, lane);
                            Cst[0][jj] = __builtin_amdgcn_mfma_f32_16x16x32_bf16(av[0][kk], kf, Cst[0][jj], 0, 0, 0); Cst[1][jj] = __builtin_amdgcn_mfma_f32_16x16x32_bf16(av[1][kk], kf, Cst[1][jj], 0, 0, 0);
                            Nst[jj] = __builtin_amdgcn_mfma_f32_16x16x32_bf16(wf[kk], kf, Nst[jj], 0, 0, 0); }
#pragma unroll
                        for (int vi = 0; vi < 2; ++vi)
#pragma unroll
                            for (int i = 0; i < 4; ++i) CSw[(16 * vi + 4 * q + i) * 136 + 16 * dj + r] = (bf16)f2bf(Cst[vi][jj][i]);
                        if (q == 0) CSw[32 * 136 + 16 * dj + r] = (bf16)f2bf(Nst[jj][0]); } }
                }
                __syncthreads();
            }
        }
    }
}

template <int PROBE> PHASE_FN void hg_scan_phase(Frame F, const GAS bf16* Q, const GAS bf16* V, const GAS bf16* LF, GAS bf16* HSf, GAS bf16* HSb) {
    constexpr int O_QT = 0, O_KT = 17408, O_IN = 34816, INB = 39936  , O_AS = O_IN + 2 * INB, O_ST = O_AS + 2 * 9216, O_HO = O_ST + 2 * 8704, O_SBL = O_HO + 5120, O_WT = O_SBL + 1024, O_CTR = O_WT + 2048;
    LAS unsigned* actr = (LAS unsigned*)(F.lds + O_CTR);
    const int tid = F.tid, lane = F.lane, w = F.wave, r = lane & 15, q = lane >> 4;
    constexpr int NCH = T / 64;
    for (int unit = F.bid; unit < 256; unit += F.G) {
        const int un = (F.G == 256) ? ((((unit & 7) * 8 + (unit >> 5)) << 2) | ((unit >> 3) & 3)) : unit;
        const int vs = un & 3, dir = (un >> 2) & 1, h = (un >> 3) & 7, b = un >> 6;
        GAS bf16* HS = dir ? HSb : HSf; const GAS bf16* LFd = LF + (size_t)dir * NTOK * 1024;
        __syncthreads();
        for (int i = tid; i < (O_CTR + 16) / 4; i += NTHR) ((LAS unsigned*)F.lds)[i] = 0u;
        __syncthreads();
        if (w >= 4) {
            const int a = w - 4, ptid = tid - 256, g4 = lane & 15, lp = 4 * a + (lane >> 4); unsigned abar = 0;
            u32x4 rq0[4], rl0[4], rv0;
#define HG_LOAD(cc, S) do { _Pragma("unroll") for (int j_ = 0; j_ < 4; ++j_) { const int row_ = seq_row(b, dir, (cc) * 64 + 4 * g4 + j_); rq##S[j_] = *(const GAS u32x4*)(Q + (size_t)row_ * 1024 + h * 128 + 8 * lp); rl##S[j_] = *(const GAS u32x4*)(LFd + (size_t)row_ * 1024 + h * 128 + 8 * lp); } \
                const int vrow_ = seq_row(b, dir, (cc) * 64 + (ptid >> 2)); rv##S = *(const GAS u32x4*)(V + (size_t)vrow_ * 1024 + h * 128 + vs * 32 + 8 * (ptid & 3)); } while (0)
#define HG_ATILE(cc, ti_, sj_) do { LAS bf16* as_ = (LAS bf16*)(F.lds + O_AS + ((cc) & 1) * 9216); f32x4 acc_ = {0.f, 0.f, 0.f, 0.f}; \
                acc_ = mm16<128>(acc_, (const LAS bf16*)(F.lds + O_QT) + 16 * (ti_) * 136, 136, (const LAS bf16*)(F.lds + O_KT) + 16 * (sj_) * 136, 136, lane); \
                _Pragma("unroll") for (int i_ = 0; i_ < 4; ++i_) { const int t_ = 16 * (ti_) + 4 * q + i_, s_ = 16 * (sj_) + r; as_[t_ * 72 + s_] = (bf16)f2bf(s_ <= t_ ? acc_[i_] : 0.f); } } while (0)
#define HG_ATILES(cc) do { if (a == 0) { HG_ATILE(cc, 3, 0); HG_ATILE(cc, 3, 1); HG_ATILE(cc, 0, 0); } else if (a == 1) { HG_ATILE(cc, 3, 2); HG_ATILE(cc, 3, 3); HG_ATILE(cc, 1, 0); } \
                else if (a == 2) { HG_ATILE(cc, 2, 0); HG_ATILE(cc, 2, 1); } else { HG_ATILE(cc, 2, 2); HG_ATILE(cc, 1, 1); } } while (0)
#define HG_PREP(cc, S) do { LAS unsigned char* ib_ = F.lds + O_IN + ((cc) & 1) * INB; \
                float lf_[4][8], bc_[4][8]; \
                _Pragma("unroll") for (int j_ = 0; j_ < 4; ++j_) _Pragma("unroll") for (int k_ = 0; k_ < 4; ++k_) { lf_[j_][2 * k_] = 1.4426950408889634f * bflo(rl##S[j_][k_]); lf_[j_][2 * k_ + 1] = 1.4426950408889634f * bfhi(rl##S[j_][k_]); }     \
                float br_[8], bl_[8]; \
                _Pragma("unroll") for (int k_ = 0; k_ < 8; ++k_) { float run_ = 0.f; _Pragma("unroll") for (int j_ = 0; j_ < 4; ++j_) { run_ += lf_[j_][k_]; bc_[j_][k_] = run_; } \
                    float x_ = run_; x_ += dpp_keep<0x111, 0xF>(0.f, x_); x_ += dpp_keep<0x112, 0xF>(0.f, x_); x_ += dpp_keep<0x114, 0xF>(0.f, x_); x_ += dpp_keep<0x118, 0xF>(0.f, x_);     \
                    const float ex_ = x_ - run_; _Pragma("unroll") for (int j_ = 0; j_ < 4; ++j_) bc_[j_][k_] += ex_; \
                    br_[k_] = __builtin_bit_cast(float, __builtin_amdgcn_ds_bpermute(((lane & 48) | 7) << 2, __builtin_bit_cast(int, x_))); bl_[k_] = __builtin_bit_cast(float, __builtin_amdgcn_ds_bpermute(((lane & 48) | 15) << 2, __builtin_bit_cast(int, x_))); } \
                _Pragma("unroll") for (int j_ = 0; j_ < 4; ++j_) { const int t_ = 4 * g4 + j_; u32x4 oq_, oi_, ok_, oh_; \
                    _Pragma("unroll") for (int k_ = 0; k_ < 4; ++k_) { float a2_[2], i2_[2], k2_[2], h2_[2]; \
                        _Pragma("unroll") for (int hh_ = 0; hh_ < 2; ++hh_) { const int c_ = 2 * k_ + hh_; const float bt_ = bc_[j_][c_], key_ = 1.0f - __builtin_amdgcn_exp2f(lf_[j_][c_]), qv_ = hh_ ? bfhi(rq##S[j_][k_]) : bflo(rq##S[j_][k_]); \
                            a2_[hh_] = qv_ * __builtin_amdgcn_exp2f(fminf(bt_ - br_[c_], 115.f)); i2_[hh_] = qv_ * __builtin_amdgcn_exp2f(bt_); k2_[hh_] = key_ * __builtin_amdgcn_exp2f(fminf(br_[c_] - bt_, 115.f)); h2_[hh_] = key_ * __builtin_amdgcn_exp2f(bl_[c_] - bt_); } \
                        oq_[k_] = pk2(a2_[0], a2_[1]); oi_[k_] = pk2(i2_[0], i2_[1]); ok_[k_] = pk2(k2_[0], k2_[1]); oh_[k_] = pk2(h2_[0], h2_[1]); } \
                    *(LAS u32x4*)((LAS bf16*)(F.lds + O_QT) + t_ * 136 + 8 * lp) = oq_; *(LAS u32x4*)((LAS bf16*)(F.lds + O_KT) + t_ * 136 + 8 * lp) = ok_; \
                    *(LAS u32x4*)((LAS bf16*)ib_ + t_ * 136 + 8 * lp) = oi_; *(LAS u32x4*)((LAS bf16*)(ib_ + 17408) + t_ * 136 + 8 * lp) = oh_; } \
                *(LAS u32x4*)((LAS bf16*)(ib_ + 34816) + (ptid >> 2) * 40 + 8 * (ptid & 3)) = rv##S; \
                if (g4 == 0) { LAS float* sbl_ = (LAS float*)(F.lds + O_SBL) + ((cc) & 1) * 128; _Pragma("unroll") for (int k_ = 0; k_ < 8; ++k_) sbl_[8 * lp + k_] = __builtin_amdgcn_exp2f(bl_[k_]); } } while (0)
            HG_LOAD(0, 0);
            HG_PREP(0, 0); HG_LOAD(1, 0);
            group_barrier(actr, 4 * (++abar), lane);
            HG_ATILES(0);
            __syncthreads();
            for (int c = 0; c < NCH; ++c) {
                if (c + 1 < NCH && !(PROBE & 2)) {
                    HG_PREP(c + 1, 0);
                    if (c + 2 < NCH) HG_LOAD(c + 2, 0);
                    group_barrier(actr, 4 * (++abar), lane);
                    HG_ATILES(c + 1);
                }
                __syncthreads();
            }
#undef HG_LOAD
#undef HG_ATILE
#undef HG_ATILES
#undef HG_PREP
        } else {
            f32x4 Sst[2][2];
#pragma unroll
            for (int i = 0; i < 2; ++i) { Sst[i][0] = (f32x4){0.f, 0.f, 0.f, 0.f}; Sst[i][1] = Sst[i][0]; }
            __syncthreads();
            for (int c = 0; c < NCH; ++c) {
                if (!(PROBE & 1)) {
                const LAS unsigned char* ib = F.lds + O_IN + (c & 1) * INB;
                const LAS bf16* QI = (const LAS bf16*)ib; const LAS bf16* KH = (const LAS bf16*)(ib + 17408); const LAS bf16* VS = (const LAS bf16*)(ib + 34816);
                const LAS bf16* AS = (const LAS bf16*)(F.lds + O_AS + (c & 1) * 9216); const LAS bf16* STr = (const LAS bf16*)(F.lds + O_ST + (c & 1) * 8704); LAS bf16* STw = (LAS bf16*)(F.lds + O_ST + ((c + 1) & 1) * 8704);
                LAS bf16* HO = (LAS bf16*)(F.lds + O_HO); const LAS float* sbl = (const LAS float*)(F.lds + O_SBL) + (c & 1) * 128;
                {   const int ti = w; f32x4 o[2]; o[0] = (f32x4){0.f, 0.f, 0.f, 0.f}; o[1] = o[0];
#pragma unroll
                    for (int kk = 0; kk < 2; ++kk) { const bf16x8 af = row_frag(AS + 16 * ti * 72, 72, 32 * kk, lane);
#pragma unroll
                        for (int vj = 0; vj < 2; ++vj) o[vj] = __builtin_amdgcn_mfma_f32_16x16x32_bf16(af, tr_frag(VS, 40, 32 * kk, 16 * vj, lane), o[vj], 0, 0, 0); }
#pragma unroll
                    for (int kk = 0; kk < 4; ++kk) { const bf16x8 qf = row_frag(QI + 16 * ti * 136, 136, 32 * kk, lane);
#pragma unroll
                        for (int vj = 0; vj < 2; ++vj) o[vj] = __builtin_amdgcn_mfma_f32_16x16x32_bf16(qf, row_frag(STr + 16 * vj * 136, 136, 32 * kk, lane), o[vj], 0, 0, 0); }
#pragma unroll
                    for (int i = 0; i < 4; ++i)
#pragma unroll
                        for (int vj = 0; vj < 2; ++vj) HO[(16 * ti + 4 * q + i) * 40 + 16 * vj + r] = (bf16)f2bf(o[vj][i]);
                    LDS_WAIT();
                    { const int t_ = 16 * ti + (lane >> 2); const int row = seq_row(b, dir, c * 64 + t_); *(GAS u32x4*)(HS + (size_t)row * 1024 + h * 128 + vs * 32 + 8 * (lane & 3)) = *(const LAS u32x4*)(HO + t_ * 40 + 8 * (lane & 3)); } }
                {   bf16x8 av[2][2];
#pragma unroll
                    for (int kk = 0; kk < 2; ++kk) { av[0][kk] = tr_frag(VS, 40, 32 * kk, 0, lane); av[1][kk] = tr_frag(VS, 40, 32 * kk, 16, lane); }
#pragma unroll
                    for (int jj = 0; jj < 2; ++jj) { const int kj = 2 * w + jj; const float sb = sbl[16 * kj + r]; Sst[0][jj] = Sst[0][jj] * sb; Sst[1][jj] = Sst[1][jj] * sb;
#pragma unroll
                        for (int kk = 0; kk < 2; ++kk) { const bf16x8 kf = tr_frag(KH, 136, 32 * kk, 16 * kj, lane);
                            Sst[0][jj] = __builtin_amdgcn_mfma_f32_16x16x32_bf16(av[0][kk], kf, Sst[0][jj], 0, 0, 0); Sst[1][jj] = __builtin_amdgcn_mfma_f32_16x16x32_bf16(av[1][kk], kf, Sst[1][jj], 0, 0, 0); }
#pragma unroll
                        for (int vi = 0; vi < 2; ++vi)
#pragma unroll
                            for (int i = 0; i < 4; ++i) STw[(16 * vi + 4 * q + i) * 136 + 16 * kj + r] = (bf16)f2bf(Sst[vi][jj][i]); } }
                }
                __syncthreads();
            }
        }
    }
}

__device__ __forceinline__ void gflag_wait(const LAS unsigned* ctr, unsigned target) { while ((unsigned)__builtin_amdgcn_readfirstlane((int)__hip_atomic_load(ctr, __ATOMIC_RELAXED, __HIP_MEMORY_SCOPE_WORKGROUP)) < target) __builtin_amdgcn_s_sleep(1); asm volatile("" ::: "memory"); }
__device__ __forceinline__ void gflag_post(LAS unsigned* ctr, int lane) { LDS_WAIT(); if (lane == 0) __hip_atomic_fetch_add(ctr, 1u, __ATOMIC_RELAXED, __HIP_MEMORY_SCOPE_WORKGROUP); }
template <int PROBE> PHASE_FN void hg_scan3_phase(Frame F, const GAS bf16* Q, const GAS bf16* V, const GAS bf16* LF, GAS bf16* HSf, GAS bf16* HSb) {
    constexpr int O_QT = 0, O_KT = 17408, O_IN = 34816, INB = 39936  , O_AS = O_IN + 2 * INB, O_ST = O_AS + 2 * 9216, O_HO = O_ST + 2 * 8704, O_SBL = O_HO + 5120, O_WT = O_SBL + 1024, O_CTR = O_WT + 2048;
    LAS unsigned* QKR = (LAS unsigned*)(F.lds + O_CTR);
    const int tid = F.tid, lane = F.lane, w = F.wave, r = lane & 15, q = lane >> 4;
    constexpr int NCH = T / 64;
    for (int unit = F.bid; unit < 256; unit += F.G) {
        const int un = (F.G == 256) ? ((((unit & 7) * 8 + (unit >> 5)) << 2) | ((unit >> 3) & 3)) : unit;
        const int vs = un & 3, dir = (un >> 2) & 1, h = (un >> 3) & 7, b = un >> 6;
        GAS bf16* HS = dir ? HSb : HSf; const GAS bf16* LFd = LF + (size_t)dir * NTOK * 1024;
        __syncthreads();
        for (int i = tid; i < (O_CTR + 16) / 4; i += NTHR) ((LAS unsigned*)F.lds)[i] = 0u;
        __syncthreads();
        if (w >= 4) {
            const int a = w - 4, ptid = tid - 256, g4 = lane & 15, lp = 4 * a + (lane >> 4);
            u32x4 rq0[4], rl0[4], rv0, rq1[4], rl1[4], rv1;
#define HG_LOAD(cc, S) do { _Pragma("unroll") for (int j_ = 0; j_ < 4; ++j_) { const int row_ = seq_row(b, dir, (cc) * 64 + 4 * g4 + j_); rq##S[j_] = *(const GAS u32x4*)(Q + (size_t)row_ * 1024 + h * 128 + 8 * lp); rl##S[j_] = *(const GAS u32x4*)(LFd + (size_t)row_ * 1024 + h * 128 + 8 * lp); } \
                const int vrow_ = seq_row(b, dir, (cc) * 64 + (ptid >> 2)); rv##S = *(const GAS u32x4*)(V + (size_t)vrow_ * 1024 + h * 128 + vs * 32 + 8 * (ptid & 3)); } while (0)
#define HG_PREP(cc, S) do { const u32x4 vcur_ = rv##S; LAS unsigned char* ib_ = F.lds + O_IN + ((cc) & 1) * INB; \
                float lf_[4][8], bc_[4][8]; \
                _Pragma("unroll") for (int j_ = 0; j_ < 4; ++j_) _Pragma("unroll") for (int k_ = 0; k_ < 4; ++k_) { lf_[j_][2 * k_] = 1.4426950408889634f * bflo(rl##S[j_][k_]); lf_[j_][2 * k_ + 1] = 1.4426950408889634f * bfhi(rl##S[j_][k_]); }     \
                float br_[8], bl_[8]; \
                _Pragma("unroll") for (int k_ = 0; k_ < 8; ++k_) { float run_ = 0.f; _Pragma("unroll") for (int j_ = 0; j_ < 4; ++j_) { run_ += lf_[j_][k_]; bc_[j_][k_] = run_; } \
                    float x_ = run_; x_ += dpp_keep<0x111, 0xF>(0.f, x_); x_ += dpp_keep<0x112, 0xF>(0.f, x_); x_ += dpp_keep<0x114, 0xF>(0.f, x_); x_ += dpp_keep<0x118, 0xF>(0.f, x_);     \
                    const float ex_ = x_ - run_; _Pragma("unroll") for (int j_ = 0; j_ < 4; ++j_) bc_[j_][k_] += ex_; \
                    br_[k_] = __builtin_bit_cast(float, __builtin_amdgcn_ds_bpermute(((lane & 48) | 7) << 2, __builtin_bit_cast(int, x_))); bl_[k_] = __builtin_bit_cast(float, __builtin_amdgcn_ds_bpermute(((lane & 48) | 15) << 2, __builtin_bit_cast(int, x_))); } \
                gflag_wait(QKR + 1, 4u * (unsigned)(cc));                                  \
                if ((cc) >= 2) gflag_wait(QKR + 2, 4u * (unsigned)((cc) - 1));             \
                _Pragma("unroll") for (int j_ = 0; j_ < 4; ++j_) { const int t_ = 4 * g4 + j_; u32x4 oq_, oi_, ok_, oh_; \
                    _Pragma("unroll") for (int k_ = 0; k_ < 4; ++k_) { float a2_[2], i2_[2], k2_[2], h2_[2]; \
                        _Pragma("unroll") for (int hh_ = 0; hh_ < 2; ++hh_) { const int c_ = 2 * k_ + hh_; const float bt_ = bc_[j_][c_], key_ = 1.0f - __builtin_amdgcn_exp2f(lf_[j_][c_]), qv_ = hh_ ? bfhi(rq##S[j_][k_]) : bflo(rq##S[j_][k_]); \
                            a2_[hh_] = qv_ * __builtin_amdgcn_exp2f(fminf(bt_ - br_[c_], 115.f)); i2_[hh_] = qv_ * __builtin_amdgcn_exp2f(bt_); k2_[hh_] = key_ * __builtin_amdgcn_exp2f(fminf(br_[c_] - bt_, 115.f)); h2_[hh_] = key_ * __builtin_amdgcn_exp2f(bl_[c_] - bt_); } \
                        oq_[k_] = pk2(a2_[0], a2_[1]); oi_[k_] = pk2(i2_[0], i2_[1]); ok_[k_] = pk2(k2_[0], k2_[1]); oh_[k_] = pk2(h2_[0], h2_[1]); } \
                    *(LAS u32x4*)((LAS bf16*)(F.lds + O_QT) + t_ * 136 + 8 * lp) = oq_; *(LAS u32x4*)((LAS bf16*)(F.lds + O_KT) + t_ * 136 + 8 * lp) = ok_; \
                    *(LAS u32x4*)((LAS bf16*)ib_ + t_ * 136 + 8 * lp) = oi_; *(LAS u32x4*)((LAS bf16*)(ib_ + 17408) + t_ * 136 + 8 * lp) = oh_; } \
                *(LAS u32x4*)((LAS bf16*)(ib_ + 34816) + (ptid >> 2) * 40 + 8 * (ptid & 3)) = vcur_; \
                if (g4 == 0) { LAS float* sbl_ = (LAS float*)(F.lds + O_SBL) + ((cc) & 1) * 128; _Pragma("unroll") for (int k_ = 0; k_ < 8; ++k_) sbl_[8 * lp + k_] = __builtin_amdgcn_exp2f(bl_[k_]); } } while (0)
            HG_LOAD(0, 0); HG_LOAD(1, 1);
#define HG_ASTEP(pp, S) do { if (!(PROBE & 2)) HG_PREP(pp, S); else { gflag_wait(QKR + 1, 4u * (unsigned)(pp)); if ((pp) >= 2) gflag_wait(QKR + 2, 4u * (unsigned)((pp) - 1)); } \
                gflag_post(QKR, lane); if ((pp) + 2 < NCH) HG_LOAD((pp) + 2, S); } while (0)
            for (int p = 0; p < NCH; p += 2) { HG_ASTEP(p, 0); HG_ASTEP(p + 1, 1); }
#undef HG_ASTEP
#undef HG_LOAD
#undef HG_PREP
        } else {
            const int a = w;
#define HG_ATILE(cc, ti_, sj_) do { LAS bf16* as_ = (LAS bf16*)(F.lds + O_AS + ((cc) & 1) * 9216); f32x4 acc_ = {0.f, 0.f, 0.f, 0.f}; \
                acc_ = mm16<128>(acc_, (const LAS bf16*)(F.lds + O_QT) + 16 * (ti_) * 136, 136, (const LAS bf16*)(F.lds + O_KT) + 16 * (sj_) * 136, 136, lane); \
                _Pragma("unroll") for (int i_ = 0; i_ < 4; ++i_) { const int t_ = 16 * (ti_) + 4 * q + i_, s_ = 16 * (sj_) + r; as_[t_ * 72 + s_] = (bf16)f2bf(s_ <= t_ ? acc_[i_] : 0.f); } } while (0)
#define HG_ATILES(cc) do { if (a == 0) { HG_ATILE(cc, 3, 0); HG_ATILE(cc, 3, 1); HG_ATILE(cc, 0, 0); } else if (a == 1) { HG_ATILE(cc, 3, 2); HG_ATILE(cc, 3, 3); HG_ATILE(cc, 1, 0); } \
                else if (a == 2) { HG_ATILE(cc, 2, 0); HG_ATILE(cc, 2, 1); } else { HG_ATILE(cc, 2, 2); HG_ATILE(cc, 1, 1); } } while (0)

            f32x4 Sst[2][2];
#pragma unroll
            for (int i = 0; i < 2; ++i) { Sst[i][0] = (f32x4){0.f, 0.f, 0.f, 0.f}; Sst[i][1] = Sst[i][0]; }
            gflag_wait(QKR, 4u); HG_ATILES(0); gflag_post(QKR + 1, lane);
            for (int c = 0; c < NCH; ++c) {
                gflag_wait(QKR + 1, 4u * (unsigned)(c + 1)); gflag_wait(QKR + 2, 4u * (unsigned)c);
                if (!(PROBE & 1)) {
                const LAS unsigned char* ib = F.lds + O_IN + (c & 1) * INB;
                const LAS bf16* QI = (const LAS bf16*)ib; const LAS bf16* KH = (const LAS bf16*)(ib + 17408); const LAS bf16* VS = (const LAS bf16*)(ib + 34816);
                const LAS bf16* AS = (const LAS bf16*)(F.lds + O_AS + (c & 1) * 9216); const LAS bf16* STr = (const LAS bf16*)(F.lds + O_ST + (c & 1) * 8704); LAS bf16* STw = (LAS bf16*)(F.lds + O_ST + ((c + 1) & 1) * 8704);
                LAS bf16* HO = (LAS bf16*)(F.lds + O_HO); const LAS float* sbl = (const LAS float*)(F.lds + O_SBL) + (c & 1) * 128;
                {   const int ti = w; f32x4 o[2]; o[0] = (f32x4){0.f, 0.f, 0.f, 0.f}; o[1] = o[0];
#pragma unroll
                    for (int kk = 0; kk < 2; ++kk) { const bf16x8 af = row_frag(AS + 16 * ti * 72, 72, 32 * kk, lane);
#pragma unroll
                        for (int vj = 0; vj < 2; ++vj) o[vj] = __builtin_amdgcn_mfma_f32_16x16x32_bf16(af, tr_frag(VS, 40, 32 * kk, 16 * vj, lane), o[vj], 0, 0, 0); }
#pragma unroll
                    for (int kk = 0; kk < 4; ++kk) { const bf16x8 qf = row_frag(QI + 16 * ti * 136, 136, 32 * kk, lane);
#pragma unroll
                        for (int vj = 0; vj < 2; ++vj) o[vj] = __builtin_amdgcn_mfma_f32_16x16x32_bf16(qf, row_frag(STr + 16 * vj * 136, 136, 32 * kk, lane), o[vj], 0, 0, 0); }
#pragma unroll
                    for (int i = 0; i < 4; ++i)
#pragma unroll
                        for (int vj = 0; vj < 2; ++vj) HO[(16 * ti + 4 * q + i) * 40 + 16 * vj + r] = (bf16)f2bf(o[vj][i]);
                    LDS_WAIT();
                    { const int t_ = 16 * ti + (lane >> 2); const int row = seq_row(b, dir, c * 64 + t_); *(GAS u32x4*)(HS + (size_t)row * 1024 + h * 128 + vs * 32 + 8 * (lane & 3)) = *(const LAS u32x4*)(HO + t_ * 40 + 8 * (lane & 3)); } }
                {   bf16x8 av[2][2];
#pragma unroll
                    for (int kk = 0; kk < 2; ++kk) { av[0][kk] = tr_frag(VS, 40, 32 * kk, 0, lane); av[1][kk] = tr_frag(VS, 40, 32 * kk, 16, lane); }
#pragma unroll
                    for (int jj = 0; jj < 2; ++jj) { const int kj = 2 * w + jj; const float sb = sbl[16 * kj + r]; Sst[0][jj] = Sst[0][jj] * sb; Sst[1][jj] = Sst[1][jj] * sb;
#pragma unroll
                        for (int kk = 0; kk < 2; ++kk) { const bf16x8 kf = tr_frag(KH, 136, 32 * kk, 16 * kj, lane);
                            Sst[0][jj] = __builtin_amdgcn_mfma_f32_16x16x32_bf16(av[0][kk], kf, Sst[0][jj], 0, 0, 0); Sst[1][jj] = __builtin_amdgcn_mfma_f32_16x16x32_bf16(av[1][kk], kf, Sst[1][jj], 0, 0, 0); }
#pragma unroll
                        for (int vi = 0; vi < 2; ++vi)
#pragma unroll
                            for (int i = 0; i < 4; ++i) STw[(16 * vi + 4 * q + i) * 136 + 16 * kj + r] = (bf16)f2bf(Sst[vi][jj][i]); } }
                }
                gflag_post(QKR + 2, lane);
                if (c + 1 < NCH) { gflag_wait(QKR, 4u * (unsigned)(c + 2)); HG_ATILES(c + 1); gflag_post(QKR + 1, lane); }
            }
#undef HG_ATILE
#undef HG_ATILES

        }
    }
}

template <int PROBE> PHASE_FN void ml_scan3_phase(Frame F, const GAS bf16* QK, const GAS bf16* V, const GAS float* GATES, GAS bf16* HS) {
    constexpr int OFF_Q = 0, OFF_K = 17408, OFF_V = 34816, OFF_VW = 40960, OFF_WKR = 46080, INB = 48384;
    constexpr int O_SS = 2 * INB, O_CS = O_SS + 2 * 9216, O_HO = O_CS + 2 * 13056, O_SC = O_HO + 2 * 5120, O_CTR = O_SC + 4 * 1344; static_assert(O_CTR + 16 <= MISC_OFF, "ml_scan3 LDS map");
    LAS float* SCb = (LAS float*)(F.lds + O_SC);
    LAS unsigned* CT = (LAS unsigned*)(F.lds + O_CTR);
    const int tid = F.tid, w = F.wave; int lane = F.lane, r = lane & 15, q = lane >> 4;
    constexpr int NCH = T / 64;
    for (int unit = F.bid; unit < 256; unit += F.G) {
        const int un = (F.G == 256) ? ((((unit & 7) * 8 + (unit >> 5)) << 2) | ((unit >> 3) & 3)) : unit;
        const int vs = un & 3, dir = (un >> 2) & 1, h = (un >> 3) & 7, b = un >> 6;
        __syncthreads();
        for (int i = tid; i < (O_CTR + 16) / 4; i += NTHR) ((LAS unsigned*)F.lds)[i] = 0u;
        __syncthreads();
        if (tid < 128) ((LAS bf16*)(F.lds + (tid >> 6) * INB + OFF_V))[(tid & 63) * 48 + 32] = (bf16)0x3f80;
        __syncthreads();
        if (w >= 4) {
            const int a = w - 4, ptid = tid - 256; int lrow = ptid >> 2, lp = ptid & 3;
#define ML_RELAUNDER() asm volatile("" : "+v"(lrow), "+v"(lp), "+v"(lane), "+v"(r), "+v"(q))
            float m_run = 0.f; u32x4 rq0[4], rk0[4], rv0, rq1[4], rk1[4], rv1; float rig = 0.f, rlf = 0.f;
#define ML_LOAD(cc, S) do { const int row_ = seq_row(b, dir, (cc) * 64 + lrow); const GAS bf16* qp_ = QK + (size_t)row_ * 2048 + h * 128; \
                _Pragma("unroll") for (int j_ = 0; j_ < 4; ++j_) { rq##S[j_] = *(const GAS u32x4*)(qp_ + 8 * (lp + 4 * j_)); rk##S[j_] = *(const GAS u32x4*)(qp_ + 1024 + 8 * (lp + 4 * j_)); } \
                rv##S = *(const GAS u32x4*)(V + (size_t)row_ * 1024 + h * 128 + vs * 32 + 8 * lp); } while (0)
#define ML_GLOAD(cc) do { const int grow_ = seq_row(b, dir, (cc) * 64 + lane); rig = GATES[(size_t)grow_ * 32 + dir * 16 + h]; rlf = GATES[(size_t)grow_ * 32 + dir * 16 + 8 + h]; } while (0)
#define ML_SCALARS(cc) do { const float lf_ = logsigmoid_f(rlf); const float bc_ = wave_scan_add(lf_); const float u_ = rig - bc_; const float pm_ = wave_scan_max(u_); \
                const float cc_ = fmaxf(m_run, pm_), blast_ = lane63(bc_), pmall_ = lane63(pm_), mnew_ = blast_ + fmaxf(m_run, pmall_); LAS float* sc_ = SCb + ((cc) & 3) * 336; \
                sc_[lane] = u_; sc_[64 + lane] = cc_; sc_[128 + lane] = __expf(m_run - cc_); sc_[192 + lane] = __expf(-(bc_ + cc_)); sc_[256 + lane] = __expf(blast_ + u_ - mnew_); \
                if (lane == 0) sc_[320] = __expf(blast_ + m_run - mnew_); m_run = mnew_; } while (0)
#define ML_STAGE(cc, S) do { LAS unsigned char* ib_ = F.lds + ((cc) & 1) * INB; const LAS float* sc_ = SCb + ((cc) & 3) * 336; \
                _Pragma("unroll") for (int j_ = 0; j_ < 4; ++j_) { *(LAS u32x4*)((LAS bf16*)(ib_ + OFF_Q) + lrow * 136 + 8 * (lp + 4 * j_)) = rq##S[j_]; *(LAS u32x4*)((LAS bf16*)(ib_ + OFF_K) + lrow * 136 + 8 * (lp + 4 * j_)) = rk##S[j_]; } \
                const float wk_ = sc_[256 + lrow]; u32x4 vw_; _Pragma("unroll") for (int j_ = 0; j_ < 4; ++j_) vw_[j_] = pk2(bflo(rv##S[j_]) * wk_, bfhi(rv##S[j_]) * wk_); \
                *(LAS u32x4*)((LAS bf16*)(ib_ + OFF_V) + lrow * 48 + 8 * lp) = rv##S; *(LAS u32x4*)((LAS bf16*)(ib_ + OFF_VW) + lrow * 40 + 8 * lp) = vw_; \
                if (ptid < 64) ((LAS bf16*)(ib_ + OFF_WKR))[ptid] = (bf16)f2bf(sc_[256 + ptid]); } while (0)
#define ML_STILE(cc, ti_, sj_) do { const LAS unsigned char* ib_ = F.lds + ((cc) & 1) * INB; const LAS float* sc_ = SCb + ((cc) & 3) * 336; LAS bf16* ss_ = (LAS bf16*)(F.lds + O_SS + ((cc) & 1) * 9216); \
                f32x4 acc_ = {0.f, 0.f, 0.f, 0.f}; acc_ = mm16<128>(acc_, (const LAS bf16*)(ib_ + OFF_Q) + 16 * (ti_) * 136, 136, (const LAS bf16*)(ib_ + OFF_K) + 16 * (sj_) * 136, 136, lane); \
                const int s_ = 16 * (sj_) + r; const float us_ = sc_[s_]; \
                _Pragma("unroll") for (int i_ = 0; i_ < 4; ++i_) { const int t_ = 16 * (ti_) + 4 * q + i_; ss_[t_ * 72 + s_] = (bf16)f2bf((s_ <= t_) ? acc_[i_] * __expf(us_ - sc_[64 + t_]) : 0.f); } } while (0)
#define ML_STILES_A(cc) do { if (a == 0) { ML_STILE(cc, 3, 0); ML_STILE(cc, 3, 1); } else if (a == 1) { ML_STILE(cc, 3, 2); ML_STILE(cc, 2, 2); } else if (a == 2) { ML_STILE(cc, 3, 3); ML_STILE(cc, 2, 1); } else { ML_STILE(cc, 0, 0); } } while (0)
            ML_LOAD(0, 0); ML_LOAD(1, 1);
            if (a == 3) { ML_GLOAD(0); ML_SCALARS(0); gflag_post(CT + 3, lane); ML_GLOAD(1); ML_SCALARS(1); gflag_post(CT + 3, lane); ML_GLOAD(2); }
#define ML_ASTEP(pp, S) do { ML_RELAUNDER(); \
                if ((pp) >= 2) gflag_wait(CT + 2, 4u * (unsigned)((pp) - 1));              \
                gflag_wait(CT + 3, (unsigned)((pp) + 1));                                  \
                if (!(PROBE & 2)) ML_STAGE(pp, S); \
                gflag_post(CT, lane); \
                if ((pp) + 2 < NCH && !(PROBE & 2)) ML_LOAD((pp) + 2, S); \
                gflag_wait(CT, 4u * (unsigned)((pp) + 1));                                 \
                if (!(PROBE & 2)) ML_STILES_A(pp); \
                gflag_post(CT + 1, lane); \
                if (a == 3 && (pp) + 2 < NCH) { ML_SCALARS((pp) + 2); gflag_post(CT + 3, lane); if ((pp) + 3 < NCH) ML_GLOAD((pp) + 3); } } while (0)
            for (int p = 0; p < NCH; p += 2) { ML_ASTEP(p, 0); ML_ASTEP(p + 1, 1); }
#undef ML_ASTEP
#undef ML_STILE
#undef ML_STILES_A
#undef ML_LOAD
#undef ML_RELAUNDER
#undef ML_GLOAD
#undef ML_SCALARS
#undef ML_STAGE
        } else {
            const int a = w;
#define ML_STILE(cc, ti_, sj_) do { const LAS unsigned char* ib_ = F.lds + ((cc) & 1) * INB; const LAS float* sc_ = SCb + ((cc) & 3) * 336; LAS bf16* ss_ = (LAS bf16*)(F.lds + O_SS + ((cc) & 1) * 9216); \
                f32x4 acc_ = {0.f, 0.f, 0.f, 0.f}; acc_ = mm16<128>(acc_, (const LAS bf16*)(ib_ + OFF_Q) + 16 * (ti_) * 136, 136, (const LAS bf16*)(ib_ + OFF_K) + 16 * (sj_) * 136, 136, lane); \
                const int s_ = 16 * (sj_) + r; const float us_ = sc_[s_]; \
                _Pragma("unroll") for (int i_ = 0; i_ < 4; ++i_) { const int t_ = 16 * (ti_) + 4 * q + i_; ss_[t_ * 72 + s_] = (bf16)f2bf((s_ <= t_) ? acc_[i_] * __expf(us_ - sc_[64 + t_]) : 0.f); } } while (0)
#define ML_STILES(cc) do { if (a == 0) { ML_STILE(cc, 2, 0); } else if (a == 2) { ML_STILE(cc, 1, 0); } else if (a == 3) { ML_STILE(cc, 1, 1); } } while (0)

            f32x4 Cst[2][2], Nst[2];
#pragma unroll
            for (int i = 0; i < 2; ++i) { Nst[i] = (f32x4){0.f, 0.f, 0.f, 0.f}; Cst[i][0] = Nst[i]; Cst[i][1] = Nst[i]; }
            gflag_wait(CT, 4u); ML_STILES(0); gflag_post(CT + 1, lane);
            for (int c = 0; c < NCH; ++c) {
                gflag_wait(CT + 1, 8u * (unsigned)(c + 1)); gflag_wait(CT + 2, 4u * (unsigned)c);
                if (!(PROBE & 1)) {
                const LAS unsigned char* ib = F.lds + (c & 1) * INB;
                const LAS bf16* QS = (const LAS bf16*)(ib + OFF_Q); const LAS bf16* KS = (const LAS bf16*)(ib + OFF_K); const LAS bf16* VS = (const LAS bf16*)(ib + OFF_V); const LAS bf16* VW = (const LAS bf16*)(ib + OFF_VW); const LAS bf16* WKR = (const LAS bf16*)(ib + OFF_WKR);
                const LAS bf16* SS = (const LAS bf16*)(F.lds + O_SS + (c & 1) * 9216); const LAS bf16* CSr = (const LAS bf16*)(F.lds + O_CS + (c & 1) * 13056); LAS bf16* CSw = (LAS bf16*)(F.lds + O_CS + ((c + 1) & 1) * 13056);
                LAS bf16* HO = (LAS bf16*)(F.lds + O_HO + (c & 1) * 5120); const LAS float* sc = SCb + (c & 3) * 336;
                {   const int ti = w; f32x4 a1[2], a2[2], a3 = {0.f, 0.f, 0.f, 0.f}, a1x = a3;
#pragma unroll
                    for (int vj = 0; vj < 2; ++vj) { a1[vj] = (f32x4){0.f, 0.f, 0.f, 0.f}; a2[vj] = a1[vj]; }
#pragma unroll
                    for (int kk = 0; kk < 2; ++kk) { const bf16x8 sf = row_frag(SS + 16 * ti * 72, 72, 32 * kk, lane);
#pragma unroll
                        for (int vj = 0; vj < 2; ++vj) a1[vj] = __builtin_amdgcn_mfma_f32_16x16x32_bf16(sf, tr_frag(VS, 48, 32 * kk, 16 * vj, lane), a1[vj], 0, 0, 0);
                        a1x = __builtin_amdgcn_mfma_f32_16x16x32_bf16(sf, tr_frag(VS, 48, 32 * kk, 32, lane), a1x, 0, 0, 0); }
#pragma unroll
                    for (int kk = 0; kk < 4; ++kk) { const bf16x8 qf = row_frag(QS + 16 * ti * 136, 136, 32 * kk, lane);
#pragma unroll
                        for (int vj = 0; vj < 2; ++vj) a2[vj] = __builtin_amdgcn_mfma_f32_16x16x32_bf16(qf, row_frag(CSr + 16 * vj * 136, 136, 32 * kk, lane), a2[vj], 0, 0, 0);
                        a3 = __builtin_amdgcn_mfma_f32_16x16x32_bf16(qf, row_frag(CSr + 32 * 136, 136, 32 * kk, lane), a3, 0, 0, 0); }
#pragma unroll
                    for (int i = 0; i < 4; ++i) { const int t_ = 16 * ti + 4 * q + i; const float wi = sc[128 + t_];
                        const float den = row16_sum(a1x[i] + wi * a3[i]); const float rd = __builtin_amdgcn_rcpf(fmaxf(fabsf(den), sc[192 + t_]));
#pragma unroll
                        for (int vj = 0; vj < 2; ++vj) HO[t_ * 40 + 16 * vj + r] = (bf16)f2bf((a1[vj][i] + wi * a2[vj][i]) * rd); }
                    LDS_WAIT();
                    { const int t_ = 16 * ti + (lane >> 2); const int row_ = seq_row(b, dir, c * 64 + t_);
                      *(GAS u32x4*)(HS + ((size_t)dir * NTOK + row_) * 1024 + h * 128 + vs * 32 + 8 * (lane & 3)) = *(const LAS u32x4*)(HO + t_ * 40 + 8 * (lane & 3)); } }
                {   const float wprev = sc[320]; bf16x8 av[2][2], wf[2];
#pragma unroll
                    for (int kk = 0; kk < 2; ++kk) { av[0][kk] = tr_frag(VW, 40, 32 * kk, 0, lane); av[1][kk] = tr_frag(VW, 40, 32 * kk, 16, lane); wf[kk] = row_frag(WKR, 72, 32 * kk, lane); }
#pragma unroll
                    for (int jj = 0; jj < 2; ++jj) { const int dj = 2 * w + jj; Cst[0][jj] = Cst[0][jj] * wprev; Cst[1][jj] = Cst[1][jj] * wprev; Nst[jj] = Nst[jj] * wprev;
#pragma unroll
                        for (int kk = 0; kk < 2; ++kk) { const bf16x8 kf = tr_frag(KS, 136, 32 * kk, 16 * dj, lane);
                            Cst[0][jj] = __builtin_amdgcn_mfma_f32_16x16x32_bf16(av[0][kk], kf, Cst[0][jj], 0, 0, 0); Cst[1][jj] = __builtin_amdgcn_mfma_f32_16x16x32_bf16(av[1][kk], kf, Cst[1][jj], 0, 0, 0);
                            Nst[jj] = __builtin_amdgcn_mfma_f32_16x16x32_bf16(wf[kk], kf, Nst[jj], 0, 0, 0); }
#pragma unroll
                        for (int vi = 0; vi < 2; ++vi)
#pragma unroll
                            for (int i = 0; i < 4; ++i) CSw[(16 * vi + 4 * q + i) * 136 + 16 * dj + r] = (bf16)f2bf(Cst[vi][jj][i]);
                        if (q == 0) CSw[32 * 136 + 16 * dj + r] = (bf16)f2bf(Nst[jj][0]); } }
                }
                gflag_post(CT + 2, lane);
                if (c + 1 < NCH) { gflag_wait(CT, 4u * (unsigned)(c + 2)); ML_STILES(c + 1); gflag_post(CT + 1, lane); }
            }
#undef ML_STILE
#undef ML_STILES

        }
    }
}


constexpr int R2_NS = 8, R2_SLOT = 13312;
constexpr int R2_NK = 0, R2_RT = 2304, R2_AKL = 4608, R2_KDL = 6912, R2_TM = 9216, R2_PP = 10496, R2_VI = 11776, R2_GL = 13056;
constexpr int R2_W2T = 0, R2_A2T = 9216, R2_SVEC = 18432, R2_FLAG = 19712, R2_RING = 20480;
static_assert(R2_RING + R2_NS * R2_SLOT <= MISC_OFF, "rw_scan2 LDS map");
__device__ __forceinline__ unsigned lds_ld(const LAS unsigned* p) { return (unsigned)__builtin_amdgcn_readfirstlane((int)__hip_atomic_load(p, __ATOMIC_RELAXED, __HIP_MEMORY_SCOPE_WORKGROUP)); }
__device__ __forceinline__ f32x4 mfma16(s16x4 a, s16x4 b, f32x4 c) { return __builtin_amdgcn_mfma_f32_16x16x16bf16_1k(a, b, c, 0, 0, 0); }
__device__ __forceinline__ s16x4 pk4(float a, float b, float c, float d) { u32x2 v; v.x = pk2(a, b); v.y = pk2(c, d); return __builtin_bit_cast(s16x4, v); }
__device__ __forceinline__ s16x4 pk4(f32x4 v) { return pk4(v[0], v[1], v[2], v[3]); }
__device__ __forceinline__ s16x4 tr4(const LAS bf16* X, int ld, int k0, int n0, int lane) { const int g = lane >> 4, a = (lane & 15) >> 2, p = lane & 3; return __builtin_amdgcn_ds_read_tr16_b64_v4i16((LAS s16x4*)(X + (k0 + 4 * g + a) * ld + n0 + 4 * p)); }
__device__ __forceinline__ f32x4 mmT(f32x4 X, f32x4 Y, f32x4 C) {
#pragma unroll
    for (int i = 0; i < 4; ++i) C = __builtin_amdgcn_mfma_f32_16x16x4f32(X[i], Y[i], C, 0, 0, 0);
    return C; }
__device__ __forceinline__ float qsum4(float x) { float a = x, b = x; asm volatile("s_nop 1\n\tv_permlane16_swap_b32 %0, %1\n\ts_nop 1" : "+v"(a), "+v"(b)); const float y = a + b; float c = y, d = y; asm volatile("s_nop 1\n\tv_permlane32_swap_b32 %0, %1\n\ts_nop 1" : "+v"(c), "+v"(d)); return c + d; }
__device__ __forceinline__ float rdlane(float v, int l) { return __builtin_bit_cast(float, __builtin_amdgcn_readlane(__builtin_bit_cast(int, v), l)); }
template <int PROBE> PHASE_FN void rw_scan2_phase(Frame F, const GAS bf16* Rr, const GAS bf16* Kk, const GAS bf16* Vv, const GAS bf16* WH, const GAS bf16* AH, GAS bf16* O  , GAS float* BETA  ) {
    LAS bf16* W2T = (LAS bf16*)(F.lds + R2_W2T); LAS bf16* A2T = (LAS bf16*)(F.lds + R2_A2T); LAS float* SVEC = (LAS float*)(F.lds + R2_SVEC);
    LAS unsigned* ready = (LAS unsigned*)(F.lds + R2_FLAG); LAS unsigned* done = ready + 8; LAS unsigned* nextc = ready + 12;
    const int tid = F.tid, w = F.wave;
    constexpr int NCK = T / 16;
    for (int unit = F.bid; unit < 256; unit += F.G) {
        const int un = (F.G == 256) ? ((((unit & 7) * 16 + (unit >> 4)) << 1) | ((unit >> 3) & 1)) : unit;
        const int half = un & 1, dir = (un >> 1) & 1, h = (un >> 2) & 15, b = un >> 6;
        __syncthreads();
        for (int i = tid; i < 4096; i += NTHR) { const int l = i >> 6, jn = i & 63; W2T[jn * 72 + l] = (bf16)f2bf(-1.4426950408889634f * INP(IN_RW_W2)[((size_t)(dir * 64 + l)) * 1024 + h * 64 + jn]); A2T[jn * 72 + l] = (bf16)f2bf(-1.4426950408889634f * INP(IN_RW_A2)[((size_t)(dir * 64 + l)) * 1024 + h * 64 + jn]); }
        if (tid < 64) { SVEC[tid] = -1.4426950408889634f * INP(IN_RW_W0)[dir * 1024 + h * 64 + tid]; SVEC[64 + tid] = -1.4426950408889634f * INP(IN_RW_A0)[dir * 1024 + h * 64 + tid]; SVEC[128 + tid] = INP(IN_RW_KK)[h * 64 + tid];
            SVEC[192 + tid] = INP(IN_RW_KA)[h * 64 + tid]; SVEC[256 + tid] = INP(IN_RW_RK)[h * 64 + tid]; }
        if (tid < 16) ready[tid] = 0u;
        __syncthreads();
        if (w >= 2) {
            f32x4 ckk[4], cka[4], crk[4];
            { const int q0 = F.lane >> 4;
#pragma unroll
              for (int kt = 0; kt < 4; ++kt) { const int k0 = 16 * kt + 4 * q0; ckk[kt] = *(const LAS f32x4*)(SVEC + 128 + k0); cka[kt] = *(const LAS f32x4*)(SVEC + 192 + k0); crk[kt] = *(const LAS f32x4*)(SVEC + 256 + k0); } }
            u32x2 gr[4], gk[4]; u32x4 gw[2], ga[2], gv;
#define R2_LOAD(cc) do { const int r_ = F.lane & 15, q_ = F.lane >> 4; const size_t row_ = (size_t)seq_row(b, dir, (cc) * 16 + r_); \
                _Pragma("unroll") for (int kt = 0; kt < 4; ++kt) { gr[kt] = *(const GAS u32x2*)(Rr + row_ * 1024 + h * 64 + 16 * kt + 4 * q_); gk[kt] = *(const GAS u32x2*)(Kk + row_ * 1024 + h * 64 + 16 * kt + 4 * q_); } \
                _Pragma("unroll") for (int kk = 0; kk < 2; ++kk) { gw[kk] = *(const GAS u32x4*)(WH + row_ * 128 + dir * 64 + 32 * kk + 8 * q_); ga[kk] = *(const GAS u32x4*)(AH + row_ * 128 + dir * 64 + 32 * kk + 8 * q_); } \
                gv = *(const GAS u32x4*)(Vv + row_ * 1024 + h * 64 + half * 32 + 8 * q_); } while (0)
#define R2_GRAB(dst) do { unsigned v_ = 0u; if (F.lane == 0) v_ = __hip_atomic_fetch_add(nextc, 1u, __ATOMIC_RELAXED, __HIP_MEMORY_SCOPE_WORKGROUP); dst = __builtin_amdgcn_readfirstlane((int)v_); } while (0)
            int c, cn; R2_GRAB(c);
            if (c < NCK) R2_LOAD(c);
            for (; c < NCK; c = cn) {
                R2_GRAB(cn);
                int lane_ = F.lane; asm volatile("" : "+v"(lane_)); const int lane = lane_, r = lane & 15, q = lane >> 4;
                LAS unsigned char* sl = F.lds + R2_RING + (c & (R2_NS - 1)) * R2_SLOT;
                LAS bf16* NKs = (LAS bf16*)(sl + R2_NK); LAS bf16* RTs = (LAS bf16*)(sl + R2_RT); LAS bf16* AKL = (LAS bf16*)(sl + R2_AKL); LAS bf16* KDL = (LAS bf16*)(sl + R2_KDL);
                LAS bf16* TM = (LAS bf16*)(sl + R2_TM); LAS bf16* PP = (LAS bf16*)(sl + R2_PP); LAS bf16* VI = (LAS bf16*)(sl + R2_VI); LAS float* GL = (LAS float*)(sl + R2_GL);
                if (c >= R2_NS) { const unsigned need = (unsigned)(c - R2_NS + 1); while (lds_ld(done) < need || lds_ld(done + 1) < need) __builtin_amdgcn_s_sleep(1); }
                asm volatile("" ::: "memory");
                if (!(PROBE & 2)) {
                VM_WAIT();
                const u32x2 pr0 = gr[0], pr1 = gr[1], pr2 = gr[2], pr3 = gr[3], pk0 = gk[0], pk1 = gk[1], pk2_ = gk[2], pk3 = gk[3];
                const bf16x8 whf0 = __builtin_bit_cast(bf16x8, gw[0]), whf1 = __builtin_bit_cast(bf16x8, gw[1]), ahf0 = __builtin_bit_cast(bf16x8, ga[0]), ahf1 = __builtin_bit_cast(bf16x8, ga[1]);
                *(LAS u32x4*)(VI + r * 40 + 8 * q) = gv;
                asm volatile("" ::: "memory");
                if (cn < NCK && !(PROBE & 32)) R2_LOAD(cn);
                f32x4 accw[4], acca[4];
#pragma unroll
                for (int kh = 0; kh < 2; ++kh) { bf16x8 fw[2][2], fa[2][2];
#pragma unroll
                    for (int k2 = 0; k2 < 2; ++k2) { const int kt = 2 * kh + k2; accw[kt] = *(const LAS f32x4*)(SVEC + 16 * kt + 4 * q); acca[kt] = *(const LAS f32x4*)(SVEC + 64 + 16 * kt + 4 * q);
#pragma unroll
                        for (int kk = 0; kk < 2; ++kk) { fw[k2][kk] = *(const LAS bf16x8*)(W2T + (16 * kt + r) * 72 + 32 * kk + 8 * q); fa[k2][kk] = *(const LAS bf16x8*)(A2T + (16 * kt + r) * 72 + 32 * kk + 8 * q); } }
                    LDS_WAIT();
#pragma unroll
                    for (int k2 = 0; k2 < 2; ++k2) { const int kt = 2 * kh + k2;
                        accw[kt] = __builtin_amdgcn_mfma_f32_16x16x32_bf16(fw[k2][0], whf0, accw[kt], 0, 0, 0); accw[kt] = __builtin_amdgcn_mfma_f32_16x16x32_bf16(fw[k2][1], whf1, accw[kt], 0, 0, 0);
                        acca[kt] = __builtin_amdgcn_mfma_f32_16x16x32_bf16(fa[k2][0], ahf0, acca[kt], 0, 0, 0); acca[kt] = __builtin_amdgcn_mfma_f32_16x16x32_bf16(fa[k2][1], ahf1, acca[kt], 0, 0, 0); } }
                const u32x2 prk[4] = {pr0, pr1, pr2, pr3}, pkk[4] = {pk0, pk1, pk2_, pk3};
                float rn;
                { float ssq = 0.f;
#pragma unroll
                  for (int kt = 0; kt < 4; ++kt) { const float x0 = bflo(pkk[kt].x) * ckk[kt][0], x1 = bfhi(pkk[kt].x) * ckk[kt][1], x2 = bflo(pkk[kt].y) * ckk[kt][2], x3 = bfhi(pkk[kt].y) * ckk[kt][3]; ssq += x0 * x0 + x1 * x1 + x2 * x2 + x3 * x3; }
                  rn = __builtin_amdgcn_rsqf(fmaxf(qsum4(ssq), 1e-24f)); }
                float bet = 0.f; f32x4 g1 = {0.f, 0.f, 0.f, 0.f}, g2 = g1, g3 = g1, g4 = g1, g1t = g1;
                if (PROBE & 8) { g1 = accw[0] + acca[1]; g2 = accw[1] + acca[0]; g3 = accw[2] + acca[3]; g4 = accw[3]; g1t = acca[2]; bet = rn; } else
#pragma unroll
                for (int kt = 0; kt < 4; ++kt) {
                    const int k0 = 16 * kt + 4 * q;
                    const float kv[4] = {bflo(pkk[kt].x), bfhi(pkk[kt].x), bflo(pkk[kt].y), bfhi(pkk[kt].y)}, rv[4] = {bflo(prk[kt].x), bfhi(prk[kt].x), bflo(prk[kt].y), bfhi(prk[kt].y)};
                    float nk[4], rt[4], aki[4], kdi[4]; f32x4 glv;
#pragma unroll
                    for (int i = 0; i < 4; ++i) { const float lw = -0.8750387749145276f * __builtin_amdgcn_rcpf(1.0f + __builtin_amdgcn_exp2f(accw[kt][i]));
                        float cs = lw; cs += dpp_keep<0x111, 0xF>(0.f, cs); cs += dpp_keep<0x112, 0xF>(0.f, cs); cs += dpp_keep<0x114, 0xF>(0.f, cs); cs += dpp_keep<0x118, 0xF>(0.f, cs);
                        const float e_in = __builtin_amdgcn_exp2f(cs), e_iv = __builtin_amdgcn_rcpf(e_in), e_ex = dpp_keep<0x111, 0xF>(1.0f, e_in);
                        const float av = __builtin_amdgcn_rcpf(1.0f + __builtin_amdgcn_exp2f(acca[kt][i])), kkn = kv[i] * ckk[kt][i] * rn, akk = kkn * av, kd = kv[i] * __builtin_fmaf(av, cka[kt][i], 1.0f - cka[kt][i]);
                        bet += rv[i] * kd * crk[kt][i];
                        nk[i] = kkn * e_ex; rt[i] = rv[i] * e_in; aki[i] = akk * e_iv; kdi[i] = kd * e_iv; glv[i] = e_in; }
                    const s16x4 nkp = pk4(nk[0], nk[1], nk[2], nk[3]), rtp = pk4(rt[0], rt[1], rt[2], rt[3]), akip = pk4(aki[0], aki[1], aki[2], aki[3]), kdip = pk4(kdi[0], kdi[1], kdi[2], kdi[3]);
                    *(LAS s16x4*)(NKs + r * 72 + k0) = nkp; *(LAS s16x4*)(RTs + r * 72 + k0) = rtp; *(LAS s16x4*)(AKL + r * 72 + k0) = akip; *(LAS s16x4*)(KDL + r * 72 + k0) = kdip;
                    if (r == 15) *(LAS f32x4*)(GL + k0) = glv;
                    g1 = mfma16(nkp, akip, g1); g2 = mfma16(nkp, kdip, g2); g3 = mfma16(rtp, akip, g3); g4 = mfma16(rtp, kdip, g4); g1t = mfma16(akip, nkp, g1t); }
                bet = qsum4(bet);
                if (q == 0 && half == 0) BETA[((size_t)dir * NTOK + seq_row(b, dir, c * 16 + r)) * 16 + h] = bet;
                f32x4 Nn, Qn, W1;
#pragma unroll
                for (int i = 0; i < 4; ++i) { const int t_ = 4 * q + i; PP[t_ * 40 + r] = (bf16)f2bf(r <= t_ ? g3[i] : 0.f); PP[t_ * 40 + 16 + r] = (bf16)f2bf(r <= t_ ? g4[i] : 0.f); g2[i] = r < t_ ? g2[i] : 0.f;
                    Nn[i] = r < t_ ? -g1[i] : 0.f; Qn[i] = t_ < r ? -g1t[i] : 0.f; W1[i] = Qn[i] + (t_ == r ? 1.0f : 0.f); }
                if (PROBE & 4) { *(LAS s16x4*)(TM + r * 40 + 4 * q) = pk4(Nn + Qn + W1 + g2); } else
                { const f32x4 z4 = {0.f, 0.f, 0.f, 0.f};
                  const f32x4 Q2 = mmT(Nn, Qn, z4), N2 = mmT(Qn, Nn, z4); const f32x4 W2 = mmT(N2, W1, W1);
                  const f32x4 Q4 = mmT(N2, Q2, z4), N4 = mmT(Q2, N2, z4); const f32x4 W3 = mmT(N4, W2, W2);
                  const f32x4 N8 = mmT(Q4, N4, z4); const f32x4 W4 = mmT(N8, W3, W3);
                  const f32x4 Mp = mmT(W4, g2, z4);
                  *(LAS s16x4*)(TM + r * 40 + 4 * q) = pk4(-W4[0], -W4[1], -W4[2], -W4[3]);
#pragma unroll
                  for (int i = 0; i < 4; ++i) TM[(4 * q + i) * 40 + 16 + r] = (bf16)f2bf(-Mp[i]); }
                }
                LDS_WAIT();
                if (F.lane == 0) __hip_atomic_store(ready + (c & (R2_NS - 1)), (unsigned)(c + 1), __ATOMIC_RELAXED, __HIP_MEMORY_SCOPE_WORKGROUP);
            }
#undef R2_LOAD
#undef R2_GRAB
        } else {
            const int cw = w;
            f32x4 ST[4]; s16x4 Sb[4];
#pragma unroll
            for (int kt = 0; kt < 4; ++kt) { ST[kt] = (f32x4){0.f, 0.f, 0.f, 0.f}; Sb[kt] = (s16x4){0, 0, 0, 0}; }
#define R2C_DECL(S) s16x4 S##nk[4], S##rt[4], S##akl[4], S##kdl[4], S##vf, S##tn, S##mu, S##g3, S##g4; f32x4 S##gl[4]
#define R2C_READ(S, cc) do { int lane_ = F.lane; asm volatile("" : "+v"(lane_)); const int lane = lane_, r = lane & 15, q = lane >> 4; \
                LAS unsigned char* sl = F.lds + R2_RING + ((cc) & (R2_NS - 1)) * R2_SLOT; \
                const LAS bf16* NKs = (const LAS bf16*)(sl + R2_NK); const LAS bf16* RTs = (const LAS bf16*)(sl + R2_RT); const LAS bf16* AKL = (const LAS bf16*)(sl + R2_AKL); const LAS bf16* KDL = (const LAS bf16*)(sl + R2_KDL); \
                const LAS bf16* TM = (const LAS bf16*)(sl + R2_TM); const LAS bf16* PP = (const LAS bf16*)(sl + R2_PP); const LAS bf16* VI = (const LAS bf16*)(sl + R2_VI); const LAS float* GL = (const LAS float*)(sl + R2_GL); \
                while (lds_ld(ready + ((cc) & (R2_NS - 1))) != (unsigned)((cc) + 1)) __builtin_amdgcn_s_sleep(1); \
                asm volatile("" ::: "memory"); \
                _Pragma("unroll") for (int kt = 0; kt < 4; ++kt) { S##nk[kt] = *(const LAS s16x4*)(NKs + r * 72 + 16 * kt + 4 * q); S##rt[kt] = *(const LAS s16x4*)(RTs + r * 72 + 16 * kt + 4 * q); } \
                S##vf = tr4(VI, 40, 0, 16 * cw, lane); S##tn = *(const LAS s16x4*)(TM + r * 40 + 4 * q); S##mu = *(const LAS s16x4*)(TM + r * 40 + 16 + 4 * q); \
                _Pragma("unroll") for (int kt = 0; kt < 4; ++kt) { S##kdl[kt] = tr4(KDL, 72, 0, 16 * kt, lane); S##gl[kt] = *(const LAS f32x4*)(GL + 16 * kt + 4 * q); S##akl[kt] = tr4(AKL, 72, 0, 16 * kt, lane); } \
                S##g3 = *(const LAS s16x4*)(PP + r * 40 + 4 * q); S##g4 = *(const LAS s16x4*)(PP + r * 40 + 16 + 4 * q); } while (0)
#define R2C_CHAIN(S, cc) do { f32x4 xa = {0.f, 0.f, 0.f, 0.f}, ot = xa, ua = xa; \
                _Pragma("unroll") for (int kt = 0; kt < 4; ++kt) xa = mfma16(S##nk[kt], Sb[kt], xa);                             \
                ua = mfma16(S##mu, S##vf, ua); \
                _Pragma("unroll") for (int kt = 0; kt < 4; ++kt) ot = mfma16(Sb[kt], S##rt[kt], ot);                             \
                _Pragma("unroll") for (int kt = 0; kt < 4; ++kt) ST[kt] = mfma16(S##kdl[kt], S##vf, ST[kt]); \
                ua = mfma16(S##tn, pk4(xa), ua);                                                                                 \
                ot = mfma16(S##vf, S##g4, ot); \
                const s16x4 ub = pk4(ua); \
                _Pragma("unroll") for (int kt = 0; kt < 4; ++kt) { ST[kt] = mfma16(S##akl[kt], ub, ST[kt]) * S##gl[kt]; Sb[kt] = pk4(ST[kt]); }     \
                ot = mfma16(ub, S##g3, ot); \
                { const int r_ = F.lane & 15, q_ = F.lane >> 4; u32x2 pk_; pk_.x = pk2(ot[0], ot[1]); pk_.y = pk2(ot[2], ot[3]); \
                  *(GAS u32x2*)(O + ((size_t)dir * NTOK + (size_t)seq_row(b, dir, (cc) * 16 + r_)) * 1024 + h * 64 + half * 32 + 16 * cw + 4 * q_) = pk_; } } while (0)
#define R2C_DONE(cc) do { LDS_WAIT(); if (F.lane == 0) __hip_atomic_store(done + cw, (unsigned)((cc) + 1), __ATOMIC_RELAXED, __HIP_MEMORY_SCOPE_WORKGROUP); } while (0)
            R2C_DECL(A_); R2C_DECL(B_);
            __builtin_amdgcn_s_setprio(3);
            if (!(PROBE & 1)) {
                R2C_READ(A_, 0);
                for (int c = 0; c < NCK; c += 2) {
                    R2C_DONE(c); R2C_READ(B_, c + 1); R2C_CHAIN(A_, c);
                    R2C_DONE(c + 1); if (c + 2 < NCK) R2C_READ(A_, c + 2); R2C_CHAIN(B_, c + 1);
                }
            } else {
                for (int c = 0; c < NCK; ++c) { while (lds_ld(ready + (c & (R2_NS - 1))) != (unsigned)(c + 1)) __builtin_amdgcn_s_sleep(1); R2C_DONE(c); }
            }
            __builtin_amdgcn_s_setprio(0);
#undef R2C_DECL
#undef R2C_READ
#undef R2C_CHAIN
#undef R2C_DONE
        }
    }
}

__device__ __forceinline__ float fmix_lo(float a, unsigned b, float c) { float d; asm("v_fma_mix_f32 %0, %1, %2, %3 op_sel:[0,0,0] op_sel_hi:[0,1,0]" : "=v"(d) : "v"(a), "v"(b), "v"(c)); return d; }
__device__ __forceinline__ float fmix_hi(float a, unsigned b, float c) { float d; asm("v_fma_mix_f32 %0, %1, %2, %3 op_sel:[0,1,0] op_sel_hi:[0,1,0]" : "=v"(d) : "v"(a), "v"(b), "v"(c)); return d; }
__device__ __forceinline__ unsigned pkh2(float lo, float hi) { typedef _Float16 h2_t __attribute__((ext_vector_type(2))); h2_t v; v.x = (_Float16)lo; v.y = (_Float16)hi; return __builtin_bit_cast(unsigned, v); }
constexpr int RW_STEPB = 768;
typedef _Float16 h2_t __attribute__((ext_vector_type(2)));
template <int CTRL> __device__ __forceinline__ float dpp_add(float v) { return v + dpp_f<CTRL>(v); }
__device__ __forceinline__ float row8_sum(float v) { v = dpp_add<0xB1>(v); v = dpp_add<0x4E>(v); v = dpp_add<0x141>(v); return v; }
template <int PROBE> PHASE_FN void rw_scan_phase(Frame F, const GAS bf16* Rr, const GAS bf16* Kk, const GAS bf16* Vv, const GAS bf16* WH, const GAS bf16* AH, GAS bf16* O  , GAS float* BETA  ) {
    LAS bf16* W2T = (LAS bf16*)(F.lds + 0); LAS bf16* A2T = (LAS bf16*)(F.lds + 9216);
    LAS bf16* WHS = (LAS bf16*)(F.lds + 18432); LAS bf16* AHS = (LAS bf16*)(F.lds + 27648);
    LAS float* WPA = (LAS float*)(F.lds + 36864);
    LAS unsigned char* STEP = F.lds + 53248;
    LAS float* OP = (LAS float*)(F.lds + 102400);
    LAS float* SO = (LAS float*)(F.lds + 135168);
    LAS float* SVEC = (LAS float*)(F.lds + 143360);
    const int tid = F.tid, lane = F.lane, w = F.wave;
    constexpr int NCH = T / 32;
    for (int unit = F.bid; unit < 256; unit += F.G) {
        const int un = (F.G == 256) ? ((((unit & 7) * 16 + (unit >> 4)) << 1) | ((unit >> 3) & 1)) : unit;
        const int half = un & 1, dir = (un >> 1) & 1, h = (un >> 2) & 15, b = un >> 6;
        __syncthreads();
        for (int i = tid; i < 4096; i += NTHR) { const int l = i >> 6, jn = i & 63; W2T[jn * 72 + l] = (bf16)f2bf(INP(IN_RW_W2)[((size_t)(dir * 64 + l)) * 1024 + h * 64 + jn]); A2T[jn * 72 + l] = (bf16)f2bf(INP(IN_RW_A2)[((size_t)(dir * 64 + l)) * 1024 + h * 64 + jn]); }
        if (tid < 64) { SVEC[tid] = INP(IN_RW_W0)[dir * 1024 + h * 64 + tid]; SVEC[64 + tid] = INP(IN_RW_A0)[dir * 1024 + h * 64 + tid]; SVEC[128 + tid] = INP(IN_RW_KK)[h * 64 + tid];
            SVEC[192 + tid] = INP(IN_RW_KA)[h * 64 + tid]; SVEC[256 + tid] = INP(IN_RW_RK)[h * 64 + tid]; }
        __syncthreads();
        if (w >= 4) {
            const int p = w - 4, tl = lane >> 3, c8 = lane & 7, tp = 8 * p + tl, kc = 8 * c8;
            u32x4 rr, rk, rwh, rah; u32x2 rv;
#define RW_LOAD_RKV(cc) do { const size_t row_ = (size_t)seq_row(b, dir, (cc) * 32 + tp); rr = *(const GAS u32x4*)(Rr + row_ * 1024 + h * 64 + kc); rk = *(const GAS u32x4*)(Kk + row_ * 1024 + h * 64 + kc); \
                rv = *(const GAS u32x2*)(Vv + row_ * 1024 + h * 64 + half * 32 + 4 * c8); } while (0)
#define RW_LOAD_H(cc) do { const size_t row_ = (size_t)seq_row(b, dir, (cc) * 32 + tp); rwh = *(const GAS u32x4*)(WH + row_ * 128 + dir * 64 + kc); rah = *(const GAS u32x4*)(AH + row_ * 128 + dir * 64 + kc); } while (0)
#define RW_STAGE_H(buf) do { *(LAS u32x4*)(WHS + (buf) * (32 * 72) + tp * 72 + kc) = rwh; *(LAS u32x4*)(AHS + (buf) * (32 * 72) + tp * 72 + kc) = rah; } while (0)
#define RW_PREP(cc) do { const int bb_ = (cc) & 1; LAS float* wpa_ = WPA + p * 1024; const int r_ = lane & 15, q_ = lane >> 4; \
                _Pragma("unroll") for (int kt = 0; kt < 4; ++kt) { f32x4 aw_ = {0.f, 0.f, 0.f, 0.f}, aa_ = aw_; \
                    aw_ = mm16<64>(aw_, WHS + bb_ * (32 * 72) + 16 * (p >> 1) * 72, 72, W2T + 16 * kt * 72, 72, lane); aa_ = mm16<64>(aa_, AHS + bb_ * (32 * 72) + 16 * (p >> 1) * 72, 72, A2T + 16 * kt * 72, 72, lane); \
                    if ((q_ >> 1) == (p & 1)) { _Pragma("unroll") for (int i = 0; i < 4; ++i) { wpa_[(4 * (q_ & 1) + i) * 64 + 16 * kt + r_] = aw_[i]; wpa_[512 + (4 * (q_ & 1) + i) * 64 + 16 * kt + r_] = aa_[i]; } } } \
                LDS_WAIT(); \
                float wp_[8], ap_[8], kv_[8], rq_[8]; \
                _Pragma("unroll") for (int jj = 0; jj < 2; ++jj) { const f32x4 x_ = *(const LAS f32x4*)(wpa_ + tl * 64 + kc + 4 * jj) + *(const LAS f32x4*)(SVEC + kc + 4 * jj), y_ = *(const LAS f32x4*)(wpa_ + 512 + tl * 64 + kc + 4 * jj) + *(const LAS f32x4*)(SVEC + 64 + kc + 4 * jj); \
                    _Pragma("unroll") for (int i = 0; i < 4; ++i) { wp_[4 * jj + i] = x_[i]; ap_[4 * jj + i] = y_[i]; } } \
                _Pragma("unroll") for (int jj = 0; jj < 4; ++jj) { kv_[2 * jj] = bflo(rk[jj]); kv_[2 * jj + 1] = bfhi(rk[jj]); rq_[2 * jj] = bflo(rr[jj]); rq_[2 * jj + 1] = bfhi(rr[jj]); } \
                float now_[8], av_[8], kx_[8], gin_[8], gex_[8], ginv_[8], ssq_ = 0.f, bet_ = 0.f; \
                _Pragma("unroll") for (int j = 0; j < 8; ++j) { const float lw_ = -0.6065306597126334f * sigmoid_f(wp_[j]);     \
                    float cs_ = lw_; float y_ = __shfl_up(cs_, 8); if (tl >= 1) cs_ += y_; y_ = __shfl_up(cs_, 16); if (tl >= 2) cs_ += y_; y_ = __shfl_up(cs_, 32); if (tl >= 4) cs_ += y_;     \
                    gin_[j] = __expf(cs_); gex_[j] = __expf(cs_ - lw_); ginv_[j] = __expf(-cs_); now_[j] = gin_[j] - 1.0f;     \
                    av_[j] = sigmoid_f(ap_[j]); kx_[j] = kv_[j] * SVEC[128 + kc + j]; ssq_ += kx_[j] * kx_[j]; } \
                ssq_ = row8_sum(ssq_); const float rn_ = __builtin_amdgcn_rsqf(fmaxf(ssq_, 1e-24f)); \
                u32x4 p0_, p1_, p2_, p3_, p4_; \
                _Pragma("unroll") for (int jj = 0; jj < 4; ++jj) { float nk_[2], ak_[2], kd_[2], rs_[2]; \
                    _Pragma("unroll") for (int hh = 0; hh < 2; ++hh) { const int j = 2 * jj + hh; const float kkn_ = kx_[j] * rn_; nk_[hh] = -kkn_ * gex_[j]; ak_[hh] = kkn_ * av_[j] * ginv_[j]; const float kdt_ = kv_[j] * (1.0f + (av_[j] - 1.0f) * SVEC[192 + kc + j]); kd_[hh] = kdt_ * ginv_[j]; bet_ += rq_[j] * kdt_ * SVEC[256 + kc + j]; rs_[hh] = rq_[j] * gin_[j]; } \
                    p0_[jj] = pkh2(now_[2 * jj], now_[2 * jj + 1]); p1_[jj] = pkh2(nk_[0], nk_[1]); p4_[jj] = pkh2(rs_[0], rs_[1]); \
                    if (jj < 2) { p2_[2 * jj] = pkh2(ak_[0], kd_[0]); p2_[2 * jj + 1] = pkh2(ak_[1], kd_[1]); } else { p3_[2 * (jj - 2)] = pkh2(ak_[0], kd_[0]); p3_[2 * (jj - 2) + 1] = pkh2(ak_[1], kd_[1]); } } \
                bet_ = row8_sum(bet_); \
                LAS unsigned char* sp_ = STEP + bb_ * (32 * RW_STEPB) + tp * RW_STEPB + c8 * 80; \
                *(LAS u32x4*)sp_ = p0_; *(LAS u32x4*)(sp_ + 16) = p1_; *(LAS u32x4*)(sp_ + 32) = p2_; *(LAS u32x4*)(sp_ + 48) = p3_; *(LAS u32x4*)(sp_ + 64) = p4_; \
                *(LAS f32x4*)(STEP + bb_ * (32 * RW_STEPB) + tp * RW_STEPB + 640 + 16 * c8) = (f32x4){bflo(rv.x), bfhi(rv.x), bflo(rv.y), bfhi(rv.y)}; \
                if (c8 == 0 && half == 0) BETA[((size_t)dir * NTOK + seq_row(b, dir, (cc) * 32 + tp)) * 16 + h] = bet_; } while (0)
#define RW_STORE(cc) do { const size_t row_ = (size_t)seq_row(b, dir, (cc) * 32 + tp); const f32x4 o_ = *(const LAS f32x4*)(SO + ((cc) & 1) * 1024 + tp * 32 + 4 * c8); u32x2 pk_; pk_.x = pk2(o_[0], o_[1]); pk_.y = pk2(o_[2], o_[3]); \
                *(GAS u32x2*)(O + ((size_t)dir * NTOK + row_) * 1024 + h * 64 + half * 32 + 4 * c8) = pk_; } while (0)
            RW_LOAD_H(0); RW_LOAD_RKV(0); RW_STAGE_H(0); RW_LOAD_H(1);
            __syncthreads();
            RW_PREP(0); RW_STAGE_H(1); RW_LOAD_RKV(1); RW_LOAD_H(2);
            __syncthreads();
            for (int c = 0; c < NCH; ++c) {
                if (!(PROBE & 2)) {
                if (c > 0) RW_STORE(c - 1);
                if (c + 1 < NCH) { RW_PREP(c + 1); if (c + 2 < NCH) { RW_STAGE_H(c & 1); RW_LOAD_RKV(c + 2); if (c + 3 < NCH) RW_LOAD_H(c + 3); } }
                }
                __syncthreads();
            }
            RW_STORE(NCH - 1);
#undef RW_LOAD_RKV
#undef RW_LOAD_H
#undef RW_STAGE_H
#undef RW_PREP
#undef RW_STORE
        } else {
            const int row = tid >> 3, c8 = tid & 7;
            float S0 = 0.f, S1 = 0.f, S2 = 0.f, S3 = 0.f, S4 = 0.f, S5 = 0.f, S6 = 0.f, S7 = 0.f;
            __syncthreads();
            __syncthreads();
            for (int c = 0; c < NCH; ++c) {
                if (!(PROBE & 1)) {
                const LAS unsigned char* sp = STEP + (c & 1) * (32 * RW_STEPB) + c8 * 80; const LAS unsigned char* vp = STEP + (c & 1) * (32 * RW_STEPB) + 640 + 4 * row; LAS float* op = OP + row * 8 + c8;
                u32x4 a0 = *(const LAS u32x4*)sp, a1 = *(const LAS u32x4*)(sp + 16), a2 = *(const LAS u32x4*)(sp + 32), a3 = *(const LAS u32x4*)(sp + 48), a4 = *(const LAS u32x4*)(sp + 64); float vv = *(const LAS float*)vp;
#pragma unroll 8
                for (int t_ = 0; t_ < 32; ++t_) {
                    const int tn = (t_ + 1) & 31;
                    const LAS unsigned char* np = sp + tn * RW_STEPB;
                    const u32x4 n0 = *(const LAS u32x4*)np, n1 = *(const LAS u32x4*)(np + 16), n2 = *(const LAS u32x4*)(np + 32), n3 = *(const LAS u32x4*)(np + 48), n4 = *(const LAS u32x4*)(np + 64); const float vn = *(const LAS float*)(vp + tn * RW_STEPB);
                    float sa, sb, oa, ob; unsigned sv;
                    asm volatile(
                        "v_fma_mix_f32 %8, %0, %10, 0 op_sel:[0,0,0] op_sel_hi:[0,1,0]\n\t"
                        "v_fma_mix_f32 %9, %1, %10, 0 op_sel:[0,1,0] op_sel_hi:[0,1,0]\n\t"
                        "v_fma_mix_f32 %8, %2, %11, %8 op_sel:[0,0,0] op_sel_hi:[0,1,0]\n\t"
                        "v_fma_mix_f32 %9, %3, %11, %9 op_sel:[0,1,0] op_sel_hi:[0,1,0]\n\t"
                        "v_fma_mix_f32 %8, %4, %12, %8 op_sel:[0,0,0] op_sel_hi:[0,1,0]\n\t"
                        "v_fma_mix_f32 %9, %5, %12, %9 op_sel:[0,1,0] op_sel_hi:[0,1,0]\n\t"
                        "v_fma_mix_f32 %8, %6, %13, %8 op_sel:[0,0,0] op_sel_hi:[0,1,0]\n\t"
                        "v_fma_mix_f32 %9, %7, %13, %9 op_sel:[0,1,0] op_sel_hi:[0,1,0]\n\t"
                        "s_nop 0\n\t"
                        "v_add_f32 %8, %8, %9\n\t"
                        "s_nop 1\n\t"
                        "v_add_f32_dpp %8, %8, %8 quad_perm:[1,0,3,2] row_mask:0xf bank_mask:0xf bound_ctrl:1\n\t"
                        "s_nop 1\n\t"
                        "v_add_f32_dpp %8, %8, %8 quad_perm:[2,3,0,1] row_mask:0xf bank_mask:0xf bound_ctrl:1\n\t"
                        "s_nop 1\n\t"
                        "v_add_f32_dpp %8, %8, %8 row_half_mirror row_mask:0xf bank_mask:0xf bound_ctrl:1\n\t"
                        "s_nop 0"
                        : "+v"(S0), "+v"(S1), "+v"(S2), "+v"(S3), "+v"(S4), "+v"(S5), "+v"(S6), "+v"(S7), "=&v"(sa), "=&v"(sb)
                        : "v"(a1[0]), "v"(a1[1]), "v"(a1[2]), "v"(a1[3]));
                    if (PROBE & 4) asm volatile(
                        "v_cvt_pkrtz_f16_f32 %8, %9, %10\n\t"
                        "v_dot2c_f32_f16 %0, %8, %11\n\t"
                        "v_dot2c_f32_f16 %1, %8, %12\n\t"
                        "v_dot2c_f32_f16 %2, %8, %13\n\t"
                        "v_dot2c_f32_f16 %3, %8, %14\n\t"
                        "v_dot2c_f32_f16 %4, %8, %15\n\t"
                        "v_dot2c_f32_f16 %5, %8, %16\n\t"
                        "v_dot2c_f32_f16 %6, %8, %17\n\t"
                        "v_dot2c_f32_f16 %7, %8, %18\n\t"
                        "s_nop 2"
                        : "+v"(S0), "+v"(S1), "+v"(S2), "+v"(S3), "+v"(S4), "+v"(S5), "+v"(S6), "+v"(S7), "=&v"(sv)
                        : "v"(sa), "v"(vv), "v"(a2[0]), "v"(a2[1]), "v"(a2[2]), "v"(a2[3]), "v"(a3[0]), "v"(a3[1]), "v"(a3[2]), "v"(a3[3]));
                    else
                    asm volatile(
                        "v_cvt_pkrtz_f16_f32 %8, %11, %12\n\t"
                        "v_dot2c_f32_f16 %0, %8, %13\n\t"
                        "v_dot2c_f32_f16 %1, %8, %14\n\t"
                        "v_dot2c_f32_f16 %2, %8, %15\n\t"
                        "v_dot2c_f32_f16 %3, %8, %16\n\t"
                        "v_dot2c_f32_f16 %4, %8, %17\n\t"
                        "v_dot2c_f32_f16 %5, %8, %18\n\t"
                        "v_dot2c_f32_f16 %6, %8, %19\n\t"
                        "v_dot2c_f32_f16 %7, %8, %20\n\t"
                        "v_fma_mix_f32 %9, %0, %21, 0 op_sel:[0,0,0] op_sel_hi:[0,1,0]\n\t"
                        "v_fma_mix_f32 %10, %1, %21, 0 op_sel:[0,1,0] op_sel_hi:[0,1,0]\n\t"
                        "v_fma_mix_f32 %9, %2, %22, %9 op_sel:[0,0,0] op_sel_hi:[0,1,0]\n\t"
                        "v_fma_mix_f32 %10, %3, %22, %10 op_sel:[0,1,0] op_sel_hi:[0,1,0]\n\t"
                        "v_fma_mix_f32 %9, %4, %23, %9 op_sel:[0,0,0] op_sel_hi:[0,1,0]\n\t"
                        "v_fma_mix_f32 %10, %5, %23, %10 op_sel:[0,1,0] op_sel_hi:[0,1,0]\n\t"
                        "v_fma_mix_f32 %9, %6, %24, %9 op_sel:[0,0,0] op_sel_hi:[0,1,0]\n\t"
                        "v_fma_mix_f32 %10, %7, %24, %10 op_sel:[0,1,0] op_sel_hi:[0,1,0]\n\t"
                        "v_add_f32 %9, %9, %10\n\t"
                        "s_nop 0"
                        : "+v"(S0), "+v"(S1), "+v"(S2), "+v"(S3), "+v"(S4), "+v"(S5), "+v"(S6), "+v"(S7), "=&v"(sv), "=&v"(oa), "=&v"(ob)
                        : "v"(sa), "v"(vv), "v"(a2[0]), "v"(a2[1]), "v"(a2[2]), "v"(a2[3]), "v"(a3[0]), "v"(a3[1]), "v"(a3[2]), "v"(a3[3]), "v"(a4[0]), "v"(a4[1]), "v"(a4[2]), "v"(a4[3]));
                    if ((t_ & 7) == 7)
                        asm volatile(
                            "s_nop 1\n\t"
                            "v_fma_mix_f32 %0, %0, %8, %0 op_sel:[0,0,0] op_sel_hi:[0,1,0]\n\t"
                            "v_fma_mix_f32 %1, %1, %8, %1 op_sel:[0,1,0] op_sel_hi:[0,1,0]\n\t"
                            "v_fma_mix_f32 %2, %2, %9, %2 op_sel:[0,0,0] op_sel_hi:[0,1,0]\n\t"
                            "v_fma_mix_f32 %3, %3, %9, %3 op_sel:[0,1,0] op_sel_hi:[0,1,0]\n\t"
                            "v_fma_mix_f32 %4, %4, %10, %4 op_sel:[0,0,0] op_sel_hi:[0,1,0]\n\t"
                            "v_fma_mix_f32 %5, %5, %10, %5 op_sel:[0,1,0] op_sel_hi:[0,1,0]\n\t"
                            "v_fma_mix_f32 %6, %6, %11, %6 op_sel:[0,0,0] op_sel_hi:[0,1,0]\n\t"
                            "v_fma_mix_f32 %7, %7, %11, %7 op_sel:[0,1,0] op_sel_hi:[0,1,0]\n\t"
                            "s_nop 0"
                            : "+v"(S0), "+v"(S1), "+v"(S2), "+v"(S3), "+v"(S4), "+v"(S5), "+v"(S6), "+v"(S7)
                            : "v"(a0[0]), "v"(a0[1]), "v"(a0[2]), "v"(a0[3]));
                    if (!(PROBE & 4)) op[t_ * 256] = oa;
                    a0 = n0; a1 = n1; a2 = n2; a3 = n3; a4 = n4; vv = vn;
                }
                LDS_WAIT();
#pragma unroll
                for (int i = 0; i < 4; ++i) { const LAS f32x4* q_ = (const LAS f32x4*)(OP + ((4 * c8 + i) * 32 + row) * 8); const f32x4 x_ = q_[0] + q_[1]; SO[(c & 1) * 1024 + (4 * c8 + i) * 32 + row] = (x_[0] + x_[1]) + (x_[2] + x_[3]); }
                }
                __syncthreads();
            }
        }
    }
}

PHASE_FN void gemm_mlin(Frame F, int jl) { GAS unsigned char* MIX = F.ws + WS_MIX; GAS unsigned char* HY = F.ws + WS_HY;
    pg8::Gemm g{(const GAS bf16*)HY, (const GAS bf16*)(F.W + W_ML_WIN + jl * W_ML_WIN_SZ), NTOK, 4352, 1024}; pg8::StaticOrder So; So.init(NTOK, 4352, F.G, F.bid);
    pg8::EpiMlstmIn E{(GAS bf16*)MIX, (GAS bf16*)(MIX + 2 * ROWB), (GAS bf16*)(MIX + 3 * ROWB), (GAS float*)(MIX + 4 * ROWB), INP(IN_ML_BGATE) + jl * 32};
    pg8::gemm_phase<pg8::EpiMlstmIn, pg8::StaticOrder, true, GEMM_SP2>(F.lds, g, So, E, F.tid); }
PHASE_FN void gemm_resid(Frame F, const GAS bf16* A, const GAS bf16* Bt, int L, int dry = 0) {
    pg8::Gemm g{A, Bt, NTOK, 1024, 1024}; pg8::StaticOrder So; So.init(NTOK, 1024, F.G, F.bid);
    pg8::EpiResid E{F.ws + WS_S, (const GAS float*)(F.ws + WS_MOD) + (size_t)L * 5 * 6144, 2, dry}; pg8::gemm_phase<pg8::EpiResid, pg8::StaticOrder, true, GEMM_SP2>(F.lds, g, So, E, F.tid); }
__device__ __forceinline__ GAS bf16* rw_mix2(const Frame& F) { return (F.W == F.ws + WS_END) ? (GAS bf16*)F.out : (GAS bf16*)(F.ws + WS_END); }
PHASE_FN void gemm_rwin(Frame F) { GAS unsigned char* MIX = F.ws + WS_MIX; GAS unsigned char* HY = F.ws + WS_HY;
    GAS bf16* Rb = (GAS bf16*)MIX; GAS bf16* Kb = (GAS bf16*)(MIX + ROWB); GAS bf16* Vb = (GAS bf16*)(MIX + 2 * ROWB); GAS float* WH = (GAS float*)(MIX + 3 * ROWB); GAS float* AH = WH + (size_t)NTOK * 128; GAS bf16* GH = (GAS bf16*)(AH + (size_t)NTOK * 128);
    const GAS bf16* Wp = (const GAS bf16*)(F.W + W_RW_IN);
    const GAS bf16* Am[3] = {(const GAS bf16*)(F.ws + WS_S + ROWB), (const GAS bf16*)(MIX + 256 * MiB), rw_mix2(F)};
#pragma unroll
    for (int j = 0; j < 3; ++j) { pg8::Gemm g{Am[j], Wp + (size_t)j * 1024 * 1024, NTOK, 1024, 1024}; pg8::StaticOrder So; So.init(NTOK, 1024, F.G, (F.bid + F.G - 16 * j) % F.G);
        pg8::EpiRwkvIn E{Rb, Kb, Vb, WH, AH, GH, 4 * j}; pg8::gemm_phase<pg8::EpiRwkvIn, pg8::StaticOrder, true, GEMM_SP2>(F.lds, g, So, E, F.tid); __syncthreads(); }
    { pg8::Gemm g{(const GAS bf16*)HY, Wp + (size_t)3072 * 2048, NTOK, 512, 2048}; pg8::StaticOrder So; So.init(NTOK, 512, F.G, (F.bid + F.G - 48) % F.G);
      pg8::EpiRwkvIn E{Rb, Kb, Vb, WH, AH, GH, 12}; pg8::gemm_phase<pg8::EpiRwkvIn, pg8::StaticOrder, true, GEMM_SP2>(F.lds, g, So, E, F.tid); } }
PHASE_FN void gemm_rwg(Frame F) { GAS unsigned char* MIX = F.ws + WS_MIX;
    GAS float* WH = (GAS float*)(MIX + 3 * ROWB); GAS float* AH = WH + (size_t)NTOK * 128; GAS bf16* GH = (GAS bf16*)(AH + (size_t)NTOK * 128);
    pg8::Gemm g{GH, (const GAS bf16*)(F.W + W_RW_G2), NTOK, 1024, 256}; pg8::StaticOrder So; So.init(NTOK, 1024, F.G, F.bid);
    pg8::EpiBf16Plain E{(GAS bf16*)MIX, 1024}; pg8::gemm_phase<pg8::EpiBf16Plain, pg8::StaticOrder, GEMM_ALIGN, GEMM_SP2>(F.lds, g, So, E, F.tid); }
PHASE_FN void gemm_hgin(Frame F) { GAS unsigned char* MIX = F.ws + WS_MIX; GAS unsigned char* HY = F.ws + WS_HY;
    pg8::Gemm g{(const GAS bf16*)HY, (const GAS bf16*)(F.W + W_HG_IN), NTOK, 5120, 1024}; pg8::StaticOrder So; So.init(NTOK, 5120, F.G, F.bid);
    pg8::EpiHgrnIn E{(GAS bf16*)MIX, (GAS bf16*)(MIX + ROWB), (GAS bf16*)(MIX + 2 * ROWB), (GAS bf16*)(MIX + 3 * ROWB), (size_t)NTOK * 1024, INP(IN_HG_BF), (const GAS float*)(F.ws + WS_LB)};
    pg8::gemm_phase<pg8::EpiHgrnIn, pg8::StaticOrder, true, GEMM_SP2>(F.lds, g, So, E, F.tid); }
PHASE_FN void gemm_moe1(Frame F, int L) { GAS unsigned char* MIX = F.ws + WS_MIX; LAS int* pref = (LAS int*)(F.lds + LDS_PHASE_BYTES); moe_prefix(F, L, pref, pref + 32);
    pg8::Gemm g{(const GAS bf16*)(F.ws + WS_HY), (const GAS bf16*)(F.W + W_EX13), NSLOT, 16384, 1024, (const GAS int*)(F.ws + WS_SLOT_TOK)}; pg8::MoeOrder So{pref, F.G, F.bid};
    pg8::EpiMoe1 E{(GAS bf16*)(MIX + 140 * MiB)}; pg8::gemm_phase<pg8::EpiMoe1, pg8::MoeOrder, true, GEMM_SP2, true>(F.lds, g, So, E, F.tid); }
PHASE_FN void gemm_moe2(Frame F, int L) { GAS unsigned char* MIX = F.ws + WS_MIX; LAS int* pref = (LAS int*)(F.lds + LDS_PHASE_BYTES); moe_prefix(F, L, pref, pref + 32);
    pg8::Gemm g{(const GAS bf16*)(MIX + 140 * MiB), (const GAS bf16*)(F.W + W_EX2), NSLOT, 16384, 512}; pg8::MoeOrder So{pref, F.G, F.bid};
    pg8::EpiMoe2 E{(GAS bf16*)(MIX + 210 * MiB), (const GAS int*)(F.ws + WS_SLOT_TOK), (const GAS float*)(F.ws + WS_SLOT_GATE)};
    pg8::gemm_phase<pg8::EpiMoe2, pg8::MoeOrder, true, GEMM_SP2>(F.lds, g, So, E, F.tid); }

#ifndef MK_PER_PHASE
#define MK_PER_PHASE 0
#endif
constexpr int PH_PER_LAYER = 12, PH_LAYER0 = 2, PH_FINAL = PH_LAYER0 + DEPTH * PH_PER_LAYER, N_PHASES = PH_FINAL + 1;
__global__ void __launch_bounds__(NTHR, 2) fwd_kernel(Args args) {
    extern __shared__ __attribute__((aligned(16))) unsigned char lds_raw[];
    Frame F;
    F.lds = (LAS unsigned char*)lds_raw; F.out = (GAS float*)args.out; F.ws = (GAS unsigned char*)args.ws; F.W = (GAS unsigned char*)args.wts;
    F.tid = threadIdx.x; F.lane = F.tid & 63; F.wave = __builtin_amdgcn_readfirstlane(F.tid >> 6); F.bid = blockIdx.x; F.G = gridDim.x;
    volatile LAS unsigned* MISC = (volatile LAS unsigned*)(F.lds + MISC_OFF);
    if (F.tid < 32) MISC[F.tid] = 0u;
    if (F.tid < 42) ((LAS unsigned long long*)(F.lds + PTAB_OFF))[F.tid] = (unsigned long long)args.in[F.tid];
    __syncthreads();
    const int lo = args.ph_lo, hi = args.ph_hi;
    XcdBarrier bar; bar.bar = (unsigned*)args.ws + CW_BAR; bar.x = 0; bar.st = MISC + 8;
    if (hi - lo > 1) bar = xcd_barrier_post((unsigned*)args.ws + CW_BAR, MISC + 8);
#define IN(k) (lo <= (k) && (k) < hi)
#ifndef EXTRA_BARS
#define EXTRA_BARS 0
#endif
#define SEAM(k) do { if ((k) + 1 < hi) { xcd_barrier(bar); for (int eb_ = 0; eb_ < EXTRA_BARS; ++eb_) xcd_barrier(bar); } } while (0)
#ifndef EXW_IN_OUT
#define EXW_IN_OUT 1
#endif
#define EXW_TAILN(Fp_, L_, NT_) do { int rem_ = (NT_) % Fp_.G; if (2 * rem_ > Fp_.G) rem_ = 0; if (Fp_.bid >= rem_) { __syncthreads(); Frame F2_ = Fp_; F2_.bid = Fp_.bid - rem_; F2_.G = Fp_.G - rem_; expert_weights(F2_, L_); } } while (0)
#define EXW_TAIL(Fp_, L_) do { if (EXW_IN_OUT && kind != 2) EXW_TAILN(Fp_, L_, (NTOK / 256) * 4); } while (0)
#ifndef DUP_MASK
#define DUP_MASK 0
#endif
#ifndef PRB_MASK
#define PRB_MASK 0
#endif
#define PRB(bit, stmt) do { if ((PRB_MASK >> (bit)) & 1) { stmt; xcd_barrier(bar); } } while (0)
#define DUP(bit, stmt) do { stmt; if ((DUP_MASK >> (bit)) & 1) { xcd_barrier(bar); stmt; } } while (0)

    if (IN(0)) { PRB(0, pre_phase(fresh(F))); pre_phase(fresh(F)); SEAM(0); }
    if (IN(1)) { PRB(0, modsum_phase(fresh(F))); modsum_phase(fresh(F)); SEAM(1); }

    for (int L = 0; L < DEPTH; ++L) {
        const int kind = L % 3, jl = L / 3, pb = PH_LAYER0 + L * PH_PER_LAYER;
        if (IN(pb + 0)) { if (!EXW_IN_OUT) { DUP(6, expert_weights(fresh(F), L)); } if ((PRB_MASK >> 1) & 1) { norm_phase<0, 1>(fresh(F), L, L > 0, kind == 1 ? 2048 : 1024); xcd_barrier(bar); } norm_phase<0>(fresh(F), L, L > 0, kind == 1 ? 2048 : 1024, L == 0); SEAM(pb + 0); }
        if (kind == 0) {
            if (IN(pb + 2)) { DUP(3, gemm_mlin(fresh(F), jl)); SEAM(pb + 2); }
            if (IN(pb + 3)) { DUP(7, conv_phase(fresh(F), jl)); SEAM(pb + 3); }
            if (IN(pb + 4)) { const Frame Fp = fresh(F); GAS unsigned char* MIX = Fp.ws + WS_MIX;
#ifndef SC_PROBE
#define SC_PROBE 0
#endif
#ifndef ML_SCAN
#define ML_SCAN ml_scan3_phase
#endif
#ifndef HG_SCAN
#define HG_SCAN hg_scan3_phase
#endif
#ifndef HG_PROBE
#define HG_PROBE 0
#endif
                if (SC_PROBE) { ML_SCAN<SC_PROBE>(Fp, (const GAS bf16*)(Fp.ws + WS_HY), (const GAS bf16*)(MIX + 2 * ROWB), (const GAS float*)(MIX + 4 * ROWB), (GAS bf16*)MIX); xcd_barrier(bar); }
                DUP(0, ML_SCAN<0>(Fp, (const GAS bf16*)(Fp.ws + WS_HY), (const GAS bf16*)(MIX + 2 * ROWB), (const GAS float*)(MIX + 4 * ROWB), (GAS bf16*)MIX)); SEAM(pb + 4); }
            if (IN(pb + 6)) { const Frame Fp = fresh(F); GAS unsigned char* MIX = Fp.ws + WS_MIX;
                PRB(4, headnorm_phase(Fp, (const GAS bf16*)MIX, (const GAS bf16*)(MIX + ROWB), (const GAS bf16*)(MIX + 3 * ROWB), ldptr(Fp, IN_ML_HEADG) + jl * 1024, (GAS bf16*)(Fp.ws + WS_HY + ROWB)));
                headnorm_phase(Fp, (const GAS bf16*)MIX, (const GAS bf16*)(MIX + ROWB), (const GAS bf16*)(MIX + 3 * ROWB), ldptr(Fp, IN_ML_HEADG) + jl * 1024, (GAS bf16*)(Fp.ws + WS_HY + ROWB)); SEAM(pb + 6); }
            if (IN(pb + 7)) { const Frame Fp = fresh(F); PRB(5, gemm_resid(Fp, (const GAS bf16*)(Fp.ws + WS_HY + ROWB), (const GAS bf16*)(Fp.W + W_ML_WOUT + jl * 2 * MiB), L, 1)); gemm_resid(Fp, (const GAS bf16*)(Fp.ws + WS_HY + ROWB), (const GAS bf16*)(Fp.W + W_ML_WOUT + jl * 2 * MiB), L); EXW_TAIL(Fp, L); SEAM(pb + 7); }
        } else if (kind == 1) {
            if (IN(pb + 1)) { const Frame Fp = fresh(F); du_phase(Fp, (GAS bf16*)(Fp.ws + WS_S + ROWB), (GAS bf16*)(Fp.ws + WS_MIX + 256 * MiB), rw_mix2(Fp)); SEAM(pb + 1); }
            if (IN(pb + 2)) { gemm_rwin(fresh(F)); SEAM(pb + 2); }
            if (IN(pb + 4)) { const Frame Fp = fresh(F); GAS unsigned char* MIX = Fp.ws + WS_MIX; GAS float* WH = (GAS float*)(MIX + 3 * ROWB); GAS float* AH = WH + (size_t)NTOK * 128; GAS float* BETA = (GAS float*)((GAS bf16*)(AH + (size_t)NTOK * 128) + (size_t)NTOK * 256);

#ifndef RW_PROBE
#define RW_PROBE 0
#endif
#ifndef RW_SCAN
#define RW_SCAN rw_scan2_phase
#endif
                if (RW_PROBE) { RW_SCAN<RW_PROBE>(Fp, (const GAS bf16*)MIX, (const GAS bf16*)(MIX + ROWB), (const GAS bf16*)(MIX + 2 * ROWB), (const GAS bf16*)WH, (const GAS bf16*)AH, (GAS bf16*)(Fp.ws + WS_HY), BETA); xcd_barrier(bar); }
                DUP(1, RW_SCAN<0>(Fp, (const GAS bf16*)MIX, (const GAS bf16*)(MIX + ROWB), (const GAS bf16*)(MIX + 2 * ROWB), (const GAS bf16*)WH, (const GAS bf16*)AH, (GAS bf16*)(Fp.ws + WS_HY), BETA)); SEAM(pb + 4); }
            if (IN(pb + 5)) { PRB(4, gemm_rwg(fresh(F))); gemm_rwg(fresh(F)); SEAM(pb + 5); }
            if (IN(pb + 6)) { const Frame Fp = fresh(F); GAS unsigned char* MIX = Fp.ws + WS_MIX; GAS float* WH = (GAS float*)(MIX + 3 * ROWB); GAS float* AH = WH + (size_t)NTOK * 128; GAS float* BETA = (GAS float*)((GAS bf16*)(AH + (size_t)NTOK * 128) + (size_t)NTOK * 256);
                PRB(4, rwpost_phase(Fp, (const GAS bf16*)(Fp.ws + WS_HY), (const GAS bf16*)(Fp.ws + WS_HY + ROWB), BETA, (const GAS bf16*)(MIX + 2 * ROWB), (const GAS bf16*)MIX, (GAS bf16*)(MIX + ROWB)));
                rwpost_phase(Fp, (const GAS bf16*)(Fp.ws + WS_HY), (const GAS bf16*)(Fp.ws + WS_HY + ROWB), BETA, (const GAS bf16*)(MIX + 2 * ROWB), (const GAS bf16*)MIX, (GAS bf16*)(MIX + ROWB)); SEAM(pb + 6); }
            if (IN(pb + 7)) { const Frame Fp = fresh(F); PRB(5, gemm_resid(Fp, (const GAS bf16*)(Fp.ws + WS_MIX + ROWB), (const GAS bf16*)(Fp.W + W_RW_WOUT), L, 1)); gemm_resid(Fp, (const GAS bf16*)(Fp.ws + WS_MIX + ROWB), (const GAS bf16*)(Fp.W + W_RW_WOUT), L); EXW_TAIL(Fp, L); SEAM(pb + 7); }
        } else {
            if (IN(pb + 2)) { DUP(3, gemm_hgin(fresh(F))); if (EXW_IN_OUT) { const Frame Fp = fresh(F); EXW_TAILN(Fp, L, (NTOK / 256) * 20); } SEAM(pb + 2); }
            if (IN(pb + 4)) { const Frame Fp = fresh(F); GAS unsigned char* MIX = Fp.ws + WS_MIX;
                if (HG_PROBE) { HG_SCAN<HG_PROBE>(Fp, (const GAS bf16*)MIX, (const GAS bf16*)(MIX + ROWB), (const GAS bf16*)(MIX + 3 * ROWB), (GAS bf16*)(Fp.ws + WS_HY + ROWB), (GAS bf16*)(Fp.ws + WS_HY)); xcd_barrier(bar); }
                DUP(2, HG_SCAN<0>(Fp, (const GAS bf16*)MIX, (const GAS bf16*)(MIX + ROWB), (const GAS bf16*)(MIX + 3 * ROWB), (GAS bf16*)(Fp.ws + WS_HY + ROWB), (GAS bf16*)(Fp.ws + WS_HY))); SEAM(pb + 4); }
            if (IN(pb + 6)) { const Frame Fp = fresh(F); GAS unsigned char* MIX = Fp.ws + WS_MIX;
                headnorm_phase(Fp, (const GAS bf16*)(Fp.ws + WS_HY + ROWB), (const GAS bf16*)(Fp.ws + WS_HY), (const GAS bf16*)(MIX + 2 * ROWB), ldptr(Fp, IN_HG_HEADG), (GAS bf16*)(Fp.ws + WS_HY + ROWB)); SEAM(pb + 6); }
            if (IN(pb + 7)) { const Frame Fp = fresh(F); PRB(5, gemm_resid(Fp, (const GAS bf16*)(Fp.ws + WS_HY + ROWB), (const GAS bf16*)(Fp.W + W_HG_WOUT), L, 1)); gemm_resid(Fp, (const GAS bf16*)(Fp.ws + WS_HY + ROWB), (const GAS bf16*)(Fp.W + W_HG_WOUT), L); EXW_TAIL(Fp, L); SEAM(pb + 7); }
        }
        if (IN(pb + 8)) { if ((PRB_MASK >> 2) & 1) { route2_phase<1>(fresh(F), L); xcd_barrier(bar); } route2_phase<0>(fresh(F), L);
            SEAM(pb + 8); }
        if (IN(pb + 9)) { if ((PRB_MASK >> 3) & 1) { slots_phase<1>(fresh(F), L); xcd_barrier(bar); } slots_phase<0>(fresh(F), L); SEAM(pb + 9); }
        if (IN(pb + 10)) { DUP(4, gemm_moe1(fresh(F), L)); SEAM(pb + 10); }
        if (IN(pb + 11)) { DUP(5, gemm_moe2(fresh(F), L)); SEAM(pb + 11); }
    }
    if (IN(PH_FINAL)) norm_phase<2>(fresh(F), 0, true, 1024);
#undef IN
#undef SEAM
}

extern "C" void kernel_launch(void* const* d_in, const int* in_sizes, int n_in, void* d_out, int out_size, void* d_ws, size_t ws_size, hipStream_t stream) {
    static int grid = 0;
    if (grid == 0) {
        if (n_in != 42 || out_size != NB * SEQ * D || ws_size < WS_END || (ws_size < WS_END + W_BYTES && ws_size < WS_END + ROWB)) { fprintf(stderr, "kernel_launch: unexpected problem (n_in %d, out %d, ws %zu)\n", n_in, out_size, ws_size); grid = -1; return; }
        int dev = 0, cus = 0, per_cu = 0;
        if (hipGetDevice(&dev) != hipSuccess || hipDeviceGetAttribute(&cus, hipDeviceAttributeMultiprocessorCount, dev) != hipSuccess) { grid = -1; return; }
        if (hipFuncSetAttribute((const void*)fwd_kernel, hipFuncAttributeMaxDynamicSharedMemorySize, LDS_BYTES) != hipSuccess) { fprintf(stderr, "kernel_launch: hipFuncSetAttribute failed\n"); grid = -1; return; }
        if (hipOccupancyMaxActiveBlocksPerMultiprocessor(&per_cu, (const void*)fwd_kernel, NTHR, LDS_BYTES) != hipSuccess || per_cu < 1) { fprintf(stderr, "kernel_launch: occupancy query reports %d\n", per_cu); (void)hipGetLastError(); grid = -1; return; }
        grid = cus;
    }
    if (grid < 0) return;
    (void)hipMemsetAsync(d_ws, 0, CTL_ZERO_BYTES, stream);
    Args a{};
    for (int i = 0; i < 42; ++i) a.in[i] = (const float*)d_in[i];
    a.out = (float*)d_out; a.ws = (unsigned char*)d_ws;
    a.wts = (ws_size >= WS_END + W_BYTES) ? (unsigned char*)d_ws + WS_END : (unsigned char*)d_out;
#if MK_PER_PHASE
    for (int p = 0; p < N_PHASES; ++p) { a.ph_lo = p; a.ph_hi = p + 1; hipLaunchKernelGGL(fwd_kernel, dim3(grid), dim3(NTHR), LDS_BYTES, stream, a); }
#else
    a.ph_lo = 0; a.ph_hi = N_PHASES;
    hipLaunchKernelGGL(fwd_kernel, dim3(grid), dim3(NTHR), LDS_BYTES, stream, a);
#endif
}
```
